# Optimizing an MI355X kernel written in HIP

```python
import jax
import jax.numpy as jnp
from jax import lax
import numpy as np

D_MODEL = 1024
BATCH = 8
SEQ = 4096
DEPTH = 2

CHUNK = 64
N_META = 16
MIX_WIDTH = D_MODEL
RMS_EPS = 1e-6

MLA_HEADS = 4
MLA_NOPE = 128
MLA_ROPE = 64
MLA_V = 128
MLA_Q_LORA = 512
MLA_KV_LORA = 256
ROPE_THETA = 10000.0
Q_BLOCK = 128
MLA_WIDTH = MLA_HEADS * MLA_V

RWKV_WIDTH = MIX_WIDTH - MLA_WIDTH
RWKV_HEAD = 64
RWKV_HEADS = RWKV_WIDTH // RWKV_HEAD
W_LORA = 64
A_LORA = 64
V_LORA = 32
G_LORA = 128
GN_EPS = 64e-5

MLA_COLS = MLA_Q_LORA + MLA_KV_LORA + MLA_ROPE
RWKV_COLS = 3 * RWKV_WIDTH + W_LORA + A_LORA + G_LORA
IN_COLS = MLA_COLS + RWKV_COLS

DENSE_FF = 2816
N_EXPERTS = 8
TOP_K = 2
EXPERT_FF = 3584
MOE_BLOCK = 256
N_DENSE = (DEPTH + 1) // 2
N_MOE = DEPTH // 2

kernel_name = 'hybrid_mla_rwkv7_moe_stream_encoder'


def rms_norm(x, g):
    xf = x.astype(jnp.float32)
    y = xf * lax.rsqrt(jnp.mean(xf * xf, -1, keepdims=True) + RMS_EPS)
    return (y * g.astype(jnp.float32)).astype(x.dtype)


def rope(x, pos):
    half = MLA_ROPE // 2
    inv = ROPE_THETA ** (-jnp.arange(half, dtype=jnp.float32) / half)
    ang = pos.astype(jnp.float32)[:, None] * inv[None, :]
    cos, sin = jnp.cos(ang), jnp.sin(ang)
    xf = x.astype(jnp.float32)
    x1, x2 = xf[..., :half], xf[..., half:]
    return jnp.concatenate([x1 * cos - x2 * sin, x1 * sin + x2 * cos], -1).astype(x.dtype)


def chunk_ids(n_pad, n_valid):
    idx = jnp.arange(n_pad)
    cid = jnp.where(idx < N_META, 0, 1 + (idx - N_META) // CHUNK)
    return jnp.where(idx < n_valid, cid, n_pad)


def mla_mixer(pm, q_norm, kv_norm, w_uq, w_ukv):
    B, L, _ = pm.shape
    c_q = pm[..., :MLA_Q_LORA]
    c_kv = pm[..., MLA_Q_LORA:MLA_Q_LORA + MLA_KV_LORA]
    k_rope_in = pm[..., MLA_Q_LORA + MLA_KV_LORA:]
    pos = jnp.arange(L)
    q = (rms_norm(c_q, q_norm) @ w_uq).reshape(B, L, MLA_HEADS, MLA_NOPE + MLA_ROPE).transpose(0, 2, 1, 3)
    kv = (rms_norm(c_kv, kv_norm) @ w_ukv).reshape(B, L, MLA_HEADS, MLA_NOPE + MLA_V).transpose(0, 2, 1, 3)
    q_nope, q_rope = q[..., :MLA_NOPE], rope(q[..., MLA_NOPE:], pos)
    k_nope, v = kv[..., :MLA_NOPE], kv[..., MLA_NOPE:]
    k_rope = rope(k_rope_in, pos)
    n_blk = -(-L // Q_BLOCK)
    Lp = n_blk * Q_BLOCK
    pad4 = ((0, 0), (0, 0), (0, Lp - L), (0, 0))
    q_nope, q_rope = jnp.pad(q_nope, pad4), jnp.pad(q_rope, pad4)
    k_nope, v = jnp.pad(k_nope, pad4), jnp.pad(v, pad4)
    k_rope = jnp.pad(k_rope, ((0, 0), (0, Lp - L), (0, 0)))
    cid = chunk_ids(Lp, L)
    scale = (MLA_NOPE + MLA_ROPE) ** -0.5

    def to_blocks(t):
        return t.reshape(B, MLA_HEADS, n_blk, Q_BLOCK, t.shape[-1]).transpose(2, 0, 1, 3, 4)

    def query_block(args):
        qn, qr, qc = args
        s = jnp.einsum('bhqd,bhkd->bhqk', qn, k_nope) + jnp.einsum('bhqr,bkr->bhqk', qr, k_rope)
        s = s.astype(jnp.float32) * scale
        s = jnp.where(cid[None, :] <= qc[:, None], s, -jnp.inf)
        p = jax.nn.softmax(s, axis=-1).astype(v.dtype)
        return jnp.einsum('bhqk,bhkd->bhqd', p, v)

    o = lax.map(query_block, (to_blocks(q_nope), to_blocks(q_rope), cid.reshape(n_blk, Q_BLOCK)))
    o = o.transpose(1, 0, 3, 2, 4).reshape(B, Lp, MLA_WIDTH)
    return o[:, :L]


def token_shift(p, mu):
    prev = jnp.pad(p, ((0, 0), (1, 0), (0, 0)))[:, :-1]
    return p + (prev - p) * mu


def rwkv7_scan(r, w, k, v, a, b):
    B, L, H, N = r.shape

    def step(S, xs):
        r_t, w_t, k_t, v_t, a_t, b_t = xs
        sa = jnp.einsum('bhij,bhj->bhi', S, a_t)
        S = S * w_t[:, :, None, :] + sa[..., None] * b_t[:, :, None, :] + v_t[..., :, None] * k_t[:, :, None, :]
        return S, jnp.einsum('bhij,bhj->bhi', S, r_t)

    S0 = jnp.zeros((B, H, N, N), jnp.float32)
    xs = tuple(t.transpose(1, 0, 2, 3) for t in (r, w, k, v, a, b))
    _, y = lax.scan(step, S0, xs)
    return y.transpose(1, 0, 2, 3)


def rwkv7_mixer(p, mu, w0, w2, a0, a2, g2, k_k, k_a, r_k, ln_w, ln_b, v_first, v_res):
    B, L, _ = p.shape
    C, H, N = RWKV_WIDTH, RWKV_HEADS, RWKV_HEAD
    f32 = jnp.float32
    p = token_shift(p, mu)
    r = p[..., :C]
    k = p[..., C:2 * C]
    v = p[..., 2 * C:3 * C]
    o = 3 * C
    xw = p[..., o:o + W_LORA]
    xa = p[..., o + W_LORA:o + W_LORA + A_LORA]
    xg = p[..., o + W_LORA + A_LORA:]
    w_log = -jax.nn.softplus(-(w0 + jnp.tanh(xw) @ w2)) - 0.5
    decay = jnp.exp(-jnp.exp(w_log.astype(f32)))
    if v_res is None:
        v_first = v
    else:
        v0, v1, v2 = v_res
        v = v + (v_first - v) * jax.nn.sigmoid(v0 + (v @ v1) @ v2)
    a = jax.nn.sigmoid(a0 + xa @ a2)
    g = jax.nn.sigmoid(xg) @ g2

    def heads(t):
        return t.astype(f32).reshape(B, L, H, N)

    kk = heads(k * k_k)
    kk = kk * lax.rsqrt(jnp.maximum(jnp.sum(kk * kk, -1, keepdims=True), 1e-24))
    k = k * (1 + (a - 1) * k_a)
    rh, kh, vh, ah = heads(r), heads(k), heads(v), heads(a)
    y = rwkv7_scan(rh, decay.reshape(B, L, H, N), kh, vh, -kk, kk * ah)
    mean = jnp.mean(y, -1, keepdims=True)
    var = jnp.mean(jnp.square(y - mean), -1, keepdims=True)
    y = ((y - mean) * lax.rsqrt(var + GN_EPS)).reshape(B, L, C) * ln_w.astype(f32) + ln_b.astype(f32)
    bonus = jnp.sum(rh * kh * r_k.astype(f32), -1, keepdims=True) * vh
    y = (y + bonus.reshape(B, L, C)).astype(p.dtype) * g
    return y, v_first


def swiglu(h, w_gate, w_up, w_down):
    return (jax.nn.silu(h @ w_gate) * (h @ w_up)) @ w_down


def moe_swiglu(h, router, router_bias, w_gate, w_up, w_down):
    B, L, D = h.shape
    T = B * L
    x = h.reshape(T, D)
    logits = (x @ router).astype(jnp.float32) + router_bias.astype(jnp.float32)
    top_logit, top_idx = lax.top_k(logits, TOP_K)
    gates = jax.nn.softmax(top_logit, axis=-1)
    n_assign = T * TOP_K
    flat_e = top_idx.reshape(-1)
    flat_tok = jnp.repeat(jnp.arange(T, dtype=jnp.int32), TOP_K)
    flat_g = gates.reshape(-1)
    order = jnp.argsort(flat_e)
    se, stok, sg = flat_e[order], flat_tok[order], flat_g[order]
    counts = jnp.zeros((N_EXPERTS,), jnp.int32).at[flat_e].add(1)
    padded = (counts + MOE_BLOCK - 1) // MOE_BLOCK * MOE_BLOCK
    start = jnp.cumsum(counts) - counts
    pend = jnp.cumsum(padded)
    pstart = pend - padded
    slot = pstart[se] + (jnp.arange(n_assign, dtype=jnp.int32) - start[se])
    n_blocks = (n_assign + N_EXPERTS * (MOE_BLOCK - 1)) // MOE_BLOCK + 1
    P = n_blocks * MOE_BLOCK
    slot_tok = jnp.full((P,), T, jnp.int32).at[slot].set(stok)
    slot_gate = jnp.zeros((P,), jnp.float32).at[slot].set(sg)
    block_e = jnp.minimum(jnp.searchsorted(pend, jnp.arange(n_blocks, dtype=jnp.int32) * MOE_BLOCK, side='right'), N_EXPERTS - 1)
    x_pad = jnp.concatenate([x, jnp.zeros((1, D), x.dtype)], 0)
    xb = x_pad[slot_tok].reshape(n_blocks, MOE_BLOCK, D)

    def expert_block(args):
        xe, e = args
        return swiglu(xe, w_gate[e], w_up[e], w_down[e])

    yb = lax.map(expert_block, (xb, block_e)).reshape(P, D)
    out = jnp.zeros((T + 1, D), jnp.float32).at[slot_tok].add(yb.astype(jnp.float32) * slot_gate[:, None])
    return out[:T].astype(h.dtype).reshape(B, L, D)


def setup_inputs(seed: int = 0) -> dict:
    key = jax.random.key(seed)
    keys = iter(jax.random.split(key, 64))
    f32 = jnp.float32

    def normal(shape, scale):
        return scale * jax.random.normal(next(keys), shape, f32)

    def gain(shape):
        return 1.0 + 0.01 * jax.random.normal(next(keys), shape, f32)

    D, C = D_MODEL, RWKV_WIDTH
    return {
        'x': normal((BATCH, SEQ, D), 1.0),
        'meta_tokens': normal((N_META, D), 1.0),
        'attn_norm': gain((DEPTH, D)),
        'ffn_norm': gain((DEPTH, D)),
        'final_norm': gain((D,)),
        'w_in': normal((DEPTH, D, IN_COLS), D ** -0.5),
        'w_out': normal((DEPTH, MIX_WIDTH, D), MIX_WIDTH ** -0.5),
        'mla_q_norm': gain((DEPTH, MLA_Q_LORA)),
        'mla_kv_norm': gain((DEPTH, MLA_KV_LORA)),
        'mla_w_uq': normal((DEPTH, MLA_Q_LORA, MLA_HEADS * (MLA_NOPE + MLA_ROPE)), MLA_Q_LORA ** -0.5),
        'mla_w_ukv': normal((DEPTH, MLA_KV_LORA, MLA_HEADS * (MLA_NOPE + MLA_V)), MLA_KV_LORA ** -0.5),
        'rwkv_mu': jax.random.uniform(next(keys), (DEPTH, RWKV_COLS), f32),
        'rwkv_w0': -2.5 + normal((DEPTH, C), 0.5),
        'rwkv_w2': normal((DEPTH, W_LORA, C), W_LORA ** -0.5),
        'rwkv_a0': normal((DEPTH, C), 0.5),
        'rwkv_a2': normal((DEPTH, A_LORA, C), A_LORA ** -0.5),
        'rwkv_g2': normal((DEPTH, G_LORA, C), G_LORA ** -0.5),
        'rwkv_k_k': 0.85 + normal((DEPTH, C), 0.05),
        'rwkv_k_a': 1.0 + normal((DEPTH, C), 0.05),
        'rwkv_r_k': normal((DEPTH, RWKV_HEADS, RWKV_HEAD), 0.1),
        'rwkv_ln_w': gain((DEPTH, C)),
        'rwkv_ln_b': normal((DEPTH, C), 0.01),
        'rwkv_v0': normal((DEPTH - 1, C), 0.5),
        'rwkv_v1': normal((DEPTH - 1, C, V_LORA), C ** -0.5),
        'rwkv_v2': normal((DEPTH - 1, V_LORA, C), V_LORA ** -0.5),
        'ffn_w_gate': normal((N_DENSE, D, DENSE_FF), D ** -0.5),
        'ffn_w_up': normal((N_DENSE, D, DENSE_FF), D ** -0.5),
        'ffn_w_down': normal((N_DENSE, DENSE_FF, D), DENSE_FF ** -0.5),
        'moe_router': normal((N_MOE, D, N_EXPERTS), D ** -0.5),
        'moe_router_bias': normal((N_MOE, N_EXPERTS), 0.01),
        'moe_w_gate': normal((N_MOE, N_EXPERTS, D, EXPERT_FF), D ** -0.5),
        'moe_w_up': normal((N_MOE, N_EXPERTS, D, EXPERT_FF), D ** -0.5),
        'moe_w_down': normal((N_MOE, N_EXPERTS, EXPERT_FF, D), EXPERT_FF ** -0.5),
    }


def reference(x, meta_tokens, attn_norm, ffn_norm, final_norm, w_in, w_out, mla_q_norm, mla_kv_norm, mla_w_uq, mla_w_ukv, rwkv_mu, rwkv_w0, rwkv_w2, rwkv_a0, rwkv_a2, rwkv_g2, rwkv_k_k, rwkv_k_a, rwkv_r_k, rwkv_ln_w, rwkv_ln_b, rwkv_v0, rwkv_v1, rwkv_v2, ffn_w_gate, ffn_w_up, ffn_w_down, moe_router, moe_router_bias, moe_w_gate, moe_w_up, moe_w_down):
    B = x.shape[0]
    meta = jnp.broadcast_to(meta_tokens[None].astype(x.dtype), (B, N_META, D_MODEL))
    h = jnp.concatenate([meta, x], axis=1)
    v_first = None
    for i in range(DEPTH):
        u = rms_norm(h, attn_norm[i])
        proj = u @ w_in[i]
        y_mla = mla_mixer(proj[..., :MLA_COLS], mla_q_norm[i], mla_kv_norm[i], mla_w_uq[i], mla_w_ukv[i])
        v_res = None if i == 0 else (rwkv_v0[i - 1], rwkv_v1[i - 1], rwkv_v2[i - 1])
        y_rwkv, v_first = rwkv7_mixer(proj[..., MLA_COLS:], rwkv_mu[i], rwkv_w0[i], rwkv_w2[i], rwkv_a0[i], rwkv_a2[i], rwkv_g2[i], rwkv_k_k[i], rwkv_k_a[i], rwkv_r_k[i], rwkv_ln_w[i], rwkv_ln_b[i], v_first, v_res)
        h = h + jnp.concatenate([y_mla, y_rwkv], axis=-1) @ w_out[i]
        u = rms_norm(h, ffn_norm[i])
        j = i // 2
        if i % 2 == 0:
            f = swiglu(u, ffn_w_gate[j], ffn_w_up[j], ffn_w_down[j])
        else:
            f = moe_swiglu(u, moe_router[j], moe_router_bias[j], moe_w_gate[j], moe_w_up[j], moe_w_down[j])
        h = h + f
    return rms_norm(h, final_norm)[:, N_META:]
```

```cpp
#include <hip/hip_runtime.h>
#include <cstdio>
#include <cstdint>
namespace pg8 {
#define PG8_LAS __attribute__((address_space(3)))
typedef unsigned short bf16_t;
typedef short bf16x8 __attribute__((ext_vector_type(8)));
typedef float f32x4 __attribute__((ext_vector_type(4)));
typedef unsigned u32x4 __attribute__((ext_vector_type(4)));
constexpr int BM = 256, BK = 64, HALF = 128, HTB = HALF * BK * 2  , STAGE_BYTES = 8 * HTB, NXCD = 8, WGM = 8;

__host__ __device__ __forceinline__ int lds_byte(int r, int c) { const int st = (r >> 4) * 2 + (c >> 5), rr = r & 15, cc = c & 31, ob = rr * 64 + cc * 2; return st * 1024 + (ob ^ (((ob >> 9) & 1) << 5)); }
__host__ __device__ __forceinline__ void stage_rc(int b, int& R, int& C) { const int st = b / 1024, sb = b % 1024, swz = sb ^ (((sb >> 9) & 1) << 5); R = (st >> 1) * 16 + swz / 64; C = (st & 1) * 32 + (swz % 64) / 2; }
__host__ __device__ __forceinline__ int perm32(int rho) { const int n = rho >> 4, i = rho & 15; return 8 * (i >> 2) + 4 * n + (i & 3); }

struct Unit { int pm, pn, k0; };
struct Gemm { const bf16_t* A; const bf16_t* Bt; int M, N, K, lda, ldb, pad; };

struct StaticOrder {
    static constexpr bool GATHER = false;
    int nM, nN, nwg, G, c;
    __host__ __device__ void init(int M, int N, int G_, int c_) { nM = M / BM; nN = N / BM; nwg = nM * nN; G = G_; c = c_; }
    __host__ __device__ bool next(int i, Unit& u) const {
        const long L = (long)i * G + c; if (L >= nwg) return false;
        int wgid = (int)L; { const int q = nwg / NXCD, r = nwg % NXCD, xcd = wgid % NXCD, off = wgid / NXCD; wgid = (xcd < r ? xcd * (q + 1) : r * (q + 1) + (xcd - r) * q) + off; }
        const int nig = WGM * nN, gid = wgid / nig, fm = gid * WGM, gsz = (nM - fm) < WGM ? (nM - fm) : WGM;
        u.pm = fm + ((wgid % nig) % gsz); u.pn = (wgid % nig) / gsz; u.k0 = 0; return true;
    }
    __device__ __forceinline__ void a_ready(const Unit&) const {}
    __device__ __forceinline__ void done(const Unit&) const {}
};

__device__ __forceinline__ unsigned cvt_pk_bf16(float lo, float hi) { unsigned r; asm volatile("v_cvt_pk_bf16_f32 %0, %1, %2" : "=v"(r) : "v"(lo), "v"(hi)); return r; }
typedef int i32x4_ __attribute__((ext_vector_type(4)));
typedef int i32x8_ __attribute__((ext_vector_type(8)));
template <class Epi, class Sched, bool ALIGN_EPI = false, bool SP2 = false, bool FP8 = false>
__device__ __forceinline__ void gemm_phase(PG8_LAS unsigned char* lds, const Gemm g, const Sched& S, const Epi& E) {
    int tid_ = threadIdx.x; asm volatile("" : "+v"(tid_)); const int tid = tid_, wid = __builtin_amdgcn_readfirstlane(tid >> 6), lane = tid & 63, wr = wid >> 2, wc = wid & 3, fr = lane & 15, fq = lane >> 4;
    const int K = g.K, nt = K / BK;
    unsigned voffA[2], voffB[2];
#pragma unroll
    for (int i = 0; i < 2; ++i) { int R, C; stage_rc(tid * 16 + i * 8192, R, C); const int Rb = Epi::PERM ? ((R & ~31) + perm32(R & 31)) : R;
        voffA[i] = (unsigned)(R * g.lda + C) * 2u; voffB[i] = (unsigned)(Rb * g.ldb + C) * 2u; }
    constexpr bool GATHER = Sched::GATHER;
    unsigned vAc[2][2] = {{0u, 0u}, {0u, 0u}}, vAn[2][2] = {{0u, 0u}, {0u, 0u}}, cbA[2] = {0u, 0u};
    if constexpr (GATHER) {
#pragma unroll
        for (int i = 0; i < 2; ++i) { int R, C; stage_rc(tid * 16 + i * 8192, R, C); cbA[i] = (unsigned)C * 2u; }
    }
#define PG8_IDX_DMA(un, slot) do { if constexpr (GATHER) { const int* rp_ = S.rows + (size_t)(un).pm * 256 + 128 * (lane >> 5) + 64 * ((lane >> 4) & 1) + 16 * (wid >> 1) + (lane & 15); \
        __builtin_amdgcn_global_load_lds((const unsigned*)rp_, (PG8_LAS unsigned*)(lds + STAGE_BYTES + wid * 512 + (slot) * 256), 4, 0, 0); } } while (0)
#define PG8_IDX_READ(dst, slot) do { if constexpr (GATHER) { int t3_ = threadIdx.x; asm volatile("" : "+v"(t3_));     \
        _Pragma("unroll") for (int h_ = 0; h_ < 2; ++h_) _Pragma("unroll") for (int i_ = 0; i_ < 2; ++i_) { int R_, C_; stage_rc(t3_ * 16 + i_ * 8192, R_, C_); \
        int tk_ = *(const PG8_LAS int*)(lds + STAGE_BYTES + (t3_ >> 6) * 512 + (slot) * 256 + 4 * (32 * h_ + 16 * i_ + ((t3_ & 63) >> 2))); tk_ = tk_ < 0 ? S.zero_row : tk_; \
        dst[h_][i_] = (unsigned)tk_ * (unsigned)(g.lda * 2) + (unsigned)C_ * 2u; } } } while (0)
#define PG8_STAGE_A(bufoff, base, h, nx) do { if constexpr (GATHER) { const unsigned vs_[2] = {(nx) ? vAn[h][0] : vAc[h][0], (nx) ? vAn[h][1] : vAc[h][1]}; PG8_STAGE(bufoff, base, vs_); } \
        else { PG8_STAGE(bufoff, (base) + (h) * hstepA, voffA); } } while (0)
    const size_t kstep = (size_t)(BK * 2);
    const size_t hstepA = (size_t)HALF * g.lda * 2, hstepB = (size_t)HALF * g.ldb * 2;
    const size_t tstepA = 2 * hstepA, tstepB = 2 * hstepB;
    const unsigned ldsw = (unsigned)wid * 1024u;
    const int aoff = lds_byte(wr * 64 + fr, fq * 8), boff = lds_byte(wc * 32 + fr, fq * 8);
#define PG8_SA(b, h) (((b) * 2 + (h)) * HTB)
#define PG8_SB(b, h) ((4 + (b) * 2 + (h)) * HTB)
#define PG8_STAGE(bufoff, gbase, voff) do { const char* gb_ = (const char*)(gbase); asm volatile("" : "+s"(gb_));   \
        _Pragma("unroll") for (int _i = 0; _i < 2; ++_i) \
        __builtin_amdgcn_global_load_lds((const unsigned*)(gb_ + (voff)[_i]), (PG8_LAS unsigned*)(lds + (bufoff) + ldsw + _i * 8192), 16, 0, 0); } while (0)
#define PG8_LDA(dst, b, h) do { _Pragma("unroll") for (int m = 0; m < 4; ++m) _Pragma("unroll") for (int k = 0; k < 2; ++k) dst[m][k] = *(const PG8_LAS bf16x8*)(lds + PG8_SA(b, h) + aoff + m * 2048 + k * 1024); } while (0)
#define PG8_LDB(dst, b, h) do { _Pragma("unroll") for (int n = 0; n < 2; ++n) _Pragma("unroll") for (int k = 0; k < 2; ++k) dst[n][k] = *(const PG8_LAS bf16x8*)(lds + PG8_SB(b, h) + boff + n * 2048 + k * 1024); } while (0)
#define PG8_MMA(ai, bj, At, Bt) do { __builtin_amdgcn_s_setprio(1); _Pragma("unroll") for (int m = 0; m < 4; ++m) _Pragma("unroll") for (int n = 0; n < 2; ++n) { \
        if constexpr (FP8) { const i32x8_ b8_ = __builtin_shufflevector(__builtin_bit_cast(i32x4_, Bt[n][0]), __builtin_bit_cast(i32x4_, Bt[n][1]), 0, 1, 2, 3, 4, 5, 6, 7); \
            const i32x8_ a8_ = __builtin_shufflevector(__builtin_bit_cast(i32x4_, At[m][0]), __builtin_bit_cast(i32x4_, At[m][1]), 0, 1, 2, 3, 4, 5, 6, 7); \
            acc[ai][bj][m][n] = __builtin_amdgcn_mfma_scale_f32_16x16x128_f8f6f4(b8_, a8_, acc[ai][bj][m][n], 0, 0, 0, 0, 0, 0); }     \
        else { _Pragma("unroll") for (int k = 0; k < 2; ++k) acc[ai][bj][m][n] = __builtin_amdgcn_mfma_f32_16x16x32_bf16(Bt[n][k], At[m][k], acc[ai][bj][m][n], 0, 0, 0); } } \
        __builtin_amdgcn_s_setprio(0); } while (0)
#define PG8_WAIT_V(n) asm volatile("s_waitcnt vmcnt(" #n ")" ::: "memory")
#define PG8_WAIT_L(n) asm volatile("s_waitcnt lgkmcnt(" #n ")" ::: "memory")
#define PG8_BAR __builtin_amdgcn_s_barrier()
#define PG8_SCHED __builtin_amdgcn_sched_barrier(0)
    Unit cur, nxt; int ui = 0;
    if (!S.next(0, cur)) return;
    float zf_ = 0.f; asm volatile("" : "+v"(zf_));
    f32x4 acc[2][2][4][2];
#pragma unroll
    for (int a = 0; a < 2; ++a)
#pragma unroll
        for (int b = 0; b < 2; ++b)
#pragma unroll
            for (int m = 0; m < 4; ++m)
#pragma unroll
                for (int n = 0; n < 2; ++n) acc[a][b][m][n] = (f32x4){zf_, zf_, zf_, zf_};
    bf16x8 At[4][2], B0[2][2], B1[2][2];
    const char* cA = (const char*)g.A + (GATHER ? (size_t)0 : (size_t)cur.pm * tstepA) + (size_t)cur.k0 * 2; const char* cB = (const char*)g.Bt + (size_t)cur.pn * tstepB + (size_t)cur.k0 * 2;
    S.a_ready(cur);
    if constexpr (GATHER) { PG8_IDX_DMA(cur, 0); asm volatile("s_waitcnt vmcnt(0)" ::: "memory"); PG8_IDX_READ(vAc, 0); }
    if constexpr (SP2) {
        PG8_STAGE(PG8_SB(0, 0), cB, voffB); PG8_STAGE(PG8_SB(0, 1), cB + hstepB, voffB); PG8_STAGE_A(PG8_SA(0, 0), cA, 0, false); PG8_STAGE_A(PG8_SA(0, 1), cA, 1, false);
        if (wr == 1) PG8_BAR;
        PG8_WAIT_V(2); PG8_BAR;
        PG8_STAGE(PG8_SB(1, 0), cB + kstep, voffB); PG8_STAGE_A(PG8_SA(1, 0), cA + kstep, 0, false); PG8_STAGE(PG8_SB(1, 1), cB + hstepB + kstep, voffB);
        PG8_WAIT_V(6); PG8_BAR;
    } else {
        PG8_STAGE(PG8_SB(0, 0), cB, voffB); PG8_STAGE(PG8_SA(0, 0), cA, voffA); PG8_STAGE(PG8_SB(0, 1), cB + hstepB, voffB); PG8_STAGE(PG8_SA(0, 1), cA + hstepA, voffA);
        if (wr == 1) PG8_BAR;
        PG8_WAIT_V(4); PG8_BAR;
        PG8_STAGE(PG8_SB(1, 0), cB + kstep, voffB); PG8_STAGE(PG8_SA(1, 0), cA + kstep, voffA); PG8_STAGE(PG8_SB(1, 1), cB + hstepB + kstep, voffB);
        PG8_WAIT_V(6); PG8_BAR;
    }
    for (;;) {
        const bool has_next = S.next(ui + 1, nxt);
        const char* nA = has_next ? (const char*)g.A + (GATHER ? (size_t)0 : (size_t)nxt.pm * tstepA) + (size_t)nxt.k0 * 2 : cA; const char* nB = has_next ? (const char*)g.Bt + (size_t)nxt.pn * tstepB + (size_t)nxt.k0 * 2 : cB;
        if constexpr (GATHER) { if (has_next) PG8_IDX_DMA(nxt, (ui + 1) & 1); }
        for (int t = 0; t < nt; t += 2) {
            const bool last = (t == nt - 2); const bool lnx = last && has_next;
            const char* a1 = cA + (size_t)(t + 1) * kstep;
            const char* a2 = last ? nA : cA + (size_t)(t + 2) * kstep; const char* b2 = last ? nB : cB + (size_t)(t + 2) * kstep;
            const char* a3 = a2 + kstep; const char* b3 = b2 + kstep;
            if (last && has_next) S.a_ready(nxt);
            if constexpr (GATHER) { if (lnx) PG8_IDX_READ(vAn, (ui + 1) & 1); }
            if constexpr (SP2) {
            PG8_LDB(B0, 0, 0); PG8_LDB(B1, 0, 1); PG8_SCHED; PG8_LDA(At, 0, 0); PG8_STAGE_A(PG8_SA(1, 1), a1, 1, false);
            PG8_WAIT_V(8); PG8_WAIT_L(0); PG8_BAR; PG8_MMA(0, 0, At, B0); PG8_MMA(0, 1, At, B1); PG8_BAR; PG8_SCHED;
            PG8_LDA(At, 0, 1); PG8_STAGE(PG8_SB(0, 0), b2, voffB); PG8_STAGE(PG8_SB(0, 1), b2 + hstepB, voffB); PG8_STAGE_A(PG8_SA(0, 0), a2, 0, lnx);
            PG8_WAIT_V(8); PG8_WAIT_L(0); PG8_BAR; PG8_MMA(1, 0, At, B0); PG8_MMA(1, 1, At, B1); PG8_BAR; PG8_SCHED;
            PG8_LDB(B0, 1, 0); PG8_LDB(B1, 1, 1); PG8_SCHED; PG8_LDA(At, 1, 0); PG8_STAGE_A(PG8_SA(0, 1), a2, 1, lnx);
            PG8_WAIT_V(8); PG8_WAIT_L(0); PG8_BAR; PG8_MMA(0, 0, At, B0); PG8_MMA(0, 1, At, B1); PG8_BAR; PG8_SCHED;
            PG8_LDA(At, 1, 1); PG8_STAGE(PG8_SB(1, 0), b3, voffB); PG8_STAGE(PG8_SB(1, 1), b3 + hstepB, voffB); PG8_STAGE_A(PG8_SA(1, 0), a3, 0, lnx);
            PG8_WAIT_V(8); PG8_WAIT_L(0); PG8_BAR; PG8_MMA(1, 0, At, B0); PG8_MMA(1, 1, At, B1); PG8_BAR; PG8_SCHED;
            } else {
            PG8_LDB(B0, 0, 0); PG8_SCHED; PG8_LDA(At, 0, 0); PG8_STAGE(PG8_SA(1, 1), a1 + hstepA, voffA);
            PG8_WAIT_L(8); PG8_BAR; PG8_WAIT_L(0); PG8_MMA(0, 0, At, B0); PG8_BAR; PG8_SCHED;
            PG8_LDB(B1, 0, 1); PG8_STAGE(PG8_SB(0, 0), b2, voffB);
            PG8_BAR; PG8_WAIT_L(0); PG8_MMA(0, 1, At, B1); PG8_BAR;
            PG8_LDA(At, 0, 1); PG8_STAGE(PG8_SA(0, 0), a2, voffA);
            PG8_BAR; PG8_WAIT_L(0); PG8_MMA(1, 0, At, B0); PG8_BAR; PG8_SCHED;
            PG8_STAGE(PG8_SB(0, 1), b2 + hstepB, voffB);
            PG8_WAIT_V(6); PG8_BAR; PG8_MMA(1, 1, At, B1); PG8_BAR;
            PG8_LDB(B0, 1, 0); PG8_SCHED; PG8_LDA(At, 1, 0); PG8_STAGE(PG8_SA(0, 1), a2 + hstepA, voffA);
            PG8_WAIT_L(8); PG8_BAR; PG8_WAIT_L(0); PG8_MMA(0, 0, At, B0); PG8_BAR; PG8_SCHED;
            PG8_LDB(B1, 1, 1); PG8_STAGE(PG8_SB(1, 0), b3, voffB);
            PG8_BAR; PG8_WAIT_L(0); PG8_MMA(0, 1, At, B1); PG8_BAR;
            PG8_LDA(At, 1, 1); PG8_STAGE(PG8_SA(1, 0), a3, voffA);
            PG8_BAR; PG8_WAIT_L(0); PG8_MMA(1, 0, At, B0); PG8_BAR; PG8_SCHED;
            PG8_STAGE(PG8_SB(1, 1), b3 + hstepB, voffB);
            PG8_WAIT_V(6); PG8_BAR; PG8_MMA(1, 1, At, B1); PG8_BAR;
            }
        }
        if constexpr (ALIGN_EPI) { if (wr == 0) PG8_BAR; }
        if constexpr (!Epi::AFTER_DRAIN) { int t2_ = threadIdx.x; asm volatile("" : "+v"(t2_)); const int fr2_ = t2_ & 15, fq2_ = (t2_ >> 4) & 3;
            E(acc, cur, wr, wc, fr2_, fq2_); S.done(cur); }
        if (!has_next) break;
#pragma unroll
        for (int a = 0; a < 2; ++a)
#pragma unroll
            for (int b = 0; b < 2; ++b)
#pragma unroll
                for (int m = 0; m < 4; ++m)
#pragma unroll
                    for (int n = 0; n < 2; ++n) acc[a][b][m][n] = (f32x4){zf_, zf_, zf_, zf_};
        cur = nxt; cA = nA; cB = nB; ++ui;
        if constexpr (GATHER) { vAc[0][0] = vAn[0][0]; vAc[0][1] = vAn[0][1]; vAc[1][0] = vAn[1][0]; vAc[1][1] = vAn[1][1]; }
        if constexpr (ALIGN_EPI) { if (wr == 1) PG8_BAR; }
    }
    PG8_WAIT_V(0);
    if constexpr (!ALIGN_EPI) { if (wr == 0) PG8_BAR; }
    PG8_BAR;
    if constexpr (Epi::AFTER_DRAIN) { E.fused(acc, cur, wr, wc, fr, fq, lds, wid, lane); S.done(cur); }
#undef PG8_SA
#undef PG8_SB
#undef PG8_STAGE
#undef PG8_STAGE_A
#undef PG8_IDX_DMA
#undef PG8_IDX_READ
#undef PG8_LDA
#undef PG8_LDB
#undef PG8_MMA
#undef PG8_WAIT_V
#undef PG8_WAIT_L
#undef PG8_BAR
#undef PG8_SCHED
}
}

typedef unsigned short bf16_t;
typedef short bf16x8 __attribute__((ext_vector_type(8)));
typedef short s16x4 __attribute__((ext_vector_type(4)));
typedef float f32x4 __attribute__((ext_vector_type(4)));
typedef float f32x16 __attribute__((ext_vector_type(16)));
typedef unsigned u32x4 __attribute__((ext_vector_type(4)));
typedef unsigned u32x2 __attribute__((ext_vector_type(2)));
#define LAS __attribute__((address_space(3)))
#define GAS __attribute__((address_space(1)))

constexpr int D = 1024, NB = 8, SEQ = 4096, NMETA = 16;
constexpr int RREAL = NB * SEQ;
constexpr int RVALID = RREAL + NMETA;
constexpr int NPAN = 129, RP = NPAN * 256;
constexpr int PMW = 1024, PRW = 1792;
constexpr int CW = 512;
constexpr int FF0 = 2816, FFE = 3584, NEXP = 8;
constexpr float RMS_EPS = 1e-6f, GN_EPS = 64e-5f;
constexpr int MOE_MAXPAN = 144;
constexpr int MOE_TAILPAN = 128, MOE_GAP = 8;
#ifndef MOE_CSKIP
#define MOE_CSKIP 5
#endif

typedef float f32x2_t __attribute__((ext_vector_type(2))); typedef __bf16 bf16x2_t __attribute__((ext_vector_type(2)));
__device__ __forceinline__ unsigned cvtpk(float lo, float hi) { f32x2_t v = {lo, hi}; bf16x2_t b = __builtin_convertvector(v, bf16x2_t); return __builtin_bit_cast(unsigned, b); }
__device__ __forceinline__ bf16_t f2bf_hw(float x) { return (bf16_t)(cvtpk(x, x) & 0xffffu); }
__device__ __forceinline__ float bf2f(bf16_t b) { return __uint_as_float(((unsigned)b) << 16); }
__device__ __forceinline__ bf16_t f2bf(float f) { unsigned u = __float_as_uint(f); u += 0x7fffu + ((u >> 16) & 1u); return (bf16_t)(u >> 16); }
__device__ __forceinline__ unsigned pk2(float lo, float hi) { return (unsigned)f2bf(lo) | ((unsigned)f2bf(hi) << 16); }
#define DPP_F(v_, ctrl_, rmask_) __int_as_float(__builtin_amdgcn_update_dpp(0, __float_as_int(v_), (ctrl_), (rmask_), 0xf, false))
__device__ __forceinline__ float wave_sum(float v) {
    v += DPP_F(v, 0xB1, 0xf); v += DPP_F(v, 0x4E, 0xf); v += DPP_F(v, 0x141, 0xf); v += DPP_F(v, 0x140, 0xf);
    v += DPP_F(v, 0x142, 0xa); v += DPP_F(v, 0x143, 0xc);
    return __int_as_float(__builtin_amdgcn_readlane(__float_as_int(v), 63));
}
__device__ __forceinline__ float wave_max(float v) {
    v = fmaxf(v, DPP_F(v, 0xB1, 0xf)); v = fmaxf(v, DPP_F(v, 0x4E, 0xf)); v = fmaxf(v, DPP_F(v, 0x141, 0xf)); v = fmaxf(v, DPP_F(v, 0x140, 0xf));
    v = fmaxf(v, DPP_F(v, 0x142, 0xa)); v = fmaxf(v, DPP_F(v, 0x143, 0xc));
    return __int_as_float(__builtin_amdgcn_readlane(__float_as_int(v), 63));
}
constexpr float F8_MAX = 448.0f, F8_ACT = 8.0f;
__device__ __forceinline__ unsigned pk4_f8(float a, float b, float c, float d) {
    float mx = F8_MAX; asm volatile("" : "+v"(mx));
    a = __builtin_amdgcn_fmed3f(a, -mx, mx); b = __builtin_amdgcn_fmed3f(b, -mx, mx); c = __builtin_amdgcn_fmed3f(c, -mx, mx); d = __builtin_amdgcn_fmed3f(d, -mx, mx);
    int r = __builtin_amdgcn_cvt_pk_fp8_f32(a, b, 0, false); r = __builtin_amdgcn_cvt_pk_fp8_f32(c, d, r, true); return (unsigned)r; }
__device__ __forceinline__ float moe_wscale(const unsigned* ctl, int t, int e);
__device__ __forceinline__ float quad_sum(float v) { v += DPP_F(v, 0xB1, 0xf); v += DPP_F(v, 0x4E, 0xf); return v; }
__device__ __forceinline__ float sigmoidf_(float x) { return 1.0f / (1.0f + __expf(-x)); }
__device__ __forceinline__ int row_pos(int row) { return row < RREAL ? NMETA + (row & (SEQ - 1)) : row - RREAL; }
__device__ __forceinline__ int row_prev(int row) { if (row < RREAL) return (row & (SEQ - 1)) ? row - 1 : RVALID - 1; return row == RREAL ? -1 : row - 1; }

constexpr size_t MiB = 1u << 20;
constexpr size_t WS_CTL = 0;
constexpr size_t WS_HMETA = 1 * MiB;
constexpr size_t WS_WB = 2 * MiB;
constexpr size_t LW_STRIDE = 10 * MiB;
constexpr size_t LW_WIN = 0, LW_WUQ = LW_WIN + (size_t)2816 * 1024 * 2, LW_WK = LW_WUQ + (size_t)768 * 512 * 2, LW_WV = LW_WK + (size_t)512 * 256 * 2,
                 LW_LORA = LW_WV + (size_t)512 * 256 * 2, LW_WOUT = LW_LORA + (size_t)1536 * 256 * 2, LW_END = LW_WOUT + (size_t)1024 * 1024 * 2;
static_assert(LW_END <= LW_STRIDE, "layer weights");
constexpr size_t WS_V1T = WS_WB + 2 * LW_STRIDE, WS_V2T = WS_V1T + (size_t)256 * 512 * 2, WS_FGU = WS_V2T + (size_t)512 * 256 * 2,
                 WS_FDN = WS_FGU + (size_t)5632 * 1024 * 2, WS_ROPE = WS_FDN + (size_t)1024 * 2816 * 2, WS_WB_END = WS_ROPE + (size_t)4112 * 64 * 4;
constexpr size_t WS_TB = WS_FGU;
constexpr size_t WS_ARENA = 41 * MiB;
static_assert(WS_WB_END <= WS_ARENA, "weights fit");
static_assert((size_t)8 * 256 * 1024 * 4 <= (size_t)5632 * 1024 * 2, "list-1 tail buffer fits the dense gate/up weight slot");
constexpr size_t SZ_R1024 = (size_t)RP * 1024 * 2, SZ_R512 = (size_t)RP * 512 * 2, SZ_R256 = (size_t)RP * 256 * 2;
constexpr size_t A_U = WS_ARENA;
constexpr size_t A_KN = A_U + SZ_R1024;
constexpr size_t A_VT = A_KN + SZ_R512;
constexpr size_t A_LOUT = A_U, A_VMIX = A_VT;
static_assert((size_t)RP * 1536 * 2 == SZ_R1024 + SZ_R512, "LORA_OUT fills the U and KN slots exactly");
constexpr size_t A_PM = A_VT + SZ_R512;
constexpr size_t A_PR = A_PM + SZ_R1024;
constexpr size_t A_SMALL = A_PR + (size_t)RP * PRW * 2;
constexpr size_t A_RSTDQ = A_SMALL, A_RSTDKV = A_RSTDQ + (size_t)RP * 4, A_KROPE = A_RSTDKV + (size_t)RP * 4, A_SMALL_END = A_KROPE + (size_t)RP * 64 * 2;
constexpr size_t A_LIN = (A_SMALL_END + 4095) & ~(size_t)4095;
constexpr size_t A_VSH = A_LIN + SZ_R256;
constexpr size_t A_CHK = A_LIN;
constexpr size_t SZ_CHK = (size_t)258 * 8 * 32768;
constexpr size_t A_VFIRST = (A_CHK + SZ_CHK > A_VSH + SZ_R512 ? A_CHK + SZ_CHK : A_VSH + SZ_R512);
constexpr size_t A_VP = A_VFIRST + SZ_R512;
constexpr size_t A_RK = A_VP + SZ_R512;
constexpr size_t A_YS = A_RK + (size_t)RP * 8 * 4;
constexpr size_t A_SCST = A_YS + SZ_R512;
constexpr size_t A_PART = A_SCST + (size_t)64 * 4096 * 4;
constexpr size_t A_END1 = A_PART + (size_t)11 * NMETA * 1024 * 4;
constexpr size_t A_ACT0 = A_PM;
constexpr size_t A_MGU = A_KN;
constexpr size_t A_MDN = A_MGU + (size_t)NEXP * 7168 * 1024 * 2;
constexpr size_t A_MTAB = A_MDN + (size_t)NEXP * 1024 * 3584 * 2;
constexpr size_t MT_E = 0, MT_G = MT_E + (size_t)2 * RREAL * 4, MT_STOK = MT_G + (size_t)2 * RREAL * 4, MT_TSLOT = MT_STOK + (size_t)2 * MOE_MAXPAN * 256 * 4  , MT_SGATE = MT_TSLOT + (size_t)RREAL * 4,
                 MT_BE = MT_SGATE + (size_t)2 * MOE_MAXPAN * 256 * 4, MT_END = MT_BE + 2 * 256 * 4;
constexpr size_t A_MACT = (A_MTAB + MT_END + 4095) & ~(size_t)4095;
constexpr size_t XB_LIST = (size_t)MOE_MAXPAN * 256 * 1024;
constexpr size_t A_XB = A_MACT + (size_t)MOE_MAXPAN * 256 * FFE;
static_assert(A_XB + 2 * XB_LIST <= A_MACT + (size_t)MOE_MAXPAN * 256 * FFE * 2, "XB inside the old activation footprint");
constexpr size_t A_END2 = A_MACT + (size_t)MOE_MAXPAN * 256 * FFE * 2;
constexpr size_t WS_NEED = (A_END1 > A_END2 ? A_END1 : A_END2);
static_assert(WS_NEED <= 557619232ull, "workspace budget (sum of the inputs' bytes)");
static_assert(A_ACT0 + (size_t)RP * FF0 * 2 <= A_SMALL, "dense act overlay");
constexpr int CW_CNT = 64;
constexpr int CW_FILL = 128;
constexpr int CW_NPAN = 192;
constexpr int CW_WINV = 16448;
constexpr int CW_WMAX = 16384;
constexpr int CW_WGCNT = 8192;


__device__ __forceinline__ unsigned long long kp_uniform(unsigned long long kp) { const unsigned lo = __builtin_amdgcn_readfirstlane((unsigned)kp), hi = __builtin_amdgcn_readfirstlane((unsigned)(kp >> 32)); return ((unsigned long long)hi << 32) | lo; }
__device__ __forceinline__ const void* ldk(unsigned long long kp, int off) { unsigned long long v;
    asm volatile("s_load_dwordx2 %0, %1, %2\n\ts_waitcnt lgkmcnt(0)" : "=s"(v) : "s"(kp), "i"(off) : "memory"); return (const void*)v; }
__device__ __forceinline__ int opq(int v) { asm volatile("" : "+v"(v)); return v; }
__device__ __forceinline__ int opqs(int v) { asm volatile("" : "+s"(v)); return v; }
__device__ __forceinline__ void lds_barrier() { asm volatile("s_waitcnt lgkmcnt(0)\n\ts_barrier" ::: "memory"); }

__device__ __forceinline__ float moe_wscale_bits(unsigned bits) { const float m = __uint_as_float(bits);
    return m > 0.f ? __builtin_amdgcn_exp2f(floorf(__builtin_amdgcn_logf(224.0f / m))) : 1.0f; }
__device__ __forceinline__ float moe_wscale(const unsigned* ctl, int t, int e) { return moe_wscale_bits((unsigned)__builtin_amdgcn_readfirstlane((int)ctl[CW_WMAX + t * 8 + e])); }
#define XB_TMO      128
#define XB_XCNT(j)  (256  + 64 * (j))
#define XB_XSUB(j)  (1280 + 64 * (j))
#define XB_XGEN(j)  (2304 + 64 * (j))
#define XB_TOP      3328
#define XB_TOPGEN   3392
#define XCD_BAR_WORDS 3456
#define XB_SPIN_CAP (1u << 18)

__device__ __forceinline__ unsigned xb_ld(unsigned* p)              { return __hip_atomic_load(p, __ATOMIC_RELAXED, __HIP_MEMORY_SCOPE_AGENT); }
__device__ __forceinline__ unsigned xb_add(unsigned* p, unsigned v) { return __hip_atomic_fetch_add(p, v, __ATOMIC_RELAXED, __HIP_MEMORY_SCOPE_AGENT); }
__device__ __forceinline__ unsigned xb_xcc_id() { return (unsigned)__builtin_amdgcn_s_getreg((3 << 11) | 20) & 0xFu; }
#define XB_SPIN(cond, bar) do { unsigned _sp = 0; while (cond) { __builtin_amdgcn_s_sleep(1); \
    if ((++_sp & 255u) == 0u) { if (xb_ld(&(bar)[XB_TMO])) break; if (_sp > XB_SPIN_CAP) { atomicAdd(&(bar)[XB_TMO], 1u); break; } } } } while (0)

struct XcdBarrier {
    unsigned* bar; unsigned x;
    volatile LAS unsigned* st;
};

__device__ __forceinline__ XcdBarrier xcd_barrier_post(unsigned* bar, volatile LAS unsigned* st) {
    XcdBarrier b; b.bar = bar; b.x = xb_xcc_id(); b.st = st;
    if (threadIdx.x == 0) (void)xb_add(&bar[XB_XCNT(b.x)], 1u);
    return b;
}
__device__ __forceinline__ void xcd_barrier_complete(unsigned* bar, unsigned x, unsigned& nloc, unsigned& nx) {
    const unsigned G = gridDim.x * gridDim.y * gridDim.z;
    unsigned sum, cnt, mine, sp = 0u;
    for (;;) {
        sum = 0u; cnt = 0u; mine = 0u;
#pragma unroll
        for (unsigned j = 0; j < 16; ++j) { const unsigned c = xb_ld(&bar[XB_XCNT(j)]); sum += c; cnt += (c > 0u) ? 1u : 0u; mine = (j == x) ? c : mine; }
        if (sum == G) break;
        __builtin_amdgcn_s_sleep(1);
        if ((++sp & 255u) == 0u) { if (xb_ld(&bar[XB_TMO])) break; if (sp > XB_SPIN_CAP) { atomicAdd(&bar[XB_TMO], 1u); break; } }
    }
    nloc = mine > 0u ? mine : 1u; nx = cnt > 0u ? cnt : 1u;
}

__device__ __attribute__((noinline)) void xcd_barrier_fn(unsigned* bar_, unsigned x_, volatile LAS unsigned* st_) {
    XcdBarrier b; b.bar = bar_; b.x = x_; b.st = st_;
    asm volatile("s_waitcnt vmcnt(0)" ::: "memory");
    __syncthreads();
    if (threadIdx.x == 0) {
        unsigned* bar = b.bar;
        __builtin_amdgcn_s_waitcnt(0);
        unsigned nloc = b.st[0], nx = b.st[1];
        if (nloc == 0u) { xcd_barrier_complete(bar, b.x, nloc, nx); b.st[0] = nloc; b.st[1] = nx; }
        const unsigned old = xb_add(&bar[XB_XSUB(b.x)], 1u);
        const unsigned gen = old / nloc;
        if (old + 1u == (gen + 1u) * nloc) {
            __builtin_amdgcn_fence(__ATOMIC_RELEASE, "agent");
            asm volatile("s_waitcnt vmcnt(0)" ::: "memory");
            const unsigned og = xb_add(&bar[XB_TOP], 1u);
            const unsigned tg = og / nx;
            if (og + 1u == (tg + 1u) * nx) xb_add(&bar[XB_TOPGEN], 1u);
            else XB_SPIN(xb_ld(&bar[XB_TOPGEN]) == tg, bar);
            __builtin_amdgcn_fence(__ATOMIC_ACQUIRE, "agent");
            xb_add(&bar[XB_XGEN(b.x)], 1u);
            asm volatile("s_waitcnt vmcnt(0)" ::: "memory");
        } else {
            XB_SPIN(xb_ld(&bar[XB_XGEN(b.x)]) == gen, bar);
            __builtin_amdgcn_fence(__ATOMIC_ACQUIRE, "agent");
            asm volatile("s_waitcnt vmcnt(0)" ::: "memory");
        }
    }
    __syncthreads();
}

__device__ __forceinline__ void xcd_barrier(const XcdBarrier& b) { xcd_barrier_fn(b.bar, b.x, b.st); }
using pg8::Unit;
struct EpiInProj { static constexpr bool PERM = true, AFTER_DRAIN = false; bf16_t* PM; bf16_t* PR;
    __device__ __forceinline__ void operator()(const f32x4 (&acc)[2][2][4][2], const Unit& u, int wr, int wc, int fr, int fq) const {
        const int row0 = u.pm * 256 + wr * 64 + fr; bf16_t* base; int ld, colt;
        if (u.pn < 4) { base = PM; ld = PMW; colt = u.pn * 256; } else { base = PR; ld = PRW; colt = (u.pn - 4) * 256; }
        const int col0 = colt + wc * 32 + 8 * fq;
#pragma unroll
        for (int ai = 0; ai < 2; ++ai)
#pragma unroll
            for (int m = 0; m < 4; ++m) { bf16_t* rowp = base + (size_t)(row0 + ai * 128 + m * 16) * ld + col0;
#pragma unroll
                for (int bj = 0; bj < 2; ++bj) { const f32x4 v0 = acc[ai][bj][m][0], v1 = acc[ai][bj][m][1];
                    u32x4 w; w.x = pg8::cvt_pk_bf16(v0[0], v0[1]); w.y = pg8::cvt_pk_bf16(v0[2], v0[3]); w.z = pg8::cvt_pk_bf16(v1[0], v1[1]); w.w = pg8::cvt_pk_bf16(v1[2], v1[3]);
                    *(u32x4*)(rowp + bj * 128) = w; } }
    }
};
struct EpiRowScale { static constexpr bool PERM = true, AFTER_DRAIN = false; bf16_t* O; const float* rs; int ldc, pad;
    __device__ __forceinline__ void operator()(const f32x4 (&acc)[2][2][4][2], const Unit& u, int wr, int wc, int fr, int fq) const {
        const int row0 = u.pm * 256 + wr * 64 + fr; const int col0 = u.pn * 256 + wc * 32 + 8 * fq;
#pragma unroll
        for (int ai = 0; ai < 2; ++ai)
#pragma unroll
            for (int m = 0; m < 4; ++m) { const int row = row0 + ai * 128 + m * 16; const float s = rs ? rs[row] : 1.f; bf16_t* rowp = O + (size_t)row * ldc + col0;
#pragma unroll
                for (int bj = 0; bj < 2; ++bj) { const f32x4 v0 = acc[ai][bj][m][0] * s, v1 = acc[ai][bj][m][1] * s;
                    u32x4 w; w.x = pg8::cvt_pk_bf16(v0[0], v0[1]); w.y = pg8::cvt_pk_bf16(v0[2], v0[3]); w.z = pg8::cvt_pk_bf16(v1[0], v1[1]); w.w = pg8::cvt_pk_bf16(v1[2], v1[3]);
                    *(u32x4*)(rowp + bj * 128) = w; } }
    }
};
struct EpiColScale { static constexpr bool PERM = true, AFTER_DRAIN = false; bf16_t* O; const float* cs; int ldc, pad;
    __device__ __forceinline__ void operator()(const f32x4 (&acc)[2][2][4][2], const Unit& u, int wr, int wc, int fr, int fq) const {
        const int row0 = u.pm * 256 + wr * 64 + fr; const int col0 = u.pn * 256 + wc * 32 + 8 * fq;
        f32x4 sc[2][2];
#pragma unroll
        for (int bj = 0; bj < 2; ++bj) { sc[bj][0] = *(const f32x4*)(cs + col0 + bj * 128); sc[bj][1] = *(const f32x4*)(cs + col0 + bj * 128 + 4); }
#pragma unroll
        for (int ai = 0; ai < 2; ++ai)
#pragma unroll
            for (int m = 0; m < 4; ++m) { bf16_t* rowp = O + (size_t)(row0 + ai * 128 + m * 16) * ldc + col0;
#pragma unroll
                for (int bj = 0; bj < 2; ++bj) { const f32x4 v0 = acc[ai][bj][m][0] * sc[bj][0], v1 = acc[ai][bj][m][1] * sc[bj][1];
                    u32x4 w; w.x = pg8::cvt_pk_bf16(v0[0], v0[1]); w.y = pg8::cvt_pk_bf16(v0[2], v0[3]); w.z = pg8::cvt_pk_bf16(v1[0], v1[1]); w.w = pg8::cvt_pk_bf16(v1[2], v1[3]);
                    *(u32x4*)(rowp + bj * 128) = w; } }
    }
};
struct EpiResid { static constexpr bool PERM = false, AFTER_DRAIN = false; float* out; float* hmeta; const float* src; float scale; int pad;
    __device__ __forceinline__ void operator()(const f32x4 (&acc)[2][2][4][2], const Unit& u, int wr, int wc, int fr, int fq) const {
        const int rl = wr * 64 + fr, col0 = u.pn * 256 + wc * 32 + 4 * fq;
        float* base = u.pm < 128 ? out + (size_t)u.pm * 256 * D : hmeta; const float* sbase = u.pm < 128 ? src + (size_t)u.pm * 256 * D : hmeta;
#pragma unroll
        for (int ai = 0; ai < 2; ++ai)
#pragma unroll
            for (int m = 0; m < 4; ++m) { const size_t ro = (size_t)(rl + ai * 128 + m * 16) * D + col0;
#pragma unroll
                for (int bj = 0; bj < 2; ++bj)
#pragma unroll
                    for (int n = 0; n < 2; ++n) { const f32x4 hv = *(const f32x4*)(sbase + ro + bj * 128 + n * 16); *(f32x4*)(base + ro + bj * 128 + n * 16) = hv + acc[ai][bj][m][n] * scale; }
                asm volatile("" ::: "memory"); }
    }
};
struct EpiSwiGLU { static constexpr bool PERM = true, AFTER_DRAIN = false; bf16_t* O; int ldc, nmod, pn_off, pad;
    __device__ __forceinline__ void operator()(const f32x4 (&acc)[2][2][4][2], const Unit& u, int wr, int wc, int fr, int fq) const {
        const int row0 = u.pm * 256 + wr * 64 + fr; const int pnl = (u.pn % nmod) - pn_off; const int col0 = pnl * 128 + wc * 32 + 8 * fq;
#pragma unroll
        for (int ai = 0; ai < 2; ++ai)
#pragma unroll
            for (int m = 0; m < 4; ++m) { bf16_t* rowp = O + (size_t)(row0 + ai * 128 + m * 16) * ldc + col0; float r[8];
#pragma unroll
                for (int n = 0; n < 2; ++n)
#pragma unroll
                    for (int j = 0; j < 4; ++j) { const float g = acc[ai][0][m][n][j], up = acc[ai][1][m][n][j]; r[4 * n + j] = g / (1.0f + __expf(-g)) * up; }
                u32x4 w; w.x = pg8::cvt_pk_bf16(r[0], r[1]); w.y = pg8::cvt_pk_bf16(r[2], r[3]); w.z = pg8::cvt_pk_bf16(r[4], r[5]); w.w = pg8::cvt_pk_bf16(r[6], r[7]);
                *(u32x4*)rowp = w; }
    }
};
struct EpiSwiGLU8 { static constexpr bool PERM = false, AFTER_DRAIN = false; unsigned char* O; const unsigned* ctl; int ldc, nmod;
    __device__ __forceinline__ void operator()(const f32x4 (&acc)[2][2][4][2], const Unit& u, int wr, int wc, int fr, int fq) const {
        const int row0 = u.pm * 256 + wr * 64 + fr; const int e = u.pn / nmod, pnl = u.pn % nmod; const int col0 = pnl * 128 + wc * 32 + 4 * fq;
        const float ig = __uint_as_float(__builtin_amdgcn_readfirstlane((int)ctl[CW_WINV + e])), iu = __uint_as_float(__builtin_amdgcn_readfirstlane((int)ctl[CW_WINV + 8 + e])) * F8_ACT;
#pragma unroll
        for (int ai = 0; ai < 2; ++ai)
#pragma unroll
            for (int m = 0; m < 4; ++m) { unsigned char* rowp = O + (size_t)(row0 + ai * 128 + m * 16) * ldc + col0;
#pragma unroll
                for (int n = 0; n < 2; ++n) { float r[4];
#pragma unroll
                    for (int j = 0; j < 4; ++j) { const float g = acc[ai][0][m][n][j] * ig, up = acc[ai][1][m][n][j] * iu; r[j] = g / (1.0f + __expf(-g)) * up; }
                    *(unsigned*)(rowp + n * 16) = pk4_f8(r[0], r[1], r[2], r[3]); } }
    }
};
struct EpiMoeDown { static constexpr bool PERM = false, AFTER_DRAIN = false; float* out; const int* stok; const float* sgate; int nmod; float scale; const unsigned* ctl;
    __device__ __forceinline__ void operator()(const f32x4 (&acc)[2][2][4][2], const Unit& u, int wr, int wc, int fr, int fq) const {
        const int row0 = u.pm * 256 + wr * 64 + fr; const int col0 = (u.pn % nmod) * 256 + wc * 32 + 4 * fq;
        const float winv = ctl ? __uint_as_float(__builtin_amdgcn_readfirstlane((int)ctl[CW_WINV + 16 + u.pn / nmod])) : 1.0f;
#pragma unroll
        for (int ai = 0; ai < 2; ++ai)
#pragma unroll
            for (int m = 0; m < 4; ++m) { const int prow = row0 + ai * 128 + m * 16; const int tok = stok[prow]; if (tok < 0) continue; const float gt = sgate[prow] * scale * winv;
                float* rowp = out + (size_t)tok * D + col0;
#pragma unroll
                for (int bj = 0; bj < 2; ++bj)
#pragma unroll
                    for (int n = 0; n < 2; ++n) { f32x4* p = (f32x4*)(rowp + bj * 128 + n * 16); *p = *p + acc[ai][bj][m][n] * gt; }
                asm volatile("" ::: "memory"); }
    }
};
struct EpiMoeDownStore { static constexpr bool PERM = false, AFTER_DRAIN = false; float* tb; const int* stok; const float* sgate; int nmod, pm0; const unsigned* ctl;
    __device__ __forceinline__ void operator()(const f32x4 (&acc)[2][2][4][2], const Unit& u, int wr, int wc, int fr, int fq) const {
        const int row0 = u.pm * 256 + wr * 64 + fr; const int col0 = (u.pn % nmod) * 256 + wc * 32 + 4 * fq;
#pragma unroll
        for (int ai = 0; ai < 2; ++ai)
#pragma unroll
            for (int m = 0; m < 4; ++m) { const int prow = row0 + ai * 128 + m * 16; const int tok = stok[prow]; if (tok < 0) continue; const float gt = sgate[prow] * __uint_as_float(__builtin_amdgcn_readfirstlane((int)ctl[CW_WINV + 16 + u.pn / nmod]));
                float* rowp = tb + (size_t)(prow - pm0 * 256) * D + col0;
#pragma unroll
                for (int bj = 0; bj < 2; ++bj)
#pragma unroll
                    for (int n = 0; n < 2; ++n) *(f32x4*)(rowp + bj * 128 + n * 16) = acc[ai][bj][m][n] * gt; }
    }
};
struct MoeOrder { static constexpr bool GATHER = false; const int* block_e; const unsigned* npan; int nN, emul, pn_off, G, c, lmax;
    __device__ __forceinline__ bool next(int i, Unit& u) const { const int L = i * G + c; const int np = __builtin_amdgcn_readfirstlane((int)(*npan)); if (L >= np * nN || (lmax && L >= lmax)) return false;
        const int pm = L / nN; u.k0 = 0; u.pm = pm; u.pn = __builtin_amdgcn_readfirstlane(block_e[pm]) * emul + pn_off + (L % nN); return true; }
    __device__ __forceinline__ void a_ready(const Unit&) const {}
    __device__ __forceinline__ void done(const Unit&) const {}
};


struct EpiResidPartial { static constexpr bool PERM = false, AFTER_DRAIN = false; float* part;
    __device__ __forceinline__ void operator()(const f32x4 (&acc)[2][2][4][2], const Unit& u, int wr, int wc, int fr, int fq) const {
        const int rl = wr * 64 + fr, col0 = u.pn * 256 + wc * 32 + 4 * fq; float* base = part + (size_t)(u.k0 >> 8) * NMETA * D;
#pragma unroll
        for (int ai = 0; ai < 2; ++ai)
#pragma unroll
            for (int m = 0; m < 4; ++m) { const int row = rl + ai * 128 + m * 16; if (row >= NMETA) continue;
                float* rowp = base + (size_t)row * D + col0;
#pragma unroll
                for (int bj = 0; bj < 2; ++bj)
#pragma unroll
                    for (int n = 0; n < 2; ++n) *(f32x4*)(rowp + bj * 128 + n * 16) = acc[ai][bj][m][n]; }
    }
};
struct DenseTailOrder { static constexpr bool GATHER = false; int nN, nsl, G, c;
    __device__ __forceinline__ bool next(int i, Unit& u) const { const int idx = i * G + c; if (idx >= nN * nsl) return false; u.pm = 128; u.pn = idx / nsl; u.k0 = (idx % nsl) * 256; return true; }
    __device__ __forceinline__ void a_ready(const Unit&) const {}
    __device__ __forceinline__ void done(const Unit&) const {}
};
template <bool GA> struct MoeGatherOrderT { static constexpr bool GATHER = GA;
    const int* block_e; const unsigned* npan; const int* rows; int nN, emul, pn_off, G, c, zero_row;
    int pm_lo, pm_hi, gap, rot, T, cskip;
    __device__ __forceinline__ bool next(int i, Unit& u) const {
        int cc = c - rot; cc += cc < 0 ? G : 0;
        int L;
        if (T == 0) L = i * G + cc;
        else { const int W0 = G - T; if (cc < W0) L = i < cskip ? i * W0 + cc : cskip * W0 + (i - cskip) * G + cc; else L = cskip * W0 + i * G + cc; }
        int np = __builtin_amdgcn_readfirstlane((int)(*npan)); np = np < pm_hi ? np : pm_hi;
        const int pl = pm_lo + L / nN; if (pl >= np) return false;
        const int pm = pl + (pl >= MOE_TAILPAN ? gap : 0); u.k0 = 0; u.pm = pm; u.pn = __builtin_amdgcn_readfirstlane(block_e[pm]) * emul + pn_off + (L % nN); return true; }
    __device__ __forceinline__ void a_ready(const Unit&) const {}
    __device__ __forceinline__ void done(const Unit&) const {}
};
using MoeGatherOrder = MoeGatherOrderT<true>; using MoeSlotOrder = MoeGatherOrderT<false>;
struct MoeShiftTailOrder { static constexpr bool GATHER = false; const int* block_e; const unsigned* npan; int nN, emul, gap, wg_first, c, pad;
    __device__ __forceinline__ bool next(int i, Unit& u) const { const int t = wg_first - c; const int np = __builtin_amdgcn_readfirstlane((int)(*npan)); const int L = MOE_TAILPAN * nN + t;
        if (i > 0 || t < 0 || L >= np * nN) return false;
        const int pm = L / nN + gap; u.k0 = 0; u.pm = pm; u.pn = __builtin_amdgcn_readfirstlane(block_e[pm]) * emul + (L % nN); return true; }
    __device__ __forceinline__ void a_ready(const Unit&) const {}
    __device__ __forceinline__ void done(const Unit&) const {}
};

__device__ __forceinline__ int map_row(int mode, int n, int rowoff) {
    if (mode == 1) return n < 832 ? n : n + 192;
    if (mode == 2) return rowoff + (n >> 7) * 256 + (n & 127);
    if (mode == 3) return rowoff + (n >> 7) * 256 + 128 + (n & 127);
    if (mode == 4) return (n >> 8) * 128 + (n & 127) + ((n & 128) ? 512 : 0);
    return rowoff + n;
}
__device__ __forceinline__ void transpose_item(const float* __restrict__ W, int K, int N, bf16_t* __restrict__ dst, int ld, int koff, int mode, int rowoff, const float* __restrict__ gain, LAS float* scr, int item, int lane) {
    const int nblk = N / 32; const int kb = item / nblk, nb = item % nblk, k0 = 64 * kb, n0 = 32 * nb;
#pragma unroll 8
    for (int i = 0; i < 32; ++i) { const int kk = 2 * i + (lane >> 5); float v = W[(size_t)(k0 + kk) * N + n0 + (lane & 31)]; if (gain) v *= gain[k0 + kk]; scr[kk * 33 + (lane & 31)] = v; }
    asm volatile("s_waitcnt lgkmcnt(0)" ::: "memory");
    const int c = lane & 7;
#pragma unroll
    for (int j = 0; j < 4; ++j) { const int n = (lane >> 3) + 8 * j; const LAS float* s = scr + (8 * c) * 33 + n;
        u32x4 o; o.x = pk2(s[0 * 33], s[1 * 33]); o.y = pk2(s[2 * 33], s[3 * 33]); o.z = pk2(s[4 * 33], s[5 * 33]); o.w = pk2(s[6 * 33], s[7 * 33]);
        *(u32x4*)(dst + (size_t)map_row(mode, n0 + n, rowoff) * ld + koff + k0 + 8 * c) = o; }
    asm volatile("s_waitcnt lgkmcnt(0)" ::: "memory");
}
__device__ __forceinline__ void transpose_item_f8(const float* __restrict__ W, int K, int N, unsigned char* __restrict__ dst, int ld, int mode, int rowoff, float scale, LAS float* scr, int item, int lane) {
    const int nblk = N / 32; const int kb = item / nblk, nb = item % nblk, k0 = 64 * kb, n0 = 32 * nb;
#pragma unroll 8
    for (int i = 0; i < 32; ++i) { const int kk = 2 * i + (lane >> 5); scr[kk * 33 + (lane & 31)] = W[(size_t)(k0 + kk) * N + n0 + (lane & 31)] * scale; }
    asm volatile("s_waitcnt lgkmcnt(0)" ::: "memory");
    const int c = lane & 7;
#pragma unroll
    for (int j = 0; j < 4; ++j) { const int n = (lane >> 3) + 8 * j; const LAS float* s = scr + (8 * c) * 33 + n;
        u32x2 o; o.x = pk4_f8(s[0 * 33], s[1 * 33], s[2 * 33], s[3 * 33]); o.y = pk4_f8(s[4 * 33], s[5 * 33], s[6 * 33], s[7 * 33]);
        *(u32x2*)(dst + (size_t)map_row(mode, n0 + n, rowoff) * ld + k0 + 8 * c) = o; }
    asm volatile("s_waitcnt lgkmcnt(0)" ::: "memory");
}
struct TrJob8 { const float* W; unsigned char* dst; int K, N, ld, mode, rowoff; float scale; };
__device__ __forceinline__ void ph_transpose_f8(const TrJob8& J, LAS float* scr, int gw, int ngw, int lane) {
    lane = opq(lane);
    const int nitems = (J.K / 64) * (J.N / 32);
    for (int it = gw; it < nitems; it += ngw) transpose_item_f8(J.W, J.K, J.N, J.dst, J.ld, J.mode, J.rowoff, J.scale, scr, it, lane);
}
struct TrJob { const float* W; const float* gain; bf16_t* dst; int K, N, ld, koff, mode, rowoff; };
__device__ __forceinline__ void ph_transpose(const TrJob& J, LAS float* scr, int gw, int ngw, int lane) {
    lane = opq(lane);
    const int nitems = (J.K / 64) * (J.N / 32);
    for (int it = gw; it < nitems; it += ngw) transpose_item(J.W, J.K, J.N, J.dst, J.ld, J.koff, J.mode, J.rowoff, J.gain, scr, it, lane);
}
__device__ __forceinline__ const float* hrow_c(const float* out, const float* hmeta, int row) { return row < RREAL ? out + (size_t)row * D : hmeta + (size_t)(row - RREAL) * D; }
__device__ __forceinline__ void ph_init(const float* __restrict__ x, const float* __restrict__ meta, float* __restrict__ out, float* __restrict__ hmeta, float* __restrict__ rope,
                                        const float* __restrict__ v1, const float* __restrict__ v2, bf16_t* __restrict__ v12t, size_t gt, size_t ngt) {
    (void)x; (void)out;
    for (size_t i = gt; i < (size_t)256 * D; i += ngt) hmeta[i] = i < (size_t)NMETA * D ? meta[i] : 0.f;
    for (size_t i = gt; i < (size_t)4112 * 32; i += ngt) { const int pos = (int)(i / 32), j = (int)(i % 32);
        const float inv = powf(10000.0f, -(float)j / 32.0f); const float ang = (float)pos * inv; rope[2 * i] = cosf(ang); rope[2 * i + 1] = sinf(ang); }
    for (size_t i = gt; i < (size_t)512 * 512; i += ngt) { const int n = (int)(i >> 9), k = (int)(i & 511); float s = 0.f;
#pragma unroll 8
        for (int j = 0; j < 32; ++j) s += v1[k * 32 + j] * v2[j * 512 + n];
        v12t[i] = f2bf(s); }
}
__device__ __forceinline__ void ph_rmsnorm(const float* __restrict__ out, const float* hmeta, const float* __restrict__ g, bf16_t* __restrict__ U, const float* __restrict__ part, int nsl, int gw, int ngw, int lane) {
    lane = opq(lane);
    for (int row = gw; row < RP; row += ngw) {
        unsigned long long* o8 = (unsigned long long*)(U + (size_t)row * D) + lane;
        if (row >= RVALID) {
#pragma unroll
            for (int j = 0; j < 4; ++j) o8[64 * j] = 0ull;
            continue; }
        const f32x4* xr = (const f32x4*)hrow_c(out, hmeta, row) + lane; const f32x4* g4 = (const f32x4*)g + lane;
        f32x4 v[4]; float s = 0.f;
#pragma unroll
        for (int j = 0; j < 4; ++j) v[j] = xr[64 * j];
        if (row >= RREAL && nsl > 0) {
            for (int sl = 0; sl < nsl; ++sl) { const f32x4* pr = (const f32x4*)(part + ((size_t)sl * NMETA + (row - RREAL)) * D) + lane;
#pragma unroll
                for (int j = 0; j < 4; ++j) v[j] = v[j] + pr[64 * j]; }
            f32x4* hw = (f32x4*)xr;
#pragma unroll
            for (int j = 0; j < 4; ++j) hw[64 * j] = v[j]; }
#pragma unroll
        for (int j = 0; j < 4; ++j) s += (v[j].x * v[j].x + v[j].y * v[j].y) + (v[j].z * v[j].z + v[j].w * v[j].w);
        const float rstd = rsqrtf(wave_sum(s) * (1.f / D) + RMS_EPS);
#pragma unroll
        for (int j = 0; j < 4; ++j) { const f32x4 gg = g4[64 * j]; o8[64 * j] = (unsigned long long)pk2(v[j].x * rstd * gg.x, v[j].y * rstd * gg.y) | ((unsigned long long)pk2(v[j].z * rstd * gg.z, v[j].w * rstd * gg.w) << 32); }
    }
}
__device__ __forceinline__ void unpack8(const u32x4 v, float (&f)[8]) {
    f[0] = __uint_as_float(v.x << 16); f[1] = __uint_as_float(v.x & 0xffff0000u); f[2] = __uint_as_float(v.y << 16); f[3] = __uint_as_float(v.y & 0xffff0000u);
    f[4] = __uint_as_float(v.z << 16); f[5] = __uint_as_float(v.z & 0xffff0000u); f[6] = __uint_as_float(v.w << 16); f[7] = __uint_as_float(v.w & 0xffff0000u);
}
__device__ __forceinline__ void ph_prep(const bf16_t* __restrict__ PM, const bf16_t* __restrict__ PR, const float* __restrict__ mu, const float* __restrict__ rope,
                                        float* __restrict__ rstdq, float* __restrict__ rstdkv, bf16_t* __restrict__ KR, bf16_t* __restrict__ LIN, bf16_t* __restrict__ VSH, int do_vsh, int gw, int ngw, int lane) {
    lane = opq(lane);
    for (int row = gw; row < RP; row += ngw) {
        const bf16_t* pm = PM + (size_t)row * PMW;
        float f[8], sq = 0.f, skv = 0.f;
        unpack8(*(const u32x4*)(pm + lane * 8), f);
#pragma unroll
        for (int j = 0; j < 8; ++j) sq += f[j] * f[j];
        if (lane < 32) { unpack8(*(const u32x4*)(pm + 512 + lane * 8), f);
#pragma unroll
            for (int j = 0; j < 8; ++j) skv += f[j] * f[j]; }
        sq = wave_sum(sq); skv = wave_sum(skv);
        if (lane == 0) { rstdq[row] = rsqrtf(sq * (1.f / 512.f) + RMS_EPS); rstdkv[row] = rsqrtf(skv * (1.f / 256.f) + RMS_EPS); }
        const int pos = row_pos(row);
        if (lane < 32) { const float x1 = bf2f(pm[768 + lane]), x2 = bf2f(pm[800 + lane]); const float c = rope[2 * (pos * 32 + lane)], s = rope[2 * (pos * 32 + lane) + 1];
            KR[(size_t)row * 64 + lane] = f2bf(x1 * c - x2 * s); KR[(size_t)row * 64 + 32 + lane] = f2bf(x1 * s + x2 * c); }
        const int pr = row_prev(row); const bool valid = row < RVALID; const float pmk = pr < 0 ? 0.f : 1.f;
        const bf16_t* x = PR + (size_t)row * PRW; const bf16_t* xp = PR + (size_t)(pr < 0 ? row : pr) * PRW;
        if (lane < 32) {
            float a[8], b[8]; unpack8(*(const u32x4*)(x + 1536 + lane * 8), a); unpack8(*(const u32x4*)(xp + 1536 + lane * 8), b);
            const f32x4 m0 = *(const f32x4*)(mu + 1536 + lane * 8), m1 = *(const f32x4*)(mu + 1536 + lane * 8 + 4); const float mm[8] = {m0.x, m0.y, m0.z, m0.w, m1.x, m1.y, m1.z, m1.w};
            float o[8];
#pragma unroll
            for (int j = 0; j < 8; ++j) { float v = a[j] + (pmk * b[j] - a[j]) * mm[j]; v = lane < 8 ? tanhf(v) : (lane < 16 ? v : sigmoidf_(v)); o[j] = valid ? v : 0.f; }
            u32x4 w; w.x = pk2(o[0], o[1]); w.y = pk2(o[2], o[3]); w.z = pk2(o[4], o[5]); w.w = pk2(o[6], o[7]); *(u32x4*)(LIN + (size_t)row * 256 + lane * 8) = w; }
        if (do_vsh) {
            float a[8], b[8]; unpack8(*(const u32x4*)(x + 1024 + lane * 8), a); unpack8(*(const u32x4*)(xp + 1024 + lane * 8), b);
            const f32x4 m0 = *(const f32x4*)(mu + 1024 + lane * 8), m1 = *(const f32x4*)(mu + 1024 + lane * 8 + 4); const float mm[8] = {m0.x, m0.y, m0.z, m0.w, m1.x, m1.y, m1.z, m1.w};
            float o[8];
#pragma unroll
            for (int j = 0; j < 8; ++j) { const float v = a[j] + (pmk * b[j] - a[j]) * mm[j]; o[j] = valid ? v : 0.f; }
            u32x4 w; w.x = pk2(o[0], o[1]); w.y = pk2(o[2], o[3]); w.z = pk2(o[4], o[5]); w.w = pk2(o[6], o[7]); *(u32x4*)(VSH + (size_t)row * 512 + lane * 8) = w; }
    }
}

__device__ __forceinline__ void ph_norm_route(LAS unsigned char* lds, const float* __restrict__ out, const float* __restrict__ g, const float* __restrict__ router, const float* __restrict__ rbias,
                                              bf16_t* __restrict__ U, int* __restrict__ TE, float* __restrict__ TG, int* __restrict__ STOK, unsigned* __restrict__ ctl, int bid, int nblk, int wave, int lane) {
    lane = opq(lane); nblk = opqs(nblk); bid = opqs(bid);
    { constexpr int NFILL = 2 * MOE_MAXPAN * 256 + RREAL; const int per = (NFILL + nblk - 1) / nblk; const int t_ = wave * 64 + lane;
      for (int i = t_; i < per; i += 512) { const int idx = bid * per + i; if (idx < NFILL) STOK[idx] = -1; } }
    const int rpw = (RREAL + nblk - 1) / nblk, rpwave = (rpw + 7) / 8;
    int c1[8], c2[8];
#pragma unroll
    for (int e = 0; e < 8; ++e) { c1[e] = 0; c2[e] = 0; }
    for (int k = 0; k < rpwave; ++k) { const int rl = wave * rpwave + k; const int row = bid * rpw + rl; if (rl >= rpw || row >= RREAL) break;
        const f32x4* xr = (const f32x4*)(out + (size_t)row * D) + lane; const f32x4* g4 = (const f32x4*)g + lane;
        f32x4 v[4]; float s = 0.f;
#pragma unroll
        for (int j = 0; j < 4; ++j) { v[j] = xr[64 * j]; s += (v[j].x * v[j].x + v[j].y * v[j].y) + (v[j].z * v[j].z + v[j].w * v[j].w); }
        const float rstd = rsqrtf(wave_sum(s) * (1.f / D) + RMS_EPS);
        unsigned* o4 = (unsigned*)((unsigned char*)U + (size_t)row * D) + lane;
        float lg[8];
#pragma unroll
        for (int e = 0; e < 8; ++e) lg[e] = 0.f;
#pragma unroll
        for (int j = 0; j < 4; ++j) { const f32x4 gg = g4[64 * j]; f32x4 xn; xn.x = v[j].x * rstd * gg.x; xn.y = v[j].y * rstd * gg.y; xn.z = v[j].z * rstd * gg.z; xn.w = v[j].w * rstd * gg.w;
            o4[64 * j] = pk4_f8(xn.x * F8_ACT, xn.y * F8_ACT, xn.z * F8_ACT, xn.w * F8_ACT);
            const int d0 = 4 * (lane + 64 * j);
#pragma unroll
            for (int q = 0; q < 4; ++q) { const f32x4 ra = *(const f32x4*)(router + (size_t)(d0 + q) * 8), rb = *(const f32x4*)(router + (size_t)(d0 + q) * 8 + 4); const float xv = xn[q];
                lg[0] += xv * ra.x; lg[1] += xv * ra.y; lg[2] += xv * ra.z; lg[3] += xv * ra.w; lg[4] += xv * rb.x; lg[5] += xv * rb.y; lg[6] += xv * rb.z; lg[7] += xv * rb.w; }
            asm volatile("" ::: "memory"); }
#pragma unroll
        for (int e = 0; e < 8; ++e) { float t_ = wave_sum(lg[e]); asm volatile("" : "+v"(t_)); lg[e] = t_ + rbias[e]; }
        int e1 = 0; float l1 = lg[0];
#pragma unroll
        for (int e = 1; e < 8; ++e) if (lg[e] > l1) { l1 = lg[e]; e1 = e; }
        int e2 = e1 == 0 ? 1 : 0; float l2 = -INFINITY;
#pragma unroll
        for (int e = 0; e < 8; ++e) if (e != e1 && lg[e] > l2) { l2 = lg[e]; e2 = e; }
        const float g1 = 1.0f / (1.0f + __expf(l2 - l1)), g2 = 1.0f - g1;
        { const int e1v = e1, e2v = e2;
#pragma unroll
        for (int e = 0; e < 8; ++e) { c1[e] += (e1v == e) ? 1 : 0; c2[e] += (e2v == e) ? 1 : 0; } }
        if (lane == 0) { TE[row] = e1; TE[RREAL + row] = e2; TG[row] = g1; TG[RREAL + row] = g2; }
    }
    LAS int* wc = (LAS int*)(lds + 80000);
    if (lane == 0) {
#pragma unroll
        for (int e = 0; e < 8; ++e) { wc[wave * 16 + e] = c1[e]; wc[wave * 16 + 8 + e] = c2[e]; } }
    __syncthreads();
    const int t = wave * 64 + lane;
    if (t < 16) { int sum = 0;
#pragma unroll
        for (int ww = 0; ww < 8; ++ww) sum += wc[ww * 16 + t];
        ctl[CW_WGCNT + bid * 16 + t] = (unsigned)sum; }
}
__device__ __forceinline__ void ph_moe_assign(LAS unsigned char* lds, int list, const int* __restrict__ TE, const float* __restrict__ TG, int* __restrict__ STOK, float* __restrict__ SGATE, int* __restrict__ BE, unsigned* __restrict__ ctl,
                                              int bid, int nblk, int tid) {
    LAS int* sh = (LAS int*)lds;
    __syncthreads();
    if (tid < 8) { int tot = 0, pre = 0;
        for (int b = 0; b < nblk; ++b) { const int v = (int)ctl[CW_WGCNT + b * 16 + 8 * list + tid]; tot += v; pre += b < bid ? v : 0; }
        sh[tid] = tot; sh[8 + tid] = pre; }
    __syncthreads();
    if (tid == 0) { int pan = 0;
        for (int e = 0; e < 8; ++e) { const int np = (sh[e] + 255) >> 8; sh[16 + e] = pan << 8;
            if (bid == 0) for (int q = 0; q < np; ++q) { const int pi = pan + q; BE[256 * list + pi + (list == 1 && pi >= MOE_TAILPAN ? MOE_GAP : 0)] = e; }
            pan += np; }
        if (bid == 0) ctl[CW_NPAN + list] = (unsigned)pan; }
    __syncthreads();
    if (tid < 64) {
        const int rpw = (RREAL + nblk - 1) / nblk; int run[8];
#pragma unroll
        for (int q = 0; q < 8; ++q) run[q] = 0;
        for (int r0 = 0; r0 < rpw; r0 += 64) { const int rl = r0 + tid, row = bid * rpw + rl; const bool ok = rl < rpw && row < RREAL;
            const int ee = ok ? TE[list * RREAL + row] : -1; int slot = -1;
#pragma unroll
            for (int e = 0; e < 8; ++e) { const unsigned long long m = __builtin_amdgcn_ballot_w64(ee == e);
                const int rank = (int)__builtin_amdgcn_mbcnt_hi((unsigned)(m >> 32), __builtin_amdgcn_mbcnt_lo((unsigned)m, 0u));
                if (ee == e) { slot = sh[16 + e] + sh[8 + e] + run[e] + rank; if (list == 1 && slot >= MOE_TAILPAN * 256) slot += MOE_GAP * 256; }
                run[e] += __builtin_popcountll(m); }
            if (ok) { STOK[list * (MOE_MAXPAN * 256) + slot] = row; SGATE[list * (MOE_MAXPAN * 256) + slot] = TG[list * RREAL + row];
                if (list == 1 && slot >= (MOE_TAILPAN + MOE_GAP) * 256) STOK[2 * MOE_MAXPAN * 256 + row] = slot - (MOE_TAILPAN + MOE_GAP) * 256; } }
    }
}
__device__ __forceinline__ void ph_moe_gather8(const unsigned char* __restrict__ U8, const int* __restrict__ STOK, unsigned char* __restrict__ XB, int gw, int ngw, int lane) {
    lane = opq(lane);
    unsigned z0 = 0u; asm volatile("" : "+v"(z0));
    for (int prow = gw; prow < 2 * MOE_MAXPAN * 256; prow += ngw) { const int tok = STOK[prow]; u32x4* d = (u32x4*)(XB + (size_t)prow * 1024) + lane; u32x4 z; z.x = z.y = z.z = z.w = z0;
        if (tok < 0) d[0] = z; else d[0] = ((const u32x4*)(U8 + (size_t)tok * 1024))[lane]; }
}
__device__ __forceinline__ void ph_moe_gather(const bf16_t* __restrict__ U, const int* __restrict__ STOK, bf16_t* __restrict__ XB, const unsigned* __restrict__ npan, int gw, int ngw, int lane) {
    lane = opq(lane);
    const int nrow = (int)(*npan) * 256;
    for (int prow = gw; prow < nrow; prow += ngw) { const int tok = STOK[prow]; u32x4* d = (u32x4*)(XB + (size_t)prow * D) + lane; u32x4 z; z.x = z.y = z.z = z.w = 0u;
        if (tok < 0) { d[0] = z; d[64] = z; } else { const u32x4* s = (const u32x4*)(U + (size_t)tok * D) + lane; d[0] = s[0]; d[64] = s[64]; } }
}
__device__ __forceinline__ void ph_final(float* __restrict__ out, const float* __restrict__ g, const int* __restrict__ tslot, const float* __restrict__ tb, int gw, int ngw, int lane, float pscale = 1.0f) {
    lane = opq(lane);
    for (int row = gw; row < RREAL; row += ngw) {
        f32x4* xr = (f32x4*)(out + (size_t)row * D) + lane; const f32x4* g4 = (const f32x4*)g + lane;
        const int ts = __builtin_amdgcn_readfirstlane(tslot[row]);
        f32x4 v[4]; float s = 0.f;
#pragma unroll
        for (int j = 0; j < 4; ++j) v[j] = xr[64 * j];
        if (ts >= 0) { const f32x4* tr = (const f32x4*)(tb + (size_t)ts * D) + lane;
#pragma unroll
            for (int j = 0; j < 4; ++j) v[j] = v[j] + tr[64 * j]; }
#pragma unroll
        for (int j = 0; j < 4; ++j) s += (v[j].x * v[j].x + v[j].y * v[j].y) + (v[j].z * v[j].z + v[j].w * v[j].w);
        const float rstd = rsqrtf(wave_sum(s) * (1.f / D) + RMS_EPS);
#pragma unroll
        for (int j = 0; j < 4; ++j) { const f32x4 gg = g4[64 * j]; f32x4 o; o.x = v[j].x * rstd * gg.x * pscale; o.y = v[j].y * rstd * gg.y * pscale; o.z = v[j].z * rstd * gg.z * pscale; o.w = v[j].w * rstd * gg.w * pscale; xr[64 * j] = o; }
    }
}

constexpr int KS_STRIDE = 200, VS_STRIDE = 72;
constexpr int ATT_LDS = 64 * KS_STRIDE * 2 + 128 * VS_STRIDE * 2;
__device__ __forceinline__ bf16x8 pack8(const f32x16& x, int s) {
    u32x4 p;
    if (s == 0) { p.x = cvtpk(x[0], x[1]); p.y = cvtpk(x[2], x[3]); p.z = cvtpk(x[4], x[5]); p.w = cvtpk(x[6], x[7]); }
    else { p.x = cvtpk(x[8], x[9]); p.y = cvtpk(x[10], x[11]); p.z = cvtpk(x[12], x[13]); p.w = cvtpk(x[14], x[15]); }
    return __builtin_bit_cast(bf16x8, p);
}
__device__ __forceinline__ void attn_unit(LAS unsigned char* lds, const bf16_t* __restrict__ Q, const bf16_t* __restrict__ KN, const bf16_t* __restrict__ KR, const bf16_t* __restrict__ VT,
                                          bf16_t* __restrict__ MIX, const float* __restrict__ rope, int h, int qrow0, int kbase, int ntile, int wlim, bool wave_active) {
    const int tid = opq(threadIdx.x), lane = tid & 63, w = tid >> 6, r = lane & 31, hh = lane >> 5;
    LAS bf16_t* Ks = (LAS bf16_t*)lds; LAS bf16_t* Vs = (LAS bf16_t*)(lds + 64 * KS_STRIDE * 2);
    const int qrow = qrow0 + 32 * w + r;
    bf16x8 qf[12];
#pragma unroll
    for (int ks = 0; ks < 12; ++ks) qf[ks] = *(const GAS bf16x8*)(Q + (size_t)qrow * 768 + 192 * h + 16 * ks + 8 * hh);
    {
        const int pos = row_pos(qrow); const GAS float* rt = (const GAS float*)(rope + (size_t)pos * 64);
#pragma unroll
        for (int half = 0; half < 2; ++half) { const GAS float* cs = rt + 2 * (16 * half + 8 * hh);
#pragma unroll
            for (int j = 0; j < 8; ++j) { const float c = cs[2 * j], sn = cs[2 * j + 1]; const float x1 = bf2f((bf16_t)qf[8 + half][j]), x2 = bf2f((bf16_t)qf[10 + half][j]);
                qf[8 + half][j] = (short)f2bf(x1 * c - x2 * sn); qf[10 + half][j] = (short)f2bf(x1 * sn + x2 * c); } }
    }
    float z0 = 0.f; asm volatile("" : "+v"(z0));
    f32x16 oacc[4];
#pragma unroll
    for (int i = 0; i < 4; ++i)
#pragma unroll
        for (int j = 0; j < 16; ++j) oacc[i][j] = z0;
    float mrun = -INFINITY, lsum = 0.f;
    const float sc = 0.07216878364870322f * 1.4426950408889634f;
    u32x4 kreg[3], vreg[2];
    const unsigned kn_off0 = (unsigned)(((tid >> 4) * 512 + h * 128 + (tid & 15) * 8) * 2), kn_off1 = kn_off0 + 32u * 512u * 2u;
    const unsigned kr_off = (unsigned)(((tid >> 3) * 64 + (tid & 7) * 8) * 2);
    const unsigned vt_off0 = (unsigned)((((size_t)(h * 128 + (tid >> 3))) * RP + (tid & 7) * 8) * 2), vt_off1 = vt_off0 + 64u * (unsigned)RP * 2u;
#define ATT_GLOAD(tt_) do { const int krow0_ = (tt_) == 0 ? RREAL : kbase + 64 * ((tt_) - 1); \
    const char* knb_ = (const char*)KN + (size_t)krow0_ * 1024; const char* krb_ = (const char*)KR + (size_t)krow0_ * 128; const char* vtb_ = (const char*)VT + (size_t)krow0_ * 2; \
    kreg[0] = *(const GAS u32x4*)(knb_ + kn_off0); kreg[1] = *(const GAS u32x4*)(knb_ + kn_off1); kreg[2] = *(const GAS u32x4*)(krb_ + kr_off); \
    vreg[0] = *(const GAS u32x4*)(vtb_ + vt_off0); vreg[1] = *(const GAS u32x4*)(vtb_ + vt_off1); } while (0)
    ATT_GLOAD(0);
    for (int tt = 0; tt < ntile; ++tt) {
#ifdef PROBE_ATT_STAGE2
        __syncthreads();
        *(LAS u32x4*)(Ks + (tid >> 4) * KS_STRIDE + (tid & 15) * 8) = kreg[0]; *(LAS u32x4*)(Ks + (32 + (tid >> 4)) * KS_STRIDE + (tid & 15) * 8) = kreg[1];
        *(LAS u32x4*)(Ks + (tid >> 3) * KS_STRIDE + 128 + (tid & 7) * 8) = kreg[2];
#pragma unroll
        for (int i = 0; i < 2; ++i) {
            LAS u32x2* d = (LAS u32x2*)(Vs + ((tid >> 3) + 64 * i) * VS_STRIDE + ((tid & 7) >> 1) * 16 + (tid & 1) * 4);
            u32x2 lo; lo.x = vreg[i].x; lo.y = vreg[i].y; u32x2 hi; hi.x = vreg[i].z; hi.y = vreg[i].w; d[0] = lo; d[2] = hi; }
        __syncthreads();
#endif
        __syncthreads();
        *(LAS u32x4*)(Ks + (tid >> 4) * KS_STRIDE + (tid & 15) * 8) = kreg[0]; *(LAS u32x4*)(Ks + (32 + (tid >> 4)) * KS_STRIDE + (tid & 15) * 8) = kreg[1];
        *(LAS u32x4*)(Ks + (tid >> 3) * KS_STRIDE + 128 + (tid & 7) * 8) = kreg[2];
#pragma unroll
        for (int i = 0; i < 2; ++i) {
            LAS u32x2* d = (LAS u32x2*)(Vs + ((tid >> 3) + 64 * i) * VS_STRIDE + ((tid & 7) >> 1) * 16 + (tid & 1) * 4);
            u32x2 lo; lo.x = vreg[i].x; lo.y = vreg[i].y; u32x2 hi; hi.x = vreg[i].z; hi.y = vreg[i].w; d[0] = lo; d[2] = hi; }
        __syncthreads();
        const bool comp = wave_active && tt <= wlim;
        if (tt + 1 < ntile) ATT_GLOAD(tt + 1);
        if (comp) {
            f32x16 sacc[2];
#pragma unroll
            for (int b = 0; b < 2; ++b)
#pragma unroll
                for (int j = 0; j < 16; ++j) sacc[b][j] = z0;
#ifdef PROBE_ATT_QK2
            {
            __builtin_amdgcn_sched_barrier(0);
            {
                const LAS bf16_t* kb0 = Ks + r * KS_STRIDE + 8 * hh;
                bf16x8 kf[6];
#pragma unroll
                for (int i = 0; i < 6; ++i) kf[i] = *(const LAS bf16x8*)(kb0 + 16 * i);
#pragma unroll
                for (int i = 0; i < 24; ++i) { sacc[i / 12] = __builtin_amdgcn_mfma_f32_32x32x16_bf16(kf[i % 6], qf[i % 12], sacc[i / 12], 0, 0, 0);
                    if (i + 6 < 24) kf[i % 6] = *(const LAS bf16x8*)(kb0 + ((i + 6) / 12) * 32 * KS_STRIDE + 16 * ((i + 6) % 12)); }
                __builtin_amdgcn_sched_group_barrier(0x100, 6, 0);
#pragma unroll
                for (int i = 0; i < 18; ++i) { __builtin_amdgcn_sched_group_barrier(0x008, 1, 0); __builtin_amdgcn_sched_group_barrier(0x100, 1, 0); }
                __builtin_amdgcn_sched_group_barrier(0x008, 6, 0);
            }
            __builtin_amdgcn_sched_barrier(0);
                asm volatile("" : "+v"(sacc[0][0]), "+v"(sacc[1][0]));
#pragma unroll
                for (int b = 0; b < 2; ++b)
#pragma unroll
                    for (int j = 0; j < 16; ++j) sacc[b][j] = z0;
            }
#endif
            __builtin_amdgcn_sched_barrier(0);
            {
                const LAS bf16_t* kb0 = Ks + r * KS_STRIDE + 8 * hh;
                bf16x8 kf[6];
#pragma unroll
                for (int i = 0; i < 6; ++i) kf[i] = *(const LAS bf16x8*)(kb0 + 16 * i);
#pragma unroll
                for (int i = 0; i < 24; ++i) { sacc[i / 12] = __builtin_amdgcn_mfma_f32_32x32x16_bf16(kf[i % 6], qf[i % 12], sacc[i / 12], 0, 0, 0);
                    if (i + 6 < 24) kf[i % 6] = *(const LAS bf16x8*)(kb0 + ((i + 6) / 12) * 32 * KS_STRIDE + 16 * ((i + 6) % 12)); }
                __builtin_amdgcn_sched_group_barrier(0x100, 6, 0);
#pragma unroll
                for (int i = 0; i < 18; ++i) { __builtin_amdgcn_sched_group_barrier(0x008, 1, 0); __builtin_amdgcn_sched_group_barrier(0x100, 1, 0); }
                __builtin_amdgcn_sched_group_barrier(0x008, 6, 0);
            }
            __builtin_amdgcn_sched_barrier(0);
            if (tt == 0) {
#pragma unroll
                for (int j = 8; j < 16; ++j) sacc[0][j] = -INFINITY;
#pragma unroll
                for (int j = 0; j < 16; ++j) sacc[1][j] = -INFINITY; }
            float tmax = fmaxf(sacc[0][0], sacc[1][0]);
#pragma unroll
            for (int j = 1; j < 16; ++j) tmax = fmaxf(tmax, fmaxf(sacc[0][j], sacc[1][j]));
            tmax = fmaxf(tmax, __int_as_float(__builtin_amdgcn_ds_bpermute((lane ^ 32) << 2, __float_as_int(tmax)))) * sc;
            const float mnew = fmaxf(mrun, tmax); const float alpha = __builtin_amdgcn_exp2f(mrun - mnew); mrun = mnew;
            float psum = 0.f;
#pragma unroll
            for (int b = 0; b < 2; ++b)
#pragma unroll
                for (int j = 0; j < 16; ++j) { const float p = __builtin_amdgcn_exp2f(__builtin_fmaf(sacc[b][j], sc, -mnew)); sacc[b][j] = p; psum += p; }
            lsum = lsum * alpha + psum;
            if (__builtin_amdgcn_ballot_w64(alpha != 1.0f) != 0ull) {
#pragma unroll
            for (int i = 0; i < 4; ++i)
#pragma unroll
                for (int j = 0; j < 16; ++j) oacc[i][j] *= alpha; }
            bf16x8 pf[4];
            pf[0] = pack8(sacc[0], 0); pf[1] = pack8(sacc[0], 1); pf[2] = pack8(sacc[1], 0); pf[3] = pack8(sacc[1], 1);
#ifdef PROBE_ATT_PV2
            {
                const LAS bf16_t* vb0 = Vs + r * VS_STRIDE + 8 * hh;
#pragma unroll
                for (int j = 0; j < 16; ++j) { sacc[0][j] = z0; sacc[1][j] = z0; }
#pragma unroll
                for (int i = 0; i < 16; ++i) { const bf16x8 vfd = *(const LAS bf16x8*)(vb0 + 32 * (i >> 2) * VS_STRIDE + 16 * (i & 3));
                    sacc[i & 1] = __builtin_amdgcn_mfma_f32_32x32x16_bf16(vfd, pf[i & 3], sacc[i & 1], 0, 0, 0); }
                asm volatile("" :: "v"(sacc[0][0]), "v"(sacc[1][0]));
            }
#endif
            __builtin_amdgcn_sched_barrier(0);
            {
                const LAS bf16_t* vb0 = Vs + r * VS_STRIDE + 8 * hh;
                bf16x8 vf[16];
#pragma unroll
                for (int i = 0; i < 16; ++i) vf[i] = *(const LAS bf16x8*)(vb0 + 32 * (i >> 2) * VS_STRIDE + 16 * (i & 3));
#pragma unroll
                for (int i = 0; i < 16; ++i) oacc[i >> 2] = __builtin_amdgcn_mfma_f32_32x32x16_bf16(vf[i], pf[i & 3], oacc[i >> 2], 0, 0, 0);
                __builtin_amdgcn_sched_group_barrier(0x100, 8, 1);
#pragma unroll
                for (int i = 0; i < 8; ++i) { __builtin_amdgcn_sched_group_barrier(0x008, 1, 1); __builtin_amdgcn_sched_group_barrier(0x100, 1, 1); }
                __builtin_amdgcn_sched_group_barrier(0x008, 8, 1);
            }
            __builtin_amdgcn_sched_barrier(0);
        }
    }
    if (wave_active) {
        const float ltot = lsum + __int_as_float(__builtin_amdgcn_ds_bpermute((lane ^ 32) << 2, __float_as_int(lsum))); const float inv = 1.0f / ltot;
        bf16_t* orow = MIX + (size_t)qrow * D + 128 * h;
#pragma unroll
        for (int dvb = 0; dvb < 4; ++dvb)
#pragma unroll
            for (int g = 0; g < 4; ++g) { u32x2 o; o.x = cvtpk(oacc[dvb][4 * g] * inv, oacc[dvb][4 * g + 1] * inv); o.y = cvtpk(oacc[dvb][4 * g + 2] * inv, oacc[dvb][4 * g + 3] * inv);
                *(GAS u32x2*)(orow + 32 * dvb + 8 * g + 4 * hh) = o; }
    }
    __syncthreads();
}
__device__ __forceinline__ void attn_phase(LAS unsigned char* lds, const bf16_t* Q, const bf16_t* KN, const bf16_t* KR, const bf16_t* VT, bf16_t* MIX, const float* rope, int bid, int nblk) {
    const int w = opq(threadIdx.x) >> 6;
    for (int s = bid; s < 512; s += nblk) {
        const int round = s >> 8, x = s & 255; const int bh = (x >> 4) + 16 * round, qb = round ? 15 - (x & 15) : (x & 15);
        const int b = bh >> 2, h = bh & 3;
        attn_unit(lds, Q, KN, KR, VT, MIX, rope, h, b * SEQ + 256 * qb, b * SEQ, 4 * qb + 5, 4 * qb + (w >> 1) + 1, true);
    }
    for (int s = bid; s < 4; s += nblk)
        attn_unit(lds, Q, KN, KR, VT, MIX, rope, s, RREAL, 0, 1, 0, w == 0);
}

constexpr int CLS = 72;
constexpr int CSLOT = 64 * CLS * 2;
constexpr int CHK_BYTES = 32768;
constexpr int NSEQ_HALF0 = 257;
struct CpP { const bf16_t* PR; const bf16_t* LO; const bf16_t* VMIX; const bf16_t* VFIRST; bf16_t* VP; float* RK; unsigned char* CHK;
    const float *mu, *w0, *a0, *k_k, *k_a, *r_k, *v0; int layer, pad; };

__device__ __forceinline__ void mm64(f32x16& acc, const LAS bf16_t* a, const LAS bf16_t* b, int r, int hh) {
    bf16x8 af[4], bf[4];
#pragma unroll
    for (int ks = 0; ks < 4; ++ks) { af[ks] = *(const LAS bf16x8*)(a + r * CLS + 16 * ks + 8 * hh); bf[ks] = *(const LAS bf16x8*)(b + r * CLS + 16 * ks + 8 * hh); }
#pragma unroll
    for (int ks = 0; ks < 4; ++ks) acc = __builtin_amdgcn_mfma_f32_32x32x16_bf16(af[ks], bf[ks], acc, 0, 0, 0);
}
__device__ __forceinline__ void st_tile(const f32x16& acc, LAS bf16_t* dst, int m0, int n0, int r, int hh) {
#pragma unroll
    for (int q = 0; q < 16; ++q) dst[(m0 + (q & 3) + 8 * (q >> 2) + 4 * hh) * CLS + n0 + r] = f2bf_hw(acc[q]);
}
__device__ __forceinline__ void st_tile_t(const f32x16& acc, LAS bf16_t* dst, int m0, int n0, int r, int hh) {
#pragma unroll
    for (int g = 0; g < 4; ++g) { u32x2 o; o.x = cvtpk(acc[4 * g], acc[4 * g + 1]); o.y = cvtpk(acc[4 * g + 2], acc[4 * g + 3]);
        *(LAS u32x2*)(dst + (n0 + r) * CLS + m0 + 8 * g + 4 * hh) = o; }
}
__device__ __forceinline__ void zero16(f32x16& a, float z) {
#pragma unroll
    for (int q = 0; q < 16; ++q) a[q] = z;
}
struct CpRaw { bf16_t xr[9], xk[9], xv[9], lw[8], la[8], vm[8], vf[8]; float mu_r, mu_k, mu_v, w0, a0, kkc, kac, rkc, v0, pm0; };
__device__ __forceinline__ void cp_issue(const CpP& P, int row0, int hd, int w, int lane, CpRaw& R) {
    const int c = hd * 64 + lane;
    R.mu_r = ((const GAS float*)P.mu)[c]; R.mu_k = ((const GAS float*)P.mu)[512 + c]; R.mu_v = ((const GAS float*)P.mu)[1024 + c]; R.w0 = ((const GAS float*)P.w0)[c]; R.a0 = ((const GAS float*)P.a0)[c];
    R.kkc = ((const GAS float*)P.k_k)[c]; R.kac = ((const GAS float*)P.k_a)[c]; R.rkc = ((const GAS float*)P.r_k)[c]; R.v0 = P.layer ? ((const GAS float*)P.v0)[c] : 0.f;
    const int rw0 = row0 + 8 * w; const int prow0 = w == 0 ? row_prev(row0) : rw0 - 1; R.pm0 = prow0 < 0 ? 0.f : 1.f;
    { const GAS bf16_t* xp = (const GAS bf16_t*)(P.PR + (size_t)(prow0 < 0 ? rw0 : prow0) * PRW); R.xr[0] = xp[c]; R.xk[0] = xp[512 + c]; R.xv[0] = xp[1024 + c]; }
#pragma unroll
    for (int q = 0; q < 8; ++q) { const GAS bf16_t* x = (const GAS bf16_t*)(P.PR + (size_t)(rw0 + q) * PRW); R.xr[q + 1] = x[c]; R.xk[q + 1] = x[512 + c]; R.xv[q + 1] = x[1024 + c];
        const GAS bf16_t* lo = (const GAS bf16_t*)(P.LO + (size_t)(rw0 + q) * 1536); R.lw[q] = lo[c]; R.la[q] = lo[512 + c];
        if (P.layer) { R.vm[q] = ((const GAS bf16_t*)P.VMIX)[(size_t)(rw0 + q) * 512 + c]; R.vf[q] = ((const GAS bf16_t*)P.VFIRST)[(size_t)(rw0 + q) * 512 + c]; } else { R.vm[q] = 0; R.vf[q] = 0; } }
}
__device__ __forceinline__ void rwkv_cp_task(LAS unsigned char* lds, const CpP& P, int row0, int hd, unsigned char* out, CpRaw& R, bool has_next, int nrow0, int nhd) {
    const int tid = opq(threadIdx.x), lane = tid & 63, w = __builtin_amdgcn_readfirstlane(tid >> 6), r = lane & 31, hh = lane >> 5;
    float z0 = 0.f; asm volatile("" : "+v"(z0));
    LAS bf16_t* S_ATtm = (LAS bf16_t*)(lds + 0 * CSLOT);
    LAS bf16_t* S_BHtm = (LAS bf16_t*)(lds + 1 * CSLOT);
    LAS bf16_t* S_KHtm = (LAS bf16_t*)(lds + 2 * CSLOT);
    LAS bf16_t* S_RTtm = (LAS bf16_t*)(lds + 3 * CSLOT);
    LAS bf16_t* S_ATcm = (LAS bf16_t*)(lds + 4 * CSLOT);
    LAS bf16_t* S_BBcm = (LAS bf16_t*)(lds + 5 * CSLOT);
    LAS bf16_t* S_KBcm = (LAS bf16_t*)(lds + 6 * CSLOT);
    LAS bf16_t* S_VTcm = (LAS bf16_t*)(lds + 7 * CSLOT);
    LAS bf16_t* S_Q0a = (LAS bf16_t*)(lds + 8 * CSLOT);
    LAS bf16_t* S_Q0b = (LAS bf16_t*)(lds + 9 * CSLOT);
    LAS bf16_t* S_PP0 = (LAS bf16_t*)(lds + 10 * CSLOT);
    LAS bf16_t* S_Na = (LAS bf16_t*)(lds + 11 * CSLOT);
    LAS bf16_t* S_XT = (LAS bf16_t*)(lds + 12 * CSLOT);
    LAS bf16_t* S_Pa = (LAS bf16_t*)(lds + 13 * CSLOT);
    LAS bf16_t* S_Qa = (LAS bf16_t*)(lds + 14 * CSLOT);
    LAS float* S_TOT = (LAS float*)(lds + 15 * CSLOT);
    LAS bf16_t* Qa[2] = {S_Q0a, S_ATtm}; LAS bf16_t* Qb[2] = {S_Q0b, S_BHtm}; LAS bf16_t* PPa[2] = {S_PP0, S_KHtm};

    {
        const int c = hd * 64 + lane;
        const float mu_r = R.mu_r, mu_k = R.mu_k, mu_v = R.mu_v, w0 = R.w0, a0 = R.a0, kkc = R.kkc, kac = R.kac, rkc = R.rkc, v0 = R.v0, pm0 = R.pm0;
        float fr[8], fk[8], fv[8], fa[8], fb[8], lw[8];
        const int rw0 = row0 + 8 * w;
#pragma unroll
        for (int q = 0; q < 8; ++q) { const int row = rw0 + q; const bool valid = row < RVALID; const float pm = q == 0 ? pm0 : 1.f;
            float rr = bf2f(R.xr[q + 1]), kk = bf2f(R.xk[q + 1]), vv = bf2f(R.xv[q + 1]);
            rr = rr + (pm * bf2f(R.xr[q]) - rr) * mu_r; kk = kk + (pm * bf2f(R.xk[q]) - kk) * mu_k; vv = vv + (pm * bf2f(R.xv[q]) - vv) * mu_v;
            const float wpre = bf2f(R.lw[q]), apre = bf2f(R.la[q]);
            constexpr float L2E = 1.4426950408889634f;
            float lwv = -0.6065306597126334f * __builtin_amdgcn_rcpf(1.0f + __builtin_amdgcn_exp2f(-(w0 + wpre) * L2E));
            const float asig = __builtin_amdgcn_rcpf(1.0f + __builtin_amdgcn_exp2f(-(a0 + apre) * L2E));
            if (P.layer) { const float vm = bf2f(R.vm[q]), vf = bf2f(R.vf[q]); vv = vv + (vf - vv) * __builtin_amdgcn_rcpf(1.0f + __builtin_amdgcn_exp2f(-(v0 + vm) * L2E)); }
            const float kkr = kk * kkc; const float ss = wave_sum(kkr * kkr); float kn = kkr * rsqrtf(fmaxf(ss, 1e-24f));
            float k2 = kk * (1.f + (asig - 1.f) * kac);
            const float rk = wave_sum(rr * k2 * rkc);
            if (!valid) { rr = 0.f; k2 = 0.f; vv = 0.f; kn = 0.f; lwv = 0.f; }
            ((GAS bf16_t*)P.VP)[(size_t)row * 512 + c] = f2bf_hw(vv); if (lane == 0) ((GAS float*)P.RK)[(size_t)row * 8 + hd] = valid ? rk : 0.f;
            fr[q] = rr; fk[q] = k2; fv[q] = vv; fa[q] = -kn; fb[q] = kn * asig; lw[q] = lwv; }
        if (has_next) cp_issue(P, nrow0, nhd, w, lane, R);
        float cum[8]; cum[0] = lw[0];
#pragma unroll
        for (int q = 1; q < 8; ++q) cum[q] = cum[q - 1] + lw[q];
        S_TOT[w * 64 + lane] = cum[7];
        lds_barrier();
        float off = 0.f, tot = 0.f;
#pragma unroll
        for (int ww = 0; ww < 8; ++ww) { const float tv = S_TOT[ww * 64 + lane]; off += ww < w ? tv : 0.f; tot += tv; }
        constexpr float L2E_ = 1.4426950408889634f;
        const float etot = __builtin_amdgcn_exp2f(tot * L2E_);
        if (w == 0) S_TOT[512 + lane] = etot;
        float at[8], bh[8], kh[8], rt[8], bb[8], kb[8];
        float ecprev = __builtin_amdgcn_exp2f(off * L2E_);
#pragma unroll
        for (int q = 0; q < 8; ++q) { const float ci = off + cum[q]; const float ec = __builtin_amdgcn_exp2f(ci * L2E_), ecp = ecprev, en = __builtin_amdgcn_rcpf(ec), ee = etot * en; ecprev = ec;
            rt[q] = fr[q] * ec; at[q] = fa[q] * ecp; bh[q] = fb[q] * en; kh[q] = fk[q] * en; bb[q] = fb[q] * ee; kb[q] = fk[q] * ee; }
#pragma unroll
        for (int q = 0; q < 8; ++q) { const int t = 8 * w + q; S_ATtm[t * CLS + lane] = f2bf_hw(at[q]); S_BHtm[t * CLS + lane] = f2bf_hw(bh[q]); S_KHtm[t * CLS + lane] = f2bf_hw(kh[q]); S_RTtm[t * CLS + lane] = f2bf_hw(rt[q]); }
        { u32x4 o;
          o.x = cvtpk(at[0], at[1]); o.y = cvtpk(at[2], at[3]); o.z = cvtpk(at[4], at[5]); o.w = cvtpk(at[6], at[7]); *(LAS u32x4*)(S_ATcm + lane * CLS + 8 * w) = o;
          o.x = cvtpk(bb[0], bb[1]); o.y = cvtpk(bb[2], bb[3]); o.z = cvtpk(bb[4], bb[5]); o.w = cvtpk(bb[6], bb[7]); *(LAS u32x4*)(S_BBcm + lane * CLS + 8 * w) = o;
          o.x = cvtpk(kb[0], kb[1]); o.y = cvtpk(kb[2], kb[3]); o.z = cvtpk(kb[4], kb[5]); o.w = cvtpk(kb[6], kb[7]); *(LAS u32x4*)(S_KBcm + lane * CLS + 8 * w) = o;
          o.x = cvtpk(fv[0], fv[1]); o.y = cvtpk(fv[2], fv[3]); o.z = cvtpk(fv[4], fv[5]); o.w = cvtpk(fv[6], fv[7]); *(LAS u32x4*)(S_VTcm + lane * CLS + 8 * w) = o; }
    }
    lds_barrier();
    const int q4 = w & 3, mb = q4 >> 1, nb = q4 & 1; const bool upper = (mb == 0 && nb == 1);
    f32x16 pacc;
    {
        f32x16 a0, a1; zero16(a0, z0); zero16(a1, z0);
        const LAS bf16_t* lhs = (w < 4 ? S_ATtm : S_RTtm) + 32 * mb * CLS;
        if (!upper) { mm64(a0, lhs, S_BHtm + 32 * nb * CLS, r, hh); mm64(a1, lhs, S_KHtm + 32 * nb * CLS, r, hh); }
        const int s = 32 * nb + r;
#pragma unroll
        for (int q = 0; q < 16; ++q) { const int t = 32 * mb + (q & 3) + 8 * (q >> 2) + 4 * hh; const bool keep = w < 4 ? (s < t) : (s <= t); if (!keep) { a0[q] = z0; a1[q] = z0; } }
        if (w < 4) { st_tile(a0, S_Q0a, 32 * mb, 32 * nb, r, hh); st_tile_t(a0, S_Q0b, 32 * mb, 32 * nb, r, hh); st_tile(a1, S_Na, 32 * mb, 32 * nb, r, hh);
            pacc = a0;
#pragma unroll
            for (int q = 0; q < 16; ++q) { const int t = 32 * mb + (q & 3) + 8 * (q >> 2) + 4 * hh; if (t == s) pacc[q] += 1.0f; }
            st_tile(pacc, S_PP0, 32 * mb, 32 * nb, r, hh); }
        else { st_tile(a0, S_Pa, 32 * mb, 32 * nb, r, hh); st_tile(a1, S_Qa, 32 * mb, 32 * nb, r, hh); zero16(pacc, z0); }
    }
    lds_barrier();
    {
        f32x16 a; zero16(a, z0);
        if (w >= 4) { if (!upper) { mm64(a, Qa[0] + 32 * mb * CLS, Qb[0] + 32 * nb * CLS, r, hh); } st_tile(a, Qa[1], 32 * mb, 32 * nb, r, hh); st_tile_t(a, Qb[1], 32 * mb, 32 * nb, r, hh); }
        else { mm64(a, S_Na + 32 * mb * CLS, S_VTcm + 32 * nb * CLS, r, hh); st_tile_t(a, S_XT, 32 * mb, 32 * nb, r, hh); }
    }
    lds_barrier();
#pragma unroll 1
    for (int k = 1; k <= 5; ++k) {
        const int rs = k & 1, ws_ = rs ^ 1;
        if (w < 4) { if (!upper) mm64(pacc, PPa[ws_] + 32 * mb * CLS, Qb[rs] + 32 * nb * CLS, r, hh); st_tile(pacc, PPa[rs], 32 * mb, 32 * nb, r, hh); }
        else if (k < 5) { f32x16 a; zero16(a, z0); if (!upper) mm64(a, Qa[rs] + 32 * mb * CLS, Qb[rs] + 32 * nb * CLS, r, hh); st_tile(a, Qa[ws_], 32 * mb, 32 * nb, r, hh); st_tile_t(a, Qb[ws_], 32 * mb, 32 * nb, r, hh); }
        lds_barrier();
    }
    {
        f32x16 a; zero16(a, z0);
        mm64(a, PPa[1] + 32 * mb * CLS, (w < 4 ? S_ATcm : S_XT) + 32 * nb * CLS, r, hh);
        st_tile_t(a, w < 4 ? S_Q0a : S_Q0b, 32 * mb, 32 * nb, r, hh);
    }
    lds_barrier();
    {
        LAS bf16_t* W1T = S_Q0a; LAS bf16_t* U1T = S_Q0b;
        f32x16 a, b; zero16(a, z0); zero16(b, z0);
        GAS u32x4* o128 = (GAS u32x4*)out;
        if (w < 4) {
            mm64(a, S_BBcm + 32 * mb * CLS, U1T + 32 * nb * CLS, r, hh); mm64(a, S_KBcm + 32 * mb * CLS, S_VTcm + 32 * nb * CLS, r, hh);
            mm64(b, W1T + 32 * mb * CLS, S_BBcm + 32 * nb * CLS, r, hh);
            const float gam = S_TOT[512 + 32 * nb + r];
#pragma unroll
            for (int q = 0; q < 16; ++q) { const int j = 32 * mb + (q & 3) + 8 * (q >> 2) + 4 * hh; if (j == 32 * nb + r) b[q] += gam; }
            u32x4 h0, h1, g0, g1;
            h0.x = cvtpk(a[0], a[1]); h0.y = cvtpk(a[2], a[3]); h0.z = cvtpk(a[4], a[5]); h0.w = cvtpk(a[6], a[7]);
            h1.x = cvtpk(a[8], a[9]); h1.y = cvtpk(a[10], a[11]); h1.z = cvtpk(a[12], a[13]); h1.w = cvtpk(a[14], a[15]);
            g0.x = cvtpk(b[0], b[1]); g0.y = cvtpk(b[2], b[3]); g0.z = cvtpk(b[4], b[5]); g0.w = cvtpk(b[6], b[7]);
            g1.x = cvtpk(b[8], b[9]); g1.y = cvtpk(b[10], b[11]); g1.z = cvtpk(b[12], b[13]); g1.w = cvtpk(b[14], b[15]);
            o128[1024 + ((mb * 2 + nb) * 64 + lane) * 2] = h0; o128[1024 + ((mb * 2 + nb) * 64 + lane) * 2 + 1] = h1;
            o128[(nb * 4 + 2 * mb) * 64 + lane] = g0; o128[(nb * 4 + 2 * mb + 1) * 64 + lane] = g1;
        } else {
            mm64(a, S_Pa + 32 * mb * CLS, U1T + 32 * nb * CLS, r, hh); mm64(a, S_Qa + 32 * mb * CLS, S_VTcm + 32 * nb * CLS, r, hh);
            mm64(b, W1T + 32 * mb * CLS, S_Pa + 32 * nb * CLS, r, hh);
#pragma unroll
            for (int g = 0; g < 4; ++g) { const s16x4 rv = *(const LAS s16x4*)(S_RTtm + (32 * nb + r) * CLS + 32 * mb + 8 * g + 4 * hh);
#pragma unroll
                for (int e = 0; e < 4; ++e) b[4 * g + e] += bf2f((bf16_t)rv[e]); }
            u32x4 y0, y1, r0, r1;
            y0.x = cvtpk(a[0], a[1]); y0.y = cvtpk(a[2], a[3]); y0.z = cvtpk(a[4], a[5]); y0.w = cvtpk(a[6], a[7]);
            y1.x = cvtpk(a[8], a[9]); y1.y = cvtpk(a[10], a[11]); y1.z = cvtpk(a[12], a[13]); y1.w = cvtpk(a[14], a[15]);
            r0.x = cvtpk(b[0], b[1]); r0.y = cvtpk(b[2], b[3]); r0.z = cvtpk(b[4], b[5]); r0.w = cvtpk(b[6], b[7]);
            r1.x = cvtpk(b[8], b[9]); r1.y = cvtpk(b[10], b[11]); r1.z = cvtpk(b[12], b[13]); r1.w = cvtpk(b[14], b[15]);
            o128[1536 + ((mb * 2 + nb) * 64 + lane) * 2] = y0; o128[1536 + ((mb * 2 + nb) * 64 + lane) * 2 + 1] = y1;
            o128[512 + (nb * 4 + 2 * mb) * 64 + lane] = r0; o128[512 + (nb * 4 + 2 * mb + 1) * 64 + lane] = r1;
        }
    }
    lds_barrier();
}

struct ScP { const unsigned char* CHK; bf16_t* YS; };
__device__ __forceinline__ void scan_unpack16(f32x16& acc, const u32x4 y0, const u32x4 y1) {
    acc[0] = __uint_as_float(y0.x << 16); acc[1] = __uint_as_float(y0.x & 0xffff0000u); acc[2] = __uint_as_float(y0.y << 16); acc[3] = __uint_as_float(y0.y & 0xffff0000u);
    acc[4] = __uint_as_float(y0.z << 16); acc[5] = __uint_as_float(y0.z & 0xffff0000u); acc[6] = __uint_as_float(y0.w << 16); acc[7] = __uint_as_float(y0.w & 0xffff0000u);
    acc[8] = __uint_as_float(y1.x << 16); acc[9] = __uint_as_float(y1.x & 0xffff0000u); acc[10] = __uint_as_float(y1.y << 16); acc[11] = __uint_as_float(y1.y & 0xffff0000u);
    acc[12] = __uint_as_float(y1.z << 16); acc[13] = __uint_as_float(y1.z & 0xffff0000u); acc[14] = __uint_as_float(y1.w << 16); acc[15] = __uint_as_float(y1.w & 0xffff0000u);
}
__device__ __forceinline__ void scan_step(const LAS unsigned char* sl, LAS float* ybuf, f32x16 (&st)[2], int w, int lane, int r, int hh) {
    bf16x8 ar[2][4], ag[2][4]; u32x4 yi[2][2], hi[2][2];
#pragma unroll
    for (int tb = 0; tb < 2; ++tb) { const LAS u32x4* yf = (const LAS u32x4*)(sl + 24576) + ((tb * 2 + w) * 64 + lane) * 2; yi[tb][0] = yf[0]; yi[tb][1] = yf[1];
        const LAS u32x4* hf = (const LAS u32x4*)(sl + 16384) + ((tb * 2 + w) * 64 + lane) * 2; hi[tb][0] = hf[0]; hi[tb][1] = hf[1];
#pragma unroll
        for (int ks = 0; ks < 4; ++ks) { ar[tb][ks] = *(const LAS bf16x8*)(sl + 8192 + ((tb * 4 + ks) * 64 + lane) * 16); ag[tb][ks] = *(const LAS bf16x8*)(sl + ((tb * 4 + ks) * 64 + lane) * 16); } }
    bf16x8 sf[4];
    sf[0] = pack8(st[0], 0); sf[1] = pack8(st[0], 1); sf[2] = pack8(st[1], 0); sf[3] = pack8(st[1], 1);
    f32x16 ya[2], sa[2];
#pragma unroll
    for (int tb = 0; tb < 2; ++tb) { scan_unpack16(ya[tb], yi[tb][0], yi[tb][1]); scan_unpack16(sa[tb], hi[tb][0], hi[tb][1]); }
#pragma unroll
    for (int ks = 0; ks < 4; ++ks) {
        ya[0] = __builtin_amdgcn_mfma_f32_32x32x16_bf16(ar[0][ks], sf[ks], ya[0], 0, 0, 0); ya[1] = __builtin_amdgcn_mfma_f32_32x32x16_bf16(ar[1][ks], sf[ks], ya[1], 0, 0, 0);
        sa[0] = __builtin_amdgcn_mfma_f32_32x32x16_bf16(ag[0][ks], sf[ks], sa[0], 0, 0, 0); sa[1] = __builtin_amdgcn_mfma_f32_32x32x16_bf16(ag[1][ks], sf[ks], sa[1], 0, 0, 0); }
    st[0] = sa[0]; st[1] = sa[1];
#pragma unroll
    for (int tb = 0; tb < 2; ++tb)
#pragma unroll
        for (int q = 0; q < 16; ++q) ybuf[(32 * tb + (q & 3) + 8 * (q >> 2) + 4 * hh) * 64 + 32 * w + r] = ya[tb][q];
}
__device__ __forceinline__ void rwkv_scan_unit(LAS unsigned char* lds, const ScP& P, int seq0, int seqm, int nmeta, int nreal, int brow0, int hd, bool write_meta, const float* st_in, float* st_out) {
    const int tid = opq(threadIdx.x), lane = tid & 63, w = __builtin_amdgcn_readfirstlane(tid >> 6), r = lane & 31, hh = lane >> 5;
    const int N = nmeta + nreal;
    float z0 = 0.f; asm volatile("" : "+v"(z0));
    LAS float* ybuf = (LAS float*)(lds + 65536);
    f32x16 st[2]; zero16(st[0], z0); zero16(st[1], z0);
    if (st_in != nullptr && w < 2) { const GAS f32x4* sp = (const GAS f32x4*)(st_in + ((size_t)w * 64 + lane) * 32);
#pragma unroll
        for (int i = 0; i < 8; ++i) { const f32x4 v = sp[i];
#pragma unroll
            for (int j = 0; j < 4; ++j) st[i >> 2][4 * (i & 3) + j] = v[j]; } }
    const int c = hd * 64 + lane;
#define SCAN_SRC(n_) ((const GAS u32x4*)(P.CHK + ((size_t)((n_) < nmeta ? seqm : seq0 + (n_) - nmeta) * 8 + hd) * CHK_BYTES))
    u32x4 pa[4], pb[4], pc[4];
    { const GAS u32x4* s0 = SCAN_SRC(0); const GAS u32x4* s1 = SCAN_SRC(1); const GAS u32x4* s2 = SCAN_SRC(2);
#pragma unroll
      for (int i = 0; i < 4; ++i) pc[i] = s0[tid + 512 * i];
#pragma unroll
      for (int i = 0; i < 4; ++i) pa[i] = s1[tid + 512 * i];
#pragma unroll
      for (int i = 0; i < 4; ++i) pb[i] = s2[tid + 512 * i];
#pragma unroll
      for (int i = 0; i < 4; ++i) *(LAS u32x4*)(lds + (tid + 512 * i) * 16) = pc[i]; }
    lds_barrier();
#define SCAN_ITER(n_, PCUR, PMID, PNEXT) do { \
        const int n = (n_); \
        if (n + 3 < N) { const GAS u32x4* s3 = SCAN_SRC(n + 3); _Pragma("unroll") for (int i = 0; i < 4; ++i) PNEXT[i] = s3[tid + 512 * i]; } \
        if (w < 2) scan_step(lds + (n & 1) * 32768, ybuf, st, w, lane, r, hh); \
        lds_barrier(); \
        if (n + 1 < N) { _Pragma("unroll") for (int i = 0; i < 4; ++i) *(LAS u32x4*)(lds + ((n + 1) & 1) * 32768 + (tid + 512 * i) * 16) = PCUR[i]; } \
        if (w >= 2) { const int crow0 = n < nmeta ? RREAL : brow0 + 64 * (n - nmeta); const int nrow = n < nmeta ? (write_meta ? NMETA : 0) : 64; \
            for (int t = w - 2; t < nrow; t += 6) ((GAS bf16_t*)P.YS)[(size_t)(crow0 + t) * 512 + c] = f2bf_hw(ybuf[t * 64 + lane]); } \
        lds_barrier(); } while (0)
    int n3 = 0;
#pragma unroll 1
    for (; n3 + 3 <= N; n3 += 3) { SCAN_ITER(n3, pa, pb, pc); SCAN_ITER(n3 + 1, pb, pc, pa); SCAN_ITER(n3 + 2, pc, pa, pb); }
    if (N - n3 >= 1) SCAN_ITER(n3, pa, pb, pc);
    if (N - n3 >= 2) SCAN_ITER(n3 + 1, pb, pc, pa);
#undef SCAN_ITER
#undef SCAN_SRC
    if (st_out != nullptr && w < 2) { GAS f32x4* sp = (GAS f32x4*)(st_out + ((size_t)w * 64 + lane) * 32);
#pragma unroll
        for (int i = 0; i < 8; ++i) { f32x4 v;
#pragma unroll
            for (int j = 0; j < 4; ++j) v[j] = st[i >> 2][4 * (i & 3) + j];
            sp[i] = v; } }
}
struct PostP { const bf16_t* YS; const bf16_t* VP; const float* RK; const bf16_t* LO; bf16_t* MIX; const float *ln_w, *ln_b; };
__device__ __forceinline__ void rwkv_post(const PostP& P, int q, int rlo, int rhi, bool with_meta, int gw, int ngw, int lane) {
    lane = opq(lane);
    const int nreal = (rhi - rlo) * 8, ntot = nreal + (with_meta ? NMETA * 8 : 0);
    for (int item = gw; item < ntot; item += ngw) { const int ri = rlo + (item >> 3); const int row = item < nreal ? (ri >> 10) * SEQ + 1024 * q + (ri & 1023) : RREAL + ((item - nreal) >> 3); const int hd = item & 7, c = hd * 64 + lane;
        const float y = bf2f(P.YS[(size_t)row * 512 + c]); const float g = bf2f(P.LO[(size_t)row * 1536 + 1024 + c]), vp = bf2f(P.VP[(size_t)row * 512 + c]), rk = P.RK[(size_t)row * 8 + hd];
        const float mean = wave_sum(y) * (1.f / 64.f); const float d = y - mean; const float var = wave_sum(d * d) * (1.f / 64.f);
        const float yn = d * rsqrtf(var + GN_EPS) * P.ln_w[c] + P.ln_b[c];
        P.MIX[(size_t)row * D + 512 + c] = f2bf_hw((yn + rk * vp) * g); }
}

constexpr int LDS_BYTES = 147456, LDS_MISC = LDS_BYTES - 512;
struct Params { const float* in[33]; float* out; unsigned char* ws; };
constexpr int CW_BAR = 4096;


#ifndef PROBE_REP_MISC
#define PROBE_REP_MISC 1
#endif
#ifndef MOE_TAIL
#define MOE_TAIL 0
#endif
#ifndef PROBE_REP_OUTPROJ
#define PROBE_REP_OUTPROJ 1
#endif
#ifndef PROBE_REP_FFNDN
#define PROBE_REP_FFNDN 1
#endif
#ifndef PROBE_REP_MOEDN
#define PROBE_REP_MOEDN 1
#endif
#ifndef PROBE_REP_NORM
#define PROBE_REP_NORM 1
#endif
#ifndef PROBE_REP_INPROJ
#define PROBE_REP_INPROJ 1
#endif
#ifndef PROBE_REP_PREP
#define PROBE_REP_PREP 1
#endif
#ifndef PROBE_REP_P4A
#define PROBE_REP_P4A 1
#endif
#ifndef PROBE_REP_ATT
#define PROBE_REP_ATT 1
#endif
#ifndef PROBE_REP_P4B
#define PROBE_REP_P4B 1
#endif
#ifndef PROBE_REP_CP
#define PROBE_REP_CP 1
#endif
#ifndef PROBE_REP_SCAN
#define PROBE_REP_SCAN 1
#endif
#ifndef PROBE_REP_FFNGU
#define PROBE_REP_FFNGU 1
#endif
#ifndef PROBE_REP_MOETR
#define PROBE_REP_MOETR 1
#endif
#ifndef PROBE_REP_GATHER
#define PROBE_REP_GATHER 1
#endif
#ifndef PROBE_REP_MOEGU
#define PROBE_REP_MOEGU 1
#endif
#define LDP(k) ((const float*)ldk(kp, 8 * (k)))
#define OUTP ((float*)ldk(kp, 264))
#define WSP ((unsigned char*)ldk(kp, 272))
#define NOINL __device__ __attribute__((noinline))
#define WAVE_IDS() const int tid = threadIdx.x, lane = tid & 63, wave = __builtin_amdgcn_readfirstlane(tid >> 6), bid = (int)blockIdx.x, nblk = (int)gridDim.x, gw = bid * 8 + wave, ngw = nblk * 8; (void)lane; (void)gw; (void)ngw
NOINL void f_p0(unsigned long long kp_, LAS unsigned char* lds) {
    const unsigned long long kp = kp_uniform(kp_); WAVE_IDS(); LAS float* scr = (LAS float*)(lds + wave * 8448);
    {
        unsigned* ctl = (unsigned*)(WSP + WS_CTL);
#pragma unroll 1
        for (int te = wave; te < 24; te += 8) { const int t = te >> 3, e = te & 7;
            const float* wt = t == 0 ? LDP(30) : (t == 1 ? LDP(31) : LDP(32));
            const f32x4 v = ((const f32x4*)(wt + (size_t)e * ((size_t)D * FFE) + (size_t)(bid % 256) * 14336))[lane];
            const float m = wave_max(fmaxf(fmaxf(fabsf(v.x), fabsf(v.y)), fmaxf(fabsf(v.z), fabsf(v.w))));
            if (lane == 0) atomicMax(&ctl[CW_WMAX + te], __float_as_uint(m)); } }
    { unsigned char* ws = WSP;
      ph_init(LDP(0), LDP(1), OUTP, (float*)(ws + WS_HMETA), (float*)(ws + WS_ROPE), LDP(23), LDP(24), (bf16_t*)(ws + WS_V1T), (size_t)bid * 512 + tid, (size_t)nblk * 512); }
#pragma unroll 1
    for (int l = 0; l < 2; ++l) { unsigned char* lw = WSP + WS_WB + l * LW_STRIDE;
        { const TrJob J{LDP(5) + (size_t)l * D * 2624, nullptr, (bf16_t*)(lw + LW_WIN), D, 2624, 1024, 0, 1, 0}; ph_transpose(J, scr, gw, ngw, lane); }
        { const TrJob J{LDP(9) + (size_t)l * 512 * 768, LDP(7) + l * 512, (bf16_t*)(lw + LW_WUQ), 512, 768, 512, 0, 0, 0}; ph_transpose(J, scr, gw, ngw, lane); }
        { const TrJob J{LDP(10) + (size_t)l * 256 * 1024, LDP(8) + l * 256, (bf16_t*)(lw + LW_WK), 256, 1024, 256, 0, 4, 0}; ph_transpose(J, scr, gw, ngw, lane); }
        { const TrJob J{LDP(13) + (size_t)l * 64 * 512, nullptr, (bf16_t*)(lw + LW_LORA), 64, 512, 256, 0, 0, 0}; ph_transpose(J, scr, gw, ngw, lane); }
        { const TrJob J{LDP(15) + (size_t)l * 64 * 512, nullptr, (bf16_t*)(lw + LW_LORA), 64, 512, 256, 64, 0, 512}; ph_transpose(J, scr, gw, ngw, lane); }
        { const TrJob J{LDP(16) + (size_t)l * 128 * 512, nullptr, (bf16_t*)(lw + LW_LORA), 128, 512, 256, 128, 0, 1024}; ph_transpose(J, scr, gw, ngw, lane); }
        { const TrJob J{LDP(6) + (size_t)l * D * D, nullptr, (bf16_t*)(lw + LW_WOUT), D, D, 1024, 0, 0, 0}; ph_transpose(J, scr, gw, ngw, lane); }
    }
    { const TrJob J{LDP(25), nullptr, (bf16_t*)(WSP + WS_FGU), D, FF0, 1024, 0, 2, 0}; ph_transpose(J, scr, gw, ngw, lane); }
    { const TrJob J{LDP(26), nullptr, (bf16_t*)(WSP + WS_FGU), D, FF0, 1024, 0, 3, 0}; ph_transpose(J, scr, gw, ngw, lane); }
    { const TrJob J{LDP(27), nullptr, (bf16_t*)(WSP + WS_FDN), FF0, D, FF0, 0, 0, 0}; ph_transpose(J, scr, gw, ngw, lane); }
}
NOINL void f_rmsnorm(unsigned long long kp_, int which, int l) { const unsigned long long kp = kp_uniform(kp_); which = __builtin_amdgcn_readfirstlane(which); l = __builtin_amdgcn_readfirstlane(l); WAVE_IDS(); unsigned char* ws = WSP;
    const float* hsrc = (which == 0 && l == 0) ? LDP(0) : (const float*)OUTP;
    ph_rmsnorm(hsrc, (const float*)(ws + WS_HMETA), (which ? LDP(3) : LDP(2)) + l * D, (bf16_t*)(ws + A_U), (const float*)(ws + A_PART), which ? 4 : (l ? 11 : 0), gw, ngw, lane); }
NOINL void f_prep(unsigned long long kp_, int l) { const unsigned long long kp = kp_uniform(kp_); l = __builtin_amdgcn_readfirstlane(l); WAVE_IDS(); unsigned char* ws = WSP;
    ph_prep((const bf16_t*)(ws + A_PM), (const bf16_t*)(ws + A_PR), LDP(11) + l * 1792, (const float*)(ws + WS_ROPE), (float*)(ws + A_RSTDQ), (float*)(ws + A_RSTDKV),
            (bf16_t*)(ws + A_KROPE), (bf16_t*)(ws + A_LIN), (bf16_t*)(ws + A_VSH), l, gw, ngw, lane); }
constexpr int RW_NSEQ = 129;
constexpr size_t RW_BUF = (size_t)RW_NSEQ * 8 * CHK_BYTES;
static_assert(2 * RW_BUF <= A_VFIRST - A_CHK, "two chunk buffers fit the chunk region");
constexpr int RW_SKIP = 4;
__device__ __forceinline__ bool rw_is_scan_wg(int bid) { return (bid & 3) == 0; }
__device__ __forceinline__ int rw_rank(int bid) { return bid - (bid >> 2) - 1; }
__device__ __forceinline__ void f_rwkv_cp(unsigned long long kp_, LAS unsigned char* lds, int l, int q) {
    const unsigned long long kp = kp_uniform(kp_); l = __builtin_amdgcn_readfirstlane(l); q = __builtin_amdgcn_readfirstlane(q);
    const int bid = (int)blockIdx.x, nblk = (int)gridDim.x; unsigned char* ws = WSP;
    const CpP cp{(const bf16_t*)(ws + A_PR), (const bf16_t*)(ws + A_LOUT), (const bf16_t*)(ws + A_VMIX), (const bf16_t*)(ws + A_VFIRST), (bf16_t*)(ws + (l ? A_VP : A_VFIRST)), (float*)(ws + A_RK), ws + A_CHK + (size_t)(q & 1) * RW_BUF,
                 LDP(11) + l * 1792, LDP(12) + l * 512, LDP(14) + l * 512, LDP(17) + l * 512, LDP(18) + l * 512, LDP(19) + l * 512, LDP(22), l, 0};
    const int ntask = (q == 0 ? RW_NSEQ : RW_NSEQ - 1) * 8, hs = q == 0 ? 0 : RW_SKIP, NS = nblk - ((nblk + 3) >> 2);
    const bool scanwg = rw_is_scan_wg(bid); const int rank = rw_rank(bid);
#define RW_TASK(i_) (scanwg ? hs * NS + (i_) * nblk + bid : ((i_) < hs ? (i_) * NS + rank : hs * NS + ((i_) - hs) * nblk + bid))
#define RW_ROW0(t_) (((t_) >> 3) == 128 ? RREAL : ((t_) >> 7) * SEQ + (16 * q + (((t_) >> 3) & 15)) * 64)
    const int tid_ = opq(threadIdx.x), lane_ = tid_ & 63, w_ = __builtin_amdgcn_readfirstlane(tid_ >> 6);
    int task = RW_TASK(0); if (task >= ntask) return;
    CpRaw raw; cp_issue(cp, RW_ROW0(task), task & 7, w_, lane_, raw);
#pragma unroll 1
    for (int i = 0; ; ++i) { const int nxt = RW_TASK(i + 1); const bool has_next = nxt < ntask;
        rwkv_cp_task(lds, cp, RW_ROW0(task), task & 7, cp.CHK + (size_t)task * CHK_BYTES, raw, has_next, has_next ? RW_ROW0(nxt) : 0, nxt & 7);
        if (!has_next) break;
        task = nxt; }
#undef RW_TASK
#undef RW_ROW0
}
__device__ __forceinline__ void f_rwkv_scan(unsigned long long kp_, LAS unsigned char* lds, int l, int q) {
    const unsigned long long kp = kp_uniform(kp_); l = __builtin_amdgcn_readfirstlane(l); q = __builtin_amdgcn_readfirstlane(q);
    const int bid = (int)blockIdx.x, nblk = (int)gridDim.x; if (!rw_is_scan_wg(bid)) return;
    unsigned char* ws = WSP; const ScP sp{ws + A_CHK + (size_t)(q & 1) * RW_BUF, (bf16_t*)(ws + A_YS)};
#pragma unroll 1
    for (int unit = bid >> 2; unit < 64; unit += (nblk + 3) >> 2) { const int b = unit >> 3, hd = unit & 7; float* stp = (float*)(ws + A_SCST) + (size_t)unit * 4096;
        rwkv_scan_unit(lds, sp, b * 16, 128, q == 0 ? 1 : 0, 16, b * SEQ + q * 1024, hd, q == 0 && b == 0, q == 0 ? nullptr : stp, q == 3 ? nullptr : stp); }
}
NOINL void f_rwkv_post(unsigned long long kp_, int l, int q, int mode) {
    const unsigned long long kp = kp_uniform(kp_); l = __builtin_amdgcn_readfirstlane(l); q = __builtin_amdgcn_readfirstlane(q); mode = __builtin_amdgcn_readfirstlane(mode); WAVE_IDS(); unsigned char* ws = WSP;
    const PostP pp{(const bf16_t*)(ws + A_YS), (const bf16_t*)(ws + (l ? A_VP : A_VFIRST)), (const float*)(ws + A_RK), (const bf16_t*)(ws + A_LOUT), (bf16_t*)(ws + A_PM), LDP(20) + l * 512, LDP(21) + l * 512};
    const bool scanwg = rw_is_scan_wg(bid); const int nscan = (nblk + 3) >> 2, NS = nblk - nscan;
    if (mode == 2) rwkv_post(pp, q, 0, 8192, q == 0, gw, ngw, lane);
    else if (mode == 1) { if (!scanwg) rwkv_post(pp, q, 0, 8192, q == 0, rw_rank(bid) * 8 + wave, NS * 8, lane); }
    else if (scanwg) rwkv_post(pp, q, 0, 4096, false, (bid >> 2) * 8 + wave, nscan * 8, lane);
    else rwkv_post(pp, q, 4096, 8192, q == 0, rw_rank(bid) * 8 + wave, NS * 8, lane); }
NOINL void f_ffn_meta(unsigned long long kp_) {
    const unsigned long long kp = kp_uniform(kp_); WAVE_IDS(); unsigned char* ws = WSP;
    const int job = bid * 8 + wave; if (job >= FF0 / 16) return;
    const int f0 = job * 16, l15 = lane & 15, kq = lane >> 4;
    const bf16_t* wg = (const bf16_t*)(ws + WS_FGU) + (size_t)((f0 >> 7) * 256 + (f0 & 127) + l15) * 1024 + 8 * kq;
    const bf16_t* wu = wg + (size_t)128 * 1024;
    const bf16_t* xu = (const bf16_t*)(ws + A_U) + (size_t)(RREAL + l15) * D + 8 * kq;
    f32x4 ag = {0.f, 0.f, 0.f, 0.f}, au = {0.f, 0.f, 0.f, 0.f};
#pragma unroll 8
    for (int ks = 0; ks < 32; ++ks) { const bf16x8 a = *(const GAS bf16x8*)(wg + 32 * ks), b = *(const GAS bf16x8*)(wu + 32 * ks), x = *(const GAS bf16x8*)(xu + 32 * ks);
        ag = __builtin_amdgcn_mfma_f32_16x16x32_bf16(a, x, ag, 0, 0, 0); au = __builtin_amdgcn_mfma_f32_16x16x32_bf16(b, x, au, 0, 0, 0); }
    float r[4];
#pragma unroll
    for (int j = 0; j < 4; ++j) { const float g = ag[j], up = au[j]; r[j] = g / (1.0f + __expf(-g)) * up; }
    u32x2 o; o.x = cvtpk(r[0], r[1]); o.y = cvtpk(r[2], r[3]);
    *(GAS u32x2*)((bf16_t*)(ws + A_ACT0) + (size_t)(RREAL + l15) * FF0 + f0 + 4 * kq) = o;
}
NOINL void f_moe_tr(unsigned long long kp_, LAS unsigned char* lds) {
    const unsigned long long kp = kp_uniform(kp_); WAVE_IDS(); LAS float* scr = (LAS float*)(lds + wave * 8448);
    if (bid == 0 && tid < 24) { unsigned* ctlw = (unsigned*)(WSP + WS_CTL); const float sc = moe_wscale_bits(ctlw[CW_WMAX + tid]); ctlw[CW_WINV + tid] = __float_as_uint(1.0f / (F8_ACT * sc)); }
#pragma unroll 1
    for (int e = 0; e < NEXP * PROBE_REP_MOETR; ++e) { const int ee = e % NEXP;
        const unsigned* ctl = (const unsigned*)(WSP + WS_CTL);
        { const TrJob8 J{LDP(30) + (size_t)ee * D * FFE, WSP + A_MGU, D, FFE, 1024, 2, ee * 2 * FFE, moe_wscale(ctl, 0, ee)}; ph_transpose_f8(J, scr, gw, ngw, lane); }
        { const TrJob8 J{LDP(31) + (size_t)ee * D * FFE, WSP + A_MGU, D, FFE, 1024, 3, ee * 2 * FFE, moe_wscale(ctl, 1, ee)}; ph_transpose_f8(J, scr, gw, ngw, lane); }
        { const TrJob8 J{LDP(32) + (size_t)ee * FFE * D, WSP + A_MDN, FFE, D, FFE, 0, ee * D, moe_wscale(ctl, 2, ee)}; ph_transpose_f8(J, scr, gw, ngw, lane); }
    }
}
__device__ __forceinline__ void f_moe_route(unsigned long long kp_, LAS unsigned char* lds) {
    const unsigned long long kp = kp_uniform(kp_); WAVE_IDS(); unsigned char* ws = WSP;
    ph_norm_route(lds, OUTP, LDP(3) + D, LDP(28), LDP(29), (bf16_t*)(ws + A_U), (int*)(ws + A_MTAB + MT_E), (float*)(ws + A_MTAB + MT_G), (int*)(ws + A_MTAB + MT_STOK), (unsigned*)(ws + WS_CTL), bid, nblk, wave, lane); }
NOINL void f_moe_gather8(unsigned long long kp_) { const unsigned long long kp = kp_uniform(kp_); WAVE_IDS(); unsigned char* ws = WSP;
    ph_moe_gather8(ws + A_U, (const int*)(ws + A_MTAB + MT_STOK), ws + A_XB, gw, ngw, lane); }
NOINL void f_moe_assign(unsigned long long kp_, LAS unsigned char* lds, int list) { const unsigned long long kp = kp_uniform(kp_); list = __builtin_amdgcn_readfirstlane(list); WAVE_IDS(); unsigned char* ws = WSP;
    ph_moe_assign(lds, list, (const int*)(ws + A_MTAB + MT_E), (const float*)(ws + A_MTAB + MT_G), (int*)(ws + A_MTAB + MT_STOK), (float*)(ws + A_MTAB + MT_SGATE), (int*)(ws + A_MTAB + MT_BE), (unsigned*)(ws + WS_CTL), bid, nblk, tid); }
NOINL void f_final(unsigned long long kp_) { const unsigned long long kp = kp_uniform(kp_); WAVE_IDS(); unsigned char* ws = WSP; ph_final(OUTP, LDP(4), (const int*)(ws + A_MTAB + MT_TSLOT), (const float*)(ws + WS_TB), gw, ngw, lane); }

__global__ void __launch_bounds__(512, 2) fwd(Params P) {
    extern __shared__ __attribute__((aligned(16))) unsigned char lds_raw[];
    LAS unsigned char* lds = (LAS unsigned char*)lds_raw;
    const int tid = threadIdx.x;
    const int bid = (int)blockIdx.x, nblk = (int)gridDim.x;
    const unsigned long long kp = (unsigned long long)__builtin_amdgcn_kernarg_segment_ptr();
    volatile LAS unsigned* misc = (volatile LAS unsigned*)(lds + LDS_MISC);
    if (tid < 64) misc[tid] = 0u;
    __syncthreads();
    XcdBarrier bar;
    { unsigned* ctl0 = (unsigned*)(WSP + WS_CTL); bar = xcd_barrier_post(ctl0 + CW_BAR, misc + 8); }
#ifdef PROBE_BAR2
#define GRID_BAR() do { xcd_barrier(bar); xcd_barrier(bar); } while (0)
#else
#define GRID_BAR() xcd_barrier(bar)
#endif
    for (int rep_ = 0; rep_ < PROBE_REP_MISC; ++rep_) f_p0(kp, lds);
    GRID_BAR();

#pragma unroll 1
    for (int l = 0; l < 2; ++l) {
        for (int rep_ = 0; rep_ < PROBE_REP_NORM; ++rep_) f_rmsnorm(kp, 0, l);
        GRID_BAR();
_Pragma("unroll 1") for (int rep_ = 0; rep_ < PROBE_REP_INPROJ; ++rep_) {
        { unsigned char* ws = WSP; pg8::Gemm g{(const bf16_t*)(ws + A_U), (const bf16_t*)(ws + WS_WB + l * LW_STRIDE + LW_WIN), RP, 2816, 1024, 1024, 1024, 0}; pg8::StaticOrder S; S.init(RP, 2816, opqs(nblk), opqs(bid));
          EpiInProj E{(bf16_t*)(ws + A_PM), (bf16_t*)(ws + A_PR)};
          pg8::gemm_phase<EpiInProj, pg8::StaticOrder, true, true>(lds, g, S, E); }
}
        GRID_BAR();
        for (int rep_ = 0; rep_ < PROBE_REP_PREP; ++rep_) f_prep(kp, l);
        GRID_BAR();
_Pragma("unroll 1") for (int rep_ = 0; rep_ < PROBE_REP_P4A; ++rep_) {
        { unsigned char* ws = WSP; pg8::Gemm g{(const bf16_t*)(ws + A_PM), (const bf16_t*)(ws + WS_WB + l * LW_STRIDE + LW_WUQ), RP, 768, 512, 1024, 512, 0}; pg8::StaticOrder S; S.init(RP, 768, opqs(nblk), opqs(bid));
          EpiRowScale E{(bf16_t*)(ws + A_U), (const float*)(ws + A_RSTDQ), 768, 0};
          pg8::gemm_phase<EpiRowScale, pg8::StaticOrder, true, true>(lds, g, S, E); }
        { unsigned char* ws = WSP; pg8::Gemm g{(const bf16_t*)(ws + A_PM) + 512, (const bf16_t*)(ws + WS_WB + l * LW_STRIDE + LW_WK), RP, 512, 256, 1024, 256, 0}; pg8::StaticOrder S; S.init(RP, 512, opqs(nblk), opqs((bid + nblk - 131) % nblk));
          EpiRowScale E{(bf16_t*)(ws + A_KN), (const float*)(ws + A_RSTDKV), 512, 0};
          pg8::gemm_phase<EpiRowScale, pg8::StaticOrder, true, true>(lds, g, S, E); }
        { unsigned char* ws = WSP; pg8::Gemm g{(const bf16_t*)(ws + WS_WB + l * LW_STRIDE + LW_WV), (const bf16_t*)(ws + A_PM) + 512, 512, RP, 256, 256, 1024, 0}; pg8::StaticOrder S; S.init(512, RP, opqs(nblk), opqs((bid + nblk - 133) % nblk));
          EpiColScale E{(bf16_t*)(ws + A_VT), (const float*)(ws + A_RSTDKV), RP, 0};
          pg8::gemm_phase<EpiColScale, pg8::StaticOrder, true, true>(lds, g, S, E); }
}
        GRID_BAR();
_Pragma("unroll 1") for (int rep_ = 0; rep_ < PROBE_REP_ATT; ++rep_) {
        { unsigned char* ws = WSP; attn_phase(lds, (const bf16_t*)(ws + A_U), (const bf16_t*)(ws + A_KN), (const bf16_t*)(ws + A_KROPE), (const bf16_t*)(ws + A_VT), (bf16_t*)(ws + A_PM), (const float*)(ws + WS_ROPE), opqs(bid), opqs(nblk)); }
}
        GRID_BAR();
_Pragma("unroll 1") for (int rep_ = 0; rep_ < PROBE_REP_P4B; ++rep_) {
        { unsigned char* ws = WSP; pg8::Gemm g{(const bf16_t*)(ws + A_LIN), (const bf16_t*)(ws + WS_WB + l * LW_STRIDE + LW_LORA), RP, 1536, 256, 256, 256, 0}; pg8::StaticOrder S; S.init(RP, 1536, opqs(nblk), opqs(bid));
          EpiRowScale E{(bf16_t*)(ws + A_LOUT), nullptr, 1536, 0};
          pg8::gemm_phase<EpiRowScale, pg8::StaticOrder, true, true>(lds, g, S, E); }
        if (l == 1) {
            unsigned char* ws = WSP; pg8::Gemm g{(const bf16_t*)(ws + A_VSH), (const bf16_t*)(ws + WS_V1T), RP, 512, 512, 512, 512, 0}; pg8::StaticOrder S; S.init(RP, 512, opqs(nblk), opqs((bid + nblk - 6) % nblk));
            EpiRowScale E{(bf16_t*)(ws + A_VMIX), nullptr, 512, 0};
            pg8::gemm_phase<EpiRowScale, pg8::StaticOrder, true, true>(lds, g, S, E);
        }
}
        GRID_BAR();
#pragma unroll 1
        for (int stp = 0; stp < 6; ++stp) {
            if (stp >= 1 && stp <= 4) { _Pragma("unroll 1") for (int rep_ = 0; rep_ < PROBE_REP_SCAN; ++rep_) f_rwkv_scan(kp, lds, l, stp - 1); }
            if (stp <= 3) { _Pragma("unroll 1") for (int rep_ = 0; rep_ < PROBE_REP_CP; ++rep_) f_rwkv_cp(kp, lds, l, stp); }
            if (stp >= 2) { for (int rep_ = 0; rep_ < PROBE_REP_MISC; ++rep_) f_rwkv_post(kp, l, stp - 2, stp <= 3 ? 0 : stp - 3); }
            GRID_BAR();
        }
_Pragma("unroll 1") for (int rep_ = 0; rep_ < PROBE_REP_OUTPROJ; ++rep_) {
        { unsigned char* ws = WSP; pg8::Gemm g{(const bf16_t*)(ws + A_PM), (const bf16_t*)(ws + WS_WB + l * LW_STRIDE + LW_WOUT), RREAL, 1024, 1024, 1024, 1024, 0}; pg8::StaticOrder S; S.init(RREAL, 1024, opqs(nblk), opqs(bid));
          EpiResid E{OUTP, (float*)(ws + WS_HMETA), (l == 0 && rep_ == 0) ? LDP(0) : (const float*)OUTP, rep_ == 0 ? 1.0f : 0.0f, 0};
          pg8::gemm_phase<EpiResid, pg8::StaticOrder, true, true>(lds, g, S, E); }
        if (rep_ == 0 && l == 0) {
          unsigned char* ws = WSP; pg8::Gemm g{(const bf16_t*)(ws + A_PM), (const bf16_t*)(ws + WS_WB + l * LW_STRIDE + LW_WOUT), RP, 1024, 256, 1024, 1024, 0};
          const DenseTailOrder S{4, 4, opqs(nblk), opqs(bid)}; EpiResidPartial E{(float*)(ws + A_PART)};
          pg8::gemm_phase<EpiResidPartial, DenseTailOrder, true, true>(lds, g, S, E); }
}
        GRID_BAR();
        if (l == 0) {
            for (int rep_ = 0; rep_ < PROBE_REP_MISC; ++rep_) f_rmsnorm(kp, 1, 0);
            GRID_BAR();
_Pragma("unroll 1") for (int rep_ = 0; rep_ < PROBE_REP_FFNGU; ++rep_) {
            f_ffn_meta(kp);
            { unsigned char* ws = WSP; pg8::Gemm g{(const bf16_t*)(ws + A_U), (const bf16_t*)(ws + WS_FGU), RREAL, 2 * FF0, 1024, 1024, 1024, 0}; pg8::StaticOrder S; S.init(RREAL, 2 * FF0, opqs(nblk), opqs(bid));
              EpiSwiGLU E{(bf16_t*)(ws + A_ACT0), FF0, 22, 0, 0};
              pg8::gemm_phase<EpiSwiGLU, pg8::StaticOrder, true, true>(lds, g, S, E); }
}
            GRID_BAR();
_Pragma("unroll 1") for (int rep_ = 0; rep_ < PROBE_REP_FFNDN; ++rep_) {
            { unsigned char* ws = WSP; pg8::Gemm g{(const bf16_t*)(ws + A_ACT0), (const bf16_t*)(ws + WS_FDN), RREAL, 1024, FF0, FF0, FF0, 0}; pg8::StaticOrder S; S.init(RREAL, 1024, opqs(nblk), opqs(bid));
              EpiResid E{OUTP, (float*)(ws + WS_HMETA), (const float*)OUTP, rep_ == 0 ? 1.0f : 0.0f, 0};
              pg8::gemm_phase<EpiResid, pg8::StaticOrder, true, true>(lds, g, S, E); }
            if (rep_ == 0) {
              unsigned char* ws = WSP; pg8::Gemm g{(const bf16_t*)(ws + A_ACT0), (const bf16_t*)(ws + WS_FDN), RP, 1024, 256, FF0, FF0, 0};
              const DenseTailOrder S{4, 11, opqs(nblk), opqs(bid)}; EpiResidPartial E{(float*)(ws + A_PART)};
              pg8::gemm_phase<EpiResidPartial, DenseTailOrder, true, true>(lds, g, S, E); }
}
            GRID_BAR();
        } else {
            f_moe_tr(kp, lds);
            f_moe_route(kp, lds);
            GRID_BAR();
            f_moe_assign(kp, lds, 0);
            f_moe_assign(kp, lds, 1);
            GRID_BAR();
            f_moe_gather8(kp);
            GRID_BAR();
#pragma unroll 1
            for (int list = 0; list < 2; ++list) {
                const int np0 = __builtin_amdgcn_readfirstlane((int)((const unsigned*)(WSP + WS_CTL))[CW_NPAN]), np1 = __builtin_amdgcn_readfirstlane((int)((const unsigned*)(WSP + WS_CTL))[CW_NPAN + 1]);
                const int T0 = np0 > MOE_TAILPAN ? (np0 - MOE_TAILPAN) * 4 : 0, T1 = np1 > MOE_TAILPAN ? (np1 - MOE_TAILPAN) * 4 : 0;
                if (list == 1) {
                    { unsigned char* ws = WSP; pg8::Gemm g{(const bf16_t*)(ws + A_MACT), (const bf16_t*)(ws + A_MDN), 0, 0, FFE / 2, FFE / 2, FFE / 2, 0};
                      const MoeShiftTailOrder S{(const int*)(ws + A_MTAB + MT_BE), (const unsigned*)(ws + WS_CTL) + CW_NPAN, 4, 4, 0, opqs(nblk) - 1, opqs(bid), 0};
                      EpiMoeDown E{OUTP, (const int*)(ws + A_MTAB + MT_STOK), (const float*)(ws + A_MTAB + MT_SGATE), 4, 1.0f, (const unsigned*)(ws + WS_CTL)};
                      pg8::gemm_phase<EpiMoeDown, MoeShiftTailOrder, true, true, true>(lds, g, S, E); }
                    { unsigned char* ws = WSP; pg8::Gemm g{(const bf16_t*)(ws + A_MACT), (const bf16_t*)(ws + A_MDN), 0, 0, FFE / 2, FFE / 2, FFE / 2, 0};
                      const MoeShiftTailOrder S{(const int*)(ws + A_MTAB + MT_BE) + 256, (const unsigned*)(ws + WS_CTL) + CW_NPAN + 1, 4, 4, MOE_GAP, opqs(nblk) - 1 - T0, opqs(bid), 0};
                      EpiMoeDownStore E{(float*)(ws + WS_TB), (const int*)(ws + A_MTAB + MT_STOK) + MOE_MAXPAN * 256, (const float*)(ws + A_MTAB + MT_SGATE) + MOE_MAXPAN * 256, 4, MOE_TAILPAN + MOE_GAP, (const unsigned*)(ws + WS_CTL)};
                      pg8::gemm_phase<EpiMoeDownStore, MoeShiftTailOrder, true, true, true>(lds, g, S, E); }
                }
_Pragma("unroll 1") for (int rep_ = 0; rep_ < PROBE_REP_MOEGU; ++rep_) {
                { unsigned char* ws = WSP; pg8::Gemm g{(const bf16_t*)(ws + A_XB + (size_t)list * XB_LIST), (const bf16_t*)(ws + A_MGU), 0, 0, 512, 512, 512, 0};
                  const int Tt = list == 1 && T0 + T1 < opqs(nblk) ? T0 + T1 : 0;
                  const MoeSlotOrder S{(const int*)(ws + A_MTAB + MT_BE) + 256 * list, (const unsigned*)(ws + WS_CTL) + CW_NPAN + list, (const int*)(ws + A_MTAB + MT_STOK) + list * MOE_MAXPAN * 256, 28, 28, 0, opqs(nblk), opqs(bid), RREAL,
                                         0, list == 0 ? MOE_MAXPAN : MOE_TAILPAN, 0, 0, Tt, MOE_CSKIP};
                  EpiSwiGLU8 E{ws + A_MACT, (const unsigned*)(ws + WS_CTL), FFE, 28};
                  pg8::gemm_phase<EpiSwiGLU8, MoeSlotOrder, true, true, true>(lds, g, S, E); }
                if (list == 0) {
                  unsigned char* ws = WSP; pg8::Gemm g{(const bf16_t*)(ws + A_XB + XB_LIST), (const bf16_t*)(ws + A_MGU), 0, 0, 512, 512, 512, 0};
                  const int nb = opqs(nblk);
                  const MoeSlotOrder S{(const int*)(ws + A_MTAB + MT_BE) + 256, (const unsigned*)(ws + WS_CTL) + CW_NPAN + 1, (const int*)(ws + A_MTAB + MT_STOK) + MOE_MAXPAN * 256, 28, 28, 0, nb, opqs(bid), RREAL,
                                         MOE_TAILPAN, MOE_MAXPAN, MOE_GAP, (np0 * 28) % nb, 0, 0};
                  EpiSwiGLU8 E{ws + A_MACT, (const unsigned*)(ws + WS_CTL), FFE, 28};
                  pg8::gemm_phase<EpiSwiGLU8, MoeSlotOrder, true, true, true>(lds, g, S, E); }
}
                GRID_BAR();
_Pragma("unroll 1") for (int rep_ = 0; rep_ < PROBE_REP_MOEDN; ++rep_) {
                { unsigned char* ws = WSP; pg8::Gemm g{(const bf16_t*)(ws + A_MACT), (const bf16_t*)(ws + A_MDN), 0, 0, FFE / 2, FFE / 2, FFE / 2, 0};
                  const MoeOrder S{(const int*)(ws + A_MTAB + MT_BE) + 256 * list, (const unsigned*)(ws + WS_CTL) + CW_NPAN + list, 4, 4, 0, opqs(nblk), opqs(bid), MOE_TAILPAN * 4};
                  EpiMoeDown E{OUTP, (const int*)(ws + A_MTAB + MT_STOK) + list * MOE_MAXPAN * 256, (const float*)(ws + A_MTAB + MT_SGATE) + list * MOE_MAXPAN * 256, 4, rep_ == 0 ? 1.0f : 0.0f, (const unsigned*)(ws + WS_CTL)};
                  pg8::gemm_phase<EpiMoeDown, MoeOrder, true, true, true>(lds, g, S, E); }
}
                GRID_BAR();
            }
        }
    }
    f_final(kp);
}

extern "C" void kernel_launch(void* const* d_in, const int* in_sizes, int n_in, void* d_out, int out_size, void* d_ws, size_t ws_size, hipStream_t stream) {
    static int grid = 0;
    if (grid == 0) {
        if (n_in != 33 || ws_size < WS_NEED || out_size != RREAL * D) { fprintf(stderr, "kernel_launch: unexpected arguments (n_in %d, ws %zu need %zu, out %d)\n", n_in, ws_size, (size_t)WS_NEED, out_size); grid = -1; return; }
        int dev = 0, cus = 0;
        if (hipGetDevice(&dev) != hipSuccess || hipDeviceGetAttribute(&cus, hipDeviceAttributeMultiprocessorCount, dev) != hipSuccess) { grid = -1; return; }
        if (hipFuncSetAttribute((const void*)fwd, hipFuncAttributeMaxDynamicSharedMemorySize, LDS_BYTES) != hipSuccess) { fprintf(stderr, "kernel_launch: hipFuncSetAttribute failed\n"); grid = -1; return; }
        int per_cu = 0; (void)hipOccupancyMaxActiveBlocksPerMultiprocessor(&per_cu, (const void*)fwd, 512, LDS_BYTES); (void)hipGetLastError();
        grid = cus;
    }
    if (grid < 0) return;
    unsigned char* ws = (unsigned char*)d_ws;
    (void)hipMemsetAsync(ws + WS_CTL, 0, 1 * MiB, stream);
    (void)hipMemsetAsync(ws + WS_WB, 0, WS_ROPE - WS_WB, stream);
    Params p{};
    for (int i = 0; i < 33; ++i) p.in[i] = (const float*)d_in[i];
    p.out = (float*)d_out; p.ws = ws;
    hipLaunchKernelGGL(fwd, dim3(grid), dim3(512), LDS_BYTES, stream, p);
}
```

```cpp
#include <hip/hip_runtime.h>
#include <cstdio>
#include <cstdint>
namespace pg8 {
#define PG8_LAS __attribute__((address_space(3)))
typedef unsigned short bf16_t;
typedef short bf16x8 __attribute__((ext_vector_type(8)));
typedef float f32x4 __attribute__((ext_vector_type(4)));
typedef unsigned u32x4 __attribute__((ext_vector_type(4)));
constexpr int BM = 256, BK = 64, HALF = 128, HTB = HALF * BK * 2  , STAGE_BYTES = 8 * HTB, NXCD = 8, WGM = 8;

__host__ __device__ __forceinline__ int lds_byte(int r, int c) { const int st = (r >> 4) * 2 + (c >> 5), rr = r & 15, cc = c & 31, ob = rr * 64 + cc * 2; return st * 1024 + (ob ^ (((ob >> 9) & 1) << 5)); }
__host__ __device__ __forceinline__ void stage_rc(int b, int& R, int& C) { const int st = b / 1024, sb = b % 1024, swz = sb ^ (((sb >> 9) & 1) << 5); R = (st >> 1) * 16 + swz / 64; C = (st & 1) * 32 + (swz % 64) / 2; }
__host__ __device__ __forceinline__ int perm32(int rho) { const int n = rho >> 4, i = rho & 15; return 8 * (i >> 2) + 4 * n + (i & 3); }

struct Unit { int pm, pn, k0; };
struct Gemm { const bf16_t* A; const bf16_t* Bt; int M, N, K, lda, ldb, pad; };

struct StaticOrder {
    static constexpr bool GATHER = false;
    int nM, nN, nwg, G, c;
    __host__ __device__ void init(int M, int N, int G_, int c_) { nM = M / BM; nN = N / BM; nwg = nM * nN; G = G_; c = c_; }
    __host__ __device__ bool next(int i, Unit& u) const {
        const long L = (long)i * G + c; if (L >= nwg) return false;
        int wgid = (int)L; { const int q = nwg / NXCD, r = nwg % NXCD, xcd = wgid % NXCD, off = wgid / NXCD; wgid = (xcd < r ? xcd * (q + 1) : r * (q + 1) + (xcd - r) * q) + off; }
        const int nig = WGM * nN, gid = wgid / nig, fm = gid * WGM, gsz = (nM - fm) < WGM ? (nM - fm) : WGM;
        u.pm = fm + ((wgid % nig) % gsz); u.pn = (wgid % nig) / gsz; u.k0 = 0; return true;
    }
    __device__ __forceinline__ void a_ready(const Unit&) const {}
    __device__ __forceinline__ void done(const Unit&) const {}
};

__device__ __forceinline__ unsigned cvt_pk_bf16(float lo, float hi) { unsigned r; asm volatile("v_cvt_pk_bf16_f32 %0, %1, %2" : "=v"(r) : "v"(lo), "v"(hi)); return r; }
typedef int i32x4_ __attribute__((ext_vector_type(4)));
typedef int i32x8_ __attribute__((ext_vector_type(8)));
template <class Epi, class Sched, bool ALIGN_EPI = false, bool SP2 = false, bool FP8 = false>
__device__ __forceinline__ void gemm_phase(PG8_LAS unsigned char* lds, const Gemm g, const Sched& S, const Epi& E) {
    int tid_ = threadIdx.x; asm volatile("" : "+v"(tid_)); const int tid = tid_, wid = __builtin_amdgcn_readfirstlane(tid >> 6), lane = tid & 63, wr = wid >> 2, wc = wid & 3, fr = lane & 15, fq = lane >> 4;
    const int K = g.K, nt = K / BK;
    unsigned voffA[2], voffB[2];
#pragma unroll
    for (int i = 0; i < 2; ++i) { int R, C; stage_rc(tid * 16 + i * 8192, R, C); const int Rb = Epi::PERM ? ((R & ~31) + perm32(R & 31)) : R;
        voffA[i] = (unsigned)(R * g.lda + C) * 2u; voffB[i] = (unsigned)(Rb * g.ldb + C) * 2u; }
    constexpr bool GATHER = Sched::GATHER;
    unsigned vAc[2][2] = {{0u, 0u}, {0u, 0u}}, vAn[2][2] = {{0u, 0u}, {0u, 0u}}, cbA[2] = {0u, 0u};
    if constexpr (GATHER) {
#pragma unroll
        for (int i = 0; i < 2; ++i) { int R, C; stage_rc(tid * 16 + i * 8192, R, C); cbA[i] = (unsigned)C * 2u; }
    }
#define PG8_IDX_DMA(un, slot) do { if constexpr (GATHER) { const int* rp_ = S.rows + (size_t)(un).pm * 256 + 128 * (lane >> 5) + 64 * ((lane >> 4) & 1) + 16 * (wid >> 1) + (lane & 15); \
        __builtin_amdgcn_global_load_lds((const unsigned*)rp_, (PG8_LAS unsigned*)(lds + STAGE_BYTES + wid * 512 + (slot) * 256), 4, 0, 0); } } while (0)
#define PG8_IDX_READ(dst, slot) do { if constexpr (GATHER) { int t3_ = threadIdx.x; asm volatile("" : "+v"(t3_));     \
        _Pragma("unroll") for (int h_ = 0; h_ < 2; ++h_) _Pragma("unroll") for (int i_ = 0; i_ < 2; ++i_) { int R_, C_; stage_rc(t3_ * 16 + i_ * 8192, R_, C_); \
        int tk_ = *(const PG8_LAS int*)(lds + STAGE_BYTES + (t3_ >> 6) * 512 + (slot) * 256 + 4 * (32 * h_ + 16 * i_ + ((t3_ & 63) >> 2))); tk_ = tk_ < 0 ? S.zero_row : tk_; \
        dst[h_][i_] = (unsigned)tk_ * (unsigned)(g.lda * 2) + (unsigned)C_ * 2u; } } } while (0)
#define PG8_STAGE_A(bufoff, base, h, nx) do { if constexpr (GATHER) { const unsigned vs_[2] = {(nx) ? vAn[h][0] : vAc[h][0], (nx) ? vAn[h][1] : vAc[h][1]}; PG8_STAGE(bufoff, base, vs_); } \
        else { PG8_STAGE(bufoff, (base) + (h) * hstepA, voffA); } } while (0)
    const size_t kstep = (size_t)(BK * 2);
    const size_t hstepA = (size_t)HALF * g.lda * 2, hstepB = (size_t)HALF * g.ldb * 2;
    const size_t tstepA = 2 * hstepA, tstepB = 2 * hstepB;
    const unsigned ldsw = (unsigned)wid * 1024u;
    const int aoff = lds_byte(wr * 64 + fr, fq * 8), boff = lds_byte(wc * 32 + fr, fq * 8);
#define PG8_SA(b, h) (((b) * 2 + (h)) * HTB)
#define PG8_SB(b, h) ((4 + (b) * 2 + (h)) * HTB)
#define PG8_STAGE(bufoff, gbase, voff) do { const char* gb_ = (const char*)(gbase); asm volatile("" : "+s"(gb_));   \
        _Pragma("unroll") for (int _i = 0; _i < 2; ++_i) \
        __builtin_amdgcn_global_load_lds((const unsigned*)(gb_ + (voff)[_i]), (PG8_LAS unsigned*)(lds + (bufoff) + ldsw + _i * 8192), 16, 0, 0); } while (0)
#define PG8_LDA(dst, b, h) do { _Pragma("unroll") for (int m = 0; m < 4; ++m) _Pragma("unroll") for (int k = 0; k < 2; ++k) dst[m][k] = *(const PG8_LAS bf16x8*)(lds + PG8_SA(b, h) + aoff + m * 2048 + k * 1024); } while (0)
#define PG8_LDB(dst, b, h) do { _Pragma("unroll") for (int n = 0; n < 2; ++n) _Pragma("unroll") for (int k = 0; k < 2; ++k) dst[n][k] = *(const PG8_LAS bf16x8*)(lds + PG8_SB(b, h) + boff + n * 2048 + k * 1024); } while (0)
#define PG8_MMA(ai, bj, At, Bt) do { __builtin_amdgcn_s_setprio(1); _Pragma("unroll") for (int m = 0; m < 4; ++m) _Pragma("unroll") for (int n = 0; n < 2; ++n) { \
        if constexpr (FP8) { const i32x8_ b8_ = __builtin_shufflevector(__builtin_bit_cast(i32x4_, Bt[n][0]), __builtin_bit_cast(i32x4_, Bt[n][1]), 0, 1, 2, 3, 4, 5, 6, 7); \
            const i32x8_ a8_ = __builtin_shufflevector(__builtin_bit_cast(i32x4_, At[m][0]), __builtin_bit_cast(i32x4_, At[m][1]), 0, 1, 2, 3, 4, 5, 6, 7); \
            acc[ai][bj][m][n] = __builtin_amdgcn_mfma_scale_f32_16x16x128_f8f6f4(b8_, a8_, acc[ai][bj][m][n], 0, 0, 0, 0, 0, 0); }     \
        else { _Pragma("unroll") for (int k = 0; k < 2; ++k) acc[ai][bj][m][n] = __builtin_amdgcn_mfma_f32_16x16x32_bf16(Bt[n][k], At[m][k], acc[ai][bj][m][n], 0, 0, 0); } } \
        __builtin_amdgcn_s_setprio(0); } while (0)
#define PG8_WAIT_V(n) asm volatile("s_waitcnt vmcnt(" #n ")" ::: "memory")
#define PG8_WAIT_L(n) asm volatile("s_waitcnt lgkmcnt(" #n ")" ::: "memory")
#define PG8_BAR __builtin_amdgcn_s_barrier()
#define PG8_SCHED __builtin_amdgcn_sched_barrier(0)
    Unit cur, nxt; int ui = 0;
    if (!S.next(0, cur)) return;
    float zf_ = 0.f; asm volatile("" : "+v"(zf_));
    f32x4 acc[2][2][4][2];
#pragma unroll
    for (int a = 0; a < 2; ++a)
#pragma unroll
        for (int b = 0; b < 2; ++b)
#pragma unroll
            for (int m = 0; m < 4; ++m)
#pragma unroll
                for (int n = 0; n < 2; ++n) acc[a][b][m][n] = (f32x4){zf_, zf_, zf_, zf_};
    bf16x8 At[4][2], B0[2][2], B1[2][2];
    const char* cA = (const char*)g.A + (GATHER ? (size_t)0 : (size_t)cur.pm * tstepA) + (size_t)cur.k0 * 2; const char* cB = (const char*)g.Bt + (size_t)cur.pn * tstepB + (size_t)cur.k0 * 2;
    S.a_ready(cur);
    if constexpr (GATHER) { PG8_IDX_DMA(cur, 0); asm volatile("s_waitcnt vmcnt(0)" ::: "memory"); PG8_IDX_READ(vAc, 0); }
    if constexpr (SP2) {
        PG8_STAGE(PG8_SB(0, 0), cB, voffB); PG8_STAGE(PG8_SB(0, 1), cB + hstepB, voffB); PG8_STAGE_A(PG8_SA(0, 0), cA, 0, false); PG8_STAGE_A(PG8_SA(0, 1), cA, 1, false);
        if (wr == 1) PG8_BAR;
        PG8_WAIT_V(2); PG8_BAR;
        PG8_STAGE(PG8_SB(1, 0), cB + kstep, voffB); PG8_STAGE_A(PG8_SA(1, 0), cA + kstep, 0, false); PG8_STAGE(PG8_SB(1, 1), cB + hstepB + kstep, voffB);
        PG8_WAIT_V(6); PG8_BAR;
    } else {
        PG8_STAGE(PG8_SB(0, 0), cB, voffB); PG8_STAGE(PG8_SA(0, 0), cA, voffA); PG8_STAGE(PG8_SB(0, 1), cB + hstepB, voffB); PG8_STAGE(PG8_SA(0, 1), cA + hstepA, voffA);
        if (wr == 1) PG8_BAR;
        PG8_WAIT_V(4); PG8_BAR;
        PG8_STAGE(PG8_SB(1, 0), cB + kstep, voffB); PG8_STAGE(PG8_SA(1, 0), cA + kstep, voffA); PG8_STAGE(PG8_SB(1, 1), cB + hstepB + kstep, voffB);
        PG8_WAIT_V(6); PG8_BAR;
    }
    for (;;) {
        const bool has_next = S.next(ui + 1, nxt);
        const char* nA = has_next ? (const char*)g.A + (GATHER ? (size_t)0 : (size_t)nxt.pm * tstepA) + (size_t)nxt.k0 * 2 : cA; const char* nB = has_next ? (const char*)g.Bt + (size_t)nxt.pn * tstepB + (size_t)nxt.k0 * 2 : cB;
        if constexpr (GATHER) { if (has_next) PG8_IDX_DMA(nxt, (ui + 1) & 1); }
        for (int t = 0; t < nt; t += 2) {
            const bool last = (t == nt - 2); const bool lnx = last && has_next;
            const char* a1 = cA + (size_t)(t + 1) * kstep;
            const char* a2 = last ? nA : cA + (size_t)(t + 2) * kstep; const char* b2 = last ? nB : cB + (size_t)(t + 2) * kstep;
            const char* a3 = a2 + kstep; const char* b3 = b2 + kstep;
            if (last && has_next) S.a_ready(nxt);
            if constexpr (GATHER) { if (lnx) PG8_IDX_READ(vAn, (ui + 1) & 1); }
            if constexpr (SP2) {
            PG8_LDB(B0, 0, 0); PG8_LDB(B1, 0, 1); PG8_SCHED; PG8_LDA(At, 0, 0); PG8_STAGE_A(PG8_SA(1, 1), a1, 1, false);
            PG8_WAIT_V(8); PG8_WAIT_L(0); PG8_BAR; PG8_MMA(0, 0, At, B0); PG8_MMA(0, 1, At, B1); PG8_BAR; PG8_SCHED;
            PG8_LDA(At, 0, 1); PG8_STAGE(PG8_SB(0, 0), b2, voffB); PG8_STAGE(PG8_SB(0, 1), b2 + hstepB, voffB); PG8_STAGE_A(PG8_SA(0, 0), a2, 0, lnx);
            PG8_WAIT_V(8); PG8_WAIT_L(0); PG8_BAR; PG8_MMA(1, 0, At, B0); PG8_MMA(1, 1, At, B1); PG8_BAR; PG8_SCHED;
            PG8_LDB(B0, 1, 0); PG8_LDB(B1, 1, 1); PG8_SCHED; PG8_LDA(At, 1, 0); PG8_STAGE_A(PG8_SA(0, 1), a2, 1, lnx);
            PG8_WAIT_V(8); PG8_WAIT_L(0); PG8_BAR; PG8_MMA(0, 0, At, B0); PG8_MMA(0, 1, At, B1); PG8_BAR; PG8_SCHED;
            PG8_LDA(At, 1, 1); PG8_STAGE(PG8_SB(1, 0), b3, voffB); PG8_STAGE(PG8_SB(1, 1), b3 + hstepB, voffB); PG8_STAGE_A(PG8_SA(1, 0), a3, 0, lnx);
            PG8_WAIT_V(8); PG8_WAIT_L(0); PG8_BAR; PG8_MMA(1, 0, At, B0); PG8_MMA(1, 1, At, B1); PG8_BAR; PG8_SCHED;
            } else {
            PG8_LDB(B0, 0, 0); PG8_SCHED; PG8_LDA(At, 0, 0); PG8_STAGE(PG8_SA(1, 1), a1 + hstepA, voffA);
            PG8_WAIT_L(8); PG8_BAR; PG8_WAIT_L(0); PG8_MMA(0, 0, At, B0); PG8_BAR; PG8_SCHED;
            PG8_LDB(B1, 0, 1); PG8_STAGE(PG8_SB(0, 0), b2, voffB);
            PG8_BAR; PG8_WAIT_L(0); PG8_MMA(0, 1, At, B1); PG8_BAR;
            PG8_LDA(At, 0, 1); PG8_STAGE(PG8_SA(0, 0), a2, voffA);
            PG8_BAR; PG8_WAIT_L(0); PG8_MMA(1, 0, At, B0); PG8_BAR; PG8_SCHED;
            PG8_STAGE(PG8_SB(0, 1), b2 + hstepB, voffB);
            PG8_WAIT_V(6); PG8_BAR; PG8_MMA(1, 1, At, B1); PG8_BAR;
            PG8_LDB(B0, 1, 0); PG8_SCHED; PG8_LDA(At, 1, 0); PG8_STAGE(PG8_SA(0, 1), a2 + hstepA, voffA);
            PG8_WAIT_L(8); PG8_BAR; PG8_WAIT_L(0); PG8_MMA(0, 0, At, B0); PG8_BAR; PG8_SCHED;
            PG8_LDB(B1, 1, 1); PG8_STAGE(PG8_SB(1, 0), b3, voffB);
            PG8_BAR; PG8_WAIT_L(0); PG8_MMA(0, 1, At, B1); PG8_BAR;
            PG8_LDA(At, 1, 1); PG8_STAGE(PG8_SA(1, 0), a3, voffA);
            PG8_BAR; PG8_WAIT_L(0); PG8_MMA(1, 0, At, B0); PG8_BAR; PG8_SCHED;
            PG8_STAGE(PG8_SB(1, 1), b3 + hstepB, voffB);
            PG8_WAIT_V(6); PG8_BAR; PG8_MMA(1, 1, At, B1); PG8_BAR;
            }
        }
        if constexpr (ALIGN_EPI) { if (wr == 0) PG8_BAR; }
        if constexpr (!Epi::AFTER_DRAIN) { int t2_ = threadIdx.x; asm volatile("" : "+v"(t2_)); const int fr2_ = t2_ & 15, fq2_ = (t2_ >> 4) & 3;
            E(acc, cur, wr, wc, fr2_, fq2_); S.done(cur); }
        if (!has_next) break;
#pragma unroll
        for (int a = 0; a < 2; ++a)
#pragma unroll
            for (int b = 0; b < 2; ++b)
#pragma unroll
                for (int m = 0; m < 4; ++m)
#pragma unroll
                    for (int n = 0; n < 2; ++n) acc[a][b][m][n] = (f32x4){zf_, zf_, zf_, zf_};
        cur = nxt; cA = nA; cB = nB; ++ui;
        if constexpr (GATHER) { vAc[0][0] = vAn[0][0]; vAc[0][1] = vAn[0][1]; vAc[1][0] = vAn[1][0]; vAc[1][1] = vAn[1][1]; }
        if constexpr (ALIGN_EPI) { if (wr == 1) PG8_BAR; }
    }
    PG8_WAIT_V(0);
    if constexpr (!ALIGN_EPI) { if (wr == 0) PG8_BAR; }
    PG8_BAR;
    if constexpr (Epi::AFTER_DRAIN) { E.fused(acc, cur, wr, wc, fr, fq, lds, wid, lane); S.done(cur); }
#undef PG8_SA
#undef PG8_SB
#undef PG8_STAGE
#undef PG8_STAGE_A
#undef PG8_IDX_DMA
#undef PG8_IDX_READ
#undef PG8_LDA
#undef PG8_LDB
#undef PG8_MMA
#undef PG8_WAIT_V
#undef PG8_WAIT_L
#undef PG8_BAR
#undef PG8_SCHED
}
}

typedef unsigned short bf16_t;
typedef short bf16x8 __attribute__((ext_vector_type(8)));
typedef short s16x4 __attribute__((ext_vector_type(4)));
typedef float f32x4 __attribute__((ext_vector_type(4)));
typedef float f32x16 __attribute__((ext_vector_type(16)));
typedef unsigned u32x4 __attribute__((ext_vector_type(4)));
typedef unsigned u32x2 __attribute__((ext_vector_type(2)));
#define LAS __attribute__((address_space(3)))
#define GAS __attribute__((address_space(1)))

constexpr int D = 1024, NB = 8, SEQ = 4096, NMETA = 16;
constexpr int RREAL = NB * SEQ;
constexpr int RVALID = RREAL + NMETA;
constexpr int NPAN = 129, RP = NPAN * 256;
constexpr int PMW = 1024, PRW = 1792;
constexpr int CW = 512;
constexpr int FF0 = 2816, FFE = 3584, NEXP = 8;
constexpr float RMS_EPS = 1e-6f, GN_EPS = 64e-5f;
constexpr int MOE_MAXPAN = 144;
constexpr int MOE_TAILPAN = 128, MOE_GAP = 8;
#ifndef MOE_CSKIP
#define MOE_CSKIP 5
#endif

typedef float f32x2_t __attribute__((ext_vector_type(2))); typedef __bf16 bf16x2_t __attribute__((ext_vector_type(2)));
__device__ __forceinline__ unsigned cvtpk(float lo, float hi) { f32x2_t v = {lo, hi}; bf16x2_t b = __builtin_convertvector(v, bf16x2_t); return __builtin_bit_cast(unsigned, b); }
__device__ __forceinline__ bf16_t f2bf_hw(float x) { return (bf16_t)(cvtpk(x, x) & 0xffffu); }
__device__ __forceinline__ float bf2f(bf16_t b) { return __uint_as_float(((unsigned)b) << 16); }
__device__ __forceinline__ bf16_t f2bf(float f) { unsigned u = __float_as_uint(f); u += 0x7fffu + ((u >> 16) & 1u); return (bf16_t)(u >> 16); }
__device__ __forceinline__ unsigned pk2(float lo, float hi) { return (unsigned)f2bf(lo) | ((unsigned)f2bf(hi) << 16); }
#define DPP_F(v_, ctrl_, rmask_) __int_as_float(__builtin_amdgcn_update_dpp(0, __float_as_int(v_), (ctrl_), (rmask_), 0xf, false))
__device__ __forceinline__ float wave_sum(float v) {
    v += DPP_F(v, 0xB1, 0xf); v += DPP_F(v, 0x4E, 0xf); v += DPP_F(v, 0x141, 0xf); v += DPP_F(v, 0x140, 0xf);
    v += DPP_F(v, 0x142, 0xa); v += DPP_F(v, 0x143, 0xc);
    return __int_as_float(__builtin_amdgcn_readlane(__float_as_int(v), 63));
}
__device__ __forceinline__ float wave_max(float v) {
    v = fmaxf(v, DPP_F(v, 0xB1, 0xf)); v = fmaxf(v, DPP_F(v, 0x4E, 0xf)); v = fmaxf(v, DPP_F(v, 0x141, 0xf)); v = fmaxf(v, DPP_F(v, 0x140, 0xf));
    v = fmaxf(v, DPP_F(v, 0x142, 0xa)); v = fmaxf(v, DPP_F(v, 0x143, 0xc));
    return __int_as_float(__builtin_amdgcn_readlane(__float_as_int(v), 63));
}
constexpr float F8_MAX = 448.0f, F8_ACT = 8.0f;
__device__ __forceinline__ unsigned pk4_f8(float a, float b, float c, float d) {
    float mx = F8_MAX; asm volatile("" : "+v"(mx));
    a = __builtin_amdgcn_fmed3f(a, -mx, mx); b = __builtin_amdgcn_fmed3f(b, -mx, mx); c = __builtin_amdgcn_fmed3f(c, -mx, mx); d = __builtin_amdgcn_fmed3f(d, -mx, mx);
    int r = __builtin_amdgcn_cvt_pk_fp8_f32(a, b, 0, false); r = __builtin_amdgcn_cvt_pk_fp8_f32(c, d, r, true); return (unsigned)r; }
__device__ __forceinline__ float moe_wscale(const unsigned* ctl, int t, int e);
__device__ __forceinline__ float quad_sum(float v) { v += DPP_F(v, 0xB1, 0xf); v += DPP_F(v, 0x4E, 0xf); return v; }
__device__ __forceinline__ float sigmoidf_(float x) { return 1.0f / (1.0f + __expf(-x)); }
__device__ __forceinline__ int row_pos(int row) { return row < RREAL ? NMETA + (row & (SEQ - 1)) : row - RREAL; }
__device__ __forceinline__ int row_prev(int row) { if (row < RREAL) return (row & (SEQ - 1)) ? row - 1 : RVALID - 1; return row == RREAL ? -1 : row - 1; }

constexpr size_t MiB = 1u << 20;
constexpr size_t WS_CTL = 0;
constexpr size_t WS_HMETA = 1 * MiB;
constexpr size_t WS_WB = 2 * MiB;
constexpr size_t LW_STRIDE = 10 * MiB;
constexpr size_t LW_WIN = 0, LW_WUQ = LW_WIN + (size_t)2816 * 1024 * 2, LW_WK = LW_WUQ + (size_t)768 * 512 * 2, LW_WV = LW_WK + (size_t)512 * 256 * 2,
                 LW_LORA = LW_WV + (size_t)512 * 256 * 2, LW_WOUT = LW_LORA + (size_t)1536 * 256 * 2, LW_END = LW_WOUT + (size_t)1024 * 1024 * 2;
static_assert(LW_END <= LW_STRIDE, "layer weights");
constexpr size_t WS_V1T = WS_WB + 2 * LW_STRIDE, WS_V2T = WS_V1T + (size_t)256 * 512 * 2, WS_FGU = WS_V2T + (size_t)512 * 256 * 2,
                 WS_FDN = WS_FGU + (size_t)5632 * 1024 * 2, WS_ROPE = WS_FDN + (size_t)1024 * 2816 * 2, WS_WB_END = WS_ROPE + (size_t)4112 * 64 * 4;
constexpr size_t WS_TB = WS_FGU;
constexpr size_t WS_ARENA = 41 * MiB;
static_assert(WS_WB_END <= WS_ARENA, "weights fit");
static_assert((size_t)8 * 256 * 1024 * 4 <= (size_t)5632 * 1024 * 2, "list-1 tail buffer fits the dense gate/up weight slot");
constexpr size_t SZ_R1024 = (size_t)RP * 1024 * 2, SZ_R512 = (size_t)RP * 512 * 2, SZ_R256 = (size_t)RP * 256 * 2;
constexpr size_t A_U = WS_ARENA;
constexpr size_t A_KN = A_U + SZ_R1024;
constexpr size_t A_VT = A_KN + SZ_R512;
constexpr size_t A_LOUT = A_U, A_VMIX = A_VT;
static_assert((size_t)RP * 1536 * 2 == SZ_R1024 + SZ_R512, "LORA_OUT fills the U and KN slots exactly");
constexpr size_t A_PM = A_VT + SZ_R512;
constexpr size_t A_PR = A_PM + SZ_R1024;
constexpr size_t A_SMALL = A_PR + (size_t)RP * PRW * 2;
constexpr size_t A_RSTDQ = A_SMALL, A_RSTDKV = A_RSTDQ + (size_t)RP * 4, A_KROPE = A_RSTDKV + (size_t)RP * 4, A_SMALL_END = A_KROPE + (size_t)RP * 64 * 2;
constexpr size_t A_LIN = (A_SMALL_END + 4095) & ~(size_t)4095;
constexpr size_t A_VSH = A_LIN + SZ_R256;
constexpr size_t A_CHK = A_LIN;
constexpr size_t SZ_CHK = (size_t)258 * 8 * 32768;
constexpr size_t A_VFIRST = (A_CHK + SZ_CHK > A_VSH + SZ_R512 ? A_CHK + SZ_CHK : A_VSH + SZ_R512);
constexpr size_t A_VP = A_VFIRST + SZ_R512;
constexpr size_t A_RK = A_VP + SZ_R512;
constexpr size_t A_YS = A_RK + (size_t)RP * 8 * 4;
constexpr size_t A_SCST = A_YS + SZ_R512;
constexpr size_t A_PART = A_SCST + (size_t)64 * 4096 * 4;
constexpr size_t A_END1 = A_PART + (size_t)11 * NMETA * 1024 * 4;
constexpr size_t A_ACT0 = A_PM;
constexpr size_t A_MGU = A_KN;
constexpr size_t A_MDN = A_MGU + (size_t)NEXP * 7168 * 1024 * 2;
constexpr size_t A_MTAB = A_MDN + (size_t)NEXP * 1024 * 3584 * 2;
constexpr size_t MT_E = 0, MT_G = MT_E + (size_t)2 * RREAL * 4, MT_STOK = MT_G + (size_t)2 * RREAL * 4, MT_TSLOT = MT_STOK + (size_t)2 * MOE_MAXPAN * 256 * 4  , MT_SGATE = MT_TSLOT + (size_t)RREAL * 4,
                 MT_BE = MT_SGATE + (size_t)2 * MOE_MAXPAN * 256 * 4, MT_END = MT_BE + 2 * 256 * 4;
constexpr size_t A_MACT = (A_MTAB + MT_END + 4095) & ~(size_t)4095;
constexpr size_t XB_LIST = (size_t)MOE_MAXPAN * 256 * 1024;
constexpr size_t A_XB = A_MACT + (size_t)MOE_MAXPAN * 256 * FFE;
static_assert(A_XB + 2 * XB_LIST <= A_MACT + (size_t)MOE_MAXPAN * 256 * FFE * 2, "XB inside the old activation footprint");
constexpr size_t A_END2 = A_MACT + (size_t)MOE_MAXPAN * 256 * FFE * 2;
constexpr size_t WS_NEED = (A_END1 > A_END2 ? A_END1 : A_END2);
static_assert(WS_NEED <= 557619232ull, "workspace budget (sum of the inputs' bytes)");
static_assert(A_ACT0 + (size_t)RP * FF0 * 2 <= A_SMALL, "dense act overlay");
constexpr int CW_CNT = 64;
constexpr int CW_FILL = 128;
constexpr int CW_NPAN = 192;
constexpr int CW_WINV = 16448;
constexpr int CW_WMAX = 16384;
constexpr int CW_WGCNT = 8192;


__device__ __forceinline__ unsigned long long kp_uniform(unsigned long long kp) { const unsigned lo = __builtin_amdgcn_readfirstlane((unsigned)kp), hi = __builtin_amdgcn_readfirstlane((unsigned)(kp >> 32)); return ((unsigned long long)hi << 32) | lo; }
__device__ __forceinline__ const void* ldk(unsigned long long kp, int off) { unsigned long long v;
    asm volatile("s_load_dwordx2 %0, %1, %2\n\ts_waitcnt lgkmcnt(0)" : "=s"(v) : "s"(kp), "i"(off) : "memory"); return (const void*)v; }
__device__ __forceinline__ int opq(int v) { asm volatile("" : "+v"(v)); return v; }
__device__ __forceinline__ int opqs(int v) { asm volatile("" : "+s"(v)); return v; }
__device__ __forceinline__ void lds_barrier() { asm volatile("s_waitcnt lgkmcnt(0)\n\ts_barrier" ::: "memory"); }

__device__ __forceinline__ float moe_wscale_bits(unsigned bits) { const float m = __uint_as_float(bits);
    return m > 0.f ? __builtin_amdgcn_exp2f(floorf(__builtin_amdgcn_logf(224.0f / m))) : 1.0f; }
__device__ __forceinline__ float moe_wscale(const unsigned* ctl, int t, int e) { return moe_wscale_bits((unsigned)__builtin_amdgcn_readfirstlane((int)ctl[CW_WMAX + t * 8 + e])); }
#define XB_TMO      128
#define XB_XCNT(j)  (256  + 64 * (j))
#define XB_XSUB(j)  (1280 + 64 * (j))
#define XB_XGEN(j)  (2304 + 64 * (j))
#define XB_TOP      3328
#define XB_TOPGEN   3392
#define XCD_BAR_WORDS 3456
#define XB_SPIN_CAP (1u << 18)

__device__ __forceinline__ unsigned xb_ld(unsigned* p)              { return __hip_atomic_load(p, __ATOMIC_RELAXED, __HIP_MEMORY_SCOPE_AGENT); }
__device__ __forceinline__ unsigned xb_add(unsigned* p, unsigned v) { return __hip_atomic_fetch_add(p, v, __ATOMIC_RELAXED, __HIP_MEMORY_SCOPE_AGENT); }
__device__ __forceinline__ unsigned xb_xcc_id() { return (unsigned)__builtin_amdgcn_s_getreg((3 << 11) | 20) & 0xFu; }
#define XB_SPIN(cond, bar) do { unsigned _sp = 0; while (cond) { __builtin_amdgcn_s_sleep(1); \
    if ((++_sp & 255u) == 0u) { if (xb_ld(&(bar)[XB_TMO])) break; if (_sp > XB_SPIN_CAP) { atomicAdd(&(bar)[XB_TMO], 1u); break; } } } } while (0)

struct XcdBarrier {
    unsigned* bar; unsigned x;
    volatile LAS unsigned* st;
};

__device__ __forceinline__ XcdBarrier xcd_barrier_post(unsigned* bar, volatile LAS unsigned* st) {
    XcdBarrier b; b.bar = bar; b.x = xb_xcc_id(); b.st = st;
    if (threadIdx.x == 0) (void)xb_add(&bar[XB_XCNT(b.x)], 1u);
    return b;
}
__device__ __forceinline__ void xcd_barrier_complete(unsigned* bar, unsigned x, unsigned& nloc, unsigned& nx) {
    const unsigned G = gridDim.x * gridDim.y * gridDim.z;
    unsigned sum, cnt, mine, sp = 0u;
    for (;;) {
        sum = 0u; cnt = 0u; mine = 0u;
#pragma unroll
        for (unsigned j = 0; j < 16; ++j) { const unsigned c = xb_ld(&bar[XB_XCNT(j)]); sum += c; cnt += (c > 0u) ? 1u : 0u; mine = (j == x) ? c : mine; }
        if (sum == G) break;
        __builtin_amdgcn_s_sleep(1);
        if ((++sp & 255u) == 0u) { if (xb_ld(&bar[XB_TMO])) break; if (sp > XB_SPIN_CAP) { atomicAdd(&bar[XB_TMO], 1u); break; } }
    }
    nloc = mine > 0u ? mine : 1u; nx = cnt > 0u ? cnt : 1u;
}

__device__ __attribute__((noinline)) void xcd_barrier_fn(unsigned* bar_, unsigned x_, volatile LAS unsigned* st_) {
    XcdBarrier b; b.bar = bar_; b.x = x_; b.st = st_;
    asm volatile("s_waitcnt vmcnt(0)" ::: "memory");
    __syncthreads();
    if (threadIdx.x == 0) {
        unsigned* bar = b.bar;
        __builtin_amdgcn_s_waitcnt(0);
        unsigned nloc = b.st[0], nx = b.st[1];
        if (nloc == 0u) { xcd_barrier_complete(bar, b.x, nloc, nx); b.st[0] = nloc; b.st[1] = nx; }
        const unsigned old = xb_add(&bar[XB_XSUB(b.x)], 1u);
        const unsigned gen = old / nloc;
        if (old + 1u == (gen + 1u) * nloc) {
            __builtin_amdgcn_fence(__ATOMIC_RELEASE, "agent");
            asm volatile("s_waitcnt vmcnt(0)" ::: "memory");
            const unsigned og = xb_add(&bar[XB_TOP], 1u);
            const unsigned tg = og / nx;
            if (og + 1u == (tg + 1u) * nx) xb_add(&bar[XB_TOPGEN], 1u);
            else XB_SPIN(xb_ld(&bar[XB_TOPGEN]) == tg, bar);
            __builtin_amdgcn_fence(__ATOMIC_ACQUIRE, "agent");
            xb_add(&bar[XB_XGEN(b.x)], 1u);
            asm volatile("s_waitcnt vmcnt(0)" ::: "memory");
        } else {
            XB_SPIN(xb_ld(&bar[XB_XGEN(b.x)]) == gen, bar);
            __builtin_amdgcn_fence(__ATOMIC_ACQUIRE, "agent");
            asm volatile("s_waitcnt vmcnt(0)" ::: "memory");
        }
    }
    __syncthreads();
}

__device__ __forceinline__ void xcd_barrier(const XcdBarrier& b) { xcd_barrier_fn(b.bar, b.x, b.st); }
using pg8::Unit;
struct EpiInProj { static constexpr bool PERM = true, AFTER_DRAIN = false; bf16_t* PM; bf16_t* PR;
    __device__ __forceinline__ void operator()(const f32x4 (&acc)[2][2][4][2], const Unit& u, int wr, int wc, int fr, int fq) const {
        const int row0 = u.pm * 256 + wr * 64 + fr; bf16_t* base; int ld, colt;
        if (u.pn < 4) { base = PM; ld = PMW; colt = u.pn * 256; } else { base = PR; ld = PRW; colt = (u.pn - 4) * 256; }
        const int col0 = colt + wc * 32 + 8 * fq;
#pragma unroll
        for (int ai = 0; ai < 2; ++ai)
#pragma unroll
            for (int m = 0; m < 4; ++m) { bf16_t* rowp = base + (size_t)(row0 + ai * 128 + m * 16) * ld + col0;
#pragma unroll
                for (int bj = 0; bj < 2; ++bj) { const f32x4 v0 = acc[ai][bj][m][0], v1 = acc[ai][bj][m][1];
                    u32x4 w; w.x = pg8::cvt_pk_bf16(v0[0], v0[1]); w.y = pg8::cvt_pk_bf16(v0[2], v0[3]); w.z = pg8::cvt_pk_bf16(v1[0], v1[1]); w.w = pg8::cvt_pk_bf16(v1[2], v1[3]);
                    *(u32x4*)(rowp + bj * 128) = w; } }
    }
};
struct EpiRowScale { static constexpr bool PERM = true, AFTER_DRAIN = false; bf16_t* O; const float* rs; int ldc, pad;
    __device__ __forceinline__ void operator()(const f32x4 (&acc)[2][2][4][2], const Unit& u, int wr, int wc, int fr, int fq) const {
        const int row0 = u.pm * 256 + wr * 64 + fr; const int col0 = u.pn * 256 + wc * 32 + 8 * fq;
#pragma unroll
        for (int ai = 0; ai < 2; ++ai)
#pragma unroll
            for (int m = 0; m < 4; ++m) { const int row = row0 + ai * 128 + m * 16; const float s = rs ? rs[row] : 1.f; bf16_t* rowp = O + (size_t)row * ldc + col0;
#pragma unroll
                for (int bj = 0; bj < 2; ++bj) { const f32x4 v0 = acc[ai][bj][m][0] * s, v1 = acc[ai][bj][m][1] * s;
                    u32x4 w; w.x = pg8::cvt_pk_bf16(v0[0], v0[1]); w.y = pg8::cvt_pk_bf16(v0[2], v0[3]); w.z = pg8::cvt_pk_bf16(v1[0], v1[1]); w.w = pg8::cvt_pk_bf16(v1[2], v1[3]);
                    *(u32x4*)(rowp + bj * 128) = w; } }
    }
};
struct EpiColScale { static constexpr bool PERM = true, AFTER_DRAIN = false; bf16_t* O; const float* cs; int ldc, pad;
    __device__ __forceinline__ void operator()(const f32x4 (&acc)[2][2][4][2], const Unit& u, int wr, int wc, int fr, int fq) const {
        const int row0 = u.pm * 256 + wr * 64 + fr; const int col0 = u.pn * 256 + wc * 32 + 8 * fq;
        f32x4 sc[2][2];
#pragma unroll
        for (int bj = 0; bj < 2; ++bj) { sc[bj][0] = *(const f32x4*)(cs + col0 + bj * 128); sc[bj][1] = *(const f32x4*)(cs + col0 + bj * 128 + 4); }
#pragma unroll
        for (int ai = 0; ai < 2; ++ai)
#pragma unroll
            for (int m = 0; m < 4; ++m) { bf16_t* rowp = O + (size_t)(row0 + ai * 128 + m * 16) * ldc + col0;
#pragma unroll
                for (int bj = 0; bj < 2; ++bj) { const f32x4 v0 = acc[ai][bj][m][0] * sc[bj][0], v1 = acc[ai][bj][m][1] * sc[bj][1];
                    u32x4 w; w.x = pg8::cvt_pk_bf16(v0[0], v0[1]); w.y = pg8::cvt_pk_bf16(v0[2], v0[3]); w.z = pg8::cvt_pk_bf16(v1[0], v1[1]); w.w = pg8::cvt_pk_bf16(v1[2], v1[3]);
                    *(u32x4*)(rowp + bj * 128) = w; } }
    }
};
struct EpiResid { static constexpr bool PERM = false, AFTER_DRAIN = false; float* out; float* hmeta; const float* src; float scale; int pad;
    __device__ __forceinline__ void operator()(const f32x4 (&acc)[2][2][4][2], const Unit& u, int wr, int wc, int fr, int fq) const {
        const int rl = wr * 64 + fr, col0 = u.pn * 256 + wc * 32 + 4 * fq;
        float* base = u.pm < 128 ? out + (size_t)u.pm * 256 * D : hmeta; const float* sbase = u.pm < 128 ? src + (size_t)u.pm * 256 * D : hmeta;
#pragma unroll
        for (int ai = 0; ai < 2; ++ai)
#pragma unroll
            for (int m = 0; m < 4; ++m) { const size_t ro = (size_t)(rl + ai * 128 + m * 16) * D + col0;
#pragma unroll
                for (int bj = 0; bj < 2; ++bj)
#pragma unroll
                    for (int n = 0; n < 2; ++n) { const f32x4 hv = *(const f32x4*)(sbase + ro + bj * 128 + n * 16); *(f32x4*)(base + ro + bj * 128 + n * 16) = hv + acc[ai][bj][m][n] * scale; }
                asm volatile("" ::: "memory"); }
    }
};
struct EpiSwiGLU { static constexpr bool PERM = true, AFTER_DRAIN = false; bf16_t* O; int ldc, nmod, pn_off, pad;
    __device__ __forceinline__ void operator()(const f32x4 (&acc)[2][2][4][2], const Unit& u, int wr, int wc, int fr, int fq) const {
        const int row0 = u.pm * 256 + wr * 64 + fr; const int pnl = (u.pn % nmod) - pn_off; const int col0 = pnl * 128 + wc * 32 + 8 * fq;
#pragma unroll
        for (int ai = 0; ai < 2; ++ai)
#pragma unroll
            for (int m = 0; m < 4; ++m) { bf16_t* rowp = O + (size_t)(row0 + ai * 128 + m * 16) * ldc + col0; float r[8];
#pragma unroll
                for (int n = 0; n < 2; ++n)
#pragma unroll
                    for (int j = 0; j < 4; ++j) { const float g = acc[ai][0][m][n][j], up = acc[ai][1][m][n][j]; r[4 * n + j] = g / (1.0f + __expf(-g)) * up; }
                u32x4 w; w.x = pg8::cvt_pk_bf16(r[0], r[1]); w.y = pg8::cvt_pk_bf16(r[2], r[3]); w.z = pg8::cvt_pk_bf16(r[4], r[5]); w.w = pg8::cvt_pk_bf16(r[6], r[7]);
                *(u32x4*)rowp = w; }
    }
};
struct EpiSwiGLU8 { static constexpr bool PERM = false, AFTER_DRAIN = false; unsigned char* O; const unsigned* ctl; int ldc, nmod;
    __device__ __forceinline__ void operator()(const f32x4 (&acc)[2][2][4][2], const Unit& u, int wr, int wc, int fr, int fq) const {
        const int row0 = u.pm * 256 + wr * 64 + fr; const int e = u.pn / nmod, pnl = u.pn % nmod; const int col0 = pnl * 128 + wc * 32 + 4 * fq;
        const float ig = __uint_as_float(__builtin_amdgcn_readfirstlane((int)ctl[CW_WINV + e])), iu = __uint_as_float(__builtin_amdgcn_readfirstlane((int)ctl[CW_WINV + 8 + e])) * F8_ACT;
#pragma unroll
        for (int ai = 0; ai < 2; ++ai)
#pragma unroll
            for (int m = 0; m < 4; ++m) { unsigned char* rowp = O + (size_t)(row0 + ai * 128 + m * 16) * ldc + col0;
#pragma unroll
                for (int n = 0; n < 2; ++n) { float r[4];
#pragma unroll
                    for (int j = 0; j < 4; ++j) { const float g = acc[ai][0][m][n][j] * ig, up = acc[ai][1][m][n][j] * iu; r[j] = g / (1.0f + __expf(-g)) * up; }
                    *(unsigned*)(rowp + n * 16) = pk4_f8(r[0], r[1], r[2], r[3]); } }
    }
};
struct EpiMoeDown { static constexpr bool PERM = false, AFTER_DRAIN = false; float* out; const int* stok; const float* sgate; int nmod; float scale; const unsigned* ctl;
    __device__ __forceinline__ void operator()(const f32x4 (&acc)[2][2][4][2], const Unit& u, int wr, int wc, int fr, int fq) const {
        const int row0 = u.pm * 256 + wr * 64 + fr; const int col0 = (u.pn % nmod) * 256 + wc * 32 + 4 * fq;
        const float winv = ctl ? __uint_as_float(__builtin_amdgcn_readfirstlane((int)ctl[CW_WINV + 16 + u.pn / nmod])) : 1.0f;
#pragma unroll
        for (int ai = 0; ai < 2; ++ai)
#pragma unroll
            for (int m = 0; m < 4; ++m) { const int prow = row0 + ai * 128 + m * 16; const int tok = stok[prow]; if (tok < 0) continue; const float gt = sgate[prow] * scale * winv;
                float* rowp = out + (size_t)tok * D + col0;
#pragma unroll
                for (int bj = 0; bj < 2; ++bj)
#pragma unroll
                    for (int n = 0; n < 2; ++n) { f32x4* p = (f32x4*)(rowp + bj * 128 + n * 16); *p = *p + acc[ai][bj][m][n] * gt; }
                asm volatile("" ::: "memory"); }
    }
};
struct EpiMoeDownStore { static constexpr bool PERM = false, AFTER_DRAIN = false; float* tb; const int* stok; const float* sgate; int nmod, pm0; const unsigned* ctl;
    __device__ __forceinline__ void operator()(const f32x4 (&acc)[2][2][4][2], const Unit& u, int wr, int wc, int fr, int fq) const {
        const int row0 = u.pm * 256 + wr * 64 + fr; const int col0 = (u.pn % nmod) * 256 + wc * 32 + 4 * fq;
#pragma unroll
        for (int ai = 0; ai < 2; ++ai)
#pragma unroll
            for (int m = 0; m < 4; ++m) { const int prow = row0 + ai * 128 + m * 16; const int tok = stok[prow]; if (tok < 0) continue; const float gt = sgate[prow] * __uint_as_float(__builtin_amdgcn_readfirstlane((int)ctl[CW_WINV + 16 + u.pn / nmod]));
                float* rowp = tb + (size_t)(prow - pm0 * 256) * D + col0;
#pragma unroll
                for (int bj = 0; bj < 2; ++bj)
#pragma unroll
                    for (int n = 0; n < 2; ++n) *(f32x4*)(rowp + bj * 128 + n * 16) = acc[ai][bj][m][n] * gt; }
    }
};
struct MoeOrder { static constexpr bool GATHER = false; const int* block_e; const unsigned* npan; int nN, emul, pn_off, G, c, lmax;
    __device__ __forceinline__ bool next(int i, Unit& u) const { const int L = i * G + c; const int np = __builtin_amdgcn_readfirstlane((int)(*npan)); if (L >= np * nN || (lmax && L >= lmax)) return false;
        const int pm = L / nN; u.k0 = 0; u.pm = pm; u.pn = __builtin_amdgcn_readfirstlane(block_e[pm]) * emul + pn_off + (L % nN); return true; }
    __device__ __forceinline__ void a_ready(const Unit&) const {}
    __device__ __forceinline__ void done(const Unit&) const {}
};


struct EpiResidPartial { static constexpr bool PERM = false, AFTER_DRAIN = false; float* part;
    __device__ __forceinline__ void operator()(const f32x4 (&acc)[2][2][4][2], const Unit& u, int wr, int wc, int fr, int fq) const {
        const int rl = wr * 64 + fr, col0 = u.pn * 256 + wc * 32 + 4 * fq; float* base = part + (size_t)(u.k0 >> 8) * NMETA * D;
#pragma unroll
        for (int ai = 0; ai < 2; ++ai)
#pragma unroll
            for (int m = 0; m < 4; ++m) { const int row = rl + ai * 128 + m * 16; if (row >= NMETA) continue;
                float* rowp = base + (size_t)row * D + col0;
#pragma unroll
                for (int bj = 0; bj < 2; ++bj)
#pragma unroll
                    for (int n = 0; n < 2; ++n) *(f32x4*)(rowp + bj * 128 + n * 16) = acc[ai][bj][m][n]; }
    }
};
struct DenseTailOrder { static constexpr bool GATHER = false; int nN, nsl, G, c;
    __device__ __forceinline__ bool next(int i, Unit& u) const { const int idx = i * G + c; if (idx >= nN * nsl) return false; u.pm = 128; u.pn = idx / nsl; u.k0 = (idx % nsl) * 256; return true; }
    __device__ __forceinline__ void a_ready(const Unit&) const {}
    __device__ __forceinline__ void done(const Unit&) const {}
};
template <bool GA> struct MoeGatherOrderT { static constexpr bool GATHER = GA;
    const int* block_e; const unsigned* npan; const int* rows; int nN, emul, pn_off, G, c, zero_row;
    int pm_lo, pm_hi, gap, rot, T, cskip;
    __device__ __forceinline__ bool next(int i, Unit& u) const {
        int cc = c - rot; cc += cc < 0 ? G : 0;
        int L;
        if (T == 0) L = i * G + cc;
        else { const int W0 = G - T; if (cc < W0) L = i < cskip ? i * W0 + cc : cskip * W0 + (i - cskip) * G + cc; else L = cskip * W0 + i * G + cc; }
        int np = __builtin_amdgcn_readfirstlane((int)(*npan)); np = np < pm_hi ? np : pm_hi;
        const int pl = pm_lo + L / nN; if (pl >= np) return false;
        const int pm = pl + (pl >= MOE_TAILPAN ? gap : 0); u.k0 = 0; u.pm = pm; u.pn = __builtin_amdgcn_readfirstlane(block_e[pm]) * emul + pn_off + (L % nN); return true; }
    __device__ __forceinline__ void a_ready(const Unit&) const {}
    __device__ __forceinline__ void done(const Unit&) const {}
};
using MoeGatherOrder = MoeGatherOrderT<true>; using MoeSlotOrder = MoeGatherOrderT<false>;
struct MoeShiftTailOrder { static constexpr bool GATHER = false; const int* block_e; const unsigned* npan; int nN, emul, gap, wg_first, c, pad;
    __device__ __forceinline__ bool next(int i, Unit& u) const { const int t = wg_first - c; const int np = __builtin_amdgcn_readfirstlane((int)(*npan)); const int L = MOE_TAILPAN * nN + t;
        if (i > 0 || t < 0 || L >= np * nN) return false;
        const int pm = L / nN + gap; u.k0 = 0; u.pm = pm; u.pn = __builtin_amdgcn_readfirstlane(block_e[pm]) * emul + (L % nN); return true; }
    __device__ __forceinline__ void a_ready(const Unit&) const {}
    __device__ __forceinline__ void done(const Unit&) const {}
};

__device__ __forceinline__ int map_row(int mode, int n, int rowoff) {
    if (mode == 1) return n < 832 ? n : n + 192;
    if (mode == 2) return rowoff + (n >> 7) * 256 + (n & 127);
    if (mode == 3) return rowoff + (n >> 7) * 256 + 128 + (n & 127);
    if (mode == 4) return (n >> 8) * 128 + (n & 127) + ((n & 128) ? 512 : 0);
    return rowoff + n;
}
__device__ __forceinline__ void transpose_item(const float* __restrict__ W, int K, int N, bf16_t* __restrict__ dst, int ld, int koff, int mode, int rowoff, const float* __restrict__ gain, LAS float* scr, int item, int lane) {
    const int nblk = N / 32; const int kb = item / nblk, nb = item % nblk, k0 = 64 * kb, n0 = 32 * nb;
#pragma unroll 8
    for (int i = 0; i < 32; ++i) { const int kk = 2 * i + (lane >> 5); float v = W[(size_t)(k0 + kk) * N + n0 + (lane & 31)]; if (gain) v *= gain[k0 + kk]; scr[kk * 33 + (lane & 31)] = v; }
    asm volatile("s_waitcnt lgkmcnt(0)" ::: "memory");
    const int c = lane & 7;
#pragma unroll
    for (int j = 0; j < 4; ++j) { const int n = (lane >> 3) + 8 * j; const LAS float* s = scr + (8 * c) * 33 + n;
        u32x4 o; o.x = pk2(s[0 * 33], s[1 * 33]); o.y = pk2(s[2 * 33], s[3 * 33]); o.z = pk2(s[4 * 33], s[5 * 33]); o.w = pk2(s[6 * 33], s[7 * 33]);
        *(u32x4*)(dst + (size_t)map_row(mode, n0 + n, rowoff) * ld + koff + k0 + 8 * c) = o; }
    asm volatile("s_waitcnt lgkmcnt(0)" ::: "memory");
}
__device__ __forceinline__ void transpose_item_f8(const float* __restrict__ W, int K, int N, unsigned char* __restrict__ dst, int ld, int mode, int rowoff, float scale, LAS float* scr, int item, int lane) {
    const int nblk = N / 32; const int kb = item / nblk, nb = item % nblk, k0 = 64 * kb, n0 = 32 * nb;
#pragma unroll 8
    for (int i = 0; i < 32; ++i) { const int kk = 2 * i + (lane >> 5); scr[kk * 33 + (lane & 31)] = W[(size_t)(k0 + kk) * N + n0 + (lane & 31)] * scale; }
    asm volatile("s_waitcnt lgkmcnt(0)" ::: "memory");
    const int c = lane & 7;
#pragma unroll
    for (int j = 0; j < 4; ++j) { const int n = (lane >> 3) + 8 * j; const LAS float* s = scr + (8 * c) * 33 + n;
        u32x2 o; o.x = pk4_f8(s[0 * 33], s[1 * 33], s[2 * 33], s[3 * 33]); o.y = pk4_f8(s[4 * 33], s[5 * 33], s[6 * 33], s[7 * 33]);
        *(u32x2*)(dst + (size_t)map_row(mode, n0 + n, rowoff) * ld + k0 + 8 * c) = o; }
    asm volatile("s_waitcnt lgkmcnt(0)" ::: "memory");
}
struct TrJob8 { const float* W; unsigned char* dst; int K, N, ld, mode, rowoff; float scale; };
__device__ __forceinline__ void ph_transpose_f8(const TrJob8& J, LAS float* scr, int gw, int ngw, int lane) {
    lane = opq(lane);
    const int nitems = (J.K / 64) * (J.N / 32);
    for (int it = gw; it < nitems; it += ngw) transpose_item_f8(J.W, J.K, J.N, J.dst, J.ld, J.mode, J.rowoff, J.scale, scr, it, lane);
}
struct TrJob { const float* W; const float* gain; bf16_t* dst; int K, N, ld, koff, mode, rowoff; };
__device__ __forceinline__ void ph_transpose(const TrJob& J, LAS float* scr, int gw, int ngw, int lane) {
    lane = opq(lane);
    const int nitems = (J.K / 64) * (J.N / 32);
    for (int it = gw; it < nitems; it += ngw) transpose_item(J.W, J.K, J.N, J.dst, J.ld, J.koff, J.mode, J.rowoff, J.gain, scr, it, lane);
}
__device__ __forceinline__ const float* hrow_c(const float* out, const float* hmeta, int row) { return row < RREAL ? out + (size_t)row * D : hmeta + (size_t)(row - RREAL) * D; }
__device__ __forceinline__ void ph_init(const float* __restrict__ x, const float* __restrict__ meta, float* __restrict__ out, float* __restrict__ hmeta, float* __restrict__ rope,
                                        const float* __restrict__ v1, const float* __restrict__ v2, bf16_t* __restrict__ v12t, size_t gt, size_t ngt) {
    (void)x; (void)out;
    for (size_t i = gt; i < (size_t)256 * D; i += ngt) hmeta[i] = i < (size_t)NMETA * D ? meta[i] : 0.f;
    for (size_t i = gt; i < (size_t)4112 * 32; i += ngt) { const int pos = (int)(i / 32), j = (int)(i % 32);
        const float inv = powf(10000.0f, -(float)j / 32.0f); const float ang = (float)pos * inv; rope[2 * i] = cosf(ang); rope[2 * i + 1] = sinf(ang); }
    for (size_t i = gt; i < (size_t)512 * 512; i += ngt) { const int n = (int)(i >> 9), k = (int)(i & 511); float s = 0.f;
#pragma unroll 8
        for (int j = 0; j < 32; ++j) s += v1[k * 32 + j] * v2[j * 512 + n];
        v12t[i] = f2bf(s); }
}
__device__ __forceinline__ void ph_rmsnorm(const float* __restrict__ out, const float* hmeta, const float* __restrict__ g, bf16_t* __restrict__ U, const float* __restrict__ part, int nsl, int gw, int ngw, int lane) {
    lane = opq(lane);
    for (int row = gw; row < RP; row += ngw) {
        unsigned long long* o8 = (unsigned long long*)(U + (size_t)row * D) + lane;
        if (row >= RVALID) {
#pragma unroll
            for (int j = 0; j < 4; ++j) o8[64 * j] = 0ull;
            continue; }
        const f32x4* xr = (const f32x4*)hrow_c(out, hmeta, row) + lane; const f32x4* g4 = (const f32x4*)g + lane;
        f32x4 v[4]; float s = 0.f;
#pragma unroll
        for (int j = 0; j < 4; ++j) v[j] = xr[64 * j];
        if (row >= RREAL && nsl > 0) {
            for (int sl = 0; sl < nsl; ++sl) { const f32x4* pr = (const f32x4*)(part + ((size_t)sl * NMETA + (row - RREAL)) * D) + lane;
#pragma unroll
                for (int j = 0; j < 4; ++j) v[j] = v[j] + pr[64 * j]; }
            f32x4* hw = (f32x4*)xr;
#pragma unroll
            for (int j = 0; j < 4; ++j) hw[64 * j] = v[j]; }
#pragma unroll
        for (int j = 0; j < 4; ++j) s += (v[j].x * v[j].x + v[j].y * v[j].y) + (v[j].z * v[j].z + v[j].w * v[j].w);
        const float rstd = rsqrtf(wave_sum(s) * (1.f / D) + RMS_EPS);
#pragma unroll
        for (int j = 0; j < 4; ++j) { const f32x4 gg = g4[64 * j]; o8[64 * j] = (unsigned long long)pk2(v[j].x * rstd * gg.x, v[j].y * rstd * gg.y) | ((unsigned long long)pk2(v[j].z * rstd * gg.z, v[j].w * rstd * gg.w) << 32); }
    }
}
__device__ __forceinline__ void unpack8(const u32x4 v, float (&f)[8]) {
    f[0] = __uint_as_float(v.x << 16); f[1] = __uint_as_float(v.x & 0xffff0000u); f[2] = __uint_as_float(v.y << 16); f[3] = __uint_as_float(v.y & 0xffff0000u);
    f[4] = __uint_as_float(v.z << 16); f[5] = __uint_as_float(v.z & 0xffff0000u); f[6] = __uint_as_float(v.w << 16); f[7] = __uint_as_float(v.w & 0xffff0000u);
}
__device__ __forceinline__ void ph_prep(const bf16_t* __restrict__ PM, const bf16_t* __restrict__ PR, const float* __restrict__ mu, const float* __restrict__ rope,
                                        float* __restrict__ rstdq, float* __restrict__ rstdkv, bf16_t* __restrict__ KR, bf16_t* __restrict__ LIN, bf16_t* __restrict__ VSH, int do_vsh, int gw, int ngw, int lane) {
    lane = opq(lane);
    for (int row = gw; row < RP; row += ngw) {
        const bf16_t* pm = PM + (size_t)row * PMW;
        float f[8], sq = 0.f, skv = 0.f;
        unpack8(*(const u32x4*)(pm + lane * 8), f);
#pragma unroll
        for (int j = 0; j < 8; ++j) sq += f[j] * f[j];
        if (lane < 32) { unpack8(*(const u32x4*)(pm + 512 + lane * 8), f);
#pragma unroll
            for (int j = 0; j < 8; ++j) skv += f[j] * f[j]; }
        sq = wave_sum(sq); skv = wave_sum(skv);
        if (lane == 0) { rstdq[row] = rsqrtf(sq * (1.f / 512.f) + RMS_EPS); rstdkv[row] = rsqrtf(skv * (1.f / 256.f) + RMS_EPS); }
        const int pos = row_pos(row);
        if (lane < 32) { const float x1 = bf2f(pm[768 + lane]), x2 = bf2f(pm[800 + lane]); const float c = rope[2 * (pos * 32 + lane)], s = rope[2 * (pos * 32 + lane) + 1];
            KR[(size_t)row * 64 + lane] = f2bf(x1 * c - x2 * s); KR[(size_t)row * 64 + 32 + lane] = f2bf(x1 * s + x2 * c); }
        const int pr = row_prev(row); const bool valid = row < RVALID; const float pmk = pr < 0 ? 0.f : 1.f;
        const bf16_t* x = PR + (size_t)row * PRW; const bf16_t* xp = PR + (size_t)(pr < 0 ? row : pr) * PRW;
        if (lane < 32) {
            float a[8], b[8]; unpack8(*(const u32x4*)(x + 1536 + lane * 8), a); unpack8(*(const u32x4*)(xp + 1536 + lane * 8), b);
            const f32x4 m0 = *(const f32x4*)(mu + 1536 + lane * 8), m1 = *(const f32x4*)(mu + 1536 + lane * 8 + 4); const float mm[8] = {m0.x, m0.y, m0.z, m0.w, m1.x, m1.y, m1.z, m1.w};
            float o[8];
#pragma unroll
            for (int j = 0; j < 8; ++j) { float v = a[j] + (pmk * b[j] - a[j]) * mm[j]; v = lane < 8 ? tanhf(v) : (lane < 16 ? v : sigmoidf_(v)); o[j] = valid ? v : 0.f; }
            u32x4 w; w.x = pk2(o[0], o[1]); w.y = pk2(o[2], o[3]); w.z = pk2(o[4], o[5]); w.w = pk2(o[6], o[7]); *(u32x4*)(LIN + (size_t)row * 256 + lane * 8) = w; }
        if (do_vsh) {
            float a[8], b[8]; unpack8(*(const u32x4*)(x + 1024 + lane * 8), a); unpack8(*(const u32x4*)(xp + 1024 + lane * 8), b);
            const f32x4 m0 = *(const f32x4*)(mu + 1024 + lane * 8), m1 = *(const f32x4*)(mu + 1024 + lane * 8 + 4); const float mm[8] = {m0.x, m0.y, m0.z, m0.w, m1.x, m1.y, m1.z, m1.w};
            float o[8];
#pragma unroll
            for (int j = 0; j < 8; ++j) { const float v = a[j] + (pmk * b[j] - a[j]) * mm[j]; o[j] = valid ? v : 0.f; }
            u32x4 w; w.x = pk2(o[0], o[1]); w.y = pk2(o[2], o[3]); w.z = pk2(o[4], o[5]); w.w = pk2(o[6], o[7]); *(u32x4*)(VSH + (size_t)row * 512 + lane * 8) = w; }
    }
}

__device__ __forceinline__ void ph_norm_route(LAS unsigned char* lds, const float* __restrict__ out, const float* __restrict__ g, const float* __restrict__ router, const float* __restrict__ rbias,
                                              bf16_t* __restrict__ U, int* __restrict__ TE, float* __restrict__ TG, int* __restrict__ STOK, unsigned* __restrict__ ctl, int bid, int nblk, int wave, int lane) {
    lane = opq(lane); nblk = opqs(nblk); bid = opqs(bid);
    { constexpr int NFILL = 2 * MOE_MAXPAN * 256 + RREAL; const int per = (NFILL + nblk - 1) / nblk; const int t_ = wave * 64 + lane;
      for (int i = t_; i < per; i += 512) { const int idx = bid * per + i; if (idx < NFILL) STOK[idx] = -1; } }
    const int rpw = (RREAL + nblk - 1) / nblk, rpwave = (rpw + 7) / 8;
    int c1[8], c2[8];
#pragma unroll
    for (int e = 0; e < 8; ++e) { c1[e] = 0; c2[e] = 0; }
    for (int k = 0; k < rpwave; ++k) { const int rl = wave * rpwave + k; const int row = bid * rpw + rl; if (rl >= rpw || row >= RREAL) break;
        const f32x4* xr = (const f32x4*)(out + (size_t)row * D) + lane; const f32x4* g4 = (const f32x4*)g + lane;
        f32x4 v[4]; float s = 0.f;
#pragma unroll
        for (int j = 0; j < 4; ++j) { v[j] = xr[64 * j]; s += (v[j].x * v[j].x + v[j].y * v[j].y) + (v[j].z * v[j].z + v[j].w * v[j].w); }
        const float rstd = rsqrtf(wave_sum(s) * (1.f / D) + RMS_EPS);
        unsigned* o4 = (unsigned*)((unsigned char*)U + (size_t)row * D) + lane;
        float lg[8];
#pragma unroll
        for (int e = 0; e < 8; ++e) lg[e] = 0.f;
#pragma unroll
        for (int j = 0; j < 4; ++j) { const f32x4 gg = g4[64 * j]; f32x4 xn; xn.x = v[j].x * rstd * gg.x; xn.y = v[j].y * rstd * gg.y; xn.z = v[j].z * rstd * gg.z; xn.w = v[j].w * rstd * gg.w;
            o4[64 * j] = pk4_f8(xn.x * F8_ACT, xn.y * F8_ACT, xn.z * F8_ACT, xn.w * F8_ACT);
            const int d0 = 4 * (lane + 64 * j);
#pragma unroll
            for (int q = 0; q < 4; ++q) { const f32x4 ra = *(const f32x4*)(router + (size_t)(d0 + q) * 8), rb = *(const f32x4*)(router + (size_t)(d0 + q) * 8 + 4); const float xv = xn[q];
                lg[0] += xv * ra.x; lg[1] += xv * ra.y; lg[2] += xv * ra.z; lg[3] += xv * ra.w; lg[4] += xv * rb.x; lg[5] += xv * rb.y; lg[6] += xv * rb.z; lg[7] += xv * rb.w; }
            asm volatile("" ::: "memory"); }
#pragma unroll
        for (int e = 0; e < 8; ++e) { float t_ = wave_sum(lg[e]); asm volatile("" : "+v"(t_)); lg[e] = t_ + rbias[e]; }
        int e1 = 0; float l1 = lg[0];
#pragma unroll
        for (int e = 1; e < 8; ++e) if (lg[e] > l1) { l1 = lg[e]; e1 = e; }
        int e2 = e1 == 0 ? 1 : 0; float l2 = -INFINITY;
#pragma unroll
        for (int e = 0; e < 8; ++e) if (e != e1 && lg[e] > l2) { l2 = lg[e]; e2 = e; }
        const float g1 = 1.0f / (1.0f + __expf(l2 - l1)), g2 = 1.0f - g1;
        { const int e1v = e1, e2v = e2;
#pragma unroll
        for (int e = 0; e < 8; ++e) { c1[e] += (e1v == e) ? 1 : 0; c2[e] += (e2v == e) ? 1 : 0; } }
        if (lane == 0) { TE[row] = e1; TE[RREAL + row] = e2; TG[row] = g1; TG[RREAL + row] = g2; }
    }
    LAS int* wc = (LAS int*)(lds + 80000);
    if (lane == 0) {
#pragma unroll
        for (int e = 0; e < 8; ++e) { wc[wave * 16 + e] = c1[e]; wc[wave * 16 + 8 + e] = c2[e]; } }
    __syncthreads();
    const int t = wave * 64 + lane;
    if (t < 16) { int sum = 0;
#pragma unroll
        for (int ww = 0; ww < 8; ++ww) sum += wc[ww * 16 + t];
        ctl[CW_WGCNT + bid * 16 + t] = (unsigned)sum; }
}
__device__ __forceinline__ void ph_moe_assign(LAS unsigned char* lds, int list, const int* __restrict__ TE, const float* __restrict__ TG, int* __restrict__ STOK, float* __restrict__ SGATE, int* __restrict__ BE, unsigned* __restrict__ ctl,
                                              const unsigned char* __restrict__ U8, unsigned char* __restrict__ XB, int bid, int nblk, int tid) {
    LAS int* sh = (LAS int*)lds;
    __syncthreads();
    if (tid < 8) { int tot = 0, pre = 0;
        for (int b = 0; b < nblk; ++b) { const int v = (int)ctl[CW_WGCNT + b * 16 + 8 * list + tid]; tot += v; pre += b < bid ? v : 0; }
        sh[tid] = tot; sh[8 + tid] = pre; }
    __syncthreads();
    if (tid == 0) { int pan = 0;
        for (int e = 0; e < 8; ++e) { const int np = (sh[e] + 255) >> 8; sh[16 + e] = pan << 8;
            if (bid == 0) for (int q = 0; q < np; ++q) { const int pi = pan + q; BE[256 * list + pi + (list == 1 && pi >= MOE_TAILPAN ? MOE_GAP : 0)] = e; }
            pan += np; }
        if (bid == 0) ctl[CW_NPAN + list] = (unsigned)pan; }
    __syncthreads();
    if (tid < 64) {
        const int rpw = (RREAL + nblk - 1) / nblk; int run[8];
#pragma unroll
        for (int q = 0; q < 8; ++q) run[q] = 0;
        for (int r0 = 0; r0 < rpw; r0 += 64) { const int rl = r0 + tid, row = bid * rpw + rl; const bool ok = rl < rpw && row < RREAL;
            const int ee = ok ? TE[list * RREAL + row] : -1; int slot = -1;
#pragma unroll
            for (int e = 0; e < 8; ++e) { const unsigned long long m = __builtin_amdgcn_ballot_w64(ee == e);
                const int rank = (int)__builtin_amdgcn_mbcnt_hi((unsigned)(m >> 32), __builtin_amdgcn_mbcnt_lo((unsigned)m, 0u));
                if (ee == e) { slot = sh[16 + e] + sh[8 + e] + run[e] + rank; if (list == 1 && slot >= MOE_TAILPAN * 256) slot += MOE_GAP * 256; }
                run[e] += __builtin_popcountll(m); }
            if (rl < rpw) sh[32 + rl] = ok ? slot : -1;
            if (ok) { STOK[list * (MOE_MAXPAN * 256) + slot] = row; SGATE[list * (MOE_MAXPAN * 256) + slot] = TG[list * RREAL + row];
                if (list == 1 && slot >= (MOE_TAILPAN + MOE_GAP) * 256) STOK[2 * MOE_MAXPAN * 256 + row] = slot - (MOE_TAILPAN + MOE_GAP) * 256; } }
    }
    __syncthreads();
    {
        const int rpw = (RREAL + nblk - 1) / nblk, w = tid >> 6, ln = tid & 63; unsigned char* xl = XB + (size_t)list * (MOE_MAXPAN * 256) * 1024;
        for (int rl = w; rl < rpw; rl += 8) { const int slot = sh[32 + rl]; if (slot >= 0) ((u32x4*)(xl + (size_t)slot * 1024))[ln] = ((const u32x4*)(U8 + (size_t)(bid * rpw + rl) * 1024))[ln]; }
        if (bid < 8) { const int e = bid, lo = sh[16 + e] + sh[e], hi = sh[16 + e] + (((sh[e] + 255) >> 8) << 8); unsigned z0 = 0u; asm volatile("" : "+v"(z0)); u32x4 z; z.x = z.y = z.z = z.w = z0;
            for (int p0 = lo + w; p0 < hi; p0 += 8) { const int slot = p0 + ((list == 1 && p0 >= MOE_TAILPAN * 256) ? MOE_GAP * 256 : 0); ((u32x4*)(xl + (size_t)slot * 1024))[ln] = z; } }
    }
}
__device__ __forceinline__ void ph_moe_gather8(const unsigned char* __restrict__ U8, const int* __restrict__ STOK, unsigned char* __restrict__ XB, int gw, int ngw, int lane) {
    lane = opq(lane);
    unsigned z0 = 0u; asm volatile("" : "+v"(z0));
    for (int prow = gw; prow < 2 * MOE_MAXPAN * 256; prow += ngw) { const int tok = STOK[prow]; u32x4* d = (u32x4*)(XB + (size_t)prow * 1024) + lane; u32x4 z; z.x = z.y = z.z = z.w = z0;
        if (tok < 0) d[0] = z; else d[0] = ((const u32x4*)(U8 + (size_t)tok * 1024))[lane]; }
}
__device__ __forceinline__ void ph_moe_gather(const bf16_t* __restrict__ U, const int* __restrict__ STOK, bf16_t* __restrict__ XB, const unsigned* __restrict__ npan, int gw, int ngw, int lane) {
    lane = opq(lane);
    const int nrow = (int)(*npan) * 256;
    for (int prow = gw; prow < nrow; prow += ngw) { const int tok = STOK[prow]; u32x4* d = (u32x4*)(XB + (size_t)prow * D) + lane; u32x4 z; z.x = z.y = z.z = z.w = 0u;
        if (tok < 0) { d[0] = z; d[64] = z; } else { const u32x4* s = (const u32x4*)(U + (size_t)tok * D) + lane; d[0] = s[0]; d[64] = s[64]; } }
}
__device__ __forceinline__ void ph_final(float* __restrict__ out, const float* __restrict__ g, const int* __restrict__ tslot, const float* __restrict__ tb, int gw, int ngw, int lane, float pscale = 1.0f) {
    lane = opq(lane);
    for (int row = gw; row < RREAL; row += ngw) {
        f32x4* xr = (f32x4*)(out + (size_t)row * D) + lane; const f32x4* g4 = (const f32x4*)g + lane;
        const int ts = __builtin_amdgcn_readfirstlane(tslot[row]);
        f32x4 v[4]; float s = 0.f;
#pragma unroll
        for (int j = 0; j < 4; ++j) v[j] = xr[64 * j];
        if (ts >= 0) { const f32x4* tr = (const f32x4*)(tb + (size_t)ts * D) + lane;
#pragma unroll
            for (int j = 0; j < 4; ++j) v[j] = v[j] + tr[64 * j]; }
#pragma unroll
        for (int j = 0; j < 4; ++j) s += (v[j].x * v[j].x + v[j].y * v[j].y) + (v[j].z * v[j].z + v[j].w * v[j].w);
        const float rstd = rsqrtf(wave_sum(s) * (1.f / D) + RMS_EPS);
#pragma unroll
        for (int j = 0; j < 4; ++j) { const f32x4 gg = g4[64 * j]; f32x4 o; o.x = v[j].x * rstd * gg.x * pscale; o.y = v[j].y * rstd * gg.y * pscale; o.z = v[j].z * rstd * gg.z * pscale; o.w = v[j].w * rstd * gg.w * pscale; xr[64 * j] = o; }
    }
}

constexpr int KS_STRIDE = 200, VS_STRIDE = 72;
constexpr int ATT_LDS = 64 * KS_STRIDE * 2 + 128 * VS_STRIDE * 2;
__device__ __forceinline__ bf16x8 pack8(const f32x16& x, int s) {
    u32x4 p;
    if (s == 0) { p.x = cvtpk(x[0], x[1]); p.y = cvtpk(x[2], x[3]); p.z = cvtpk(x[4], x[5]); p.w = cvtpk(x[6], x[7]); }
    else { p.x = cvtpk(x[8], x[9]); p.y = cvtpk(x[10], x[11]); p.z = cvtpk(x[12], x[13]); p.w = cvtpk(x[14], x[15]); }
    return __builtin_bit_cast(bf16x8, p);
}
__device__ __forceinline__ void attn_unit(LAS unsigned char* lds, const bf16_t* __restrict__ Q, const bf16_t* __restrict__ KN, const bf16_t* __restrict__ KR, const bf16_t* __restrict__ VT,
                                          bf16_t* __restrict__ MIX, const float* __restrict__ rope, int h, int qrow0, int kbase, int ntile, int wlim, bool wave_active) {
    const int tid = opq(threadIdx.x), lane = tid & 63, w = tid >> 6, r = lane & 31, hh = lane >> 5;
    LAS bf16_t* Ks = (LAS bf16_t*)lds; LAS bf16_t* Vs = (LAS bf16_t*)(lds + 64 * KS_STRIDE * 2);
    const int qrow = qrow0 + 32 * w + r;
    bf16x8 qf[12];
#pragma unroll
    for (int ks = 0; ks < 12; ++ks) qf[ks] = *(const GAS bf16x8*)(Q + (size_t)qrow * 768 + 192 * h + 16 * ks + 8 * hh);
    {
        const int pos = row_pos(qrow); const GAS float* rt = (const GAS float*)(rope + (size_t)pos * 64);
#pragma unroll
        for (int half = 0; half < 2; ++half) { const GAS float* cs = rt + 2 * (16 * half + 8 * hh);
#pragma unroll
            for (int j = 0; j < 8; ++j) { const float c = cs[2 * j], sn = cs[2 * j + 1]; const float x1 = bf2f((bf16_t)qf[8 + half][j]), x2 = bf2f((bf16_t)qf[10 + half][j]);
                qf[8 + half][j] = (short)f2bf(x1 * c - x2 * sn); qf[10 + half][j] = (short)f2bf(x1 * sn + x2 * c); } }
    }
    float z0 = 0.f; asm volatile("" : "+v"(z0));
    f32x16 oacc[4];
#pragma unroll
    for (int i = 0; i < 4; ++i)
#pragma unroll
        for (int j = 0; j < 16; ++j) oacc[i][j] = z0;
    float mrun = -INFINITY, lsum = 0.f;
    const float sc = 0.07216878364870322f * 1.4426950408889634f;
    u32x4 kreg[3], vreg[2];
    const unsigned kn_off0 = (unsigned)(((tid >> 4) * 512 + h * 128 + (tid & 15) * 8) * 2), kn_off1 = kn_off0 + 32u * 512u * 2u;
    const unsigned kr_off = (unsigned)(((tid >> 3) * 64 + (tid & 7) * 8) * 2);
    const unsigned vt_off0 = (unsigned)((((size_t)(h * 128 + (tid >> 3))) * RP + (tid & 7) * 8) * 2), vt_off1 = vt_off0 + 64u * (unsigned)RP * 2u;
#define ATT_GLOAD(tt_) do { const int krow0_ = (tt_) == 0 ? RREAL : kbase + 64 * ((tt_) - 1); \
    const char* knb_ = (const char*)KN + (size_t)krow0_ * 1024; const char* krb_ = (const char*)KR + (size_t)krow0_ * 128; const char* vtb_ = (const char*)VT + (size_t)krow0_ * 2; \
    kreg[0] = *(const GAS u32x4*)(knb_ + kn_off0); kreg[1] = *(const GAS u32x4*)(knb_ + kn_off1); kreg[2] = *(const GAS u32x4*)(krb_ + kr_off); \
    vreg[0] = *(const GAS u32x4*)(vtb_ + vt_off0); vreg[1] = *(const GAS u32x4*)(vtb_ + vt_off1); } while (0)
    ATT_GLOAD(0);
    for (int tt = 0; tt < ntile; ++tt) {
#ifdef PROBE_ATT_STAGE2
        __syncthreads();
        *(LAS u32x4*)(Ks + (tid >> 4) * KS_STRIDE + (tid & 15) * 8) = kreg[0]; *(LAS u32x4*)(Ks + (32 + (tid >> 4)) * KS_STRIDE + (tid & 15) * 8) = kreg[1];
        *(LAS u32x4*)(Ks + (tid >> 3) * KS_STRIDE + 128 + (tid & 7) * 8) = kreg[2];
#pragma unroll
        for (int i = 0; i < 2; ++i) {
            LAS u32x2* d = (LAS u32x2*)(Vs + ((tid >> 3) + 64 * i) * VS_STRIDE + ((tid & 7) >> 1) * 16 + (tid & 1) * 4);
            u32x2 lo; lo.x = vreg[i].x; lo.y = vreg[i].y; u32x2 hi; hi.x = vreg[i].z; hi.y = vreg[i].w; d[0] = lo; d[2] = hi; }
        __syncthreads();
#endif
        __syncthreads();
        *(LAS u32x4*)(Ks + (tid >> 4) * KS_STRIDE + (tid & 15) * 8) = kreg[0]; *(LAS u32x4*)(Ks + (32 + (tid >> 4)) * KS_STRIDE + (tid & 15) * 8) = kreg[1];
        *(LAS u32x4*)(Ks + (tid >> 3) * KS_STRIDE + 128 + (tid & 7) * 8) = kreg[2];
#pragma unroll
        for (int i = 0; i < 2; ++i) {
            LAS u32x2* d = (LAS u32x2*)(Vs + ((tid >> 3) + 64 * i) * VS_STRIDE + ((tid & 7) >> 1) * 16 + (tid & 1) * 4);
            u32x2 lo; lo.x = vreg[i].x; lo.y = vreg[i].y; u32x2 hi; hi.x = vreg[i].z; hi.y = vreg[i].w; d[0] = lo; d[2] = hi; }
        __syncthreads();
        const bool comp = wave_active && tt <= wlim;
        if (tt + 1 < ntile) ATT_GLOAD(tt + 1);
        if (comp) {
            f32x16 sacc[2];
#pragma unroll
            for (int b = 0; b < 2; ++b)
#pragma unroll
                for (int j = 0; j < 16; ++j) sacc[b][j] = z0;
#ifdef PROBE_ATT_QK2
            {
            __builtin_amdgcn_sched_barrier(0);
            {
                const LAS bf16_t* kb0 = Ks + r * KS_STRIDE + 8 * hh;
                bf16x8 kf[6];
#pragma unroll
                for (int i = 0; i < 6; ++i) kf[i] = *(const LAS bf16x8*)(kb0 + 16 * i);
#pragma unroll
                for (int i = 0; i < 24; ++i) { sacc[i / 12] = __builtin_amdgcn_mfma_f32_32x32x16_bf16(kf[i % 6], qf[i % 12], sacc[i / 12], 0, 0, 0);
                    if (i + 6 < 24) kf[i % 6] = *(const LAS bf16x8*)(kb0 + ((i + 6) / 12) * 32 * KS_STRIDE + 16 * ((i + 6) % 12)); }
                __builtin_amdgcn_sched_group_barrier(0x100, 6, 0);
#pragma unroll
                for (int i = 0; i < 18; ++i) { __builtin_amdgcn_sched_group_barrier(0x008, 1, 0); __builtin_amdgcn_sched_group_barrier(0x100, 1, 0); }
                __builtin_amdgcn_sched_group_barrier(0x008, 6, 0);
            }
            __builtin_amdgcn_sched_barrier(0);
                asm volatile("" : "+v"(sacc[0][0]), "+v"(sacc[1][0]));
#pragma unroll
                for (int b = 0; b < 2; ++b)
#pragma unroll
                    for (int j = 0; j < 16; ++j) sacc[b][j] = z0;
            }
#endif
            __builtin_amdgcn_sched_barrier(0);
            {
                const LAS bf16_t* kb0 = Ks + r * KS_STRIDE + 8 * hh;
                bf16x8 kf[6];
#pragma unroll
                for (int i = 0; i < 6; ++i) kf[i] = *(const LAS bf16x8*)(kb0 + 16 * i);
#pragma unroll
                for (int i = 0; i < 24; ++i) { sacc[i / 12] = __builtin_amdgcn_mfma_f32_32x32x16_bf16(kf[i % 6], qf[i % 12], sacc[i / 12], 0, 0, 0);
                    if (i + 6 < 24) kf[i % 6] = *(const LAS bf16x8*)(kb0 + ((i + 6) / 12) * 32 * KS_STRIDE + 16 * ((i + 6) % 12)); }
                __builtin_amdgcn_sched_group_barrier(0x100, 6, 0);
#pragma unroll
                for (int i = 0; i < 18; ++i) { __builtin_amdgcn_sched_group_barrier(0x008, 1, 0); __builtin_amdgcn_sched_group_barrier(0x100, 1, 0); }
                __builtin_amdgcn_sched_group_barrier(0x008, 6, 0);
            }
            __builtin_amdgcn_sched_barrier(0);
            if (tt == 0) {
#pragma unroll
                for (int j = 8; j < 16; ++j) sacc[0][j] = -INFINITY;
#pragma unroll
                for (int j = 0; j < 16; ++j) sacc[1][j] = -INFINITY; }
            float tmax = fmaxf(sacc[0][0], sacc[1][0]);
#pragma unroll
            for (int j = 1; j < 16; ++j) tmax = fmaxf(tmax, fmaxf(sacc[0][j], sacc[1][j]));
            tmax = fmaxf(tmax, __int_as_float(__builtin_amdgcn_ds_bpermute((lane ^ 32) << 2, __float_as_int(tmax)))) * sc;
            const float mnew = fmaxf(mrun, tmax); const float alpha = __builtin_amdgcn_exp2f(mrun - mnew); mrun = mnew;
            float psum = 0.f;
#pragma unroll
            for (int b = 0; b < 2; ++b)
#pragma unroll
                for (int j = 0; j < 16; ++j) { const float p = __builtin_amdgcn_exp2f(__builtin_fmaf(sacc[b][j], sc, -mnew)); sacc[b][j] = p; psum += p; }
            lsum = lsum * alpha + psum;
            if (__builtin_amdgcn_ballot_w64(alpha != 1.0f) != 0ull) {
#pragma unroll
            for (int i = 0; i < 4; ++i)
#pragma unroll
                for (int j = 0; j < 16; ++j) oacc[i][j] *= alpha; }
            bf16x8 pf[4];
            pf[0] = pack8(sacc[0], 0); pf[1] = pack8(sacc[0], 1); pf[2] = pack8(sacc[1], 0); pf[3] = pack8(sacc[1], 1);
#ifdef PROBE_ATT_PV2
            {
                const LAS bf16_t* vb0 = Vs + r * VS_STRIDE + 8 * hh;
#pragma unroll
                for (int j = 0; j < 16; ++j) { sacc[0][j] = z0; sacc[1][j] = z0; }
#pragma unroll
                for (int i = 0; i < 16; ++i) { const bf16x8 vfd = *(const LAS bf16x8*)(vb0 + 32 * (i >> 2) * VS_STRIDE + 16 * (i & 3));
                    sacc[i & 1] = __builtin_amdgcn_mfma_f32_32x32x16_bf16(vfd, pf[i & 3], sacc[i & 1], 0, 0, 0); }
                asm volatile("" :: "v"(sacc[0][0]), "v"(sacc[1][0]));
            }
#endif
            __builtin_amdgcn_sched_barrier(0);
            {
                const LAS bf16_t* vb0 = Vs + r * VS_STRIDE + 8 * hh;
                bf16x8 vf[16];
#pragma unroll
                for (int i = 0; i < 16; ++i) vf[i] = *(const LAS bf16x8*)(vb0 + 32 * (i >> 2) * VS_STRIDE + 16 * (i & 3));
#pragma unroll
                for (int i = 0; i < 16; ++i) oacc[i >> 2] = __builtin_amdgcn_mfma_f32_32x32x16_bf16(vf[i], pf[i & 3], oacc[i >> 2], 0, 0, 0);
                __builtin_amdgcn_sched_group_barrier(0x100, 8, 1);
#pragma unroll
                for (int i = 0; i < 8; ++i) { __builtin_amdgcn_sched_group_barrier(0x008, 1, 1); __builtin_amdgcn_sched_group_barrier(0x100, 1, 1); }
                __builtin_amdgcn_sched_group_barrier(0x008, 8, 1);
            }
            __builtin_amdgcn_sched_barrier(0);
        }
    }
    if (wave_active) {
        const float ltot = lsum + __int_as_float(__builtin_amdgcn_ds_bpermute((lane ^ 32) << 2, __float_as_int(lsum))); const float inv = 1.0f / ltot;
        bf16_t* orow = MIX + (size_t)qrow * D + 128 * h;
#pragma unroll
        for (int dvb = 0; dvb < 4; ++dvb)
#pragma unroll
            for (int g = 0; g < 4; ++g) { u32x2 o; o.x = cvtpk(oacc[dvb][4 * g] * inv, oacc[dvb][4 * g + 1] * inv); o.y = cvtpk(oacc[dvb][4 * g + 2] * inv, oacc[dvb][4 * g + 3] * inv);
                *(GAS u32x2*)(orow + 32 * dvb + 8 * g + 4 * hh) = o; }
    }
    __syncthreads();
}
__device__ __forceinline__ void attn_phase(LAS unsigned char* lds, const bf16_t* Q, const bf16_t* KN, const bf16_t* KR, const bf16_t* VT, bf16_t* MIX, const float* rope, int bid, int nblk) {
    const int w = opq(threadIdx.x) >> 6;
    for (int s = bid; s < 512; s += nblk) {
        const int round = s >> 8, x = s & 255; const int bh = (x >> 4) + 16 * round, qb = round ? 15 - (x & 15) : (x & 15);
        const int b = bh >> 2, h = bh & 3;
        attn_unit(lds, Q, KN, KR, VT, MIX, rope, h, b * SEQ + 256 * qb, b * SEQ, 4 * qb + 5, 4 * qb + (w >> 1) + 1, true);
    }
    for (int s = bid; s < 4; s += nblk)
        attn_unit(lds, Q, KN, KR, VT, MIX, rope, s, RREAL, 0, 1, 0, w == 0);
}

constexpr int CLS = 72;
constexpr int CSLOT = 64 * CLS * 2;
constexpr int CHK_BYTES = 32768;
constexpr int NSEQ_HALF0 = 257;
struct CpP { const bf16_t* PR; const bf16_t* LO; const bf16_t* VMIX; const bf16_t* VFIRST; bf16_t* VP; float* RK; unsigned char* CHK;
    const float *mu, *w0, *a0, *k_k, *k_a, *r_k, *v0; int layer, pad; };

__device__ __forceinline__ void mm64(f32x16& acc, const LAS bf16_t* a, const LAS bf16_t* b, int r, int hh) {
    bf16x8 af[4], bf[4];
#pragma unroll
    for (int ks = 0; ks < 4; ++ks) { af[ks] = *(const LAS bf16x8*)(a + r * CLS + 16 * ks + 8 * hh); bf[ks] = *(const LAS bf16x8*)(b + r * CLS + 16 * ks + 8 * hh); }
#pragma unroll
    for (int ks = 0; ks < 4; ++ks) acc = __builtin_amdgcn_mfma_f32_32x32x16_bf16(af[ks], bf[ks], acc, 0, 0, 0);
}
__device__ __forceinline__ void st_tile(const f32x16& acc, LAS bf16_t* dst, int m0, int n0, int r, int hh) {
#pragma unroll
    for (int q = 0; q < 16; ++q) dst[(m0 + (q & 3) + 8 * (q >> 2) + 4 * hh) * CLS + n0 + r] = f2bf_hw(acc[q]);
}
__device__ __forceinline__ void st_tile_t(const f32x16& acc, LAS bf16_t* dst, int m0, int n0, int r, int hh) {
#pragma unroll
    for (int g = 0; g < 4; ++g) { u32x2 o; o.x = cvtpk(acc[4 * g], acc[4 * g + 1]); o.y = cvtpk(acc[4 * g + 2], acc[4 * g + 3]);
        *(LAS u32x2*)(dst + (n0 + r) * CLS + m0 + 8 * g + 4 * hh) = o; }
}
__device__ __forceinline__ void zero16(f32x16& a, float z) {
#pragma unroll
    for (int q = 0; q < 16; ++q) a[q] = z;
}
struct CpRaw { bf16_t xr[9], xk[9], xv[9], lw[8], la[8], vm[8], vf[8]; float mu_r, mu_k, mu_v, w0, a0, kkc, kac, rkc, v0, pm0; };
__device__ __forceinline__ void cp_issue(const CpP& P, int row0, int hd, int w, int lane, CpRaw& R) {
    const int c = hd * 64 + lane;
    R.mu_r = ((const GAS float*)P.mu)[c]; R.mu_k = ((const GAS float*)P.mu)[512 + c]; R.mu_v = ((const GAS float*)P.mu)[1024 + c]; R.w0 = ((const GAS float*)P.w0)[c]; R.a0 = ((const GAS float*)P.a0)[c];
    R.kkc = ((const GAS float*)P.k_k)[c]; R.kac = ((const GAS float*)P.k_a)[c]; R.rkc = ((const GAS float*)P.r_k)[c]; R.v0 = P.layer ? ((const GAS float*)P.v0)[c] : 0.f;
    const int rw0 = row0 + 8 * w; const int prow0 = w == 0 ? row_prev(row0) : rw0 - 1; R.pm0 = prow0 < 0 ? 0.f : 1.f;
    { const GAS bf16_t* xp = (const GAS bf16_t*)(P.PR + (size_t)(prow0 < 0 ? rw0 : prow0) * PRW); R.xr[0] = xp[c]; R.xk[0] = xp[512 + c]; R.xv[0] = xp[1024 + c]; }
#pragma unroll
    for (int q = 0; q < 8; ++q) { const GAS bf16_t* x = (const GAS bf16_t*)(P.PR + (size_t)(rw0 + q) * PRW); R.xr[q + 1] = x[c]; R.xk[q + 1] = x[512 + c]; R.xv[q + 1] = x[1024 + c];
        const GAS bf16_t* lo = (const GAS bf16_t*)(P.LO + (size_t)(rw0 + q) * 1536); R.lw[q] = lo[c]; R.la[q] = lo[512 + c];
        if (P.layer) { R.vm[q] = ((const GAS bf16_t*)P.VMIX)[(size_t)(rw0 + q) * 512 + c]; R.vf[q] = ((const GAS bf16_t*)P.VFIRST)[(size_t)(rw0 + q) * 512 + c]; } else { R.vm[q] = 0; R.vf[q] = 0; } }
}
__device__ __forceinline__ void rwkv_cp_task(LAS unsigned char* lds, const CpP& P, int row0, int hd, unsigned char* out, CpRaw& R, bool has_next, int nrow0, int nhd) {
    const int tid = opq(threadIdx.x), lane = tid & 63, w = __builtin_amdgcn_readfirstlane(tid >> 6), r = lane & 31, hh = lane >> 5;
    float z0 = 0.f; asm volatile("" : "+v"(z0));
    LAS bf16_t* S_ATtm = (LAS bf16_t*)(lds + 0 * CSLOT);
    LAS bf16_t* S_BHtm = (LAS bf16_t*)(lds + 1 * CSLOT);
    LAS bf16_t* S_KHtm = (LAS bf16_t*)(lds + 2 * CSLOT);
    LAS bf16_t* S_RTtm = (LAS bf16_t*)(lds + 3 * CSLOT);
    LAS bf16_t* S_ATcm = (LAS bf16_t*)(lds + 4 * CSLOT);
    LAS bf16_t* S_BBcm = (LAS bf16_t*)(lds + 5 * CSLOT);
    LAS bf16_t* S_KBcm = (LAS bf16_t*)(lds + 6 * CSLOT);
    LAS bf16_t* S_VTcm = (LAS bf16_t*)(lds + 7 * CSLOT);
    LAS bf16_t* S_Q0a = (LAS bf16_t*)(lds + 8 * CSLOT);
    LAS bf16_t* S_Q0b = (LAS bf16_t*)(lds + 9 * CSLOT);
    LAS bf16_t* S_PP0 = (LAS bf16_t*)(lds + 10 * CSLOT);
    LAS bf16_t* S_Na = (LAS bf16_t*)(lds + 11 * CSLOT);
    LAS bf16_t* S_XT = (LAS bf16_t*)(lds + 12 * CSLOT);
    LAS bf16_t* S_Pa = (LAS bf16_t*)(lds + 13 * CSLOT);
    LAS bf16_t* S_Qa = (LAS bf16_t*)(lds + 14 * CSLOT);
    LAS float* S_TOT = (LAS float*)(lds + 15 * CSLOT);
    LAS bf16_t* Qa[2] = {S_Q0a, S_ATtm}; LAS bf16_t* Qb[2] = {S_Q0b, S_BHtm}; LAS bf16_t* PPa[2] = {S_PP0, S_KHtm};

    {
        const int c = hd * 64 + lane;
        const float mu_r = R.mu_r, mu_k = R.mu_k, mu_v = R.mu_v, w0 = R.w0, a0 = R.a0, kkc = R.kkc, kac = R.kac, rkc = R.rkc, v0 = R.v0, pm0 = R.pm0;
        float fr[8], fk[8], fv[8], fa[8], fb[8], lw[8];
        const int rw0 = row0 + 8 * w;
#pragma unroll
        for (int q = 0; q < 8; ++q) { const int row = rw0 + q; const bool valid = row < RVALID; const float pm = q == 0 ? pm0 : 1.f;
            float rr = bf2f(R.xr[q + 1]), kk = bf2f(R.xk[q + 1]), vv = bf2f(R.xv[q + 1]);
            rr = rr + (pm * bf2f(R.xr[q]) - rr) * mu_r; kk = kk + (pm * bf2f(R.xk[q]) - kk) * mu_k; vv = vv + (pm * bf2f(R.xv[q]) - vv) * mu_v;
            const float wpre = bf2f(R.lw[q]), apre = bf2f(R.la[q]);
            constexpr float L2E = 1.4426950408889634f;
            float lwv = -0.6065306597126334f * __builtin_amdgcn_rcpf(1.0f + __builtin_amdgcn_exp2f(-(w0 + wpre) * L2E));
            const float asig = __builtin_amdgcn_rcpf(1.0f + __builtin_amdgcn_exp2f(-(a0 + apre) * L2E));
            if (P.layer) { const float vm = bf2f(R.vm[q]), vf = bf2f(R.vf[q]); vv = vv + (vf - vv) * __builtin_amdgcn_rcpf(1.0f + __builtin_amdgcn_exp2f(-(v0 + vm) * L2E)); }
            const float kkr = kk * kkc; const float ss = wave_sum(kkr * kkr); float kn = kkr * rsqrtf(fmaxf(ss, 1e-24f));
            float k2 = kk * (1.f + (asig - 1.f) * kac);
            const float rk = wave_sum(rr * k2 * rkc);
            if (!valid) { rr = 0.f; k2 = 0.f; vv = 0.f; kn = 0.f; lwv = 0.f; }
            ((GAS bf16_t*)P.VP)[(size_t)row * 512 + c] = f2bf_hw(vv); if (lane == 0) ((GAS float*)P.RK)[(size_t)row * 8 + hd] = valid ? rk : 0.f;
            fr[q] = rr; fk[q] = k2; fv[q] = vv; fa[q] = -kn; fb[q] = kn * asig; lw[q] = lwv; }
        if (has_next) cp_issue(P, nrow0, nhd, w, lane, R);
        float cum[8]; cum[0] = lw[0];
#pragma unroll
        for (int q = 1; q < 8; ++q) cum[q] = cum[q - 1] + lw[q];
        S_TOT[w * 64 + lane] = cum[7];
        lds_barrier();
        float off = 0.f, tot = 0.f;
#pragma unroll
        for (int ww = 0; ww < 8; ++ww) { const float tv = S_TOT[ww * 64 + lane]; off += ww < w ? tv : 0.f; tot += tv; }
        constexpr float L2E_ = 1.4426950408889634f;
        const float etot = __builtin_amdgcn_exp2f(tot * L2E_);
        if (w == 0) S_TOT[512 + lane] = etot;
        float at[8], bh[8], kh[8], rt[8], bb[8], kb[8];
        float ecprev = __builtin_amdgcn_exp2f(off * L2E_);
#pragma unroll
        for (int q = 0; q < 8; ++q) { const float ci = off + cum[q]; const float ec = __builtin_amdgcn_exp2f(ci * L2E_), ecp = ecprev, en = __builtin_amdgcn_rcpf(ec), ee = etot * en; ecprev = ec;
            rt[q] = fr[q] * ec; at[q] = fa[q] * ecp; bh[q] = fb[q] * en; kh[q] = fk[q] * en; bb[q] = fb[q] * ee; kb[q] = fk[q] * ee; }
#pragma unroll
        for (int q = 0; q < 8; ++q) { const int t = 8 * w + q; S_ATtm[t * CLS + lane] = f2bf_hw(at[q]); S_BHtm[t * CLS + lane] = f2bf_hw(bh[q]); S_KHtm[t * CLS + lane] = f2bf_hw(kh[q]); S_RTtm[t * CLS + lane] = f2bf_hw(rt[q]); }
        { u32x4 o;
          o.x = cvtpk(at[0], at[1]); o.y = cvtpk(at[2], at[3]); o.z = cvtpk(at[4], at[5]); o.w = cvtpk(at[6], at[7]); *(LAS u32x4*)(S_ATcm + lane * CLS + 8 * w) = o;
          o.x = cvtpk(bb[0], bb[1]); o.y = cvtpk(bb[2], bb[3]); o.z = cvtpk(bb[4], bb[5]); o.w = cvtpk(bb[6], bb[7]); *(LAS u32x4*)(S_BBcm + lane * CLS + 8 * w) = o;
          o.x = cvtpk(kb[0], kb[1]); o.y = cvtpk(kb[2], kb[3]); o.z = cvtpk(kb[4], kb[5]); o.w = cvtpk(kb[6], kb[7]); *(LAS u32x4*)(S_KBcm + lane * CLS + 8 * w) = o;
          o.x = cvtpk(fv[0], fv[1]); o.y = cvtpk(fv[2], fv[3]); o.z = cvtpk(fv[4], fv[5]); o.w = cvtpk(fv[6], fv[7]); *(LAS u32x4*)(S_VTcm + lane * CLS + 8 * w) = o; }
    }
    lds_barrier();
    const int q4 = w & 3, mb = q4 >> 1, nb = q4 & 1; const bool upper = (mb == 0 && nb == 1);
    f32x16 pacc;
    {
        f32x16 a0, a1; zero16(a0, z0); zero16(a1, z0);
        const LAS bf16_t* lhs = (w < 4 ? S_ATtm : S_RTtm) + 32 * mb * CLS;
        if (!upper) { mm64(a0, lhs, S_BHtm + 32 * nb * CLS, r, hh); mm64(a1, lhs, S_KHtm + 32 * nb * CLS, r, hh); }
        const int s = 32 * nb + r;
#pragma unroll
        for (int q = 0; q < 16; ++q) { const int t = 32 * mb + (q & 3) + 8 * (q >> 2) + 4 * hh; const bool keep = w < 4 ? (s < t) : (s <= t); if (!keep) { a0[q] = z0; a1[q] = z0; } }
        if (w < 4) { st_tile(a0, S_Q0a, 32 * mb, 32 * nb, r, hh); st_tile_t(a0, S_Q0b, 32 * mb, 32 * nb, r, hh); st_tile(a1, S_Na, 32 * mb, 32 * nb, r, hh);
            pacc = a0;
#pragma unroll
            for (int q = 0; q < 16; ++q) { const int t = 32 * mb + (q & 3) + 8 * (q >> 2) + 4 * hh; if (t == s) pacc[q] += 1.0f; }
            st_tile(pacc, S_PP0, 32 * mb, 32 * nb, r, hh); }
        else { st_tile(a0, S_Pa, 32 * mb, 32 * nb, r, hh); st_tile(a1, S_Qa, 32 * mb, 32 * nb, r, hh); zero16(pacc, z0); }
    }
    lds_barrier();
    {
        f32x16 a; zero16(a, z0);
        if (w >= 4) { if (!upper) { mm64(a, Qa[0] + 32 * mb * CLS, Qb[0] + 32 * nb * CLS, r, hh); } st_tile(a, Qa[1], 32 * mb, 32 * nb, r, hh); st_tile_t(a, Qb[1], 32 * mb, 32 * nb, r, hh); }
        else { mm64(a, S_Na + 32 * mb * CLS, S_VTcm + 32 * nb * CLS, r, hh); st_tile_t(a, S_XT, 32 * mb, 32 * nb, r, hh); }
    }
    lds_barrier();
#pragma unroll 1
    for (int k = 1; k <= 5; ++k) {
        const int rs = k & 1, ws_ = rs ^ 1;
        if (w < 4) { if (!upper) mm64(pacc, PPa[ws_] + 32 * mb * CLS, Qb[rs] + 32 * nb * CLS, r, hh); st_tile(pacc, PPa[rs], 32 * mb, 32 * nb, r, hh); }
        else if (k < 5) { f32x16 a; zero16(a, z0); if (!upper) mm64(a, Qa[rs] + 32 * mb * CLS, Qb[rs] + 32 * nb * CLS, r, hh); st_tile(a, Qa[ws_], 32 * mb, 32 * nb, r, hh); st_tile_t(a, Qb[ws_], 32 * mb, 32 * nb, r, hh); }
        lds_barrier();
    }
    {
        f32x16 a; zero16(a, z0);
        mm64(a, PPa[1] + 32 * mb * CLS, (w < 4 ? S_ATcm : S_XT) + 32 * nb * CLS, r, hh);
        st_tile_t(a, w < 4 ? S_Q0a : S_Q0b, 32 * mb, 32 * nb, r, hh);
    }
    lds_barrier();
    {
        LAS bf16_t* W1T = S_Q0a; LAS bf16_t* U1T = S_Q0b;
        f32x16 a, b; zero16(a, z0); zero16(b, z0);
        GAS u32x4* o128 = (GAS u32x4*)out;
        if (w < 4) {
            mm64(a, S_BBcm + 32 * mb * CLS, U1T + 32 * nb * CLS, r, hh); mm64(a, S_KBcm + 32 * mb * CLS, S_VTcm + 32 * nb * CLS, r, hh);
            mm64(b, W1T + 32 * mb * CLS, S_BBcm + 32 * nb * CLS, r, hh);
            const float gam = S_TOT[512 + 32 * nb + r];
#pragma unroll
            for (int q = 0; q < 16; ++q) { const int j = 32 * mb + (q & 3) + 8 * (q >> 2) + 4 * hh; if (j == 32 * nb + r) b[q] += gam; }
            u32x4 h0, h1, g0, g1;
            h0.x = cvtpk(a[0], a[1]); h0.y = cvtpk(a[2], a[3]); h0.z = cvtpk(a[4], a[5]); h0.w = cvtpk(a[6], a[7]);
            h1.x = cvtpk(a[8], a[9]); h1.y = cvtpk(a[10], a[11]); h1.z = cvtpk(a[12], a[13]); h1.w = cvtpk(a[14], a[15]);
            g0.x = cvtpk(b[0], b[1]); g0.y = cvtpk(b[2], b[3]); g0.z = cvtpk(b[4], b[5]); g0.w = cvtpk(b[6], b[7]);
            g1.x = cvtpk(b[8], b[9]); g1.y = cvtpk(b[10], b[11]); g1.z = cvtpk(b[12], b[13]); g1.w = cvtpk(b[14], b[15]);
            o128[1024 + ((mb * 2 + nb) * 64 + lane) * 2] = h0; o128[1024 + ((mb * 2 + nb) * 64 + lane) * 2 + 1] = h1;
            o128[(nb * 4 + 2 * mb) * 64 + lane] = g0; o128[(nb * 4 + 2 * mb + 1) * 64 + lane] = g1;
        } else {
            mm64(a, S_Pa + 32 * mb * CLS, U1T + 32 * nb * CLS, r, hh); mm64(a, S_Qa + 32 * mb * CLS, S_VTcm + 32 * nb * CLS, r, hh);
            mm64(b, W1T + 32 * mb * CLS, S_Pa + 32 * nb * CLS, r, hh);
#pragma unroll
            for (int g = 0; g < 4; ++g) { const s16x4 rv = *(const LAS s16x4*)(S_RTtm + (32 * nb + r) * CLS + 32 * mb + 8 * g + 4 * hh);
#pragma unroll
                for (int e = 0; e < 4; ++e) b[4 * g + e] += bf2f((bf16_t)rv[e]); }
            u32x4 y0, y1, r0, r1;
            y0.x = cvtpk(a[0], a[1]); y0.y = cvtpk(a[2], a[3]); y0.z = cvtpk(a[4], a[5]); y0.w = cvtpk(a[6], a[7]);
            y1.x = cvtpk(a[8], a[9]); y1.y = cvtpk(a[10], a[11]); y1.z = cvtpk(a[12], a[13]); y1.w = cvtpk(a[14], a[15]);
            r0.x = cvtpk(b[0], b[1]); r0.y = cvtpk(b[2], b[3]); r0.z = cvtpk(b[4], b[5]); r0.w = cvtpk(b[6], b[7]);
            r1.x = cvtpk(b[8], b[9]); r1.y = cvtpk(b[10], b[11]); r1.z = cvtpk(b[12], b[13]); r1.w = cvtpk(b[14], b[15]);
            o128[1536 + ((mb * 2 + nb) * 64 + lane) * 2] = y0; o128[1536 + ((mb * 2 + nb) * 64 + lane) * 2 + 1] = y1;
            o128[512 + (nb * 4 + 2 * mb) * 64 + lane] = r0; o128[512 + (nb * 4 + 2 * mb + 1) * 64 + lane] = r1;
        }
    }
    lds_barrier();
}

struct ScP { const unsigned char* CHK; bf16_t* YS; };
__device__ __forceinline__ void scan_unpack16(f32x16& acc, const u32x4 y0, const u32x4 y1) {
    acc[0] = __uint_as_float(y0.x << 16); acc[1] = __uint_as_float(y0.x & 0xffff0000u); acc[2] = __uint_as_float(y0.y << 16); acc[3] = __uint_as_float(y0.y & 0xffff0000u);
    acc[4] = __uint_as_float(y0.z << 16); acc[5] = __uint_as_float(y0.z & 0xffff0000u); acc[6] = __uint_as_float(y0.w << 16); acc[7] = __uint_as_float(y0.w & 0xffff0000u);
    acc[8] = __uint_as_float(y1.x << 16); acc[9] = __uint_as_float(y1.x & 0xffff0000u); acc[10] = __uint_as_float(y1.y << 16); acc[11] = __uint_as_float(y1.y & 0xffff0000u);
    acc[12] = __uint_as_float(y1.z << 16); acc[13] = __uint_as_float(y1.z & 0xffff0000u); acc[14] = __uint_as_float(y1.w << 16); acc[15] = __uint_as_float(y1.w & 0xffff0000u);
}
__device__ __forceinline__ void scan_step(const LAS unsigned char* sl, LAS float* ybuf, f32x16 (&st)[2], int w, int lane, int r, int hh) {
    bf16x8 ar[2][4], ag[2][4]; u32x4 yi[2][2], hi[2][2];
#pragma unroll
    for (int tb = 0; tb < 2; ++tb) { const LAS u32x4* yf = (const LAS u32x4*)(sl + 24576) + ((tb * 2 + w) * 64 + lane) * 2; yi[tb][0] = yf[0]; yi[tb][1] = yf[1];
        const LAS u32x4* hf = (const LAS u32x4*)(sl + 16384) + ((tb * 2 + w) * 64 + lane) * 2; hi[tb][0] = hf[0]; hi[tb][1] = hf[1];
#pragma unroll
        for (int ks = 0; ks < 4; ++ks) { ar[tb][ks] = *(const LAS bf16x8*)(sl + 8192 + ((tb * 4 + ks) * 64 + lane) * 16); ag[tb][ks] = *(const LAS bf16x8*)(sl + ((tb * 4 + ks) * 64 + lane) * 16); } }
    bf16x8 sf[4];
    sf[0] = pack8(st[0], 0); sf[1] = pack8(st[0], 1); sf[2] = pack8(st[1], 0); sf[3] = pack8(st[1], 1);
    f32x16 ya[2], sa[2];
#pragma unroll
    for (int tb = 0; tb < 2; ++tb) { scan_unpack16(ya[tb], yi[tb][0], yi[tb][1]); scan_unpack16(sa[tb], hi[tb][0], hi[tb][1]); }
#pragma unroll
    for (int ks = 0; ks < 4; ++ks) {
        ya[0] = __builtin_amdgcn_mfma_f32_32x32x16_bf16(ar[0][ks], sf[ks], ya[0], 0, 0, 0); ya[1] = __builtin_amdgcn_mfma_f32_32x32x16_bf16(ar[1][ks], sf[ks], ya[1], 0, 0, 0);
        sa[0] = __builtin_amdgcn_mfma_f32_32x32x16_bf16(ag[0][ks], sf[ks], sa[0], 0, 0, 0); sa[1] = __builtin_amdgcn_mfma_f32_32x32x16_bf16(ag[1][ks], sf[ks], sa[1], 0, 0, 0); }
    st[0] = sa[0]; st[1] = sa[1];
#pragma unroll
    for (int tb = 0; tb < 2; ++tb)
#pragma unroll
        for (int q = 0; q < 16; ++q) ybuf[(32 * tb + (q & 3) + 8 * (q >> 2) + 4 * hh) * 64 + 32 * w + r] = ya[tb][q];
}
__device__ __forceinline__ void rwkv_scan_unit(LAS unsigned char* lds, const ScP& P, int seq0, int seqm, int nmeta, int nreal, int brow0, int hd, bool write_meta, const float* st_in, float* st_out) {
    const int tid = opq(threadIdx.x), lane = tid & 63, w = __builtin_amdgcn_readfirstlane(tid >> 6), r = lane & 31, hh = lane >> 5;
    const int N = nmeta + nreal;
    float z0 = 0.f; asm volatile("" : "+v"(z0));
    LAS float* ybuf = (LAS float*)(lds + 65536);
    f32x16 st[2]; zero16(st[0], z0); zero16(st[1], z0);
    if (st_in != nullptr && w < 2) { const GAS f32x4* sp = (const GAS f32x4*)(st_in + ((size_t)w * 64 + lane) * 32);
#pragma unroll
        for (int i = 0; i < 8; ++i) { const f32x4 v = sp[i];
#pragma unroll
            for (int j = 0; j < 4; ++j) st[i >> 2][4 * (i & 3) + j] = v[j]; } }
    const int c = hd * 64 + lane;
#define SCAN_SRC(n_) ((const GAS u32x4*)(P.CHK + ((size_t)((n_) < nmeta ? seqm : seq0 + (n_) - nmeta) * 8 + hd) * CHK_BYTES))
    u32x4 pa[4], pb[4], pc[4];
    { const GAS u32x4* s0 = SCAN_SRC(0); const GAS u32x4* s1 = SCAN_SRC(1); const GAS u32x4* s2 = SCAN_SRC(2);
#pragma unroll
      for (int i = 0; i < 4; ++i) pc[i] = s0[tid + 512 * i];
#pragma unroll
      for (int i = 0; i < 4; ++i) pa[i] = s1[tid + 512 * i];
#pragma unroll
      for (int i = 0; i < 4; ++i) pb[i] = s2[tid + 512 * i];
#pragma unroll
      for (int i = 0; i < 4; ++i) *(LAS u32x4*)(lds + (tid + 512 * i) * 16) = pc[i]; }
    lds_barrier();
#define SCAN_ITER(n_, PCUR, PMID, PNEXT) do { \
        const int n = (n_); \
        if (n + 3 < N) { const GAS u32x4* s3 = SCAN_SRC(n + 3); _Pragma("unroll") for (int i = 0; i < 4; ++i) PNEXT[i] = s3[tid + 512 * i]; } \
        if (w < 2) scan_step(lds + (n & 1) * 32768, ybuf, st, w, lane, r, hh); \
        lds_barrier(); \
        if (n + 1 < N) { _Pragma("unroll") for (int i = 0; i < 4; ++i) *(LAS u32x4*)(lds + ((n + 1) & 1) * 32768 + (tid + 512 * i) * 16) = PCUR[i]; } \
        if (w >= 2) { const int crow0 = n < nmeta ? RREAL : brow0 + 64 * (n - nmeta); const int nrow = n < nmeta ? (write_meta ? NMETA : 0) : 64; \
            for (int t = w - 2; t < nrow; t += 6) ((GAS bf16_t*)P.YS)[(size_t)(crow0 + t) * 512 + c] = f2bf_hw(ybuf[t * 64 + lane]); } \
        lds_barrier(); } while (0)
    int n3 = 0;
#pragma unroll 1
    for (; n3 + 3 <= N; n3 += 3) { SCAN_ITER(n3, pa, pb, pc); SCAN_ITER(n3 + 1, pb, pc, pa); SCAN_ITER(n3 + 2, pc, pa, pb); }
    if (N - n3 >= 1) SCAN_ITER(n3, pa, pb, pc);
    if (N - n3 >= 2) SCAN_ITER(n3 + 1, pb, pc, pa);
#undef SCAN_ITER
#undef SCAN_SRC
    if (st_out != nullptr && w < 2) { GAS f32x4* sp = (GAS f32x4*)(st_out + ((size_t)w * 64 + lane) * 32);
#pragma unroll
        for (int i = 0; i < 8; ++i) { f32x4 v;
#pragma unroll
            for (int j = 0; j < 4; ++j) v[j] = st[i >> 2][4 * (i & 3) + j];
            sp[i] = v; } }
}
struct PostP { const bf16_t* YS; const bf16_t* VP; const float* RK; const bf16_t* LO; bf16_t* MIX; const float *ln_w, *ln_b; };
__device__ __forceinline__ void rwkv_post(const PostP& P, int q, int rlo, int rhi, bool with_meta, int gw, int ngw, int lane) {
    lane = opq(lane);
    const int nreal = (rhi - rlo) * 8, ntot = nreal + (with_meta ? NMETA * 8 : 0);
    for (int item = gw; item < ntot; item += ngw) { const int ri = rlo + (item >> 3); const int row = item < nreal ? (ri >> 10) * SEQ + 1024 * q + (ri & 1023) : RREAL + ((item - nreal) >> 3); const int hd = item & 7, c = hd * 64 + lane;
        const float y = bf2f(P.YS[(size_t)row * 512 + c]); const float g = bf2f(P.LO[(size_t)row * 1536 + 1024 + c]), vp = bf2f(P.VP[(size_t)row * 512 + c]), rk = P.RK[(size_t)row * 8 + hd];
        const float mean = wave_sum(y) * (1.f / 64.f); const float d = y - mean; const float var = wave_sum(d * d) * (1.f / 64.f);
        const float yn = d * rsqrtf(var + GN_EPS) * P.ln_w[c] + P.ln_b[c];
        P.MIX[(size_t)row * D + 512 + c] = f2bf_hw((yn + rk * vp) * g); }
}

constexpr int LDS_BYTES = 147456, LDS_MISC = LDS_BYTES - 512;
struct Params { const float* in[33]; float* out; unsigned char* ws; };
constexpr int CW_BAR = 4096;


#ifndef PROBE_REP_MISC
#define PROBE_REP_MISC 1
#endif
#ifndef MOE_TAIL
#define MOE_TAIL 0
#endif
#ifndef PROBE_REP_OUTPROJ
#define PROBE_REP_OUTPROJ 1
#endif
#ifndef PROBE_REP_FFNDN
#define PROBE_REP_FFNDN 1
#endif
#ifndef PROBE_REP_MOEDN
#define PROBE_REP_MOEDN 1
#endif
#ifndef PROBE_REP_NORM
#define PROBE_REP_NORM 1
#endif
#ifndef PROBE_REP_INPROJ
#define PROBE_REP_INPROJ 1
#endif
#ifndef PROBE_REP_PREP
#define PROBE_REP_PREP 1
#endif
#ifndef PROBE_REP_P4A
#define PROBE_REP_P4A 1
#endif
#ifndef PROBE_REP_ATT
#define PROBE_REP_ATT 1
#endif
#ifndef PROBE_REP_P4B
#define PROBE_REP_P4B 1
#endif
#ifndef PROBE_REP_CP
#define PROBE_REP_CP 1
#endif
#ifndef PROBE_REP_SCAN
#define PROBE_REP_SCAN 1
#endif
#ifndef PROBE_REP_FFNGU
#define PROBE_REP_FFNGU 1
#endif
#ifndef PROBE_REP_MOETR
#define PROBE_REP_MOETR 1
#endif
#ifndef PROBE_REP_GATHER
#define PROBE_REP_GATHER 1
#endif
#ifndef PROBE_REP_MOEGU
#define PROBE_REP_MOEGU 1
#endif
#define LDP(k) ((const float*)ldk(kp, 8 * (k)))
#define OUTP ((float*)ldk(kp, 264))
#define WSP ((unsigned char*)ldk(kp, 272))
#define NOINL __device__ __attribute__((noinline))
#define WAVE_IDS() const int tid = threadIdx.x, lane = tid & 63, wave = __builtin_amdgcn_readfirstlane(tid >> 6), bid = (int)blockIdx.x, nblk = (int)gridDim.x, gw = bid * 8 + wave, ngw = nblk * 8; (void)lane; (void)gw; (void)ngw
NOINL void f_p0(unsigned long long kp_, LAS unsigned char* lds) {
    const unsigned long long kp = kp_uniform(kp_); WAVE_IDS(); LAS float* scr = (LAS float*)(lds + wave * 8448);
    {
        unsigned* ctl = (unsigned*)(WSP + WS_CTL);
#pragma unroll 1
        for (int te = wave; te < 24; te += 8) { const int t = te >> 3, e = te & 7;
            const float* wt = t == 0 ? LDP(30) : (t == 1 ? LDP(31) : LDP(32));
            const f32x4 v = ((const f32x4*)(wt + (size_t)e * ((size_t)D * FFE) + (size_t)(bid % 256) * 14336))[lane];
            const float m = wave_max(fmaxf(fmaxf(fabsf(v.x), fabsf(v.y)), fmaxf(fabsf(v.z), fabsf(v.w))));
            if (lane == 0) atomicMax(&ctl[CW_WMAX + te], __float_as_uint(m)); } }
    { unsigned char* ws = WSP;
      ph_init(LDP(0), LDP(1), OUTP, (float*)(ws + WS_HMETA), (float*)(ws + WS_ROPE), LDP(23), LDP(24), (bf16_t*)(ws + WS_V1T), (size_t)bid * 512 + tid, (size_t)nblk * 512); }
#pragma unroll 1
    for (int l = 0; l < 2; ++l) { unsigned char* lw = WSP + WS_WB + l * LW_STRIDE;
        { const TrJob J{LDP(5) + (size_t)l * D * 2624, nullptr, (bf16_t*)(lw + LW_WIN), D, 2624, 1024, 0, 1, 0}; ph_transpose(J, scr, gw, ngw, lane); }
        { const TrJob J{LDP(9) + (size_t)l * 512 * 768, LDP(7) + l * 512, (bf16_t*)(lw + LW_WUQ), 512, 768, 512, 0, 0, 0}; ph_transpose(J, scr, gw, ngw, lane); }
        { const TrJob J{LDP(10) + (size_t)l * 256 * 1024, LDP(8) + l * 256, (bf16_t*)(lw + LW_WK), 256, 1024, 256, 0, 4, 0}; ph_transpose(J, scr, gw, ngw, lane); }
        { const TrJob J{LDP(13) + (size_t)l * 64 * 512, nullptr, (bf16_t*)(lw + LW_LORA), 64, 512, 256, 0, 0, 0}; ph_transpose(J, scr, gw, ngw, lane); }
        { const TrJob J{LDP(15) + (size_t)l * 64 * 512, nullptr, (bf16_t*)(lw + LW_LORA), 64, 512, 256, 64, 0, 512}; ph_transpose(J, scr, gw, ngw, lane); }
        { const TrJob J{LDP(16) + (size_t)l * 128 * 512, nullptr, (bf16_t*)(lw + LW_LORA), 128, 512, 256, 128, 0, 1024}; ph_transpose(J, scr, gw, ngw, lane); }
        { const TrJob J{LDP(6) + (size_t)l * D * D, nullptr, (bf16_t*)(lw + LW_WOUT), D, D, 1024, 0, 0, 0}; ph_transpose(J, scr, gw, ngw, lane); }
    }
    { const TrJob J{LDP(25), nullptr, (bf16_t*)(WSP + WS_FGU), D, FF0, 1024, 0, 2, 0}; ph_transpose(J, scr, gw, ngw, lane); }
    { const TrJob J{LDP(26), nullptr, (bf16_t*)(WSP + WS_FGU), D, FF0, 1024, 0, 3, 0}; ph_transpose(J, scr, gw, ngw, lane); }
    { const TrJob J{LDP(27), nullptr, (bf16_t*)(WSP + WS_FDN), FF0, D, FF0, 0, 0, 0}; ph_transpose(J, scr, gw, ngw, lane); }
}
NOINL void f_rmsnorm(unsigned long long kp_, int which, int l) { const unsigned long long kp = kp_uniform(kp_); which = __builtin_amdgcn_readfirstlane(which); l = __builtin_amdgcn_readfirstlane(l); WAVE_IDS(); unsigned char* ws = WSP;
    const float* hsrc = (which == 0 && l == 0) ? LDP(0) : (const float*)OUTP;
    ph_rmsnorm(hsrc, (const float*)(ws + WS_HMETA), (which ? LDP(3) : LDP(2)) + l * D, (bf16_t*)(ws + A_U), (const float*)(ws + A_PART), which ? 4 : (l ? 11 : 0), gw, ngw, lane); }
NOINL void f_prep(unsigned long long kp_, int l) { const unsigned long long kp = kp_uniform(kp_); l = __builtin_amdgcn_readfirstlane(l); WAVE_IDS(); unsigned char* ws = WSP;
    ph_prep((const bf16_t*)(ws + A_PM), (const bf16_t*)(ws + A_PR), LDP(11) + l * 1792, (const float*)(ws + WS_ROPE), (float*)(ws + A_RSTDQ), (float*)(ws + A_RSTDKV),
            (bf16_t*)(ws + A_KROPE), (bf16_t*)(ws + A_LIN), (bf16_t*)(ws + A_VSH), l, gw, ngw, lane); }
constexpr int RW_NSEQ = 129;
constexpr size_t RW_BUF = (size_t)RW_NSEQ * 8 * CHK_BYTES;
static_assert(2 * RW_BUF <= A_VFIRST - A_CHK, "two chunk buffers fit the chunk region");
constexpr int RW_SKIP = 4;
__device__ __forceinline__ bool rw_is_scan_wg(int bid) { return (bid & 3) == 0; }
__device__ __forceinline__ int rw_rank(int bid) { return bid - (bid >> 2) - 1; }
__device__ __forceinline__ void f_rwkv_cp(unsigned long long kp_, LAS unsigned char* lds, int l, int q) {
    const unsigned long long kp = kp_uniform(kp_); l = __builtin_amdgcn_readfirstlane(l); q = __builtin_amdgcn_readfirstlane(q);
    const int bid = (int)blockIdx.x, nblk = (int)gridDim.x; unsigned char* ws = WSP;
    const CpP cp{(const bf16_t*)(ws + A_PR), (const bf16_t*)(ws + A_LOUT), (const bf16_t*)(ws + A_VMIX), (const bf16_t*)(ws + A_VFIRST), (bf16_t*)(ws + (l ? A_VP : A_VFIRST)), (float*)(ws + A_RK), ws + A_CHK + (size_t)(q & 1) * RW_BUF,
                 LDP(11) + l * 1792, LDP(12) + l * 512, LDP(14) + l * 512, LDP(17) + l * 512, LDP(18) + l * 512, LDP(19) + l * 512, LDP(22), l, 0};
    const int ntask = (q == 0 ? RW_NSEQ : RW_NSEQ - 1) * 8, hs = q == 0 ? 0 : RW_SKIP, NS = nblk - ((nblk + 3) >> 2);
    const bool scanwg = rw_is_scan_wg(bid); const int rank = rw_rank(bid);
#define RW_TASK(i_) (scanwg ? hs * NS + (i_) * nblk + bid : ((i_) < hs ? (i_) * NS + rank : hs * NS + ((i_) - hs) * nblk + bid))
#define RW_ROW0(t_) (((t_) >> 3) == 128 ? RREAL : ((t_) >> 7) * SEQ + (16 * q + (((t_) >> 3) & 15)) * 64)
    const int tid_ = opq(threadIdx.x), lane_ = tid_ & 63, w_ = __builtin_amdgcn_readfirstlane(tid_ >> 6);
    int task = RW_TASK(0); if (task >= ntask) return;
    CpRaw raw; cp_issue(cp, RW_ROW0(task), task & 7, w_, lane_, raw);
#pragma unroll 1
    for (int i = 0; ; ++i) { const int nxt = RW_TASK(i + 1); const bool has_next = nxt < ntask;
        rwkv_cp_task(lds, cp, RW_ROW0(task), task & 7, cp.CHK + (size_t)task * CHK_BYTES, raw, has_next, has_next ? RW_ROW0(nxt) : 0, nxt & 7);
        if (!has_next) break;
        task = nxt; }
#undef RW_TASK
#undef RW_ROW0
}
__device__ __forceinline__ void f_rwkv_scan(unsigned long long kp_, LAS unsigned char* lds, int l, int q) {
    const unsigned long long kp = kp_uniform(kp_); l = __builtin_amdgcn_readfirstlane(l); q = __builtin_amdgcn_readfirstlane(q);
    const int bid = (int)blockIdx.x, nblk = (int)gridDim.x; if (!rw_is_scan_wg(bid)) return;
    unsigned char* ws = WSP; const ScP sp{ws + A_CHK + (size_t)(q & 1) * RW_BUF, (bf16_t*)(ws + A_YS)};
#pragma unroll 1
    for (int unit = bid >> 2; unit < 64; unit += (nblk + 3) >> 2) { const int b = unit >> 3, hd = unit & 7; float* stp = (float*)(ws + A_SCST) + (size_t)unit * 4096;
        rwkv_scan_unit(lds, sp, b * 16, 128, q == 0 ? 1 : 0, 16, b * SEQ + q * 1024, hd, q == 0 && b == 0, q == 0 ? nullptr : stp, q == 3 ? nullptr : stp); }
}
NOINL void f_rwkv_post(unsigned long long kp_, int l, int q, int mode) {
    const unsigned long long kp = kp_uniform(kp_); l = __builtin_amdgcn_readfirstlane(l); q = __builtin_amdgcn_readfirstlane(q); mode = __builtin_amdgcn_readfirstlane(mode); WAVE_IDS(); unsigned char* ws = WSP;
    const PostP pp{(const bf16_t*)(ws + A_YS), (const bf16_t*)(ws + (l ? A_VP : A_VFIRST)), (const float*)(ws + A_RK), (const bf16_t*)(ws + A_LOUT), (bf16_t*)(ws + A_PM), LDP(20) + l * 512, LDP(21) + l * 512};
    const bool scanwg = rw_is_scan_wg(bid); const int nscan = (nblk + 3) >> 2, NS = nblk - nscan;
    if (mode == 2) rwkv_post(pp, q, 0, 8192, q == 0, gw, ngw, lane);
    else if (mode == 1) { if (!scanwg) rwkv_post(pp, q, 0, 8192, q == 0, rw_rank(bid) * 8 + wave, NS * 8, lane); }
    else if (scanwg) rwkv_post(pp, q, 0, 4096, false, (bid >> 2) * 8 + wave, nscan * 8, lane);
    else rwkv_post(pp, q, 4096, 8192, q == 0, rw_rank(bid) * 8 + wave, NS * 8, lane); }
NOINL void f_ffn_meta(unsigned long long kp_) {
    const unsigned long long kp = kp_uniform(kp_); WAVE_IDS(); unsigned char* ws = WSP;
    const int job = bid * 8 + wave; if (job >= FF0 / 16) return;
    const int f0 = job * 16, l15 = lane & 15, kq = lane >> 4;
    const bf16_t* wg = (const bf16_t*)(ws + WS_FGU) + (size_t)((f0 >> 7) * 256 + (f0 & 127) + l15) * 1024 + 8 * kq;
    const bf16_t* wu = wg + (size_t)128 * 1024;
    const bf16_t* xu = (const bf16_t*)(ws + A_U) + (size_t)(RREAL + l15) * D + 8 * kq;
    f32x4 ag = {0.f, 0.f, 0.f, 0.f}, au = {0.f, 0.f, 0.f, 0.f};
#pragma unroll 8
    for (int ks = 0; ks < 32; ++ks) { const bf16x8 a = *(const GAS bf16x8*)(wg + 32 * ks), b = *(const GAS bf16x8*)(wu + 32 * ks), x = *(const GAS bf16x8*)(xu + 32 * ks);
        ag = __builtin_amdgcn_mfma_f32_16x16x32_bf16(a, x, ag, 0, 0, 0); au = __builtin_amdgcn_mfma_f32_16x16x32_bf16(b, x, au, 0, 0, 0); }
    float r[4];
#pragma unroll
    for (int j = 0; j < 4; ++j) { const float g = ag[j], up = au[j]; r[j] = g / (1.0f + __expf(-g)) * up; }
    u32x2 o; o.x = cvtpk(r[0], r[1]); o.y = cvtpk(r[2], r[3]);
    *(GAS u32x2*)((bf16_t*)(ws + A_ACT0) + (size_t)(RREAL + l15) * FF0 + f0 + 4 * kq) = o;
}
NOINL void f_moe_tr(unsigned long long kp_, LAS unsigned char* lds) {
    const unsigned long long kp = kp_uniform(kp_); WAVE_IDS(); LAS float* scr = (LAS float*)(lds + wave * 8448);
    if (bid == 0 && tid < 24) { unsigned* ctlw = (unsigned*)(WSP + WS_CTL); const float sc = moe_wscale_bits(ctlw[CW_WMAX + tid]); ctlw[CW_WINV + tid] = __float_as_uint(1.0f / (F8_ACT * sc)); }
#pragma unroll 1
    for (int e = 0; e < NEXP * PROBE_REP_MOETR; ++e) { const int ee = e % NEXP;
        const unsigned* ctl = (const unsigned*)(WSP + WS_CTL);
        { const TrJob8 J{LDP(30) + (size_t)ee * D * FFE, WSP + A_MGU, D, FFE, 1024, 2, ee * 2 * FFE, moe_wscale(ctl, 0, ee)}; ph_transpose_f8(J, scr, gw, ngw, lane); }
        { const TrJob8 J{LDP(31) + (size_t)ee * D * FFE, WSP + A_MGU, D, FFE, 1024, 3, ee * 2 * FFE, moe_wscale(ctl, 1, ee)}; ph_transpose_f8(J, scr, gw, ngw, lane); }
        { const TrJob8 J{LDP(32) + (size_t)ee * FFE * D, WSP + A_MDN, FFE, D, FFE, 0, ee * D, moe_wscale(ctl, 2, ee)}; ph_transpose_f8(J, scr, gw, ngw, lane); }
    }
}
__device__ __forceinline__ void f_moe_route(unsigned long long kp_, LAS unsigned char* lds) {
    const unsigned long long kp = kp_uniform(kp_); WAVE_IDS(); unsigned char* ws = WSP;
    ph_norm_route(lds, OUTP, LDP(3) + D, LDP(28), LDP(29), (bf16_t*)(ws + A_U), (int*)(ws + A_MTAB + MT_E), (float*)(ws + A_MTAB + MT_G), (int*)(ws + A_MTAB + MT_STOK), (unsigned*)(ws + WS_CTL), bid, nblk, wave, lane); }
NOINL void f_moe_assign(unsigned long long kp_, LAS unsigned char* lds, int list) { const unsigned long long kp = kp_uniform(kp_); list = __builtin_amdgcn_readfirstlane(list); WAVE_IDS(); unsigned char* ws = WSP;
    ph_moe_assign(lds, list, (const int*)(ws + A_MTAB + MT_E), (const float*)(ws + A_MTAB + MT_G), (int*)(ws + A_MTAB + MT_STOK), (float*)(ws + A_MTAB + MT_SGATE), (int*)(ws + A_MTAB + MT_BE), (unsigned*)(ws + WS_CTL), ws + A_U, ws + A_XB, bid, nblk, tid); }
NOINL void f_final(unsigned long long kp_) { const unsigned long long kp = kp_uniform(kp_); WAVE_IDS(); unsigned char* ws = WSP; ph_final(OUTP, LDP(4), (const int*)(ws + A_MTAB + MT_TSLOT), (const float*)(ws + WS_TB), gw, ngw, lane); }

__global__ void __launch_bounds__(512, 2) fwd(Params P) {
    extern __shared__ __attribute__((aligned(16))) unsigned char lds_raw[];
    LAS unsigned char* lds = (LAS unsigned char*)lds_raw;
    const int tid = threadIdx.x;
    const int bid = (int)blockIdx.x, nblk = (int)gridDim.x;
    const unsigned long long kp = (unsigned long long)__builtin_amdgcn_kernarg_segment_ptr();
    volatile LAS unsigned* misc = (volatile LAS unsigned*)(lds + LDS_MISC);
    if (tid < 64) misc[tid] = 0u;
    __syncthreads();
    XcdBarrier bar;
    { unsigned* ctl0 = (unsigned*)(WSP + WS_CTL); bar = xcd_barrier_post(ctl0 + CW_BAR, misc + 8); }
#ifdef PROBE_BAR2
#define GRID_BAR() do { xcd_barrier(bar); xcd_barrier(bar); } while (0)
#else
#define GRID_BAR() xcd_barrier(bar)
#endif
    for (int rep_ = 0; rep_ < PROBE_REP_MISC; ++rep_) f_p0(kp, lds);
    GRID_BAR();

#pragma unroll 1
    for (int l = 0; l < 2; ++l) {
        for (int rep_ = 0; rep_ < PROBE_REP_NORM; ++rep_) f_rmsnorm(kp, 0, l);
        GRID_BAR();
_Pragma("unroll 1") for (int rep_ = 0; rep_ < PROBE_REP_INPROJ; ++rep_) {
        { unsigned char* ws = WSP; pg8::Gemm g{(const bf16_t*)(ws + A_U), (const bf16_t*)(ws + WS_WB + l * LW_STRIDE + LW_WIN), RP, 2816, 1024, 1024, 1024, 0}; pg8::StaticOrder S; S.init(RP, 2816, opqs(nblk), opqs(bid));
          EpiInProj E{(bf16_t*)(ws + A_PM), (bf16_t*)(ws + A_PR)};
          pg8::gemm_phase<EpiInProj, pg8::StaticOrder, true, true>(lds, g, S, E); }
}
        GRID_BAR();
        for (int rep_ = 0; rep_ < PROBE_REP_PREP; ++rep_) f_prep(kp, l);
        GRID_BAR();
_Pragma("unroll 1") for (int rep_ = 0; rep_ < PROBE_REP_P4A; ++rep_) {
        { unsigned char* ws = WSP; pg8::Gemm g{(const bf16_t*)(ws + A_PM), (const bf16_t*)(ws + WS_WB + l * LW_STRIDE + LW_WUQ), RP, 768, 512, 1024, 512, 0}; pg8::StaticOrder S; S.init(RP, 768, opqs(nblk), opqs(bid));
          EpiRowScale E{(bf16_t*)(ws + A_U), (const float*)(ws + A_RSTDQ), 768, 0};
          pg8::gemm_phase<EpiRowScale, pg8::StaticOrder, true, true>(lds, g, S, E); }
        { unsigned char* ws = WSP; pg8::Gemm g{(const bf16_t*)(ws + A_PM) + 512, (const bf16_t*)(ws + WS_WB + l * LW_STRIDE + LW_WK), RP, 512, 256, 1024, 256, 0}; pg8::StaticOrder S; S.init(RP, 512, opqs(nblk), opqs((bid + nblk - 131) % nblk));
          EpiRowScale E{(bf16_t*)(ws + A_KN), (const float*)(ws + A_RSTDKV), 512, 0};
          pg8::gemm_phase<EpiRowScale, pg8::StaticOrder, true, true>(lds, g, S, E); }
        { unsigned char* ws = WSP; pg8::Gemm g{(const bf16_t*)(ws + WS_WB + l * LW_STRIDE + LW_WV), (const bf16_t*)(ws + A_PM) + 512, 512, RP, 256, 256, 1024, 0}; pg8::StaticOrder S; S.init(512, RP, opqs(nblk), opqs((bid + nblk - 133) % nblk));
          EpiColScale E{(bf16_t*)(ws + A_VT), (const float*)(ws + A_RSTDKV), RP, 0};
          pg8::gemm_phase<EpiColScale, pg8::StaticOrder, true, true>(lds, g, S, E); }
}
        GRID_BAR();
_Pragma("unroll 1") for (int rep_ = 0; rep_ < PROBE_REP_ATT; ++rep_) {
        { unsigned char* ws = WSP; attn_phase(lds, (const bf16_t*)(ws + A_U), (const bf16_t*)(ws + A_KN), (const bf16_t*)(ws + A_KROPE), (const bf16_t*)(ws + A_VT), (bf16_t*)(ws + A_PM), (const float*)(ws + WS_ROPE), opqs(bid), opqs(nblk)); }
}
        GRID_BAR();
_Pragma("unroll 1") for (int rep_ = 0; rep_ < PROBE_REP_P4B; ++rep_) {
        { unsigned char* ws = WSP; pg8::Gemm g{(const bf16_t*)(ws + A_LIN), (const bf16_t*)(ws + WS_WB + l * LW_STRIDE + LW_LORA), RP, 1536, 256, 256, 256, 0}; pg8::StaticOrder S; S.init(RP, 1536, opqs(nblk), opqs(bid));
          EpiRowScale E{(bf16_t*)(ws + A_LOUT), nullptr, 1536, 0};
          pg8::gemm_phase<EpiRowScale, pg8::StaticOrder, true, true>(lds, g, S, E); }
        if (l == 1) {
            unsigned char* ws = WSP; pg8::Gemm g{(const bf16_t*)(ws + A_VSH), (const bf16_t*)(ws + WS_V1T), RP, 512, 512, 512, 512, 0}; pg8::StaticOrder S; S.init(RP, 512, opqs(nblk), opqs((bid + nblk - 6) % nblk));
            EpiRowScale E{(bf16_t*)(ws + A_VMIX), nullptr, 512, 0};
            pg8::gemm_phase<EpiRowScale, pg8::StaticOrder, true, true>(lds, g, S, E);
        }
}
        GRID_BAR();
#pragma unroll 1
        for (int stp = 0; stp < 6; ++stp) {
            if (stp >= 1 && stp <= 4) { _Pragma("unroll 1") for (int rep_ = 0; rep_ < PROBE_REP_SCAN; ++rep_) f_rwkv_scan(kp, lds, l, stp - 1); }
            if (stp <= 3) { _Pragma("unroll 1") for (int rep_ = 0; rep_ < PROBE_REP_CP; ++rep_) f_rwkv_cp(kp, lds, l, stp); }
            if (stp >= 2) { for (int rep_ = 0; rep_ < PROBE_REP_MISC; ++rep_) f_rwkv_post(kp, l, stp - 2, stp <= 3 ? 0 : stp - 3); }
            GRID_BAR();
        }
_Pragma("unroll 1") for (int rep_ = 0; rep_ < PROBE_REP_OUTPROJ; ++rep_) {
        { unsigned char* ws = WSP; pg8::Gemm g{(const bf16_t*)(ws + A_PM), (const bf16_t*)(ws + WS_WB + l * LW_STRIDE + LW_WOUT), RREAL, 1024, 1024, 1024, 1024, 0}; pg8::StaticOrder S; S.init(RREAL, 1024, opqs(nblk), opqs(bid));
          EpiResid E{OUTP, (float*)(ws + WS_HMETA), (l == 0 && rep_ == 0) ? LDP(0) : (const float*)OUTP, rep_ == 0 ? 1.0f : 0.0f, 0};
          pg8::gemm_phase<EpiResid, pg8::StaticOrder, true, true>(lds, g, S, E); }
        if (rep_ == 0 && l == 0) {
          unsigned char* ws = WSP; pg8::Gemm g{(const bf16_t*)(ws + A_PM), (const bf16_t*)(ws + WS_WB + l * LW_STRIDE + LW_WOUT), RP, 1024, 256, 1024, 1024, 0};
          const DenseTailOrder S{4, 4, opqs(nblk), opqs(bid)}; EpiResidPartial E{(float*)(ws + A_PART)};
          pg8::gemm_phase<EpiResidPartial, DenseTailOrder, true, true>(lds, g, S, E); }
}
        GRID_BAR();
        if (l == 0) {
            for (int rep_ = 0; rep_ < PROBE_REP_MISC; ++rep_) f_rmsnorm(kp, 1, 0);
            GRID_BAR();
_Pragma("unroll 1") for (int rep_ = 0; rep_ < PROBE_REP_FFNGU; ++rep_) {
            f_ffn_meta(kp);
            { unsigned char* ws = WSP; pg8::Gemm g{(const bf16_t*)(ws + A_U), (const bf16_t*)(ws + WS_FGU), RREAL, 2 * FF0, 1024, 1024, 1024, 0}; pg8::StaticOrder S; S.init(RREAL, 2 * FF0, opqs(nblk), opqs(bid));
              EpiSwiGLU E{(bf16_t*)(ws + A_ACT0), FF0, 22, 0, 0};
              pg8::gemm_phase<EpiSwiGLU, pg8::StaticOrder, true, true>(lds, g, S, E); }
}
            GRID_BAR();
_Pragma("unroll 1") for (int rep_ = 0; rep_ < PROBE_REP_FFNDN; ++rep_) {
            { unsigned char* ws = WSP; pg8::Gemm g{(const bf16_t*)(ws + A_ACT0), (const bf16_t*)(ws + WS_FDN), RREAL, 1024, FF0, FF0, FF0, 0}; pg8::StaticOrder S; S.init(RREAL, 1024, opqs(nblk), opqs(bid));
              EpiResid E{OUTP, (float*)(ws + WS_HMETA), (const float*)OUTP, rep_ == 0 ? 1.0f : 0.0f, 0};
              pg8::gemm_phase<EpiResid, pg8::StaticOrder, true, true>(lds, g, S, E); }
            if (rep_ == 0) {
              unsigned char* ws = WSP; pg8::Gemm g{(const bf16_t*)(ws + A_ACT0), (const bf16_t*)(ws + WS_FDN), RP, 1024, 256, FF0, FF0, 0};
              const DenseTailOrder S{4, 11, opqs(nblk), opqs(bid)}; EpiResidPartial E{(float*)(ws + A_PART)};
              pg8::gemm_phase<EpiResidPartial, DenseTailOrder, true, true>(lds, g, S, E); }
}
            GRID_BAR();
        } else {
            f_moe_tr(kp, lds);
            f_moe_route(kp, lds);
            GRID_BAR();
            f_moe_assign(kp, lds, 0);
            f_moe_assign(kp, lds, 1);
            GRID_BAR();
#pragma unroll 1
            for (int list = 0; list < 2; ++list) {
                const int np0 = __builtin_amdgcn_readfirstlane((int)((const unsigned*)(WSP + WS_CTL))[CW_NPAN]), np1 = __builtin_amdgcn_readfirstlane((int)((const unsigned*)(WSP + WS_CTL))[CW_NPAN + 1]);
                const int T0 = np0 > MOE_TAILPAN ? (np0 - MOE_TAILPAN) * 4 : 0, T1 = np1 > MOE_TAILPAN ? (np1 - MOE_TAILPAN) * 4 : 0;
                if (list == 1) {
                    { unsigned char* ws = WSP; pg8::Gemm g{(const bf16_t*)(ws + A_MACT), (const bf16_t*)(ws + A_MDN), 0, 0, FFE / 2, FFE / 2, FFE / 2, 0};
                      const MoeShiftTailOrder S{(const int*)(ws + A_MTAB + MT_BE), (const unsigned*)(ws + WS_CTL) + CW_NPAN, 4, 4, 0, opqs(nblk) - 1, opqs(bid), 0};
                      EpiMoeDown E{OUTP, (const int*)(ws + A_MTAB + MT_STOK), (const float*)(ws + A_MTAB + MT_SGATE), 4, 1.0f, (const unsigned*)(ws + WS_CTL)};
                      pg8::gemm_phase<EpiMoeDown, MoeShiftTailOrder, true, true, true>(lds, g, S, E); }
                    { unsigned char* ws = WSP; pg8::Gemm g{(const bf16_t*)(ws + A_MACT), (const bf16_t*)(ws + A_MDN), 0, 0, FFE / 2, FFE / 2, FFE / 2, 0};
                      const MoeShiftTailOrder S{(const int*)(ws + A_MTAB + MT_BE) + 256, (const unsigned*)(ws + WS_CTL) + CW_NPAN + 1, 4, 4, MOE_GAP, opqs(nblk) - 1 - T0, opqs(bid), 0};
                      EpiMoeDownStore E{(float*)(ws + WS_TB), (const int*)(ws + A_MTAB + MT_STOK) + MOE_MAXPAN * 256, (const float*)(ws + A_MTAB + MT_SGATE) + MOE_MAXPAN * 256, 4, MOE_TAILPAN + MOE_GAP, (const unsigned*)(ws + WS_CTL)};
                      pg8::gemm_phase<EpiMoeDownStore, MoeShiftTailOrder, true, true, true>(lds, g, S, E); }
                }
_Pragma("unroll 1") for (int rep_ = 0; rep_ < PROBE_REP_MOEGU; ++rep_) {
                { unsigned char* ws = WSP; pg8::Gemm g{(const bf16_t*)(ws + A_XB + (size_t)list * XB_LIST), (const bf16_t*)(ws + A_MGU), 0, 0, 512, 512, 512, 0};
                  const int Tt = list == 1 && T0 + T1 < opqs(nblk) ? T0 + T1 : 0;
                  const MoeSlotOrder S{(const int*)(ws + A_MTAB + MT_BE) + 256 * list, (const unsigned*)(ws + WS_CTL) + CW_NPAN + list, (const int*)(ws + A_MTAB + MT_STOK) + list * MOE_MAXPAN * 256, 28, 28, 0, opqs(nblk), opqs(bid), RREAL,
                                         0, list == 0 ? MOE_MAXPAN : MOE_TAILPAN, 0, 0, Tt, MOE_CSKIP};
                  EpiSwiGLU8 E{ws + A_MACT, (const unsigned*)(ws + WS_CTL), FFE, 28};
                  pg8::gemm_phase<EpiSwiGLU8, MoeSlotOrder, true, true, true>(lds, g, S, E); }
                if (list == 0) {
                  unsigned char* ws = WSP; pg8::Gemm g{(const bf16_t*)(ws + A_XB + XB_LIST), (const bf16_t*)(ws + A_MGU), 0, 0, 512, 512, 512, 0};
                  const int nb = opqs(nblk);
                  const MoeSlotOrder S{(const int*)(ws + A_MTAB + MT_BE) + 256, (const unsigned*)(ws + WS_CTL) + CW_NPAN + 1, (const int*)(ws + A_MTAB + MT_STOK) + MOE_MAXPAN * 256, 28, 28, 0, nb, opqs(bid), RREAL,
                                         MOE_TAILPAN, MOE_MAXPAN, MOE_GAP, (np0 * 28) % nb, 0, 0};
                  EpiSwiGLU8 E{ws + A_MACT, (const unsigned*)(ws + WS_CTL), FFE, 28};
                  pg8::gemm_phase<EpiSwiGLU8, MoeSlotOrder, true, true, true>(lds, g, S, E); }
}
                GRID_BAR();
_Pragma("unroll 1") for (int rep_ = 0; rep_ < PROBE_REP_MOEDN; ++rep_) {
                { unsigned char* ws = WSP; pg8::Gemm g{(const bf16_t*)(ws + A_MACT), (const bf16_t*)(ws + A_MDN), 0, 0, FFE / 2, FFE / 2, FFE / 2, 0};
                  const MoeOrder S{(const int*)(ws + A_MTAB + MT_BE) + 256 * list, (const unsigned*)(ws + WS_CTL) + CW_NPAN + list, 4, 4, 0, opqs(nblk), opqs(bid), MOE_TAILPAN * 4};
                  EpiMoeDown E{OUTP, (const int*)(ws + A_MTAB + MT_STOK) + list * MOE_MAXPAN * 256, (const float*)(ws + A_MTAB + MT_SGATE) + list * MOE_MAXPAN * 256, 4, rep_ == 0 ? 1.0f : 0.0f, (const unsigned*)(ws + WS_CTL)};
                  pg8::gemm_phase<EpiMoeDown, MoeOrder, true, true, true>(lds, g, S, E); }
}
                GRID_BAR();
            }
        }
    }
    f_final(kp);
}

extern "C" void kernel_launch(void* const* d_in, const int* in_sizes, int n_in, void* d_out, int out_size, void* d_ws, size_t ws_size, hipStream_t stream) {
    static int grid = 0;
    if (grid == 0) {
        if (n_in != 33 || ws_size < WS_NEED || out_size != RREAL * D) { fprintf(stderr, "kernel_launch: unexpected arguments (n_in %d, ws %zu need %zu, out %d)\n", n_in, ws_size, (size_t)WS_NEED, out_size); grid = -1; return; }
        int dev = 0, cus = 0;
        if (hipGetDevice(&dev) != hipSuccess || hipDeviceGetAttribute(&cus, hipDeviceAttributeMultiprocessorCount, dev) != hipSuccess) { grid = -1; return; }
        if (hipFuncSetAttribute((const void*)fwd, hipFuncAttributeMaxDynamicSharedMemorySize, LDS_BYTES) != hipSuccess) { fprintf(stderr, "kernel_launch: hipFuncSetAttribute failed\n"); grid = -1; return; }
        int per_cu = 0; (void)hipOccupancyMaxActiveBlocksPerMultiprocessor(&per_cu, (const void*)fwd, 512, LDS_BYTES); (void)hipGetLastError();
        grid = cus;
    }
    if (grid < 0) return;
    unsigned char* ws = (unsigned char*)d_ws;
    (void)hipMemsetAsync(ws + WS_CTL, 0, 1 * MiB, stream);
    (void)hipMemsetAsync(ws + WS_WB, 0, WS_ROPE - WS_WB, stream);
    Params p{};
    for (int i = 0; i < 33; ++i) p.in[i] = (const float*)d_in[i];
    p.out = (float*)d_out; p.ws = ws;
    hipLaunchKernelGGL(fwd, dim3(grid), dim3(512), LDS_BYTES, stream, p);
}
```

```cpp
#include <hip/hip_runtime.h>
#include <cstdio>
#include <cstdint>
namespace pg8 {
#define PG8_LAS __attribute__((address_space(3)))
typedef unsigned short bf16_t;
typedef short bf16x8 __attribute__((ext_vector_type(8)));
typedef float f32x4 __attribute__((ext_vector_type(4)));
typedef unsigned u32x4 __attribute__((ext_vector_type(4)));
constexpr int BM = 256, BK = 64, HALF = 128, HTB = HALF * BK * 2  , STAGE_BYTES = 8 * HTB, NXCD = 8, WGM = 8;

__host__ __device__ __forceinline__ int lds_byte(int r, int c) { const int st = (r >> 4) * 2 + (c >> 5), rr = r & 15, cc = c & 31, ob = rr * 64 + cc * 2; return st * 1024 + (ob ^ (((ob >> 9) & 1) << 5)); }
__host__ __device__ __forceinline__ void stage_rc(int b, int& R, int& C) { const int st = b / 1024, sb = b % 1024, swz = sb ^ (((sb >> 9) & 1) << 5); R = (st >> 1) * 16 + swz / 64; C = (st & 1) * 32 + (swz % 64) / 2; }
__host__ __device__ __forceinline__ int perm32(int rho) { const int n = rho >> 4, i = rho & 15; return 8 * (i >> 2) + 4 * n + (i & 3); }

struct Unit { int pm, pn, k0; };
struct Gemm { const bf16_t* A; const bf16_t* Bt; int M, N, K, lda, ldb, pad; };

struct StaticOrder {
    static constexpr bool GATHER = false;
    int nM, nN, nwg, G, c;
    __host__ __device__ void init(int M, int N, int G_, int c_) { nM = M / BM; nN = N / BM; nwg = nM * nN; G = G_; c = c_; }
    __host__ __device__ bool next(int i, Unit& u) const {
        const long L = (long)i * G + c; if (L >= nwg) return false;
        int wgid = (int)L; { const int q = nwg / NXCD, r = nwg % NXCD, xcd = wgid % NXCD, off = wgid / NXCD; wgid = (xcd < r ? xcd * (q + 1) : r * (q + 1) + (xcd - r) * q) + off; }
        const int nig = WGM * nN, gid = wgid / nig, fm = gid * WGM, gsz = (nM - fm) < WGM ? (nM - fm) : WGM;
        u.pm = fm + ((wgid % nig) % gsz); u.pn = (wgid % nig) / gsz; u.k0 = 0; return true;
    }
    __device__ __forceinline__ void a_ready(const Unit&) const {}
    __device__ __forceinline__ void done(const Unit&) const {}
};

__device__ __forceinline__ unsigned cvt_pk_bf16(float lo, float hi) { unsigned r; asm volatile("v_cvt_pk_bf16_f32 %0, %1, %2" : "=v"(r) : "v"(lo), "v"(hi)); return r; }
typedef int i32x4_ __attribute__((ext_vector_type(4)));
typedef int i32x8_ __attribute__((ext_vector_type(8)));
template <class Epi, class Sched, bool ALIGN_EPI = false, bool SP2 = false, bool FP8 = false>
__device__ __forceinline__ void gemm_phase(PG8_LAS unsigned char* lds, const Gemm g, const Sched& S, const Epi& E) {
    int tid_ = threadIdx.x; asm volatile("" : "+v"(tid_)); const int tid = tid_, wid = __builtin_amdgcn_readfirstlane(tid >> 6), lane = tid & 63, wr = wid >> 2, wc = wid & 3, fr = lane & 15, fq = lane >> 4;
    const int K = g.K, nt = K / BK;
    unsigned voffA[2], voffB[2];
#pragma unroll
    for (int i = 0; i < 2; ++i) { int R, C; stage_rc(tid * 16 + i * 8192, R, C); const int Rb = Epi::PERM ? ((R & ~31) + perm32(R & 31)) : R;
        voffA[i] = (unsigned)(R * g.lda + C) * 2u; voffB[i] = (unsigned)(Rb * g.ldb + C) * 2u; }
    constexpr bool GATHER = Sched::GATHER;
    unsigned vAc[2][2] = {{0u, 0u}, {0u, 0u}}, vAn[2][2] = {{0u, 0u}, {0u, 0u}}, cbA[2] = {0u, 0u};
    if constexpr (GATHER) {
#pragma unroll
        for (int i = 0; i < 2; ++i) { int R, C; stage_rc(tid * 16 + i * 8192, R, C); cbA[i] = (unsigned)C * 2u; }
    }
#define PG8_IDX_DMA(un, slot) do { if constexpr (GATHER) { const int* rp_ = S.rows + (size_t)(un).pm * 256 + 128 * (lane >> 5) + 64 * ((lane >> 4) & 1) + 16 * (wid >> 1) + (lane & 15); \
        __builtin_amdgcn_global_load_lds((const unsigned*)rp_, (PG8_LAS unsigned*)(lds + STAGE_BYTES + wid * 512 + (slot) * 256), 4, 0, 0); } } while (0)
#define PG8_IDX_READ(dst, slot) do { if constexpr (GATHER) { int t3_ = threadIdx.x; asm volatile("" : "+v"(t3_));     \
        _Pragma("unroll") for (int h_ = 0; h_ < 2; ++h_) _Pragma("unroll") for (int i_ = 0; i_ < 2; ++i_) { int R_, C_; stage_rc(t3_ * 16 + i_ * 8192, R_, C_); \
        int tk_ = *(const PG8_LAS int*)(lds + STAGE_BYTES + (t3_ >> 6) * 512 + (slot) * 256 + 4 * (32 * h_ + 16 * i_ + ((t3_ & 63) >> 2))); tk_ = tk_ < 0 ? S.zero_row : tk_; \
        dst[h_][i_] = (unsigned)tk_ * (unsigned)(g.lda * 2) + (unsigned)C_ * 2u; } } } while (0)
#define PG8_STAGE_A(bufoff, base, h, nx) do { if constexpr (GATHER) { const unsigned vs_[2] = {(nx) ? vAn[h][0] : vAc[h][0], (nx) ? vAn[h][1] : vAc[h][1]}; PG8_STAGE(bufoff, base, vs_); } \
        else { PG8_STAGE(bufoff, (base) + (h) * hstepA, voffA); } } while (0)
    const size_t kstep = (size_t)(BK * 2);
    const size_t hstepA = (size_t)HALF * g.lda * 2, hstepB = (size_t)HALF * g.ldb * 2;
    const size_t tstepA = 2 * hstepA, tstepB = 2 * hstepB;
    const unsigned ldsw = (unsigned)wid * 1024u;
    const int aoff = lds_byte(wr * 64 + fr, fq * 8), boff = lds_byte(wc * 32 + fr, fq * 8);
#define PG8_SA(b, h) (((b) * 2 + (h)) * HTB)
#define PG8_SB(b, h) ((4 + (b) * 2 + (h)) * HTB)
#define PG8_STAGE(bufoff, gbase, voff) do { const char* gb_ = (const char*)(gbase); asm volatile("" : "+s"(gb_));   \
        _Pragma("unroll") for (int _i = 0; _i < 2; ++_i) \
        __builtin_amdgcn_global_load_lds((const unsigned*)(gb_ + (voff)[_i]), (PG8_LAS unsigned*)(lds + (bufoff) + ldsw + _i * 8192), 16, 0, 0); } while (0)
#define PG8_LDA(dst, b, h) do { _Pragma("unroll") for (int m = 0; m < 4; ++m) _Pragma("unroll") for (int k = 0; k < 2; ++k) dst[m][k] = *(const PG8_LAS bf16x8*)(lds + PG8_SA(b, h) + aoff + m * 2048 + k * 1024); } while (0)
#define PG8_LDB(dst, b, h) do { _Pragma("unroll") for (int n = 0; n < 2; ++n) _Pragma("unroll") for (int k = 0; k < 2; ++k) dst[n][k] = *(const PG8_LAS bf16x8*)(lds + PG8_SB(b, h) + boff + n * 2048 + k * 1024); } while (0)
#define PG8_MMA(ai, bj, At, Bt) do { __builtin_amdgcn_s_setprio(1); _Pragma("unroll") for (int m = 0; m < 4; ++m) _Pragma("unroll") for (int n = 0; n < 2; ++n) { \
        if constexpr (FP8) { const i32x8_ b8_ = __builtin_shufflevector(__builtin_bit_cast(i32x4_, Bt[n][0]), __builtin_bit_cast(i32x4_, Bt[n][1]), 0, 1, 2, 3, 4, 5, 6, 7); \
            const i32x8_ a8_ = __builtin_shufflevector(__builtin_bit_cast(i32x4_, At[m][0]), __builtin_bit_cast(i32x4_, At[m][1]), 0, 1, 2, 3, 4, 5, 6, 7); \
            acc[ai][bj][m][n] = __builtin_amdgcn_mfma_scale_f32_16x16x128_f8f6f4(b8_, a8_, acc[ai][bj][m][n], 0, 0, 0, 0, 0, 0); }     \
        else { _Pragma("unroll") for (int k = 0; k < 2; ++k) acc[ai][bj][m][n] = __builtin_amdgcn_mfma_f32_16x16x32_bf16(Bt[n][k], At[m][k], acc[ai][bj][m][n], 0, 0, 0); } } \
        __builtin_amdgcn_s_setprio(0); } while (0)
#define PG8_WAIT_V(n) asm volatile("s_waitcnt vmcnt(" #n ")" ::: "memory")
#define PG8_WAIT_L(n) asm volatile("s_waitcnt lgkmcnt(" #n ")" ::: "memory")
#define PG8_BAR __builtin_amdgcn_s_barrier()
#define PG8_SCHED __builtin_amdgcn_sched_barrier(0)
    Unit cur, nxt; int ui = 0;
    if (!S.next(0, cur)) return;
    float zf_ = 0.f; asm volatile("" : "+v"(zf_));
    f32x4 acc[2][2][4][2];
#pragma unroll
    for (int a = 0; a < 2; ++a)
#pragma unroll
        for (int b = 0; b < 2; ++b)
#pragma unroll
            for (int m = 0; m < 4; ++m)
#pragma unroll
                for (int n = 0; n < 2; ++n) acc[a][b][m][n] = (f32x4){zf_, zf_, zf_, zf_};
    bf16x8 At[4][2], B0[2][2], B1[2][2];
    const char* cA = (const char*)g.A + (GATHER ? (size_t)0 : (size_t)cur.pm * tstepA) + (size_t)cur.k0 * 2; const char* cB = (const char*)g.Bt + (size_t)cur.pn * tstepB + (size_t)cur.k0 * 2;
    S.a_ready(cur);
    if constexpr (GATHER) { PG8_IDX_DMA(cur, 0); asm volatile("s_waitcnt vmcnt(0)" ::: "memory"); PG8_IDX_READ(vAc, 0); }
    if constexpr (SP2) {
        PG8_STAGE(PG8_SB(0, 0), cB, voffB); PG8_STAGE(PG8_SB(0, 1), cB + hstepB, voffB); PG8_STAGE_A(PG8_SA(0, 0), cA, 0, false); PG8_STAGE_A(PG8_SA(0, 1), cA, 1, false);
        if (wr == 1) PG8_BAR;
        PG8_WAIT_V(2); PG8_BAR;
        PG8_STAGE(PG8_SB(1, 0), cB + kstep, voffB); PG8_STAGE_A(PG8_SA(1, 0), cA + kstep, 0, false); PG8_STAGE(PG8_SB(1, 1), cB + hstepB + kstep, voffB);
        PG8_WAIT_V(6); PG8_BAR;
    } else {
        PG8_STAGE(PG8_SB(0, 0), cB, voffB); PG8_STAGE(PG8_SA(0, 0), cA, voffA); PG8_STAGE(PG8_SB(0, 1), cB + hstepB, voffB); PG8_STAGE(PG8_SA(0, 1), cA + hstepA, voffA);
        if (wr == 1) PG8_BAR;
        PG8_WAIT_V(4); PG8_BAR;
        PG8_STAGE(PG8_SB(1, 0), cB + kstep, voffB); PG8_STAGE(PG8_SA(1, 0), cA + kstep, voffA); PG8_STAGE(PG8_SB(1, 1), cB + hstepB + kstep, voffB);
        PG8_WAIT_V(6); PG8_BAR;
    }
    for (;;) {
        const bool has_next = S.next(ui + 1, nxt);
        const char* nA = has_next ? (const char*)g.A + (GATHER ? (size_t)0 : (size_t)nxt.pm * tstepA) + (size_t)nxt.k0 * 2 : cA; const char* nB = has_next ? (const char*)g.Bt + (size_t)nxt.pn * tstepB + (size_t)nxt.k0 * 2 : cB;
        if constexpr (GATHER) { if (has_next) PG8_IDX_DMA(nxt, (ui + 1) & 1); }
        for (int t = 0; t < nt; t += 2) {
            const bool last = (t == nt - 2); const bool lnx = last && has_next;
            const char* a1 = cA + (size_t)(t + 1) * kstep;
            const char* a2 = last ? nA : cA + (size_t)(t + 2) * kstep; const char* b2 = last ? nB : cB + (size_t)(t + 2) * kstep;
            const char* a3 = a2 + kstep; const char* b3 = b2 + kstep;
            if (last && has_next) S.a_ready(nxt);
            if constexpr (GATHER) { if (lnx) PG8_IDX_READ(vAn, (ui + 1) & 1); }
            if constexpr (SP2) {
            PG8_LDB(B0, 0, 0); PG8_LDB(B1, 0, 1); PG8_SCHED; PG8_LDA(At, 0, 0); PG8_STAGE_A(PG8_SA(1, 1), a1, 1, false);
            PG8_WAIT_V(8); PG8_WAIT_L(0); PG8_BAR; PG8_MMA(0, 0, At, B0); PG8_MMA(0, 1, At, B1); PG8_BAR; PG8_SCHED;
            PG8_LDA(At, 0, 1); PG8_STAGE(PG8_SB(0, 0), b2, voffB); PG8_STAGE(PG8_SB(0, 1), b2 + hstepB, voffB); PG8_STAGE_A(PG8_SA(0, 0), a2, 0, lnx);
            PG8_WAIT_V(8); PG8_WAIT_L(0); PG8_BAR; PG8_MMA(1, 0, At, B0); PG8_MMA(1, 1, At, B1); PG8_BAR; PG8_SCHED;
            PG8_LDB(B0, 1, 0); PG8_LDB(B1, 1, 1); PG8_SCHED; PG8_LDA(At, 1, 0); PG8_STAGE_A(PG8_SA(0, 1), a2, 1, lnx);
            PG8_WAIT_V(8); PG8_WAIT_L(0); PG8_BAR; PG8_MMA(0, 0, At, B0); PG8_MMA(0, 1, At, B1); PG8_BAR; PG8_SCHED;
            PG8_LDA(At, 1, 1); PG8_STAGE(PG8_SB(1, 0), b3, voffB); PG8_STAGE(PG8_SB(1, 1), b3 + hstepB, voffB); PG8_STAGE_A(PG8_SA(1, 0), a3, 0, lnx);
            PG8_WAIT_V(8); PG8_WAIT_L(0); PG8_BAR; PG8_MMA(1, 0, At, B0); PG8_MMA(1, 1, At, B1); PG8_BAR; PG8_SCHED;
            } else {
            PG8_LDB(B0, 0, 0); PG8_SCHED; PG8_LDA(At, 0, 0); PG8_STAGE(PG8_SA(1, 1), a1 + hstepA, voffA);
            PG8_WAIT_L(8); PG8_BAR; PG8_WAIT_L(0); PG8_MMA(0, 0, At, B0); PG8_BAR; PG8_SCHED;
            PG8_LDB(B1, 0, 1); PG8_STAGE(PG8_SB(0, 0), b2, voffB);
            PG8_BAR; PG8_WAIT_L(0); PG8_MMA(0, 1, At, B1); PG8_BAR;
            PG8_LDA(At, 0, 1); PG8_STAGE(PG8_SA(0, 0), a2, voffA);
            PG8_BAR; PG8_WAIT_L(0); PG8_MMA(1, 0, At, B0); PG8_BAR; PG8_SCHED;
            PG8_STAGE(PG8_SB(0, 1), b2 + hstepB, voffB);
            PG8_WAIT_V(6); PG8_BAR; PG8_MMA(1, 1, At, B1); PG8_BAR;
            PG8_LDB(B0, 1, 0); PG8_SCHED; PG8_LDA(At, 1, 0); PG8_STAGE(PG8_SA(0, 1), a2 + hstepA, voffA);
            PG8_WAIT_L(8); PG8_BAR; PG8_WAIT_L(0); PG8_MMA(0, 0, At, B0); PG8_BAR; PG8_SCHED;
            PG8_LDB(B1, 1, 1); PG8_STAGE(PG8_SB(1, 0), b3, voffB);
            PG8_BAR; PG8_WAIT_L(0); PG8_MMA(0, 1, At, B1); PG8_BAR;
            PG8_LDA(At, 1, 1); PG8_STAGE(PG8_SA(1, 0), a3, voffA);
            PG8_BAR; PG8_WAIT_L(0); PG8_MMA(1, 0, At, B0); PG8_BAR; PG8_SCHED;
            PG8_STAGE(PG8_SB(1, 1), b3 + hstepB, voffB);
            PG8_WAIT_V(6); PG8_BAR; PG8_MMA(1, 1, At, B1); PG8_BAR;
            }
        }
        if constexpr (ALIGN_EPI) { if (wr == 0) PG8_BAR; }
        if constexpr (!Epi::AFTER_DRAIN) { int t2_ = threadIdx.x; asm volatile("" : "+v"(t2_)); const int fr2_ = t2_ & 15, fq2_ = (t2_ >> 4) & 3;
            E(acc, cur, wr, wc, fr2_, fq2_); S.done(cur); }
        if (!has_next) break;
#pragma unroll
        for (int a = 0; a < 2; ++a)
#pragma unroll
            for (int b = 0; b < 2; ++b)
#pragma unroll
                for (int m = 0; m < 4; ++m)
#pragma unroll
                    for (int n = 0; n < 2; ++n) acc[a][b][m][n] = (f32x4){zf_, zf_, zf_, zf_};
        cur = nxt; cA = nA; cB = nB; ++ui;
        if constexpr (GATHER) { vAc[0][0] = vAn[0][0]; vAc[0][1] = vAn[0][1]; vAc[1][0] = vAn[1][0]; vAc[1][1] = vAn[1][1]; }
        if constexpr (ALIGN_EPI) { if (wr == 1) PG8_BAR; }
    }
    PG8_WAIT_V(0);
    if constexpr (!ALIGN_EPI) { if (wr == 0) PG8_BAR; }
    PG8_BAR;
    if constexpr (Epi::AFTER_DRAIN) { E.fused(acc, cur, wr, wc, fr, fq, lds, wid, lane); S.done(cur); }
#undef PG8_SA
#undef PG8_SB
#undef PG8_STAGE
#undef PG8_STAGE_A
#undef PG8_IDX_DMA
#undef PG8_IDX_READ
#undef PG8_LDA
#undef PG8_LDB
#undef PG8_MMA
#undef PG8_WAIT_V
#undef PG8_WAIT_L
#undef PG8_BAR
#undef PG8_SCHED
}
}

typedef unsigned short bf16_t;
typedef short bf16x8 __attribute__((ext_vector_type(8)));
typedef short s16x4 __attribute__((ext_vector_type(4)));
typedef float f32x4 __attribute__((ext_vector_type(4)));
typedef float f32x16 __attribute__((ext_vector_type(16)));
typedef unsigned u32x4 __attribute__((ext_vector_type(4)));
typedef unsigned u32x2 __attribute__((ext_vector_type(2)));
#define LAS __attribute__((address_space(3)))
#define GAS __attribute__((address_space(1)))

constexpr int D = 1024, NB = 8, SEQ = 4096, NMETA = 16;
constexpr int RREAL = NB * SEQ;
constexpr int RVALID = RREAL + NMETA;
constexpr int NPAN = 129, RP = NPAN * 256;
constexpr int PMW = 1024, PRW = 1792;
constexpr int CW = 512;
constexpr int FF0 = 2816, FFE = 3584, NEXP = 8;
constexpr float RMS_EPS = 1e-6f, GN_EPS = 64e-5f;
constexpr int MOE_MAXPAN = 144;
constexpr int MOE_TAILPAN = 128, MOE_GAP = 8;
#ifndef MOE_CSKIP
#define MOE_CSKIP 5
#endif

typedef float f32x2_t __attribute__((ext_vector_type(2))); typedef __bf16 bf16x2_t __attribute__((ext_vector_type(2)));
__device__ __forceinline__ unsigned cvtpk(float lo, float hi) { f32x2_t v = {lo, hi}; bf16x2_t b = __builtin_convertvector(v, bf16x2_t); return __builtin_bit_cast(unsigned, b); }
__device__ __forceinline__ bf16_t f2bf_hw(float x) { return (bf16_t)(cvtpk(x, x) & 0xffffu); }
__device__ __forceinline__ float bf2f(bf16_t b) { return __uint_as_float(((unsigned)b) << 16); }
__device__ __forceinline__ bf16_t f2bf(float f) { unsigned u = __float_as_uint(f); u += 0x7fffu + ((u >> 16) & 1u); return (bf16_t)(u >> 16); }
__device__ __forceinline__ unsigned pk2(float lo, float hi) { return (unsigned)f2bf(lo) | ((unsigned)f2bf(hi) << 16); }
#define DPP_F(v_, ctrl_, rmask_) __int_as_float(__builtin_amdgcn_update_dpp(0, __float_as_int(v_), (ctrl_), (rmask_), 0xf, false))
__device__ __forceinline__ float wave_sum(float v) {
    v += DPP_F(v, 0xB1, 0xf); v += DPP_F(v, 0x4E, 0xf); v += DPP_F(v, 0x141, 0xf); v += DPP_F(v, 0x140, 0xf);
    v += DPP_F(v, 0x142, 0xa); v += DPP_F(v, 0x143, 0xc);
    return __int_as_float(__builtin_amdgcn_readlane(__float_as_int(v), 63));
}
__device__ __forceinline__ float wave_max(float v) {
    v = fmaxf(v, DPP_F(v, 0xB1, 0xf)); v = fmaxf(v, DPP_F(v, 0x4E, 0xf)); v = fmaxf(v, DPP_F(v, 0x141, 0xf)); v = fmaxf(v, DPP_F(v, 0x140, 0xf));
    v = fmaxf(v, DPP_F(v, 0x142, 0xa)); v = fmaxf(v, DPP_F(v, 0x143, 0xc));
    return __int_as_float(__builtin_amdgcn_readlane(__float_as_int(v), 63));
}
constexpr float F8_MAX = 448.0f, F8_ACT = 8.0f;
__device__ __forceinline__ unsigned pk4_f8(float a, float b, float c, float d) {
    float mx = F8_MAX; asm volatile("" : "+v"(mx));
    a = __builtin_amdgcn_fmed3f(a, -mx, mx); b = __builtin_amdgcn_fmed3f(b, -mx, mx); c = __builtin_amdgcn_fmed3f(c, -mx, mx); d = __builtin_amdgcn_fmed3f(d, -mx, mx);
    int r = __builtin_amdgcn_cvt_pk_fp8_f32(a, b, 0, false); r = __builtin_amdgcn_cvt_pk_fp8_f32(c, d, r, true); return (unsigned)r; }
__device__ __forceinline__ float moe_wscale(const unsigned* ctl, int t, int e);
__device__ __forceinline__ float quad_sum(float v) { v += DPP_F(v, 0xB1, 0xf); v += DPP_F(v, 0x4E, 0xf); return v; }
__device__ __forceinline__ float sigmoidf_(float x) { return 1.0f / (1.0f + __expf(-x)); }
__device__ __forceinline__ int row_pos(int row) { return row < RREAL ? NMETA + (row & (SEQ - 1)) : row - RREAL; }
__device__ __forceinline__ int row_prev(int row) { if (row < RREAL) return (row & (SEQ - 1)) ? row - 1 : RVALID - 1; return row == RREAL ? -1 : row - 1; }

constexpr size_t MiB = 1u << 20;
constexpr size_t WS_CTL = 0;
constexpr size_t WS_HMETA = 1 * MiB;
constexpr size_t WS_WB = 2 * MiB;
constexpr size_t LW_STRIDE = 10 * MiB;
constexpr size_t LW_WIN = 0, LW_WUQ = LW_WIN + (size_t)2816 * 1024 * 2, LW_WK = LW_WUQ + (size_t)768 * 512 * 2, LW_WV = LW_WK + (size_t)512 * 256 * 2,
                 LW_LORA = LW_WV + (size_t)512 * 256 * 2, LW_WOUT = LW_LORA + (size_t)1536 * 256 * 2, LW_END = LW_WOUT + (size_t)1024 * 1024 * 2;
static_assert(LW_END <= LW_STRIDE, "layer weights");
constexpr size_t WS_V1T = WS_WB + 2 * LW_STRIDE, WS_V2T = WS_V1T + (size_t)256 * 512 * 2, WS_FGU = WS_V2T + (size_t)512 * 256 * 2,
                 WS_FDN = WS_FGU + (size_t)5632 * 1024 * 2, WS_ROPE = WS_FDN + (size_t)1024 * 2816 * 2, WS_WB_END = WS_ROPE + (size_t)4112 * 64 * 4;
constexpr size_t WS_TB = WS_FGU;
constexpr size_t WS_ARENA = 41 * MiB;
static_assert(WS_WB_END <= WS_ARENA, "weights fit");
static_assert((size_t)8 * 256 * 1024 * 4 <= (size_t)5632 * 1024 * 2, "list-1 tail buffer fits the dense gate/up weight slot");
constexpr size_t SZ_R1024 = (size_t)RP * 1024 * 2, SZ_R512 = (size_t)RP * 512 * 2, SZ_R256 = (size_t)RP * 256 * 2;
constexpr size_t A_U = WS_ARENA;
constexpr size_t A_KN = A_U + SZ_R1024;
constexpr size_t A_VT = A_KN + SZ_R512;
constexpr size_t A_LOUT = A_U, A_VMIX = A_VT;
static_assert((size_t)RP * 1536 * 2 == SZ_R1024 + SZ_R512, "LORA_OUT fills the U and KN slots exactly");
constexpr size_t A_PM = A_VT + SZ_R512;
constexpr size_t A_PR = A_PM + SZ_R1024;
constexpr size_t A_SMALL = A_PR + (size_t)RP * PRW * 2;
constexpr size_t A_RSTDQ = A_SMALL, A_RSTDKV = A_RSTDQ + (size_t)RP * 4, A_KROPE = A_RSTDKV + (size_t)RP * 4, A_SMALL_END = A_KROPE + (size_t)RP * 64 * 2;
constexpr size_t A_LIN = (A_SMALL_END + 4095) & ~(size_t)4095;
constexpr size_t A_VSH = A_LIN + SZ_R256;
constexpr size_t A_CHK = A_LIN;
constexpr size_t SZ_CHK = (size_t)258 * 8 * 32768;
constexpr size_t A_VFIRST = (A_CHK + SZ_CHK > A_VSH + SZ_R512 ? A_CHK + SZ_CHK : A_VSH + SZ_R512);
constexpr size_t A_VP = A_VFIRST + SZ_R512;
constexpr size_t A_RK = A_VP + SZ_R512;
constexpr size_t A_YS = A_RK + (size_t)RP * 8 * 4;
constexpr size_t A_SCST = A_YS + SZ_R512;
constexpr size_t A_PART = A_SCST + (size_t)64 * 4096 * 4;
constexpr size_t A_END1 = A_PART + (size_t)11 * NMETA * 1024 * 4;
constexpr size_t A_ACT0 = A_PM;
constexpr size_t A_MGU = A_KN;
constexpr size_t A_MDN = A_MGU + (size_t)NEXP * 7168 * 1024 * 2;
constexpr size_t A_MTAB = A_MDN + (size_t)NEXP * 1024 * 3584 * 2;
constexpr size_t MT_E = 0, MT_G = MT_E + (size_t)2 * RREAL * 4, MT_STOK = MT_G + (size_t)2 * RREAL * 4, MT_TSLOT = MT_STOK + (size_t)2 * MOE_MAXPAN * 256 * 4  , MT_SGATE = MT_TSLOT + (size_t)RREAL * 4,
                 MT_BE = MT_SGATE + (size_t)2 * MOE_MAXPAN * 256 * 4, MT_END = MT_BE + 2 * 256 * 4;
constexpr size_t A_MACT = (A_MTAB + MT_END + 4095) & ~(size_t)4095;
constexpr size_t XB_LIST = (size_t)MOE_MAXPAN * 256 * 1024;
constexpr size_t A_XB = A_MACT + (size_t)MOE_MAXPAN * 256 * FFE;
static_assert(A_XB + 2 * XB_LIST <= A_MACT + (size_t)MOE_MAXPAN * 256 * FFE * 2, "XB inside the old activation footprint");
constexpr size_t A_END2 = A_MACT + (size_t)MOE_MAXPAN * 256 * FFE * 2;
constexpr size_t WS_NEED = (A_END1 > A_END2 ? A_END1 : A_END2);
static_assert(WS_NEED <= 557619232ull, "workspace budget (sum of the inputs' bytes)");
static_assert(A_ACT0 + (size_t)RP * FF0 * 2 <= A_SMALL, "dense act overlay");
constexpr int CW_CNT = 64;
constexpr int CW_FILL = 128;
constexpr int CW_NPAN = 192;
constexpr int CW_WINV = 16448;
constexpr int CW_WMAX = 16384;
constexpr int CW_WGCNT = 8192;


__device__ __forceinline__ unsigned long long kp_uniform(unsigned long long kp) { const unsigned lo = __builtin_amdgcn_readfirstlane((unsigned)kp), hi = __builtin_amdgcn_readfirstlane((unsigned)(kp >> 32)); return ((unsigned long long)hi << 32) | lo; }
__device__ __forceinline__ const void* ldk(unsigned long long kp, int off) { unsigned long long v;
    asm volatile("s_load_dwordx2 %0, %1, %2\n\ts_waitcnt lgkmcnt(0)" : "=s"(v) : "s"(kp), "i"(off) : "memory"); return (const void*)v; }
__device__ __forceinline__ int opq(int v) { asm volatile("" : "+v"(v)); return v; }
__device__ __forceinline__ int opqs(int v) { asm volatile("" : "+s"(v)); return v; }
__device__ __forceinline__ void lds_barrier() { asm volatile("s_waitcnt lgkmcnt(0)\n\ts_barrier" ::: "memory"); }

__device__ __forceinline__ float moe_wscale_bits(unsigned bits) { const float m = __uint_as_float(bits);
    return m > 0.f ? __builtin_amdgcn_exp2f(floorf(__builtin_amdgcn_logf(224.0f / m))) : 1.0f; }
__device__ __forceinline__ float moe_wscale(const unsigned* ctl, int t, int e) { return moe_wscale_bits((unsigned)__builtin_amdgcn_readfirstlane((int)ctl[CW_WMAX + t * 8 + e])); }
#define XB_TMO      128
#define XB_XCNT(j)  (256  + 64 * (j))
#define XB_XSUB(j)  (1280 + 64 * (j))
#define XB_XGEN(j)  (2304 + 64 * (j))
#define XB_TOP      3328
#define XB_TOPGEN   3392
#define XCD_BAR_WORDS 3456
#define XB_SPIN_CAP (1u << 18)

__device__ __forceinline__ unsigned xb_ld(unsigned* p)              { return __hip_atomic_load(p, __ATOMIC_RELAXED, __HIP_MEMORY_SCOPE_AGENT); }
__device__ __forceinline__ unsigned xb_add(unsigned* p, unsigned v) { return __hip_atomic_fetch_add(p, v, __ATOMIC_RELAXED, __HIP_MEMORY_SCOPE_AGENT); }
__device__ __forceinline__ unsigned xb_xcc_id() { return (unsigned)__builtin_amdgcn_s_getreg((3 << 11) | 20) & 0xFu; }
#define XB_SPIN(cond, bar) do { unsigned _sp = 0; while (cond) { __builtin_amdgcn_s_sleep(1); \
    if ((++_sp & 255u) == 0u) { if (xb_ld(&(bar)[XB_TMO])) break; if (_sp > XB_SPIN_CAP) { atomicAdd(&(bar)[XB_TMO], 1u); break; } } } } while (0)

struct XcdBarrier {
    unsigned* bar; unsigned x;
    volatile LAS unsigned* st;
};

__device__ __forceinline__ XcdBarrier xcd_barrier_post(unsigned* bar, volatile LAS unsigned* st) {
    XcdBarrier b; b.bar = bar; b.x = xb_xcc_id(); b.st = st;
    if (threadIdx.x == 0) (void)xb_add(&bar[XB_XCNT(b.x)], 1u);
    return b;
}
__device__ __forceinline__ void xcd_barrier_complete(unsigned* bar, unsigned x, unsigned& nloc, unsigned& nx) {
    const unsigned G = gridDim.x * gridDim.y * gridDim.z;
    unsigned sum, cnt, mine, sp = 0u;
    for (;;) {
        sum = 0u; cnt = 0u; mine = 0u;
#pragma unroll
        for (unsigned j = 0; j < 16; ++j) { const unsigned c = xb_ld(&bar[XB_XCNT(j)]); sum += c; cnt += (c > 0u) ? 1u : 0u; mine = (j == x) ? c : mine; }
        if (sum == G) break;
        __builtin_amdgcn_s_sleep(1);
        if ((++sp & 255u) == 0u) { if (xb_ld(&bar[XB_TMO])) break; if (sp > XB_SPIN_CAP) { atomicAdd(&bar[XB_TMO], 1u); break; } }
    }
    nloc = mine > 0u ? mine : 1u; nx = cnt > 0u ? cnt : 1u;
}

__device__ __attribute__((noinline)) void xcd_barrier_fn(unsigned* bar_, unsigned x_, volatile LAS unsigned* st_) {
    XcdBarrier b; b.bar = bar_; b.x = x_; b.st = st_;
    asm volatile("s_waitcnt vmcnt(0)" ::: "memory");
    __syncthreads();
    if (threadIdx.x == 0) {
        unsigned* bar = b.bar;
        __builtin_amdgcn_s_waitcnt(0);
        unsigned nloc = b.st[0], nx = b.st[1];
        if (nloc == 0u) { xcd_barrier_complete(bar, b.x, nloc, nx); b.st[0] = nloc; b.st[1] = nx; }
        const unsigned old = xb_add(&bar[XB_XSUB(b.x)], 1u);
        const unsigned gen = old / nloc;
        if (old + 1u == (gen + 1u) * nloc) {
            __builtin_amdgcn_fence(__ATOMIC_RELEASE, "agent");
            asm volatile("s_waitcnt vmcnt(0)" ::: "memory");
            const unsigned og = xb_add(&bar[XB_TOP], 1u);
            const unsigned tg = og / nx;
            if (og + 1u == (tg + 1u) * nx) xb_add(&bar[XB_TOPGEN], 1u);
            else XB_SPIN(xb_ld(&bar[XB_TOPGEN]) == tg, bar);
            __builtin_amdgcn_fence(__ATOMIC_ACQUIRE, "agent");
            xb_add(&bar[XB_XGEN(b.x)], 1u);
            asm volatile("s_waitcnt vmcnt(0)" ::: "memory");
        } else {
            XB_SPIN(xb_ld(&bar[XB_XGEN(b.x)]) == gen, bar);
            __builtin_amdgcn_fence(__ATOMIC_ACQUIRE, "agent");
            asm volatile("s_waitcnt vmcnt(0)" ::: "memory");
        }
    }
    __syncthreads();
}

__device__ __forceinline__ void xcd_barrier(const XcdBarrier& b) { xcd_barrier_fn(b.bar, b.x, b.st); }
using pg8::Unit;
struct EpiInProj { static constexpr bool PERM = true, AFTER_DRAIN = false; bf16_t* PM; bf16_t* PR;
    __device__ __forceinline__ void operator()(const f32x4 (&acc)[2][2][4][2], const Unit& u, int wr, int wc, int fr, int fq) const {
        const int row0 = u.pm * 256 + wr * 64 + fr; bf16_t* base; int ld, colt;
        if (u.pn < 4) { base = PM; ld = PMW; colt = u.pn * 256; } else { base = PR; ld = PRW; colt = (u.pn - 4) * 256; }
        const int col0 = colt + wc * 32 + 8 * fq;
#pragma unroll
        for (int ai = 0; ai < 2; ++ai)
#pragma unroll
            for (int m = 0; m < 4; ++m) { bf16_t* rowp = base + (size_t)(row0 + ai * 128 + m * 16) * ld + col0;
#pragma unroll
                for (int bj = 0; bj < 2; ++bj) { const f32x4 v0 = acc[ai][bj][m][0], v1 = acc[ai][bj][m][1];
                    u32x4 w; w.x = pg8::cvt_pk_bf16(v0[0], v0[1]); w.y = pg8::cvt_pk_bf16(v0[2], v0[3]); w.z = pg8::cvt_pk_bf16(v1[0], v1[1]); w.w = pg8::cvt_pk_bf16(v1[2], v1[3]);
                    *(u32x4*)(rowp + bj * 128) = w; } }
    }
};
struct EpiRowScale { static constexpr bool PERM = true, AFTER_DRAIN = false; bf16_t* O; const float* rs; int ldc, pad;
    __device__ __forceinline__ void operator()(const f32x4 (&acc)[2][2][4][2], const Unit& u, int wr, int wc, int fr, int fq) const {
        const int row0 = u.pm * 256 + wr * 64 + fr; const int col0 = u.pn * 256 + wc * 32 + 8 * fq;
#pragma unroll
        for (int ai = 0; ai < 2; ++ai)
#pragma unroll
            for (int m = 0; m < 4; ++m) { const int row = row0 + ai * 128 + m * 16; const float s = rs ? rs[row] : 1.f; bf16_t* rowp = O + (size_t)row * ldc + col0;
#pragma unroll
                for (int bj = 0; bj < 2; ++bj) { const f32x4 v0 = acc[ai][bj][m][0] * s, v1 = acc[ai][bj][m][1] * s;
                    u32x4 w; w.x = pg8::cvt_pk_bf16(v0[0], v0[1]); w.y = pg8::cvt_pk_bf16(v0[2], v0[3]); w.z = pg8::cvt_pk_bf16(v1[0], v1[1]); w.w = pg8::cvt_pk_bf16(v1[2], v1[3]);
                    *(u32x4*)(rowp + bj * 128) = w; } }
    }
};
struct EpiColScale { static constexpr bool PERM = true, AFTER_DRAIN = false; bf16_t* O; const float* cs; int ldc, pad;
    __device__ __forceinline__ void operator()(const f32x4 (&acc)[2][2][4][2], const Unit& u, int wr, int wc, int fr, int fq) const {
        const int row0 = u.pm * 256 + wr * 64 + fr; const int col0 = u.pn * 256 + wc * 32 + 8 * fq;
        f32x4 sc[2][2];
#pragma unroll
        for (int bj = 0; bj < 2; ++bj) { sc[bj][0] = *(const f32x4*)(cs + col0 + bj * 128); sc[bj][1] = *(const f32x4*)(cs + col0 + bj * 128 + 4); }
#pragma unroll
        for (int ai = 0; ai < 2; ++ai)
#pragma unroll
            for (int m = 0; m < 4; ++m) { bf16_t* rowp = O + (size_t)(row0 + ai * 128 + m * 16) * ldc + col0;
#pragma unroll
                for (int bj = 0; bj < 2; ++bj) { const f32x4 v0 = acc[ai][bj][m][0] * sc[bj][0], v1 = acc[ai][bj][m][1] * sc[bj][1];
                    u32x4 w; w.x = pg8::cvt_pk_bf16(v0[0], v0[1]); w.y = pg8::cvt_pk_bf16(v0[2], v0[3]); w.z = pg8::cvt_pk_bf16(v1[0], v1[1]); w.w = pg8::cvt_pk_bf16(v1[2], v1[3]);
                    *(u32x4*)(rowp + bj * 128) = w; } }
    }
};
struct EpiResid { static constexpr bool PERM = false, AFTER_DRAIN = false; float* out; float* hmeta; const float* src; float scale; int pad;
    __device__ __forceinline__ void operator()(const f32x4 (&acc)[2][2][4][2], const Unit& u, int wr, int wc, int fr, int fq) const {
        const int rl = wr * 64 + fr, col0 = u.pn * 256 + wc * 32 + 4 * fq;
        float* base = u.pm < 128 ? out + (size_t)u.pm * 256 * D : hmeta; const float* sbase = u.pm < 128 ? src + (size_t)u.pm * 256 * D : hmeta;
#pragma unroll
        for (int ai = 0; ai < 2; ++ai)
#pragma unroll
            for (int m = 0; m < 4; ++m) { const size_t ro = (size_t)(rl + ai * 128 + m * 16) * D + col0;
#pragma unroll
                for (int bj = 0; bj < 2; ++bj)
#pragma unroll
                    for (int n = 0; n < 2; ++n) { const f32x4 hv = *(const f32x4*)(sbase + ro + bj * 128 + n * 16); *(f32x4*)(base + ro + bj * 128 + n * 16) = hv + acc[ai][bj][m][n] * scale; }
                asm volatile("" ::: "memory"); }
    }
};
struct EpiSwiGLU { static constexpr bool PERM = true, AFTER_DRAIN = false; bf16_t* O; int ldc, nmod, pn_off, pad;
    __device__ __forceinline__ void operator()(const f32x4 (&acc)[2][2][4][2], const Unit& u, int wr, int wc, int fr, int fq) const {
        const int row0 = u.pm * 256 + wr * 64 + fr; const int pnl = (u.pn % nmod) - pn_off; const int col0 = pnl * 128 + wc * 32 + 8 * fq;
#pragma unroll
        for (int ai = 0; ai < 2; ++ai)
#pragma unroll
            for (int m = 0; m < 4; ++m) { bf16_t* rowp = O + (size_t)(row0 + ai * 128 + m * 16) * ldc + col0; float r[8];
#pragma unroll
                for (int n = 0; n < 2; ++n)
#pragma unroll
                    for (int j = 0; j < 4; ++j) { const float g = acc[ai][0][m][n][j], up = acc[ai][1][m][n][j]; r[4 * n + j] = g / (1.0f + __expf(-g)) * up; }
                u32x4 w; w.x = pg8::cvt_pk_bf16(r[0], r[1]); w.y = pg8::cvt_pk_bf16(r[2], r[3]); w.z = pg8::cvt_pk_bf16(r[4], r[5]); w.w = pg8::cvt_pk_bf16(r[6], r[7]);
                *(u32x4*)rowp = w; }
    }
};
struct EpiSwiGLU8 { static constexpr bool PERM = false, AFTER_DRAIN = false; unsigned char* O; const unsigned* ctl; int ldc, nmod;
    __device__ __forceinline__ void operator()(const f32x4 (&acc)[2][2][4][2], const Unit& u, int wr, int wc, int fr, int fq) const {
        const int row0 = u.pm * 256 + wr * 64 + fr; const int e = u.pn / nmod, pnl = u.pn % nmod; const int col0 = pnl * 128 + wc * 32 + 4 * fq;
        const float ig = __uint_as_float(__builtin_amdgcn_readfirstlane((int)ctl[CW_WINV + e])), iu = __uint_as_float(__builtin_amdgcn_readfirstlane((int)ctl[CW_WINV + 8 + e])) * F8_ACT;
#pragma unroll
        for (int ai = 0; ai < 2; ++ai)
#pragma unroll
            for (int m = 0; m < 4; ++m) { unsigned char* rowp = O + (size_t)(row0 + ai * 128 + m * 16) * ldc + col0;
#pragma unroll
                for (int n = 0; n < 2; ++n) { float r[4];
#pragma unroll
                    for (int j = 0; j < 4; ++j) { const float g = acc[ai][0][m][n][j] * ig, up = acc[ai][1][m][n][j] * iu; r[j] = g / (1.0f + __expf(-g)) * up; }
                    *(unsigned*)(rowp + n * 16) = pk4_f8(r[0], r[1], r[2], r[3]); } }
    }
};
struct EpiMoeDown { static constexpr bool PERM = false, AFTER_DRAIN = false; float* out; const int* stok; const float* sgate; int nmod; float scale; const unsigned* ctl;
    __device__ __forceinline__ void operator()(const f32x4 (&acc)[2][2][4][2], const Unit& u, int wr, int wc, int fr, int fq) const {
        const int row0 = u.pm * 256 + wr * 64 + fr; const int col0 = (u.pn % nmod) * 256 + wc * 32 + 4 * fq;
        const float winv = ctl ? __uint_as_float(__builtin_amdgcn_readfirstlane((int)ctl[CW_WINV + 16 + u.pn / nmod])) : 1.0f;
#pragma unroll
        for (int ai = 0; ai < 2; ++ai)
#pragma unroll
            for (int m = 0; m < 4; ++m) { const int prow = row0 + ai * 128 + m * 16; const int tok = stok[prow]; if (tok < 0) continue; const float gt = sgate[prow] * scale * winv;
                float* rowp = out + (size_t)tok * D + col0;
#pragma unroll
                for (int bj = 0; bj < 2; ++bj)
#pragma unroll
                    for (int n = 0; n < 2; ++n) { f32x4* p = (f32x4*)(rowp + bj * 128 + n * 16); *p = *p + acc[ai][bj][m][n] * gt; }
                asm volatile("" ::: "memory"); }
    }
};
struct EpiMoeDownStore { static constexpr bool PERM = false, AFTER_DRAIN = false; float* tb; const int* stok; const float* sgate; int nmod, pm0; const unsigned* ctl;
    __device__ __forceinline__ void operator()(const f32x4 (&acc)[2][2][4][2], const Unit& u, int wr, int wc, int fr, int fq) const {
        const int row0 = u.pm * 256 + wr * 64 + fr; const int col0 = (u.pn % nmod) * 256 + wc * 32 + 4 * fq;
#pragma unroll
        for (int ai = 0; ai < 2; ++ai)
#pragma unroll
            for (int m = 0; m < 4; ++m) { const int prow = row0 + ai * 128 + m * 16; const int tok = stok[prow]; if (tok < 0) continue; const float gt = sgate[prow] * __uint_as_float(__builtin_amdgcn_readfirstlane((int)ctl[CW_WINV + 16 + u.pn / nmod]));
                float* rowp = tb + (size_t)(prow - pm0 * 256) * D + col0;
#pragma unroll
                for (int bj = 0; bj < 2; ++bj)
#pragma unroll
                    for (int n = 0; n < 2; ++n) *(f32x4*)(rowp + bj * 128 + n * 16) = acc[ai][bj][m][n] * gt; }
    }
};
struct MoeOrder { static constexpr bool GATHER = false; const int* block_e; const unsigned* npan; int nN, emul, pn_off, G, c, lmax;
    __device__ __forceinline__ bool next(int i, Unit& u) const { const int L = i * G + c; const int np = __builtin_amdgcn_readfirstlane((int)(*npan)); if (L >= np * nN || (lmax && L >= lmax)) return false;
        const int pm = L / nN; u.k0 = 0; u.pm = pm; u.pn = __builtin_amdgcn_readfirstlane(block_e[pm]) * emul + pn_off + (L % nN); return true; }
    __device__ __forceinline__ void a_ready(const Unit&) const {}
    __device__ __forceinline__ void done(const Unit&) const {}
};


struct EpiResidPartial { static constexpr bool PERM = false, AFTER_DRAIN = false; float* part;
    __device__ __forceinline__ void operator()(const f32x4 (&acc)[2][2][4][2], const Unit& u, int wr, int wc, int fr, int fq) const {
        const int rl = wr * 64 + fr, col0 = u.pn * 256 + wc * 32 + 4 * fq; float* base = part + (size_t)(u.k0 >> 8) * NMETA * D;
#pragma unroll
        for (int ai = 0; ai < 2; ++ai)
#pragma unroll
            for (int m = 0; m < 4; ++m) { const int row = rl + ai * 128 + m * 16; if (row >= NMETA) continue;
                float* rowp = base + (size_t)row * D + col0;
#pragma unroll
                for (int bj = 0; bj < 2; ++bj)
#pragma unroll
                    for (int n = 0; n < 2; ++n) *(f32x4*)(rowp + bj * 128 + n * 16) = acc[ai][bj][m][n]; }
    }
};
struct DenseTailOrder { static constexpr bool GATHER = false; int nN, nsl, G, c;
    __device__ __forceinline__ bool next(int i, Unit& u) const { const int idx = i * G + c; if (idx >= nN * nsl) return false; u.pm = 128; u.pn = idx / nsl; u.k0 = (idx % nsl) * 256; return true; }
    __device__ __forceinline__ void a_ready(const Unit&) const {}
    __device__ __forceinline__ void done(const Unit&) const {}
};
template <bool GA> struct MoeGatherOrderT { static constexpr bool GATHER = GA;
    const int* block_e; const unsigned* npan; const int* rows; int nN, emul, pn_off, G, c, zero_row;
    int pm_lo, pm_hi, gap, rot, T, cskip;
    __device__ __forceinline__ bool next(int i, Unit& u) const {
        int cc = c - rot; cc += cc < 0 ? G : 0;
        int L;
        if (T == 0) L = i * G + cc;
        else { const int W0 = G - T; if (cc < W0) L = i < cskip ? i * W0 + cc : cskip * W0 + (i - cskip) * G + cc; else L = cskip * W0 + i * G + cc; }
        int np = __builtin_amdgcn_readfirstlane((int)(*npan)); np = np < pm_hi ? np : pm_hi;
        const int pl = pm_lo + L / nN; if (pl >= np) return false;
        const int pm = pl + (pl >= MOE_TAILPAN ? gap : 0); u.k0 = 0; u.pm = pm; u.pn = __builtin_amdgcn_readfirstlane(block_e[pm]) * emul + pn_off + (L % nN); return true; }
    __device__ __forceinline__ void a_ready(const Unit&) const {}
    __device__ __forceinline__ void done(const Unit&) const {}
};
using MoeGatherOrder = MoeGatherOrderT<true>; using MoeSlotOrder = MoeGatherOrderT<false>;
struct MoeShiftTailOrder { static constexpr bool GATHER = false; const int* block_e; const unsigned* npan; int nN, emul, gap, wg_first, c, pad;
    __device__ __forceinline__ bool next(int i, Unit& u) const { const int t = wg_first - c; const int np = __builtin_amdgcn_readfirstlane((int)(*npan)); const int L = MOE_TAILPAN * nN + t;
        if (i > 0 || t < 0 || L >= np * nN) return false;
        const int pm = L / nN + gap; u.k0 = 0; u.pm = pm; u.pn = __builtin_amdgcn_readfirstlane(block_e[pm]) * emul + (L % nN); return true; }
    __device__ __forceinline__ void a_ready(const Unit&) const {}
    __device__ __forceinline__ void done(const Unit&) const {}
};

__device__ __forceinline__ int map_row(int mode, int n, int rowoff) {
    if (mode == 1) return n < 832 ? n : n + 192;
    if (mode == 2) return rowoff + (n >> 7) * 256 + (n & 127);
    if (mode == 3) return rowoff + (n >> 7) * 256 + 128 + (n & 127);
    if (mode == 4) return (n >> 8) * 128 + (n & 127) + ((n & 128) ? 512 : 0);
    return rowoff + n;
}
__device__ __forceinline__ void transpose_item(const float* __restrict__ W, int K, int N, bf16_t* __restrict__ dst, int ld, int koff, int mode, int rowoff, const float* __restrict__ gain, LAS float* scr, int item, int lane) {
    const int nblk = N / 32; const int kb = item / nblk, nb = item % nblk, k0 = 64 * kb, n0 = 32 * nb;
#pragma unroll 8
    for (int i = 0; i < 32; ++i) { const int kk = 2 * i + (lane >> 5); float v = W[(size_t)(k0 + kk) * N + n0 + (lane & 31)]; if (gain) v *= gain[k0 + kk]; scr[kk * 33 + (lane & 31)] = v; }
    asm volatile("s_waitcnt lgkmcnt(0)" ::: "memory");
    const int c = lane & 7;
#pragma unroll
    for (int j = 0; j < 4; ++j) { const int n = (lane >> 3) + 8 * j; const LAS float* s = scr + (8 * c) * 33 + n;
        u32x4 o; o.x = pk2(s[0 * 33], s[1 * 33]); o.y = pk2(s[2 * 33], s[3 * 33]); o.z = pk2(s[4 * 33], s[5 * 33]); o.w = pk2(s[6 * 33], s[7 * 33]);
        *(u32x4*)(dst + (size_t)map_row(mode, n0 + n, rowoff) * ld + koff + k0 + 8 * c) = o; }
    asm volatile("s_waitcnt lgkmcnt(0)" ::: "memory");
}
__device__ __forceinline__ void transpose_item_f8(const float* __restrict__ W, int K, int N, unsigned char* __restrict__ dst, int ld, int mode, int rowoff, float scale, LAS float* scr, int item, int lane) {
    const int nblk = N / 32; const int kb = item / nblk, nb = item % nblk, k0 = 64 * kb, n0 = 32 * nb;
#pragma unroll 8
    for (int i = 0; i < 32; ++i) { const int kk = 2 * i + (lane >> 5); scr[kk * 33 + (lane & 31)] = W[(size_t)(k0 + kk) * N + n0 + (lane & 31)] * scale; }
    asm volatile("s_waitcnt lgkmcnt(0)" ::: "memory");
    const int c = lane & 7;
#pragma unroll
    for (int j = 0; j < 4; ++j) { const int n = (lane >> 3) + 8 * j; const LAS float* s = scr + (8 * c) * 33 + n;
        u32x2 o; o.x = pk4_f8(s[0 * 33], s[1 * 33], s[2 * 33], s[3 * 33]); o.y = pk4_f8(s[4 * 33], s[5 * 33], s[6 * 33], s[7 * 33]);
        *(u32x2*)(dst + (size_t)map_row(mode, n0 + n, rowoff) * ld + k0 + 8 * c) = o; }
    asm volatile("s_waitcnt lgkmcnt(0)" ::: "memory");
}
struct TrJob8 { const float* W; unsigned char* dst; int K, N, ld, mode, rowoff; float scale; };
__device__ __forceinline__ void ph_transpose_f8(const TrJob8& J, LAS float* scr, int gw, int ngw, int lane) {
    lane = opq(lane);
    const int nitems = (J.K / 64) * (J.N / 32);
    for (int it = gw; it < nitems; it += ngw) transpose_item_f8(J.W, J.K, J.N, J.dst, J.ld, J.mode, J.rowoff, J.scale, scr, it, lane);
}
struct TrJob { const float* W; const float* gain; bf16_t* dst; int K, N, ld, koff, mode, rowoff; };
__device__ __forceinline__ void ph_transpose(const TrJob& J, LAS float* scr, int gw, int ngw, int lane) {
    lane = opq(lane);
    const int nitems = (J.K / 64) * (J.N / 32);
    for (int it = gw; it < nitems; it += ngw) transpose_item(J.W, J.K, J.N, J.dst, J.ld, J.koff, J.mode, J.rowoff, J.gain, scr, it, lane);
}
__device__ __forceinline__ const float* hrow_c(const float* out, const float* hmeta, int row) { return row < RREAL ? out + (size_t)row * D : hmeta + (size_t)(row - RREAL) * D; }
__device__ __forceinline__ void ph_init(const float* __restrict__ x, const float* __restrict__ meta, float* __restrict__ out, float* __restrict__ hmeta, float* __restrict__ rope,
                                        const float* __restrict__ v1, const float* __restrict__ v2, bf16_t* __restrict__ v12t, size_t gt, size_t ngt) {
    (void)x; (void)out;
    for (size_t i = gt; i < (size_t)256 * D; i += ngt) hmeta[i] = i < (size_t)NMETA * D ? meta[i] : 0.f;
    for (size_t i = gt; i < (size_t)4112 * 32; i += ngt) { const int pos = (int)(i / 32), j = (int)(i % 32);
        const float inv = powf(10000.0f, -(float)j / 32.0f); const float ang = (float)pos * inv; rope[2 * i] = cosf(ang); rope[2 * i + 1] = sinf(ang); }
    for (size_t i = gt; i < (size_t)512 * 512; i += ngt) { const int n = (int)(i >> 9), k = (int)(i & 511); float s = 0.f;
#pragma unroll 8
        for (int j = 0; j < 32; ++j) s += v1[k * 32 + j] * v2[j * 512 + n];
        v12t[i] = f2bf(s); }
}
__device__ __forceinline__ void ph_rmsnorm(const float* __restrict__ out, const float* hmeta, const float* __restrict__ g, bf16_t* __restrict__ U, const float* __restrict__ part, int nsl, int gw, int ngw, int lane) {
    lane = opq(lane);
    for (int row = gw; row < RP; row += ngw) {
        unsigned long long* o8 = (unsigned long long*)(U + (size_t)row * D) + lane;
        if (row >= RVALID) {
#pragma unroll
            for (int j = 0; j < 4; ++j) o8[64 * j] = 0ull;
            continue; }
        const f32x4* xr = (const f32x4*)hrow_c(out, hmeta, row) + lane; const f32x4* g4 = (const f32x4*)g + lane;
        f32x4 v[4]; float s = 0.f;
#pragma unroll
        for (int j = 0; j < 4; ++j) v[j] = xr[64 * j];
        if (row >= RREAL && nsl > 0) {
            for (int sl = 0; sl < nsl; ++sl) { const f32x4* pr = (const f32x4*)(part + ((size_t)sl * NMETA + (row - RREAL)) * D) + lane;
#pragma unroll
                for (int j = 0; j < 4; ++j) v[j] = v[j] + pr[64 * j]; }
            f32x4* hw = (f32x4*)xr;
#pragma unroll
            for (int j = 0; j < 4; ++j) hw[64 * j] = v[j]; }
#pragma unroll
        for (int j = 0; j < 4; ++j) s += (v[j].x * v[j].x + v[j].y * v[j].y) + (v[j].z * v[j].z + v[j].w * v[j].w);
        const float rstd = rsqrtf(wave_sum(s) * (1.f / D) + RMS_EPS);
#pragma unroll
        for (int j = 0; j < 4; ++j) { const f32x4 gg = g4[64 * j]; o8[64 * j] = (unsigned long long)pk2(v[j].x * rstd * gg.x, v[j].y * rstd * gg.y) | ((unsigned long long)pk2(v[j].z * rstd * gg.z, v[j].w * rstd * gg.w) << 32); }
    }
}
__device__ __forceinline__ void unpack8(const u32x4 v, float (&f)[8]) {
    f[0] = __uint_as_float(v.x << 16); f[1] = __uint_as_float(v.x & 0xffff0000u); f[2] = __uint_as_float(v.y << 16); f[3] = __uint_as_float(v.y & 0xffff0000u);
    f[4] = __uint_as_float(v.z << 16); f[5] = __uint_as_float(v.z & 0xffff0000u); f[6] = __uint_as_float(v.w << 16); f[7] = __uint_as_float(v.w & 0xffff0000u);
}
__device__ __forceinline__ void ph_prep(const bf16_t* __restrict__ PM, const bf16_t* __restrict__ PR, const float* __restrict__ mu, const float* __restrict__ rope,
                                        float* __restrict__ rstdq, float* __restrict__ rstdkv, bf16_t* __restrict__ KR, bf16_t* __restrict__ LIN, bf16_t* __restrict__ VSH, int do_vsh, int gw, int ngw, int lane) {
    lane = opq(lane);
    for (int row = gw; row < RP; row += ngw) {
        const bf16_t* pm = PM + (size_t)row * PMW;
        float f[8], sq = 0.f, skv = 0.f;
        unpack8(*(const u32x4*)(pm + lane * 8), f);
#pragma unroll
        for (int j = 0; j < 8; ++j) sq += f[j] * f[j];
        if (lane < 32) { unpack8(*(const u32x4*)(pm + 512 + lane * 8), f);
#pragma unroll
            for (int j = 0; j < 8; ++j) skv += f[j] * f[j]; }
        sq = wave_sum(sq); skv = wave_sum(skv);
        if (lane == 0) { rstdq[row] = rsqrtf(sq * (1.f / 512.f) + RMS_EPS); rstdkv[row] = rsqrtf(skv * (1.f / 256.f) + RMS_EPS); }
        const int pos = row_pos(row);
        if (lane < 32) { const float x1 = bf2f(pm[768 + lane]), x2 = bf2f(pm[800 + lane]); const float c = rope[2 * (pos * 32 + lane)], s = rope[2 * (pos * 32 + lane) + 1];
            KR[(size_t)row * 64 + lane] = f2bf(x1 * c - x2 * s); KR[(size_t)row * 64 + 32 + lane] = f2bf(x1 * s + x2 * c); }
        const int pr = row_prev(row); const bool valid = row < RVALID; const float pmk = pr < 0 ? 0.f : 1.f;
        const bf16_t* x = PR + (size_t)row * PRW; const bf16_t* xp = PR + (size_t)(pr < 0 ? row : pr) * PRW;
        if (lane < 32) {
            float a[8], b[8]; unpack8(*(const u32x4*)(x + 1536 + lane * 8), a); unpack8(*(const u32x4*)(xp + 1536 + lane * 8), b);
            const f32x4 m0 = *(const f32x4*)(mu + 1536 + lane * 8), m1 = *(const f32x4*)(mu + 1536 + lane * 8 + 4); const float mm[8] = {m0.x, m0.y, m0.z, m0.w, m1.x, m1.y, m1.z, m1.w};
            float o[8];
#pragma unroll
            for (int j = 0; j < 8; ++j) { float v = a[j] + (pmk * b[j] - a[j]) * mm[j]; v = lane < 8 ? tanhf(v) : (lane < 16 ? v : sigmoidf_(v)); o[j] = valid ? v : 0.f; }
            u32x4 w; w.x = pk2(o[0], o[1]); w.y = pk2(o[2], o[3]); w.z = pk2(o[4], o[5]); w.w = pk2(o[6], o[7]); *(u32x4*)(LIN + (size_t)row * 256 + lane * 8) = w; }
        if (do_vsh) {
            float a[8], b[8]; unpack8(*(const u32x4*)(x + 1024 + lane * 8), a); unpack8(*(const u32x4*)(xp + 1024 + lane * 8), b);
            const f32x4 m0 = *(const f32x4*)(mu + 1024 + lane * 8), m1 = *(const f32x4*)(mu + 1024 + lane * 8 + 4); const float mm[8] = {m0.x, m0.y, m0.z, m0.w, m1.x, m1.y, m1.z, m1.w};
            float o[8];
#pragma unroll
            for (int j = 0; j < 8; ++j) { const float v = a[j] + (pmk * b[j] - a[j]) * mm[j]; o[j] = valid ? v : 0.f; }
            u32x4 w; w.x = pk2(o[0], o[1]); w.y = pk2(o[2], o[3]); w.z = pk2(o[4], o[5]); w.w = pk2(o[6], o[7]); *(u32x4*)(VSH + (size_t)row * 512 + lane * 8) = w; }
    }
}

__device__ __forceinline__ void ph_norm_route(LAS unsigned char* lds, const float* __restrict__ out, const float* __restrict__ g, const float* __restrict__ router, const float* __restrict__ rbias,
                                              bf16_t* __restrict__ U, int* __restrict__ TE, float* __restrict__ TG, int* __restrict__ STOK, unsigned* __restrict__ ctl, int bid, int nblk, int wave, int lane) {
    lane = opq(lane); nblk = opqs(nblk); bid = opqs(bid);
    { constexpr int NFILL = 2 * MOE_MAXPAN * 256 + RREAL; const int per = (NFILL + nblk - 1) / nblk; const int t_ = wave * 64 + lane;
      for (int i = t_; i < per; i += 512) { const int idx = bid * per + i; if (idx < NFILL) STOK[idx] = -1; } }
    const int rpw = (RREAL + nblk - 1) / nblk, rpwave = (rpw + 7) / 8;
    int c1[8], c2[8];
#pragma unroll
    for (int e = 0; e < 8; ++e) { c1[e] = 0; c2[e] = 0; }
    for (int k = 0; k < rpwave; ++k) { const int rl = wave * rpwave + k; const int row = bid * rpw + rl; if (rl >= rpw || row >= RREAL) break;
        const f32x4* xr = (const f32x4*)(out + (size_t)row * D) + lane; const f32x4* g4 = (const f32x4*)g + lane;
        f32x4 v[4]; float s = 0.f;
#pragma unroll
        for (int j = 0; j < 4; ++j) { v[j] = xr[64 * j]; s += (v[j].x * v[j].x + v[j].y * v[j].y) + (v[j].z * v[j].z + v[j].w * v[j].w); }
        const float rstd = rsqrtf(wave_sum(s) * (1.f / D) + RMS_EPS);
        unsigned* o4 = (unsigned*)((unsigned char*)U + (size_t)row * D) + lane;
        float lg[8];
#pragma unroll
        for (int e = 0; e < 8; ++e) lg[e] = 0.f;
#pragma unroll
        for (int j = 0; j < 4; ++j) { const f32x4 gg = g4[64 * j]; f32x4 xn; xn.x = v[j].x * rstd * gg.x; xn.y = v[j].y * rstd * gg.y; xn.z = v[j].z * rstd * gg.z; xn.w = v[j].w * rstd * gg.w;
            o4[64 * j] = pk4_f8(xn.x * F8_ACT, xn.y * F8_ACT, xn.z * F8_ACT, xn.w * F8_ACT);
            const int d0 = 4 * (lane + 64 * j);
#pragma unroll
            for (int q = 0; q < 4; ++q) { const f32x4 ra = *(const f32x4*)(router + (size_t)(d0 + q) * 8), rb = *(const f32x4*)(router + (size_t)(d0 + q) * 8 + 4); const float xv = xn[q];
                lg[0] += xv * ra.x; lg[1] += xv * ra.y; lg[2] += xv * ra.z; lg[3] += xv * ra.w; lg[4] += xv * rb.x; lg[5] += xv * rb.y; lg[6] += xv * rb.z; lg[7] += xv * rb.w; }
            asm volatile("" ::: "memory"); }
#pragma unroll
        for (int e = 0; e < 8; ++e) { float t_ = wave_sum(lg[e]); asm volatile("" : "+v"(t_)); lg[e] = t_ + rbias[e]; }
        int e1 = 0; float l1 = lg[0];
#pragma unroll
        for (int e = 1; e < 8; ++e) if (lg[e] > l1) { l1 = lg[e]; e1 = e; }
        int e2 = e1 == 0 ? 1 : 0; float l2 = -INFINITY;
#pragma unroll
        for (int e = 0; e < 8; ++e) if (e != e1 && lg[e] > l2) { l2 = lg[e]; e2 = e; }
        const float g1 = 1.0f / (1.0f + __expf(l2 - l1)), g2 = 1.0f - g1;
        { const int e1v = e1, e2v = e2;
#pragma unroll
        for (int e = 0; e < 8; ++e) { c1[e] += (e1v == e) ? 1 : 0; c2[e] += (e2v == e) ? 1 : 0; } }
        if (lane == 0) { TE[row] = e1; TE[RREAL + row] = e2; TG[row] = g1; TG[RREAL + row] = g2; }
    }
    LAS int* wc = (LAS int*)(lds + 80000);
    if (lane == 0) {
#pragma unroll
        for (int e = 0; e < 8; ++e) { wc[wave * 16 + e] = c1[e]; wc[wave * 16 + 8 + e] = c2[e]; } }
    __syncthreads();
    const int t = wave * 64 + lane;
    if (t < 16) { int sum = 0;
#pragma unroll
        for (int ww = 0; ww < 8; ++ww) sum += wc[ww * 16 + t];
        ctl[CW_WGCNT + bid * 16 + t] = (unsigned)sum; }
}
__device__ __forceinline__ void ph_moe_assign(LAS unsigned char* lds, int list, const int* __restrict__ TE, const float* __restrict__ TG, int* __restrict__ STOK, float* __restrict__ SGATE, int* __restrict__ BE, unsigned* __restrict__ ctl,
                                              const unsigned char* __restrict__ U8, unsigned char* __restrict__ XB, int bid, int nblk, int tid) {
    LAS int* sh = (LAS int*)lds;
    __syncthreads();
    if (tid < 8) { int tot = 0, pre = 0;
        for (int b = 0; b < nblk; ++b) { const int v = (int)ctl[CW_WGCNT + b * 16 + 8 * list + tid]; tot += v; pre += b < bid ? v : 0; }
        sh[tid] = tot; sh[8 + tid] = pre; }
    __syncthreads();
    if (tid == 0) { int pan = 0;
        for (int e = 0; e < 8; ++e) { const int np = (sh[e] + 255) >> 8; sh[16 + e] = pan << 8;
            if (bid == 0) for (int q = 0; q < np; ++q) { const int pi = pan + q; BE[256 * list + pi + (list == 1 && pi >= MOE_TAILPAN ? MOE_GAP : 0)] = e; }
            pan += np; }
        if (bid == 0) ctl[CW_NPAN + list] = (unsigned)pan; }
    __syncthreads();
    if (tid < 64) {
        const int rpw = (RREAL + nblk - 1) / nblk; int run[8];
#pragma unroll
        for (int q = 0; q < 8; ++q) run[q] = 0;
        for (int r0 = 0; r0 < rpw; r0 += 64) { const int rl = r0 + tid, row = bid * rpw + rl; const bool ok = rl < rpw && row < RREAL;
            const int ee = ok ? TE[list * RREAL + row] : -1; int slot = -1;
#pragma unroll
            for (int e = 0; e < 8; ++e) { const unsigned long long m = __builtin_amdgcn_ballot_w64(ee == e);
                const int rank = (int)__builtin_amdgcn_mbcnt_hi((unsigned)(m >> 32), __builtin_amdgcn_mbcnt_lo((unsigned)m, 0u));
                if (ee == e) { slot = sh[16 + e] + sh[8 + e] + run[e] + rank; if (list == 1 && slot >= MOE_TAILPAN * 256) slot += MOE_GAP * 256; }
                run[e] += __builtin_popcountll(m); }
            if (rl < rpw) sh[32 + rl] = ok ? slot : -1;
            if (ok) { STOK[list * (MOE_MAXPAN * 256) + slot] = row; SGATE[list * (MOE_MAXPAN * 256) + slot] = TG[list * RREAL + row];
                if (list == 1 && slot >= (MOE_TAILPAN + MOE_GAP) * 256) STOK[2 * MOE_MAXPAN * 256 + row] = slot - (MOE_TAILPAN + MOE_GAP) * 256; } }
    }
    __syncthreads();
    {
        const int rpw = (RREAL + nblk - 1) / nblk, w = tid >> 6, ln = tid & 63; unsigned char* xl = XB + (size_t)list * (MOE_MAXPAN * 256) * 1024;
        for (int rl = w; rl < rpw; rl += 8) { const int slot = sh[32 + rl]; if (slot >= 0) ((u32x4*)(xl + (size_t)slot * 1024))[ln] = ((const u32x4*)(U8 + (size_t)(bid * rpw + rl) * 1024))[ln]; }
        if (bid < 8) { const int e = bid, lo = sh[16 + e] + sh[e], hi = sh[16 + e] + (((sh[e] + 255) >> 8) << 8); unsigned z0 = 0u; asm volatile("" : "+v"(z0)); u32x4 z; z.x = z.y = z.z = z.w = z0;
            for (int p0 = lo + w; p0 < hi; p0 += 8) { const int slot = p0 + ((list == 1 && p0 >= MOE_TAILPAN * 256) ? MOE_GAP * 256 : 0); ((u32x4*)(xl + (size_t)slot * 1024))[ln] = z; } }
    }
}
__device__ __forceinline__ void ph_final(float* __restrict__ out, const float* __restrict__ g, const int* __restrict__ tslot, const float* __restrict__ tb, int gw, int ngw, int lane, float pscale = 1.0f) {
    lane = opq(lane);
    for (int row = gw; row < RREAL; row += ngw) {
        f32x4* xr = (f32x4*)(out + (size_t)row * D) + lane; const f32x4* g4 = (const f32x4*)g + lane;
        const int ts = __builtin_amdgcn_readfirstlane(tslot[row]);
        f32x4 v[4]; float s = 0.f;
#pragma unroll
        for (int j = 0; j < 4; ++j) v[j] = xr[64 * j];
        if (ts >= 0) { const f32x4* tr = (const f32x4*)(tb + (size_t)ts * D) + lane;
#pragma unroll
            for (int j = 0; j < 4; ++j) v[j] = v[j] + tr[64 * j]; }
#pragma unroll
        for (int j = 0; j < 4; ++j) s += (v[j].x * v[j].x + v[j].y * v[j].y) + (v[j].z * v[j].z + v[j].w * v[j].w);
        const float rstd = rsqrtf(wave_sum(s) * (1.f / D) + RMS_EPS);
#pragma unroll
        for (int j = 0; j < 4; ++j) { const f32x4 gg = g4[64 * j]; f32x4 o; o.x = v[j].x * rstd * gg.x * pscale; o.y = v[j].y * rstd * gg.y * pscale; o.z = v[j].z * rstd * gg.z * pscale; o.w = v[j].w * rstd * gg.w * pscale; xr[64 * j] = o; }
    }
}

constexpr int KS_STRIDE = 200, VS_STRIDE = 72;
constexpr int ATT_LDS = 64 * KS_STRIDE * 2 + 128 * VS_STRIDE * 2;
__device__ __forceinline__ bf16x8 pack8(const f32x16& x, int s) {
    u32x4 p;
    if (s == 0) { p.x = cvtpk(x[0], x[1]); p.y = cvtpk(x[2], x[3]); p.z = cvtpk(x[4], x[5]); p.w = cvtpk(x[6], x[7]); }
    else { p.x = cvtpk(x[8], x[9]); p.y = cvtpk(x[10], x[11]); p.z = cvtpk(x[12], x[13]); p.w = cvtpk(x[14], x[15]); }
    return __builtin_bit_cast(bf16x8, p);
}
__device__ __forceinline__ void attn_unit(LAS unsigned char* lds, const bf16_t* __restrict__ Q, const bf16_t* __restrict__ KN, const bf16_t* __restrict__ KR, const bf16_t* __restrict__ VT,
                                          bf16_t* __restrict__ MIX, const float* __restrict__ rope, int h, int qrow0, int kbase, int ntile, int wlim, bool wave_active) {
    const int tid = opq(threadIdx.x), lane = tid & 63, w = tid >> 6, r = lane & 31, hh = lane >> 5;
    LAS bf16_t* Ks = (LAS bf16_t*)lds; LAS bf16_t* Vs = (LAS bf16_t*)(lds + 64 * KS_STRIDE * 2);
    const int qrow = qrow0 + 32 * w + r;
    bf16x8 qf[12];
#pragma unroll
    for (int ks = 0; ks < 12; ++ks) qf[ks] = *(const GAS bf16x8*)(Q + (size_t)qrow * 768 + 192 * h + 16 * ks + 8 * hh);
    {
        const int pos = row_pos(qrow); const GAS float* rt = (const GAS float*)(rope + (size_t)pos * 64);
#pragma unroll
        for (int half = 0; half < 2; ++half) { const GAS float* cs = rt + 2 * (16 * half + 8 * hh);
#pragma unroll
            for (int j = 0; j < 8; ++j) { const float c = cs[2 * j], sn = cs[2 * j + 1]; const float x1 = bf2f((bf16_t)qf[8 + half][j]), x2 = bf2f((bf16_t)qf[10 + half][j]);
                qf[8 + half][j] = (short)f2bf(x1 * c - x2 * sn); qf[10 + half][j] = (short)f2bf(x1 * sn + x2 * c); } }
    }
    float z0 = 0.f; asm volatile("" : "+v"(z0));
    f32x16 oacc[4];
#pragma unroll
    for (int i = 0; i < 4; ++i)
#pragma unroll
        for (int j = 0; j < 16; ++j) oacc[i][j] = z0;
    float mrun = -INFINITY, lsum = 0.f;
    const float sc = 0.07216878364870322f * 1.4426950408889634f;
    u32x4 kreg[3], vreg[2];
    const unsigned kn_off0 = (unsigned)(((tid >> 4) * 512 + h * 128 + (tid & 15) * 8) * 2), kn_off1 = kn_off0 + 32u * 512u * 2u;
    const unsigned kr_off = (unsigned)(((tid >> 3) * 64 + (tid & 7) * 8) * 2);
    const unsigned vt_off0 = (unsigned)((((size_t)(h * 128 + (tid >> 3))) * RP + (tid & 7) * 8) * 2), vt_off1 = vt_off0 + 64u * (unsigned)RP * 2u;
#define ATT_GLOAD(tt_) do { const int krow0_ = (tt_) == 0 ? RREAL : kbase + 64 * ((tt_) - 1); \
    const char* knb_ = (const char*)KN + (size_t)krow0_ * 1024; const char* krb_ = (const char*)KR + (size_t)krow0_ * 128; const char* vtb_ = (const char*)VT + (size_t)krow0_ * 2; \
    kreg[0] = *(const GAS u32x4*)(knb_ + kn_off0); kreg[1] = *(const GAS u32x4*)(knb_ + kn_off1); kreg[2] = *(const GAS u32x4*)(krb_ + kr_off); \
    vreg[0] = *(const GAS u32x4*)(vtb_ + vt_off0); vreg[1] = *(const GAS u32x4*)(vtb_ + vt_off1); } while (0)
    ATT_GLOAD(0);
    for (int tt = 0; tt < ntile; ++tt) {
#ifdef PROBE_ATT_STAGE2
        __syncthreads();
        *(LAS u32x4*)(Ks + (tid >> 4) * KS_STRIDE + (tid & 15) * 8) = kreg[0]; *(LAS u32x4*)(Ks + (32 + (tid >> 4)) * KS_STRIDE + (tid & 15) * 8) = kreg[1];
        *(LAS u32x4*)(Ks + (tid >> 3) * KS_STRIDE + 128 + (tid & 7) * 8) = kreg[2];
#pragma unroll
        for (int i = 0; i < 2; ++i) {
            LAS u32x2* d = (LAS u32x2*)(Vs + ((tid >> 3) + 64 * i) * VS_STRIDE + ((tid & 7) >> 1) * 16 + (tid & 1) * 4);
            u32x2 lo; lo.x = vreg[i].x; lo.y = vreg[i].y; u32x2 hi; hi.x = vreg[i].z; hi.y = vreg[i].w; d[0] = lo; d[2] = hi; }
        __syncthreads();
#endif
        __syncthreads();
        *(LAS u32x4*)(Ks + (tid >> 4) * KS_STRIDE + (tid & 15) * 8) = kreg[0]; *(LAS u32x4*)(Ks + (32 + (tid >> 4)) * KS_STRIDE + (tid & 15) * 8) = kreg[1];
        *(LAS u32x4*)(Ks + (tid >> 3) * KS_STRIDE + 128 + (tid & 7) * 8) = kreg[2];
#pragma unroll
        for (int i = 0; i < 2; ++i) {
            LAS u32x2* d = (LAS u32x2*)(Vs + ((tid >> 3) + 64 * i) * VS_STRIDE + ((tid & 7) >> 1) * 16 + (tid & 1) * 4);
            u32x2 lo; lo.x = vreg[i].x; lo.y = vreg[i].y; u32x2 hi; hi.x = vreg[i].z; hi.y = vreg[i].w; d[0] = lo; d[2] = hi; }
        __syncthreads();
        const bool comp = wave_active && tt <= wlim;
        if (tt + 1 < ntile) ATT_GLOAD(tt + 1);
        if (comp) {
            f32x16 sacc[2];
#pragma unroll
            for (int b = 0; b < 2; ++b)
#pragma unroll
                for (int j = 0; j < 16; ++j) sacc[b][j] = z0;
#ifdef PROBE_ATT_QK2
            {
            __builtin_amdgcn_sched_barrier(0);
            {
                const LAS bf16_t* kb0 = Ks + r * KS_STRIDE + 8 * hh;
                bf16x8 kf[6];
#pragma unroll
                for (int i = 0; i < 6; ++i) kf[i] = *(const LAS bf16x8*)(kb0 + 16 * i);
#pragma unroll
                for (int i = 0; i < 24; ++i) { sacc[i / 12] = __builtin_amdgcn_mfma_f32_32x32x16_bf16(kf[i % 6], qf[i % 12], sacc[i / 12], 0, 0, 0);
                    if (i + 6 < 24) kf[i % 6] = *(const LAS bf16x8*)(kb0 + ((i + 6) / 12) * 32 * KS_STRIDE + 16 * ((i + 6) % 12)); }
                __builtin_amdgcn_sched_group_barrier(0x100, 6, 0);
#pragma unroll
                for (int i = 0; i < 18; ++i) { __builtin_amdgcn_sched_group_barrier(0x008, 1, 0); __builtin_amdgcn_sched_group_barrier(0x100, 1, 0); }
                __builtin_amdgcn_sched_group_barrier(0x008, 6, 0);
            }
            __builtin_amdgcn_sched_barrier(0);
                asm volatile("" : "+v"(sacc[0][0]), "+v"(sacc[1][0]));
#pragma unroll
                for (int b = 0; b < 2; ++b)
#pragma unroll
                    for (int j = 0; j < 16; ++j) sacc[b][j] = z0;
            }
#endif
            __builtin_amdgcn_sched_barrier(0);
            {
                const LAS bf16_t* kb0 = Ks + r * KS_STRIDE + 8 * hh;
                bf16x8 kf[6];
#pragma unroll
                for (int i = 0; i < 6; ++i) kf[i] = *(const LAS bf16x8*)(kb0 + 16 * i);
#pragma unroll
                for (int i = 0; i < 24; ++i) { sacc[i / 12] = __builtin_amdgcn_mfma_f32_32x32x16_bf16(kf[i % 6], qf[i % 12], sacc[i / 12], 0, 0, 0);
                    if (i + 6 < 24) kf[i % 6] = *(const LAS bf16x8*)(kb0 + ((i + 6) / 12) * 32 * KS_STRIDE + 16 * ((i + 6) % 12)); }
                __builtin_amdgcn_sched_group_barrier(0x100, 6, 0);
#pragma unroll
                for (int i = 0; i < 18; ++i) { __builtin_amdgcn_sched_group_barrier(0x008, 1, 0); __builtin_amdgcn_sched_group_barrier(0x100, 1, 0); }
                __builtin_amdgcn_sched_group_barrier(0x008, 6, 0);
            }
            __builtin_amdgcn_sched_barrier(0);
            if (tt == 0) {
#pragma unroll
                for (int j = 8; j < 16; ++j) sacc[0][j] = -INFINITY;
#pragma unroll
                for (int j = 0; j < 16; ++j) sacc[1][j] = -INFINITY; }
            float tmax = fmaxf(sacc[0][0], sacc[1][0]);
#pragma unroll
            for (int j = 1; j < 16; ++j) tmax = fmaxf(tmax, fmaxf(sacc[0][j], sacc[1][j]));
            tmax = fmaxf(tmax, __int_as_float(__builtin_amdgcn_ds_bpermute((lane ^ 32) << 2, __float_as_int(tmax)))) * sc;
            const float mnew = fmaxf(mrun, tmax); const float alpha = __builtin_amdgcn_exp2f(mrun - mnew); mrun = mnew;
            float psum = 0.f;
#pragma unroll
            for (int b = 0; b < 2; ++b)
#pragma unroll
                for (int j = 0; j < 16; ++j) { const float p = __builtin_amdgcn_exp2f(__builtin_fmaf(sacc[b][j], sc, -mnew)); sacc[b][j] = p; psum += p; }
            lsum = lsum * alpha + psum;
            if (__builtin_amdgcn_ballot_w64(alpha != 1.0f) != 0ull) {
#pragma unroll
            for (int i = 0; i < 4; ++i)
#pragma unroll
                for (int j = 0; j < 16; ++j) oacc[i][j] *= alpha; }
            bf16x8 pf[4];
            pf[0] = pack8(sacc[0], 0); pf[1] = pack8(sacc[0], 1); pf[2] = pack8(sacc[1], 0); pf[3] = pack8(sacc[1], 1);
#ifdef PROBE_ATT_PV2
            {
                const LAS bf16_t* vb0 = Vs + r * VS_STRIDE + 8 * hh;
#pragma unroll
                for (int j = 0; j < 16; ++j) { sacc[0][j] = z0; sacc[1][j] = z0; }
#pragma unroll
                for (int i = 0; i < 16; ++i) { const bf16x8 vfd = *(const LAS bf16x8*)(vb0 + 32 * (i >> 2) * VS_STRIDE + 16 * (i & 3));
                    sacc[i & 1] = __builtin_amdgcn_mfma_f32_32x32x16_bf16(vfd, pf[i & 3], sacc[i & 1], 0, 0, 0); }
                asm volatile("" :: "v"(sacc[0][0]), "v"(sacc[1][0]));
            }
#endif
            __builtin_amdgcn_sched_barrier(0);
            {
                const LAS bf16_t* vb0 = Vs + r * VS_STRIDE + 8 * hh;
                bf16x8 vf[16];
#pragma unroll
                for (int i = 0; i < 16; ++i) vf[i] = *(const LAS bf16x8*)(vb0 + 32 * (i >> 2) * VS_STRIDE + 16 * (i & 3));
#pragma unroll
                for (int i = 0; i < 16; ++i) oacc[i >> 2] = __builtin_amdgcn_mfma_f32_32x32x16_bf16(vf[i], pf[i & 3], oacc[i >> 2], 0, 0, 0);
                __builtin_amdgcn_sched_group_barrier(0x100, 8, 1);
#pragma unroll
                for (int i = 0; i < 8; ++i) { __builtin_amdgcn_sched_group_barrier(0x008, 1, 1); __builtin_amdgcn_sched_group_barrier(0x100, 1, 1); }
                __builtin_amdgcn_sched_group_barrier(0x008, 8, 1);
            }
            __builtin_amdgcn_sched_barrier(0);
        }
    }
    if (wave_active) {
        const float ltot = lsum + __int_as_float(__builtin_amdgcn_ds_bpermute((lane ^ 32) << 2, __float_as_int(lsum))); const float inv = 1.0f / ltot;
        bf16_t* orow = MIX + (size_t)qrow * D + 128 * h;
#pragma unroll
        for (int dvb = 0; dvb < 4; ++dvb)
#pragma unroll
            for (int g = 0; g < 4; ++g) { u32x2 o; o.x = cvtpk(oacc[dvb][4 * g] * inv, oacc[dvb][4 * g + 1] * inv); o.y = cvtpk(oacc[dvb][4 * g + 2] * inv, oacc[dvb][4 * g + 3] * inv);
                *(GAS u32x2*)(orow + 32 * dvb + 8 * g + 4 * hh) = o; }
    }
    __syncthreads();
}
__device__ __forceinline__ void attn_phase(LAS unsigned char* lds, const bf16_t* Q, const bf16_t* KN, const bf16_t* KR, const bf16_t* VT, bf16_t* MIX, const float* rope, int bid, int nblk) {
    const int w = opq(threadIdx.x) >> 6;
    for (int s = bid; s < 512; s += nblk) {
        const int round = s >> 8, x = s & 255; const int bh = (x >> 4) + 16 * round, qb = round ? 15 - (x & 15) : (x & 15);
        const int b = bh >> 2, h = bh & 3;
        attn_unit(lds, Q, KN, KR, VT, MIX, rope, h, b * SEQ + 256 * qb, b * SEQ, 4 * qb + 5, 4 * qb + (w >> 1) + 1, true);
    }
    for (int s = bid; s < 4; s += nblk)
        attn_unit(lds, Q, KN, KR, VT, MIX, rope, s, RREAL, 0, 1, 0, w == 0);
}

constexpr int CLS = 72;
constexpr int CSLOT = 64 * CLS * 2;
constexpr int CHK_BYTES = 32768;
constexpr int NSEQ_HALF0 = 257;
struct CpP { const bf16_t* PR; const bf16_t* LO; const bf16_t* VMIX; const bf16_t* VFIRST; bf16_t* VP; float* RK; unsigned char* CHK;
    const float *mu, *w0, *a0, *k_k, *k_a, *r_k, *v0; int layer, pad; };

__device__ __forceinline__ void mm64(f32x16& acc, const LAS bf16_t* a, const LAS bf16_t* b, int r, int hh) {
    bf16x8 af[4], bf[4];
#pragma unroll
    for (int ks = 0; ks < 4; ++ks) { af[ks] = *(const LAS bf16x8*)(a + r * CLS + 16 * ks + 8 * hh); bf[ks] = *(const LAS bf16x8*)(b + r * CLS + 16 * ks + 8 * hh); }
#pragma unroll
    for (int ks = 0; ks < 4; ++ks) acc = __builtin_amdgcn_mfma_f32_32x32x16_bf16(af[ks], bf[ks], acc, 0, 0, 0);
}
__device__ __forceinline__ void st_tile(const f32x16& acc, LAS bf16_t* dst, int m0, int n0, int r, int hh) {
#pragma unroll
    for (int q = 0; q < 16; ++q) dst[(m0 + (q & 3) + 8 * (q >> 2) + 4 * hh) * CLS + n0 + r] = f2bf_hw(acc[q]);
}
__device__ __forceinline__ void st_tile_t(const f32x16& acc, LAS bf16_t* dst, int m0, int n0, int r, int hh) {
#pragma unroll
    for (int g = 0; g < 4; ++g) { u32x2 o; o.x = cvtpk(acc[4 * g], acc[4 * g + 1]); o.y = cvtpk(acc[4 * g + 2], acc[4 * g + 3]);
        *(LAS u32x2*)(dst + (n0 + r) * CLS + m0 + 8 * g + 4 * hh) = o; }
}
__device__ __forceinline__ void zero16(f32x16& a, float z) {
#pragma unroll
    for (int q = 0; q < 16; ++q) a[q] = z;
}
struct CpRaw { bf16_t xr[9], xk[9], xv[9], lw[8], la[8], vm[8], vf[8]; float mu_r, mu_k, mu_v, w0, a0, kkc, kac, rkc, v0, pm0; };
__device__ __forceinline__ void cp_issue(const CpP& P, int row0, int hd, int w, int lane, CpRaw& R) {
    const int c = hd * 64 + lane;
    R.mu_r = ((const GAS float*)P.mu)[c]; R.mu_k = ((const GAS float*)P.mu)[512 + c]; R.mu_v = ((const GAS float*)P.mu)[1024 + c]; R.w0 = ((const GAS float*)P.w0)[c]; R.a0 = ((const GAS float*)P.a0)[c];
    R.kkc = ((const GAS float*)P.k_k)[c]; R.kac = ((const GAS float*)P.k_a)[c]; R.rkc = ((const GAS float*)P.r_k)[c]; R.v0 = P.layer ? ((const GAS float*)P.v0)[c] : 0.f;
    const int rw0 = row0 + 8 * w; const int prow0 = w == 0 ? row_prev(row0) : rw0 - 1; R.pm0 = prow0 < 0 ? 0.f : 1.f;
    { const GAS bf16_t* xp = (const GAS bf16_t*)(P.PR + (size_t)(prow0 < 0 ? rw0 : prow0) * PRW); R.xr[0] = xp[c]; R.xk[0] = xp[512 + c]; R.xv[0] = xp[1024 + c]; }
#pragma unroll
    for (int q = 0; q < 8; ++q) { const GAS bf16_t* x = (const GAS bf16_t*)(P.PR + (size_t)(rw0 + q) * PRW); R.xr[q + 1] = x[c]; R.xk[q + 1] = x[512 + c]; R.xv[q + 1] = x[1024 + c];
        const GAS bf16_t* lo = (const GAS bf16_t*)(P.LO + (size_t)(rw0 + q) * 1536); R.lw[q] = lo[c]; R.la[q] = lo[512 + c];
        if (P.layer) { R.vm[q] = ((const GAS bf16_t*)P.VMIX)[(size_t)(rw0 + q) * 512 + c]; R.vf[q] = ((const GAS bf16_t*)P.VFIRST)[(size_t)(rw0 + q) * 512 + c]; } else { R.vm[q] = 0; R.vf[q] = 0; } }
}
__device__ __forceinline__ void rwkv_cp_task(LAS unsigned char* lds, const CpP& P, int row0, int hd, unsigned char* out, CpRaw& R, bool has_next, int nrow0, int nhd) {
    const int tid = opq(threadIdx.x), lane = tid & 63, w = __builtin_amdgcn_readfirstlane(tid >> 6), r = lane & 31, hh = lane >> 5;
    float z0 = 0.f; asm volatile("" : "+v"(z0));
    LAS bf16_t* S_ATtm = (LAS bf16_t*)(lds + 0 * CSLOT);
    LAS bf16_t* S_BHtm = (LAS bf16_t*)(lds + 1 * CSLOT);
    LAS bf16_t* S_KHtm = (LAS bf16_t*)(lds + 2 * CSLOT);
    LAS bf16_t* S_RTtm = (LAS bf16_t*)(lds + 3 * CSLOT);
    LAS bf16_t* S_ATcm = (LAS bf16_t*)(lds + 4 * CSLOT);
    LAS bf16_t* S_BBcm = (LAS bf16_t*)(lds + 5 * CSLOT);
    LAS bf16_t* S_KBcm = (LAS bf16_t*)(lds + 6 * CSLOT);
    LAS bf16_t* S_VTcm = (LAS bf16_t*)(lds + 7 * CSLOT);
    LAS bf16_t* S_Q0a = (LAS bf16_t*)(lds + 8 * CSLOT);
    LAS bf16_t* S_Q0b = (LAS bf16_t*)(lds + 9 * CSLOT);
    LAS bf16_t* S_PP0 = (LAS bf16_t*)(lds + 10 * CSLOT);
    LAS bf16_t* S_Na = (LAS bf16_t*)(lds + 11 * CSLOT);
    LAS bf16_t* S_XT = (LAS bf16_t*)(lds + 12 * CSLOT);
    LAS bf16_t* S_Pa = (LAS bf16_t*)(lds + 13 * CSLOT);
    LAS bf16_t* S_Qa = (LAS bf16_t*)(lds + 14 * CSLOT);
    LAS float* S_TOT = (LAS float*)(lds + 15 * CSLOT);
    LAS bf16_t* Qa[2] = {S_Q0a, S_ATtm}; LAS bf16_t* Qb[2] = {S_Q0b, S_BHtm}; LAS bf16_t* PPa[2] = {S_PP0, S_KHtm};

    {
        const int c = hd * 64 + lane;
        const float mu_r = R.mu_r, mu_k = R.mu_k, mu_v = R.mu_v, w0 = R.w0, a0 = R.a0, kkc = R.kkc, kac = R.kac, rkc = R.rkc, v0 = R.v0, pm0 = R.pm0;
        float fr[8], fk[8], fv[8], fa[8], fb[8], lw[8];
        const int rw0 = row0 + 8 * w;
#pragma unroll
        for (int q = 0; q < 8; ++q) { const int row = rw0 + q; const bool valid = row < RVALID; const float pm = q == 0 ? pm0 : 1.f;
            float rr = bf2f(R.xr[q + 1]), kk = bf2f(R.xk[q + 1]), vv = bf2f(R.xv[q + 1]);
            rr = rr + (pm * bf2f(R.xr[q]) - rr) * mu_r; kk = kk + (pm * bf2f(R.xk[q]) - kk) * mu_k; vv = vv + (pm * bf2f(R.xv[q]) - vv) * mu_v;
            const float wpre = bf2f(R.lw[q]), apre = bf2f(R.la[q]);
            constexpr float L2E = 1.4426950408889634f;
            float lwv = -0.6065306597126334f * __builtin_amdgcn_rcpf(1.0f + __builtin_amdgcn_exp2f(-(w0 + wpre) * L2E));
            const float asig = __builtin_amdgcn_rcpf(1.0f + __builtin_amdgcn_exp2f(-(a0 + apre) * L2E));
            if (P.layer) { const float vm = bf2f(R.vm[q]), vf = bf2f(R.vf[q]); vv = vv + (vf - vv) * __builtin_amdgcn_rcpf(1.0f + __builtin_amdgcn_exp2f(-(v0 + vm) * L2E)); }
            const float kkr = kk * kkc; const float ss = wave_sum(kkr * kkr); float kn = kkr * rsqrtf(fmaxf(ss, 1e-24f));
            float k2 = kk * (1.f + (asig - 1.f) * kac);
            const float rk = wave_sum(rr * k2 * rkc);
            if (!valid) { rr = 0.f; k2 = 0.f; vv = 0.f; kn = 0.f; lwv = 0.f; }
            ((GAS bf16_t*)P.VP)[(size_t)row * 512 + c] = f2bf_hw(vv); if (lane == 0) ((GAS float*)P.RK)[(size_t)row * 8 + hd] = valid ? rk : 0.f;
            fr[q] = rr; fk[q] = k2; fv[q] = vv; fa[q] = -kn; fb[q] = kn * asig; lw[q] = lwv; }
        if (has_next) cp_issue(P, nrow0, nhd, w, lane, R);
        float cum[8]; cum[0] = lw[0];
#pragma unroll
        for (int q = 1; q < 8; ++q) cum[q] = cum[q - 1] + lw[q];
        S_TOT[w * 64 + lane] = cum[7];
        lds_barrier();
        float off = 0.f, tot = 0.f;
#pragma unroll
        for (int ww = 0; ww < 8; ++ww) { const float tv = S_TOT[ww * 64 + lane]; off += ww < w ? tv : 0.f; tot += tv; }
        constexpr float L2E_ = 1.4426950408889634f;
        const float etot = __builtin_amdgcn_exp2f(tot * L2E_);
        if (w == 0) S_TOT[512 + lane] = etot;
        float at[8], bh[8], kh[8], rt[8], bb[8], kb[8];
        float ecprev = __builtin_amdgcn_exp2f(off * L2E_);
#pragma unroll
        for (int q = 0; q < 8; ++q) { const float ci = off + cum[q]; const float ec = __builtin_amdgcn_exp2f(ci * L2E_), ecp = ecprev, en = __builtin_amdgcn_rcpf(ec), ee = etot * en; ecprev = ec;
            rt[q] = fr[q] * ec; at[q] = fa[q] * ecp; bh[q] = fb[q] * en; kh[q] = fk[q] * en; bb[q] = fb[q] * ee; kb[q] = fk[q] * ee; }
#pragma unroll
        for (int q = 0; q < 8; ++q) { const int t = 8 * w + q; S_ATtm[t * CLS + lane] = f2bf_hw(at[q]); S_BHtm[t * CLS + lane] = f2bf_hw(bh[q]); S_KHtm[t * CLS + lane] = f2bf_hw(kh[q]); S_RTtm[t * CLS + lane] = f2bf_hw(rt[q]); }
        { u32x4 o;
          o.x = cvtpk(at[0], at[1]); o.y = cvtpk(at[2], at[3]); o.z = cvtpk(at[4], at[5]); o.w = cvtpk(at[6], at[7]); *(LAS u32x4*)(S_ATcm + lane * CLS + 8 * w) = o;
          o.x = cvtpk(bb[0], bb[1]); o.y = cvtpk(bb[2], bb[3]); o.z = cvtpk(bb[4], bb[5]); o.w = cvtpk(bb[6], bb[7]); *(LAS u32x4*)(S_BBcm + lane * CLS + 8 * w) = o;
          o.x = cvtpk(kb[0], kb[1]); o.y = cvtpk(kb[2], kb[3]); o.z = cvtpk(kb[4], kb[5]); o.w = cvtpk(kb[6], kb[7]); *(LAS u32x4*)(S_KBcm + lane * CLS + 8 * w) = o;
          o.x = cvtpk(fv[0], fv[1]); o.y = cvtpk(fv[2], fv[3]); o.z = cvtpk(fv[4], fv[5]); o.w = cvtpk(fv[6], fv[7]); *(LAS u32x4*)(S_VTcm + lane * CLS + 8 * w) = o; }
    }
    lds_barrier();
    const int q4 = w & 3, mb = q4 >> 1, nb = q4 & 1; const bool upper = (mb == 0 && nb == 1);
    f32x16 pacc;
    {
        f32x16 a0, a1; zero16(a0, z0); zero16(a1, z0);
        const LAS bf16_t* lhs = (w < 4 ? S_ATtm : S_RTtm) + 32 * mb * CLS;
        if (!upper) { mm64(a0, lhs, S_BHtm + 32 * nb * CLS, r, hh); mm64(a1, lhs, S_KHtm + 32 * nb * CLS, r, hh); }
        const int s = 32 * nb + r;
#pragma unroll
        for (int q = 0; q < 16; ++q) { const int t = 32 * mb + (q & 3) + 8 * (q >> 2) + 4 * hh; const bool keep = w < 4 ? (s < t) : (s <= t); if (!keep) { a0[q] = z0; a1[q] = z0; } }
        if (w < 4) { st_tile(a0, S_Q0a, 32 * mb, 32 * nb, r, hh); st_tile_t(a0, S_Q0b, 32 * mb, 32 * nb, r, hh); st_tile(a1, S_Na, 32 * mb, 32 * nb, r, hh);
            pacc = a0;
#pragma unroll
            for (int q = 0; q < 16; ++q) { const int t = 32 * mb + (q & 3) + 8 * (q >> 2) + 4 * hh; if (t == s) pacc[q] += 1.0f; }
            st_tile(pacc, S_PP0, 32 * mb, 32 * nb, r, hh); }
        else { st_tile(a0, S_Pa, 32 * mb, 32 * nb, r, hh); st_tile(a1, S_Qa, 32 * mb, 32 * nb, r, hh); zero16(pacc, z0); }
    }
    lds_barrier();
    {
        f32x16 a; zero16(a, z0);
        if (w >= 4) { if (!upper) { mm64(a, Qa[0] + 32 * mb * CLS, Qb[0] + 32 * nb * CLS, r, hh); } st_tile(a, Qa[1], 32 * mb, 32 * nb, r, hh); st_tile_t(a, Qb[1], 32 * mb, 32 * nb, r, hh); }
        else { mm64(a, S_Na + 32 * mb * CLS, S_VTcm + 32 * nb * CLS, r, hh); st_tile_t(a, S_XT, 32 * mb, 32 * nb, r, hh); }
    }
    lds_barrier();
#pragma unroll 1
    for (int k = 1; k <= 5; ++k) {
        const int rs = k & 1, ws_ = rs ^ 1;
        if (w < 4) { if (!upper) mm64(pacc, PPa[ws_] + 32 * mb * CLS, Qb[rs] + 32 * nb * CLS, r, hh); st_tile(pacc, PPa[rs], 32 * mb, 32 * nb, r, hh); }
        else if (k < 5) { f32x16 a; zero16(a, z0); if (!upper) mm64(a, Qa[rs] + 32 * mb * CLS, Qb[rs] + 32 * nb * CLS, r, hh); st_tile(a, Qa[ws_], 32 * mb, 32 * nb, r, hh); st_tile_t(a, Qb[ws_], 32 * mb, 32 * nb, r, hh); }
        lds_barrier();
    }
    {
        f32x16 a; zero16(a, z0);
        mm64(a, PPa[1] + 32 * mb * CLS, (w < 4 ? S_ATcm : S_XT) + 32 * nb * CLS, r, hh);
        st_tile_t(a, w < 4 ? S_Q0a : S_Q0b, 32 * mb, 32 * nb, r, hh);
    }
    lds_barrier();
    {
        LAS bf16_t* W1T = S_Q0a; LAS bf16_t* U1T = S_Q0b;
        f32x16 a, b; zero16(a, z0); zero16(b, z0);
        GAS u32x4* o128 = (GAS u32x4*)out;
        if (w < 4) {
            mm64(a, S_BBcm + 32 * mb * CLS, U1T + 32 * nb * CLS, r, hh); mm64(a, S_KBcm + 32 * mb * CLS, S_VTcm + 32 * nb * CLS, r, hh);
            mm64(b, W1T + 32 * mb * CLS, S_BBcm + 32 * nb * CLS, r, hh);
            const float gam = S_TOT[512 + 32 * nb + r];
#pragma unroll
            for (int q = 0; q < 16; ++q) { const int j = 32 * mb + (q & 3) + 8 * (q >> 2) + 4 * hh; if (j == 32 * nb + r) b[q] += gam; }
            u32x4 h0, h1, g0, g1;
            h0.x = cvtpk(a[0], a[1]); h0.y = cvtpk(a[2], a[3]); h0.z = cvtpk(a[4], a[5]); h0.w = cvtpk(a[6], a[7]);
            h1.x = cvtpk(a[8], a[9]); h1.y = cvtpk(a[10], a[11]); h1.z = cvtpk(a[12], a[13]); h1.w = cvtpk(a[14], a[15]);
            g0.x = cvtpk(b[0], b[1]); g0.y = cvtpk(b[2], b[3]); g0.z = cvtpk(b[4], b[5]); g0.w = cvtpk(b[6], b[7]);
            g1.x = cvtpk(b[8], b[9]); g1.y = cvtpk(b[10], b[11]); g1.z = cvtpk(b[12], b[13]); g1.w = cvtpk(b[14], b[15]);
            o128[1024 + ((mb * 2 + nb) * 64 + lane) * 2] = h0; o128[1024 + ((mb * 2 + nb) * 64 + lane) * 2 + 1] = h1;
            o128[(nb * 4 + 2 * mb) * 64 + lane] = g0; o128[(nb * 4 + 2 * mb + 1) * 64 + lane] = g1;
        } else {
            mm64(a, S_Pa + 32 * mb * CLS, U1T + 32 * nb * CLS, r, hh); mm64(a, S_Qa + 32 * mb * CLS, S_VTcm + 32 * nb * CLS, r, hh);
            mm64(b, W1T + 32 * mb * CLS, S_Pa + 32 * nb * CLS, r, hh);
#pragma unroll
            for (int g = 0; g < 4; ++g) { const s16x4 rv = *(const LAS s16x4*)(S_RTtm + (32 * nb + r) * CLS + 32 * mb + 8 * g + 4 * hh);
#pragma unroll
                for (int e = 0; e < 4; ++e) b[4 * g + e] += bf2f((bf16_t)rv[e]); }
            u32x4 y0, y1, r0, r1;
            y0.x = cvtpk(a[0], a[1]); y0.y = cvtpk(a[2], a[3]); y0.z = cvtpk(a[4], a[5]); y0.w = cvtpk(a[6], a[7]);
            y1.x = cvtpk(a[8], a[9]); y1.y = cvtpk(a[10], a[11]); y1.z = cvtpk(a[12], a[13]); y1.w = cvtpk(a[14], a[15]);
            r0.x = cvtpk(b[0], b[1]); r0.y = cvtpk(b[2], b[3]); r0.z = cvtpk(b[4], b[5]); r0.w = cvtpk(b[6], b[7]);
            r1.x = cvtpk(b[8], b[9]); r1.y = cvtpk(b[10], b[11]); r1.z = cvtpk(b[12], b[13]); r1.w = cvtpk(b[14], b[15]);
            o128[1536 + ((mb * 2 + nb) * 64 + lane) * 2] = y0; o128[1536 + ((mb * 2 + nb) * 64 + lane) * 2 + 1] = y1;
            o128[512 + (nb * 4 + 2 * mb) * 64 + lane] = r0; o128[512 + (nb * 4 + 2 * mb + 1) * 64 + lane] = r1;
        }
    }
    lds_barrier();
}

struct ScP { const unsigned char* CHK; bf16_t* YS; };
__device__ __forceinline__ void scan_unpack16(f32x16& acc, const u32x4 y0, const u32x4 y1) {
    acc[0] = __uint_as_float(y0.x << 16); acc[1] = __uint_as_float(y0.x & 0xffff0000u); acc[2] = __uint_as_float(y0.y << 16); acc[3] = __uint_as_float(y0.y & 0xffff0000u);
    acc[4] = __uint_as_float(y0.z << 16); acc[5] = __uint_as_float(y0.z & 0xffff0000u); acc[6] = __uint_as_float(y0.w << 16); acc[7] = __uint_as_float(y0.w & 0xffff0000u);
    acc[8] = __uint_as_float(y1.x << 16); acc[9] = __uint_as_float(y1.x & 0xffff0000u); acc[10] = __uint_as_float(y1.y << 16); acc[11] = __uint_as_float(y1.y & 0xffff0000u);
    acc[12] = __uint_as_float(y1.z << 16); acc[13] = __uint_as_float(y1.z & 0xffff0000u); acc[14] = __uint_as_float(y1.w << 16); acc[15] = __uint_as_float(y1.w & 0xffff0000u);
}
__device__ __forceinline__ void scan_step(const LAS unsigned char* sl, LAS float* ybuf, f32x16 (&st)[2], int w, int lane, int r, int hh) {
    bf16x8 ar[2][4], ag[2][4]; u32x4 yi[2][2], hi[2][2];
#pragma unroll
    for (int tb = 0; tb < 2; ++tb) { const LAS u32x4* yf = (const LAS u32x4*)(sl + 24576) + ((tb * 2 + w) * 64 + lane) * 2; yi[tb][0] = yf[0]; yi[tb][1] = yf[1];
        const LAS u32x4* hf = (const LAS u32x4*)(sl + 16384) + ((tb * 2 + w) * 64 + lane) * 2; hi[tb][0] = hf[0]; hi[tb][1] = hf[1];
#pragma unroll
        for (int ks = 0; ks < 4; ++ks) { ar[tb][ks] = *(const LAS bf16x8*)(sl + 8192 + ((tb * 4 + ks) * 64 + lane) * 16); ag[tb][ks] = *(const LAS bf16x8*)(sl + ((tb * 4 + ks) * 64 + lane) * 16); } }
    bf16x8 sf[4];
    sf[0] = pack8(st[0], 0); sf[1] = pack8(st[0], 1); sf[2] = pack8(st[1], 0); sf[3] = pack8(st[1], 1);
    f32x16 ya[2], sa[2];
#pragma unroll
    for (int tb = 0; tb < 2; ++tb) { scan_unpack16(ya[tb], yi[tb][0], yi[tb][1]); scan_unpack16(sa[tb], hi[tb][0], hi[tb][1]); }
#pragma unroll
    for (int ks = 0; ks < 4; ++ks) {
        ya[0] = __builtin_amdgcn_mfma_f32_32x32x16_bf16(ar[0][ks], sf[ks], ya[0], 0, 0, 0); ya[1] = __builtin_amdgcn_mfma_f32_32x32x16_bf16(ar[1][ks], sf[ks], ya[1], 0, 0, 0);
        sa[0] = __builtin_amdgcn_mfma_f32_32x32x16_bf16(ag[0][ks], sf[ks], sa[0], 0, 0, 0); sa[1] = __builtin_amdgcn_mfma_f32_32x32x16_bf16(ag[1][ks], sf[ks], sa[1], 0, 0, 0); }
    st[0] = sa[0]; st[1] = sa[1];
#pragma unroll
    for (int tb = 0; tb < 2; ++tb)
#pragma unroll
        for (int q = 0; q < 16; ++q) ybuf[(32 * tb + (q & 3) + 8 * (q >> 2) + 4 * hh) * 64 + 32 * w + r] = ya[tb][q];
}
__device__ __forceinline__ void rwkv_scan_unit(LAS unsigned char* lds, const ScP& P, int seq0, int seqm, int nmeta, int nreal, int brow0, int hd, bool write_meta, const float* st_in, float* st_out) {
    const int tid = opq(threadIdx.x), lane = tid & 63, w = __builtin_amdgcn_readfirstlane(tid >> 6), r = lane & 31, hh = lane >> 5;
    const int N = nmeta + nreal;
    float z0 = 0.f; asm volatile("" : "+v"(z0));
    LAS float* ybuf = (LAS float*)(lds + 65536);
    f32x16 st[2]; zero16(st[0], z0); zero16(st[1], z0);
    if (st_in != nullptr && w < 2) { const GAS f32x4* sp = (const GAS f32x4*)(st_in + ((size_t)w * 64 + lane) * 32);
#pragma unroll
        for (int i = 0; i < 8; ++i) { const f32x4 v = sp[i];
#pragma unroll
            for (int j = 0; j < 4; ++j) st[i >> 2][4 * (i & 3) + j] = v[j]; } }
    const int c = hd * 64 + lane;
#define SCAN_SRC(n_) ((const GAS u32x4*)(P.CHK + ((size_t)((n_) < nmeta ? seqm : seq0 + (n_) - nmeta) * 8 + hd) * CHK_BYTES))
    u32x4 pa[4], pb[4], pc[4];
    { const GAS u32x4* s0 = SCAN_SRC(0); const GAS u32x4* s1 = SCAN_SRC(1); const GAS u32x4* s2 = SCAN_SRC(2);
#pragma unroll
      for (int i = 0; i < 4; ++i) pc[i] = s0[tid + 512 * i];
#pragma unroll
      for (int i = 0; i < 4; ++i) pa[i] = s1[tid + 512 * i];
#pragma unroll
      for (int i = 0; i < 4; ++i) pb[i] = s2[tid + 512 * i];
#pragma unroll
      for (int i = 0; i < 4; ++i) *(LAS u32x4*)(lds + (tid + 512 * i) * 16) = pc[i]; }
    lds_barrier();
#define SCAN_ITER(n_, PCUR, PMID, PNEXT) do { \
        const int n = (n_); \
        if (n + 3 < N) { const GAS u32x4* s3 = SCAN_SRC(n + 3); _Pragma("unroll") for (int i = 0; i < 4; ++i) PNEXT[i] = s3[tid + 512 * i]; } \
        if (w < 2) scan_step(lds + (n & 1) * 32768, ybuf, st, w, lane, r, hh); \
        lds_barrier(); \
        if (n + 1 < N) { _Pragma("unroll") for (int i = 0; i < 4; ++i) *(LAS u32x4*)(lds + ((n + 1) & 1) * 32768 + (tid + 512 * i) * 16) = PCUR[i]; } \
        if (w >= 2) { const int crow0 = n < nmeta ? RREAL : brow0 + 64 * (n - nmeta); const int nrow = n < nmeta ? (write_meta ? NMETA : 0) : 64; \
            for (int t = w - 2; t < nrow; t += 6) ((GAS bf16_t*)P.YS)[(size_t)(crow0 + t) * 512 + c] = f2bf_hw(ybuf[t * 64 + lane]); } \
        lds_barrier(); } while (0)
    int n3 = 0;
#pragma unroll 1
    for (; n3 + 3 <= N; n3 += 3) { SCAN_ITER(n3, pa, pb, pc); SCAN_ITER(n3 + 1, pb, pc, pa); SCAN_ITER(n3 + 2, pc, pa, pb); }
    if (N - n3 >= 1) SCAN_ITER(n3, pa, pb, pc);
    if (N - n3 >= 2) SCAN_ITER(n3 + 1, pb, pc, pa);
#undef SCAN_ITER
#undef SCAN_SRC
    if (st_out != nullptr && w < 2) { GAS f32x4* sp = (GAS f32x4*)(st_out + ((size_t)w * 64 + lane) * 32);
#pragma unroll
        for (int i = 0; i < 8; ++i) { f32x4 v;
#pragma unroll
            for (int j = 0; j < 4; ++j) v[j] = st[i >> 2][4 * (i & 3) + j];
            sp[i] = v; } }
}
struct PostP { const bf16_t* YS; const bf16_t* VP; const float* RK; const bf16_t* LO; bf16_t* MIX; const float *ln_w, *ln_b; };
__device__ __forceinline__ void rwkv_post(const PostP& P, int q, int rlo, int rhi, bool with_meta, int gw, int ngw, int lane) {
    lane = opq(lane);
    const int nreal = (rhi - rlo) * 8, ntot = nreal + (with_meta ? NMETA * 8 : 0);
    for (int item = gw; item < ntot; item += ngw) { const int ri = rlo + (item >> 3); const int row = item < nreal ? (ri >> 10) * SEQ + 1024 * q + (ri & 1023) : RREAL + ((item - nreal) >> 3); const int hd = item & 7, c = hd * 64 + lane;
        const float y = bf2f(P.YS[(size_t)row * 512 + c]); const float g = bf2f(P.LO[(size_t)row * 1536 + 1024 + c]), vp = bf2f(P.VP[(size_t)row * 512 + c]), rk = P.RK[(size_t)row * 8 + hd];
        const float mean = wave_sum(y) * (1.f / 64.f); const float d = y - mean; const float var = wave_sum(d * d) * (1.f / 64.f);
        const float yn = d * rsqrtf(var + GN_EPS) * P.ln_w[c] + P.ln_b[c];
        P.MIX[(size_t)row * D + 512 + c] = f2bf_hw((yn + rk * vp) * g); }
}

constexpr int LDS_BYTES = 147456, LDS_MISC = LDS_BYTES - 512;
struct Params { const float* in[33]; float* out; unsigned char* ws; };
constexpr int CW_BAR = 4096;


#ifndef PROBE_REP_MISC
#define PROBE_REP_MISC 1
#endif
#ifndef MOE_TAIL
#define MOE_TAIL 0
#endif
#ifndef PROBE_REP_OUTPROJ
#define PROBE_REP_OUTPROJ 1
#endif
#ifndef PROBE_REP_FFNDN
#define PROBE_REP_FFNDN 1
#endif
#ifndef PROBE_REP_MOEDN
#define PROBE_REP_MOEDN 1
#endif
#ifndef PROBE_REP_NORM
#define PROBE_REP_NORM 1
#endif
#ifndef PROBE_REP_INPROJ
#define PROBE_REP_INPROJ 1
#endif
#ifndef PROBE_REP_PREP
#define PROBE_REP_PREP 1
#endif
#ifndef PROBE_REP_P4A
#define PROBE_REP_P4A 1
#endif
#ifndef PROBE_REP_ATT
#define PROBE_REP_ATT 1
#endif
#ifndef PROBE_REP_P4B
#define PROBE_REP_P4B 1
#endif
#ifndef PROBE_REP_CP
#define PROBE_REP_CP 1
#endif
#ifndef PROBE_REP_SCAN
#define PROBE_REP_SCAN 1
#endif
#ifndef PROBE_REP_FFNGU
#define PROBE_REP_FFNGU 1
#endif
#ifndef PROBE_REP_MOETR
#define PROBE_REP_MOETR 1
#endif
#ifndef PROBE_REP_GATHER
#define PROBE_REP_GATHER 1
#endif
#ifndef PROBE_REP_MOEGU
#define PROBE_REP_MOEGU 1
#endif
#define LDP(k) ((const float*)ldk(kp, 8 * (k)))
#define OUTP ((float*)ldk(kp, 264))
#define WSP ((unsigned char*)ldk(kp, 272))
#define NOINL __device__ __attribute__((noinline))
#define WAVE_IDS() const int tid = threadIdx.x, lane = tid & 63, wave = __builtin_amdgcn_readfirstlane(tid >> 6), bid = (int)blockIdx.x, nblk = (int)gridDim.x, gw = bid * 8 + wave, ngw = nblk * 8; (void)lane; (void)gw; (void)ngw
NOINL void f_p0(unsigned long long kp_, LAS unsigned char* lds) {
    const unsigned long long kp = kp_uniform(kp_); WAVE_IDS(); LAS float* scr = (LAS float*)(lds + wave * 8448);
    {
        unsigned* ctl = (unsigned*)(WSP + WS_CTL);
#pragma unroll 1
        for (int te = wave; te < 24; te += 8) { const int t = te >> 3, e = te & 7;
            const float* wt = t == 0 ? LDP(30) : (t == 1 ? LDP(31) : LDP(32));
            const f32x4 v = ((const f32x4*)(wt + (size_t)e * ((size_t)D * FFE) + (size_t)(bid % 256) * 14336))[lane];
            const float m = wave_max(fmaxf(fmaxf(fabsf(v.x), fabsf(v.y)), fmaxf(fabsf(v.z), fabsf(v.w))));
            if (lane == 0) atomicMax(&ctl[CW_WMAX + te], __float_as_uint(m)); } }
    { unsigned char* ws = WSP;
      ph_init(LDP(0), LDP(1), OUTP, (float*)(ws + WS_HMETA), (float*)(ws + WS_ROPE), LDP(23), LDP(24), (bf16_t*)(ws + WS_V1T), (size_t)bid * 512 + tid, (size_t)nblk * 512); }
#pragma unroll 1
    for (int l = 0; l < 2; ++l) { unsigned char* lw = WSP + WS_WB + l * LW_STRIDE;
        { const TrJob J{LDP(5) + (size_t)l * D * 2624, nullptr, (bf16_t*)(lw + LW_WIN), D, 2624, 1024, 0, 1, 0}; ph_transpose(J, scr, gw, ngw, lane); }
        { const TrJob J{LDP(9) + (size_t)l * 512 * 768, LDP(7) + l * 512, (bf16_t*)(lw + LW_WUQ), 512, 768, 512, 0, 0, 0}; ph_transpose(J, scr, gw, ngw, lane); }
        { const TrJob J{LDP(10) + (size_t)l * 256 * 1024, LDP(8) + l * 256, (bf16_t*)(lw + LW_WK), 256, 1024, 256, 0, 4, 0}; ph_transpose(J, scr, gw, ngw, lane); }
        { const TrJob J{LDP(13) + (size_t)l * 64 * 512, nullptr, (bf16_t*)(lw + LW_LORA), 64, 512, 256, 0, 0, 0}; ph_transpose(J, scr, gw, ngw, lane); }
        { const TrJob J{LDP(15) + (size_t)l * 64 * 512, nullptr, (bf16_t*)(lw + LW_LORA), 64, 512, 256, 64, 0, 512}; ph_transpose(J, scr, gw, ngw, lane); }
        { const TrJob J{LDP(16) + (size_t)l * 128 * 512, nullptr, (bf16_t*)(lw + LW_LORA), 128, 512, 256, 128, 0, 1024}; ph_transpose(J, scr, gw, ngw, lane); }
        { const TrJob J{LDP(6) + (size_t)l * D * D, nullptr, (bf16_t*)(lw + LW_WOUT), D, D, 1024, 0, 0, 0}; ph_transpose(J, scr, gw, ngw, lane); }
    }
    { const TrJob J{LDP(25), nullptr, (bf16_t*)(WSP + WS_FGU), D, FF0, 1024, 0, 2, 0}; ph_transpose(J, scr, gw, ngw, lane); }
    { const TrJob J{LDP(26), nullptr, (bf16_t*)(WSP + WS_FGU), D, FF0, 1024, 0, 3, 0}; ph_transpose(J, scr, gw, ngw, lane); }
    { const TrJob J{LDP(27), nullptr, (bf16_t*)(WSP + WS_FDN), FF0, D, FF0, 0, 0, 0}; ph_transpose(J, scr, gw, ngw, lane); }
}
NOINL void f_rmsnorm(unsigned long long kp_, int which, int l) { const unsigned long long kp = kp_uniform(kp_); which = __builtin_amdgcn_readfirstlane(which); l = __builtin_amdgcn_readfirstlane(l); WAVE_IDS(); unsigned char* ws = WSP;
    const float* hsrc = (which == 0 && l == 0) ? LDP(0) : (const float*)OUTP;
    ph_rmsnorm(hsrc, (const float*)(ws + WS_HMETA), (which ? LDP(3) : LDP(2)) + l * D, (bf16_t*)(ws + A_U), (const float*)(ws + A_PART), which ? 4 : (l ? 11 : 0), gw, ngw, lane); }
NOINL void f_prep(unsigned long long kp_, int l) { const unsigned long long kp = kp_uniform(kp_); l = __builtin_amdgcn_readfirstlane(l); WAVE_IDS(); unsigned char* ws = WSP;
    ph_prep((const bf16_t*)(ws + A_PM), (const bf16_t*)(ws + A_PR), LDP(11) + l * 1792, (const float*)(ws + WS_ROPE), (float*)(ws + A_RSTDQ), (float*)(ws + A_RSTDKV),
            (bf16_t*)(ws + A_KROPE), (bf16_t*)(ws + A_LIN), (bf16_t*)(ws + A_VSH), l, gw, ngw, lane); }
constexpr int RW_NSEQ = 129;
constexpr size_t RW_BUF = (size_t)RW_NSEQ * 8 * CHK_BYTES;
static_assert(2 * RW_BUF <= A_VFIRST - A_CHK, "two chunk buffers fit the chunk region");
constexpr int RW_SKIP = 4;
__device__ __forceinline__ bool rw_is_scan_wg(int bid) { return (bid & 3) == 0; }
__device__ __forceinline__ int rw_rank(int bid) { return bid - (bid >> 2) - 1; }
__device__ __forceinline__ void f_rwkv_cp(unsigned long long kp_, LAS unsigned char* lds, int l, int q) {
    const unsigned long long kp = kp_uniform(kp_); l = __builtin_amdgcn_readfirstlane(l); q = __builtin_amdgcn_readfirstlane(q);
    const int bid = (int)blockIdx.x, nblk = (int)gridDim.x; unsigned char* ws = WSP;
    const CpP cp{(const bf16_t*)(ws + A_PR), (const bf16_t*)(ws + A_LOUT), (const bf16_t*)(ws + A_VMIX), (const bf16_t*)(ws + A_VFIRST), (bf16_t*)(ws + (l ? A_VP : A_VFIRST)), (float*)(ws + A_RK), ws + A_CHK + (size_t)(q & 1) * RW_BUF,
                 LDP(11) + l * 1792, LDP(12) + l * 512, LDP(14) + l * 512, LDP(17) + l * 512, LDP(18) + l * 512, LDP(19) + l * 512, LDP(22), l, 0};
    const int ntask = (q == 0 ? RW_NSEQ : RW_NSEQ - 1) * 8, hs = q == 0 ? 0 : RW_SKIP, NS = nblk - ((nblk + 3) >> 2);
    const bool scanwg = rw_is_scan_wg(bid); const int rank = rw_rank(bid);
#define RW_TASK(i_) (scanwg ? hs * NS + (i_) * nblk + bid : ((i_) < hs ? (i_) * NS + rank : hs * NS + ((i_) - hs) * nblk + bid))
#define RW_ROW0(t_) (((t_) >> 3) == 128 ? RREAL : ((t_) >> 7) * SEQ + (16 * q + (((t_) >> 3) & 15)) * 64)
    const int tid_ = opq(threadIdx.x), lane_ = tid_ & 63, w_ = __builtin_amdgcn_readfirstlane(tid_ >> 6);
    int task = RW_TASK(0); if (task >= ntask) return;
    CpRaw raw; cp_issue(cp, RW_ROW0(task), task & 7, w_, lane_, raw);
#pragma unroll 1
    for (int i = 0; ; ++i) { const int nxt = RW_TASK(i + 1); const bool has_next = nxt < ntask;
        rwkv_cp_task(lds, cp, RW_ROW0(task), task & 7, cp.CHK + (size_t)task * CHK_BYTES, raw, has_next, has_next ? RW_ROW0(nxt) : 0, nxt & 7);
        if (!has_next) break;
        task = nxt; }
#undef RW_TASK
#undef RW_ROW0
}
__device__ __forceinline__ void f_rwkv_scan(unsigned long long kp_, LAS unsigned char* lds, int l, int q) {
    const unsigned long long kp = kp_uniform(kp_); l = __builtin_amdgcn_readfirstlane(l); q = __builtin_amdgcn_readfirstlane(q);
    const int bid = (int)blockIdx.x, nblk = (int)gridDim.x; if (!rw_is_scan_wg(bid)) return;
    unsigned char* ws = WSP; const ScP sp{ws + A_CHK + (size_t)(q & 1) * RW_BUF, (bf16_t*)(ws + A_YS)};
#pragma unroll 1
    for (int unit = bid >> 2; unit < 64; unit += (nblk + 3) >> 2) { const int b = unit >> 3, hd = unit & 7; float* stp = (float*)(ws + A_SCST) + (size_t)unit * 4096;
        rwkv_scan_unit(lds, sp, b * 16, 128, q == 0 ? 1 : 0, 16, b * SEQ + q * 1024, hd, q == 0 && b == 0, q == 0 ? nullptr : stp, q == 3 ? nullptr : stp); }
}
NOINL void f_rwkv_post(unsigned long long kp_, int l, int q, int mode) {
    const unsigned long long kp = kp_uniform(kp_); l = __builtin_amdgcn_readfirstlane(l); q = __builtin_amdgcn_readfirstlane(q); mode = __builtin_amdgcn_readfirstlane(mode); WAVE_IDS(); unsigned char* ws = WSP;
    const PostP pp{(const bf16_t*)(ws + A_YS), (const bf16_t*)(ws + (l ? A_VP : A_VFIRST)), (const float*)(ws + A_RK), (const bf16_t*)(ws + A_LOUT), (bf16_t*)(ws + A_PM), LDP(20) + l * 512, LDP(21) + l * 512};
    const bool scanwg = rw_is_scan_wg(bid); const int nscan = (nblk + 3) >> 2, NS = nblk - nscan;
    if (mode == 2) rwkv_post(pp, q, 0, 8192, q == 0, gw, ngw, lane);
    else if (mode == 1) { if (!scanwg) rwkv_post(pp, q, 0, 8192, q == 0, rw_rank(bid) * 8 + wave, NS * 8, lane); }
    else if (scanwg) rwkv_post(pp, q, 0, 4096, false, (bid >> 2) * 8 + wave, nscan * 8, lane);
    else rwkv_post(pp, q, 4096, 8192, q == 0, rw_rank(bid) * 8 + wave, NS * 8, lane); }
NOINL void f_ffn_meta(unsigned long long kp_) {
    const unsigned long long kp = kp_uniform(kp_); WAVE_IDS(); unsigned char* ws = WSP;
    const int job = bid * 8 + wave; if (job >= FF0 / 16) return;
    const int f0 = job * 16, l15 = lane & 15, kq = lane >> 4;
    const bf16_t* wg = (const bf16_t*)(ws + WS_FGU) + (size_t)((f0 >> 7) * 256 + (f0 & 127) + l15) * 1024 + 8 * kq;
    const bf16_t* wu = wg + (size_t)128 * 1024;
    const bf16_t* xu = (const bf16_t*)(ws + A_U) + (size_t)(RREAL + l15) * D + 8 * kq;
    f32x4 ag = {0.f, 0.f, 0.f, 0.f}, au = {0.f, 0.f, 0.f, 0.f};
#pragma unroll 8
    for (int ks = 0; ks < 32; ++ks) { const bf16x8 a = *(const GAS bf16x8*)(wg + 32 * ks), b = *(const GAS bf16x8*)(wu + 32 * ks), x = *(const GAS bf16x8*)(xu + 32 * ks);
        ag = __builtin_amdgcn_mfma_f32_16x16x32_bf16(a, x, ag, 0, 0, 0); au = __builtin_amdgcn_mfma_f32_16x16x32_bf16(b, x, au, 0, 0, 0); }
    float r[4];
#pragma unroll
    for (int j = 0; j < 4; ++j) { const float g = ag[j], up = au[j]; r[j] = g / (1.0f + __expf(-g)) * up; }
    u32x2 o; o.x = cvtpk(r[0], r[1]); o.y = cvtpk(r[2], r[3]);
    *(GAS u32x2*)((bf16_t*)(ws + A_ACT0) + (size_t)(RREAL + l15) * FF0 + f0 + 4 * kq) = o;
}
NOINL void f_moe_tr(unsigned long long kp_, LAS unsigned char* lds) {
    const unsigned long long kp = kp_uniform(kp_); WAVE_IDS(); LAS float* scr = (LAS float*)(lds + wave * 8448);
    if (bid == 0 && tid < 24) { unsigned* ctlw = (unsigned*)(WSP + WS_CTL); const float sc = moe_wscale_bits(ctlw[CW_WMAX + tid]); ctlw[CW_WINV + tid] = __float_as_uint(1.0f / (F8_ACT * sc)); }
#pragma unroll 1
    for (int e = 0; e < NEXP * PROBE_REP_MOETR; ++e) { const int ee = e % NEXP;
        const unsigned* ctl = (const unsigned*)(WSP + WS_CTL);
        { const TrJob8 J{LDP(30) + (size_t)ee * D * FFE, WSP + A_MGU, D, FFE, 1024, 2, ee * 2 * FFE, moe_wscale(ctl, 0, ee)}; ph_transpose_f8(J, scr, gw, ngw, lane); }
        { const TrJob8 J{LDP(31) + (size_t)ee * D * FFE, WSP + A_MGU, D, FFE, 1024, 3, ee * 2 * FFE, moe_wscale(ctl, 1, ee)}; ph_transpose_f8(J, scr, gw, ngw, lane); }
        { const TrJob8 J{LDP(32) + (size_t)ee * FFE * D, WSP + A_MDN, FFE, D, FFE, 0, ee * D, moe_wscale(ctl, 2, ee)}; ph_transpose_f8(J, scr, gw, ngw, lane); }
    }
}
__device__ __forceinline__ void f_moe_route(unsigned long long kp_, LAS unsigned char* lds) {
    const unsigned long long kp = kp_uniform(kp_); WAVE_IDS(); unsigned char* ws = WSP;
    ph_norm_route(lds, OUTP, LDP(3) + D, LDP(28), LDP(29), (bf16_t*)(ws + A_U), (int*)(ws + A_MTAB + MT_E), (float*)(ws + A_MTAB + MT_G), (int*)(ws + A_MTAB + MT_STOK), (unsigned*)(ws + WS_CTL), bid, nblk, wave, lane); }
NOINL void f_moe_assign(unsigned long long kp_, LAS unsigned char* lds, int list) { const unsigned long long kp = kp_uniform(kp_); list = __builtin_amdgcn_readfirstlane(list); WAVE_IDS(); unsigned char* ws = WSP;
    ph_moe_assign(lds, list, (const int*)(ws + A_MTAB + MT_E), (const float*)(ws + A_MTAB + MT_G), (int*)(ws + A_MTAB + MT_STOK), (float*)(ws + A_MTAB + MT_SGATE), (int*)(ws + A_MTAB + MT_BE), (unsigned*)(ws + WS_CTL), ws + A_U, ws + A_XB, bid, nblk, tid); }
NOINL void f_final(unsigned long long kp_) { const unsigned long long kp = kp_uniform(kp_); WAVE_IDS(); unsigned char* ws = WSP; ph_final(OUTP, LDP(4), (const int*)(ws + A_MTAB + MT_TSLOT), (const float*)(ws + WS_TB), gw, ngw, lane); }

__global__ void __launch_bounds__(512, 2) fwd(Params P) {
    extern __shared__ __attribute__((aligned(16))) unsigned char lds_raw[];
    LAS unsigned char* lds = (LAS unsigned char*)lds_raw;
    const int tid = threadIdx.x;
    const int bid = (int)blockIdx.x, nblk = (int)gridDim.x;
    const unsigned long long kp = (unsigned long long)__builtin_amdgcn_kernarg_segment_ptr();
    volatile LAS unsigned* misc = (volatile LAS unsigned*)(lds + LDS_MISC);
    if (tid < 64) misc[tid] = 0u;
    __syncthreads();
    XcdBarrier bar;
    { unsigned* ctl0 = (unsigned*)(WSP + WS_CTL); bar = xcd_barrier_post(ctl0 + CW_BAR, misc + 8); }
#ifdef PROBE_BAR2
#define GRID_BAR() do { xcd_barrier(bar); xcd_barrier(bar); } while (0)
#else
#define GRID_BAR() xcd_barrier(bar)
#endif
    for (int rep_ = 0; rep_ < PROBE_REP_MISC; ++rep_) f_p0(kp, lds);
    GRID_BAR();

#pragma unroll 1
    for (int l = 0; l < 2; ++l) {
        for (int rep_ = 0; rep_ < PROBE_REP_NORM; ++rep_) f_rmsnorm(kp, 0, l);
        GRID_BAR();
_Pragma("unroll 1") for (int rep_ = 0; rep_ < PROBE_REP_INPROJ; ++rep_) {
        { unsigned char* ws = WSP; pg8::Gemm g{(const bf16_t*)(ws + A_U), (const bf16_t*)(ws + WS_WB + l * LW_STRIDE + LW_WIN), RP, 2816, 1024, 1024, 1024, 0}; pg8::StaticOrder S; S.init(RP, 2816, opqs(nblk), opqs(bid));
          EpiInProj E{(bf16_t*)(ws + A_PM), (bf16_t*)(ws + A_PR)};
          pg8::gemm_phase<EpiInProj, pg8::StaticOrder, true, true>(lds, g, S, E); }
}
        GRID_BAR();
        for (int rep_ = 0; rep_ < PROBE_REP_PREP; ++rep_) f_prep(kp, l);
        GRID_BAR();
_Pragma("unroll 1") for (int rep_ = 0; rep_ < PROBE_REP_P4A; ++rep_) {
        { unsigned char* ws = WSP; pg8::Gemm g{(const bf16_t*)(ws + A_PM), (const bf16_t*)(ws + WS_WB + l * LW_STRIDE + LW_WUQ), RP, 768, 512, 1024, 512, 0}; pg8::StaticOrder S; S.init(RP, 768, opqs(nblk), opqs(bid));
          EpiRowScale E{(bf16_t*)(ws + A_U), (const float*)(ws + A_RSTDQ), 768, 0};
          pg8::gemm_phase<EpiRowScale, pg8::StaticOrder, true, true>(lds, g, S, E); }
        { unsigned char* ws = WSP; pg8::Gemm g{(const bf16_t*)(ws + A_PM) + 512, (const bf16_t*)(ws + WS_WB + l * LW_STRIDE + LW_WK), RP, 512, 256, 1024, 256, 0}; pg8::StaticOrder S; S.init(RP, 512, opqs(nblk), opqs((bid + nblk - 131) % nblk));
          EpiRowScale E{(bf16_t*)(ws + A_KN), (const float*)(ws + A_RSTDKV), 512, 0};
          pg8::gemm_phase<EpiRowScale, pg8::StaticOrder, true, true>(lds, g, S, E); }
        { unsigned char* ws = WSP; pg8::Gemm g{(const bf16_t*)(ws + WS_WB + l * LW_STRIDE + LW_WV), (const bf16_t*)(ws + A_PM) + 512, 512, RP, 256, 256, 1024, 0}; pg8::StaticOrder S; S.init(512, RP, opqs(nblk), opqs((bid + nblk - 133) % nblk));
          EpiColScale E{(bf16_t*)(ws + A_VT), (const float*)(ws + A_RSTDKV), RP, 0};
          pg8::gemm_phase<EpiColScale, pg8::StaticOrder, true, true>(lds, g, S, E); }
}
        GRID_BAR();
_Pragma("unroll 1") for (int rep_ = 0; rep_ < PROBE_REP_ATT; ++rep_) {
        { unsigned char* ws = WSP; attn_phase(lds, (const bf16_t*)(ws + A_U), (const bf16_t*)(ws + A_KN), (const bf16_t*)(ws + A_KROPE), (const bf16_t*)(ws + A_VT), (bf16_t*)(ws + A_PM), (const float*)(ws + WS_ROPE), opqs(bid), opqs(nblk)); }
}
        GRID_BAR();
_Pragma("unroll 1") for (int rep_ = 0; rep_ < PROBE_REP_P4B; ++rep_) {
        { unsigned char* ws = WSP; pg8::Gemm g{(const bf16_t*)(ws + A_LIN), (const bf16_t*)(ws + WS_WB + l * LW_STRIDE + LW_LORA), RP, 1536, 256, 256, 256, 0}; pg8::StaticOrder S; S.init(RP, 1536, opqs(nblk), opqs(bid));
          EpiRowScale E{(bf16_t*)(ws + A_LOUT), nullptr, 1536, 0};
          pg8::gemm_phase<EpiRowScale, pg8::StaticOrder, true, true>(lds, g, S, E); }
        if (l == 1) {
            unsigned char* ws = WSP; pg8::Gemm g{(const bf16_t*)(ws + A_VSH), (const bf16_t*)(ws + WS_V1T), RP, 512, 512, 512, 512, 0}; pg8::StaticOrder S; S.init(RP, 512, opqs(nblk), opqs((bid + nblk - 6) % nblk));
            EpiRowScale E{(bf16_t*)(ws + A_VMIX), nullptr, 512, 0};
            pg8::gemm_phase<EpiRowScale, pg8::StaticOrder, true, true>(lds, g, S, E);
        }
}
        GRID_BAR();
#pragma unroll 1
        for (int stp = 0; stp < 6; ++stp) {
            if (stp >= 1 && stp <= 4) { _Pragma("unroll 1") for (int rep_ = 0; rep_ < PROBE_REP_SCAN; ++rep_) f_rwkv_scan(kp, lds, l, stp - 1); }
            if (stp <= 3) { _Pragma("unroll 1") for (int rep_ = 0; rep_ < PROBE_REP_CP; ++rep_) f_rwkv_cp(kp, lds, l, stp); }
            if (stp >= 2) { for (int rep_ = 0; rep_ < PROBE_REP_MISC; ++rep_) f_rwkv_post(kp, l, stp - 2, stp <= 3 ? 0 : stp - 3); }
            GRID_BAR();
        }
_Pragma("unroll 1") for (int rep_ = 0; rep_ < PROBE_REP_OUTPROJ; ++rep_) {
        { unsigned char* ws = WSP; pg8::Gemm g{(const bf16_t*)(ws + A_PM), (const bf16_t*)(ws + WS_WB + l * LW_STRIDE + LW_WOUT), RREAL, 1024, 1024, 1024, 1024, 0}; pg8::StaticOrder S; S.init(RREAL, 1024, opqs(nblk), opqs(bid));
          EpiResid E{OUTP, (float*)(ws + WS_HMETA), (l == 0 && rep_ == 0) ? LDP(0) : (const float*)OUTP, rep_ == 0 ? 1.0f : 0.0f, 0};
          pg8::gemm_phase<EpiResid, pg8::StaticOrder, true, true>(lds, g, S, E); }
        if (rep_ == 0 && l == 0) {
          unsigned char* ws = WSP; pg8::Gemm g{(const bf16_t*)(ws + A_PM), (const bf16_t*)(ws + WS_WB + l * LW_STRIDE + LW_WOUT), RP, 1024, 256, 1024, 1024, 0};
          const DenseTailOrder S{4, 4, opqs(nblk), opqs(bid)}; EpiResidPartial E{(float*)(ws + A_PART)};
          pg8::gemm_phase<EpiResidPartial, DenseTailOrder, true, true>(lds, g, S, E); }
}
        GRID_BAR();
        if (l == 0) {
            for (int rep_ = 0; rep_ < PROBE_REP_MISC; ++rep_) f_rmsnorm(kp, 1, 0);
            GRID_BAR();
_Pragma("unroll 1") for (int rep_ = 0; rep_ < PROBE_REP_FFNGU; ++rep_) {
            f_ffn_meta(kp);
            { unsigned char* ws = WSP; pg8::Gemm g{(const bf16_t*)(ws + A_U), (const bf16_t*)(ws + WS_FGU), RREAL, 2 * FF0, 1024, 1024, 1024, 0}; pg8::StaticOrder S; S.init(RREAL, 2 * FF0, opqs(nblk), opqs(bid));
              EpiSwiGLU E{(bf16_t*)(ws + A_ACT0), FF0, 22, 0, 0};
              pg8::gemm_phase<EpiSwiGLU, pg8::StaticOrder, true, true>(lds, g, S, E); }
}
            GRID_BAR();
_Pragma("unroll 1") for (int rep_ = 0; rep_ < PROBE_REP_FFNDN; ++rep_) {
            { unsigned char* ws = WSP; pg8::Gemm g{(const bf16_t*)(ws + A_ACT0), (const bf16_t*)(ws + WS_FDN), RREAL, 1024, FF0, FF0, FF0, 0}; pg8::StaticOrder S; S.init(RREAL, 1024, opqs(nblk), opqs(bid));
              EpiResid E{OUTP, (float*)(ws + WS_HMETA), (const float*)OUTP, rep_ == 0 ? 1.0f : 0.0f, 0};
              pg8::gemm_phase<EpiResid, pg8::StaticOrder, true, true>(lds, g, S, E); }
            if (rep_ == 0) {
              unsigned char* ws = WSP; pg8::Gemm g{(const bf16_t*)(ws + A_ACT0), (const bf16_t*)(ws + WS_FDN), RP, 1024, 256, FF0, FF0, 0};
              const DenseTailOrder S{4, 11, opqs(nblk), opqs(bid)}; EpiResidPartial E{(float*)(ws + A_PART)};
              pg8::gemm_phase<EpiResidPartial, DenseTailOrder, true, true>(lds, g, S, E); }
}
            GRID_BAR();
        } else {
            f_moe_tr(kp, lds);
            f_moe_route(kp, lds);
            GRID_BAR();
            f_moe_assign(kp, lds, 0);
            f_moe_assign(kp, lds, 1);
            GRID_BAR();
#pragma unroll 1
            for (int list = 0; list < 2; ++list) {
                const int np0 = __builtin_amdgcn_readfirstlane((int)((const unsigned*)(WSP + WS_CTL))[CW_NPAN]), np1 = __builtin_amdgcn_readfirstlane((int)((const unsigned*)(WSP + WS_CTL))[CW_NPAN + 1]);
                const int T0 = np0 > MOE_TAILPAN ? (np0 - MOE_TAILPAN) * 4 : 0, T1 = np1 > MOE_TAILPAN ? (np1 - MOE_TAILPAN) * 4 : 0;
                if (list == 1) {
                    { unsigned char* ws = WSP; pg8::Gemm g{(const bf16_t*)(ws + A_MACT), (const bf16_t*)(ws + A_MDN), 0, 0, FFE / 2, FFE / 2, FFE / 2, 0};
                      const MoeShiftTailOrder S{(const int*)(ws + A_MTAB + MT_BE), (const unsigned*)(ws + WS_CTL) + CW_NPAN, 4, 4, 0, opqs(nblk) - 1, opqs(bid), 0};
                      EpiMoeDown E{OUTP, (const int*)(ws + A_MTAB + MT_STOK), (const float*)(ws + A_MTAB + MT_SGATE), 4, 1.0f, (const unsigned*)(ws + WS_CTL)};
                      pg8::gemm_phase<EpiMoeDown, MoeShiftTailOrder, true, true, true>(lds, g, S, E); }
                    { unsigned char* ws = WSP; pg8::Gemm g{(const bf16_t*)(ws + A_MACT), (const bf16_t*)(ws + A_MDN), 0, 0, FFE / 2, FFE / 2, FFE / 2, 0};
                      const MoeShiftTailOrder S{(const int*)(ws + A_MTAB + MT_BE) + 256, (const unsigned*)(ws + WS_CTL) + CW_NPAN + 1, 4, 4, MOE_GAP, opqs(nblk) - 1 - T0, opqs(bid), 0};
                      EpiMoeDownStore E{(float*)(ws + WS_TB), (const int*)(ws + A_MTAB + MT_STOK) + MOE_MAXPAN * 256, (const float*)(ws + A_MTAB + MT_SGATE) + MOE_MAXPAN * 256, 4, MOE_TAILPAN + MOE_GAP, (const unsigned*)(ws + WS_CTL)};
                      pg8::gemm_phase<EpiMoeDownStore, MoeShiftTailOrder, true, true, true>(lds, g, S, E); }
                }
_Pragma("unroll 1") for (int rep_ = 0; rep_ < PROBE_REP_MOEGU; ++rep_) {
                { unsigned char* ws = WSP; pg8::Gemm g{(const bf16_t*)(ws + A_XB + (size_t)list * XB_LIST), (const bf16_t*)(ws + A_MGU), 0, 0, 512, 512, 512, 0};
                  const int Tt = list == 1 && T0 + T1 < opqs(nblk) ? T0 + T1 : 0;
                  const MoeSlotOrder S{(const int*)(ws + A_MTAB + MT_BE) + 256 * list, (const unsigned*)(ws + WS_CTL) + CW_NPAN + list, (const int*)(ws + A_MTAB + MT_STOK) + list * MOE_MAXPAN * 256, 28, 28, 0, opqs(nblk), opqs(bid), RREAL,
                                         0, list == 0 ? MOE_MAXPAN : MOE_TAILPAN, 0, 0, Tt, MOE_CSKIP};
                  EpiSwiGLU8 E{ws + A_MACT, (const unsigned*)(ws + WS_CTL), FFE, 28};
                  pg8::gemm_phase<EpiSwiGLU8, MoeSlotOrder, true, true, true>(lds, g, S, E); }
                if (list == 0) {
                  unsigned char* ws = WSP; pg8::Gemm g{(const bf16_t*)(ws + A_XB + XB_LIST), (const bf16_t*)(ws + A_MGU), 0, 0, 512, 512, 512, 0};
                  const int nb = opqs(nblk);
                  const MoeSlotOrder S{(const int*)(ws + A_MTAB + MT_BE) + 256, (const unsigned*)(ws + WS_CTL) + CW_NPAN + 1, (const int*)(ws + A_MTAB + MT_STOK) + MOE_MAXPAN * 256, 28, 28, 0, nb, opqs(bid), RREAL,
                                         MOE_TAILPAN, MOE_MAXPAN, MOE_GAP, (np0 * 28) % nb, 0, 0};
                  EpiSwiGLU8 E{ws + A_MACT, (const unsigned*)(ws + WS_CTL), FFE, 28};
                  pg8::gemm_phase<EpiSwiGLU8, MoeSlotOrder, true, true, true>(lds, g, S, E); }
}
                GRID_BAR();
_Pragma("unroll 1") for (int rep_ = 0; rep_ < PROBE_REP_MOEDN; ++rep_) {
                { unsigned char* ws = WSP; pg8::Gemm g{(const bf16_t*)(ws + A_MACT), (const bf16_t*)(ws + A_MDN), 0, 0, FFE / 2, FFE / 2, FFE / 2, 0};
                  const MoeOrder S{(const int*)(ws + A_MTAB + MT_BE) + 256 * list, (const unsigned*)(ws + WS_CTL) + CW_NPAN + list, 4, 4, 0, opqs(nblk), opqs(bid), MOE_TAILPAN * 4};
                  EpiMoeDown E{OUTP, (const int*)(ws + A_MTAB + MT_STOK) + list * MOE_MAXPAN * 256, (const float*)(ws + A_MTAB + MT_SGATE) + list * MOE_MAXPAN * 256, 4, rep_ == 0 ? 1.0f : 0.0f, (const unsigned*)(ws + WS_CTL)};
                  pg8::gemm_phase<EpiMoeDown, MoeOrder, true, true, true>(lds, g, S, E); }
}
                GRID_BAR();
            }
        }
    }
    f_final(kp);
}

extern "C" void kernel_launch(void* const* d_in, const int* in_sizes, int n_in, void* d_out, int out_size, void* d_ws, size_t ws_size, hipStream_t stream) {
    static int grid = 0;
    if (grid == 0) {
        if (n_in != 33 || ws_size < WS_NEED || out_size != RREAL * D) { fprintf(stderr, "kernel_launch: unexpected arguments (n_in %d, ws %zu need %zu, out %d)\n", n_in, ws_size, (size_t)WS_NEED, out_size); grid = -1; return; }
        int dev = 0, cus = 0;
        if (hipGetDevice(&dev) != hipSuccess || hipDeviceGetAttribute(&cus, hipDeviceAttributeMultiprocessorCount, dev) != hipSuccess) { grid = -1; return; }
        if (hipFuncSetAttribute((const void*)fwd, hipFuncAttributeMaxDynamicSharedMemorySize, LDS_BYTES) != hipSuccess) { fprintf(stderr, "kernel_launch: hipFuncSetAttribute failed\n"); grid = -1; return; }
        int per_cu = 0; (void)hipOccupancyMaxActiveBlocksPerMultiprocessor(&per_cu, (const void*)fwd, 512, LDS_BYTES); (void)hipGetLastError();
        grid = cus;
    }
    if (grid < 0) return;
    unsigned char* ws = (unsigned char*)d_ws;
    (void)hipMemsetAsync(ws + WS_CTL, 0, 1 * MiB, stream);
    (void)hipMemsetAsync(ws + WS_WB, 0, WS_ROPE - WS_WB, stream);
    Params p{};
    for (int i = 0; i < 33; ++i) p.in[i] = (const float*)d_in[i];
    p.out = (float*)d_out; p.ws = ws;
    hipLaunchKernelGGL(fwd, dim3(grid), dim3(512), LDS_BYTES, stream, p);
}
```

```cpp
#include <hip/hip_runtime.h>
#include <cstdio>
#include <cstdint>
namespace pg8 {
#define PG8_LAS __attribute__((address_space(3)))
typedef unsigned short bf16_t;
typedef short bf16x8 __attribute__((ext_vector_type(8)));
typedef float f32x4 __attribute__((ext_vector_type(4)));
typedef unsigned u32x4 __attribute__((ext_vector_type(4)));
constexpr int BM = 256, BK = 64, HALF = 128, HTB = HALF * BK * 2  , STAGE_BYTES = 8 * HTB, NXCD = 8, WGM = 8;

__host__ __device__ __forceinline__ int lds_byte(int r, int c) { const int st = (r >> 4) * 2 + (c >> 5), rr = r & 15, cc = c & 31, ob = rr * 64 + cc * 2; return st * 1024 + (ob ^ (((ob >> 9) & 1) << 5)); }
__host__ __device__ __forceinline__ void stage_rc(int b, int& R, int& C) { const int st = b / 1024, sb = b % 1024, swz = sb ^ (((sb >> 9) & 1) << 5); R = (st >> 1) * 16 + swz / 64; C = (st & 1) * 32 + (swz % 64) / 2; }
__host__ __device__ __forceinline__ int perm32(int rho) { const int n = rho >> 4, i = rho & 15; return 8 * (i >> 2) + 4 * n + (i & 3); }

struct Unit { int pm, pn, k0; };
struct Gemm { const bf16_t* A; const bf16_t* Bt; int M, N, K, lda, ldb, pad; };

struct StaticOrder {
    static constexpr bool GATHER = false;
    int nM, nN, nwg, G, c;
    __host__ __device__ void init(int M, int N, int G_, int c_) { nM = M / BM; nN = N / BM; nwg = nM * nN; G = G_; c = c_; }
    __host__ __device__ bool next(int i, Unit& u) const {
        const long L = (long)i * G + c; if (L >= nwg) return false;
        int wgid = (int)L; { const int q = nwg / NXCD, r = nwg % NXCD, xcd = wgid % NXCD, off = wgid / NXCD; wgid = (xcd < r ? xcd * (q + 1) : r * (q + 1) + (xcd - r) * q) + off; }
        const int nig = WGM * nN, gid = wgid / nig, fm = gid * WGM, gsz = (nM - fm) < WGM ? (nM - fm) : WGM;
        u.pm = fm + ((wgid % nig) % gsz); u.pn = (wgid % nig) / gsz; u.k0 = 0; return true;
    }
    __device__ __forceinline__ void a_ready(const Unit&) const {}
    __device__ __forceinline__ void done(const Unit&) const {}
};

__device__ __forceinline__ unsigned cvt_pk_bf16(float lo, float hi) { unsigned r; asm volatile("v_cvt_pk_bf16_f32 %0, %1, %2" : "=v"(r) : "v"(lo), "v"(hi)); return r; }
typedef int i32x4_ __attribute__((ext_vector_type(4)));
typedef int i32x8_ __attribute__((ext_vector_type(8)));
template <class Epi, class Sched, bool ALIGN_EPI = false, bool SP2 = false, bool FP8 = false>
__device__ __forceinline__ void gemm_phase(PG8_LAS unsigned char* lds, const Gemm g, const Sched& S, const Epi& E) {
    int tid_ = threadIdx.x; asm volatile("" : "+v"(tid_)); const int tid = tid_, wid = __builtin_amdgcn_readfirstlane(tid >> 6), lane = tid & 63, wr = wid >> 2, wc = wid & 3, fr = lane & 15, fq = lane >> 4;
    const int K = g.K, nt = K / BK;
    unsigned voffA[2], voffB[2];
#pragma unroll
    for (int i = 0; i < 2; ++i) { int R, C; stage_rc(tid * 16 + i * 8192, R, C); const int Rb = Epi::PERM ? ((R & ~31) + perm32(R & 31)) : R;
        voffA[i] = (unsigned)(R * g.lda + C) * 2u; voffB[i] = (unsigned)(Rb * g.ldb + C) * 2u; }
    constexpr bool GATHER = Sched::GATHER;
    unsigned vAc[2][2] = {{0u, 0u}, {0u, 0u}}, vAn[2][2] = {{0u, 0u}, {0u, 0u}}, cbA[2] = {0u, 0u};
    if constexpr (GATHER) {
#pragma unroll
        for (int i = 0; i < 2; ++i) { int R, C; stage_rc(tid * 16 + i * 8192, R, C); cbA[i] = (unsigned)C * 2u; }
    }
#define PG8_IDX_DMA(un, slot) do { if constexpr (GATHER) { const int* rp_ = S.rows + (size_t)(un).pm * 256 + 128 * (lane >> 5) + 64 * ((lane >> 4) & 1) + 16 * (wid >> 1) + (lane & 15); \
        __builtin_amdgcn_global_load_lds((const unsigned*)rp_, (PG8_LAS unsigned*)(lds + STAGE_BYTES + wid * 512 + (slot) * 256), 4, 0, 0); } } while (0)
#define PG8_IDX_READ(dst, slot) do { if constexpr (GATHER) { int t3_ = threadIdx.x; asm volatile("" : "+v"(t3_));     \
        _Pragma("unroll") for (int h_ = 0; h_ < 2; ++h_) _Pragma("unroll") for (int i_ = 0; i_ < 2; ++i_) { int R_, C_; stage_rc(t3_ * 16 + i_ * 8192, R_, C_); \
        int tk_ = *(const PG8_LAS int*)(lds + STAGE_BYTES + (t3_ >> 6) * 512 + (slot) * 256 + 4 * (32 * h_ + 16 * i_ + ((t3_ & 63) >> 2))); tk_ = tk_ < 0 ? S.zero_row : tk_; \
        dst[h_][i_] = (unsigned)tk_ * (unsigned)(g.lda * 2) + (unsigned)C_ * 2u; } } } while (0)
#define PG8_STAGE_A(bufoff, base, h, nx) do { if constexpr (GATHER) { const unsigned vs_[2] = {(nx) ? vAn[h][0] : vAc[h][0], (nx) ? vAn[h][1] : vAc[h][1]}; PG8_STAGE(bufoff, base, vs_); } \
        else { PG8_STAGE(bufoff, (base) + (h) * hstepA, voffA); } } while (0)
    const size_t kstep = (size_t)(BK * 2);
    const size_t hstepA = (size_t)HALF * g.lda * 2, hstepB = (size_t)HALF * g.ldb * 2;
    const size_t tstepA = 2 * hstepA, tstepB = 2 * hstepB;
    const unsigned ldsw = (unsigned)wid * 1024u;
    const int aoff = lds_byte(wr * 64 + fr, fq * 8), boff = lds_byte(wc * 32 + fr, fq * 8);
#define PG8_SA(b, h) (((b) * 2 + (h)) * HTB)
#define PG8_SB(b, h) ((4 + (b) * 2 + (h)) * HTB)
#define PG8_STAGE(bufoff, gbase, voff) do { const char* gb_ = (const char*)(gbase); asm volatile("" : "+s"(gb_));   \
        _Pragma("unroll") for (int _i = 0; _i < 2; ++_i) \
        __builtin_amdgcn_global_load_lds((const unsigned*)(gb_ + (voff)[_i]), (PG8_LAS unsigned*)(lds + (bufoff) + ldsw + _i * 8192), 16, 0, 0); } while (0)
#define PG8_LDA(dst, b, h) do { _Pragma("unroll") for (int m = 0; m < 4; ++m) _Pragma("unroll") for (int k = 0; k < 2; ++k) dst[m][k] = *(const PG8_LAS bf16x8*)(lds + PG8_SA(b, h) + aoff + m * 2048 + k * 1024); } while (0)
#define PG8_LDB(dst, b, h) do { _Pragma("unroll") for (int n = 0; n < 2; ++n) _Pragma("unroll") for (int k = 0; k < 2; ++k) dst[n][k] = *(const PG8_LAS bf16x8*)(lds + PG8_SB(b, h) + boff + n * 2048 + k * 1024); } while (0)
#define PG8_MMA(ai, bj, At, Bt) do { __builtin_amdgcn_s_setprio(1); _Pragma("unroll") for (int m = 0; m < 4; ++m) _Pragma("unroll") for (int n = 0; n < 2; ++n) { \
        if constexpr (FP8) { const i32x8_ b8_ = __builtin_shufflevector(__builtin_bit_cast(i32x4_, Bt[n][0]), __builtin_bit_cast(i32x4_, Bt[n][1]), 0, 1, 2, 3, 4, 5, 6, 7); \
            const i32x8_ a8_ = __builtin_shufflevector(__builtin_bit_cast(i32x4_, At[m][0]), __builtin_bit_cast(i32x4_, At[m][1]), 0, 1, 2, 3, 4, 5, 6, 7); \
            acc[ai][bj][m][n] = __builtin_amdgcn_mfma_scale_f32_16x16x128_f8f6f4(b8_, a8_, acc[ai][bj][m][n], 0, 0, 0, 0, 0, 0); }     \
        else { _Pragma("unroll") for (int k = 0; k < 2; ++k) acc[ai][bj][m][n] = __builtin_amdgcn_mfma_f32_16x16x32_bf16(Bt[n][k], At[m][k], acc[ai][bj][m][n], 0, 0, 0); } } \
        __builtin_amdgcn_s_setprio(0); } while (0)
#define PG8_WAIT_V(n) asm volatile("s_waitcnt vmcnt(" #n ")" ::: "memory")
#define PG8_WAIT_L(n) asm volatile("s_waitcnt lgkmcnt(" #n ")" ::: "memory")
#define PG8_BAR __builtin_amdgcn_s_barrier()
#define PG8_SCHED __builtin_amdgcn_sched_barrier(0)
    Unit cur, nxt; int ui = 0;
    if (!S.next(0, cur)) return;
    float zf_ = 0.f; asm volatile("" : "+v"(zf_));
    f32x4 acc[2][2][4][2];
#pragma unroll
    for (int a = 0; a < 2; ++a)
#pragma unroll
        for (int b = 0; b < 2; ++b)
#pragma unroll
            for (int m = 0; m < 4; ++m)
#pragma unroll
                for (int n = 0; n < 2; ++n) acc[a][b][m][n] = (f32x4){zf_, zf_, zf_, zf_};
    bf16x8 At[4][2], B0[2][2], B1[2][2];
    const char* cA = (const char*)g.A + (GATHER ? (size_t)0 : (size_t)cur.pm * tstepA) + (size_t)cur.k0 * 2; const char* cB = (const char*)g.Bt + (size_t)cur.pn * tstepB + (size_t)cur.k0 * 2;
    S.a_ready(cur);
    if constexpr (GATHER) { PG8_IDX_DMA(cur, 0); asm volatile("s_waitcnt vmcnt(0)" ::: "memory"); PG8_IDX_READ(vAc, 0); }
    if constexpr (SP2) {
        PG8_STAGE(PG8_SB(0, 0), cB, voffB); PG8_STAGE(PG8_SB(0, 1), cB + hstepB, voffB); PG8_STAGE_A(PG8_SA(0, 0), cA, 0, false); PG8_STAGE_A(PG8_SA(0, 1), cA, 1, false);
        if (wr == 1) PG8_BAR;
        PG8_WAIT_V(2); PG8_BAR;
        PG8_STAGE(PG8_SB(1, 0), cB + kstep, voffB); PG8_STAGE_A(PG8_SA(1, 0), cA + kstep, 0, false); PG8_STAGE(PG8_SB(1, 1), cB + hstepB + kstep, voffB);
        PG8_WAIT_V(6); PG8_BAR;
    } else {
        PG8_STAGE(PG8_SB(0, 0), cB, voffB); PG8_STAGE(PG8_SA(0, 0), cA, voffA); PG8_STAGE(PG8_SB(0, 1), cB + hstepB, voffB); PG8_STAGE(PG8_SA(0, 1), cA + hstepA, voffA);
        if (wr == 1) PG8_BAR;
        PG8_WAIT_V(4); PG8_BAR;
        PG8_STAGE(PG8_SB(1, 0), cB + kstep, voffB); PG8_STAGE(PG8_SA(1, 0), cA + kstep, voffA); PG8_STAGE(PG8_SB(1, 1), cB + hstepB + kstep, voffB);
        PG8_WAIT_V(6); PG8_BAR;
    }
    for (;;) {
        const bool has_next = S.next(ui + 1, nxt);
        const char* nA = has_next ? (const char*)g.A + (GATHER ? (size_t)0 : (size_t)nxt.pm * tstepA) + (size_t)nxt.k0 * 2 : cA; const char* nB = has_next ? (const char*)g.Bt + (size_t)nxt.pn * tstepB + (size_t)nxt.k0 * 2 : cB;
        if constexpr (GATHER) { if (has_next) PG8_IDX_DMA(nxt, (ui + 1) & 1); }
        for (int t = 0; t < nt; t += 2) {
            const bool last = (t == nt - 2); const bool lnx = last && has_next;
            const char* a1 = cA + (size_t)(t + 1) * kstep;
            const char* a2 = last ? nA : cA + (size_t)(t + 2) * kstep; const char* b2 = last ? nB : cB + (size_t)(t + 2) * kstep;
            const char* a3 = a2 + kstep; const char* b3 = b2 + kstep;
            if (last && has_next) S.a_ready(nxt);
            if constexpr (GATHER) { if (lnx) PG8_IDX_READ(vAn, (ui + 1) & 1); }
            if constexpr (SP2) {
            PG8_LDB(B0, 0, 0); PG8_LDB(B1, 0, 1); PG8_SCHED; PG8_LDA(At, 0, 0); PG8_STAGE_A(PG8_SA(1, 1), a1, 1, false);
            PG8_WAIT_V(8); PG8_WAIT_L(0); PG8_BAR; PG8_MMA(0, 0, At, B0); PG8_MMA(0, 1, At, B1); PG8_BAR; PG8_SCHED;
            PG8_LDA(At, 0, 1); PG8_STAGE(PG8_SB(0, 0), b2, voffB); PG8_STAGE(PG8_SB(0, 1), b2 + hstepB, voffB); PG8_STAGE_A(PG8_SA(0, 0), a2, 0, lnx);
            PG8_WAIT_V(8); PG8_WAIT_L(0); PG8_BAR; PG8_MMA(1, 0, At, B0); PG8_MMA(1, 1, At, B1); PG8_BAR; PG8_SCHED;
            PG8_LDB(B0, 1, 0); PG8_LDB(B1, 1, 1); PG8_SCHED; PG8_LDA(At, 1, 0); PG8_STAGE_A(PG8_SA(0, 1), a2, 1, lnx);
            PG8_WAIT_V(8); PG8_WAIT_L(0); PG8_BAR; PG8_MMA(0, 0, At, B0); PG8_MMA(0, 1, At, B1); PG8_BAR; PG8_SCHED;
            PG8_LDA(At, 1, 1); PG8_STAGE(PG8_SB(1, 0), b3, voffB); PG8_STAGE(PG8_SB(1, 1), b3 + hstepB, voffB); PG8_STAGE_A(PG8_SA(1, 0), a3, 0, lnx);
            PG8_WAIT_V(8); PG8_WAIT_L(0); PG8_BAR; PG8_MMA(1, 0, At, B0); PG8_MMA(1, 1, At, B1); PG8_BAR; PG8_SCHED;
            } else {
            PG8_LDB(B0, 0, 0); PG8_SCHED; PG8_LDA(At, 0, 0); PG8_STAGE(PG8_SA(1, 1), a1 + hstepA, voffA);
            PG8_WAIT_L(8); PG8_BAR; PG8_WAIT_L(0); PG8_MMA(0, 0, At, B0); PG8_BAR; PG8_SCHED;
            PG8_LDB(B1, 0, 1); PG8_STAGE(PG8_SB(0, 0), b2, voffB);
            PG8_BAR; PG8_WAIT_L(0); PG8_MMA(0, 1, At, B1); PG8_BAR;
            PG8_LDA(At, 0, 1); PG8_STAGE(PG8_SA(0, 0), a2, voffA);
            PG8_BAR; PG8_WAIT_L(0); PG8_MMA(1, 0, At, B0); PG8_BAR; PG8_SCHED;
            PG8_STAGE(PG8_SB(0, 1), b2 + hstepB, voffB);
            PG8_WAIT_V(6); PG8_BAR; PG8_MMA(1, 1, At, B1); PG8_BAR;
            PG8_LDB(B0, 1, 0); PG8_SCHED; PG8_LDA(At, 1, 0); PG8_STAGE(PG8_SA(0, 1), a2 + hstepA, voffA);
            PG8_WAIT_L(8); PG8_BAR; PG8_WAIT_L(0); PG8_MMA(0, 0, At, B0); PG8_BAR; PG8_SCHED;
            PG8_LDB(B1, 1, 1); PG8_STAGE(PG8_SB(1, 0), b3, voffB);
            PG8_BAR; PG8_WAIT_L(0); PG8_MMA(0, 1, At, B1); PG8_BAR;
            PG8_LDA(At, 1, 1); PG8_STAGE(PG8_SA(1, 0), a3, voffA);
            PG8_BAR; PG8_WAIT_L(0); PG8_MMA(1, 0, At, B0); PG8_BAR; PG8_SCHED;
            PG8_STAGE(PG8_SB(1, 1), b3 + hstepB, voffB);
            PG8_WAIT_V(6); PG8_BAR; PG8_MMA(1, 1, At, B1); PG8_BAR;
            }
        }
        if constexpr (ALIGN_EPI) { if (wr == 0) PG8_BAR; }
        if constexpr (!Epi::AFTER_DRAIN) { int t2_ = threadIdx.x; asm volatile("" : "+v"(t2_)); const int fr2_ = t2_ & 15, fq2_ = (t2_ >> 4) & 3;
            E(acc, cur, wr, wc, fr2_, fq2_); S.done(cur); }
        if (!has_next) break;
#pragma unroll
        for (int a = 0; a < 2; ++a)
#pragma unroll
            for (int b = 0; b < 2; ++b)
#pragma unroll
                for (int m = 0; m < 4; ++m)
#pragma unroll
                    for (int n = 0; n < 2; ++n) acc[a][b][m][n] = (f32x4){zf_, zf_, zf_, zf_};
        cur = nxt; cA = nA; cB = nB; ++ui;
        if constexpr (GATHER) { vAc[0][0] = vAn[0][0]; vAc[0][1] = vAn[0][1]; vAc[1][0] = vAn[1][0]; vAc[1][1] = vAn[1][1]; }
        if constexpr (ALIGN_EPI) { if (wr == 1) PG8_BAR; }
    }
    PG8_WAIT_V(0);
    if constexpr (!ALIGN_EPI) { if (wr == 0) PG8_BAR; }
    PG8_BAR;
    if constexpr (Epi::AFTER_DRAIN) { E.fused(acc, cur, wr, wc, fr, fq, lds, wid, lane); S.done(cur); }
#undef PG8_SA
#undef PG8_SB
#undef PG8_STAGE
#undef PG8_STAGE_A
#undef PG8_IDX_DMA
#undef PG8_IDX_READ
#undef PG8_LDA
#undef PG8_LDB
#undef PG8_MMA
#undef PG8_WAIT_V
#undef PG8_WAIT_L
#undef PG8_BAR
#undef PG8_SCHED
}
}

typedef unsigned short bf16_t;
typedef short bf16x8 __attribute__((ext_vector_type(8)));
typedef short s16x4 __attribute__((ext_vector_type(4)));
typedef float f32x4 __attribute__((ext_vector_type(4)));
typedef float f32x16 __attribute__((ext_vector_type(16)));
typedef unsigned u32x4 __attribute__((ext_vector_type(4)));
typedef unsigned u32x2 __attribute__((ext_vector_type(2)));
#define LAS __attribute__((address_space(3)))
#define GAS __attribute__((address_space(1)))

constexpr int D = 1024, NB = 8, SEQ = 4096, NMETA = 16;
constexpr int RREAL = NB * SEQ;
constexpr int RVALID = RREAL + NMETA;
constexpr int NPAN = 129, RP = NPAN * 256;
constexpr int PMW = 1024, PRW = 1792;
constexpr int CW = 512;
constexpr int FF0 = 2816, FFE = 3584, NEXP = 8;
constexpr float RMS_EPS = 1e-6f, GN_EPS = 64e-5f;
constexpr int MOE_MAXPAN = 144;
constexpr int MOE_TAILPAN = 128, MOE_GAP = 8;
#ifndef MOE_CSKIP
#define MOE_CSKIP 5
#endif

typedef float f32x2_t __attribute__((ext_vector_type(2))); typedef __bf16 bf16x2_t __attribute__((ext_vector_type(2)));
__device__ __forceinline__ unsigned cvtpk(float lo, float hi) { f32x2_t v = {lo, hi}; bf16x2_t b = __builtin_convertvector(v, bf16x2_t); return __builtin_bit_cast(unsigned, b); }
__device__ __forceinline__ bf16_t f2bf_hw(float x) { return (bf16_t)(cvtpk(x, x) & 0xffffu); }
__device__ __forceinline__ float bf2f(bf16_t b) { return __uint_as_float(((unsigned)b) << 16); }
__device__ __forceinline__ bf16_t f2bf(float f) { unsigned u = __float_as_uint(f); u += 0x7fffu + ((u >> 16) & 1u); return (bf16_t)(u >> 16); }
__device__ __forceinline__ unsigned pk2(float lo, float hi) { return (unsigned)f2bf(lo) | ((unsigned)f2bf(hi) << 16); }
#define DPP_F(v_, ctrl_, rmask_) __int_as_float(__builtin_amdgcn_update_dpp(0, __float_as_int(v_), (ctrl_), (rmask_), 0xf, false))
__device__ __forceinline__ float wave_sum(float v) {
    v += DPP_F(v, 0xB1, 0xf); v += DPP_F(v, 0x4E, 0xf); v += DPP_F(v, 0x141, 0xf); v += DPP_F(v, 0x140, 0xf);
    v += DPP_F(v, 0x142, 0xa); v += DPP_F(v, 0x143, 0xc);
    return __int_as_float(__builtin_amdgcn_readlane(__float_as_int(v), 63));
}
__device__ __forceinline__ float wave_max(float v) {
    v = fmaxf(v, DPP_F(v, 0xB1, 0xf)); v = fmaxf(v, DPP_F(v, 0x4E, 0xf)); v = fmaxf(v, DPP_F(v, 0x141, 0xf)); v = fmaxf(v, DPP_F(v, 0x140, 0xf));
    v = fmaxf(v, DPP_F(v, 0x142, 0xa)); v = fmaxf(v, DPP_F(v, 0x143, 0xc));
    return __int_as_float(__builtin_amdgcn_readlane(__float_as_int(v), 63));
}
constexpr float F8_MAX = 448.0f, F8_ACT = 8.0f;
__device__ __forceinline__ unsigned pk4_f8(float a, float b, float c, float d) {
    float mx = F8_MAX; asm volatile("" : "+v"(mx));
    a = __builtin_amdgcn_fmed3f(a, -mx, mx); b = __builtin_amdgcn_fmed3f(b, -mx, mx); c = __builtin_amdgcn_fmed3f(c, -mx, mx); d = __builtin_amdgcn_fmed3f(d, -mx, mx);
    int r = __builtin_amdgcn_cvt_pk_fp8_f32(a, b, 0, false); r = __builtin_amdgcn_cvt_pk_fp8_f32(c, d, r, true); return (unsigned)r; }
__device__ __forceinline__ float moe_wscale(const unsigned* ctl, int t, int e);
__device__ __forceinline__ float quad_sum(float v) { v += DPP_F(v, 0xB1, 0xf); v += DPP_F(v, 0x4E, 0xf); return v; }
__device__ __forceinline__ float sigmoidf_(float x) { return 1.0f / (1.0f + __expf(-x)); }
__device__ __forceinline__ int row_pos(int row) { return row < RREAL ? NMETA + (row & (SEQ - 1)) : row - RREAL; }
__device__ __forceinline__ int row_prev(int row) { if (row < RREAL) return (row & (SEQ - 1)) ? row - 1 : RVALID - 1; return row == RREAL ? -1 : row - 1; }

constexpr size_t MiB = 1u << 20;
constexpr size_t WS_CTL = 0;
constexpr size_t WS_HMETA = 1 * MiB;
constexpr size_t WS_WB = 2 * MiB;
constexpr size_t LW_STRIDE = 10 * MiB;
constexpr size_t LW_WIN = 0, LW_WUQ = LW_WIN + (size_t)2816 * 1024 * 2, LW_WK = LW_WUQ + (size_t)768 * 512 * 2, LW_WV = LW_WK + (size_t)512 * 256 * 2,
                 LW_LORA = LW_WV + (size_t)512 * 256 * 2, LW_WOUT = LW_LORA + (size_t)1536 * 256 * 2, LW_END = LW_WOUT + (size_t)1024 * 1024 * 2;
static_assert(LW_END <= LW_STRIDE, "layer weights");
constexpr size_t WS_V1T = WS_WB + 2 * LW_STRIDE, WS_V2T = WS_V1T + (size_t)256 * 512 * 2, WS_FGU = WS_V2T + (size_t)512 * 256 * 2,
                 WS_FDN = WS_FGU + (size_t)5632 * 1024 * 2, WS_ROPE = WS_FDN + (size_t)1024 * 2816 * 2, WS_WB_END = WS_ROPE + (size_t)4112 * 64 * 4;
constexpr size_t WS_TB = WS_FGU;
constexpr size_t WS_ARENA = 41 * MiB;
static_assert(WS_WB_END <= WS_ARENA, "weights fit");
static_assert((size_t)8 * 256 * 1024 * 4 <= (size_t)5632 * 1024 * 2, "list-1 tail buffer fits the dense gate/up weight slot");
constexpr size_t SZ_R1024 = (size_t)RP * 1024 * 2, SZ_R512 = (size_t)RP * 512 * 2, SZ_R256 = (size_t)RP * 256 * 2;
constexpr size_t A_U = WS_ARENA;
constexpr size_t A_KN = A_U + SZ_R1024;
constexpr size_t A_VT = A_KN + SZ_R512;
constexpr size_t A_LOUT = A_U, A_VMIX = A_VT;
static_assert((size_t)RP * 1536 * 2 == SZ_R1024 + SZ_R512, "LORA_OUT fills the U and KN slots exactly");
constexpr size_t A_PM = A_VT + SZ_R512;
constexpr size_t A_PR = A_PM + SZ_R1024;
constexpr size_t A_SMALL = A_PR + (size_t)RP * PRW * 2;
constexpr size_t A_RSTDQ = A_SMALL, A_RSTDKV = A_RSTDQ + (size_t)RP * 4, A_KROPE = A_RSTDKV + (size_t)RP * 4, A_SMALL_END = A_KROPE + (size_t)RP * 64 * 2;
constexpr size_t A_LIN = (A_SMALL_END + 4095) & ~(size_t)4095;
constexpr size_t A_VSH = A_LIN + SZ_R256;
constexpr size_t A_CHK = A_LIN;
constexpr size_t SZ_CHK = (size_t)258 * 8 * 32768;
constexpr size_t A_VFIRST = (A_CHK + SZ_CHK > A_VSH + SZ_R512 ? A_CHK + SZ_CHK : A_VSH + SZ_R512);
constexpr size_t A_VP = A_VFIRST + SZ_R512;
constexpr size_t A_RK = A_VP + SZ_R512;
constexpr size_t A_YS = A_RK + (size_t)RP * 8 * 4;
constexpr size_t A_SCST = A_YS + SZ_R512;
constexpr size_t A_PART = A_SCST + (size_t)64 * 4096 * 4;
constexpr size_t A_END1 = A_PART + (size_t)11 * NMETA * 1024 * 4;
constexpr size_t A_ACT0 = A_PM;
constexpr size_t A_MGU = A_KN;
constexpr size_t A_MDN = A_MGU + (size_t)NEXP * 7168 * 1024 * 2;
constexpr size_t A_MTAB = A_MDN + (size_t)NEXP * 1024 * 3584 * 2;
constexpr size_t MT_E = 0, MT_G = MT_E + (size_t)2 * RREAL * 4, MT_STOK = MT_G + (size_t)2 * RREAL * 4, MT_TSLOT = MT_STOK + (size_t)2 * MOE_MAXPAN * 256 * 4  , MT_SGATE = MT_TSLOT + (size_t)RREAL * 4,
                 MT_BE = MT_SGATE + (size_t)2 * MOE_MAXPAN * 256 * 4, MT_END = MT_BE + 2 * 256 * 4;
constexpr size_t A_MACT = (A_MTAB + MT_END + 4095) & ~(size_t)4095;
constexpr size_t XB_LIST = (size_t)MOE_MAXPAN * 256 * 1024;
constexpr size_t A_XB = A_MACT + (size_t)MOE_MAXPAN * 256 * FFE;
static_assert(A_XB + 2 * XB_LIST <= A_MACT + (size_t)MOE_MAXPAN * 256 * FFE * 2, "XB inside the old activation footprint");
constexpr size_t A_END2 = A_MACT + (size_t)MOE_MAXPAN * 256 * FFE * 2;
constexpr size_t WS_NEED = (A_END1 > A_END2 ? A_END1 : A_END2);
static_assert(WS_NEED <= 557619232ull, "workspace budget (sum of the inputs' bytes)");
static_assert(A_ACT0 + (size_t)RP * FF0 * 2 <= A_SMALL, "dense act overlay");
constexpr int CW_CNT = 64;
constexpr int CW_FILL = 128;
constexpr int CW_NPAN = 192;
constexpr int CW_WINV = 16448;
constexpr int CW_WMAX = 16384;
constexpr int CW_WGCNT = 8192;


__device__ __forceinline__ unsigned long long kp_uniform(unsigned long long kp) { const unsigned lo = __builtin_amdgcn_readfirstlane((unsigned)kp), hi = __builtin_amdgcn_readfirstlane((unsigned)(kp >> 32)); return ((unsigned long long)hi << 32) | lo; }
__device__ __forceinline__ const void* ldk(unsigned long long kp, int off) { unsigned long long v;
    asm volatile("s_load_dwordx2 %0, %1, %2\n\ts_waitcnt lgkmcnt(0)" : "=s"(v) : "s"(kp), "i"(off) : "memory"); return (const void*)v; }
__device__ __forceinline__ int opq(int v) { asm volatile("" : "+v"(v)); return v; }
__device__ __forceinline__ int opqs(int v) { asm volatile("" : "+s"(v)); return v; }
__device__ __forceinline__ void lds_barrier() { asm volatile("s_waitcnt lgkmcnt(0)\n\ts_barrier" ::: "memory"); }

__device__ __forceinline__ float moe_wscale_bits(unsigned bits) { const float m = __uint_as_float(bits);
    return m > 0.f ? __builtin_amdgcn_exp2f(floorf(__builtin_amdgcn_logf(224.0f / m))) : 1.0f; }
__device__ __forceinline__ float moe_wscale(const unsigned* ctl, int t, int e) { return moe_wscale_bits((unsigned)__builtin_amdgcn_readfirstlane((int)ctl[CW_WMAX + t * 8 + e])); }
#define XB_TMO      128
#define XB_XCNT(j)  (256  + 64 * (j))
#define XB_XSUB(j)  (1280 + 64 * (j))
#define XB_XGEN(j)  (2304 + 64 * (j))
#define XB_TOP      3328
#define XB_TOPGEN   3392
#define XCD_BAR_WORDS 3456
#define XB_SPIN_CAP (1u << 18)

__device__ __forceinline__ unsigned xb_ld(unsigned* p)              { return __hip_atomic_load(p, __ATOMIC_RELAXED, __HIP_MEMORY_SCOPE_AGENT); }
__device__ __forceinline__ unsigned xb_add(unsigned* p, unsigned v) { return __hip_atomic_fetch_add(p, v, __ATOMIC_RELAXED, __HIP_MEMORY_SCOPE_AGENT); }
__device__ __forceinline__ unsigned xb_xcc_id() { return (unsigned)__builtin_amdgcn_s_getreg((3 << 11) | 20) & 0xFu; }
#define XB_SPIN(cond, bar) do { unsigned _sp = 0; while (cond) { __builtin_amdgcn_s_sleep(1); \
    if ((++_sp & 255u) == 0u) { if (xb_ld(&(bar)[XB_TMO])) break; if (_sp > XB_SPIN_CAP) { atomicAdd(&(bar)[XB_TMO], 1u); break; } } } } while (0)

struct XcdBarrier {
    unsigned* bar; unsigned x;
    volatile LAS unsigned* st;
};

__device__ __forceinline__ XcdBarrier xcd_barrier_post(unsigned* bar, volatile LAS unsigned* st) {
    XcdBarrier b; b.bar = bar; b.x = xb_xcc_id(); b.st = st;
    if (threadIdx.x == 0) (void)xb_add(&bar[XB_XCNT(b.x)], 1u);
    return b;
}
__device__ __forceinline__ void xcd_barrier_complete(unsigned* bar, unsigned x, unsigned& nloc, unsigned& nx) {
    const unsigned G = gridDim.x * gridDim.y * gridDim.z;
    unsigned sum, cnt, mine, sp = 0u;
    for (;;) {
        sum = 0u; cnt = 0u; mine = 0u;
#pragma unroll
        for (unsigned j = 0; j < 16; ++j) { const unsigned c = xb_ld(&bar[XB_XCNT(j)]); sum += c; cnt += (c > 0u) ? 1u : 0u; mine = (j == x) ? c : mine; }
        if (sum == G) break;
        __builtin_amdgcn_s_sleep(1);
        if ((++sp & 255u) == 0u) { if (xb_ld(&bar[XB_TMO])) break; if (sp > XB_SPIN_CAP) { atomicAdd(&bar[XB_TMO], 1u); break; } }
    }
    nloc = mine > 0u ? mine : 1u; nx = cnt > 0u ? cnt : 1u;
}

__device__ __attribute__((noinline)) void xcd_barrier_fn(unsigned* bar_, unsigned x_, volatile LAS unsigned* st_) {
    XcdBarrier b; b.bar = bar_; b.x = x_; b.st = st_;
    asm volatile("s_waitcnt vmcnt(0)" ::: "memory");
    __syncthreads();
    if (threadIdx.x == 0) {
        unsigned* bar = b.bar;
        __builtin_amdgcn_s_waitcnt(0);
        unsigned nloc = b.st[0], nx = b.st[1];
        if (nloc == 0u) { xcd_barrier_complete(bar, b.x, nloc, nx); b.st[0] = nloc; b.st[1] = nx; }
        const unsigned old = xb_add(&bar[XB_XSUB(b.x)], 1u);
        const unsigned gen = old / nloc;
        if (old + 1u == (gen + 1u) * nloc) {
            __builtin_amdgcn_fence(__ATOMIC_RELEASE, "agent");
            asm volatile("s_waitcnt vmcnt(0)" ::: "memory");
            const unsigned og = xb_add(&bar[XB_TOP], 1u);
            const unsigned tg = og / nx;
            if (og + 1u == (tg + 1u) * nx) xb_add(&bar[XB_TOPGEN], 1u);
            else XB_SPIN(xb_ld(&bar[XB_TOPGEN]) == tg, bar);
            __builtin_amdgcn_fence(__ATOMIC_ACQUIRE, "agent");
            xb_add(&bar[XB_XGEN(b.x)], 1u);
            asm volatile("s_waitcnt vmcnt(0)" ::: "memory");
        } else {
            XB_SPIN(xb_ld(&bar[XB_XGEN(b.x)]) == gen, bar);
            __builtin_amdgcn_fence(__ATOMIC_ACQUIRE, "agent");
            asm volatile("s_waitcnt vmcnt(0)" ::: "memory");
        }
    }
    __syncthreads();
}

__device__ __forceinline__ void xcd_barrier(const XcdBarrier& b) { xcd_barrier_fn(b.bar, b.x, b.st); }
using pg8::Unit;
struct EpiInProj { static constexpr bool PERM = true, AFTER_DRAIN = false; bf16_t* PM; bf16_t* PR;
    __device__ __forceinline__ void operator()(const f32x4 (&acc)[2][2][4][2], const Unit& u, int wr, int wc, int fr, int fq) const {
        const int row0 = u.pm * 256 + wr * 64 + fr; bf16_t* base; int ld, colt;
        if (u.pn < 4) { base = PM; ld = PMW; colt = u.pn * 256; } else { base = PR; ld = PRW; colt = (u.pn - 4) * 256; }
        const int col0 = colt + wc * 32 + 8 * fq;
#pragma unroll
        for (int ai = 0; ai < 2; ++ai)
#pragma unroll
            for (int m = 0; m < 4; ++m) { bf16_t* rowp = base + (size_t)(row0 + ai * 128 + m * 16) * ld + col0;
#pragma unroll
                for (int bj = 0; bj < 2; ++bj) { const f32x4 v0 = acc[ai][bj][m][0], v1 = acc[ai][bj][m][1];
                    u32x4 w; w.x = pg8::cvt_pk_bf16(v0[0], v0[1]); w.y = pg8::cvt_pk_bf16(v0[2], v0[3]); w.z = pg8::cvt_pk_bf16(v1[0], v1[1]); w.w = pg8::cvt_pk_bf16(v1[2], v1[3]);
                    *(u32x4*)(rowp + bj * 128) = w; } }
    }
};
struct EpiRowScale { static constexpr bool PERM = true, AFTER_DRAIN = false; bf16_t* O; const float* rs; int ldc, pad;
    __device__ __forceinline__ void operator()(const f32x4 (&acc)[2][2][4][2], const Unit& u, int wr, int wc, int fr, int fq) const {
        const int row0 = u.pm * 256 + wr * 64 + fr; const int col0 = u.pn * 256 + wc * 32 + 8 * fq;
#pragma unroll
        for (int ai = 0; ai < 2; ++ai)
#pragma unroll
            for (int m = 0; m < 4; ++m) { const int row = row0 + ai * 128 + m * 16; const float s = rs ? rs[row] : 1.f; bf16_t* rowp = O + (size_t)row * ldc + col0;
#pragma unroll
                for (int bj = 0; bj < 2; ++bj) { const f32x4 v0 = acc[ai][bj][m][0] * s, v1 = acc[ai][bj][m][1] * s;
                    u32x4 w; w.x = pg8::cvt_pk_bf16(v0[0], v0[1]); w.y = pg8::cvt_pk_bf16(v0[2], v0[3]); w.z = pg8::cvt_pk_bf16(v1[0], v1[1]); w.w = pg8::cvt_pk_bf16(v1[2], v1[3]);
                    *(u32x4*)(rowp + bj * 128) = w; } }
    }
};
struct EpiColScale { static constexpr bool PERM = true, AFTER_DRAIN = false; bf16_t* O; const float* cs; int ldc, pad;
    __device__ __forceinline__ void operator()(const f32x4 (&acc)[2][2][4][2], const Unit& u, int wr, int wc, int fr, int fq) const {
        const int row0 = u.pm * 256 + wr * 64 + fr; const int col0 = u.pn * 256 + wc * 32 + 8 * fq;
        f32x4 sc[2][2];
#pragma unroll
        for (int bj = 0; bj < 2; ++bj) { sc[bj][0] = *(const f32x4*)(cs + col0 + bj * 128); sc[bj][1] = *(const f32x4*)(cs + col0 + bj * 128 + 4); }
#pragma unroll
        for (int ai = 0; ai < 2; ++ai)
#pragma unroll
            for (int m = 0; m < 4; ++m) { bf16_t* rowp = O + (size_t)(row0 + ai * 128 + m * 16) * ldc + col0;
#pragma unroll
                for (int bj = 0; bj < 2; ++bj) { const f32x4 v0 = acc[ai][bj][m][0] * sc[bj][0], v1 = acc[ai][bj][m][1] * sc[bj][1];
                    u32x4 w; w.x = pg8::cvt_pk_bf16(v0[0], v0[1]); w.y = pg8::cvt_pk_bf16(v0[2], v0[3]); w.z = pg8::cvt_pk_bf16(v1[0], v1[1]); w.w = pg8::cvt_pk_bf16(v1[2], v1[3]);
                    *(u32x4*)(rowp + bj * 128) = w; } }
    }
};
struct EpiResid { static constexpr bool PERM = false, AFTER_DRAIN = false; float* out; float* hmeta; const float* src; float scale; int pad;
    __device__ __forceinline__ void operator()(const f32x4 (&acc)[2][2][4][2], const Unit& u, int wr, int wc, int fr, int fq) const {
        const int rl = wr * 64 + fr, col0 = u.pn * 256 + wc * 32 + 4 * fq;
        float* base = u.pm < 128 ? out + (size_t)u.pm * 256 * D : hmeta; const float* sbase = u.pm < 128 ? src + (size_t)u.pm * 256 * D : hmeta;
#pragma unroll
        for (int ai = 0; ai < 2; ++ai)
#pragma unroll
            for (int m = 0; m < 4; ++m) { const size_t ro = (size_t)(rl + ai * 128 + m * 16) * D + col0;
#pragma unroll
                for (int bj = 0; bj < 2; ++bj)
#pragma unroll
                    for (int n = 0; n < 2; ++n) { const f32x4 hv = *(const f32x4*)(sbase + ro + bj * 128 + n * 16); *(f32x4*)(base + ro + bj * 128 + n * 16) = hv + acc[ai][bj][m][n] * scale; }
                asm volatile("" ::: "memory"); }
    }
};
struct EpiSwiGLU { static constexpr bool PERM = true, AFTER_DRAIN = false; bf16_t* O; int ldc, nmod, pn_off, pad;
    __device__ __forceinline__ void operator()(const f32x4 (&acc)[2][2][4][2], const Unit& u, int wr, int wc, int fr, int fq) const {
        const int row0 = u.pm * 256 + wr * 64 + fr; const int pnl = (u.pn % nmod) - pn_off; const int col0 = pnl * 128 + wc * 32 + 8 * fq;
#pragma unroll
        for (int ai = 0; ai < 2; ++ai)
#pragma unroll
            for (int m = 0; m < 4; ++m) { bf16_t* rowp = O + (size_t)(row0 + ai * 128 + m * 16) * ldc + col0; float r[8];
#pragma unroll
                for (int n = 0; n < 2; ++n)
#pragma unroll
                    for (int j = 0; j < 4; ++j) { const float g = acc[ai][0][m][n][j], up = acc[ai][1][m][n][j]; r[4 * n + j] = g / (1.0f + __expf(-g)) * up; }
                u32x4 w; w.x = pg8::cvt_pk_bf16(r[0], r[1]); w.y = pg8::cvt_pk_bf16(r[2], r[3]); w.z = pg8::cvt_pk_bf16(r[4], r[5]); w.w = pg8::cvt_pk_bf16(r[6], r[7]);
                *(u32x4*)rowp = w; }
    }
};
struct EpiSwiGLU8 { static constexpr bool PERM = false, AFTER_DRAIN = false; unsigned char* O; const unsigned* ctl; int ldc, nmod;
    __device__ __forceinline__ void operator()(const f32x4 (&acc)[2][2][4][2], const Unit& u, int wr, int wc, int fr, int fq) const {
        const int row0 = u.pm * 256 + wr * 64 + fr; const int e = u.pn / nmod, pnl = u.pn % nmod; const int col0 = pnl * 128 + wc * 32 + 4 * fq;
        const float ig = __uint_as_float(__builtin_amdgcn_readfirstlane((int)ctl[CW_WINV + e])), iu = __uint_as_float(__builtin_amdgcn_readfirstlane((int)ctl[CW_WINV + 8 + e])) * F8_ACT;
#pragma unroll
        for (int ai = 0; ai < 2; ++ai)
#pragma unroll
            for (int m = 0; m < 4; ++m) { unsigned char* rowp = O + (size_t)(row0 + ai * 128 + m * 16) * ldc + col0;
#pragma unroll
                for (int n = 0; n < 2; ++n) { float r[4];
#pragma unroll
                    for (int j = 0; j < 4; ++j) { const float g = acc[ai][0][m][n][j] * ig, up = acc[ai][1][m][n][j] * iu; r[j] = g / (1.0f + __expf(-g)) * up; }
                    *(unsigned*)(rowp + n * 16) = pk4_f8(r[0], r[1], r[2], r[3]); } }
    }
};
struct EpiMoeDown { static constexpr bool PERM = false, AFTER_DRAIN = false; float* out; const int* stok; const float* sgate; int nmod; float scale; const unsigned* ctl;
    __device__ __forceinline__ void operator()(const f32x4 (&acc)[2][2][4][2], const Unit& u, int wr, int wc, int fr, int fq) const {
        const int row0 = u.pm * 256 + wr * 64 + fr; const int col0 = (u.pn % nmod) * 256 + wc * 32 + 4 * fq;
        const float winv = ctl ? __uint_as_float(__builtin_amdgcn_readfirstlane((int)ctl[CW_WINV + 16 + u.pn / nmod])) : 1.0f;
#pragma unroll
        for (int ai = 0; ai < 2; ++ai)
#pragma unroll
            for (int m = 0; m < 4; ++m) { const int prow = row0 + ai * 128 + m * 16; const int tok = stok[prow]; if (tok < 0) continue; const float gt = sgate[prow] * scale * winv;
                float* rowp = out + (size_t)tok * D + col0;
#pragma unroll
                for (int bj = 0; bj < 2; ++bj)
#pragma unroll
                    for (int n = 0; n < 2; ++n) { f32x4* p = (f32x4*)(rowp + bj * 128 + n * 16); *p = *p + acc[ai][bj][m][n] * gt; }
                asm volatile("" ::: "memory"); }
    }
};
struct EpiMoeDownStore { static constexpr bool PERM = false, AFTER_DRAIN = false; float* tb; const int* stok; const float* sgate; int nmod, pm0; const unsigned* ctl;
    __device__ __forceinline__ void operator()(const f32x4 (&acc)[2][2][4][2], const Unit& u, int wr, int wc, int fr, int fq) const {
        const int row0 = u.pm * 256 + wr * 64 + fr; const int col0 = (u.pn % nmod) * 256 + wc * 32 + 4 * fq;
#pragma unroll
        for (int ai = 0; ai < 2; ++ai)
#pragma unroll
            for (int m = 0; m < 4; ++m) { const int prow = row0 + ai * 128 + m * 16; const int tok = stok[prow]; if (tok < 0) continue; const float gt = sgate[prow] * __uint_as_float(__builtin_amdgcn_readfirstlane((int)ctl[CW_WINV + 16 + u.pn / nmod]));
                float* rowp = tb + (size_t)(prow - pm0 * 256) * D + col0;
#pragma unroll
                for (int bj = 0; bj < 2; ++bj)
#pragma unroll
                    for (int n = 0; n < 2; ++n) *(f32x4*)(rowp + bj * 128 + n * 16) = acc[ai][bj][m][n] * gt; }
    }
};
struct MoeOrder { static constexpr bool GATHER = false; const int* block_e; const unsigned* npan; int nN, emul, pn_off, G, c, lmax;
    __device__ __forceinline__ bool next(int i, Unit& u) const { const int L = i * G + c; const int np = __builtin_amdgcn_readfirstlane((int)(*npan)); if (L >= np * nN || (lmax && L >= lmax)) return false;
        const int pm = L / nN; u.k0 = 0; u.pm = pm; u.pn = __builtin_amdgcn_readfirstlane(block_e[pm]) * emul + pn_off + (L % nN); return true; }
    __device__ __forceinline__ void a_ready(const Unit&) const {}
    __device__ __forceinline__ void done(const Unit&) const {}
};


struct EpiResidPartial { static constexpr bool PERM = false, AFTER_DRAIN = false; float* part;
    __device__ __forceinline__ void operator()(const f32x4 (&acc)[2][2][4][2], const Unit& u, int wr, int wc, int fr, int fq) const {
        const int rl = wr * 64 + fr, col0 = u.pn * 256 + wc * 32 + 4 * fq; float* base = part + (size_t)(u.k0 >> 8) * NMETA * D;
#pragma unroll
        for (int ai = 0; ai < 2; ++ai)
#pragma unroll
            for (int m = 0; m < 4; ++m) { const int row = rl + ai * 128 + m * 16; if (row >= NMETA) continue;
                float* rowp = base + (size_t)row * D + col0;
#pragma unroll
                for (int bj = 0; bj < 2; ++bj)
#pragma unroll
                    for (int n = 0; n < 2; ++n) *(f32x4*)(rowp + bj * 128 + n * 16) = acc[ai][bj][m][n]; }
    }
};
struct DenseTailOrder { static constexpr bool GATHER = false; int nN, nsl, G, c;
    __device__ __forceinline__ bool next(int i, Unit& u) const { const int idx = i * G + c; if (idx >= nN * nsl) return false; u.pm = 128; u.pn = idx / nsl; u.k0 = (idx % nsl) * 256; return true; }
    __device__ __forceinline__ void a_ready(const Unit&) const {}
    __device__ __forceinline__ void done(const Unit&) const {}
};
template <bool GA> struct MoeGatherOrderT { static constexpr bool GATHER = GA;
    const int* block_e; const unsigned* npan; const int* rows; int nN, emul, pn_off, G, c, zero_row;
    int pm_lo, pm_hi, gap, rot, T, cskip;
    __device__ __forceinline__ bool next(int i, Unit& u) const {
        int cc = c - rot; cc += cc < 0 ? G : 0;
        int L;
        if (T == 0) L = i * G + cc;
        else { const int W0 = G - T; if (cc < W0) L = i < cskip ? i * W0 + cc : cskip * W0 + (i - cskip) * G + cc; else L = cskip * W0 + i * G + cc; }
        int np = __builtin_amdgcn_readfirstlane((int)(*npan)); np = np < pm_hi ? np : pm_hi;
        const int pl = pm_lo + L / nN; if (pl >= np) return false;
        const int pm = pl + (pl >= MOE_TAILPAN ? gap : 0); u.k0 = 0; u.pm = pm; u.pn = __builtin_amdgcn_readfirstlane(block_e[pm]) * emul + pn_off + (L % nN); return true; }
    __device__ __forceinline__ void a_ready(const Unit&) const {}
    __device__ __forceinline__ void done(const Unit&) const {}
};
using MoeGatherOrder = MoeGatherOrderT<true>; using MoeSlotOrder = MoeGatherOrderT<false>;
struct MoeShiftTailOrder { static constexpr bool GATHER = false; const int* block_e; const unsigned* npan; int nN, emul, gap, wg_first, c, pad;
    __device__ __forceinline__ bool next(int i, Unit& u) const { const int t = wg_first - c; const int np = __builtin_amdgcn_readfirstlane((int)(*npan)); const int L = MOE_TAILPAN * nN + t;
        if (i > 0 || t < 0 || L >= np * nN) return false;
        const int pm = L / nN + gap; u.k0 = 0; u.pm = pm; u.pn = __builtin_amdgcn_readfirstlane(block_e[pm]) * emul + (L % nN); return true; }
    __device__ __forceinline__ void a_ready(const Unit&) const {}
    __device__ __forceinline__ void done(const Unit&) const {}
};

__device__ __forceinline__ int map_row(int mode, int n, int rowoff) {
    if (mode == 1) return n < 832 ? n : n + 192;
    if (mode == 2) return rowoff + (n >> 7) * 256 + (n & 127);
    if (mode == 3) return rowoff + (n >> 7) * 256 + 128 + (n & 127);
    if (mode == 4) return (n >> 8) * 128 + (n & 127) + ((n & 128) ? 512 : 0);
    return rowoff + n;
}
__device__ __forceinline__ void transpose_item(const float* __restrict__ W, int K, int N, bf16_t* __restrict__ dst, int ld, int koff, int mode, int rowoff, const float* __restrict__ gain, LAS float* scr, int item, int lane) {
    const int nblk = N / 32; const int kb = item / nblk, nb = item % nblk, k0 = 64 * kb, n0 = 32 * nb;
#pragma unroll 8
    for (int i = 0; i < 32; ++i) { const int kk = 2 * i + (lane >> 5); float v = W[(size_t)(k0 + kk) * N + n0 + (lane & 31)]; if (gain) v *= gain[k0 + kk]; scr[kk * 33 + (lane & 31)] = v; }
    asm volatile("s_waitcnt lgkmcnt(0)" ::: "memory");
    const int c = lane & 7;
#pragma unroll
    for (int j = 0; j < 4; ++j) { const int n = (lane >> 3) + 8 * j; const LAS float* s = scr + (8 * c) * 33 + n;
        u32x4 o; o.x = pk2(s[0 * 33], s[1 * 33]); o.y = pk2(s[2 * 33], s[3 * 33]); o.z = pk2(s[4 * 33], s[5 * 33]); o.w = pk2(s[6 * 33], s[7 * 33]);
        *(u32x4*)(dst + (size_t)map_row(mode, n0 + n, rowoff) * ld + koff + k0 + 8 * c) = o; }
    asm volatile("s_waitcnt lgkmcnt(0)" ::: "memory");
}
__device__ __forceinline__ void transpose_item_f8(const float* __restrict__ W, int K, int N, unsigned char* __restrict__ dst, int ld, int mode, int rowoff, float scale, LAS float* scr, int item, int lane) {
    const int nblk = N / 32; const int kb = item / nblk, nb = item % nblk, k0 = 64 * kb, n0 = 32 * nb;
#pragma unroll 8
    for (int i = 0; i < 32; ++i) { const int kk = 2 * i + (lane >> 5); scr[kk * 33 + (lane & 31)] = W[(size_t)(k0 + kk) * N + n0 + (lane & 31)] * scale; }
    asm volatile("s_waitcnt lgkmcnt(0)" ::: "memory");
    const int c = lane & 7;
#pragma unroll
    for (int j = 0; j < 4; ++j) { const int n = (lane >> 3) + 8 * j; const LAS float* s = scr + (8 * c) * 33 + n;
        u32x2 o; o.x = pk4_f8(s[0 * 33], s[1 * 33], s[2 * 33], s[3 * 33]); o.y = pk4_f8(s[4 * 33], s[5 * 33], s[6 * 33], s[7 * 33]);
        *(u32x2*)(dst + (size_t)map_row(mode, n0 + n, rowoff) * ld + k0 + 8 * c) = o; }
    asm volatile("s_waitcnt lgkmcnt(0)" ::: "memory");
}
struct TrJob8 { const float* W; unsigned char* dst; int K, N, ld, mode, rowoff; float scale; };
__device__ __forceinline__ void ph_transpose_f8(const TrJob8& J, LAS float* scr, int gw, int ngw, int lane) {
    lane = opq(lane);
    const int nitems = (J.K / 64) * (J.N / 32);
    for (int it = gw; it < nitems; it += ngw) transpose_item_f8(J.W, J.K, J.N, J.dst, J.ld, J.mode, J.rowoff, J.scale, scr, it, lane);
}
struct TrJob { const float* W; const float* gain; bf16_t* dst; int K, N, ld, koff, mode, rowoff; };
__device__ __forceinline__ void ph_transpose(const TrJob& J, LAS float* scr, int gw, int ngw, int lane) {
    lane = opq(lane);
    const int nitems = (J.K / 64) * (J.N / 32);
    for (int it = gw; it < nitems; it += ngw) transpose_item(J.W, J.K, J.N, J.dst, J.ld, J.koff, J.mode, J.rowoff, J.gain, scr, it, lane);
}
__device__ __forceinline__ const float* hrow_c(const float* out, const float* hmeta, int row) { return row < RREAL ? out + (size_t)row * D : hmeta + (size_t)(row - RREAL) * D; }
__device__ __forceinline__ void ph_init(const float* __restrict__ x, const float* __restrict__ meta, float* __restrict__ out, float* __restrict__ hmeta, float* __restrict__ rope,
                                        const float* __restrict__ v1, const float* __restrict__ v2, bf16_t* __restrict__ v12t, size_t gt, size_t ngt) {
    (void)x; (void)out;
    for (size_t i = gt; i < (size_t)256 * D; i += ngt) hmeta[i] = i < (size_t)NMETA * D ? meta[i] : 0.f;
    for (size_t i = gt; i < (size_t)4112 * 32; i += ngt) { const int pos = (int)(i / 32), j = (int)(i % 32);
        const float inv = powf(10000.0f, -(float)j / 32.0f); const float ang = (float)pos * inv; rope[2 * i] = cosf(ang); rope[2 * i + 1] = sinf(ang); }
    for (size_t i = gt; i < (size_t)512 * 512; i += ngt) { const int n = (int)(i >> 9), k = (int)(i & 511); float s = 0.f;
#pragma unroll 8
        for (int j = 0; j < 32; ++j) s += v1[k * 32 + j] * v2[j * 512 + n];
        v12t[i] = f2bf(s); }
}
__device__ __forceinline__ void ph_rmsnorm(const float* __restrict__ out, const float* hmeta, const float* __restrict__ g, bf16_t* __restrict__ U, const float* __restrict__ part, int nsl, int gw, int ngw, int lane) {
    lane = opq(lane);
    for (int row = gw; row < RP; row += ngw) {
        unsigned long long* o8 = (unsigned long long*)(U + (size_t)row * D) + lane;
        if (row >= RVALID) {
#pragma unroll
            for (int j = 0; j < 4; ++j) o8[64 * j] = 0ull;
            continue; }
        const f32x4* xr = (const f32x4*)hrow_c(out, hmeta, row) + lane; const f32x4* g4 = (const f32x4*)g + lane;
        f32x4 v[4]; float s = 0.f;
#pragma unroll
        for (int j = 0; j < 4; ++j) v[j] = xr[64 * j];
        if (row >= RREAL && nsl > 0) {
            for (int sl = 0; sl < nsl; ++sl) { const f32x4* pr = (const f32x4*)(part + ((size_t)sl * NMETA + (row - RREAL)) * D) + lane;
#pragma unroll
                for (int j = 0; j < 4; ++j) v[j] = v[j] + pr[64 * j]; }
            f32x4* hw = (f32x4*)xr;
#pragma unroll
            for (int j = 0; j < 4; ++j) hw[64 * j] = v[j]; }
#pragma unroll
        for (int j = 0; j < 4; ++j) s += (v[j].x * v[j].x + v[j].y * v[j].y) + (v[j].z * v[j].z + v[j].w * v[j].w);
        const float rstd = rsqrtf(wave_sum(s) * (1.f / D) + RMS_EPS);
#pragma unroll
        for (int j = 0; j < 4; ++j) { const f32x4 gg = g4[64 * j]; o8[64 * j] = (unsigned long long)pk2(v[j].x * rstd * gg.x, v[j].y * rstd * gg.y) | ((unsigned long long)pk2(v[j].z * rstd * gg.z, v[j].w * rstd * gg.w) << 32); }
    }
}
__device__ __forceinline__ void unpack8(const u32x4 v, float (&f)[8]) {
    f[0] = __uint_as_float(v.x << 16); f[1] = __uint_as_float(v.x & 0xffff0000u); f[2] = __uint_as_float(v.y << 16); f[3] = __uint_as_float(v.y & 0xffff0000u);
    f[4] = __uint_as_float(v.z << 16); f[5] = __uint_as_float(v.z & 0xffff0000u); f[6] = __uint_as_float(v.w << 16); f[7] = __uint_as_float(v.w & 0xffff0000u);
}
__device__ __forceinline__ void ph_prep(const bf16_t* __restrict__ PM, const bf16_t* __restrict__ PR, const float* __restrict__ mu, const float* __restrict__ rope,
                                        float* __restrict__ rstdq, float* __restrict__ rstdkv, bf16_t* __restrict__ KR, bf16_t* __restrict__ LIN, bf16_t* __restrict__ VSH, int do_vsh, int gw, int ngw, int lane) {
    lane = opq(lane);
    for (int row = gw; row < RP; row += ngw) {
        const bf16_t* pm = PM + (size_t)row * PMW;
        float f[8], sq = 0.f, skv = 0.f;
        unpack8(*(const u32x4*)(pm + lane * 8), f);
#pragma unroll
        for (int j = 0; j < 8; ++j) sq += f[j] * f[j];
        if (lane < 32) { unpack8(*(const u32x4*)(pm + 512 + lane * 8), f);
#pragma unroll
            for (int j = 0; j < 8; ++j) skv += f[j] * f[j]; }
        sq = wave_sum(sq); skv = wave_sum(skv);
        if (lane == 0) { rstdq[row] = rsqrtf(sq * (1.f / 512.f) + RMS_EPS); rstdkv[row] = rsqrtf(skv * (1.f / 256.f) + RMS_EPS); }
        const int pos = row_pos(row);
        if (lane < 32) { const float x1 = bf2f(pm[768 + lane]), x2 = bf2f(pm[800 + lane]); const float c = rope[2 * (pos * 32 + lane)], s = rope[2 * (pos * 32 + lane) + 1];
            KR[(size_t)row * 64 + lane] = f2bf(x1 * c - x2 * s); KR[(size_t)row * 64 + 32 + lane] = f2bf(x1 * s + x2 * c); }
        const int pr = row_prev(row); const bool valid = row < RVALID; const float pmk = pr < 0 ? 0.f : 1.f;
        const bf16_t* x = PR + (size_t)row * PRW; const bf16_t* xp = PR + (size_t)(pr < 0 ? row : pr) * PRW;
        if (lane < 32) {
            float a[8], b[8]; unpack8(*(const u32x4*)(x + 1536 + lane * 8), a); unpack8(*(const u32x4*)(xp + 1536 + lane * 8), b);
            const f32x4 m0 = *(const f32x4*)(mu + 1536 + lane * 8), m1 = *(const f32x4*)(mu + 1536 + lane * 8 + 4); const float mm[8] = {m0.x, m0.y, m0.z, m0.w, m1.x, m1.y, m1.z, m1.w};
            float o[8];
#pragma unroll
            for (int j = 0; j < 8; ++j) { float v = a[j] + (pmk * b[j] - a[j]) * mm[j]; v = lane < 8 ? tanhf(v) : (lane < 16 ? v : sigmoidf_(v)); o[j] = valid ? v : 0.f; }
            u32x4 w; w.x = pk2(o[0], o[1]); w.y = pk2(o[2], o[3]); w.z = pk2(o[4], o[5]); w.w = pk2(o[6], o[7]); *(u32x4*)(LIN + (size_t)row * 256 + lane * 8) = w; }
        if (do_vsh) {
            float a[8], b[8]; unpack8(*(const u32x4*)(x + 1024 + lane * 8), a); unpack8(*(const u32x4*)(xp + 1024 + lane * 8), b);
            const f32x4 m0 = *(const f32x4*)(mu + 1024 + lane * 8), m1 = *(const f32x4*)(mu + 1024 + lane * 8 + 4); const float mm[8] = {m0.x, m0.y, m0.z, m0.w, m1.x, m1.y, m1.z, m1.w};
            float o[8];
#pragma unroll
            for (int j = 0; j < 8; ++j) { const float v = a[j] + (pmk * b[j] - a[j]) * mm[j]; o[j] = valid ? v : 0.f; }
            u32x4 w; w.x = pk2(o[0], o[1]); w.y = pk2(o[2], o[3]); w.z = pk2(o[4], o[5]); w.w = pk2(o[6], o[7]); *(u32x4*)(VSH + (size_t)row * 512 + lane * 8) = w; }
    }
}

__device__ __forceinline__ void ph_norm_route(LAS unsigned char* lds, const float* __restrict__ out, const float* __restrict__ g, const float* __restrict__ router, const float* __restrict__ rbias,
                                              bf16_t* __restrict__ U, int* __restrict__ TE, float* __restrict__ TG, int* __restrict__ STOK, unsigned* __restrict__ ctl, int bid, int nblk, int wave, int lane) {
    lane = opq(lane); nblk = opqs(nblk); bid = opqs(bid);
    { constexpr int NFILL = 2 * MOE_MAXPAN * 256 + RREAL; const int per = (NFILL + nblk - 1) / nblk; const int t_ = wave * 64 + lane;
      for (int i = t_; i < per; i += 512) { const int idx = bid * per + i; if (idx < NFILL) STOK[idx] = -1; } }
    const int rpw = (RREAL + nblk - 1) / nblk, rpwave = (rpw + 7) / 8;
    int c1[8], c2[8];
#pragma unroll
    for (int e = 0; e < 8; ++e) { c1[e] = 0; c2[e] = 0; }
    for (int k = 0; k < rpwave; ++k) { const int rl = wave * rpwave + k; const int row = bid * rpw + rl; if (rl >= rpw || row >= RREAL) break;
        const f32x4* xr = (const f32x4*)(out + (size_t)row * D) + lane; const f32x4* g4 = (const f32x4*)g + lane;
        f32x4 v[4]; float s = 0.f;
#pragma unroll
        for (int j = 0; j < 4; ++j) { v[j] = xr[64 * j]; s += (v[j].x * v[j].x + v[j].y * v[j].y) + (v[j].z * v[j].z + v[j].w * v[j].w); }
        const float rstd = rsqrtf(wave_sum(s) * (1.f / D) + RMS_EPS);
        unsigned* o4 = (unsigned*)((unsigned char*)U + (size_t)row * D) + lane;
        float lg[8];
#pragma unroll
        for (int e = 0; e < 8; ++e) lg[e] = 0.f;
#pragma unroll
        for (int j = 0; j < 4; ++j) { const f32x4 gg = g4[64 * j]; f32x4 xn; xn.x = v[j].x * rstd * gg.x; xn.y = v[j].y * rstd * gg.y; xn.z = v[j].z * rstd * gg.z; xn.w = v[j].w * rstd * gg.w;
            o4[64 * j] = pk4_f8(xn.x * F8_ACT, xn.y * F8_ACT, xn.z * F8_ACT, xn.w * F8_ACT);
            const int d0 = 4 * (lane + 64 * j);
#pragma unroll
            for (int q = 0; q < 4; ++q) { const f32x4 ra = *(const f32x4*)(router + (size_t)(d0 + q) * 8), rb = *(const f32x4*)(router + (size_t)(d0 + q) * 8 + 4); const float xv = xn[q];
                lg[0] += xv * ra.x; lg[1] += xv * ra.y; lg[2] += xv * ra.z; lg[3] += xv * ra.w; lg[4] += xv * rb.x; lg[5] += xv * rb.y; lg[6] += xv * rb.z; lg[7] += xv * rb.w; }
            asm volatile("" ::: "memory"); }
#pragma unroll
        for (int e = 0; e < 8; ++e) { float t_ = wave_sum(lg[e]); asm volatile("" : "+v"(t_)); lg[e] = t_ + rbias[e]; }
        int e1 = 0; float l1 = lg[0];
#pragma unroll
        for (int e = 1; e < 8; ++e) if (lg[e] > l1) { l1 = lg[e]; e1 = e; }
        int e2 = e1 == 0 ? 1 : 0; float l2 = -INFINITY;
#pragma unroll
        for (int e = 0; e < 8; ++e) if (e != e1 && lg[e] > l2) { l2 = lg[e]; e2 = e; }
        const float g1 = 1.0f / (1.0f + __expf(l2 - l1)), g2 = 1.0f - g1;
        { const int e1v = e1, e2v = e2;
#pragma unroll
        for (int e = 0; e < 8; ++e) { c1[e] += (e1v == e) ? 1 : 0; c2[e] += (e2v == e) ? 1 : 0; } }
        if (lane == 0) { TE[row] = e1; TE[RREAL + row] = e2; TG[row] = g1; TG[RREAL + row] = g2; }
    }
    LAS int* wc = (LAS int*)(lds + 80000);
    if (lane == 0) {
#pragma unroll
        for (int e = 0; e < 8; ++e) { wc[wave * 16 + e] = c1[e]; wc[wave * 16 + 8 + e] = c2[e]; } }
    __syncthreads();
    const int t = wave * 64 + lane;
    if (t < 16) { int sum = 0;
#pragma unroll
        for (int ww = 0; ww < 8; ++ww) sum += wc[ww * 16 + t];
        ctl[CW_WGCNT + bid * 16 + t] = (unsigned)sum; }
}
__device__ __forceinline__ void ph_moe_assign(LAS unsigned char* lds, int list, const int* __restrict__ TE, const float* __restrict__ TG, int* __restrict__ STOK, float* __restrict__ SGATE, int* __restrict__ BE, unsigned* __restrict__ ctl,
                                              const unsigned char* __restrict__ U8, unsigned char* __restrict__ XB, int bid, int nblk, int tid) {
    LAS int* sh = (LAS int*)lds;
    __syncthreads();
    if (tid < 8) { int tot = 0, pre = 0;
        for (int b = 0; b < nblk; ++b) { const int v = (int)ctl[CW_WGCNT + b * 16 + 8 * list + tid]; tot += v; pre += b < bid ? v : 0; }
        sh[tid] = tot; sh[8 + tid] = pre; }
    __syncthreads();
    if (tid == 0) { int pan = 0;
        for (int e = 0; e < 8; ++e) { const int np = (sh[e] + 255) >> 8; sh[16 + e] = pan << 8;
            if (bid == 0) for (int q = 0; q < np; ++q) { const int pi = pan + q; BE[256 * list + pi + (list == 1 && pi >= MOE_TAILPAN ? MOE_GAP : 0)] = e; }
            pan += np; }
        if (bid == 0) ctl[CW_NPAN + list] = (unsigned)pan; }
    __syncthreads();
    if (tid < 64) {
        const int rpw = (RREAL + nblk - 1) / nblk; int run[8];
#pragma unroll
        for (int q = 0; q < 8; ++q) run[q] = 0;
        for (int r0 = 0; r0 < rpw; r0 += 64) { const int rl = r0 + tid, row = bid * rpw + rl; const bool ok = rl < rpw && row < RREAL;
            const int ee = ok ? TE[list * RREAL + row] : -1; int slot = -1;
#pragma unroll
            for (int e = 0; e < 8; ++e) { const unsigned long long m = __builtin_amdgcn_ballot_w64(ee == e);
                const int rank = (int)__builtin_amdgcn_mbcnt_hi((unsigned)(m >> 32), __builtin_amdgcn_mbcnt_lo((unsigned)m, 0u));
                if (ee == e) { slot = sh[16 + e] + sh[8 + e] + run[e] + rank; if (list == 1 && slot >= MOE_TAILPAN * 256) slot += MOE_GAP * 256; }
                run[e] += __builtin_popcountll(m); }
            if (rl < rpw) sh[32 + rl] = ok ? slot : -1;
            if (ok) { STOK[list * (MOE_MAXPAN * 256) + slot] = row; SGATE[list * (MOE_MAXPAN * 256) + slot] = TG[list * RREAL + row];
                if (list == 1 && slot >= (MOE_TAILPAN + MOE_GAP) * 256) STOK[2 * MOE_MAXPAN * 256 + row] = slot - (MOE_TAILPAN + MOE_GAP) * 256; } }
    }
    __syncthreads();
    {
        const int rpw = (RREAL + nblk - 1) / nblk, w = tid >> 6, ln = tid & 63; unsigned char* xl = XB + (size_t)list * (MOE_MAXPAN * 256) * 1024;
        for (int rl = w; rl < rpw; rl += 8) { const int slot = sh[32 + rl]; if (slot >= 0) ((u32x4*)(xl + (size_t)slot * 1024))[ln] = ((const u32x4*)(U8 + (size_t)(bid * rpw + rl) * 1024))[ln]; }
        if (bid < 8) { const int e = bid, lo = sh[16 + e] + sh[e], hi = sh[16 + e] + (((sh[e] + 255) >> 8) << 8); unsigned z0 = 0u; asm volatile("" : "+v"(z0)); u32x4 z; z.x = z.y = z.z = z.w = z0;
            for (int p0 = lo + w; p0 < hi; p0 += 8) { const int slot = p0 + ((list == 1 && p0 >= MOE_TAILPAN * 256) ? MOE_GAP * 256 : 0); ((u32x4*)(xl + (size_t)slot * 1024))[ln] = z; } }
    }
}
__device__ __forceinline__ void ph_final(float* __restrict__ out, const float* __restrict__ g, const int* __restrict__ tslot, const float* __restrict__ tb, int gw, int ngw, int lane, float pscale = 1.0f) {
    lane = opq(lane);
    for (int row = gw; row < RREAL; row += ngw) {
        f32x4* xr = (f32x4*)(out + (size_t)row * D) + lane; const f32x4* g4 = (const f32x4*)g + lane;
        const int ts = __builtin_amdgcn_readfirstlane(tslot[row]);
        f32x4 v[4]; float s = 0.f;
#pragma unroll
        for (int j = 0; j < 4; ++j) v[j] = xr[64 * j];
        if (ts >= 0) { const f32x4* tr = (const f32x4*)(tb + (size_t)ts * D) + lane;
#pragma unroll
            for (int j = 0; j < 4; ++j) v[j] = v[j] + tr[64 * j]; }
#pragma unroll
        for (int j = 0; j < 4; ++j) s += (v[j].x * v[j].x + v[j].y * v[j].y) + (v[j].z * v[j].z + v[j].w * v[j].w);
        const float rstd = rsqrtf(wave_sum(s) * (1.f / D) + RMS_EPS);
#pragma unroll
        for (int j = 0; j < 4; ++j) { const f32x4 gg = g4[64 * j]; f32x4 o; o.x = v[j].x * rstd * gg.x * pscale; o.y = v[j].y * rstd * gg.y * pscale; o.z = v[j].z * rstd * gg.z * pscale; o.w = v[j].w * rstd * gg.w * pscale; xr[64 * j] = o; }
    }
}

constexpr int KS_STRIDE = 200, VS_STRIDE = 72;
constexpr int ATT_LDS = 64 * KS_STRIDE * 2 + 128 * VS_STRIDE * 2;
__device__ __forceinline__ bf16x8 pack8(const f32x16& x, int s) {
    u32x4 p;
    if (s == 0) { p.x = cvtpk(x[0], x[1]); p.y = cvtpk(x[2], x[3]); p.z = cvtpk(x[4], x[5]); p.w = cvtpk(x[6], x[7]); }
    else { p.x = cvtpk(x[8], x[9]); p.y = cvtpk(x[10], x[11]); p.z = cvtpk(x[12], x[13]); p.w = cvtpk(x[14], x[15]); }
    return __builtin_bit_cast(bf16x8, p);
}
__device__ __forceinline__ void attn_unit(LAS unsigned char* lds, const bf16_t* __restrict__ Q, const bf16_t* __restrict__ KN, const bf16_t* __restrict__ KR, const bf16_t* __restrict__ VT,
                                          bf16_t* __restrict__ MIX, const float* __restrict__ rope, int h, int qrow0, int kbase, int ntile, int wlim, bool wave_active) {
    const int tid = opq(threadIdx.x), lane = tid & 63, w = tid >> 6, r = lane & 31, hh = lane >> 5;
    LAS bf16_t* Ks = (LAS bf16_t*)lds; LAS bf16_t* Vs = (LAS bf16_t*)(lds + 64 * KS_STRIDE * 2);
    const int qrow = qrow0 + 32 * w + r;
    bf16x8 qf[12];
#pragma unroll
    for (int ks = 0; ks < 12; ++ks) qf[ks] = *(const GAS bf16x8*)(Q + (size_t)qrow * 768 + 192 * h + 16 * ks + 8 * hh);
    {
        const int pos = row_pos(qrow); const GAS float* rt = (const GAS float*)(rope + (size_t)pos * 64);
#pragma unroll
        for (int half = 0; half < 2; ++half) { const GAS float* cs = rt + 2 * (16 * half + 8 * hh);
#pragma unroll
            for (int j = 0; j < 8; ++j) { const float c = cs[2 * j], sn = cs[2 * j + 1]; const float x1 = bf2f((bf16_t)qf[8 + half][j]), x2 = bf2f((bf16_t)qf[10 + half][j]);
                qf[8 + half][j] = (short)f2bf(x1 * c - x2 * sn); qf[10 + half][j] = (short)f2bf(x1 * sn + x2 * c); } }
    }
    float z0 = 0.f; asm volatile("" : "+v"(z0));
    f32x16 oacc[4];
#pragma unroll
    for (int i = 0; i < 4; ++i)
#pragma unroll
        for (int j = 0; j < 16; ++j) oacc[i][j] = z0;
    float mrun = -INFINITY, lsum = 0.f;
    const float sc = 0.07216878364870322f * 1.4426950408889634f;
    u32x4 kreg[3], vreg[2];
    const unsigned kn_off0 = (unsigned)(((tid >> 4) * 512 + h * 128 + (tid & 15) * 8) * 2), kn_off1 = kn_off0 + 32u * 512u * 2u;
    const unsigned kr_off = (unsigned)(((tid >> 3) * 64 + (tid & 7) * 8) * 2);
    const unsigned vt_off0 = (unsigned)((((size_t)(h * 128 + (tid >> 3))) * RP + (tid & 7) * 8) * 2), vt_off1 = vt_off0 + 64u * (unsigned)RP * 2u;
#define ATT_GLOAD(tt_) do { const int krow0_ = (tt_) == 0 ? RREAL : kbase + 64 * ((tt_) - 1); \
    const char* knb_ = (const char*)KN + (size_t)krow0_ * 1024; const char* krb_ = (const char*)KR + (size_t)krow0_ * 128; const char* vtb_ = (const char*)VT + (size_t)krow0_ * 2; \
    kreg[0] = *(const GAS u32x4*)(knb_ + kn_off0); kreg[1] = *(const GAS u32x4*)(knb_ + kn_off1); kreg[2] = *(const GAS u32x4*)(krb_ + kr_off); \
    vreg[0] = *(const GAS u32x4*)(vtb_ + vt_off0); vreg[1] = *(const GAS u32x4*)(vtb_ + vt_off1); } while (0)
    ATT_GLOAD(0);
    for (int tt = 0; tt < ntile; ++tt) {
#ifdef PROBE_ATT_STAGE2
        __syncthreads();
        *(LAS u32x4*)(Ks + (tid >> 4) * KS_STRIDE + (tid & 15) * 8) = kreg[0]; *(LAS u32x4*)(Ks + (32 + (tid >> 4)) * KS_STRIDE + (tid & 15) * 8) = kreg[1];
        *(LAS u32x4*)(Ks + (tid >> 3) * KS_STRIDE + 128 + (tid & 7) * 8) = kreg[2];
#pragma unroll
        for (int i = 0; i < 2; ++i) {
            LAS u32x2* d = (LAS u32x2*)(Vs + ((tid >> 3) + 64 * i) * VS_STRIDE + ((tid & 7) >> 1) * 16 + (tid & 1) * 4);
            u32x2 lo; lo.x = vreg[i].x; lo.y = vreg[i].y; u32x2 hi; hi.x = vreg[i].z; hi.y = vreg[i].w; d[0] = lo; d[2] = hi; }
        __syncthreads();
#endif
        __syncthreads();
        *(LAS u32x4*)(Ks + (tid >> 4) * KS_STRIDE + (tid & 15) * 8) = kreg[0]; *(LAS u32x4*)(Ks + (32 + (tid >> 4)) * KS_STRIDE + (tid & 15) * 8) = kreg[1];
        *(LAS u32x4*)(Ks + (tid >> 3) * KS_STRIDE + 128 + (tid & 7) * 8) = kreg[2];
#pragma unroll
        for (int i = 0; i < 2; ++i) {
            LAS u32x2* d = (LAS u32x2*)(Vs + ((tid >> 3) + 64 * i) * VS_STRIDE + ((tid & 7) >> 1) * 16 + (tid & 1) * 4);
            u32x2 lo; lo.x = vreg[i].x; lo.y = vreg[i].y; u32x2 hi; hi.x = vreg[i].z; hi.y = vreg[i].w; d[0] = lo; d[2] = hi; }
        __syncthreads();
        const bool comp = wave_active && tt <= wlim;
        if (tt + 1 < ntile) ATT_GLOAD(tt + 1);
        if (comp) {
            f32x16 sacc[2];
#pragma unroll
            for (int b = 0; b < 2; ++b)
#pragma unroll
                for (int j = 0; j < 16; ++j) sacc[b][j] = z0;
#ifdef PROBE_ATT_QK2
            {
            __builtin_amdgcn_sched_barrier(0);
            {
                const LAS bf16_t* kb0 = Ks + r * KS_STRIDE + 8 * hh;
                bf16x8 kf[6];
#pragma unroll
                for (int i = 0; i < 6; ++i) kf[i] = *(const LAS bf16x8*)(kb0 + 16 * i);
#pragma unroll
                for (int i = 0; i < 24; ++i) { sacc[i / 12] = __builtin_amdgcn_mfma_f32_32x32x16_bf16(kf[i % 6], qf[i % 12], sacc[i / 12], 0, 0, 0);
                    if (i + 6 < 24) kf[i % 6] = *(const LAS bf16x8*)(kb0 + ((i + 6) / 12) * 32 * KS_STRIDE + 16 * ((i + 6) % 12)); }
                __builtin_amdgcn_sched_group_barrier(0x100, 6, 0);
#pragma unroll
                for (int i = 0; i < 18; ++i) { __builtin_amdgcn_sched_group_barrier(0x008, 1, 0); __builtin_amdgcn_sched_group_barrier(0x100, 1, 0); }
                __builtin_amdgcn_sched_group_barrier(0x008, 6, 0);
            }
            __builtin_amdgcn_sched_barrier(0);
                asm volatile("" : "+v"(sacc[0][0]), "+v"(sacc[1][0]));
#pragma unroll
                for (int b = 0; b < 2; ++b)
#pragma unroll
                    for (int j = 0; j < 16; ++j) sacc[b][j] = z0;
            }
#endif
            __builtin_amdgcn_sched_barrier(0);
            {
                const LAS bf16_t* kb0 = Ks + r * KS_STRIDE + 8 * hh;
                bf16x8 kf[6];
#pragma unroll
                for (int i = 0; i < 6; ++i) kf[i] = *(const LAS bf16x8*)(kb0 + 16 * i);
#pragma unroll
                for (int i = 0; i < 24; ++i) { sacc[i / 12] = __builtin_amdgcn_mfma_f32_32x32x16_bf16(kf[i % 6], qf[i % 12], sacc[i / 12], 0, 0, 0);
                    if (i + 6 < 24) kf[i % 6] = *(const LAS bf16x8*)(kb0 + ((i + 6) / 12) * 32 * KS_STRIDE + 16 * ((i + 6) % 12)); }
                __builtin_amdgcn_sched_group_barrier(0x100, 6, 0);
#pragma unroll
                for (int i = 0; i < 18; ++i) { __builtin_amdgcn_sched_group_barrier(0x008, 1, 0); __builtin_amdgcn_sched_group_barrier(0x100, 1, 0); }
                __builtin_amdgcn_sched_group_barrier(0x008, 6, 0);
            }
            __builtin_amdgcn_sched_barrier(0);
            if (tt == 0) {
#pragma unroll
                for (int j = 8; j < 16; ++j) sacc[0][j] = -INFINITY;
#pragma unroll
                for (int j = 0; j < 16; ++j) sacc[1][j] = -INFINITY; }
            float tmax = fmaxf(sacc[0][0], sacc[1][0]);
#pragma unroll
            for (int j = 1; j < 16; ++j) tmax = fmaxf(tmax, fmaxf(sacc[0][j], sacc[1][j]));
            tmax = fmaxf(tmax, __int_as_float(__builtin_amdgcn_ds_bpermute((lane ^ 32) << 2, __float_as_int(tmax)))) * sc;
            const float mnew = fmaxf(mrun, tmax); const float alpha = __builtin_amdgcn_exp2f(mrun - mnew); mrun = mnew;
            float psum = 0.f;
#pragma unroll
            for (int b = 0; b < 2; ++b)
#pragma unroll
                for (int j = 0; j < 16; ++j) { const float p = __builtin_amdgcn_exp2f(__builtin_fmaf(sacc[b][j], sc, -mnew)); sacc[b][j] = p; psum += p; }
            lsum = lsum * alpha + psum;
            if (__builtin_amdgcn_ballot_w64(alpha != 1.0f) != 0ull) {
#pragma unroll
            for (int i = 0; i < 4; ++i)
#pragma unroll
                for (int j = 0; j < 16; ++j) oacc[i][j] *= alpha; }
            bf16x8 pf[4];
            pf[0] = pack8(sacc[0], 0); pf[1] = pack8(sacc[0], 1); pf[2] = pack8(sacc[1], 0); pf[3] = pack8(sacc[1], 1);
#ifdef PROBE_ATT_PV2
            {
                const LAS bf16_t* vb0 = Vs + r * VS_STRIDE + 8 * hh;
#pragma unroll
                for (int j = 0; j < 16; ++j) { sacc[0][j] = z0; sacc[1][j] = z0; }
#pragma unroll
                for (int i = 0; i < 16; ++i) { const bf16x8 vfd = *(const LAS bf16x8*)(vb0 + 32 * (i >> 2) * VS_STRIDE + 16 * (i & 3));
                    sacc[i & 1] = __builtin_amdgcn_mfma_f32_32x32x16_bf16(vfd, pf[i & 3], sacc[i & 1], 0, 0, 0); }
                asm volatile("" :: "v"(sacc[0][0]), "v"(sacc[1][0]));
            }
#endif
            __builtin_amdgcn_sched_barrier(0);
            {
                const LAS bf16_t* vb0 = Vs + r * VS_STRIDE + 8 * hh;
                bf16x8 vf[16];
#pragma unroll
                for (int i = 0; i < 16; ++i) vf[i] = *(const LAS bf16x8*)(vb0 + 32 * (i >> 2) * VS_STRIDE + 16 * (i & 3));
#pragma unroll
                for (int i = 0; i < 16; ++i) oacc[i >> 2] = __builtin_amdgcn_mfma_f32_32x32x16_bf16(vf[i], pf[i & 3], oacc[i >> 2], 0, 0, 0);
                __builtin_amdgcn_sched_group_barrier(0x100, 8, 1);
#pragma unroll
                for (int i = 0; i < 8; ++i) { __builtin_amdgcn_sched_group_barrier(0x008, 1, 1); __builtin_amdgcn_sched_group_barrier(0x100, 1, 1); }
                __builtin_amdgcn_sched_group_barrier(0x008, 8, 1);
            }
            __builtin_amdgcn_sched_barrier(0);
        }
    }
    if (wave_active) {
        const float ltot = lsum + __int_as_float(__builtin_amdgcn_ds_bpermute((lane ^ 32) << 2, __float_as_int(lsum))); const float inv = 1.0f / ltot;
        bf16_t* orow = MIX + (size_t)qrow * D + 128 * h;
#pragma unroll
        for (int dvb = 0; dvb < 4; ++dvb)
#pragma unroll
            for (int g = 0; g < 4; ++g) { u32x2 o; o.x = cvtpk(oacc[dvb][4 * g] * inv, oacc[dvb][4 * g + 1] * inv); o.y = cvtpk(oacc[dvb][4 * g + 2] * inv, oacc[dvb][4 * g + 3] * inv);
                *(GAS u32x2*)(orow + 32 * dvb + 8 * g + 4 * hh) = o; }
    }
    __syncthreads();
}
__device__ __forceinline__ void attn_phase(LAS unsigned char* lds, const bf16_t* Q, const bf16_t* KN, const bf16_t* KR, const bf16_t* VT, bf16_t* MIX, const float* rope, int bid, int nblk) {
    const int w = opq(threadIdx.x) >> 6;
    for (int s = bid; s < 512; s += nblk) {
        const int round = s >> 8, x = s & 255; const int bh = (x >> 4) + 16 * round, qb = round ? 15 - (x & 15) : (x & 15);
        const int b = bh >> 2, h = bh & 3;
        attn_unit(lds, Q, KN, KR, VT, MIX, rope, h, b * SEQ + 256 * qb, b * SEQ, 4 * qb + 5, 4 * qb + (w >> 1) + 1, true);
    }
    for (int s = bid; s < 4; s += nblk)
        attn_unit(lds, Q, KN, KR, VT, MIX, rope, s, RREAL, 0, 1, 0, w == 0);
}

constexpr int CLS = 72;
constexpr int CSLOT = 64 * CLS * 2;
constexpr int CHK_BYTES = 32768;
constexpr int NSEQ_HALF0 = 257;
struct CpP { const bf16_t* PR; const bf16_t* LO; const bf16_t* VMIX; const bf16_t* VFIRST; bf16_t* VP; float* RK; unsigned char* CHK;
    const float *mu, *w0, *a0, *k_k, *k_a, *r_k, *v0; int layer, pad; };

__device__ __forceinline__ void mm64(f32x16& acc, const LAS bf16_t* a, const LAS bf16_t* b, int r, int hh) {
    bf16x8 af[4], bf[4];
#pragma unroll
    for (int ks = 0; ks < 4; ++ks) { af[ks] = *(const LAS bf16x8*)(a + r * CLS + 16 * ks + 8 * hh); bf[ks] = *(const LAS bf16x8*)(b + r * CLS + 16 * ks + 8 * hh); }
#pragma unroll
    for (int ks = 0; ks < 4; ++ks) acc = __builtin_amdgcn_mfma_f32_32x32x16_bf16(af[ks], bf[ks], acc, 0, 0, 0);
}
__device__ __forceinline__ void st_tile(const f32x16& acc, LAS bf16_t* dst, int m0, int n0, int r, int hh) {
#pragma unroll
    for (int q = 0; q < 16; ++q) dst[(m0 + (q & 3) + 8 * (q >> 2) + 4 * hh) * CLS + n0 + r] = f2bf_hw(acc[q]);
}
__device__ __forceinline__ void st_tile_t(const f32x16& acc, LAS bf16_t* dst, int m0, int n0, int r, int hh) {
#pragma unroll
    for (int g = 0; g < 4; ++g) { u32x2 o; o.x = cvtpk(acc[4 * g], acc[4 * g + 1]); o.y = cvtpk(acc[4 * g + 2], acc[4 * g + 3]);
        *(LAS u32x2*)(dst + (n0 + r) * CLS + m0 + 8 * g + 4 * hh) = o; }
}
__device__ __forceinline__ void zero16(f32x16& a, float z) {
#pragma unroll
    for (int q = 0; q < 16; ++q) a[q] = z;
}
typedef float f32x2 __attribute__((ext_vector_type(2)));
struct CpRaw { unsigned xr[5], xk[5], xv[5], lw[4], la[4], vm[4], vf[4]; f32x2 mu_r, mu_k, mu_v, w0, a0, kkc, kac, rkc, v0; float pm0; };
__device__ __forceinline__ void cp_issue(const CpP& P, int row0, int hd, int w, int lane, CpRaw& R) {
    const int cp = lane & 31, rh = lane >> 5, c = hd * 64 + 2 * cp;
    R.mu_r = *(const GAS f32x2*)(P.mu + c); R.mu_k = *(const GAS f32x2*)(P.mu + 512 + c); R.mu_v = *(const GAS f32x2*)(P.mu + 1024 + c); R.w0 = *(const GAS f32x2*)(P.w0 + c); R.a0 = *(const GAS f32x2*)(P.a0 + c);
    R.kkc = *(const GAS f32x2*)(P.k_k + c); R.kac = *(const GAS f32x2*)(P.k_a + c); R.rkc = *(const GAS f32x2*)(P.r_k + c);
    if (P.layer) R.v0 = *(const GAS f32x2*)(P.v0 + c); else { R.v0.x = 0.f; R.v0.y = 0.f; }
    const int rw0 = row0 + 8 * w + 4 * rh; const int prow0 = (w == 0 && rh == 0) ? row_prev(row0) : rw0 - 1; R.pm0 = prow0 < 0 ? 0.f : 1.f;
    { const bf16_t* xp = P.PR + (size_t)(prow0 < 0 ? rw0 : prow0) * PRW + c; R.xr[0] = *(const GAS unsigned*)xp; R.xk[0] = *(const GAS unsigned*)(xp + 512); R.xv[0] = *(const GAS unsigned*)(xp + 1024); }
#pragma unroll
    for (int q = 0; q < 4; ++q) { const bf16_t* x = P.PR + (size_t)(rw0 + q) * PRW + c; R.xr[q + 1] = *(const GAS unsigned*)x; R.xk[q + 1] = *(const GAS unsigned*)(x + 512); R.xv[q + 1] = *(const GAS unsigned*)(x + 1024);
        const bf16_t* lo = P.LO + (size_t)(rw0 + q) * 1536 + c; R.lw[q] = *(const GAS unsigned*)lo; R.la[q] = *(const GAS unsigned*)(lo + 512);
        if (P.layer) { R.vm[q] = *(const GAS unsigned*)(P.VMIX + (size_t)(rw0 + q) * 512 + c); R.vf[q] = *(const GAS unsigned*)(P.VFIRST + (size_t)(rw0 + q) * 512 + c); } else { R.vm[q] = 0u; R.vf[q] = 0u; } }
}
__device__ __forceinline__ float bfl(unsigned u) { return __uint_as_float(u << 16); }
__device__ __forceinline__ float bfh(unsigned u) { return __uint_as_float(u & 0xffff0000u); }
__device__ __forceinline__ float half_tot(float v) {
    v += DPP_F(v, 0xB1, 0xf); v += DPP_F(v, 0x4E, 0xf); v += DPP_F(v, 0x141, 0xf); v += DPP_F(v, 0x140, 0xf); v += DPP_F(v, 0x142, 0xa); return v; }
__device__ __forceinline__ void rwkv_cp_task(LAS unsigned char* lds, const CpP& P, int row0, int hd, unsigned char* out, CpRaw& R, bool has_next, int nrow0, int nhd) {
    const int tid = opq(threadIdx.x), lane = tid & 63, w = __builtin_amdgcn_readfirstlane(tid >> 6), r = lane & 31, hh = lane >> 5;
    float z0 = 0.f; asm volatile("" : "+v"(z0));
    LAS bf16_t* S_ATtm = (LAS bf16_t*)(lds + 0 * CSLOT);
    LAS bf16_t* S_BHtm = (LAS bf16_t*)(lds + 1 * CSLOT);
    LAS bf16_t* S_KHtm = (LAS bf16_t*)(lds + 2 * CSLOT);
    LAS bf16_t* S_RTtm = (LAS bf16_t*)(lds + 3 * CSLOT);
    LAS bf16_t* S_ATcm = (LAS bf16_t*)(lds + 4 * CSLOT);
    LAS bf16_t* S_BBcm = (LAS bf16_t*)(lds + 5 * CSLOT);
    LAS bf16_t* S_KBcm = (LAS bf16_t*)(lds + 6 * CSLOT);
    LAS bf16_t* S_VTcm = (LAS bf16_t*)(lds + 7 * CSLOT);
    LAS bf16_t* S_Q0a = (LAS bf16_t*)(lds + 8 * CSLOT);
    LAS bf16_t* S_Q0b = (LAS bf16_t*)(lds + 9 * CSLOT);
    LAS bf16_t* S_PP0 = (LAS bf16_t*)(lds + 10 * CSLOT);
    LAS bf16_t* S_Na = (LAS bf16_t*)(lds + 11 * CSLOT);
    LAS bf16_t* S_XT = (LAS bf16_t*)(lds + 12 * CSLOT);
    LAS bf16_t* S_Pa = (LAS bf16_t*)(lds + 13 * CSLOT);
    LAS bf16_t* S_Qa = (LAS bf16_t*)(lds + 14 * CSLOT);
    LAS float* S_TOT = (LAS float*)(lds + 15 * CSLOT);
    LAS bf16_t* Qa[2] = {S_Q0a, S_ATtm}; LAS bf16_t* Qb[2] = {S_Q0b, S_BHtm}; LAS bf16_t* PPa[2] = {S_PP0, S_KHtm};

    {
        const int cp = lane & 31, rh = lane >> 5, c = hd * 64 + 2 * cp;
        const f32x2 mu_r = R.mu_r, mu_k = R.mu_k, mu_v = R.mu_v, w0 = R.w0, a0 = R.a0, kkc = R.kkc, kac = R.kac, rkc = R.rkc, v0 = R.v0; const float pm0 = R.pm0;
        float fr[4][2], fk[4][2], fv[4][2], fa[4][2], fb[4][2], lw[4][2];
        const int rw0 = row0 + 8 * w + 4 * rh;
        constexpr float L2E = 1.4426950408889634f;
#pragma unroll
        for (int q = 0; q < 4; ++q) { const int row = rw0 + q; const bool valid = row < RVALID; const float pm = q == 0 ? pm0 : 1.f;
            float rr[2] = {bfl(R.xr[q + 1]), bfh(R.xr[q + 1])}, kk[2] = {bfl(R.xk[q + 1]), bfh(R.xk[q + 1])}, vv[2] = {bfl(R.xv[q + 1]), bfh(R.xv[q + 1])};
            const float pr[2] = {bfl(R.xr[q]), bfh(R.xr[q])}, pk[2] = {bfl(R.xk[q]), bfh(R.xk[q])}, pv[2] = {bfl(R.xv[q]), bfh(R.xv[q])};
            const float wpre[2] = {bfl(R.lw[q]), bfh(R.lw[q])}, apre[2] = {bfl(R.la[q]), bfh(R.la[q])};
            float lwv[2], asig[2], kkr[2], k2[2], kn[2];
#pragma unroll
            for (int e = 0; e < 2; ++e) {
                rr[e] = rr[e] + (pm * pr[e] - rr[e]) * mu_r[e]; kk[e] = kk[e] + (pm * pk[e] - kk[e]) * mu_k[e]; vv[e] = vv[e] + (pm * pv[e] - vv[e]) * mu_v[e];
                lwv[e] = -0.6065306597126334f * __builtin_amdgcn_rcpf(1.0f + __builtin_amdgcn_exp2f(-(w0[e] + wpre[e]) * L2E));
                asig[e] = __builtin_amdgcn_rcpf(1.0f + __builtin_amdgcn_exp2f(-(a0[e] + apre[e]) * L2E));
                kkr[e] = kk[e] * kkc[e]; k2[e] = kk[e] * (1.f + (asig[e] - 1.f) * kac[e]); }
            if (P.layer) { const float vm[2] = {bfl(R.vm[q]), bfh(R.vm[q])}, vf[2] = {bfl(R.vf[q]), bfh(R.vf[q])};
#pragma unroll
                for (int e = 0; e < 2; ++e) vv[e] = vv[e] + (vf[e] - vv[e]) * __builtin_amdgcn_rcpf(1.0f + __builtin_amdgcn_exp2f(-(v0[e] + vm[e]) * L2E)); }
            const float sst = half_tot(kkr[0] * kkr[0] + kkr[1] * kkr[1]);
            const float rkt = half_tot(rr[0] * k2[0] * rkc[0] + rr[1] * k2[1] * rkc[1]);
            const float ss0 = __int_as_float(__builtin_amdgcn_readlane(__float_as_int(sst), 31)), ss1 = __int_as_float(__builtin_amdgcn_readlane(__float_as_int(sst), 63));
            const float rs = rsqrtf(fmaxf(rh ? ss1 : ss0, 1e-24f));
            kn[0] = kkr[0] * rs; kn[1] = kkr[1] * rs;
            if (!valid) {
#pragma unroll
                for (int e = 0; e < 2; ++e) { rr[e] = 0.f; k2[e] = 0.f; vv[e] = 0.f; kn[e] = 0.f; lwv[e] = 0.f; } }
            *(GAS unsigned*)(P.VP + (size_t)row * 512 + c) = cvtpk(vv[0], vv[1]); if (cp == 31) ((GAS float*)P.RK)[(size_t)row * 8 + hd] = valid ? rkt : 0.f;
#pragma unroll
            for (int e = 0; e < 2; ++e) { fr[q][e] = rr[e]; fk[q][e] = k2[e]; fv[q][e] = vv[e]; fa[q][e] = -kn[e]; fb[q][e] = kn[e] * asig[e]; lw[q][e] = lwv[e]; } }
        if (has_next) cp_issue(P, nrow0, nhd, w, lane, R);
        float cum[4][2], hoff[2];
#pragma unroll
        for (int e = 0; e < 2; ++e) { cum[0][e] = lw[0][e];
#pragma unroll
            for (int q = 1; q < 4; ++q) cum[q][e] = cum[q - 1][e] + lw[q][e];
            const float pt = __int_as_float(__builtin_amdgcn_ds_bpermute((lane ^ 32) << 2, __float_as_int(cum[3][e]))); hoff[e] = rh ? pt : 0.f; }
        if (rh) { f32x2 t2; t2.x = hoff[0] + cum[3][0]; t2.y = hoff[1] + cum[3][1]; *(LAS f32x2*)(S_TOT + w * 64 + 2 * cp) = t2; }
        lds_barrier();
        float off[2] = {0.f, 0.f}, tot[2] = {0.f, 0.f};
#pragma unroll
        for (int ww = 0; ww < 8; ++ww) { const f32x2 tv = *(const LAS f32x2*)(S_TOT + ww * 64 + 2 * cp); off[0] += ww < w ? tv.x : 0.f; off[1] += ww < w ? tv.y : 0.f; tot[0] += tv.x; tot[1] += tv.y; }
        const float etot[2] = {__builtin_amdgcn_exp2f(tot[0] * L2E), __builtin_amdgcn_exp2f(tot[1] * L2E)};
        if (w == 0 && rh == 0) { f32x2 t2; t2.x = etot[0]; t2.y = etot[1]; *(LAS f32x2*)(S_TOT + 512 + 2 * cp) = t2; }
        float at[4][2], bh[4][2], kh[4][2], rt[4][2], bb[4][2], kb[4][2];
#pragma unroll
        for (int e = 0; e < 2; ++e) { const float base = off[e] + hoff[e];
            float ecprev = __builtin_amdgcn_exp2f(base * L2E);
#pragma unroll
            for (int q = 0; q < 4; ++q) { const float ci = base + cum[q][e]; const float ec = __builtin_amdgcn_exp2f(ci * L2E), ecp = ecprev, en = __builtin_amdgcn_rcpf(ec), ee = etot[e] * en; ecprev = ec;
                rt[q][e] = fr[q][e] * ec; at[q][e] = fa[q][e] * ecp; bh[q][e] = fb[q][e] * en; kh[q][e] = fk[q][e] * en; bb[q][e] = fb[q][e] * ee; kb[q][e] = fk[q][e] * ee; } }
#pragma unroll
        for (int q = 0; q < 4; ++q) { const int t = 8 * w + 4 * rh + q;
            *(LAS unsigned*)(S_ATtm + t * CLS + 2 * cp) = cvtpk(at[q][0], at[q][1]); *(LAS unsigned*)(S_BHtm + t * CLS + 2 * cp) = cvtpk(bh[q][0], bh[q][1]);
            *(LAS unsigned*)(S_KHtm + t * CLS + 2 * cp) = cvtpk(kh[q][0], kh[q][1]); *(LAS unsigned*)(S_RTtm + t * CLS + 2 * cp) = cvtpk(rt[q][0], rt[q][1]); }
#pragma unroll
        for (int e = 0; e < 2; ++e) { const int jo = (2 * cp + e) * CLS + 8 * w + 4 * rh; u32x2 o;
            o.x = cvtpk(at[0][e], at[1][e]); o.y = cvtpk(at[2][e], at[3][e]); *(LAS u32x2*)(S_ATcm + jo) = o;
            o.x = cvtpk(bb[0][e], bb[1][e]); o.y = cvtpk(bb[2][e], bb[3][e]); *(LAS u32x2*)(S_BBcm + jo) = o;
            o.x = cvtpk(kb[0][e], kb[1][e]); o.y = cvtpk(kb[2][e], kb[3][e]); *(LAS u32x2*)(S_KBcm + jo) = o;
            o.x = cvtpk(fv[0][e], fv[1][e]); o.y = cvtpk(fv[2][e], fv[3][e]); *(LAS u32x2*)(S_VTcm + jo) = o; }
    }
    lds_barrier();
    const int q4 = w & 3, mb = q4 >> 1, nb = q4 & 1; const bool upper = (mb == 0 && nb == 1);
    f32x16 pacc;
    {
        f32x16 a0, a1; zero16(a0, z0); zero16(a1, z0);
        const LAS bf16_t* lhs = (w < 4 ? S_ATtm : S_RTtm) + 32 * mb * CLS;
        if (!upper) { mm64(a0, lhs, S_BHtm + 32 * nb * CLS, r, hh); mm64(a1, lhs, S_KHtm + 32 * nb * CLS, r, hh); }
        const int s = 32 * nb + r;
#pragma unroll
        for (int q = 0; q < 16; ++q) { const int t = 32 * mb + (q & 3) + 8 * (q >> 2) + 4 * hh; const bool keep = w < 4 ? (s < t) : (s <= t); if (!keep) { a0[q] = z0; a1[q] = z0; } }
        if (w < 4) { st_tile(a0, S_Q0a, 32 * mb, 32 * nb, r, hh); st_tile_t(a0, S_Q0b, 32 * mb, 32 * nb, r, hh); st_tile(a1, S_Na, 32 * mb, 32 * nb, r, hh);
            pacc = a0;
#pragma unroll
            for (int q = 0; q < 16; ++q) { const int t = 32 * mb + (q & 3) + 8 * (q >> 2) + 4 * hh; if (t == s) pacc[q] += 1.0f; }
            st_tile(pacc, S_PP0, 32 * mb, 32 * nb, r, hh); }
        else { st_tile(a0, S_Pa, 32 * mb, 32 * nb, r, hh); st_tile(a1, S_Qa, 32 * mb, 32 * nb, r, hh); zero16(pacc, z0); }
    }
    lds_barrier();
    {
        f32x16 a; zero16(a, z0);
        if (w >= 4) { if (!upper) { mm64(a, Qa[0] + 32 * mb * CLS, Qb[0] + 32 * nb * CLS, r, hh); } st_tile(a, Qa[1], 32 * mb, 32 * nb, r, hh); st_tile_t(a, Qb[1], 32 * mb, 32 * nb, r, hh); }
        else { mm64(a, S_Na + 32 * mb * CLS, S_VTcm + 32 * nb * CLS, r, hh); st_tile_t(a, S_XT, 32 * mb, 32 * nb, r, hh); }
    }
    lds_barrier();
#pragma unroll 1
    for (int k = 1; k <= 5; ++k) {
        const int rs = k & 1, ws_ = rs ^ 1;
        if (w < 4) { if (!upper) mm64(pacc, PPa[ws_] + 32 * mb * CLS, Qb[rs] + 32 * nb * CLS, r, hh); st_tile(pacc, PPa[rs], 32 * mb, 32 * nb, r, hh); }
        else if (k < 5) { f32x16 a; zero16(a, z0); if (!upper) mm64(a, Qa[rs] + 32 * mb * CLS, Qb[rs] + 32 * nb * CLS, r, hh); st_tile(a, Qa[ws_], 32 * mb, 32 * nb, r, hh); st_tile_t(a, Qb[ws_], 32 * mb, 32 * nb, r, hh); }
        lds_barrier();
    }
    {
        f32x16 a; zero16(a, z0);
        mm64(a, PPa[1] + 32 * mb * CLS, (w < 4 ? S_ATcm : S_XT) + 32 * nb * CLS, r, hh);
        st_tile_t(a, w < 4 ? S_Q0a : S_Q0b, 32 * mb, 32 * nb, r, hh);
    }
    lds_barrier();
    {
        LAS bf16_t* W1T = S_Q0a; LAS bf16_t* U1T = S_Q0b;
        f32x16 a, b; zero16(a, z0); zero16(b, z0);
        GAS u32x4* o128 = (GAS u32x4*)out;
        if (w < 4) {
            mm64(a, S_BBcm + 32 * mb * CLS, U1T + 32 * nb * CLS, r, hh); mm64(a, S_KBcm + 32 * mb * CLS, S_VTcm + 32 * nb * CLS, r, hh);
            mm64(b, W1T + 32 * mb * CLS, S_BBcm + 32 * nb * CLS, r, hh);
            const float gam = S_TOT[512 + 32 * nb + r];
#pragma unroll
            for (int q = 0; q < 16; ++q) { const int j = 32 * mb + (q & 3) + 8 * (q >> 2) + 4 * hh; if (j == 32 * nb + r) b[q] += gam; }
            u32x4 h0, h1, g0, g1;
            h0.x = cvtpk(a[0], a[1]); h0.y = cvtpk(a[2], a[3]); h0.z = cvtpk(a[4], a[5]); h0.w = cvtpk(a[6], a[7]);
            h1.x = cvtpk(a[8], a[9]); h1.y = cvtpk(a[10], a[11]); h1.z = cvtpk(a[12], a[13]); h1.w = cvtpk(a[14], a[15]);
            g0.x = cvtpk(b[0], b[1]); g0.y = cvtpk(b[2], b[3]); g0.z = cvtpk(b[4], b[5]); g0.w = cvtpk(b[6], b[7]);
            g1.x = cvtpk(b[8], b[9]); g1.y = cvtpk(b[10], b[11]); g1.z = cvtpk(b[12], b[13]); g1.w = cvtpk(b[14], b[15]);
            o128[1024 + ((mb * 2 + nb) * 64 + lane) * 2] = h0; o128[1024 + ((mb * 2 + nb) * 64 + lane) * 2 + 1] = h1;
            o128[(nb * 4 + 2 * mb) * 64 + lane] = g0; o128[(nb * 4 + 2 * mb + 1) * 64 + lane] = g1;
        } else {
            mm64(a, S_Pa + 32 * mb * CLS, U1T + 32 * nb * CLS, r, hh); mm64(a, S_Qa + 32 * mb * CLS, S_VTcm + 32 * nb * CLS, r, hh);
            mm64(b, W1T + 32 * mb * CLS, S_Pa + 32 * nb * CLS, r, hh);
#pragma unroll
            for (int g = 0; g < 4; ++g) { const s16x4 rv = *(const LAS s16x4*)(S_RTtm + (32 * nb + r) * CLS + 32 * mb + 8 * g + 4 * hh);
#pragma unroll
                for (int e = 0; e < 4; ++e) b[4 * g + e] += bf2f((bf16_t)rv[e]); }
            u32x4 y0, y1, r0, r1;
            y0.x = cvtpk(a[0], a[1]); y0.y = cvtpk(a[2], a[3]); y0.z = cvtpk(a[4], a[5]); y0.w = cvtpk(a[6], a[7]);
            y1.x = cvtpk(a[8], a[9]); y1.y = cvtpk(a[10], a[11]); y1.z = cvtpk(a[12], a[13]); y1.w = cvtpk(a[14], a[15]);
            r0.x = cvtpk(b[0], b[1]); r0.y = cvtpk(b[2], b[3]); r0.z = cvtpk(b[4], b[5]); r0.w = cvtpk(b[6], b[7]);
            r1.x = cvtpk(b[8], b[9]); r1.y = cvtpk(b[10], b[11]); r1.z = cvtpk(b[12], b[13]); r1.w = cvtpk(b[14], b[15]);
            o128[1536 + ((mb * 2 + nb) * 64 + lane) * 2] = y0; o128[1536 + ((mb * 2 + nb) * 64 + lane) * 2 + 1] = y1;
            o128[512 + (nb * 4 + 2 * mb) * 64 + lane] = r0; o128[512 + (nb * 4 + 2 * mb + 1) * 64 + lane] = r1;
        }
    }
    lds_barrier();
}

struct ScP { const unsigned char* CHK; bf16_t* YS; };
__device__ __forceinline__ void scan_unpack16(f32x16& acc, const u32x4 y0, const u32x4 y1) {
    acc[0] = __uint_as_float(y0.x << 16); acc[1] = __uint_as_float(y0.x & 0xffff0000u); acc[2] = __uint_as_float(y0.y << 16); acc[3] = __uint_as_float(y0.y & 0xffff0000u);
    acc[4] = __uint_as_float(y0.z << 16); acc[5] = __uint_as_float(y0.z & 0xffff0000u); acc[6] = __uint_as_float(y0.w << 16); acc[7] = __uint_as_float(y0.w & 0xffff0000u);
    acc[8] = __uint_as_float(y1.x << 16); acc[9] = __uint_as_float(y1.x & 0xffff0000u); acc[10] = __uint_as_float(y1.y << 16); acc[11] = __uint_as_float(y1.y & 0xffff0000u);
    acc[12] = __uint_as_float(y1.z << 16); acc[13] = __uint_as_float(y1.z & 0xffff0000u); acc[14] = __uint_as_float(y1.w << 16); acc[15] = __uint_as_float(y1.w & 0xffff0000u);
}
__device__ __forceinline__ void scan_step(const LAS unsigned char* sl, LAS float* ybuf, f32x16 (&st)[2], int w, int lane, int r, int hh) {
    bf16x8 ar[2][4], ag[2][4]; u32x4 yi[2][2], hi[2][2];
#pragma unroll
    for (int tb = 0; tb < 2; ++tb) { const LAS u32x4* yf = (const LAS u32x4*)(sl + 24576) + ((tb * 2 + w) * 64 + lane) * 2; yi[tb][0] = yf[0]; yi[tb][1] = yf[1];
        const LAS u32x4* hf = (const LAS u32x4*)(sl + 16384) + ((tb * 2 + w) * 64 + lane) * 2; hi[tb][0] = hf[0]; hi[tb][1] = hf[1];
#pragma unroll
        for (int ks = 0; ks < 4; ++ks) { ar[tb][ks] = *(const LAS bf16x8*)(sl + 8192 + ((tb * 4 + ks) * 64 + lane) * 16); ag[tb][ks] = *(const LAS bf16x8*)(sl + ((tb * 4 + ks) * 64 + lane) * 16); } }
    bf16x8 sf[4];
    sf[0] = pack8(st[0], 0); sf[1] = pack8(st[0], 1); sf[2] = pack8(st[1], 0); sf[3] = pack8(st[1], 1);
    f32x16 ya[2], sa[2];
#pragma unroll
    for (int tb = 0; tb < 2; ++tb) { scan_unpack16(ya[tb], yi[tb][0], yi[tb][1]); scan_unpack16(sa[tb], hi[tb][0], hi[tb][1]); }
#pragma unroll
    for (int ks = 0; ks < 4; ++ks) {
        ya[0] = __builtin_amdgcn_mfma_f32_32x32x16_bf16(ar[0][ks], sf[ks], ya[0], 0, 0, 0); ya[1] = __builtin_amdgcn_mfma_f32_32x32x16_bf16(ar[1][ks], sf[ks], ya[1], 0, 0, 0);
        sa[0] = __builtin_amdgcn_mfma_f32_32x32x16_bf16(ag[0][ks], sf[ks], sa[0], 0, 0, 0); sa[1] = __builtin_amdgcn_mfma_f32_32x32x16_bf16(ag[1][ks], sf[ks], sa[1], 0, 0, 0); }
    st[0] = sa[0]; st[1] = sa[1];
#pragma unroll
    for (int tb = 0; tb < 2; ++tb)
#pragma unroll
        for (int q = 0; q < 16; ++q) ybuf[(32 * tb + (q & 3) + 8 * (q >> 2) + 4 * hh) * 64 + 32 * w + r] = ya[tb][q];
}
__device__ __forceinline__ void rwkv_scan_unit(LAS unsigned char* lds, const ScP& P, int seq0, int seqm, int nmeta, int nreal, int brow0, int hd, bool write_meta, const float* st_in, float* st_out) {
    const int tid = opq(threadIdx.x), lane = tid & 63, w = __builtin_amdgcn_readfirstlane(tid >> 6), r = lane & 31, hh = lane >> 5;
    const int N = nmeta + nreal;
    float z0 = 0.f; asm volatile("" : "+v"(z0));
    LAS float* ybuf = (LAS float*)(lds + 65536);
    f32x16 st[2]; zero16(st[0], z0); zero16(st[1], z0);
    if (st_in != nullptr && w < 2) { const GAS f32x4* sp = (const GAS f32x4*)(st_in + ((size_t)w * 64 + lane) * 32);
#pragma unroll
        for (int i = 0; i < 8; ++i) { const f32x4 v = sp[i];
#pragma unroll
            for (int j = 0; j < 4; ++j) st[i >> 2][4 * (i & 3) + j] = v[j]; } }
    const int c = hd * 64 + lane;
#define SCAN_SRC(n_) ((const GAS u32x4*)(P.CHK + ((size_t)((n_) < nmeta ? seqm : seq0 + (n_) - nmeta) * 8 + hd) * CHK_BYTES))
    u32x4 pa[4], pb[4], pc[4];
    { const GAS u32x4* s0 = SCAN_SRC(0); const GAS u32x4* s1 = SCAN_SRC(1); const GAS u32x4* s2 = SCAN_SRC(2);
#pragma unroll
      for (int i = 0; i < 4; ++i) pc[i] = s0[tid + 512 * i];
#pragma unroll
      for (int i = 0; i < 4; ++i) pa[i] = s1[tid + 512 * i];
#pragma unroll
      for (int i = 0; i < 4; ++i) pb[i] = s2[tid + 512 * i];
#pragma unroll
      for (int i = 0; i < 4; ++i) *(LAS u32x4*)(lds + (tid + 512 * i) * 16) = pc[i]; }
    lds_barrier();
#define SCAN_ITER(n_, PCUR, PMID, PNEXT) do { \
        const int n = (n_); \
        if (n + 3 < N) { const GAS u32x4* s3 = SCAN_SRC(n + 3); _Pragma("unroll") for (int i = 0; i < 4; ++i) PNEXT[i] = s3[tid + 512 * i]; } \
        if (w < 2) scan_step(lds + (n & 1) * 32768, ybuf, st, w, lane, r, hh); \
        lds_barrier(); \
        if (n + 1 < N) { _Pragma("unroll") for (int i = 0; i < 4; ++i) *(LAS u32x4*)(lds + ((n + 1) & 1) * 32768 + (tid + 512 * i) * 16) = PCUR[i]; } \
        if (w >= 2) { const int crow0 = n < nmeta ? RREAL : brow0 + 64 * (n - nmeta); const int nrow = n < nmeta ? (write_meta ? NMETA : 0) : 64; \
            for (int t = w - 2; t < nrow; t += 6) ((GAS bf16_t*)P.YS)[(size_t)(crow0 + t) * 512 + c] = f2bf_hw(ybuf[t * 64 + lane]); } \
        lds_barrier(); } while (0)
    int n3 = 0;
#pragma unroll 1
    for (; n3 + 3 <= N; n3 += 3) { SCAN_ITER(n3, pa, pb, pc); SCAN_ITER(n3 + 1, pb, pc, pa); SCAN_ITER(n3 + 2, pc, pa, pb); }
    if (N - n3 >= 1) SCAN_ITER(n3, pa, pb, pc);
    if (N - n3 >= 2) SCAN_ITER(n3 + 1, pb, pc, pa);
#undef SCAN_ITER
#undef SCAN_SRC
    if (st_out != nullptr && w < 2) { GAS f32x4* sp = (GAS f32x4*)(st_out + ((size_t)w * 64 + lane) * 32);
#pragma unroll
        for (int i = 0; i < 8; ++i) { f32x4 v;
#pragma unroll
            for (int j = 0; j < 4; ++j) v[j] = st[i >> 2][4 * (i & 3) + j];
            sp[i] = v; } }
}
struct PostP { const bf16_t* YS; const bf16_t* VP; const float* RK; const bf16_t* LO; bf16_t* MIX; const float *ln_w, *ln_b; };
__device__ __forceinline__ void rwkv_post(const PostP& P, int q, int rlo, int rhi, bool with_meta, int gw, int ngw, int lane) {
    lane = opq(lane);
    const int nreal = (rhi - rlo) * 8, ntot = nreal + (with_meta ? NMETA * 8 : 0);
    for (int item = gw; item < ntot; item += ngw) { const int ri = rlo + (item >> 3); const int row = item < nreal ? (ri >> 10) * SEQ + 1024 * q + (ri & 1023) : RREAL + ((item - nreal) >> 3); const int hd = item & 7, c = hd * 64 + lane;
        const float y = bf2f(P.YS[(size_t)row * 512 + c]); const float g = bf2f(P.LO[(size_t)row * 1536 + 1024 + c]), vp = bf2f(P.VP[(size_t)row * 512 + c]), rk = P.RK[(size_t)row * 8 + hd];
        const float mean = wave_sum(y) * (1.f / 64.f); const float d = y - mean; const float var = wave_sum(d * d) * (1.f / 64.f);
        const float yn = d * rsqrtf(var + GN_EPS) * P.ln_w[c] + P.ln_b[c];
        P.MIX[(size_t)row * D + 512 + c] = f2bf_hw((yn + rk * vp) * g); }
}

constexpr int LDS_BYTES = 147456, LDS_MISC = LDS_BYTES - 512;
struct Params { const float* in[33]; float* out; unsigned char* ws; };
constexpr int CW_BAR = 4096;


#ifndef PROBE_REP_MISC
#define PROBE_REP_MISC 1
#endif
#ifndef MOE_TAIL
#define MOE_TAIL 0
#endif
#ifndef PROBE_REP_OUTPROJ
#define PROBE_REP_OUTPROJ 1
#endif
#ifndef PROBE_REP_FFNDN
#define PROBE_REP_FFNDN 1
#endif
#ifndef PROBE_REP_MOEDN
#define PROBE_REP_MOEDN 1
#endif
#ifndef PROBE_REP_NORM
#define PROBE_REP_NORM 1
#endif
#ifndef PROBE_REP_INPROJ
#define PROBE_REP_INPROJ 1
#endif
#ifndef PROBE_REP_PREP
#define PROBE_REP_PREP 1
#endif
#ifndef PROBE_REP_P4A
#define PROBE_REP_P4A 1
#endif
#ifndef PROBE_REP_ATT
#define PROBE_REP_ATT 1
#endif
#ifndef PROBE_REP_P4B
#define PROBE_REP_P4B 1
#endif
#ifndef PROBE_REP_CP
#define PROBE_REP_CP 1
#endif
#ifndef PROBE_REP_SCAN
#define PROBE_REP_SCAN 1
#endif
#ifndef PROBE_REP_FFNGU
#define PROBE_REP_FFNGU 1
#endif
#ifndef PROBE_REP_MOETR
#define PROBE_REP_MOETR 1
#endif
#ifndef PROBE_REP_GATHER
#define PROBE_REP_GATHER 1
#endif
#ifndef PROBE_REP_MOEGU
#define PROBE_REP_MOEGU 1
#endif
#define LDP(k) ((const float*)ldk(kp, 8 * (k)))
#define OUTP ((float*)ldk(kp, 264))
#define WSP ((unsigned char*)ldk(kp, 272))
#define NOINL __device__ __attribute__((noinline))
#define WAVE_IDS() const int tid = threadIdx.x, lane = tid & 63, wave = __builtin_amdgcn_readfirstlane(tid >> 6), bid = (int)blockIdx.x, nblk = (int)gridDim.x, gw = bid * 8 + wave, ngw = nblk * 8; (void)lane; (void)gw; (void)ngw
NOINL void f_p0(unsigned long long kp_, LAS unsigned char* lds) {
    const unsigned long long kp = kp_uniform(kp_); WAVE_IDS(); LAS float* scr = (LAS float*)(lds + wave * 8448);
    {
        unsigned* ctl = (unsigned*)(WSP + WS_CTL);
#pragma unroll 1
        for (int te = wave; te < 24; te += 8) { const int t = te >> 3, e = te & 7;
            const float* wt = t == 0 ? LDP(30) : (t == 1 ? LDP(31) : LDP(32));
            const f32x4 v = ((const f32x4*)(wt + (size_t)e * ((size_t)D * FFE) + (size_t)(bid % 256) * 14336))[lane];
            const float m = wave_max(fmaxf(fmaxf(fabsf(v.x), fabsf(v.y)), fmaxf(fabsf(v.z), fabsf(v.w))));
            if (lane == 0) atomicMax(&ctl[CW_WMAX + te], __float_as_uint(m)); } }
    { unsigned char* ws = WSP;
      ph_init(LDP(0), LDP(1), OUTP, (float*)(ws + WS_HMETA), (float*)(ws + WS_ROPE), LDP(23), LDP(24), (bf16_t*)(ws + WS_V1T), (size_t)bid * 512 + tid, (size_t)nblk * 512); }
#pragma unroll 1
    for (int l = 0; l < 2; ++l) { unsigned char* lw = WSP + WS_WB + l * LW_STRIDE;
        { const TrJob J{LDP(5) + (size_t)l * D * 2624, nullptr, (bf16_t*)(lw + LW_WIN), D, 2624, 1024, 0, 1, 0}; ph_transpose(J, scr, gw, ngw, lane); }
        { const TrJob J{LDP(9) + (size_t)l * 512 * 768, LDP(7) + l * 512, (bf16_t*)(lw + LW_WUQ), 512, 768, 512, 0, 0, 0}; ph_transpose(J, scr, gw, ngw, lane); }
        { const TrJob J{LDP(10) + (size_t)l * 256 * 1024, LDP(8) + l * 256, (bf16_t*)(lw + LW_WK), 256, 1024, 256, 0, 4, 0}; ph_transpose(J, scr, gw, ngw, lane); }
        { const TrJob J{LDP(13) + (size_t)l * 64 * 512, nullptr, (bf16_t*)(lw + LW_LORA), 64, 512, 256, 0, 0, 0}; ph_transpose(J, scr, gw, ngw, lane); }
        { const TrJob J{LDP(15) + (size_t)l * 64 * 512, nullptr, (bf16_t*)(lw + LW_LORA), 64, 512, 256, 64, 0, 512}; ph_transpose(J, scr, gw, ngw, lane); }
        { const TrJob J{LDP(16) + (size_t)l * 128 * 512, nullptr, (bf16_t*)(lw + LW_LORA), 128, 512, 256, 128, 0, 1024}; ph_transpose(J, scr, gw, ngw, lane); }
        { const TrJob J{LDP(6) + (size_t)l * D * D, nullptr, (bf16_t*)(lw + LW_WOUT), D, D, 1024, 0, 0, 0}; ph_transpose(J, scr, gw, ngw, lane); }
    }
    { const TrJob J{LDP(25), nullptr, (bf16_t*)(WSP + WS_FGU), D, FF0, 1024, 0, 2, 0}; ph_transpose(J, scr, gw, ngw, lane); }
    { const TrJob J{LDP(26), nullptr, (bf16_t*)(WSP + WS_FGU), D, FF0, 1024, 0, 3, 0}; ph_transpose(J, scr, gw, ngw, lane); }
    { const TrJob J{LDP(27), nullptr, (bf16_t*)(WSP + WS_FDN), FF0, D, FF0, 0, 0, 0}; ph_transpose(J, scr, gw, ngw, lane); }
}
NOINL void f_rmsnorm(unsigned long long kp_, int which, int l) { const unsigned long long kp = kp_uniform(kp_); which = __builtin_amdgcn_readfirstlane(which); l = __builtin_amdgcn_readfirstlane(l); WAVE_IDS(); unsigned char* ws = WSP;
    const float* hsrc = (which == 0 && l == 0) ? LDP(0) : (const float*)OUTP;
    ph_rmsnorm(hsrc, (const float*)(ws + WS_HMETA), (which ? LDP(3) : LDP(2)) + l * D, (bf16_t*)(ws + A_U), (const float*)(ws + A_PART), which ? 4 : (l ? 11 : 0), gw, ngw, lane); }
NOINL void f_prep(unsigned long long kp_, int l) { const unsigned long long kp = kp_uniform(kp_); l = __builtin_amdgcn_readfirstlane(l); WAVE_IDS(); unsigned char* ws = WSP;
    ph_prep((const bf16_t*)(ws + A_PM), (const bf16_t*)(ws + A_PR), LDP(11) + l * 1792, (const float*)(ws + WS_ROPE), (float*)(ws + A_RSTDQ), (float*)(ws + A_RSTDKV),
            (bf16_t*)(ws + A_KROPE), (bf16_t*)(ws + A_LIN), (bf16_t*)(ws + A_VSH), l, gw, ngw, lane); }
constexpr int RW_NSEQ = 129;
constexpr size_t RW_BUF = (size_t)RW_NSEQ * 8 * CHK_BYTES;
static_assert(2 * RW_BUF <= A_VFIRST - A_CHK, "two chunk buffers fit the chunk region");
constexpr int RW_SKIP = 4;
__device__ __forceinline__ bool rw_is_scan_wg(int bid) { return (bid & 3) == 0; }
__device__ __forceinline__ int rw_rank(int bid) { return bid - (bid >> 2) - 1; }
__device__ __forceinline__ void f_rwkv_cp(unsigned long long kp_, LAS unsigned char* lds, int l, int q) {
    const unsigned long long kp = kp_uniform(kp_); l = __builtin_amdgcn_readfirstlane(l); q = __builtin_amdgcn_readfirstlane(q);
    const int bid = (int)blockIdx.x, nblk = (int)gridDim.x; unsigned char* ws = WSP;
    const CpP cp{(const bf16_t*)(ws + A_PR), (const bf16_t*)(ws + A_LOUT), (const bf16_t*)(ws + A_VMIX), (const bf16_t*)(ws + A_VFIRST), (bf16_t*)(ws + (l ? A_VP : A_VFIRST)), (float*)(ws + A_RK), ws + A_CHK + (size_t)(q & 1) * RW_BUF,
                 LDP(11) + l * 1792, LDP(12) + l * 512, LDP(14) + l * 512, LDP(17) + l * 512, LDP(18) + l * 512, LDP(19) + l * 512, LDP(22), l, 0};
    const int ntask = (q == 0 ? RW_NSEQ : RW_NSEQ - 1) * 8, hs = q == 0 ? 0 : RW_SKIP, NS = nblk - ((nblk + 3) >> 2);
    const bool scanwg = rw_is_scan_wg(bid); const int rank = rw_rank(bid);
#define RW_TASK(i_) (scanwg ? hs * NS + (i_) * nblk + bid : ((i_) < hs ? (i_) * NS + rank : hs * NS + ((i_) - hs) * nblk + bid))
#define RW_ROW0(t_) (((t_) >> 3) == 128 ? RREAL : ((t_) >> 7) * SEQ + (16 * q + (((t_) >> 3) & 15)) * 64)
    const int tid_ = opq(threadIdx.x), lane_ = tid_ & 63, w_ = __builtin_amdgcn_readfirstlane(tid_ >> 6);
    int task = RW_TASK(0); if (task >= ntask) return;
    CpRaw raw; cp_issue(cp, RW_ROW0(task), task & 7, w_, lane_, raw);
#pragma unroll 1
    for (int i = 0; ; ++i) { const int nxt = RW_TASK(i + 1); const bool has_next = nxt < ntask;
        rwkv_cp_task(lds, cp, RW_ROW0(task), task & 7, cp.CHK + (size_t)task * CHK_BYTES, raw, has_next, has_next ? RW_ROW0(nxt) : 0, nxt & 7);
        if (!has_next) break;
        task = nxt; }
#undef RW_TASK
#undef RW_ROW0
}
__device__ __forceinline__ void f_rwkv_scan(unsigned long long kp_, LAS unsigned char* lds, int l, int q) {
    const unsigned long long kp = kp_uniform(kp_); l = __builtin_amdgcn_readfirstlane(l); q = __builtin_amdgcn_readfirstlane(q);
    const int bid = (int)blockIdx.x, nblk = (int)gridDim.x; if (!rw_is_scan_wg(bid)) return;
    unsigned char* ws = WSP; const ScP sp{ws + A_CHK + (size_t)(q & 1) * RW_BUF, (bf16_t*)(ws + A_YS)};
#pragma unroll 1
    for (int unit = bid >> 2; unit < 64; unit += (nblk + 3) >> 2) { const int b = unit >> 3, hd = unit & 7; float* stp = (float*)(ws + A_SCST) + (size_t)unit * 4096;
        rwkv_scan_unit(lds, sp, b * 16, 128, q == 0 ? 1 : 0, 16, b * SEQ + q * 1024, hd, q == 0 && b == 0, q == 0 ? nullptr : stp, q == 3 ? nullptr : stp); }
}
NOINL void f_rwkv_post(unsigned long long kp_, int l, int q, int mode) {
    const unsigned long long kp = kp_uniform(kp_); l = __builtin_amdgcn_readfirstlane(l); q = __builtin_amdgcn_readfirstlane(q); mode = __builtin_amdgcn_readfirstlane(mode); WAVE_IDS(); unsigned char* ws = WSP;
    const PostP pp{(const bf16_t*)(ws + A_YS), (const bf16_t*)(ws + (l ? A_VP : A_VFIRST)), (const float*)(ws + A_RK), (const bf16_t*)(ws + A_LOUT), (bf16_t*)(ws + A_PM), LDP(20) + l * 512, LDP(21) + l * 512};
    const bool scanwg = rw_is_scan_wg(bid); const int nscan = (nblk + 3) >> 2, NS = nblk - nscan;
    if (mode == 2) rwkv_post(pp, q, 0, 8192, q == 0, gw, ngw, lane);
    else if (mode == 1) { if (!scanwg) rwkv_post(pp, q, 0, 8192, q == 0, rw_rank(bid) * 8 + wave, NS * 8, lane); }
    else if (scanwg) rwkv_post(pp, q, 0, 4096, false, (bid >> 2) * 8 + wave, nscan * 8, lane);
    else rwkv_post(pp, q, 4096, 8192, q == 0, rw_rank(bid) * 8 + wave, NS * 8, lane); }
NOINL void f_ffn_meta(unsigned long long kp_) {
    const unsigned long long kp = kp_uniform(kp_); WAVE_IDS(); unsigned char* ws = WSP;
    const int job = bid * 8 + wave; if (job >= FF0 / 16) return;
    const int f0 = job * 16, l15 = lane & 15, kq = lane >> 4;
    const bf16_t* wg = (const bf16_t*)(ws + WS_FGU) + (size_t)((f0 >> 7) * 256 + (f0 & 127) + l15) * 1024 + 8 * kq;
    const bf16_t* wu = wg + (size_t)128 * 1024;
    const bf16_t* xu = (const bf16_t*)(ws + A_U) + (size_t)(RREAL + l15) * D + 8 * kq;
    f32x4 ag = {0.f, 0.f, 0.f, 0.f}, au = {0.f, 0.f, 0.f, 0.f};
#pragma unroll 8
    for (int ks = 0; ks < 32; ++ks) { const bf16x8 a = *(const GAS bf16x8*)(wg + 32 * ks), b = *(const GAS bf16x8*)(wu + 32 * ks), x = *(const GAS bf16x8*)(xu + 32 * ks);
        ag = __builtin_amdgcn_mfma_f32_16x16x32_bf16(a, x, ag, 0, 0, 0); au = __builtin_amdgcn_mfma_f32_16x16x32_bf16(b, x, au, 0, 0, 0); }
    float r[4];
#pragma unroll
    for (int j = 0; j < 4; ++j) { const float g = ag[j], up = au[j]; r[j] = g / (1.0f + __expf(-g)) * up; }
    u32x2 o; o.x = cvtpk(r[0], r[1]); o.y = cvtpk(r[2], r[3]);
    *(GAS u32x2*)((bf16_t*)(ws + A_ACT0) + (size_t)(RREAL + l15) * FF0 + f0 + 4 * kq) = o;
}
NOINL void f_moe_tr(unsigned long long kp_, LAS unsigned char* lds) {
    const unsigned long long kp = kp_uniform(kp_); WAVE_IDS(); LAS float* scr = (LAS float*)(lds + wave * 8448);
    if (bid == 0 && tid < 24) { unsigned* ctlw = (unsigned*)(WSP + WS_CTL); const float sc = moe_wscale_bits(ctlw[CW_WMAX + tid]); ctlw[CW_WINV + tid] = __float_as_uint(1.0f / (F8_ACT * sc)); }
#pragma unroll 1
    for (int e = 0; e < NEXP * PROBE_REP_MOETR; ++e) { const int ee = e % NEXP;
        const unsigned* ctl = (const unsigned*)(WSP + WS_CTL);
        { const TrJob8 J{LDP(30) + (size_t)ee * D * FFE, WSP + A_MGU, D, FFE, 1024, 2, ee * 2 * FFE, moe_wscale(ctl, 0, ee)}; ph_transpose_f8(J, scr, gw, ngw, lane); }
        { const TrJob8 J{LDP(31) + (size_t)ee * D * FFE, WSP + A_MGU, D, FFE, 1024, 3, ee * 2 * FFE, moe_wscale(ctl, 1, ee)}; ph_transpose_f8(J, scr, gw, ngw, lane); }
        { const TrJob8 J{LDP(32) + (size_t)ee * FFE * D, WSP + A_MDN, FFE, D, FFE, 0, ee * D, moe_wscale(ctl, 2, ee)}; ph_transpose_f8(J, scr, gw, ngw, lane); }
    }
}
__device__ __forceinline__ void f_moe_route(unsigned long long kp_, LAS unsigned char* lds) {
    const unsigned long long kp = kp_uniform(kp_); WAVE_IDS(); unsigned char* ws = WSP;
    ph_norm_route(lds, OUTP, LDP(3) + D, LDP(28), LDP(29), (bf16_t*)(ws + A_U), (int*)(ws + A_MTAB + MT_E), (float*)(ws + A_MTAB + MT_G), (int*)(ws + A_MTAB + MT_STOK), (unsigned*)(ws + WS_CTL), bid, nblk, wave, lane); }
NOINL void f_moe_assign(unsigned long long kp_, LAS unsigned char* lds, int list) { const unsigned long long kp = kp_uniform(kp_); list = __builtin_amdgcn_readfirstlane(list); WAVE_IDS(); unsigned char* ws = WSP;
    ph_moe_assign(lds, list, (const int*)(ws + A_MTAB + MT_E), (const float*)(ws + A_MTAB + MT_G), (int*)(ws + A_MTAB + MT_STOK), (float*)(ws + A_MTAB + MT_SGATE), (int*)(ws + A_MTAB + MT_BE), (unsigned*)(ws + WS_CTL), ws + A_U, ws + A_XB, bid, nblk, tid); }
NOINL void f_final(unsigned long long kp_) { const unsigned long long kp = kp_uniform(kp_); WAVE_IDS(); unsigned char* ws = WSP; ph_final(OUTP, LDP(4), (const int*)(ws + A_MTAB + MT_TSLOT), (const float*)(ws + WS_TB), gw, ngw, lane); }

__global__ void __launch_bounds__(512, 2) fwd(Params P) {
    extern __shared__ __attribute__((aligned(16))) unsigned char lds_raw[];
    LAS unsigned char* lds = (LAS unsigned char*)lds_raw;
    const int tid = threadIdx.x;
    const int bid = (int)blockIdx.x, nblk = (int)gridDim.x;
    const unsigned long long kp = (unsigned long long)__builtin_amdgcn_kernarg_segment_ptr();
    volatile LAS unsigned* misc = (volatile LAS unsigned*)(lds + LDS_MISC);
    if (tid < 64) misc[tid] = 0u;
    __syncthreads();
    XcdBarrier bar;
    { unsigned* ctl0 = (unsigned*)(WSP + WS_CTL); bar = xcd_barrier_post(ctl0 + CW_BAR, misc + 8); }
#ifdef PROBE_BAR2
#define GRID_BAR() do { xcd_barrier(bar); xcd_barrier(bar); } while (0)
#else
#define GRID_BAR() xcd_barrier(bar)
#endif
    for (int rep_ = 0; rep_ < PROBE_REP_MISC; ++rep_) f_p0(kp, lds);
    GRID_BAR();

#pragma unroll 1
    for (int l = 0; l < 2; ++l) {
        for (int rep_ = 0; rep_ < PROBE_REP_NORM; ++rep_) f_rmsnorm(kp, 0, l);
        GRID_BAR();
_Pragma("unroll 1") for (int rep_ = 0; rep_ < PROBE_REP_INPROJ; ++rep_) {
        { unsigned char* ws = WSP; pg8::Gemm g{(const bf16_t*)(ws + A_U), (const bf16_t*)(ws + WS_WB + l * LW_STRIDE + LW_WIN), RP, 2816, 1024, 1024, 1024, 0}; pg8::StaticOrder S; S.init(RP, 2816, opqs(nblk), opqs(bid));
          EpiInProj E{(bf16_t*)(ws + A_PM), (bf16_t*)(ws + A_PR)};
          pg8::gemm_phase<EpiInProj, pg8::StaticOrder, true, true>(lds, g, S, E); }
}
        GRID_BAR();
        for (int rep_ = 0; rep_ < PROBE_REP_PREP; ++rep_) f_prep(kp, l);
        GRID_BAR();
_Pragma("unroll 1") for (int rep_ = 0; rep_ < PROBE_REP_P4A; ++rep_) {
        { unsigned char* ws = WSP; pg8::Gemm g{(const bf16_t*)(ws + A_PM), (const bf16_t*)(ws + WS_WB + l * LW_STRIDE + LW_WUQ), RP, 768, 512, 1024, 512, 0}; pg8::StaticOrder S; S.init(RP, 768, opqs(nblk), opqs(bid));
          EpiRowScale E{(bf16_t*)(ws + A_U), (const float*)(ws + A_RSTDQ), 768, 0};
          pg8::gemm_phase<EpiRowScale, pg8::StaticOrder, true, true>(lds, g, S, E); }
        { unsigned char* ws = WSP; pg8::Gemm g{(const bf16_t*)(ws + A_PM) + 512, (const bf16_t*)(ws + WS_WB + l * LW_STRIDE + LW_WK), RP, 512, 256, 1024, 256, 0}; pg8::StaticOrder S; S.init(RP, 512, opqs(nblk), opqs((bid + nblk - 131) % nblk));
          EpiRowScale E{(bf16_t*)(ws + A_KN), (const float*)(ws + A_RSTDKV), 512, 0};
          pg8::gemm_phase<EpiRowScale, pg8::StaticOrder, true, true>(lds, g, S, E); }
        { unsigned char* ws = WSP; pg8::Gemm g{(const bf16_t*)(ws + WS_WB + l * LW_STRIDE + LW_WV), (const bf16_t*)(ws + A_PM) + 512, 512, RP, 256, 256, 1024, 0}; pg8::StaticOrder S; S.init(512, RP, opqs(nblk), opqs((bid + nblk - 133) % nblk));
          EpiColScale E{(bf16_t*)(ws + A_VT), (const float*)(ws + A_RSTDKV), RP, 0};
          pg8::gemm_phase<EpiColScale, pg8::StaticOrder, true, true>(lds, g, S, E); }
}
        GRID_BAR();
_Pragma("unroll 1") for (int rep_ = 0; rep_ < PROBE_REP_ATT; ++rep_) {
        { unsigned char* ws = WSP; attn_phase(lds, (const bf16_t*)(ws + A_U), (const bf16_t*)(ws + A_KN), (const bf16_t*)(ws + A_KROPE), (const bf16_t*)(ws + A_VT), (bf16_t*)(ws + A_PM), (const float*)(ws + WS_ROPE), opqs(bid), opqs(nblk)); }
}
        GRID_BAR();
_Pragma("unroll 1") for (int rep_ = 0; rep_ < PROBE_REP_P4B; ++rep_) {
        { unsigned char* ws = WSP; pg8::Gemm g{(const bf16_t*)(ws + A_LIN), (const bf16_t*)(ws + WS_WB + l * LW_STRIDE + LW_LORA), RP, 1536, 256, 256, 256, 0}; pg8::StaticOrder S; S.init(RP, 1536, opqs(nblk), opqs(bid));
          EpiRowScale E{(bf16_t*)(ws + A_LOUT), nullptr, 1536, 0};
          pg8::gemm_phase<EpiRowScale, pg8::StaticOrder, true, true>(lds, g, S, E); }
        if (l == 1) {
            unsigned char* ws = WSP; pg8::Gemm g{(const bf16_t*)(ws + A_VSH), (const bf16_t*)(ws + WS_V1T), RP, 512, 512, 512, 512, 0}; pg8::StaticOrder S; S.init(RP, 512, opqs(nblk), opqs((bid + nblk - 6) % nblk));
            EpiRowScale E{(bf16_t*)(ws + A_VMIX), nullptr, 512, 0};
            pg8::gemm_phase<EpiRowScale, pg8::StaticOrder, true, true>(lds, g, S, E);
        }
}
        GRID_BAR();
#pragma unroll 1
        for (int stp = 0; stp < 6; ++stp) {
            if (stp >= 1 && stp <= 4) { _Pragma("unroll 1") for (int rep_ = 0; rep_ < PROBE_REP_SCAN; ++rep_) f_rwkv_scan(kp, lds, l, stp - 1); }
            if (stp <= 3) { _Pragma("unroll 1") for (int rep_ = 0; rep_ < PROBE_REP_CP; ++rep_) f_rwkv_cp(kp, lds, l, stp); }
            if (stp >= 2) { for (int rep_ = 0; rep_ < PROBE_REP_MISC; ++rep_) f_rwkv_post(kp, l, stp - 2, stp <= 3 ? 0 : stp - 3); }
            GRID_BAR();
        }
_Pragma("unroll 1") for (int rep_ = 0; rep_ < PROBE_REP_OUTPROJ; ++rep_) {
        { unsigned char* ws = WSP; pg8::Gemm g{(const bf16_t*)(ws + A_PM), (const bf16_t*)(ws + WS_WB + l * LW_STRIDE + LW_WOUT), RREAL, 1024, 1024, 1024, 1024, 0}; pg8::StaticOrder S; S.init(RREAL, 1024, opqs(nblk), opqs(bid));
          EpiResid E{OUTP, (float*)(ws + WS_HMETA), (l == 0 && rep_ == 0) ? LDP(0) : (const float*)OUTP, rep_ == 0 ? 1.0f : 0.0f, 0};
          pg8::gemm_phase<EpiResid, pg8::StaticOrder, true, true>(lds, g, S, E); }
        if (rep_ == 0 && l == 0) {
          unsigned char* ws = WSP; pg8::Gemm g{(const bf16_t*)(ws + A_PM), (const bf16_t*)(ws + WS_WB + l * LW_STRIDE + LW_WOUT), RP, 1024, 256, 1024, 1024, 0};
          const DenseTailOrder S{4, 4, opqs(nblk), opqs(bid)}; EpiResidPartial E{(float*)(ws + A_PART)};
          pg8::gemm_phase<EpiResidPartial, DenseTailOrder, true, true>(lds, g, S, E); }
}
        GRID_BAR();
        if (l == 0) {
            for (int rep_ = 0; rep_ < PROBE_REP_MISC; ++rep_) f_rmsnorm(kp, 1, 0);
            GRID_BAR();
_Pragma("unroll 1") for (int rep_ = 0; rep_ < PROBE_REP_FFNGU; ++rep_) {
            f_ffn_meta(kp);
            { unsigned char* ws = WSP; pg8::Gemm g{(const bf16_t*)(ws + A_U), (const bf16_t*)(ws + WS_FGU), RREAL, 2 * FF0, 1024, 1024, 1024, 0}; pg8::StaticOrder S; S.init(RREAL, 2 * FF0, opqs(nblk), opqs(bid));
              EpiSwiGLU E{(bf16_t*)(ws + A_ACT0), FF0, 22, 0, 0};
              pg8::gemm_phase<EpiSwiGLU, pg8::StaticOrder, true, true>(lds, g, S, E); }
}
            GRID_BAR();
_Pragma("unroll 1") for (int rep_ = 0; rep_ < PROBE_REP_FFNDN; ++rep_) {
            { unsigned char* ws = WSP; pg8::Gemm g{(const bf16_t*)(ws + A_ACT0), (const bf16_t*)(ws + WS_FDN), RREAL, 1024, FF0, FF0, FF0, 0}; pg8::StaticOrder S; S.init(RREAL, 1024, opqs(nblk), opqs(bid));
              EpiResid E{OUTP, (float*)(ws + WS_HMETA), (const float*)OUTP, rep_ == 0 ? 1.0f : 0.0f, 0};
              pg8::gemm_phase<EpiResid, pg8::StaticOrder, true, true>(lds, g, S, E); }
            if (rep_ == 0) {
              unsigned char* ws = WSP; pg8::Gemm g{(const bf16_t*)(ws + A_ACT0), (const bf16_t*)(ws + WS_FDN), RP, 1024, 256, FF0, FF0, 0};
              const DenseTailOrder S{4, 11, opqs(nblk), opqs(bid)}; EpiResidPartial E{(float*)(ws + A_PART)};
              pg8::gemm_phase<EpiResidPartial, DenseTailOrder, true, true>(lds, g, S, E); }
}
            GRID_BAR();
        } else {
            f_moe_tr(kp, lds);
            f_moe_route(kp, lds);
            GRID_BAR();
            f_moe_assign(kp, lds, 0);
            f_moe_assign(kp, lds, 1);
            GRID_BAR();
#pragma unroll 1
            for (int list = 0; list < 2; ++list) {
                const int np0 = __builtin_amdgcn_readfirstlane((int)((const unsigned*)(WSP + WS_CTL))[CW_NPAN]), np1 = __builtin_amdgcn_readfirstlane((int)((const unsigned*)(WSP + WS_CTL))[CW_NPAN + 1]);
                const int T0 = np0 > MOE_TAILPAN ? (np0 - MOE_TAILPAN) * 4 : 0, T1 = np1 > MOE_TAILPAN ? (np1 - MOE_TAILPAN) * 4 : 0;
                if (list == 1) {
                    { unsigned char* ws = WSP; pg8::Gemm g{(const bf16_t*)(ws + A_MACT), (const bf16_t*)(ws + A_MDN), 0, 0, FFE / 2, FFE / 2, FFE / 2, 0};
                      const MoeShiftTailOrder S{(const int*)(ws + A_MTAB + MT_BE), (const unsigned*)(ws + WS_CTL) + CW_NPAN, 4, 4, 0, opqs(nblk) - 1, opqs(bid), 0};
                      EpiMoeDown E{OUTP, (const int*)(ws + A_MTAB + MT_STOK), (const float*)(ws + A_MTAB + MT_SGATE), 4, 1.0f, (const unsigned*)(ws + WS_CTL)};
                      pg8::gemm_phase<EpiMoeDown, MoeShiftTailOrder, true, true, true>(lds, g, S, E); }
                    { unsigned char* ws = WSP; pg8::Gemm g{(const bf16_t*)(ws + A_MACT), (const bf16_t*)(ws + A_MDN), 0, 0, FFE / 2, FFE / 2, FFE / 2, 0};
                      const MoeShiftTailOrder S{(const int*)(ws + A_MTAB + MT_BE) + 256, (const unsigned*)(ws + WS_CTL) + CW_NPAN + 1, 4, 4, MOE_GAP, opqs(nblk) - 1 - T0, opqs(bid), 0};
                      EpiMoeDownStore E{(float*)(ws + WS_TB), (const int*)(ws + A_MTAB + MT_STOK) + MOE_MAXPAN * 256, (const float*)(ws + A_MTAB + MT_SGATE) + MOE_MAXPAN * 256, 4, MOE_TAILPAN + MOE_GAP, (const unsigned*)(ws + WS_CTL)};
                      pg8::gemm_phase<EpiMoeDownStore, MoeShiftTailOrder, true, true, true>(lds, g, S, E); }
                }
_Pragma("unroll 1") for (int rep_ = 0; rep_ < PROBE_REP_MOEGU; ++rep_) {
                { unsigned char* ws = WSP; pg8::Gemm g{(const bf16_t*)(ws + A_XB + (size_t)list * XB_LIST), (const bf16_t*)(ws + A_MGU), 0, 0, 512, 512, 512, 0};
                  const int Tt = list == 1 && T0 + T1 < opqs(nblk) ? T0 + T1 : 0;
                  const MoeSlotOrder S{(const int*)(ws + A_MTAB + MT_BE) + 256 * list, (const unsigned*)(ws + WS_CTL) + CW_NPAN + list, (const int*)(ws + A_MTAB + MT_STOK) + list * MOE_MAXPAN * 256, 28, 28, 0, opqs(nblk), opqs(bid), RREAL,
                                         0, list == 0 ? MOE_MAXPAN : MOE_TAILPAN, 0, 0, Tt, MOE_CSKIP};
                  EpiSwiGLU8 E{ws + A_MACT, (const unsigned*)(ws + WS_CTL), FFE, 28};
                  pg8::gemm_phase<EpiSwiGLU8, MoeSlotOrder, true, true, true>(lds, g, S, E); }
                if (list == 0) {
                  unsigned char* ws = WSP; pg8::Gemm g{(const bf16_t*)(ws + A_XB + XB_LIST), (const bf16_t*)(ws + A_MGU), 0, 0, 512, 512, 512, 0};
                  const int nb = opqs(nblk);
                  const MoeSlotOrder S{(const int*)(ws + A_MTAB + MT_BE) + 256, (const unsigned*)(ws + WS_CTL) + CW_NPAN + 1, (const int*)(ws + A_MTAB + MT_STOK) + MOE_MAXPAN * 256, 28, 28, 0, nb, opqs(bid), RREAL,
                                         MOE_TAILPAN, MOE_MAXPAN, MOE_GAP, (np0 * 28) % nb, 0, 0};
                  EpiSwiGLU8 E{ws + A_MACT, (const unsigned*)(ws + WS_CTL), FFE, 28};
                  pg8::gemm_phase<EpiSwiGLU8, MoeSlotOrder, true, true, true>(lds, g, S, E); }
}
                GRID_BAR();
_Pragma("unroll 1") for (int rep_ = 0; rep_ < PROBE_REP_MOEDN; ++rep_) {
                { unsigned char* ws = WSP; pg8::Gemm g{(const bf16_t*)(ws + A_MACT), (const bf16_t*)(ws + A_MDN), 0, 0, FFE / 2, FFE / 2, FFE / 2, 0};
                  const MoeOrder S{(const int*)(ws + A_MTAB + MT_BE) + 256 * list, (const unsigned*)(ws + WS_CTL) + CW_NPAN + list, 4, 4, 0, opqs(nblk), opqs(bid), MOE_TAILPAN * 4};
                  EpiMoeDown E{OUTP, (const int*)(ws + A_MTAB + MT_STOK) + list * MOE_MAXPAN * 256, (const float*)(ws + A_MTAB + MT_SGATE) + list * MOE_MAXPAN * 256, 4, rep_ == 0 ? 1.0f : 0.0f, (const unsigned*)(ws + WS_CTL)};
                  pg8::gemm_phase<EpiMoeDown, MoeOrder, true, true, true>(lds, g, S, E); }
}
                GRID_BAR();
            }
        }
    }
    f_final(kp);
}

extern "C" void kernel_launch(void* const* d_in, const int* in_sizes, int n_in, void* d_out, int out_size, void* d_ws, size_t ws_size, hipStream_t stream) {
    static int grid = 0;
    if (grid == 0) {
        if (n_in != 33 || ws_size < WS_NEED || out_size != RREAL * D) { fprintf(stderr, "kernel_launch: unexpected arguments (n_in %d, ws %zu need %zu, out %d)\n", n_in, ws_size, (size_t)WS_NEED, out_size); grid = -1; return; }
        int dev = 0, cus = 0;
        if (hipGetDevice(&dev) != hipSuccess || hipDeviceGetAttribute(&cus, hipDeviceAttributeMultiprocessorCount, dev) != hipSuccess) { grid = -1; return; }
        if (hipFuncSetAttribute((const void*)fwd, hipFuncAttributeMaxDynamicSharedMemorySize, LDS_BYTES) != hipSuccess) { fprintf(stderr, "kernel_launch: hipFuncSetAttribute failed\n"); grid = -1; return; }
        int per_cu = 0; (void)hipOccupancyMaxActiveBlocksPerMultiprocessor(&per_cu, (const void*)fwd, 512, LDS_BYTES); (void)hipGetLastError();
        grid = cus;
    }
    if (grid < 0) return;
    unsigned char* ws = (unsigned char*)d_ws;
    (void)hipMemsetAsync(ws + WS_CTL, 0, 1 * MiB, stream);
    (void)hipMemsetAsync(ws + WS_WB, 0, WS_ROPE - WS_WB, stream);
    Params p{};
    for (int i = 0; i < 33; ++i) p.in[i] = (const float*)d_in[i];
    p.out = (float*)d_out; p.ws = ws;
    hipLaunchKernelGGL(fwd, dim3(grid), dim3(512), LDS_BYTES, stream, p);
}
```

```cpp
#include <hip/hip_runtime.h>
#include <cstdio>
#include <cstdint>
namespace pg8 {
#define PG8_LAS __attribute__((address_space(3)))
typedef unsigned short bf16_t;
typedef short bf16x8 __attribute__((ext_vector_type(8)));
typedef float f32x4 __attribute__((ext_vector_type(4)));
typedef unsigned u32x4 __attribute__((ext_vector_type(4)));
constexpr int BM = 256, BK = 64, HALF = 128, HTB = HALF * BK * 2  , STAGE_BYTES = 8 * HTB, NXCD = 8, WGM = 8;

__host__ __device__ __forceinline__ int lds_byte(int r, int c) { const int st = (r >> 4) * 2 + (c >> 5), rr = r & 15, cc = c & 31, ob = rr * 64 + cc * 2; return st * 1024 + (ob ^ (((ob >> 9) & 1) << 5)); }
__host__ __device__ __forceinline__ void stage_rc(int b, int& R, int& C) { const int st = b / 1024, sb = b % 1024, swz = sb ^ (((sb >> 9) & 1) << 5); R = (st >> 1) * 16 + swz / 64; C = (st & 1) * 32 + (swz % 64) / 2; }
__host__ __device__ __forceinline__ int perm32(int rho) { const int n = rho >> 4, i = rho & 15; return 8 * (i >> 2) + 4 * n + (i & 3); }

struct Unit { int pm, pn, k0; };
struct Gemm { const bf16_t* A; const bf16_t* Bt; int M, N, K, lda, ldb, pad; };

struct StaticOrder {
    static constexpr bool GATHER = false;
    int nM, nN, nwg, G, c;
    __host__ __device__ void init(int M, int N, int G_, int c_) { nM = M / BM; nN = N / BM; nwg = nM * nN; G = G_; c = c_; }
    __host__ __device__ bool next(int i, Unit& u) const {
        const long L = (long)i * G + c; if (L >= nwg) return false;
        int wgid = (int)L; { const int q = nwg / NXCD, r = nwg % NXCD, xcd = wgid % NXCD, off = wgid / NXCD; wgid = (xcd < r ? xcd * (q + 1) : r * (q + 1) + (xcd - r) * q) + off; }
        const int nig = WGM * nN, gid = wgid / nig, fm = gid * WGM, gsz = (nM - fm) < WGM ? (nM - fm) : WGM;
        u.pm = fm + ((wgid % nig) % gsz); u.pn = (wgid % nig) / gsz; u.k0 = 0; return true;
    }
    __device__ __forceinline__ void a_ready(const Unit&) const {}
    __device__ __forceinline__ void done(const Unit&) const {}
};

__device__ __forceinline__ unsigned cvt_pk_bf16(float lo, float hi) { unsigned r; asm volatile("v_cvt_pk_bf16_f32 %0, %1, %2" : "=v"(r) : "v"(lo), "v"(hi)); return r; }
typedef int i32x4_ __attribute__((ext_vector_type(4)));
typedef int i32x8_ __attribute__((ext_vector_type(8)));
template <class Epi, class Sched, bool ALIGN_EPI = false, bool SP2 = false, bool FP8 = false>
__device__ __forceinline__ void gemm_phase(PG8_LAS unsigned char* lds, const Gemm g, const Sched& S, const Epi& E) {
    int tid_ = threadIdx.x; asm volatile("" : "+v"(tid_)); const int tid = tid_, wid = __builtin_amdgcn_readfirstlane(tid >> 6), lane = tid & 63, wr = wid >> 2, wc = wid & 3, fr = lane & 15, fq = lane >> 4;
    const int K = g.K, nt = K / BK;
    unsigned voffA[2], voffB[2];
#pragma unroll
    for (int i = 0; i < 2; ++i) { int R, C; stage_rc(tid * 16 + i * 8192, R, C); const int Rb = Epi::PERM ? ((R & ~31) + perm32(R & 31)) : R;
        voffA[i] = (unsigned)(R * g.lda + C) * 2u; voffB[i] = (unsigned)(Rb * g.ldb + C) * 2u; }
    constexpr bool GATHER = Sched::GATHER;
    unsigned vAc[2][2] = {{0u, 0u}, {0u, 0u}}, vAn[2][2] = {{0u, 0u}, {0u, 0u}}, cbA[2] = {0u, 0u};
    if constexpr (GATHER) {
#pragma unroll
        for (int i = 0; i < 2; ++i) { int R, C; stage_rc(tid * 16 + i * 8192, R, C); cbA[i] = (unsigned)C * 2u; }
    }
#define PG8_IDX_DMA(un, slot) do { if constexpr (GATHER) { const int* rp_ = S.rows + (size_t)(un).pm * 256 + 128 * (lane >> 5) + 64 * ((lane >> 4) & 1) + 16 * (wid >> 1) + (lane & 15); \
        __builtin_amdgcn_global_load_lds((const unsigned*)rp_, (PG8_LAS unsigned*)(lds + STAGE_BYTES + wid * 512 + (slot) * 256), 4, 0, 0); } } while (0)
#define PG8_IDX_READ(dst, slot) do { if constexpr (GATHER) { int t3_ = threadIdx.x; asm volatile("" : "+v"(t3_));     \
        _Pragma("unroll") for (int h_ = 0; h_ < 2; ++h_) _Pragma("unroll") for (int i_ = 0; i_ < 2; ++i_) { int R_, C_; stage_rc(t3_ * 16 + i_ * 8192, R_, C_); \
        int tk_ = *(const PG8_LAS int*)(lds + STAGE_BYTES + (t3_ >> 6) * 512 + (slot) * 256 + 4 * (32 * h_ + 16 * i_ + ((t3_ & 63) >> 2))); tk_ = tk_ < 0 ? S.zero_row : tk_; \
        dst[h_][i_] = (unsigned)tk_ * (unsigned)(g.lda * 2) + (unsigned)C_ * 2u; } } } while (0)
#define PG8_STAGE_A(bufoff, base, h, nx) do { if constexpr (GATHER) { const unsigned vs_[2] = {(nx) ? vAn[h][0] : vAc[h][0], (nx) ? vAn[h][1] : vAc[h][1]}; PG8_STAGE(bufoff, base, vs_); } \
        else { PG8_STAGE(bufoff, (base) + (h) * hstepA, voffA); } } while (0)
    const size_t kstep = (size_t)(BK * 2);
    const size_t hstepA = (size_t)HALF * g.lda * 2, hstepB = (size_t)HALF * g.ldb * 2;
    const size_t tstepA = 2 * hstepA, tstepB = 2 * hstepB;
    const unsigned ldsw = (unsigned)wid * 1024u;
    const int aoff = lds_byte(wr * 64 + fr, fq * 8), boff = lds_byte(wc * 32 + fr, fq * 8);
#define PG8_SA(b, h) (((b) * 2 + (h)) * HTB)
#define PG8_SB(b, h) ((4 + (b) * 2 + (h)) * HTB)
#define PG8_STAGE(bufoff, gbase, voff) do { const char* gb_ = (const char*)(gbase); asm volatile("" : "+s"(gb_));   \
        _Pragma("unroll") for (int _i = 0; _i < 2; ++_i) \
        __builtin_amdgcn_global_load_lds((const unsigned*)(gb_ + (voff)[_i]), (PG8_LAS unsigned*)(lds + (bufoff) + ldsw + _i * 8192), 16, 0, 0); } while (0)
#define PG8_LDA(dst, b, h) do { _Pragma("unroll") for (int m = 0; m < 4; ++m) _Pragma("unroll") for (int k = 0; k < 2; ++k) dst[m][k] = *(const PG8_LAS bf16x8*)(lds + PG8_SA(b, h) + aoff + m * 2048 + k * 1024); } while (0)
#define PG8_LDB(dst, b, h) do { _Pragma("unroll") for (int n = 0; n < 2; ++n) _Pragma("unroll") for (int k = 0; k < 2; ++k) dst[n][k] = *(const PG8_LAS bf16x8*)(lds + PG8_SB(b, h) + boff + n * 2048 + k * 1024); } while (0)
#define PG8_MMA(ai, bj, At, Bt) do { __builtin_amdgcn_s_setprio(1); _Pragma("unroll") for (int m = 0; m < 4; ++m) _Pragma("unroll") for (int n = 0; n < 2; ++n) { \
        if constexpr (FP8) { const i32x8_ b8_ = __builtin_shufflevector(__builtin_bit_cast(i32x4_, Bt[n][0]), __builtin_bit_cast(i32x4_, Bt[n][1]), 0, 1, 2, 3, 4, 5, 6, 7); \
            const i32x8_ a8_ = __builtin_shufflevector(__builtin_bit_cast(i32x4_, At[m][0]), __builtin_bit_cast(i32x4_, At[m][1]), 0, 1, 2, 3, 4, 5, 6, 7); \
            acc[ai][bj][m][n] = __builtin_amdgcn_mfma_scale_f32_16x16x128_f8f6f4(b8_, a8_, acc[ai][bj][m][n], 0, 0, 0, 0, 0, 0); }     \
        else { _Pragma("unroll") for (int k = 0; k < 2; ++k) acc[ai][bj][m][n] = __builtin_amdgcn_mfma_f32_16x16x32_bf16(Bt[n][k], At[m][k], acc[ai][bj][m][n], 0, 0, 0); } } \
        __builtin_amdgcn_s_setprio(0); } while (0)
#define PG8_WAIT_V(n) asm volatile("s_waitcnt vmcnt(" #n ")" ::: "memory")
#define PG8_WAIT_L(n) asm volatile("s_waitcnt lgkmcnt(" #n ")" ::: "memory")
#define PG8_BAR __builtin_amdgcn_s_barrier()
#define PG8_SCHED __builtin_amdgcn_sched_barrier(0)
    Unit cur, nxt; int ui = 0;
    if (!S.next(0, cur)) return;
    float zf_ = 0.f; asm volatile("" : "+v"(zf_));
    f32x4 acc[2][2][4][2];
#pragma unroll
    for (int a = 0; a < 2; ++a)
#pragma unroll
        for (int b = 0; b < 2; ++b)
#pragma unroll
            for (int m = 0; m < 4; ++m)
#pragma unroll
                for (int n = 0; n < 2; ++n) acc[a][b][m][n] = (f32x4){zf_, zf_, zf_, zf_};
    bf16x8 At[4][2], B0[2][2], B1[2][2];
    const char* cA = (const char*)g.A + (GATHER ? (size_t)0 : (size_t)cur.pm * tstepA) + (size_t)cur.k0 * 2; const char* cB = (const char*)g.Bt + (size_t)cur.pn * tstepB + (size_t)cur.k0 * 2;
    S.a_ready(cur);
    if constexpr (GATHER) { PG8_IDX_DMA(cur, 0); asm volatile("s_waitcnt vmcnt(0)" ::: "memory"); PG8_IDX_READ(vAc, 0); }
    if constexpr (SP2) {
        PG8_STAGE(PG8_SB(0, 0), cB, voffB); PG8_STAGE(PG8_SB(0, 1), cB + hstepB, voffB); PG8_STAGE_A(PG8_SA(0, 0), cA, 0, false); PG8_STAGE_A(PG8_SA(0, 1), cA, 1, false);
        if (wr == 1) PG8_BAR;
        PG8_WAIT_V(2); PG8_BAR;
        PG8_STAGE(PG8_SB(1, 0), cB + kstep, voffB); PG8_STAGE_A(PG8_SA(1, 0), cA + kstep, 0, false); PG8_STAGE(PG8_SB(1, 1), cB + hstepB + kstep, voffB);
        PG8_WAIT_V(6); PG8_BAR;
    } else {
        PG8_STAGE(PG8_SB(0, 0), cB, voffB); PG8_STAGE(PG8_SA(0, 0), cA, voffA); PG8_STAGE(PG8_SB(0, 1), cB + hstepB, voffB); PG8_STAGE(PG8_SA(0, 1), cA + hstepA, voffA);
        if (wr == 1) PG8_BAR;
        PG8_WAIT_V(4); PG8_BAR;
        PG8_STAGE(PG8_SB(1, 0), cB + kstep, voffB); PG8_STAGE(PG8_SA(1, 0), cA + kstep, voffA); PG8_STAGE(PG8_SB(1, 1), cB + hstepB + kstep, voffB);
        PG8_WAIT_V(6); PG8_BAR;
    }
    for (;;) {
        const bool has_next = S.next(ui + 1, nxt);
        const char* nA = has_next ? (const char*)g.A + (GATHER ? (size_t)0 : (size_t)nxt.pm * tstepA) + (size_t)nxt.k0 * 2 : cA; const char* nB = has_next ? (const char*)g.Bt + (size_t)nxt.pn * tstepB + (size_t)nxt.k0 * 2 : cB;
        if constexpr (GATHER) { if (has_next) PG8_IDX_DMA(nxt, (ui + 1) & 1); }
        for (int t = 0; t < nt; t += 2) {
            const bool last = (t == nt - 2); const bool lnx = last && has_next;
            const char* a1 = cA + (size_t)(t + 1) * kstep;
            const char* a2 = last ? nA : cA + (size_t)(t + 2) * kstep; const char* b2 = last ? nB : cB + (size_t)(t + 2) * kstep;
            const char* a3 = a2 + kstep; const char* b3 = b2 + kstep;
            if (last && has_next) S.a_ready(nxt);
            if constexpr (GATHER) { if (lnx) PG8_IDX_READ(vAn, (ui + 1) & 1); }
            if constexpr (SP2) {
            PG8_LDB(B0, 0, 0); PG8_LDB(B1, 0, 1); PG8_SCHED; PG8_LDA(At, 0, 0); PG8_STAGE_A(PG8_SA(1, 1), a1, 1, false);
            PG8_WAIT_V(8); PG8_WAIT_L(0); PG8_BAR; PG8_MMA(0, 0, At, B0); PG8_MMA(0, 1, At, B1); PG8_BAR; PG8_SCHED;
            PG8_LDA(At, 0, 1); PG8_STAGE(PG8_SB(0, 0), b2, voffB); PG8_STAGE(PG8_SB(0, 1), b2 + hstepB, voffB); PG8_STAGE_A(PG8_SA(0, 0), a2, 0, lnx);
            PG8_WAIT_V(8); PG8_WAIT_L(0); PG8_BAR; PG8_MMA(1, 0, At, B0); PG8_MMA(1, 1, At, B1); PG8_BAR; PG8_SCHED;
            PG8_LDB(B0, 1, 0); PG8_LDB(B1, 1, 1); PG8_SCHED; PG8_LDA(At, 1, 0); PG8_STAGE_A(PG8_SA(0, 1), a2, 1, lnx);
            PG8_WAIT_V(8); PG8_WAIT_L(0); PG8_BAR; PG8_MMA(0, 0, At, B0); PG8_MMA(0, 1, At, B1); PG8_BAR; PG8_SCHED;
            PG8_LDA(At, 1, 1); PG8_STAGE(PG8_SB(1, 0), b3, voffB); PG8_STAGE(PG8_SB(1, 1), b3 + hstepB, voffB); PG8_STAGE_A(PG8_SA(1, 0), a3, 0, lnx);
            PG8_WAIT_V(8); PG8_WAIT_L(0); PG8_BAR; PG8_MMA(1, 0, At, B0); PG8_MMA(1, 1, At, B1); PG8_BAR; PG8_SCHED;
            } else {
            PG8_LDB(B0, 0, 0); PG8_SCHED; PG8_LDA(At, 0, 0); PG8_STAGE(PG8_SA(1, 1), a1 + hstepA, voffA);
            PG8_WAIT_L(8); PG8_BAR; PG8_WAIT_L(0); PG8_MMA(0, 0, At, B0); PG8_BAR; PG8_SCHED;
            PG8_LDB(B1, 0, 1); PG8_STAGE(PG8_SB(0, 0), b2, voffB);
            PG8_BAR; PG8_WAIT_L(0); PG8_MMA(0, 1, At, B1); PG8_BAR;
            PG8_LDA(At, 0, 1); PG8_STAGE(PG8_SA(0, 0), a2, voffA);
            PG8_BAR; PG8_WAIT_L(0); PG8_MMA(1, 0, At, B0); PG8_BAR; PG8_SCHED;
            PG8_STAGE(PG8_SB(0, 1), b2 + hstepB, voffB);
            PG8_WAIT_V(6); PG8_BAR; PG8_MMA(1, 1, At, B1); PG8_BAR;
            PG8_LDB(B0, 1, 0); PG8_SCHED; PG8_LDA(At, 1, 0); PG8_STAGE(PG8_SA(0, 1), a2 + hstepA, voffA);
            PG8_WAIT_L(8); PG8_BAR; PG8_WAIT_L(0); PG8_MMA(0, 0, At, B0); PG8_BAR; PG8_SCHED;
            PG8_LDB(B1, 1, 1); PG8_STAGE(PG8_SB(1, 0), b3, voffB);
            PG8_BAR; PG8_WAIT_L(0); PG8_MMA(0, 1, At, B1); PG8_BAR;
            PG8_LDA(At, 1, 1); PG8_STAGE(PG8_SA(1, 0), a3, voffA);
            PG8_BAR; PG8_WAIT_L(0); PG8_MMA(1, 0, At, B0); PG8_BAR; PG8_SCHED;
            PG8_STAGE(PG8_SB(1, 1), b3 + hstepB, voffB);
            PG8_WAIT_V(6); PG8_BAR; PG8_MMA(1, 1, At, B1); PG8_BAR;
            }
        }
        if constexpr (ALIGN_EPI) { if (wr == 0) PG8_BAR; }
        if constexpr (!Epi::AFTER_DRAIN) { int t2_ = threadIdx.x; asm volatile("" : "+v"(t2_)); const int fr2_ = t2_ & 15, fq2_ = (t2_ >> 4) & 3;
            E(acc, cur, wr, wc, fr2_, fq2_); S.done(cur); }
        if (!has_next) break;
#pragma unroll
        for (int a = 0; a < 2; ++a)
#pragma unroll
            for (int b = 0; b < 2; ++b)
#pragma unroll
                for (int m = 0; m < 4; ++m)
#pragma unroll
                    for (int n = 0; n < 2; ++n) acc[a][b][m][n] = (f32x4){zf_, zf_, zf_, zf_};
        cur = nxt; cA = nA; cB = nB; ++ui;
        if constexpr (GATHER) { vAc[0][0] = vAn[0][0]; vAc[0][1] = vAn[0][1]; vAc[1][0] = vAn[1][0]; vAc[1][1] = vAn[1][1]; }
        if constexpr (ALIGN_EPI) { if (wr == 1) PG8_BAR; }
    }
    PG8_WAIT_V(0);
    if constexpr (!ALIGN_EPI) { if (wr == 0) PG8_BAR; }
    PG8_BAR;
    if constexpr (Epi::AFTER_DRAIN) { E.fused(acc, cur, wr, wc, fr, fq, lds, wid, lane); S.done(cur); }
#undef PG8_SA
#undef PG8_SB
#undef PG8_STAGE
#undef PG8_STAGE_A
#undef PG8_IDX_DMA
#undef PG8_IDX_READ
#undef PG8_LDA
#undef PG8_LDB
#undef PG8_MMA
#undef PG8_WAIT_V
#undef PG8_WAIT_L
#undef PG8_BAR
#undef PG8_SCHED
}
}

typedef unsigned short bf16_t;
typedef short bf16x8 __attribute__((ext_vector_type(8)));
typedef short s16x4 __attribute__((ext_vector_type(4)));
typedef float f32x4 __attribute__((ext_vector_type(4)));
typedef float f32x16 __attribute__((ext_vector_type(16)));
typedef unsigned u32x4 __attribute__((ext_vector_type(4)));
typedef unsigned u32x2 __attribute__((ext_vector_type(2)));
#define LAS __attribute__((address_space(3)))
#define GAS __attribute__((address_space(1)))

constexpr int D = 1024, NB = 8, SEQ = 4096, NMETA = 16;
constexpr int RREAL = NB * SEQ;
constexpr int RVALID = RREAL + NMETA;
constexpr int NPAN = 129, RP = NPAN * 256;
constexpr int PMW = 1024, PRW = 1792;
constexpr int CW = 512;
constexpr int FF0 = 2816, FFE = 3584, NEXP = 8;
constexpr float RMS_EPS = 1e-6f, GN_EPS = 64e-5f;
constexpr int MOE_MAXPAN = 144;
constexpr int MOE_TAILPAN = 128, MOE_GAP = 8;
#ifndef MOE_CSKIP
#define MOE_CSKIP 5
#endif

typedef float f32x2_t __attribute__((ext_vector_type(2))); typedef __bf16 bf16x2_t __attribute__((ext_vector_type(2)));
__device__ __forceinline__ unsigned cvtpk(float lo, float hi) { f32x2_t v = {lo, hi}; bf16x2_t b = __builtin_convertvector(v, bf16x2_t); return __builtin_bit_cast(unsigned, b); }
__device__ __forceinline__ bf16_t f2bf_hw(float x) { return (bf16_t)(cvtpk(x, x) & 0xffffu); }
__device__ __forceinline__ float bf2f(bf16_t b) { return __uint_as_float(((unsigned)b) << 16); }
__device__ __forceinline__ bf16_t f2bf(float f) { unsigned u = __float_as_uint(f); u += 0x7fffu + ((u >> 16) & 1u); return (bf16_t)(u >> 16); }
__device__ __forceinline__ unsigned pk2(float lo, float hi) { return (unsigned)f2bf(lo) | ((unsigned)f2bf(hi) << 16); }
#define DPP_F(v_, ctrl_, rmask_) __int_as_float(__builtin_amdgcn_update_dpp(0, __float_as_int(v_), (ctrl_), (rmask_), 0xf, false))
__device__ __forceinline__ float wave_sum(float v) {
    v += DPP_F(v, 0xB1, 0xf); v += DPP_F(v, 0x4E, 0xf); v += DPP_F(v, 0x141, 0xf); v += DPP_F(v, 0x140, 0xf);
    v += DPP_F(v, 0x142, 0xa); v += DPP_F(v, 0x143, 0xc);
    return __int_as_float(__builtin_amdgcn_readlane(__float_as_int(v), 63));
}
__device__ __forceinline__ float wave_max(float v) {
    v = fmaxf(v, DPP_F(v, 0xB1, 0xf)); v = fmaxf(v, DPP_F(v, 0x4E, 0xf)); v = fmaxf(v, DPP_F(v, 0x141, 0xf)); v = fmaxf(v, DPP_F(v, 0x140, 0xf));
    v = fmaxf(v, DPP_F(v, 0x142, 0xa)); v = fmaxf(v, DPP_F(v, 0x143, 0xc));
    return __int_as_float(__builtin_amdgcn_readlane(__float_as_int(v), 63));
}
constexpr float F8_MAX = 448.0f, F8_ACT = 8.0f;
__device__ __forceinline__ unsigned pk4_f8(float a, float b, float c, float d) {
    float mx = F8_MAX; asm volatile("" : "+v"(mx));
    a = __builtin_amdgcn_fmed3f(a, -mx, mx); b = __builtin_amdgcn_fmed3f(b, -mx, mx); c = __builtin_amdgcn_fmed3f(c, -mx, mx); d = __builtin_amdgcn_fmed3f(d, -mx, mx);
    int r = __builtin_amdgcn_cvt_pk_fp8_f32(a, b, 0, false); r = __builtin_amdgcn_cvt_pk_fp8_f32(c, d, r, true); return (unsigned)r; }
__device__ __forceinline__ float moe_wscale(const unsigned* ctl, int t, int e);
__device__ __forceinline__ float quad_sum(float v) { v += DPP_F(v, 0xB1, 0xf); v += DPP_F(v, 0x4E, 0xf); return v; }
__device__ __forceinline__ float sigmoidf_(float x) { return 1.0f / (1.0f + __expf(-x)); }
__device__ __forceinline__ int row_pos(int row) { return row < RREAL ? NMETA + (row & (SEQ - 1)) : row - RREAL; }
__device__ __forceinline__ int row_prev(int row) { if (row < RREAL) return (row & (SEQ - 1)) ? row - 1 : RVALID - 1; return row == RREAL ? -1 : row - 1; }

constexpr size_t MiB = 1u << 20;
constexpr size_t WS_CTL = 0;
constexpr size_t WS_HMETA = 1 * MiB;
constexpr size_t WS_WB = 2 * MiB;
constexpr size_t LW_STRIDE = 10 * MiB;
constexpr size_t LW_WIN = 0, LW_WUQ = LW_WIN + (size_t)2816 * 1024 * 2, LW_WK = LW_WUQ + (size_t)768 * 512 * 2, LW_WV = LW_WK + (size_t)512 * 256 * 2,
                 LW_LORA = LW_WV + (size_t)512 * 256 * 2, LW_WOUT = LW_LORA + (size_t)1536 * 256 * 2, LW_END = LW_WOUT + (size_t)1024 * 1024 * 2;
static_assert(LW_END <= LW_STRIDE, "layer weights");
constexpr size_t WS_V1T = WS_WB + 2 * LW_STRIDE, WS_V2T = WS_V1T + (size_t)256 * 512 * 2, WS_FGU = WS_V2T + (size_t)512 * 256 * 2,
                 WS_FDN = WS_FGU + (size_t)5632 * 1024 * 2, WS_ROPE = WS_FDN + (size_t)1024 * 2816 * 2, WS_WB_END = WS_ROPE + (size_t)4112 * 64 * 4;
constexpr size_t WS_TB = WS_FGU;
constexpr size_t WS_ARENA = 41 * MiB;
static_assert(WS_WB_END <= WS_ARENA, "weights fit");
static_assert((size_t)8 * 256 * 1024 * 4 <= (size_t)5632 * 1024 * 2, "list-1 tail buffer fits the dense gate/up weight slot");
constexpr size_t SZ_R1024 = (size_t)RP * 1024 * 2, SZ_R512 = (size_t)RP * 512 * 2, SZ_R256 = (size_t)RP * 256 * 2;
constexpr size_t A_U = WS_ARENA;
constexpr size_t A_KN = A_U + SZ_R1024;
constexpr size_t A_VT = A_KN + SZ_R512;
constexpr size_t A_LOUT = A_U, A_VMIX = A_VT;
static_assert((size_t)RP * 1536 * 2 == SZ_R1024 + SZ_R512, "LORA_OUT fills the U and KN slots exactly");
constexpr size_t A_PM = A_VT + SZ_R512;
constexpr size_t A_PR = A_PM + SZ_R1024;
constexpr size_t A_SMALL = A_PR + (size_t)RP * PRW * 2;
constexpr size_t A_RSTDQ = A_SMALL, A_RSTDKV = A_RSTDQ + (size_t)RP * 4, A_KROPE = A_RSTDKV + (size_t)RP * 4, A_SMALL_END = A_KROPE + (size_t)RP * 64 * 2;
constexpr size_t A_LIN = (A_SMALL_END + 4095) & ~(size_t)4095;
constexpr size_t A_VSH = A_LIN + SZ_R256;
constexpr size_t A_CHK = A_LIN;
constexpr size_t SZ_CHK = (size_t)258 * 8 * 32768;
constexpr size_t A_VFIRST = (A_CHK + SZ_CHK > A_VSH + SZ_R512 ? A_CHK + SZ_CHK : A_VSH + SZ_R512);
constexpr size_t A_VP = A_VFIRST + SZ_R512;
constexpr size_t A_RK = A_VP + SZ_R512;
constexpr size_t A_YS = A_RK + (size_t)RP * 8 * 4;
constexpr size_t A_SCST = A_YS + SZ_R512;
constexpr size_t A_PART = A_SCST + (size_t)64 * 4096 * 4;
constexpr size_t A_END1 = A_PART + (size_t)11 * NMETA * 1024 * 4;
constexpr size_t A_ACT0 = A_PM;
constexpr size_t A_MGU = A_KN;
constexpr size_t A_MDN = A_MGU + (size_t)NEXP * 7168 * 1024 * 2;
constexpr size_t A_MTAB = A_MDN + (size_t)NEXP * 1024 * 3584 * 2;
constexpr size_t MT_E = 0, MT_G = MT_E + (size_t)2 * RREAL * 4, MT_STOK = MT_G + (size_t)2 * RREAL * 4, MT_TSLOT = MT_STOK + (size_t)2 * MOE_MAXPAN * 256 * 4  , MT_SGATE = MT_TSLOT + (size_t)RREAL * 4,
                 MT_BE = MT_SGATE + (size_t)2 * MOE_MAXPAN * 256 * 4, MT_END = MT_BE + 2 * 256 * 4;
constexpr size_t A_MACT = (A_MTAB + MT_END + 4095) & ~(size_t)4095;
constexpr size_t XB_LIST = (size_t)MOE_MAXPAN * 256 * 1024;
constexpr size_t A_XB = A_MACT + (size_t)MOE_MAXPAN * 256 * FFE;
static_assert(A_XB + 2 * XB_LIST <= A_MACT + (size_t)MOE_MAXPAN * 256 * FFE * 2, "XB inside the old activation footprint");
constexpr size_t A_END2 = A_MACT + (size_t)MOE_MAXPAN * 256 * FFE * 2;
constexpr size_t WS_NEED = (A_END1 > A_END2 ? A_END1 : A_END2);
static_assert(WS_NEED <= 557619232ull, "workspace budget (sum of the inputs' bytes)");
static_assert(A_ACT0 + (size_t)RP * FF0 * 2 <= A_SMALL, "dense act overlay");
constexpr int CW_CNT = 64;
constexpr int CW_FILL = 128;
constexpr int CW_NPAN = 192;
constexpr int CW_WINV = 16448;
constexpr int CW_WMAX = 16384;
constexpr int CW_WGCNT = 8192;


__device__ __forceinline__ unsigned long long kp_uniform(unsigned long long kp) { const unsigned lo = __builtin_amdgcn_readfirstlane((unsigned)kp), hi = __builtin_amdgcn_readfirstlane((unsigned)(kp >> 32)); return ((unsigned long long)hi << 32) | lo; }
__device__ __forceinline__ const void* ldk(unsigned long long kp, int off) { unsigned long long v;
    asm volatile("s_load_dwordx2 %0, %1, %2\n\ts_waitcnt lgkmcnt(0)" : "=s"(v) : "s"(kp), "i"(off) : "memory"); return (const void*)v; }
__device__ __forceinline__ int opq(int v) { asm volatile("" : "+v"(v)); return v; }
__device__ __forceinline__ int opqs(int v) { asm volatile("" : "+s"(v)); return v; }
__device__ __forceinline__ void lds_barrier() { asm volatile("s_waitcnt lgkmcnt(0)\n\ts_barrier" ::: "memory"); }

__device__ __forceinline__ float moe_wscale_bits(unsigned bits) { const float m = __uint_as_float(bits);
    return m > 0.f ? __builtin_amdgcn_exp2f(floorf(__builtin_amdgcn_logf(224.0f / m))) : 1.0f; }
__device__ __forceinline__ float moe_wscale(const unsigned* ctl, int t, int e) { return moe_wscale_bits((unsigned)__builtin_amdgcn_readfirstlane((int)ctl[CW_WMAX + t * 8 + e])); }
#define XB_TMO      128
#define XB_XCNT(j)  (256  + 64 * (j))
#define XB_XSUB(j)  (1280 + 64 * (j))
#define XB_XGEN(j)  (2304 + 64 * (j))
#define XB_TOP      3328
#define XB_TOPGEN   3392
#define XCD_BAR_WORDS 3456
#define XB_SPIN_CAP (1u << 18)

__device__ __forceinline__ unsigned xb_ld(unsigned* p)              { return __hip_atomic_load(p, __ATOMIC_RELAXED, __HIP_MEMORY_SCOPE_AGENT); }
__device__ __forceinline__ unsigned xb_add(unsigned* p, unsigned v) { return __hip_atomic_fetch_add(p, v, __ATOMIC_RELAXED, __HIP_MEMORY_SCOPE_AGENT); }
__device__ __forceinline__ unsigned xb_xcc_id() { return (unsigned)__builtin_amdgcn_s_getreg((3 << 11) | 20) & 0xFu; }
#define XB_SPIN(cond, bar) do { unsigned _sp = 0; while (cond) { __builtin_amdgcn_s_sleep(1); \
    if ((++_sp & 255u) == 0u) { if (xb_ld(&(bar)[XB_TMO])) break; if (_sp > XB_SPIN_CAP) { atomicAdd(&(bar)[XB_TMO], 1u); break; } } } } while (0)

struct XcdBarrier {
    unsigned* bar; unsigned x;
    volatile LAS unsigned* st;
};

__device__ __forceinline__ XcdBarrier xcd_barrier_post(unsigned* bar, volatile LAS unsigned* st) {
    XcdBarrier b; b.bar = bar; b.x = xb_xcc_id(); b.st = st;
    if (threadIdx.x == 0) (void)xb_add(&bar[XB_XCNT(b.x)], 1u);
    return b;
}
__device__ __forceinline__ void xcd_barrier_complete(unsigned* bar, unsigned x, unsigned& nloc, unsigned& nx) {
    const unsigned G = gridDim.x * gridDim.y * gridDim.z;
    unsigned sum, cnt, mine, sp = 0u;
    for (;;) {
        sum = 0u; cnt = 0u; mine = 0u;
#pragma unroll
        for (unsigned j = 0; j < 16; ++j) { const unsigned c = xb_ld(&bar[XB_XCNT(j)]); sum += c; cnt += (c > 0u) ? 1u : 0u; mine = (j == x) ? c : mine; }
        if (sum == G) break;
        __builtin_amdgcn_s_sleep(1);
        if ((++sp & 255u) == 0u) { if (xb_ld(&bar[XB_TMO])) break; if (sp > XB_SPIN_CAP) { atomicAdd(&bar[XB_TMO], 1u); break; } }
    }
    nloc = mine > 0u ? mine : 1u; nx = cnt > 0u ? cnt : 1u;
}

__device__ __attribute__((noinline)) void xcd_barrier_fn(unsigned* bar_, unsigned x_, volatile LAS unsigned* st_) {
    XcdBarrier b; b.bar = bar_; b.x = x_; b.st = st_;
    asm volatile("s_waitcnt vmcnt(0)" ::: "memory");
    __syncthreads();
    if (threadIdx.x == 0) {
        unsigned* bar = b.bar;
        __builtin_amdgcn_s_waitcnt(0);
        unsigned nloc = b.st[0], nx = b.st[1];
        if (nloc == 0u) { xcd_barrier_complete(bar, b.x, nloc, nx); b.st[0] = nloc; b.st[1] = nx; }
        const unsigned old = xb_add(&bar[XB_XSUB(b.x)], 1u);
        const unsigned gen = old / nloc;
        if (old + 1u == (gen + 1u) * nloc) {
            __builtin_amdgcn_fence(__ATOMIC_RELEASE, "agent");
            asm volatile("s_waitcnt vmcnt(0)" ::: "memory");
            const unsigned og = xb_add(&bar[XB_TOP], 1u);
            const unsigned tg = og / nx;
            if (og + 1u == (tg + 1u) * nx) xb_add(&bar[XB_TOPGEN], 1u);
            else XB_SPIN(xb_ld(&bar[XB_TOPGEN]) == tg, bar);
            __builtin_amdgcn_fence(__ATOMIC_ACQUIRE, "agent");
            xb_add(&bar[XB_XGEN(b.x)], 1u);
            asm volatile("s_waitcnt vmcnt(0)" ::: "memory");
        } else {
            XB_SPIN(xb_ld(&bar[XB_XGEN(b.x)]) == gen, bar);
            __builtin_amdgcn_fence(__ATOMIC_ACQUIRE, "agent");
            asm volatile("s_waitcnt vmcnt(0)" ::: "memory");
        }
    }
    __syncthreads();
}

__device__ __forceinline__ void xcd_barrier(const XcdBarrier& b) { xcd_barrier_fn(b.bar, b.x, b.st); }
using pg8::Unit;
struct EpiInProj { static constexpr bool PERM = true, AFTER_DRAIN = false; bf16_t* PM; bf16_t* PR;
    __device__ __forceinline__ void operator()(const f32x4 (&acc)[2][2][4][2], const Unit& u, int wr, int wc, int fr, int fq) const {
        const int row0 = u.pm * 256 + wr * 64 + fr; bf16_t* base; int ld, colt;
        if (u.pn < 4) { base = PM; ld = PMW; colt = u.pn * 256; } else { base = PR; ld = PRW; colt = (u.pn - 4) * 256; }
        const int col0 = colt + wc * 32 + 8 * fq;
#pragma unroll
        for (int ai = 0; ai < 2; ++ai)
#pragma unroll
            for (int m = 0; m < 4; ++m) { bf16_t* rowp = base + (size_t)(row0 + ai * 128 + m * 16) * ld + col0;
#pragma unroll
                for (int bj = 0; bj < 2; ++bj) { const f32x4 v0 = acc[ai][bj][m][0], v1 = acc[ai][bj][m][1];
                    u32x4 w; w.x = pg8::cvt_pk_bf16(v0[0], v0[1]); w.y = pg8::cvt_pk_bf16(v0[2], v0[3]); w.z = pg8::cvt_pk_bf16(v1[0], v1[1]); w.w = pg8::cvt_pk_bf16(v1[2], v1[3]);
                    *(u32x4*)(rowp + bj * 128) = w; } }
    }
};
struct EpiRowScale { static constexpr bool PERM = true, AFTER_DRAIN = false; bf16_t* O; const float* rs; int ldc, pad;
    __device__ __forceinline__ void operator()(const f32x4 (&acc)[2][2][4][2], const Unit& u, int wr, int wc, int fr, int fq) const {
        const int row0 = u.pm * 256 + wr * 64 + fr; const int col0 = u.pn * 256 + wc * 32 + 8 * fq;
#pragma unroll
        for (int ai = 0; ai < 2; ++ai)
#pragma unroll
            for (int m = 0; m < 4; ++m) { const int row = row0 + ai * 128 + m * 16; const float s = rs ? rs[row] : 1.f; bf16_t* rowp = O + (size_t)row * ldc + col0;
#pragma unroll
                for (int bj = 0; bj < 2; ++bj) { const f32x4 v0 = acc[ai][bj][m][0] * s, v1 = acc[ai][bj][m][1] * s;
                    u32x4 w; w.x = pg8::cvt_pk_bf16(v0[0], v0[1]); w.y = pg8::cvt_pk_bf16(v0[2], v0[3]); w.z = pg8::cvt_pk_bf16(v1[0], v1[1]); w.w = pg8::cvt_pk_bf16(v1[2], v1[3]);
                    *(u32x4*)(rowp + bj * 128) = w; } }
    }
};
struct EpiColScale { static constexpr bool PERM = true, AFTER_DRAIN = false; bf16_t* O; const float* cs; int ldc, pad;
    __device__ __forceinline__ void operator()(const f32x4 (&acc)[2][2][4][2], const Unit& u, int wr, int wc, int fr, int fq) const {
        const int row0 = u.pm * 256 + wr * 64 + fr; const int col0 = u.pn * 256 + wc * 32 + 8 * fq;
        f32x4 sc[2][2];
#pragma unroll
        for (int bj = 0; bj < 2; ++bj) { sc[bj][0] = *(const f32x4*)(cs + col0 + bj * 128); sc[bj][1] = *(const f32x4*)(cs + col0 + bj * 128 + 4); }
#pragma unroll
        for (int ai = 0; ai < 2; ++ai)
#pragma unroll
            for (int m = 0; m < 4; ++m) { bf16_t* rowp = O + (size_t)(row0 + ai * 128 + m * 16) * ldc + col0;
#pragma unroll
                for (int bj = 0; bj < 2; ++bj) { const f32x4 v0 = acc[ai][bj][m][0] * sc[bj][0], v1 = acc[ai][bj][m][1] * sc[bj][1];
                    u32x4 w; w.x = pg8::cvt_pk_bf16(v0[0], v0[1]); w.y = pg8::cvt_pk_bf16(v0[2], v0[3]); w.z = pg8::cvt_pk_bf16(v1[0], v1[1]); w.w = pg8::cvt_pk_bf16(v1[2], v1[3]);
                    *(u32x4*)(rowp + bj * 128) = w; } }
    }
};
struct EpiResid { static constexpr bool PERM = false, AFTER_DRAIN = false; float* out; float* hmeta; const float* src; float scale; int pad;
    __device__ __forceinline__ void operator()(const f32x4 (&acc)[2][2][4][2], const Unit& u, int wr, int wc, int fr, int fq) const {
        const int rl = wr * 64 + fr, col0 = u.pn * 256 + wc * 32 + 4 * fq;
        float* base = u.pm < 128 ? out + (size_t)u.pm * 256 * D : hmeta; const float* sbase = u.pm < 128 ? src + (size_t)u.pm * 256 * D : hmeta;
#pragma unroll
        for (int ai = 0; ai < 2; ++ai)
#pragma unroll
            for (int m = 0; m < 4; ++m) { const size_t ro = (size_t)(rl + ai * 128 + m * 16) * D + col0;
#pragma unroll
                for (int bj = 0; bj < 2; ++bj)
#pragma unroll
                    for (int n = 0; n < 2; ++n) { const f32x4 hv = *(const f32x4*)(sbase + ro + bj * 128 + n * 16); *(f32x4*)(base + ro + bj * 128 + n * 16) = hv + acc[ai][bj][m][n] * scale; }
                asm volatile("" ::: "memory"); }
    }
};
struct EpiSwiGLU { static constexpr bool PERM = true, AFTER_DRAIN = false; bf16_t* O; int ldc, nmod, pn_off, pad;
    __device__ __forceinline__ void operator()(const f32x4 (&acc)[2][2][4][2], const Unit& u, int wr, int wc, int fr, int fq) const {
        const int row0 = u.pm * 256 + wr * 64 + fr; const int pnl = (u.pn % nmod) - pn_off; const int col0 = pnl * 128 + wc * 32 + 8 * fq;
#pragma unroll
        for (int ai = 0; ai < 2; ++ai)
#pragma unroll
            for (int m = 0; m < 4; ++m) { bf16_t* rowp = O + (size_t)(row0 + ai * 128 + m * 16) * ldc + col0; float r[8];
#pragma unroll
                for (int n = 0; n < 2; ++n)
#pragma unroll
                    for (int j = 0; j < 4; ++j) { const float g = acc[ai][0][m][n][j], up = acc[ai][1][m][n][j]; r[4 * n + j] = g / (1.0f + __expf(-g)) * up; }
                u32x4 w; w.x = pg8::cvt_pk_bf16(r[0], r[1]); w.y = pg8::cvt_pk_bf16(r[2], r[3]); w.z = pg8::cvt_pk_bf16(r[4], r[5]); w.w = pg8::cvt_pk_bf16(r[6], r[7]);
                *(u32x4*)rowp = w; }
    }
};
struct EpiSwiGLU8 { static constexpr bool PERM = false, AFTER_DRAIN = false; unsigned char* O; const unsigned* ctl; int ldc, nmod;
    __device__ __forceinline__ void operator()(const f32x4 (&acc)[2][2][4][2], const Unit& u, int wr, int wc, int fr, int fq) const {
        const int row0 = u.pm * 256 + wr * 64 + fr; const int e = u.pn / nmod, pnl = u.pn % nmod; const int col0 = pnl * 128 + wc * 32 + 4 * fq;
        const float ig = __uint_as_float(__builtin_amdgcn_readfirstlane((int)ctl[CW_WINV + e])), iu = __uint_as_float(__builtin_amdgcn_readfirstlane((int)ctl[CW_WINV + 8 + e])) * F8_ACT;
#pragma unroll
        for (int ai = 0; ai < 2; ++ai)
#pragma unroll
            for (int m = 0; m < 4; ++m) { unsigned char* rowp = O + (size_t)(row0 + ai * 128 + m * 16) * ldc + col0;
#pragma unroll
                for (int n = 0; n < 2; ++n) { float r[4];
#pragma unroll
                    for (int j = 0; j < 4; ++j) { const float g = acc[ai][0][m][n][j] * ig, up = acc[ai][1][m][n][j] * iu; r[j] = g / (1.0f + __expf(-g)) * up; }
                    *(unsigned*)(rowp + n * 16) = pk4_f8(r[0], r[1], r[2], r[3]); } }
    }
};
struct EpiMoeDown { static constexpr bool PERM = false, AFTER_DRAIN = false; float* out; const int* stok; const float* sgate; int nmod; float scale; const unsigned* ctl;
    __device__ __forceinline__ void operator()(const f32x4 (&acc)[2][2][4][2], const Unit& u, int wr, int wc, int fr, int fq) const {
        const int row0 = u.pm * 256 + wr * 64 + fr; const int col0 = (u.pn % nmod) * 256 + wc * 32 + 4 * fq;
        const float winv = ctl ? __uint_as_float(__builtin_amdgcn_readfirstlane((int)ctl[CW_WINV + 16 + u.pn / nmod])) : 1.0f;
#pragma unroll
        for (int ai = 0; ai < 2; ++ai)
#pragma unroll
            for (int m = 0; m < 4; ++m) { const int prow = row0 + ai * 128 + m * 16; const int tok = stok[prow]; if (tok < 0) continue; const float gt = sgate[prow] * scale * winv;
                float* rowp = out + (size_t)tok * D + col0;
#pragma unroll
                for (int bj = 0; bj < 2; ++bj)
#pragma unroll
                    for (int n = 0; n < 2; ++n) { f32x4* p = (f32x4*)(rowp + bj * 128 + n * 16); *p = *p + acc[ai][bj][m][n] * gt; }
                asm volatile("" ::: "memory"); }
    }
};
struct EpiMoeDownStore { static constexpr bool PERM = false, AFTER_DRAIN = false; float* tb; const int* stok; const float* sgate; int nmod, pm0; const unsigned* ctl;
    __device__ __forceinline__ void operator()(const f32x4 (&acc)[2][2][4][2], const Unit& u, int wr, int wc, int fr, int fq) const {
        const int row0 = u.pm * 256 + wr * 64 + fr; const int col0 = (u.pn % nmod) * 256 + wc * 32 + 4 * fq;
#pragma unroll
        for (int ai = 0; ai < 2; ++ai)
#pragma unroll
            for (int m = 0; m < 4; ++m) { const int prow = row0 + ai * 128 + m * 16; const int tok = stok[prow]; if (tok < 0) continue; const float gt = sgate[prow] * __uint_as_float(__builtin_amdgcn_readfirstlane((int)ctl[CW_WINV + 16 + u.pn / nmod]));
                float* rowp = tb + (size_t)(prow - pm0 * 256) * D + col0;
#pragma unroll
                for (int bj = 0; bj < 2; ++bj)
#pragma unroll
                    for (int n = 0; n < 2; ++n) *(f32x4*)(rowp + bj * 128 + n * 16) = acc[ai][bj][m][n] * gt; }
    }
};
struct MoeOrder { static constexpr bool GATHER = false; const int* block_e; const unsigned* npan; int nN, emul, pn_off, G, c, lmax;
    __device__ __forceinline__ bool next(int i, Unit& u) const { const int L = i * G + c; const int np = __builtin_amdgcn_readfirstlane((int)(*npan)); if (L >= np * nN || (lmax && L >= lmax)) return false;
        const int pm = L / nN; u.k0 = 0; u.pm = pm; u.pn = __builtin_amdgcn_readfirstlane(block_e[pm]) * emul + pn_off + (L % nN); return true; }
    __device__ __forceinline__ void a_ready(const Unit&) const {}
    __device__ __forceinline__ void done(const Unit&) const {}
};


struct EpiResidPartial { static constexpr bool PERM = false, AFTER_DRAIN = false; float* part;
    __device__ __forceinline__ void operator()(const f32x4 (&acc)[2][2][4][2], const Unit& u, int wr, int wc, int fr, int fq) const {
        const int rl = wr * 64 + fr, col0 = u.pn * 256 + wc * 32 + 4 * fq; float* base = part + (size_t)(u.k0 >> 8) * NMETA * D;
#pragma unroll
        for (int ai = 0; ai < 2; ++ai)
#pragma unroll
            for (int m = 0; m < 4; ++m) { const int row = rl + ai * 128 + m * 16; if (row >= NMETA) continue;
                float* rowp = base + (size_t)row * D + col0;
#pragma unroll
                for (int bj = 0; bj < 2; ++bj)
#pragma unroll
                    for (int n = 0; n < 2; ++n) *(f32x4*)(rowp + bj * 128 + n * 16) = acc[ai][bj][m][n]; }
    }
};
struct DenseTailOrder { static constexpr bool GATHER = false; int nN, nsl, G, c;
    __device__ __forceinline__ bool next(int i, Unit& u) const { const int idx = i * G + c; if (idx >= nN * nsl) return false; u.pm = 128; u.pn = idx / nsl; u.k0 = (idx % nsl) * 256; return true; }
    __device__ __forceinline__ void a_ready(const Unit&) const {}
    __device__ __forceinline__ void done(const Unit&) const {}
};
template <bool GA> struct MoeGatherOrderT { static constexpr bool GATHER = GA;
    const int* block_e; const unsigned* npan; const int* rows; int nN, emul, pn_off, G, c, zero_row;
    int pm_lo, pm_hi, gap, rot, T, cskip;
    __device__ __forceinline__ bool next(int i, Unit& u) const {
        int cc = c - rot; cc += cc < 0 ? G : 0;
        int L;
        if (T == 0) L = i * G + cc;
        else { const int W0 = G - T; if (cc < W0) L = i < cskip ? i * W0 + cc : cskip * W0 + (i - cskip) * G + cc; else L = cskip * W0 + i * G + cc; }
        int np = __builtin_amdgcn_readfirstlane((int)(*npan)); np = np < pm_hi ? np : pm_hi;
        const int pl = pm_lo + L / nN; if (pl >= np) return false;
        const int pm = pl + (pl >= MOE_TAILPAN ? gap : 0); u.k0 = 0; u.pm = pm; u.pn = __builtin_amdgcn_readfirstlane(block_e[pm]) * emul + pn_off + (L % nN); return true; }
    __device__ __forceinline__ void a_ready(const Unit&) const {}
    __device__ __forceinline__ void done(const Unit&) const {}
};
using MoeGatherOrder = MoeGatherOrderT<true>; using MoeSlotOrder = MoeGatherOrderT<false>;
struct MoeShiftTailOrder { static constexpr bool GATHER = false; const int* block_e; const unsigned* npan; int nN, emul, gap, wg_first, c, pad;
    __device__ __forceinline__ bool next(int i, Unit& u) const { const int t = wg_first - c; const int np = __builtin_amdgcn_readfirstlane((int)(*npan)); const int L = MOE_TAILPAN * nN + t;
        if (i > 0 || t < 0 || L >= np * nN) return false;
        const int pm = L / nN + gap; u.k0 = 0; u.pm = pm; u.pn = __builtin_amdgcn_readfirstlane(block_e[pm]) * emul + (L % nN); return true; }
    __device__ __forceinline__ void a_ready(const Unit&) const {}
    __device__ __forceinline__ void done(const Unit&) const {}
};

__device__ __forceinline__ int map_row(int mode, int n, int rowoff) {
    if (mode == 1) return n < 832 ? n : n + 192;
    if (mode == 2) return rowoff + (n >> 7) * 256 + (n & 127);
    if (mode == 3) return rowoff + (n >> 7) * 256 + 128 + (n & 127);
    if (mode == 4) return (n >> 8) * 128 + (n & 127) + ((n & 128) ? 512 : 0);
    return rowoff + n;
}
__device__ __forceinline__ void transpose_item(const float* __restrict__ W, int K, int N, bf16_t* __restrict__ dst, int ld, int koff, int mode, int rowoff, const float* __restrict__ gain, LAS float* scr, int item, int lane) {
    const int nblk = N / 32; const int kb = item / nblk, nb = item % nblk, k0 = 64 * kb, n0 = 32 * nb;
#pragma unroll 8
    for (int i = 0; i < 32; ++i) { const int kk = 2 * i + (lane >> 5); float v = W[(size_t)(k0 + kk) * N + n0 + (lane & 31)]; if (gain) v *= gain[k0 + kk]; scr[kk * 33 + (lane & 31)] = v; }
    asm volatile("s_waitcnt lgkmcnt(0)" ::: "memory");
    const int c = lane & 7;
#pragma unroll
    for (int j = 0; j < 4; ++j) { const int n = (lane >> 3) + 8 * j; const LAS float* s = scr + (8 * c) * 33 + n;
        u32x4 o; o.x = pk2(s[0 * 33], s[1 * 33]); o.y = pk2(s[2 * 33], s[3 * 33]); o.z = pk2(s[4 * 33], s[5 * 33]); o.w = pk2(s[6 * 33], s[7 * 33]);
        *(u32x4*)(dst + (size_t)map_row(mode, n0 + n, rowoff) * ld + koff + k0 + 8 * c) = o; }
    asm volatile("s_waitcnt lgkmcnt(0)" ::: "memory");
}
__device__ __forceinline__ void transpose_item_f8(const float* __restrict__ W, int K, int N, unsigned char* __restrict__ dst, int ld, int mode, int rowoff, float scale, LAS float* scr, int item, int lane) {
    const int nblk = N / 32; const int kb = item / nblk, nb = item % nblk, k0 = 64 * kb, n0 = 32 * nb;
#pragma unroll 8
    for (int i = 0; i < 32; ++i) { const int kk = 2 * i + (lane >> 5); scr[kk * 33 + (lane & 31)] = W[(size_t)(k0 + kk) * N + n0 + (lane & 31)] * scale; }
    asm volatile("s_waitcnt lgkmcnt(0)" ::: "memory");
    const int c = lane & 7;
#pragma unroll
    for (int j = 0; j < 4; ++j) { const int n = (lane >> 3) + 8 * j; const LAS float* s = scr + (8 * c) * 33 + n;
        u32x2 o; o.x = pk4_f8(s[0 * 33], s[1 * 33], s[2 * 33], s[3 * 33]); o.y = pk4_f8(s[4 * 33], s[5 * 33], s[6 * 33], s[7 * 33]);
        *(u32x2*)(dst + (size_t)map_row(mode, n0 + n, rowoff) * ld + k0 + 8 * c) = o; }
    asm volatile("s_waitcnt lgkmcnt(0)" ::: "memory");
}
struct TrJob8 { const float* W; unsigned char* dst; int K, N, ld, mode, rowoff; float scale; };
__device__ __forceinline__ void ph_transpose_f8(const TrJob8& J, LAS float* scr, int gw, int ngw, int lane) {
    lane = opq(lane);
    const int nitems = (J.K / 64) * (J.N / 32);
    for (int it = gw; it < nitems; it += ngw) transpose_item_f8(J.W, J.K, J.N, J.dst, J.ld, J.mode, J.rowoff, J.scale, scr, it, lane);
}
struct TrJob { const float* W; const float* gain; bf16_t* dst; int K, N, ld, koff, mode, rowoff; };
__device__ __forceinline__ void ph_transpose(const TrJob& J, LAS float* scr, int gw, int ngw, int lane) {
    lane = opq(lane);
    const int nitems = (J.K / 64) * (J.N / 32);
    for (int it = gw; it < nitems; it += ngw) transpose_item(J.W, J.K, J.N, J.dst, J.ld, J.koff, J.mode, J.rowoff, J.gain, scr, it, lane);
}
__device__ __forceinline__ const float* hrow_c(const float* out, const float* hmeta, int row) { return row < RREAL ? out + (size_t)row * D : hmeta + (size_t)(row - RREAL) * D; }
__device__ __forceinline__ void ph_init(const float* __restrict__ x, const float* __restrict__ meta, float* __restrict__ out, float* __restrict__ hmeta, float* __restrict__ rope,
                                        const float* __restrict__ v1, const float* __restrict__ v2, bf16_t* __restrict__ v12t, size_t gt, size_t ngt) {
    (void)x; (void)out;
    for (size_t i = gt; i < (size_t)256 * D; i += ngt) hmeta[i] = i < (size_t)NMETA * D ? meta[i] : 0.f;
    for (size_t i = gt; i < (size_t)4112 * 32; i += ngt) { const int pos = (int)(i / 32), j = (int)(i % 32);
        const float inv = powf(10000.0f, -(float)j / 32.0f); const float ang = (float)pos * inv; rope[2 * i] = cosf(ang); rope[2 * i + 1] = sinf(ang); }
    for (size_t i = gt; i < (size_t)512 * 512; i += ngt) { const int n = (int)(i >> 9), k = (int)(i & 511); float s = 0.f;
#pragma unroll 8
        for (int j = 0; j < 32; ++j) s += v1[k * 32 + j] * v2[j * 512 + n];
        v12t[i] = f2bf(s); }
}
__device__ __forceinline__ void ph_rmsnorm(const float* __restrict__ out, const float* hmeta, const float* __restrict__ g, bf16_t* __restrict__ U, const float* __restrict__ part, int nsl, int gw, int ngw, int lane) {
    lane = opq(lane);
    for (int row = gw; row < RP; row += ngw) {
        unsigned long long* o8 = (unsigned long long*)(U + (size_t)row * D) + lane;
        if (row >= RVALID) {
#pragma unroll
            for (int j = 0; j < 4; ++j) o8[64 * j] = 0ull;
            continue; }
        const f32x4* xr = (const f32x4*)hrow_c(out, hmeta, row) + lane; const f32x4* g4 = (const f32x4*)g + lane;
        f32x4 v[4]; float s = 0.f;
#pragma unroll
        for (int j = 0; j < 4; ++j) v[j] = xr[64 * j];
        if (row >= RREAL && nsl > 0) {
            for (int sl = 0; sl < nsl; ++sl) { const f32x4* pr = (const f32x4*)(part + ((size_t)sl * NMETA + (row - RREAL)) * D) + lane;
#pragma unroll
                for (int j = 0; j < 4; ++j) v[j] = v[j] + pr[64 * j]; }
            f32x4* hw = (f32x4*)xr;
#pragma unroll
            for (int j = 0; j < 4; ++j) hw[64 * j] = v[j]; }
#pragma unroll
        for (int j = 0; j < 4; ++j) s += (v[j].x * v[j].x + v[j].y * v[j].y) + (v[j].z * v[j].z + v[j].w * v[j].w);
        const float rstd = rsqrtf(wave_sum(s) * (1.f / D) + RMS_EPS);
#pragma unroll
        for (int j = 0; j < 4; ++j) { const f32x4 gg = g4[64 * j]; o8[64 * j] = (unsigned long long)pk2(v[j].x * rstd * gg.x, v[j].y * rstd * gg.y) | ((unsigned long long)pk2(v[j].z * rstd * gg.z, v[j].w * rstd * gg.w) << 32); }
    }
}
__device__ __forceinline__ void unpack8(const u32x4 v, float (&f)[8]) {
    f[0] = __uint_as_float(v.x << 16); f[1] = __uint_as_float(v.x & 0xffff0000u); f[2] = __uint_as_float(v.y << 16); f[3] = __uint_as_float(v.y & 0xffff0000u);
    f[4] = __uint_as_float(v.z << 16); f[5] = __uint_as_float(v.z & 0xffff0000u); f[6] = __uint_as_float(v.w << 16); f[7] = __uint_as_float(v.w & 0xffff0000u);
}
__device__ __forceinline__ void ph_prep(const bf16_t* __restrict__ PM, const bf16_t* __restrict__ PR, const float* __restrict__ mu, const float* __restrict__ rope,
                                        float* __restrict__ rstdq, float* __restrict__ rstdkv, bf16_t* __restrict__ KR, bf16_t* __restrict__ LIN, bf16_t* __restrict__ VSH, int do_vsh, int gw, int ngw, int lane) {
    lane = opq(lane);
    for (int row = gw; row < RP; row += ngw) {
        const bf16_t* pm = PM + (size_t)row * PMW;
        float f[8], sq = 0.f, skv = 0.f;
        unpack8(*(const u32x4*)(pm + lane * 8), f);
#pragma unroll
        for (int j = 0; j < 8; ++j) sq += f[j] * f[j];
        if (lane < 32) { unpack8(*(const u32x4*)(pm + 512 + lane * 8), f);
#pragma unroll
            for (int j = 0; j < 8; ++j) skv += f[j] * f[j]; }
        sq = wave_sum(sq); skv = wave_sum(skv);
        if (lane == 0) { rstdq[row] = rsqrtf(sq * (1.f / 512.f) + RMS_EPS); rstdkv[row] = rsqrtf(skv * (1.f / 256.f) + RMS_EPS); }
        const int pos = row_pos(row);
        if (lane < 32) { const float x1 = bf2f(pm[768 + lane]), x2 = bf2f(pm[800 + lane]); const float c = rope[2 * (pos * 32 + lane)], s = rope[2 * (pos * 32 + lane) + 1];
            KR[(size_t)row * 64 + lane] = f2bf(x1 * c - x2 * s); KR[(size_t)row * 64 + 32 + lane] = f2bf(x1 * s + x2 * c); }
        const int pr = row_prev(row); const bool valid = row < RVALID; const float pmk = pr < 0 ? 0.f : 1.f;
        const bf16_t* x = PR + (size_t)row * PRW; const bf16_t* xp = PR + (size_t)(pr < 0 ? row : pr) * PRW;
        if (lane < 32) {
            float a[8], b[8]; unpack8(*(const u32x4*)(x + 1536 + lane * 8), a); unpack8(*(const u32x4*)(xp + 1536 + lane * 8), b);
            const f32x4 m0 = *(const f32x4*)(mu + 1536 + lane * 8), m1 = *(const f32x4*)(mu + 1536 + lane * 8 + 4); const float mm[8] = {m0.x, m0.y, m0.z, m0.w, m1.x, m1.y, m1.z, m1.w};
            float o[8];
#pragma unroll
            for (int j = 0; j < 8; ++j) { float v = a[j] + (pmk * b[j] - a[j]) * mm[j]; v = lane < 8 ? tanhf(v) : (lane < 16 ? v : sigmoidf_(v)); o[j] = valid ? v : 0.f; }
            u32x4 w; w.x = pk2(o[0], o[1]); w.y = pk2(o[2], o[3]); w.z = pk2(o[4], o[5]); w.w = pk2(o[6], o[7]); *(u32x4*)(LIN + (size_t)row * 256 + lane * 8) = w; }
        if (do_vsh) {
            float a[8], b[8]; unpack8(*(const u32x4*)(x + 1024 + lane * 8), a); unpack8(*(const u32x4*)(xp + 1024 + lane * 8), b);
            const f32x4 m0 = *(const f32x4*)(mu + 1024 + lane * 8), m1 = *(const f32x4*)(mu + 1024 + lane * 8 + 4); const float mm[8] = {m0.x, m0.y, m0.z, m0.w, m1.x, m1.y, m1.z, m1.w};
            float o[8];
#pragma unroll
            for (int j = 0; j < 8; ++j) { const float v = a[j] + (pmk * b[j] - a[j]) * mm[j]; o[j] = valid ? v : 0.f; }
            u32x4 w; w.x = pk2(o[0], o[1]); w.y = pk2(o[2], o[3]); w.z = pk2(o[4], o[5]); w.w = pk2(o[6], o[7]); *(u32x4*)(VSH + (size_t)row * 512 + lane * 8) = w; }
    }
}

__device__ __forceinline__ void ph_norm_route(LAS unsigned char* lds, const float* __restrict__ out, const float* __restrict__ g, const float* __restrict__ router, const float* __restrict__ rbias,
                                              bf16_t* __restrict__ U, int* __restrict__ TE, float* __restrict__ TG, int* __restrict__ STOK, unsigned* __restrict__ ctl, int bid, int nblk, int wave, int lane) {
    lane = opq(lane); nblk = opqs(nblk); bid = opqs(bid);
    { constexpr int NFILL = 2 * MOE_MAXPAN * 256 + RREAL; const int per = (NFILL + nblk - 1) / nblk; const int t_ = wave * 64 + lane;
      for (int i = t_; i < per; i += 512) { const int idx = bid * per + i; if (idx < NFILL) STOK[idx] = -1; } }
    const int rpw = (RREAL + nblk - 1) / nblk, rpwave = (rpw + 7) / 8;
    int c1[8], c2[8];
#pragma unroll
    for (int e = 0; e < 8; ++e) { c1[e] = 0; c2[e] = 0; }
    for (int k = 0; k < rpwave; ++k) { const int rl = wave * rpwave + k; const int row = bid * rpw + rl; if (rl >= rpw || row >= RREAL) break;
        const f32x4* xr = (const f32x4*)(out + (size_t)row * D) + lane; const f32x4* g4 = (const f32x4*)g + lane;
        f32x4 v[4]; float s = 0.f;
#pragma unroll
        for (int j = 0; j < 4; ++j) { v[j] = xr[64 * j]; s += (v[j].x * v[j].x + v[j].y * v[j].y) + (v[j].z * v[j].z + v[j].w * v[j].w); }
        const float rstd = rsqrtf(wave_sum(s) * (1.f / D) + RMS_EPS);
        unsigned* o4 = (unsigned*)((unsigned char*)U + (size_t)row * D) + lane;
        float lg[8];
#pragma unroll
        for (int e = 0; e < 8; ++e) lg[e] = 0.f;
#pragma unroll
        for (int j = 0; j < 4; ++j) { const f32x4 gg = g4[64 * j]; f32x4 xn; xn.x = v[j].x * rstd * gg.x; xn.y = v[j].y * rstd * gg.y; xn.z = v[j].z * rstd * gg.z; xn.w = v[j].w * rstd * gg.w;
            o4[64 * j] = pk4_f8(xn.x * F8_ACT, xn.y * F8_ACT, xn.z * F8_ACT, xn.w * F8_ACT);
            const int d0 = 4 * (lane + 64 * j);
#pragma unroll
            for (int q = 0; q < 4; ++q) { const f32x4 ra = *(const f32x4*)(router + (size_t)(d0 + q) * 8), rb = *(const f32x4*)(router + (size_t)(d0 + q) * 8 + 4); const float xv = xn[q];
                lg[0] += xv * ra.x; lg[1] += xv * ra.y; lg[2] += xv * ra.z; lg[3] += xv * ra.w; lg[4] += xv * rb.x; lg[5] += xv * rb.y; lg[6] += xv * rb.z; lg[7] += xv * rb.w; }
            asm volatile("" ::: "memory"); }
#pragma unroll
        for (int e = 0; e < 8; ++e) { float t_ = wave_sum(lg[e]); asm volatile("" : "+v"(t_)); lg[e] = t_ + rbias[e]; }
        int e1 = 0; float l1 = lg[0];
#pragma unroll
        for (int e = 1; e < 8; ++e) if (lg[e] > l1) { l1 = lg[e]; e1 = e; }
        int e2 = e1 == 0 ? 1 : 0; float l2 = -INFINITY;
#pragma unroll
        for (int e = 0; e < 8; ++e) if (e != e1 && lg[e] > l2) { l2 = lg[e]; e2 = e; }
        const float g1 = 1.0f / (1.0f + __expf(l2 - l1)), g2 = 1.0f - g1;
        { const int e1v = e1, e2v = e2;
#pragma unroll
        for (int e = 0; e < 8; ++e) { c1[e] += (e1v == e) ? 1 : 0; c2[e] += (e2v == e) ? 1 : 0; } }
        if (lane == 0) { TE[row] = e1; TE[RREAL + row] = e2; TG[row] = g1; TG[RREAL + row] = g2; }
    }
    LAS int* wc = (LAS int*)(lds + 80000);
    if (lane == 0) {
#pragma unroll
        for (int e = 0; e < 8; ++e) { wc[wave * 16 + e] = c1[e]; wc[wave * 16 + 8 + e] = c2[e]; } }
    __syncthreads();
    const int t = wave * 64 + lane;
    if (t < 16) { int sum = 0;
#pragma unroll
        for (int ww = 0; ww < 8; ++ww) sum += wc[ww * 16 + t];
        ctl[CW_WGCNT + bid * 16 + t] = (unsigned)sum; }
}
__device__ __forceinline__ void ph_moe_assign(LAS unsigned char* lds, int list, const int* __restrict__ TE, const float* __restrict__ TG, int* __restrict__ STOK, float* __restrict__ SGATE, int* __restrict__ BE, unsigned* __restrict__ ctl,
                                              const unsigned char* __restrict__ U8, unsigned char* __restrict__ XB, int bid, int nblk, int tid) {
    LAS int* sh = (LAS int*)lds;
    __syncthreads();
    {
        LAS float* shf = (LAS float*)(lds + 2048);
        float tv[8], pv[8];
#pragma unroll
        for (int e = 0; e < 8; ++e) { tv[e] = 0.f; pv[e] = 0.f; }
        for (int b = tid; b < nblk; b += 512) { const u32x4* cp4 = (const u32x4*)(ctl + CW_WGCNT + b * 16 + 8 * list); const u32x4 c0 = cp4[0], c1 = cp4[1];
            const float v[8] = {(float)c0.x, (float)c0.y, (float)c0.z, (float)c0.w, (float)c1.x, (float)c1.y, (float)c1.z, (float)c1.w};
#pragma unroll
            for (int e = 0; e < 8; ++e) { tv[e] += v[e]; pv[e] += b < bid ? v[e] : 0.f; } }
        const int wv = tid >> 6;
#pragma unroll
        for (int e = 0; e < 8; ++e) { const float ts = wave_sum(tv[e]), ps = wave_sum(pv[e]); if ((tid & 63) == 0) { shf[wv * 16 + e] = ts; shf[wv * 16 + 8 + e] = ps; } }
        __syncthreads();
        if (tid < 8) { float tot = 0.f, pre = 0.f;
#pragma unroll
            for (int ww = 0; ww < 8; ++ww) { tot += shf[ww * 16 + tid]; pre += shf[ww * 16 + 8 + tid]; }
            sh[tid] = (int)tot; sh[8 + tid] = (int)pre; }
    }
    __syncthreads();
    if (tid == 0) { int pan = 0;
        for (int e = 0; e < 8; ++e) { const int np = (sh[e] + 255) >> 8; sh[16 + e] = pan << 8;
            if (bid == 0) for (int q = 0; q < np; ++q) { const int pi = pan + q; BE[256 * list + pi + (list == 1 && pi >= MOE_TAILPAN ? MOE_GAP : 0)] = e; }
            pan += np; }
        if (bid == 0) ctl[CW_NPAN + list] = (unsigned)pan; }
    __syncthreads();
    if (tid < 64) {
        const int rpw = (RREAL + nblk - 1) / nblk; int run[8];
#pragma unroll
        for (int q = 0; q < 8; ++q) run[q] = 0;
        for (int r0 = 0; r0 < rpw; r0 += 64) { const int rl = r0 + tid, row = bid * rpw + rl; const bool ok = rl < rpw && row < RREAL;
            const int ee = ok ? TE[list * RREAL + row] : -1; int slot = -1;
#pragma unroll
            for (int e = 0; e < 8; ++e) { const unsigned long long m = __builtin_amdgcn_ballot_w64(ee == e);
                const int rank = (int)__builtin_amdgcn_mbcnt_hi((unsigned)(m >> 32), __builtin_amdgcn_mbcnt_lo((unsigned)m, 0u));
                if (ee == e) { slot = sh[16 + e] + sh[8 + e] + run[e] + rank; if (list == 1 && slot >= MOE_TAILPAN * 256) slot += MOE_GAP * 256; }
                run[e] += __builtin_popcountll(m); }
            if (rl < rpw) sh[32 + rl] = ok ? slot : -1;
            if (ok) { STOK[list * (MOE_MAXPAN * 256) + slot] = row; SGATE[list * (MOE_MAXPAN * 256) + slot] = TG[list * RREAL + row];
                if (list == 1 && slot >= (MOE_TAILPAN + MOE_GAP) * 256) STOK[2 * MOE_MAXPAN * 256 + row] = slot - (MOE_TAILPAN + MOE_GAP) * 256; } }
    }
    __syncthreads();
    {
        const int rpw = (RREAL + nblk - 1) / nblk, w = tid >> 6, ln = tid & 63; unsigned char* xl = XB + (size_t)list * (MOE_MAXPAN * 256) * 1024;
        for (int rl = w; rl < rpw; rl += 8) { const int slot = sh[32 + rl]; if (slot >= 0) ((u32x4*)(xl + (size_t)slot * 1024))[ln] = ((const u32x4*)(U8 + (size_t)(bid * rpw + rl) * 1024))[ln]; }
        if (bid < 8) { const int e = bid, lo = sh[16 + e] + sh[e], hi = sh[16 + e] + (((sh[e] + 255) >> 8) << 8); unsigned z0 = 0u; asm volatile("" : "+v"(z0)); u32x4 z; z.x = z.y = z.z = z.w = z0;
            for (int p0 = lo + w; p0 < hi; p0 += 8) { const int slot = p0 + ((list == 1 && p0 >= MOE_TAILPAN * 256) ? MOE_GAP * 256 : 0); ((u32x4*)(xl + (size_t)slot * 1024))[ln] = z; } }
    }
}
__device__ __forceinline__ void ph_final(float* __restrict__ out, const float* __restrict__ g, const int* __restrict__ tslot, const float* __restrict__ tb, int gw, int ngw, int lane, float pscale = 1.0f) {
    lane = opq(lane);
    for (int row = gw; row < RREAL; row += ngw) {
        f32x4* xr = (f32x4*)(out + (size_t)row * D) + lane; const f32x4* g4 = (const f32x4*)g + lane;
        const int ts = __builtin_amdgcn_readfirstlane(tslot[row]);
        f32x4 v[4]; float s = 0.f;
#pragma unroll
        for (int j = 0; j < 4; ++j) v[j] = xr[64 * j];
        if (ts >= 0) { const f32x4* tr = (const f32x4*)(tb + (size_t)ts * D) + lane;
#pragma unroll
            for (int j = 0; j < 4; ++j) v[j] = v[j] + tr[64 * j]; }
#pragma unroll
        for (int j = 0; j < 4; ++j) s += (v[j].x * v[j].x + v[j].y * v[j].y) + (v[j].z * v[j].z + v[j].w * v[j].w);
        const float rstd = rsqrtf(wave_sum(s) * (1.f / D) + RMS_EPS);
#pragma unroll
        for (int j = 0; j < 4; ++j) { const f32x4 gg = g4[64 * j]; f32x4 o; o.x = v[j].x * rstd * gg.x * pscale; o.y = v[j].y * rstd * gg.y * pscale; o.z = v[j].z * rstd * gg.z * pscale; o.w = v[j].w * rstd * gg.w * pscale; xr[64 * j] = o; }
    }
}

constexpr int KS_STRIDE = 200, VS_STRIDE = 72;
constexpr int ATT_LDS = 64 * KS_STRIDE * 2 + 128 * VS_STRIDE * 2;
__device__ __forceinline__ bf16x8 pack8(const f32x16& x, int s) {
    u32x4 p;
    if (s == 0) { p.x = cvtpk(x[0], x[1]); p.y = cvtpk(x[2], x[3]); p.z = cvtpk(x[4], x[5]); p.w = cvtpk(x[6], x[7]); }
    else { p.x = cvtpk(x[8], x[9]); p.y = cvtpk(x[10], x[11]); p.z = cvtpk(x[12], x[13]); p.w = cvtpk(x[14], x[15]); }
    return __builtin_bit_cast(bf16x8, p);
}
__device__ __forceinline__ void attn_unit(LAS unsigned char* lds, const bf16_t* __restrict__ Q, const bf16_t* __restrict__ KN, const bf16_t* __restrict__ KR, const bf16_t* __restrict__ VT,
                                          bf16_t* __restrict__ MIX, const float* __restrict__ rope, int h, int qrow0, int kbase, int ntile, int wlim, bool wave_active) {
    const int tid = opq(threadIdx.x), lane = tid & 63, w = tid >> 6, r = lane & 31, hh = lane >> 5;
    LAS bf16_t* Ks = (LAS bf16_t*)lds; LAS bf16_t* Vs = (LAS bf16_t*)(lds + 64 * KS_STRIDE * 2);
    const int qrow = qrow0 + 32 * w + r;
    bf16x8 qf[12];
#pragma unroll
    for (int ks = 0; ks < 12; ++ks) qf[ks] = *(const GAS bf16x8*)(Q + (size_t)qrow * 768 + 192 * h + 16 * ks + 8 * hh);
    {
        const int pos = row_pos(qrow); const GAS float* rt = (const GAS float*)(rope + (size_t)pos * 64);
#pragma unroll
        for (int half = 0; half < 2; ++half) { const GAS float* cs = rt + 2 * (16 * half + 8 * hh);
#pragma unroll
            for (int j = 0; j < 8; ++j) { const float c = cs[2 * j], sn = cs[2 * j + 1]; const float x1 = bf2f((bf16_t)qf[8 + half][j]), x2 = bf2f((bf16_t)qf[10 + half][j]);
                qf[8 + half][j] = (short)f2bf(x1 * c - x2 * sn); qf[10 + half][j] = (short)f2bf(x1 * sn + x2 * c); } }
    }
    float z0 = 0.f; asm volatile("" : "+v"(z0));
    f32x16 oacc[4];
#pragma unroll
    for (int i = 0; i < 4; ++i)
#pragma unroll
        for (int j = 0; j < 16; ++j) oacc[i][j] = z0;
    float mrun = -INFINITY, lsum = 0.f;
    const float sc = 0.07216878364870322f * 1.4426950408889634f;
    u32x4 kreg[3], vreg[2];
    const unsigned kn_off0 = (unsigned)(((tid >> 4) * 512 + h * 128 + (tid & 15) * 8) * 2), kn_off1 = kn_off0 + 32u * 512u * 2u;
    const unsigned kr_off = (unsigned)(((tid >> 3) * 64 + (tid & 7) * 8) * 2);
    const unsigned vt_off0 = (unsigned)((((size_t)(h * 128 + (tid >> 3))) * RP + (tid & 7) * 8) * 2), vt_off1 = vt_off0 + 64u * (unsigned)RP * 2u;
#define ATT_GLOAD(tt_) do { const int krow0_ = (tt_) == 0 ? RREAL : kbase + 64 * ((tt_) - 1); \
    const char* knb_ = (const char*)KN + (size_t)krow0_ * 1024; const char* krb_ = (const char*)KR + (size_t)krow0_ * 128; const char* vtb_ = (const char*)VT + (size_t)krow0_ * 2; \
    kreg[0] = *(const GAS u32x4*)(knb_ + kn_off0); kreg[1] = *(const GAS u32x4*)(knb_ + kn_off1); kreg[2] = *(const GAS u32x4*)(krb_ + kr_off); \
    vreg[0] = *(const GAS u32x4*)(vtb_ + vt_off0); vreg[1] = *(const GAS u32x4*)(vtb_ + vt_off1); } while (0)
    ATT_GLOAD(0);
    for (int tt = 0; tt < ntile; ++tt) {
#ifdef PROBE_ATT_STAGE2
        __syncthreads();
        *(LAS u32x4*)(Ks + (tid >> 4) * KS_STRIDE + (tid & 15) * 8) = kreg[0]; *(LAS u32x4*)(Ks + (32 + (tid >> 4)) * KS_STRIDE + (tid & 15) * 8) = kreg[1];
        *(LAS u32x4*)(Ks + (tid >> 3) * KS_STRIDE + 128 + (tid & 7) * 8) = kreg[2];
#pragma unroll
        for (int i = 0; i < 2; ++i) {
            LAS u32x2* d = (LAS u32x2*)(Vs + ((tid >> 3) + 64 * i) * VS_STRIDE + ((tid & 7) >> 1) * 16 + (tid & 1) * 4);
            u32x2 lo; lo.x = vreg[i].x; lo.y = vreg[i].y; u32x2 hi; hi.x = vreg[i].z; hi.y = vreg[i].w; d[0] = lo; d[2] = hi; }
        __syncthreads();
#endif
        __syncthreads();
        *(LAS u32x4*)(Ks + (tid >> 4) * KS_STRIDE + (tid & 15) * 8) = kreg[0]; *(LAS u32x4*)(Ks + (32 + (tid >> 4)) * KS_STRIDE + (tid & 15) * 8) = kreg[1];
        *(LAS u32x4*)(Ks + (tid >> 3) * KS_STRIDE + 128 + (tid & 7) * 8) = kreg[2];
#pragma unroll
        for (int i = 0; i < 2; ++i) {
            LAS u32x2* d = (LAS u32x2*)(Vs + ((tid >> 3) + 64 * i) * VS_STRIDE + ((tid & 7) >> 1) * 16 + (tid & 1) * 4);
            u32x2 lo; lo.x = vreg[i].x; lo.y = vreg[i].y; u32x2 hi; hi.x = vreg[i].z; hi.y = vreg[i].w; d[0] = lo; d[2] = hi; }
        __syncthreads();
        const bool comp = wave_active && tt <= wlim;
        if (tt + 1 < ntile) ATT_GLOAD(tt + 1);
        if (comp) {
            f32x16 sacc[2];
#pragma unroll
            for (int b = 0; b < 2; ++b)
#pragma unroll
                for (int j = 0; j < 16; ++j) sacc[b][j] = z0;
#ifdef PROBE_ATT_QK2
            {
            __builtin_amdgcn_sched_barrier(0);
            {
                const LAS bf16_t* kb0 = Ks + r * KS_STRIDE + 8 * hh;
                bf16x8 kf[6];
#pragma unroll
                for (int i = 0; i < 6; ++i) kf[i] = *(const LAS bf16x8*)(kb0 + 16 * i);
#pragma unroll
                for (int i = 0; i < 24; ++i) { sacc[i / 12] = __builtin_amdgcn_mfma_f32_32x32x16_bf16(kf[i % 6], qf[i % 12], sacc[i / 12], 0, 0, 0);
                    if (i + 6 < 24) kf[i % 6] = *(const LAS bf16x8*)(kb0 + ((i + 6) / 12) * 32 * KS_STRIDE + 16 * ((i + 6) % 12)); }
                __builtin_amdgcn_sched_group_barrier(0x100, 6, 0);
#pragma unroll
                for (int i = 0; i < 18; ++i) { __builtin_amdgcn_sched_group_barrier(0x008, 1, 0); __builtin_amdgcn_sched_group_barrier(0x100, 1, 0); }
                __builtin_amdgcn_sched_group_barrier(0x008, 6, 0);
            }
            __builtin_amdgcn_sched_barrier(0);
                asm volatile("" : "+v"(sacc[0][0]), "+v"(sacc[1][0]));
#pragma unroll
                for (int b = 0; b < 2; ++b)
#pragma unroll
                    for (int j = 0; j < 16; ++j) sacc[b][j] = z0;
            }
#endif
            __builtin_amdgcn_sched_barrier(0);
            {
                const LAS bf16_t* kb0 = Ks + r * KS_STRIDE + 8 * hh;
                bf16x8 kf[6];
#pragma unroll
                for (int i = 0; i < 6; ++i) kf[i] = *(const LAS bf16x8*)(kb0 + 16 * i);
#pragma unroll
                for (int i = 0; i < 24; ++i) { sacc[i / 12] = __builtin_amdgcn_mfma_f32_32x32x16_bf16(kf[i % 6], qf[i % 12], sacc[i / 12], 0, 0, 0);
                    if (i + 6 < 24) kf[i % 6] = *(const LAS bf16x8*)(kb0 + ((i + 6) / 12) * 32 * KS_STRIDE + 16 * ((i + 6) % 12)); }
                __builtin_amdgcn_sched_group_barrier(0x100, 6, 0);
#pragma unroll
                for (int i = 0; i < 18; ++i) { __builtin_amdgcn_sched_group_barrier(0x008, 1, 0); __builtin_amdgcn_sched_group_barrier(0x100, 1, 0); }
                __builtin_amdgcn_sched_group_barrier(0x008, 6, 0);
            }
            __builtin_amdgcn_sched_barrier(0);
            if (tt == 0) {
#pragma unroll
                for (int j = 8; j < 16; ++j) sacc[0][j] = -INFINITY;
#pragma unroll
                for (int j = 0; j < 16; ++j) sacc[1][j] = -INFINITY; }
            float tmax = fmaxf(sacc[0][0], sacc[1][0]);
#pragma unroll
            for (int j = 1; j < 16; ++j) tmax = fmaxf(tmax, fmaxf(sacc[0][j], sacc[1][j]));
            tmax = fmaxf(tmax, __int_as_float(__builtin_amdgcn_ds_bpermute((lane ^ 32) << 2, __float_as_int(tmax)))) * sc;
            const float mnew = fmaxf(mrun, tmax); const float alpha = __builtin_amdgcn_exp2f(mrun - mnew); mrun = mnew;
            float psum = 0.f;
#pragma unroll
            for (int b = 0; b < 2; ++b)
#pragma unroll
                for (int j = 0; j < 16; ++j) { const float p = __builtin_amdgcn_exp2f(__builtin_fmaf(sacc[b][j], sc, -mnew)); sacc[b][j] = p; psum += p; }
            lsum = lsum * alpha + psum;
            if (__builtin_amdgcn_ballot_w64(alpha != 1.0f) != 0ull) {
#pragma unroll
            for (int i = 0; i < 4; ++i)
#pragma unroll
                for (int j = 0; j < 16; ++j) oacc[i][j] *= alpha; }
            bf16x8 pf[4];
            pf[0] = pack8(sacc[0], 0); pf[1] = pack8(sacc[0], 1); pf[2] = pack8(sacc[1], 0); pf[3] = pack8(sacc[1], 1);
#ifdef PROBE_ATT_PV2
            {
                const LAS bf16_t* vb0 = Vs + r * VS_STRIDE + 8 * hh;
#pragma unroll
                for (int j = 0; j < 16; ++j) { sacc[0][j] = z0; sacc[1][j] = z0; }
#pragma unroll
                for (int i = 0; i < 16; ++i) { const bf16x8 vfd = *(const LAS bf16x8*)(vb0 + 32 * (i >> 2) * VS_STRIDE + 16 * (i & 3));
                    sacc[i & 1] = __builtin_amdgcn_mfma_f32_32x32x16_bf16(vfd, pf[i & 3], sacc[i & 1], 0, 0, 0); }
                asm volatile("" :: "v"(sacc[0][0]), "v"(sacc[1][0]));
            }
#endif
            __builtin_amdgcn_sched_barrier(0);
            {
                const LAS bf16_t* vb0 = Vs + r * VS_STRIDE + 8 * hh;
                bf16x8 vf[16];
#pragma unroll
                for (int i = 0; i < 16; ++i) vf[i] = *(const LAS bf16x8*)(vb0 + 32 * (i >> 2) * VS_STRIDE + 16 * (i & 3));
#pragma unroll
                for (int i = 0; i < 16; ++i) oacc[i >> 2] = __builtin_amdgcn_mfma_f32_32x32x16_bf16(vf[i], pf[i & 3], oacc[i >> 2], 0, 0, 0);
                __builtin_amdgcn_sched_group_barrier(0x100, 8, 1);
#pragma unroll
                for (int i = 0; i < 8; ++i) { __builtin_amdgcn_sched_group_barrier(0x008, 1, 1); __builtin_amdgcn_sched_group_barrier(0x100, 1, 1); }
                __builtin_amdgcn_sched_group_barrier(0x008, 8, 1);
            }
            __builtin_amdgcn_sched_barrier(0);
        }
    }
    if (wave_active) {
        const float ltot = lsum + __int_as_float(__builtin_amdgcn_ds_bpermute((lane ^ 32) << 2, __float_as_int(lsum))); const float inv = 1.0f / ltot;
        bf16_t* orow = MIX + (size_t)qrow * D + 128 * h;
#pragma unroll
        for (int dvb = 0; dvb < 4; ++dvb)
#pragma unroll
            for (int g = 0; g < 4; ++g) { u32x2 o; o.x = cvtpk(oacc[dvb][4 * g] * inv, oacc[dvb][4 * g + 1] * inv); o.y = cvtpk(oacc[dvb][4 * g + 2] * inv, oacc[dvb][4 * g + 3] * inv);
                *(GAS u32x2*)(orow + 32 * dvb + 8 * g + 4 * hh) = o; }
    }
    __syncthreads();
}
__device__ __forceinline__ void attn_phase(LAS unsigned char* lds, const bf16_t* Q, const bf16_t* KN, const bf16_t* KR, const bf16_t* VT, bf16_t* MIX, const float* rope, int bid, int nblk) {
    const int w = opq(threadIdx.x) >> 6;
    for (int s = bid; s < 512; s += nblk) {
        const int round = s >> 8, x = s & 255; const int bh = (x >> 4) + 16 * round, qb = round ? 15 - (x & 15) : (x & 15);
        const int b = bh >> 2, h = bh & 3;
        attn_unit(lds, Q, KN, KR, VT, MIX, rope, h, b * SEQ + 256 * qb, b * SEQ, 4 * qb + 5, 4 * qb + (w >> 1) + 1, true);
    }
    for (int s = bid; s < 4; s += nblk)
        attn_unit(lds, Q, KN, KR, VT, MIX, rope, s, RREAL, 0, 1, 0, w == 0);
}

constexpr int CLS = 72;
constexpr int CSLOT = 64 * CLS * 2;
constexpr int CHK_BYTES = 32768;
constexpr int NSEQ_HALF0 = 257;
struct CpP { const bf16_t* PR; const bf16_t* LO; const bf16_t* VMIX; const bf16_t* VFIRST; bf16_t* VP; float* RK; unsigned char* CHK;
    const float *mu, *w0, *a0, *k_k, *k_a, *r_k, *v0; int layer, pad; };

__device__ __forceinline__ void mm64(f32x16& acc, const LAS bf16_t* a, const LAS bf16_t* b, int r, int hh) {
    bf16x8 af[4], bf[4];
#pragma unroll
    for (int ks = 0; ks < 4; ++ks) { af[ks] = *(const LAS bf16x8*)(a + r * CLS + 16 * ks + 8 * hh); bf[ks] = *(const LAS bf16x8*)(b + r * CLS + 16 * ks + 8 * hh); }
#pragma unroll
    for (int ks = 0; ks < 4; ++ks) acc = __builtin_amdgcn_mfma_f32_32x32x16_bf16(af[ks], bf[ks], acc, 0, 0, 0);
}
__device__ __forceinline__ void st_tile(const f32x16& acc, LAS bf16_t* dst, int m0, int n0, int r, int hh) {
#pragma unroll
    for (int q = 0; q < 16; ++q) dst[(m0 + (q & 3) + 8 * (q >> 2) + 4 * hh) * CLS + n0 + r] = f2bf_hw(acc[q]);
}
__device__ __forceinline__ void st_tile_t(const f32x16& acc, LAS bf16_t* dst, int m0, int n0, int r, int hh) {
#pragma unroll
    for (int g = 0; g < 4; ++g) { u32x2 o; o.x = cvtpk(acc[4 * g], acc[4 * g + 1]); o.y = cvtpk(acc[4 * g + 2], acc[4 * g + 3]);
        *(LAS u32x2*)(dst + (n0 + r) * CLS + m0 + 8 * g + 4 * hh) = o; }
}
__device__ __forceinline__ void zero16(f32x16& a, float z) {
#pragma unroll
    for (int q = 0; q < 16; ++q) a[q] = z;
}
typedef float f32x2 __attribute__((ext_vector_type(2)));
struct CpRaw { unsigned xr[5], xk[5], xv[5], lw[4], la[4], vm[4], vf[4]; f32x2 mu_r, mu_k, mu_v, w0, a0, kkc, kac, rkc, v0; float pm0; };
__device__ __forceinline__ void cp_issue(const CpP& P, int row0, int hd, int w, int lane, CpRaw& R) {
    const int cp = lane & 31, rh = lane >> 5, c = hd * 64 + 2 * cp;
    R.mu_r = *(const GAS f32x2*)(P.mu + c); R.mu_k = *(const GAS f32x2*)(P.mu + 512 + c); R.mu_v = *(const GAS f32x2*)(P.mu + 1024 + c); R.w0 = *(const GAS f32x2*)(P.w0 + c); R.a0 = *(const GAS f32x2*)(P.a0 + c);
    R.kkc = *(const GAS f32x2*)(P.k_k + c); R.kac = *(const GAS f32x2*)(P.k_a + c); R.rkc = *(const GAS f32x2*)(P.r_k + c);
    if (P.layer) R.v0 = *(const GAS f32x2*)(P.v0 + c); else { R.v0.x = 0.f; R.v0.y = 0.f; }
    const int rw0 = row0 + 8 * w + 4 * rh; const int prow0 = (w == 0 && rh == 0) ? row_prev(row0) : rw0 - 1; R.pm0 = prow0 < 0 ? 0.f : 1.f;
    { const bf16_t* xp = P.PR + (size_t)(prow0 < 0 ? rw0 : prow0) * PRW + c; R.xr[0] = *(const GAS unsigned*)xp; R.xk[0] = *(const GAS unsigned*)(xp + 512); R.xv[0] = *(const GAS unsigned*)(xp + 1024); }
#pragma unroll
    for (int q = 0; q < 4; ++q) { const bf16_t* x = P.PR + (size_t)(rw0 + q) * PRW + c; R.xr[q + 1] = *(const GAS unsigned*)x; R.xk[q + 1] = *(const GAS unsigned*)(x + 512); R.xv[q + 1] = *(const GAS unsigned*)(x + 1024);
        const bf16_t* lo = P.LO + (size_t)(rw0 + q) * 1536 + c; R.lw[q] = *(const GAS unsigned*)lo; R.la[q] = *(const GAS unsigned*)(lo + 512);
        if (P.layer) { R.vm[q] = *(const GAS unsigned*)(P.VMIX + (size_t)(rw0 + q) * 512 + c); R.vf[q] = *(const GAS unsigned*)(P.VFIRST + (size_t)(rw0 + q) * 512 + c); } else { R.vm[q] = 0u; R.vf[q] = 0u; } }
}
__device__ __forceinline__ float bfl(unsigned u) { return __uint_as_float(u << 16); }
__device__ __forceinline__ float bfh(unsigned u) { return __uint_as_float(u & 0xffff0000u); }
__device__ __forceinline__ float half_tot(float v) {
    v += DPP_F(v, 0xB1, 0xf); v += DPP_F(v, 0x4E, 0xf); v += DPP_F(v, 0x141, 0xf); v += DPP_F(v, 0x140, 0xf); v += DPP_F(v, 0x142, 0xa); return v; }
__device__ __forceinline__ void rwkv_cp_task(LAS unsigned char* lds, const CpP& P, int row0, int hd, unsigned char* out, CpRaw& R, bool has_next, int nrow0, int nhd) {
    const int tid = opq(threadIdx.x), lane = tid & 63, w = __builtin_amdgcn_readfirstlane(tid >> 6), r = lane & 31, hh = lane >> 5;
    float z0 = 0.f; asm volatile("" : "+v"(z0));
    LAS bf16_t* S_ATtm = (LAS bf16_t*)(lds + 0 * CSLOT);
    LAS bf16_t* S_BHtm = (LAS bf16_t*)(lds + 1 * CSLOT);
    LAS bf16_t* S_KHtm = (LAS bf16_t*)(lds + 2 * CSLOT);
    LAS bf16_t* S_RTtm = (LAS bf16_t*)(lds + 3 * CSLOT);
    LAS bf16_t* S_ATcm = (LAS bf16_t*)(lds + 4 * CSLOT);
    LAS bf16_t* S_BBcm = (LAS bf16_t*)(lds + 5 * CSLOT);
    LAS bf16_t* S_KBcm = (LAS bf16_t*)(lds + 6 * CSLOT);
    LAS bf16_t* S_VTcm = (LAS bf16_t*)(lds + 7 * CSLOT);
    LAS bf16_t* S_Q0a = (LAS bf16_t*)(lds + 8 * CSLOT);
    LAS bf16_t* S_Q0b = (LAS bf16_t*)(lds + 9 * CSLOT);
    LAS bf16_t* S_PP0 = (LAS bf16_t*)(lds + 10 * CSLOT);
    LAS bf16_t* S_Na = (LAS bf16_t*)(lds + 11 * CSLOT);
    LAS bf16_t* S_XT = (LAS bf16_t*)(lds + 12 * CSLOT);
    LAS bf16_t* S_Pa = (LAS bf16_t*)(lds + 13 * CSLOT);
    LAS bf16_t* S_Qa = (LAS bf16_t*)(lds + 14 * CSLOT);
    LAS float* S_TOT = (LAS float*)(lds + 15 * CSLOT);
    LAS bf16_t* Qa[2] = {S_Q0a, S_ATtm}; LAS bf16_t* Qb[2] = {S_Q0b, S_BHtm}; LAS bf16_t* PPa[2] = {S_PP0, S_KHtm};

    {
        const int cp = lane & 31, rh = lane >> 5, c = hd * 64 + 2 * cp;
        const f32x2 mu_r = R.mu_r, mu_k = R.mu_k, mu_v = R.mu_v, w0 = R.w0, a0 = R.a0, kkc = R.kkc, kac = R.kac, rkc = R.rkc, v0 = R.v0; const float pm0 = R.pm0;
        float fr[4][2], fk[4][2], fv[4][2], fa[4][2], fb[4][2], lw[4][2];
        const int rw0 = row0 + 8 * w + 4 * rh;
        constexpr float L2E = 1.4426950408889634f;
#pragma unroll
        for (int q = 0; q < 4; ++q) { const int row = rw0 + q; const bool valid = row < RVALID; const float pm = q == 0 ? pm0 : 1.f;
            float rr[2] = {bfl(R.xr[q + 1]), bfh(R.xr[q + 1])}, kk[2] = {bfl(R.xk[q + 1]), bfh(R.xk[q + 1])}, vv[2] = {bfl(R.xv[q + 1]), bfh(R.xv[q + 1])};
            const float pr[2] = {bfl(R.xr[q]), bfh(R.xr[q])}, pk[2] = {bfl(R.xk[q]), bfh(R.xk[q])}, pv[2] = {bfl(R.xv[q]), bfh(R.xv[q])};
            const float wpre[2] = {bfl(R.lw[q]), bfh(R.lw[q])}, apre[2] = {bfl(R.la[q]), bfh(R.la[q])};
            float lwv[2], asig[2], kkr[2], k2[2], kn[2];
#pragma unroll
            for (int e = 0; e < 2; ++e) {
                rr[e] = rr[e] + (pm * pr[e] - rr[e]) * mu_r[e]; kk[e] = kk[e] + (pm * pk[e] - kk[e]) * mu_k[e]; vv[e] = vv[e] + (pm * pv[e] - vv[e]) * mu_v[e];
                lwv[e] = -0.6065306597126334f * __builtin_amdgcn_rcpf(1.0f + __builtin_amdgcn_exp2f(-(w0[e] + wpre[e]) * L2E));
                asig[e] = __builtin_amdgcn_rcpf(1.0f + __builtin_amdgcn_exp2f(-(a0[e] + apre[e]) * L2E));
                kkr[e] = kk[e] * kkc[e]; k2[e] = kk[e] * (1.f + (asig[e] - 1.f) * kac[e]); }
            if (P.layer) { const float vm[2] = {bfl(R.vm[q]), bfh(R.vm[q])}, vf[2] = {bfl(R.vf[q]), bfh(R.vf[q])};
#pragma unroll
                for (int e = 0; e < 2; ++e) vv[e] = vv[e] + (vf[e] - vv[e]) * __builtin_amdgcn_rcpf(1.0f + __builtin_amdgcn_exp2f(-(v0[e] + vm[e]) * L2E)); }
            const float sst = half_tot(kkr[0] * kkr[0] + kkr[1] * kkr[1]);
            const float rkt = half_tot(rr[0] * k2[0] * rkc[0] + rr[1] * k2[1] * rkc[1]);
            const float ss0 = __int_as_float(__builtin_amdgcn_readlane(__float_as_int(sst), 31)), ss1 = __int_as_float(__builtin_amdgcn_readlane(__float_as_int(sst), 63));
            const float rs = rsqrtf(fmaxf(rh ? ss1 : ss0, 1e-24f));
            kn[0] = kkr[0] * rs; kn[1] = kkr[1] * rs;
            if (!valid) {
#pragma unroll
                for (int e = 0; e < 2; ++e) { rr[e] = 0.f; k2[e] = 0.f; vv[e] = 0.f; kn[e] = 0.f; lwv[e] = 0.f; } }
            *(GAS unsigned*)(P.VP + (size_t)row * 512 + c) = cvtpk(vv[0], vv[1]); if (cp == 31) ((GAS float*)P.RK)[(size_t)row * 8 + hd] = valid ? rkt : 0.f;
#pragma unroll
            for (int e = 0; e < 2; ++e) { fr[q][e] = rr[e]; fk[q][e] = k2[e]; fv[q][e] = vv[e]; fa[q][e] = -kn[e]; fb[q][e] = kn[e] * asig[e]; lw[q][e] = lwv[e]; } }
        if (has_next) cp_issue(P, nrow0, nhd, w, lane, R);
        float cum[4][2], hoff[2];
#pragma unroll
        for (int e = 0; e < 2; ++e) { cum[0][e] = lw[0][e];
#pragma unroll
            for (int q = 1; q < 4; ++q) cum[q][e] = cum[q - 1][e] + lw[q][e];
            const float pt = __int_as_float(__builtin_amdgcn_ds_bpermute((lane ^ 32) << 2, __float_as_int(cum[3][e]))); hoff[e] = rh ? pt : 0.f; }
        if (rh) { f32x2 t2; t2.x = hoff[0] + cum[3][0]; t2.y = hoff[1] + cum[3][1]; *(LAS f32x2*)(S_TOT + w * 64 + 2 * cp) = t2; }
        lds_barrier();
        float off[2] = {0.f, 0.f}, tot[2] = {0.f, 0.f};
#pragma unroll
        for (int ww = 0; ww < 8; ++ww) { const f32x2 tv = *(const LAS f32x2*)(S_TOT + ww * 64 + 2 * cp); off[0] += ww < w ? tv.x : 0.f; off[1] += ww < w ? tv.y : 0.f; tot[0] += tv.x; tot[1] += tv.y; }
        const float etot[2] = {__builtin_amdgcn_exp2f(tot[0] * L2E), __builtin_amdgcn_exp2f(tot[1] * L2E)};
        if (w == 0 && rh == 0) { f32x2 t2; t2.x = etot[0]; t2.y = etot[1]; *(LAS f32x2*)(S_TOT + 512 + 2 * cp) = t2; }
        float at[4][2], bh[4][2], kh[4][2], rt[4][2], bb[4][2], kb[4][2];
#pragma unroll
        for (int e = 0; e < 2; ++e) { const float base = off[e] + hoff[e];
            float ecprev = __builtin_amdgcn_exp2f(base * L2E);
#pragma unroll
            for (int q = 0; q < 4; ++q) { const float ci = base + cum[q][e]; const float ec = __builtin_amdgcn_exp2f(ci * L2E), ecp = ecprev, en = __builtin_amdgcn_rcpf(ec), ee = etot[e] * en; ecprev = ec;
                rt[q][e] = fr[q][e] * ec; at[q][e] = fa[q][e] * ecp; bh[q][e] = fb[q][e] * en; kh[q][e] = fk[q][e] * en; bb[q][e] = fb[q][e] * ee; kb[q][e] = fk[q][e] * ee; } }
#pragma unroll
        for (int q = 0; q < 4; ++q) { const int t = 8 * w + 4 * rh + q;
            *(LAS unsigned*)(S_ATtm + t * CLS + 2 * cp) = cvtpk(at[q][0], at[q][1]); *(LAS unsigned*)(S_BHtm + t * CLS + 2 * cp) = cvtpk(bh[q][0], bh[q][1]);
            *(LAS unsigned*)(S_KHtm + t * CLS + 2 * cp) = cvtpk(kh[q][0], kh[q][1]); *(LAS unsigned*)(S_RTtm + t * CLS + 2 * cp) = cvtpk(rt[q][0], rt[q][1]); }
#pragma unroll
        for (int e = 0; e < 2; ++e) { const int jo = (2 * cp + e) * CLS + 8 * w + 4 * rh; u32x2 o;
            o.x = cvtpk(at[0][e], at[1][e]); o.y = cvtpk(at[2][e], at[3][e]); *(LAS u32x2*)(S_ATcm + jo) = o;
            o.x = cvtpk(bb[0][e], bb[1][e]); o.y = cvtpk(bb[2][e], bb[3][e]); *(LAS u32x2*)(S_BBcm + jo) = o;
            o.x = cvtpk(kb[0][e], kb[1][e]); o.y = cvtpk(kb[2][e], kb[3][e]); *(LAS u32x2*)(S_KBcm + jo) = o;
            o.x = cvtpk(fv[0][e], fv[1][e]); o.y = cvtpk(fv[2][e], fv[3][e]); *(LAS u32x2*)(S_VTcm + jo) = o; }
    }
    lds_barrier();
    const int q4 = w & 3, mb = q4 >> 1, nb = q4 & 1; const bool upper = (mb == 0 && nb == 1);
    f32x16 pacc;
    {
        f32x16 a0, a1; zero16(a0, z0); zero16(a1, z0);
        const LAS bf16_t* lhs = (w < 4 ? S_ATtm : S_RTtm) + 32 * mb * CLS;
        if (!upper) { mm64(a0, lhs, S_BHtm + 32 * nb * CLS, r, hh); mm64(a1, lhs, S_KHtm + 32 * nb * CLS, r, hh); }
        const int s = 32 * nb + r;
#pragma unroll
        for (int q = 0; q < 16; ++q) { const int t = 32 * mb + (q & 3) + 8 * (q >> 2) + 4 * hh; const bool keep = w < 4 ? (s < t) : (s <= t); if (!keep) { a0[q] = z0; a1[q] = z0; } }
        if (w < 4) { st_tile(a0, S_Q0a, 32 * mb, 32 * nb, r, hh); st_tile_t(a0, S_Q0b, 32 * mb, 32 * nb, r, hh); st_tile(a1, S_Na, 32 * mb, 32 * nb, r, hh);
            pacc = a0;
#pragma unroll
            for (int q = 0; q < 16; ++q) { const int t = 32 * mb + (q & 3) + 8 * (q >> 2) + 4 * hh; if (t == s) pacc[q] += 1.0f; }
            st_tile(pacc, S_PP0, 32 * mb, 32 * nb, r, hh); }
        else { st_tile(a0, S_Pa, 32 * mb, 32 * nb, r, hh); st_tile(a1, S_Qa, 32 * mb, 32 * nb, r, hh); zero16(pacc, z0); }
    }
    lds_barrier();
    {
        f32x16 a; zero16(a, z0);
        if (w >= 4) { if (!upper) { mm64(a, Qa[0] + 32 * mb * CLS, Qb[0] + 32 * nb * CLS, r, hh); } st_tile(a, Qa[1], 32 * mb, 32 * nb, r, hh); st_tile_t(a, Qb[1], 32 * mb, 32 * nb, r, hh); }
        else { mm64(a, S_Na + 32 * mb * CLS, S_VTcm + 32 * nb * CLS, r, hh); st_tile_t(a, S_XT, 32 * mb, 32 * nb, r, hh); }
    }
    lds_barrier();
#pragma unroll 1
    for (int k = 1; k <= 5; ++k) {
        const int rs = k & 1, ws_ = rs ^ 1;
        if (w < 4) { if (!upper) mm64(pacc, PPa[ws_] + 32 * mb * CLS, Qb[rs] + 32 * nb * CLS, r, hh); st_tile(pacc, PPa[rs], 32 * mb, 32 * nb, r, hh); }
        else if (k < 5) { f32x16 a; zero16(a, z0); if (!upper) mm64(a, Qa[rs] + 32 * mb * CLS, Qb[rs] + 32 * nb * CLS, r, hh); st_tile(a, Qa[ws_], 32 * mb, 32 * nb, r, hh); st_tile_t(a, Qb[ws_], 32 * mb, 32 * nb, r, hh); }
        lds_barrier();
    }
    {
        f32x16 a; zero16(a, z0);
        mm64(a, PPa[1] + 32 * mb * CLS, (w < 4 ? S_ATcm : S_XT) + 32 * nb * CLS, r, hh);
        st_tile_t(a, w < 4 ? S_Q0a : S_Q0b, 32 * mb, 32 * nb, r, hh);
    }
    lds_barrier();
    {
        LAS bf16_t* W1T = S_Q0a; LAS bf16_t* U1T = S_Q0b;
        f32x16 a, b; zero16(a, z0); zero16(b, z0);
        GAS u32x4* o128 = (GAS u32x4*)out;
        if (w < 4) {
            mm64(a, S_BBcm + 32 * mb * CLS, U1T + 32 * nb * CLS, r, hh); mm64(a, S_KBcm + 32 * mb * CLS, S_VTcm + 32 * nb * CLS, r, hh);
            mm64(b, W1T + 32 * mb * CLS, S_BBcm + 32 * nb * CLS, r, hh);
            const float gam = S_TOT[512 + 32 * nb + r];
#pragma unroll
            for (int q = 0; q < 16; ++q) { const int j = 32 * mb + (q & 3) + 8 * (q >> 2) + 4 * hh; if (j == 32 * nb + r) b[q] += gam; }
            u32x4 h0, h1, g0, g1;
            h0.x = cvtpk(a[0], a[1]); h0.y = cvtpk(a[2], a[3]); h0.z = cvtpk(a[4], a[5]); h0.w = cvtpk(a[6], a[7]);
            h1.x = cvtpk(a[8], a[9]); h1.y = cvtpk(a[10], a[11]); h1.z = cvtpk(a[12], a[13]); h1.w = cvtpk(a[14], a[15]);
            g0.x = cvtpk(b[0], b[1]); g0.y = cvtpk(b[2], b[3]); g0.z = cvtpk(b[4], b[5]); g0.w = cvtpk(b[6], b[7]);
            g1.x = cvtpk(b[8], b[9]); g1.y = cvtpk(b[10], b[11]); g1.z = cvtpk(b[12], b[13]); g1.w = cvtpk(b[14], b[15]);
            o128[1024 + ((mb * 2 + nb) * 64 + lane) * 2] = h0; o128[1024 + ((mb * 2 + nb) * 64 + lane) * 2 + 1] = h1;
            o128[(nb * 4 + 2 * mb) * 64 + lane] = g0; o128[(nb * 4 + 2 * mb + 1) * 64 + lane] = g1;
        } else {
            mm64(a, S_Pa + 32 * mb * CLS, U1T + 32 * nb * CLS, r, hh); mm64(a, S_Qa + 32 * mb * CLS, S_VTcm + 32 * nb * CLS, r, hh);
            mm64(b, W1T + 32 * mb * CLS, S_Pa + 32 * nb * CLS, r, hh);
#pragma unroll
            for (int g = 0; g < 4; ++g) { const s16x4 rv = *(const LAS s16x4*)(S_RTtm + (32 * nb + r) * CLS + 32 * mb + 8 * g + 4 * hh);
#pragma unroll
                for (int e = 0; e < 4; ++e) b[4 * g + e] += bf2f((bf16_t)rv[e]); }
            u32x4 y0, y1, r0, r1;
            y0.x = cvtpk(a[0], a[1]); y0.y = cvtpk(a[2], a[3]); y0.z = cvtpk(a[4], a[5]); y0.w = cvtpk(a[6], a[7]);
            y1.x = cvtpk(a[8], a[9]); y1.y = cvtpk(a[10], a[11]); y1.z = cvtpk(a[12], a[13]); y1.w = cvtpk(a[14], a[15]);
            r0.x = cvtpk(b[0], b[1]); r0.y = cvtpk(b[2], b[3]); r0.z = cvtpk(b[4], b[5]); r0.w = cvtpk(b[6], b[7]);
            r1.x = cvtpk(b[8], b[9]); r1.y = cvtpk(b[10], b[11]); r1.z = cvtpk(b[12], b[13]); r1.w = cvtpk(b[14], b[15]);
            o128[1536 + ((mb * 2 + nb) * 64 + lane) * 2] = y0; o128[1536 + ((mb * 2 + nb) * 64 + lane) * 2 + 1] = y1;
            o128[512 + (nb * 4 + 2 * mb) * 64 + lane] = r0; o128[512 + (nb * 4 + 2 * mb + 1) * 64 + lane] = r1;
        }
    }
    lds_barrier();
}

struct ScP { const unsigned char* CHK; bf16_t* YS; };
__device__ __forceinline__ void scan_unpack16(f32x16& acc, const u32x4 y0, const u32x4 y1) {
    acc[0] = __uint_as_float(y0.x << 16); acc[1] = __uint_as_float(y0.x & 0xffff0000u); acc[2] = __uint_as_float(y0.y << 16); acc[3] = __uint_as_float(y0.y & 0xffff0000u);
    acc[4] = __uint_as_float(y0.z << 16); acc[5] = __uint_as_float(y0.z & 0xffff0000u); acc[6] = __uint_as_float(y0.w << 16); acc[7] = __uint_as_float(y0.w & 0xffff0000u);
    acc[8] = __uint_as_float(y1.x << 16); acc[9] = __uint_as_float(y1.x & 0xffff0000u); acc[10] = __uint_as_float(y1.y << 16); acc[11] = __uint_as_float(y1.y & 0xffff0000u);
    acc[12] = __uint_as_float(y1.z << 16); acc[13] = __uint_as_float(y1.z & 0xffff0000u); acc[14] = __uint_as_float(y1.w << 16); acc[15] = __uint_as_float(y1.w & 0xffff0000u);
}
__device__ __forceinline__ void scan_step(const LAS unsigned char* sl, LAS float* ybuf, f32x16 (&st)[2], int w, int lane, int r, int hh) {
    bf16x8 ar[2][4], ag[2][4]; u32x4 yi[2][2], hi[2][2];
#pragma unroll
    for (int tb = 0; tb < 2; ++tb) { const LAS u32x4* yf = (const LAS u32x4*)(sl + 24576) + ((tb * 2 + w) * 64 + lane) * 2; yi[tb][0] = yf[0]; yi[tb][1] = yf[1];
        const LAS u32x4* hf = (const LAS u32x4*)(sl + 16384) + ((tb * 2 + w) * 64 + lane) * 2; hi[tb][0] = hf[0]; hi[tb][1] = hf[1];
#pragma unroll
        for (int ks = 0; ks < 4; ++ks) { ar[tb][ks] = *(const LAS bf16x8*)(sl + 8192 + ((tb * 4 + ks) * 64 + lane) * 16); ag[tb][ks] = *(const LAS bf16x8*)(sl + ((tb * 4 + ks) * 64 + lane) * 16); } }
    bf16x8 sf[4];
    sf[0] = pack8(st[0], 0); sf[1] = pack8(st[0], 1); sf[2] = pack8(st[1], 0); sf[3] = pack8(st[1], 1);
    f32x16 ya[2], sa[2];
#pragma unroll
    for (int tb = 0; tb < 2; ++tb) { scan_unpack16(ya[tb], yi[tb][0], yi[tb][1]); scan_unpack16(sa[tb], hi[tb][0], hi[tb][1]); }
#pragma unroll
    for (int ks = 0; ks < 4; ++ks) {
        ya[0] = __builtin_amdgcn_mfma_f32_32x32x16_bf16(ar[0][ks], sf[ks], ya[0], 0, 0, 0); ya[1] = __builtin_amdgcn_mfma_f32_32x32x16_bf16(ar[1][ks], sf[ks], ya[1], 0, 0, 0);
        sa[0] = __builtin_amdgcn_mfma_f32_32x32x16_bf16(ag[0][ks], sf[ks], sa[0], 0, 0, 0); sa[1] = __builtin_amdgcn_mfma_f32_32x32x16_bf16(ag[1][ks], sf[ks], sa[1], 0, 0, 0); }
    st[0] = sa[0]; st[1] = sa[1];
#pragma unroll
    for (int tb = 0; tb < 2; ++tb)
#pragma unroll
        for (int q = 0; q < 16; ++q) ybuf[(32 * tb + (q & 3) + 8 * (q >> 2) + 4 * hh) * 64 + 32 * w + r] = ya[tb][q];
}
__device__ __forceinline__ void rwkv_scan_unit(LAS unsigned char* lds, const ScP& P, int seq0, int seqm, int nmeta, int nreal, int brow0, int hd, bool write_meta, const float* st_in, float* st_out) {
    const int tid = opq(threadIdx.x), lane = tid & 63, w = __builtin_amdgcn_readfirstlane(tid >> 6), r = lane & 31, hh = lane >> 5;
    const int N = nmeta + nreal;
    float z0 = 0.f; asm volatile("" : "+v"(z0));
    LAS float* ybuf = (LAS float*)(lds + 65536);
    f32x16 st[2]; zero16(st[0], z0); zero16(st[1], z0);
    if (st_in != nullptr && w < 2) { const GAS f32x4* sp = (const GAS f32x4*)(st_in + ((size_t)w * 64 + lane) * 32);
#pragma unroll
        for (int i = 0; i < 8; ++i) { const f32x4 v = sp[i];
#pragma unroll
            for (int j = 0; j < 4; ++j) st[i >> 2][4 * (i & 3) + j] = v[j]; } }
    const int c = hd * 64 + lane;
#define SCAN_SRC(n_) ((const GAS u32x4*)(P.CHK + ((size_t)((n_) < nmeta ? seqm : seq0 + (n_) - nmeta) * 8 + hd) * CHK_BYTES))
    u32x4 pa[4], pb[4], pc[4];
    { const GAS u32x4* s0 = SCAN_SRC(0); const GAS u32x4* s1 = SCAN_SRC(1); const GAS u32x4* s2 = SCAN_SRC(2);
#pragma unroll
      for (int i = 0; i < 4; ++i) pc[i] = s0[tid + 512 * i];
#pragma unroll
      for (int i = 0; i < 4; ++i) pa[i] = s1[tid + 512 * i];
#pragma unroll
      for (int i = 0; i < 4; ++i) pb[i] = s2[tid + 512 * i];
#pragma unroll
      for (int i = 0; i < 4; ++i) *(LAS u32x4*)(lds + (tid + 512 * i) * 16) = pc[i]; }
    lds_barrier();
#define SCAN_ITER(n_, PCUR, PMID, PNEXT) do { \
        const int n = (n_); \
        if (n + 3 < N) { const GAS u32x4* s3 = SCAN_SRC(n + 3); _Pragma("unroll") for (int i = 0; i < 4; ++i) PNEXT[i] = s3[tid + 512 * i]; } \
        if (w < 2) scan_step(lds + (n & 1) * 32768, ybuf, st, w, lane, r, hh); \
        lds_barrier(); \
        if (n + 1 < N) { _Pragma("unroll") for (int i = 0; i < 4; ++i) *(LAS u32x4*)(lds + ((n + 1) & 1) * 32768 + (tid + 512 * i) * 16) = PCUR[i]; } \
        if (w >= 2) { const int crow0 = n < nmeta ? RREAL : brow0 + 64 * (n - nmeta); const int nrow = n < nmeta ? (write_meta ? NMETA : 0) : 64; \
            for (int t = w - 2; t < nrow; t += 6) ((GAS bf16_t*)P.YS)[(size_t)(crow0 + t) * 512 + c] = f2bf_hw(ybuf[t * 64 + lane]); } \
        lds_barrier(); } while (0)
    int n3 = 0;
#pragma unroll 1
    for (; n3 + 3 <= N; n3 += 3) { SCAN_ITER(n3, pa, pb, pc); SCAN_ITER(n3 + 1, pb, pc, pa); SCAN_ITER(n3 + 2, pc, pa, pb); }
    if (N - n3 >= 1) SCAN_ITER(n3, pa, pb, pc);
    if (N - n3 >= 2) SCAN_ITER(n3 + 1, pb, pc, pa);
#undef SCAN_ITER
#undef SCAN_SRC
    if (st_out != nullptr && w < 2) { GAS f32x4* sp = (GAS f32x4*)(st_out + ((size_t)w * 64 + lane) * 32);
#pragma unroll
        for (int i = 0; i < 8; ++i) { f32x4 v;
#pragma unroll
            for (int j = 0; j < 4; ++j) v[j] = st[i >> 2][4 * (i & 3) + j];
            sp[i] = v; } }
}
struct PostP { const bf16_t* YS; const bf16_t* VP; const float* RK; const bf16_t* LO; bf16_t* MIX; const float *ln_w, *ln_b; };
__device__ __forceinline__ void rwkv_post(const PostP& P, int q, int rlo, int rhi, bool with_meta, int gw, int ngw, int lane) {
    lane = opq(lane);
    const int nreal = (rhi - rlo) * 8, ntot = nreal + (with_meta ? NMETA * 8 : 0);
    for (int item = gw; item < ntot; item += ngw) { const int ri = rlo + (item >> 3); const int row = item < nreal ? (ri >> 10) * SEQ + 1024 * q + (ri & 1023) : RREAL + ((item - nreal) >> 3); const int hd = item & 7, c = hd * 64 + lane;
        const float y = bf2f(P.YS[(size_t)row * 512 + c]); const float g = bf2f(P.LO[(size_t)row * 1536 + 1024 + c]), vp = bf2f(P.VP[(size_t)row * 512 + c]), rk = P.RK[(size_t)row * 8 + hd];
        const float mean = wave_sum(y) * (1.f / 64.f); const float d = y - mean; const float var = wave_sum(d * d) * (1.f / 64.f);
        const float yn = d * rsqrtf(var + GN_EPS) * P.ln_w[c] + P.ln_b[c];
        P.MIX[(size_t)row * D + 512 + c] = f2bf_hw((yn + rk * vp) * g); }
}

constexpr int LDS_BYTES = 147456, LDS_MISC = LDS_BYTES - 512;
struct Params { const float* in[33]; float* out; unsigned char* ws; };
constexpr int CW_BAR = 4096;


#ifndef PROBE_REP_MISC
#define PROBE_REP_MISC 1
#endif
#ifndef MOE_TAIL
#define MOE_TAIL 0
#endif
#ifndef PROBE_REP_OUTPROJ
#define PROBE_REP_OUTPROJ 1
#endif
#ifndef PROBE_REP_FFNDN
#define PROBE_REP_FFNDN 1
#endif
#ifndef PROBE_REP_MOEDN
#define PROBE_REP_MOEDN 1
#endif
#ifndef PROBE_REP_NORM
#define PROBE_REP_NORM 1
#endif
#ifndef PROBE_REP_INPROJ
#define PROBE_REP_INPROJ 1
#endif
#ifndef PROBE_REP_PREP
#define PROBE_REP_PREP 1
#endif
#ifndef PROBE_REP_P4A
#define PROBE_REP_P4A 1
#endif
#ifndef PROBE_REP_ATT
#define PROBE_REP_ATT 1
#endif
#ifndef PROBE_REP_P4B
#define PROBE_REP_P4B 1
#endif
#ifndef PROBE_REP_CP
#define PROBE_REP_CP 1
#endif
#ifndef PROBE_REP_SCAN
#define PROBE_REP_SCAN 1
#endif
#ifndef PROBE_REP_FFNGU
#define PROBE_REP_FFNGU 1
#endif
#ifndef PROBE_REP_MOETR
#define PROBE_REP_MOETR 1
#endif
#ifndef PROBE_REP_GATHER
#define PROBE_REP_GATHER 1
#endif
#ifndef PROBE_REP_MOEGU
#define PROBE_REP_MOEGU 1
#endif
#define LDP(k) ((const float*)ldk(kp, 8 * (k)))
#define OUTP ((float*)ldk(kp, 264))
#define WSP ((unsigned char*)ldk(kp, 272))
#define NOINL __device__ __attribute__((noinline))
#define WAVE_IDS() const int tid = threadIdx.x, lane = tid & 63, wave = __builtin_amdgcn_readfirstlane(tid >> 6), bid = (int)blockIdx.x, nblk = (int)gridDim.x, gw = bid * 8 + wave, ngw = nblk * 8; (void)lane; (void)gw; (void)ngw
NOINL void f_p0(unsigned long long kp_, LAS unsigned char* lds) {
    const unsigned long long kp = kp_uniform(kp_); WAVE_IDS(); LAS float* scr = (LAS float*)(lds + wave * 8448);
    {
        unsigned* ctl = (unsigned*)(WSP + WS_CTL);
#pragma unroll 1
        for (int te = wave; te < 24; te += 8) { const int t = te >> 3, e = te & 7;
            const float* wt = t == 0 ? LDP(30) : (t == 1 ? LDP(31) : LDP(32));
            const f32x4 v = ((const f32x4*)(wt + (size_t)e * ((size_t)D * FFE) + (size_t)(bid % 256) * 14336))[lane];
            const float m = wave_max(fmaxf(fmaxf(fabsf(v.x), fabsf(v.y)), fmaxf(fabsf(v.z), fabsf(v.w))));
            if (lane == 0) atomicMax(&ctl[CW_WMAX + te], __float_as_uint(m)); } }
    { unsigned char* ws = WSP;
      ph_init(LDP(0), LDP(1), OUTP, (float*)(ws + WS_HMETA), (float*)(ws + WS_ROPE), LDP(23), LDP(24), (bf16_t*)(ws + WS_V1T), (size_t)bid * 512 + tid, (size_t)nblk * 512); }
#pragma unroll 1
    for (int l = 0; l < 2; ++l) { unsigned char* lw = WSP + WS_WB + l * LW_STRIDE;
        { const TrJob J{LDP(5) + (size_t)l * D * 2624, nullptr, (bf16_t*)(lw + LW_WIN), D, 2624, 1024, 0, 1, 0}; ph_transpose(J, scr, gw, ngw, lane); }
        { const TrJob J{LDP(9) + (size_t)l * 512 * 768, LDP(7) + l * 512, (bf16_t*)(lw + LW_WUQ), 512, 768, 512, 0, 0, 0}; ph_transpose(J, scr, gw, ngw, lane); }
        { const TrJob J{LDP(10) + (size_t)l * 256 * 1024, LDP(8) + l * 256, (bf16_t*)(lw + LW_WK), 256, 1024, 256, 0, 4, 0}; ph_transpose(J, scr, gw, ngw, lane); }
        { const TrJob J{LDP(13) + (size_t)l * 64 * 512, nullptr, (bf16_t*)(lw + LW_LORA), 64, 512, 256, 0, 0, 0}; ph_transpose(J, scr, gw, ngw, lane); }
        { const TrJob J{LDP(15) + (size_t)l * 64 * 512, nullptr, (bf16_t*)(lw + LW_LORA), 64, 512, 256, 64, 0, 512}; ph_transpose(J, scr, gw, ngw, lane); }
        { const TrJob J{LDP(16) + (size_t)l * 128 * 512, nullptr, (bf16_t*)(lw + LW_LORA), 128, 512, 256, 128, 0, 1024}; ph_transpose(J, scr, gw, ngw, lane); }
        { const TrJob J{LDP(6) + (size_t)l * D * D, nullptr, (bf16_t*)(lw + LW_WOUT), D, D, 1024, 0, 0, 0}; ph_transpose(J, scr, gw, ngw, lane); }
    }
    { const TrJob J{LDP(25), nullptr, (bf16_t*)(WSP + WS_FGU), D, FF0, 1024, 0, 2, 0}; ph_transpose(J, scr, gw, ngw, lane); }
    { const TrJob J{LDP(26), nullptr, (bf16_t*)(WSP + WS_FGU), D, FF0, 1024, 0, 3, 0}; ph_transpose(J, scr, gw, ngw, lane); }
    { const TrJob J{LDP(27), nullptr, (bf16_t*)(WSP + WS_FDN), FF0, D, FF0, 0, 0, 0}; ph_transpose(J, scr, gw, ngw, lane); }
}
NOINL void f_rmsnorm(unsigned long long kp_, int which, int l) { const unsigned long long kp = kp_uniform(kp_); which = __builtin_amdgcn_readfirstlane(which); l = __builtin_amdgcn_readfirstlane(l); WAVE_IDS(); unsigned char* ws = WSP;
    const float* hsrc = (which == 0 && l == 0) ? LDP(0) : (const float*)OUTP;
    ph_rmsnorm(hsrc, (const float*)(ws + WS_HMETA), (which ? LDP(3) : LDP(2)) + l * D, (bf16_t*)(ws + A_U), (const float*)(ws + A_PART), which ? 4 : (l ? 11 : 0), gw, ngw, lane); }
NOINL void f_prep(unsigned long long kp_, int l) { const unsigned long long kp = kp_uniform(kp_); l = __builtin_amdgcn_readfirstlane(l); WAVE_IDS(); unsigned char* ws = WSP;
    ph_prep((const bf16_t*)(ws + A_PM), (const bf16_t*)(ws + A_PR), LDP(11) + l * 1792, (const float*)(ws + WS_ROPE), (float*)(ws + A_RSTDQ), (float*)(ws + A_RSTDKV),
            (bf16_t*)(ws + A_KROPE), (bf16_t*)(ws + A_LIN), (bf16_t*)(ws + A_VSH), l, gw, ngw, lane); }
constexpr int RW_NSEQ = 129;
constexpr size_t RW_BUF = (size_t)RW_NSEQ * 8 * CHK_BYTES;
static_assert(2 * RW_BUF <= A_VFIRST - A_CHK, "two chunk buffers fit the chunk region");
constexpr int RW_SKIP = 4;
__device__ __forceinline__ bool rw_is_scan_wg(int bid) { return (bid & 3) == 0; }
__device__ __forceinline__ int rw_rank(int bid) { return bid - (bid >> 2) - 1; }
__device__ __forceinline__ void f_rwkv_cp(unsigned long long kp_, LAS unsigned char* lds, int l, int q) {
    const unsigned long long kp = kp_uniform(kp_); l = __builtin_amdgcn_readfirstlane(l); q = __builtin_amdgcn_readfirstlane(q);
    const int bid = (int)blockIdx.x, nblk = (int)gridDim.x; unsigned char* ws = WSP;
    const CpP cp{(const bf16_t*)(ws + A_PR), (const bf16_t*)(ws + A_LOUT), (const bf16_t*)(ws + A_VMIX), (const bf16_t*)(ws + A_VFIRST), (bf16_t*)(ws + (l ? A_VP : A_VFIRST)), (float*)(ws + A_RK), ws + A_CHK + (size_t)(q & 1) * RW_BUF,
                 LDP(11) + l * 1792, LDP(12) + l * 512, LDP(14) + l * 512, LDP(17) + l * 512, LDP(18) + l * 512, LDP(19) + l * 512, LDP(22), l, 0};
    const int ntask = (q == 0 ? RW_NSEQ : RW_NSEQ - 1) * 8, hs = q == 0 ? 0 : RW_SKIP, NS = nblk - ((nblk + 3) >> 2);
    const bool scanwg = rw_is_scan_wg(bid); const int rank = rw_rank(bid);
#define RW_TASK(i_) (scanwg ? hs * NS + (i_) * nblk + bid : ((i_) < hs ? (i_) * NS + rank : hs * NS + ((i_) - hs) * nblk + bid))
#define RW_ROW0(t_) (((t_) >> 3) == 128 ? RREAL : ((t_) >> 7) * SEQ + (16 * q + (((t_) >> 3) & 15)) * 64)
    const int tid_ = opq(threadIdx.x), lane_ = tid_ & 63, w_ = __builtin_amdgcn_readfirstlane(tid_ >> 6);
    int task = RW_TASK(0); if (task >= ntask) return;
    CpRaw raw; cp_issue(cp, RW_ROW0(task), task & 7, w_, lane_, raw);
#pragma unroll 1
    for (int i = 0; ; ++i) { const int nxt = RW_TASK(i + 1); const bool has_next = nxt < ntask;
        rwkv_cp_task(lds, cp, RW_ROW0(task), task & 7, cp.CHK + (size_t)task * CHK_BYTES, raw, has_next, has_next ? RW_ROW0(nxt) : 0, nxt & 7);
        if (!has_next) break;
        task = nxt; }
#undef RW_TASK
#undef RW_ROW0
}
__device__ __forceinline__ void f_rwkv_scan(unsigned long long kp_, LAS unsigned char* lds, int l, int q) {
    const unsigned long long kp = kp_uniform(kp_); l = __builtin_amdgcn_readfirstlane(l); q = __builtin_amdgcn_readfirstlane(q);
    const int bid = (int)blockIdx.x, nblk = (int)gridDim.x; if (!rw_is_scan_wg(bid)) return;
    unsigned char* ws = WSP; const ScP sp{ws + A_CHK + (size_t)(q & 1) * RW_BUF, (bf16_t*)(ws + A_YS)};
#pragma unroll 1
    for (int unit = bid >> 2; unit < 64; unit += (nblk + 3) >> 2) { const int b = unit >> 3, hd = unit & 7; float* stp = (float*)(ws + A_SCST) + (size_t)unit * 4096;
        rwkv_scan_unit(lds, sp, b * 16, 128, q == 0 ? 1 : 0, 16, b * SEQ + q * 1024, hd, q == 0 && b == 0, q == 0 ? nullptr : stp, q == 3 ? nullptr : stp); }
}
NOINL void f_rwkv_post(unsigned long long kp_, int l, int q, int mode) {
    const unsigned long long kp = kp_uniform(kp_); l = __builtin_amdgcn_readfirstlane(l); q = __builtin_amdgcn_readfirstlane(q); mode = __builtin_amdgcn_readfirstlane(mode); WAVE_IDS(); unsigned char* ws = WSP;
    const PostP pp{(const bf16_t*)(ws + A_YS), (const bf16_t*)(ws + (l ? A_VP : A_VFIRST)), (const float*)(ws + A_RK), (const bf16_t*)(ws + A_LOUT), (bf16_t*)(ws + A_PM), LDP(20) + l * 512, LDP(21) + l * 512};
    const bool scanwg = rw_is_scan_wg(bid); const int nscan = (nblk + 3) >> 2, NS = nblk - nscan;
    if (mode == 2) rwkv_post(pp, q, 0, 8192, q == 0, gw, ngw, lane);
    else if (mode == 1) { if (!scanwg) rwkv_post(pp, q, 0, 8192, q == 0, rw_rank(bid) * 8 + wave, NS * 8, lane); }
    else if (scanwg) rwkv_post(pp, q, 0, 4096, false, (bid >> 2) * 8 + wave, nscan * 8, lane);
    else rwkv_post(pp, q, 4096, 8192, q == 0, rw_rank(bid) * 8 + wave, NS * 8, lane); }
NOINL void f_ffn_meta(unsigned long long kp_) {
    const unsigned long long kp = kp_uniform(kp_); WAVE_IDS(); unsigned char* ws = WSP;
    const int job = bid * 8 + wave; if (job >= FF0 / 16) return;
    const int f0 = job * 16, l15 = lane & 15, kq = lane >> 4;
    const bf16_t* wg = (const bf16_t*)(ws + WS_FGU) + (size_t)((f0 >> 7) * 256 + (f0 & 127) + l15) * 1024 + 8 * kq;
    const bf16_t* wu = wg + (size_t)128 * 1024;
    const bf16_t* xu = (const bf16_t*)(ws + A_U) + (size_t)(RREAL + l15) * D + 8 * kq;
    f32x4 ag = {0.f, 0.f, 0.f, 0.f}, au = {0.f, 0.f, 0.f, 0.f};
#pragma unroll 8
    for (int ks = 0; ks < 32; ++ks) { const bf16x8 a = *(const GAS bf16x8*)(wg + 32 * ks), b = *(const GAS bf16x8*)(wu + 32 * ks), x = *(const GAS bf16x8*)(xu + 32 * ks);
        ag = __builtin_amdgcn_mfma_f32_16x16x32_bf16(a, x, ag, 0, 0, 0); au = __builtin_amdgcn_mfma_f32_16x16x32_bf16(b, x, au, 0, 0, 0); }
    float r[4];
#pragma unroll
    for (int j = 0; j < 4; ++j) { const float g = ag[j], up = au[j]; r[j] = g / (1.0f + __expf(-g)) * up; }
    u32x2 o; o.x = cvtpk(r[0], r[1]); o.y = cvtpk(r[2], r[3]);
    *(GAS u32x2*)((bf16_t*)(ws + A_ACT0) + (size_t)(RREAL + l15) * FF0 + f0 + 4 * kq) = o;
}
NOINL void f_moe_tr(unsigned long long kp_, LAS unsigned char* lds) {
    const unsigned long long kp = kp_uniform(kp_); WAVE_IDS(); LAS float* scr = (LAS float*)(lds + wave * 8448);
    if (bid == 0 && tid < 24) { unsigned* ctlw = (unsigned*)(WSP + WS_CTL); const float sc = moe_wscale_bits(ctlw[CW_WMAX + tid]); ctlw[CW_WINV + tid] = __float_as_uint(1.0f / (F8_ACT * sc)); }
#pragma unroll 1
    for (int e = 0; e < NEXP * PROBE_REP_MOETR; ++e) { const int ee = e % NEXP;
        const unsigned* ctl = (const unsigned*)(WSP + WS_CTL);
        { const TrJob8 J{LDP(30) + (size_t)ee * D * FFE, WSP + A_MGU, D, FFE, 1024, 2, ee * 2 * FFE, moe_wscale(ctl, 0, ee)}; ph_transpose_f8(J, scr, gw, ngw, lane); }
        { const TrJob8 J{LDP(31) + (size_t)ee * D * FFE, WSP + A_MGU, D, FFE, 1024, 3, ee * 2 * FFE, moe_wscale(ctl, 1, ee)}; ph_transpose_f8(J, scr, gw, ngw, lane); }
        { const TrJob8 J{LDP(32) + (size_t)ee * FFE * D, WSP + A_MDN, FFE, D, FFE, 0, ee * D, moe_wscale(ctl, 2, ee)}; ph_transpose_f8(J, scr, gw, ngw, lane); }
    }
}
__device__ __forceinline__ void f_moe_route(unsigned long long kp_, LAS unsigned char* lds) {
    const unsigned long long kp = kp_uniform(kp_); WAVE_IDS(); unsigned char* ws = WSP;
    ph_norm_route(lds, OUTP, LDP(3) + D, LDP(28), LDP(29), (bf16_t*)(ws + A_U), (int*)(ws + A_MTAB + MT_E), (float*)(ws + A_MTAB + MT_G), (int*)(ws + A_MTAB + MT_STOK), (unsigned*)(ws + WS_CTL), bid, nblk, wave, lane); }
NOINL void f_moe_assign(unsigned long long kp_, LAS unsigned char* lds, int list) { const unsigned long long kp = kp_uniform(kp_); list = __builtin_amdgcn_readfirstlane(list); WAVE_IDS(); unsigned char* ws = WSP;
    ph_moe_assign(lds, list, (const int*)(ws + A_MTAB + MT_E), (const float*)(ws + A_MTAB + MT_G), (int*)(ws + A_MTAB + MT_STOK), (float*)(ws + A_MTAB + MT_SGATE), (int*)(ws + A_MTAB + MT_BE), (unsigned*)(ws + WS_CTL), ws + A_U, ws + A_XB, bid, nblk, tid); }
NOINL void f_final(unsigned long long kp_) { const unsigned long long kp = kp_uniform(kp_); WAVE_IDS(); unsigned char* ws = WSP; ph_final(OUTP, LDP(4), (const int*)(ws + A_MTAB + MT_TSLOT), (const float*)(ws + WS_TB), gw, ngw, lane); }

__global__ void __launch_bounds__(512, 2) fwd(Params P) {
    extern __shared__ __attribute__((aligned(16))) unsigned char lds_raw[];
    LAS unsigned char* lds = (LAS unsigned char*)lds_raw;
    const int tid = threadIdx.x;
    const int bid = (int)blockIdx.x, nblk = (int)gridDim.x;
    const unsigned long long kp = (unsigned long long)__builtin_amdgcn_kernarg_segment_ptr();
    volatile LAS unsigned* misc = (volatile LAS unsigned*)(lds + LDS_MISC);
    if (tid < 64) misc[tid] = 0u;
    __syncthreads();
    XcdBarrier bar;
    { unsigned* ctl0 = (unsigned*)(WSP + WS_CTL); bar = xcd_barrier_post(ctl0 + CW_BAR, misc + 8); }
#ifdef PROBE_BAR2
#define GRID_BAR() do { xcd_barrier(bar); xcd_barrier(bar); } while (0)
#else
#define GRID_BAR() xcd_barrier(bar)
#endif
    for (int rep_ = 0; rep_ < PROBE_REP_MISC; ++rep_) f_p0(kp, lds);
    GRID_BAR();

#pragma unroll 1
    for (int l = 0; l < 2; ++l) {
        for (int rep_ = 0; rep_ < PROBE_REP_NORM; ++rep_) f_rmsnorm(kp, 0, l);
        GRID_BAR();
_Pragma("unroll 1") for (int rep_ = 0; rep_ < PROBE_REP_INPROJ; ++rep_) {
        { unsigned char* ws = WSP; pg8::Gemm g{(const bf16_t*)(ws + A_U), (const bf16_t*)(ws + WS_WB + l * LW_STRIDE + LW_WIN), RP, 2816, 1024, 1024, 1024, 0}; pg8::StaticOrder S; S.init(RP, 2816, opqs(nblk), opqs(bid));
          EpiInProj E{(bf16_t*)(ws + A_PM), (bf16_t*)(ws + A_PR)};
          pg8::gemm_phase<EpiInProj, pg8::StaticOrder, true, true>(lds, g, S, E); }
}
        GRID_BAR();
        for (int rep_ = 0; rep_ < PROBE_REP_PREP; ++rep_) f_prep(kp, l);
        GRID_BAR();
_Pragma("unroll 1") for (int rep_ = 0; rep_ < PROBE_REP_P4A; ++rep_) {
        { unsigned char* ws = WSP; pg8::Gemm g{(const bf16_t*)(ws + A_PM), (const bf16_t*)(ws + WS_WB + l * LW_STRIDE + LW_WUQ), RP, 768, 512, 1024, 512, 0}; pg8::StaticOrder S; S.init(RP, 768, opqs(nblk), opqs(bid));
          EpiRowScale E{(bf16_t*)(ws + A_U), (const float*)(ws + A_RSTDQ), 768, 0};
          pg8::gemm_phase<EpiRowScale, pg8::StaticOrder, true, true>(lds, g, S, E); }
        { unsigned char* ws = WSP; pg8::Gemm g{(const bf16_t*)(ws + A_PM) + 512, (const bf16_t*)(ws + WS_WB + l * LW_STRIDE + LW_WK), RP, 512, 256, 1024, 256, 0}; pg8::StaticOrder S; S.init(RP, 512, opqs(nblk), opqs((bid + nblk - 131) % nblk));
          EpiRowScale E{(bf16_t*)(ws + A_KN), (const float*)(ws + A_RSTDKV), 512, 0};
          pg8::gemm_phase<EpiRowScale, pg8::StaticOrder, true, true>(lds, g, S, E); }
        { unsigned char* ws = WSP; pg8::Gemm g{(const bf16_t*)(ws + WS_WB + l * LW_STRIDE + LW_WV), (const bf16_t*)(ws + A_PM) + 512, 512, RP, 256, 256, 1024, 0}; pg8::StaticOrder S; S.init(512, RP, opqs(nblk), opqs((bid + nblk - 133) % nblk));
          EpiColScale E{(bf16_t*)(ws + A_VT), (const float*)(ws + A_RSTDKV), RP, 0};
          pg8::gemm_phase<EpiColScale, pg8::StaticOrder, true, true>(lds, g, S, E); }
}
        GRID_BAR();
_Pragma("unroll 1") for (int rep_ = 0; rep_ < PROBE_REP_ATT; ++rep_) {
        { unsigned char* ws = WSP; attn_phase(lds, (const bf16_t*)(ws + A_U), (const bf16_t*)(ws + A_KN), (const bf16_t*)(ws + A_KROPE), (const bf16_t*)(ws + A_VT), (bf16_t*)(ws + A_PM), (const float*)(ws + WS_ROPE), opqs(bid), opqs(nblk)); }
}
        GRID_BAR();
_Pragma("unroll 1") for (int rep_ = 0; rep_ < PROBE_REP_P4B; ++rep_) {
        { unsigned char* ws = WSP; pg8::Gemm g{(const bf16_t*)(ws + A_LIN), (const bf16_t*)(ws + WS_WB + l * LW_STRIDE + LW_LORA), RP, 1536, 256, 256, 256, 0}; pg8::StaticOrder S; S.init(RP, 1536, opqs(nblk), opqs(bid));
          EpiRowScale E{(bf16_t*)(ws + A_LOUT), nullptr, 1536, 0};
          pg8::gemm_phase<EpiRowScale, pg8::StaticOrder, true, true>(lds, g, S, E); }
        if (l == 1) {
            unsigned char* ws = WSP; pg8::Gemm g{(const bf16_t*)(ws + A_VSH), (const bf16_t*)(ws + WS_V1T), RP, 512, 512, 512, 512, 0}; pg8::StaticOrder S; S.init(RP, 512, opqs(nblk), opqs((bid + nblk - 6) % nblk));
            EpiRowScale E{(bf16_t*)(ws + A_VMIX), nullptr, 512, 0};
            pg8::gemm_phase<EpiRowScale, pg8::StaticOrder, true, true>(lds, g, S, E);
        }
}
        GRID_BAR();
#pragma unroll 1
        for (int stp = 0; stp < 6; ++stp) {
            if (stp >= 1 && stp <= 4) { _Pragma("unroll 1") for (int rep_ = 0; rep_ < PROBE_REP_SCAN; ++rep_) f_rwkv_scan(kp, lds, l, stp - 1); }
            if (stp <= 3) { _Pragma("unroll 1") for (int rep_ = 0; rep_ < PROBE_REP_CP; ++rep_) f_rwkv_cp(kp, lds, l, stp); }
            if (stp >= 2) { for (int rep_ = 0; rep_ < PROBE_REP_MISC; ++rep_) f_rwkv_post(kp, l, stp - 2, stp <= 3 ? 0 : stp - 3); }
            GRID_BAR();
        }
_Pragma("unroll 1") for (int rep_ = 0; rep_ < PROBE_REP_OUTPROJ; ++rep_) {
        { unsigned char* ws = WSP; pg8::Gemm g{(const bf16_t*)(ws + A_PM), (const bf16_t*)(ws + WS_WB + l * LW_STRIDE + LW_WOUT), RREAL, 1024, 1024, 1024, 1024, 0}; pg8::StaticOrder S; S.init(RREAL, 1024, opqs(nblk), opqs(bid));
          EpiResid E{OUTP, (float*)(ws + WS_HMETA), (l == 0 && rep_ == 0) ? LDP(0) : (const float*)OUTP, rep_ == 0 ? 1.0f : 0.0f, 0};
          pg8::gemm_phase<EpiResid, pg8::StaticOrder, true, true>(lds, g, S, E); }
        if (rep_ == 0 && l == 0) {
          unsigned char* ws = WSP; pg8::Gemm g{(const bf16_t*)(ws + A_PM), (const bf16_t*)(ws + WS_WB + l * LW_STRIDE + LW_WOUT), RP, 1024, 256, 1024, 1024, 0};
          const DenseTailOrder S{4, 4, opqs(nblk), opqs(bid)}; EpiResidPartial E{(float*)(ws + A_PART)};
          pg8::gemm_phase<EpiResidPartial, DenseTailOrder, true, true>(lds, g, S, E); }
}
        GRID_BAR();
        if (l == 0) {
            for (int rep_ = 0; rep_ < PROBE_REP_MISC; ++rep_) f_rmsnorm(kp, 1, 0);
            GRID_BAR();
_Pragma("unroll 1") for (int rep_ = 0; rep_ < PROBE_REP_FFNGU; ++rep_) {
            f_ffn_meta(kp);
            { unsigned char* ws = WSP; pg8::Gemm g{(const bf16_t*)(ws + A_U), (const bf16_t*)(ws + WS_FGU), RREAL, 2 * FF0, 1024, 1024, 1024, 0}; pg8::StaticOrder S; S.init(RREAL, 2 * FF0, opqs(nblk), opqs(bid));
              EpiSwiGLU E{(bf16_t*)(ws + A_ACT0), FF0, 22, 0, 0};
              pg8::gemm_phase<EpiSwiGLU, pg8::StaticOrder, true, true>(lds, g, S, E); }
}
            GRID_BAR();
_Pragma("unroll 1") for (int rep_ = 0; rep_ < PROBE_REP_FFNDN; ++rep_) {
            { unsigned char* ws = WSP; pg8::Gemm g{(const bf16_t*)(ws + A_ACT0), (const bf16_t*)(ws + WS_FDN), RREAL, 1024, FF0, FF0, FF0, 0}; pg8::StaticOrder S; S.init(RREAL, 1024, opqs(nblk), opqs(bid));
              EpiResid E{OUTP, (float*)(ws + WS_HMETA), (const float*)OUTP, rep_ == 0 ? 1.0f : 0.0f, 0};
              pg8::gemm_phase<EpiResid, pg8::StaticOrder, true, true>(lds, g, S, E); }
            if (rep_ == 0) {
              unsigned char* ws = WSP; pg8::Gemm g{(const bf16_t*)(ws + A_ACT0), (const bf16_t*)(ws + WS_FDN), RP, 1024, 256, FF0, FF0, 0};
              const DenseTailOrder S{4, 11, opqs(nblk), opqs(bid)}; EpiResidPartial E{(float*)(ws + A_PART)};
              pg8::gemm_phase<EpiResidPartial, DenseTailOrder, true, true>(lds, g, S, E); }
}
            GRID_BAR();
        } else {
            f_moe_tr(kp, lds);
            f_moe_route(kp, lds);
            GRID_BAR();
            f_moe_assign(kp, lds, 0);
            f_moe_assign(kp, lds, 1);
            GRID_BAR();
#pragma unroll 1
            for (int list = 0; list < 2; ++list) {
                const int np0 = __builtin_amdgcn_readfirstlane((int)((const unsigned*)(WSP + WS_CTL))[CW_NPAN]), np1 = __builtin_amdgcn_readfirstlane((int)((const unsigned*)(WSP + WS_CTL))[CW_NPAN + 1]);
                const int T0 = np0 > MOE_TAILPAN ? (np0 - MOE_TAILPAN) * 4 : 0, T1 = np1 > MOE_TAILPAN ? (np1 - MOE_TAILPAN) * 4 : 0;
                if (list == 1) {
                    { unsigned char* ws = WSP; pg8::Gemm g{(const bf16_t*)(ws + A_MACT), (const bf16_t*)(ws + A_MDN), 0, 0, FFE / 2, FFE / 2, FFE / 2, 0};
                      const MoeShiftTailOrder S{(const int*)(ws + A_MTAB + MT_BE), (const unsigned*)(ws + WS_CTL) + CW_NPAN, 4, 4, 0, opqs(nblk) - 1, opqs(bid), 0};
                      EpiMoeDown E{OUTP, (const int*)(ws + A_MTAB + MT_STOK), (const float*)(ws + A_MTAB + MT_SGATE), 4, 1.0f, (const unsigned*)(ws + WS_CTL)};
                      pg8::gemm_phase<EpiMoeDown, MoeShiftTailOrder, true, true, true>(lds, g, S, E); }
                    { unsigned char* ws = WSP; pg8::Gemm g{(const bf16_t*)(ws + A_MACT), (const bf16_t*)(ws + A_MDN), 0, 0, FFE / 2, FFE / 2, FFE / 2, 0};
                      const MoeShiftTailOrder S{(const int*)(ws + A_MTAB + MT_BE) + 256, (const unsigned*)(ws + WS_CTL) + CW_NPAN + 1, 4, 4, MOE_GAP, opqs(nblk) - 1 - T0, opqs(bid), 0};
                      EpiMoeDownStore E{(float*)(ws + WS_TB), (const int*)(ws + A_MTAB + MT_STOK) + MOE_MAXPAN * 256, (const float*)(ws + A_MTAB + MT_SGATE) + MOE_MAXPAN * 256, 4, MOE_TAILPAN + MOE_GAP, (const unsigned*)(ws + WS_CTL)};
                      pg8::gemm_phase<EpiMoeDownStore, MoeShiftTailOrder, true, true, true>(lds, g, S, E); }
                }
_Pragma("unroll 1") for (int rep_ = 0; rep_ < PROBE_REP_MOEGU; ++rep_) {
                { unsigned char* ws = WSP; pg8::Gemm g{(const bf16_t*)(ws + A_XB + (size_t)list * XB_LIST), (const bf16_t*)(ws + A_MGU), 0, 0, 512, 512, 512, 0};
                  const int Tt = list == 1 && T0 + T1 < opqs(nblk) ? T0 + T1 : 0;
                  const MoeSlotOrder S{(const int*)(ws + A_MTAB + MT_BE) + 256 * list, (const unsigned*)(ws + WS_CTL) + CW_NPAN + list, (const int*)(ws + A_MTAB + MT_STOK) + list * MOE_MAXPAN * 256, 28, 28, 0, opqs(nblk), opqs(bid), RREAL,
                                         0, list == 0 ? MOE_MAXPAN : MOE_TAILPAN, 0, 0, Tt, MOE_CSKIP};
                  EpiSwiGLU8 E{ws + A_MACT, (const unsigned*)(ws + WS_CTL), FFE, 28};
                  pg8::gemm_phase<EpiSwiGLU8, MoeSlotOrder, true, true, true>(lds, g, S, E); }
                if (list == 0) {
                  unsigned char* ws = WSP; pg8::Gemm g{(const bf16_t*)(ws + A_XB + XB_LIST), (const bf16_t*)(ws + A_MGU), 0, 0, 512, 512, 512, 0};
                  const int nb = opqs(nblk);
                  const MoeSlotOrder S{(const int*)(ws + A_MTAB + MT_BE) + 256, (const unsigned*)(ws + WS_CTL) + CW_NPAN + 1, (const int*)(ws + A_MTAB + MT_STOK) + MOE_MAXPAN * 256, 28, 28, 0, nb, opqs(bid), RREAL,
                                         MOE_TAILPAN, MOE_MAXPAN, MOE_GAP, (np0 * 28) % nb, 0, 0};
                  EpiSwiGLU8 E{ws + A_MACT, (const unsigned*)(ws + WS_CTL), FFE, 28};
                  pg8::gemm_phase<EpiSwiGLU8, MoeSlotOrder, true, true, true>(lds, g, S, E); }
}
                GRID_BAR();
_Pragma("unroll 1") for (int rep_ = 0; rep_ < PROBE_REP_MOEDN; ++rep_) {
                { unsigned char* ws = WSP; pg8::Gemm g{(const bf16_t*)(ws + A_MACT), (const bf16_t*)(ws + A_MDN), 0, 0, FFE / 2, FFE / 2, FFE / 2, 0};
                  const MoeOrder S{(const int*)(ws + A_MTAB + MT_BE) + 256 * list, (const unsigned*)(ws + WS_CTL) + CW_NPAN + list, 4, 4, 0, opqs(nblk), opqs(bid), MOE_TAILPAN * 4};
                  EpiMoeDown E{OUTP, (const int*)(ws + A_MTAB + MT_STOK) + list * MOE_MAXPAN * 256, (const float*)(ws + A_MTAB + MT_SGATE) + list * MOE_MAXPAN * 256, 4, rep_ == 0 ? 1.0f : 0.0f, (const unsigned*)(ws + WS_CTL)};
                  pg8::gemm_phase<EpiMoeDown, MoeOrder, true, true, true>(lds, g, S, E); }
}
                GRID_BAR();
            }
        }
    }
    f_final(kp);
}

extern "C" void kernel_launch(void* const* d_in, const int* in_sizes, int n_in, void* d_out, int out_size, void* d_ws, size_t ws_size, hipStream_t stream) {
    static int grid = 0;
    if (grid == 0) {
        if (n_in != 33 || ws_size < WS_NEED || out_size != RREAL * D) { fprintf(stderr, "kernel_launch: unexpected arguments (n_in %d, ws %zu need %zu, out %d)\n", n_in, ws_size, (size_t)WS_NEED, out_size); grid = -1; return; }
        int dev = 0, cus = 0;
        if (hipGetDevice(&dev) != hipSuccess || hipDeviceGetAttribute(&cus, hipDeviceAttributeMultiprocessorCount, dev) != hipSuccess) { grid = -1; return; }
        if (hipFuncSetAttribute((const void*)fwd, hipFuncAttributeMaxDynamicSharedMemorySize, LDS_BYTES) != hipSuccess) { fprintf(stderr, "kernel_launch: hipFuncSetAttribute failed\n"); grid = -1; return; }
        int per_cu = 0; (void)hipOccupancyMaxActiveBlocksPerMultiprocessor(&per_cu, (const void*)fwd, 512, LDS_BYTES); (void)hipGetLastError();
        grid = cus;
    }
    if (grid < 0) return;
    unsigned char* ws = (unsigned char*)d_ws;
    (void)hipMemsetAsync(ws + WS_CTL, 0, 1 * MiB, stream);
    (void)hipMemsetAsync(ws + WS_WB, 0, WS_ROPE - WS_WB, stream);
    Params p{};
    for (int i = 0; i < 33; ++i) p.in[i] = (const float*)d_in[i];
    p.out = (float*)d_out; p.ws = ws;
    hipLaunchKernelGGL(fwd, dim3(grid), dim3(512), LDS_BYTES, stream, p);
}
```

```cpp
#include <hip/hip_runtime.h>
#include <cstdio>
#include <cstdint>
namespace pg8 {
#define PG8_LAS __attribute__((address_space(3)))
typedef unsigned short bf16_t;
typedef short bf16x8 __attribute__((ext_vector_type(8)));
typedef float f32x4 __attribute__((ext_vector_type(4)));
typedef unsigned u32x4 __attribute__((ext_vector_type(4)));
constexpr int BM = 256, BK = 64, HALF = 128, HTB = HALF * BK * 2  , STAGE_BYTES = 8 * HTB, NXCD = 8, WGM = 8;

__host__ __device__ __forceinline__ int lds_byte(int r, int c) { const int st = (r >> 4) * 2 + (c >> 5), rr = r & 15, cc = c & 31, ob = rr * 64 + cc * 2; return st * 1024 + (ob ^ (((ob >> 9) & 1) << 5)); }
__host__ __device__ __forceinline__ void stage_rc(int b, int& R, int& C) { const int st = b / 1024, sb = b % 1024, swz = sb ^ (((sb >> 9) & 1) << 5); R = (st >> 1) * 16 + swz / 64; C = (st & 1) * 32 + (swz % 64) / 2; }
__host__ __device__ __forceinline__ int perm32(int rho) { const int n = rho >> 4, i = rho & 15; return 8 * (i >> 2) + 4 * n + (i & 3); }

struct Unit { int pm, pn, k0; };
struct Gemm { const bf16_t* A; const bf16_t* Bt; int M, N, K, lda, ldb, pad; };

struct StaticOrder {
    static constexpr bool GATHER = false;
    int nM, nN, nwg, G, c;
    __host__ __device__ void init(int M, int N, int G_, int c_) { nM = M / BM; nN = N / BM; nwg = nM * nN; G = G_; c = c_; }
    __host__ __device__ bool next(int i, Unit& u) const {
        const long L = (long)i * G + c; if (L >= nwg) return false;
        int wgid = (int)L; { const int q = nwg / NXCD, r = nwg % NXCD, xcd = wgid % NXCD, off = wgid / NXCD; wgid = (xcd < r ? xcd * (q + 1) : r * (q + 1) + (xcd - r) * q) + off; }
        const int nig = WGM * nN, gid = wgid / nig, fm = gid * WGM, gsz = (nM - fm) < WGM ? (nM - fm) : WGM;
        u.pm = fm + ((wgid % nig) % gsz); u.pn = (wgid % nig) / gsz; u.k0 = 0; return true;
    }
    __device__ __forceinline__ void a_ready(const Unit&) const {}
    __device__ __forceinline__ void done(const Unit&) const {}
};

__device__ __forceinline__ unsigned cvt_pk_bf16(float lo, float hi) { unsigned r; asm volatile("v_cvt_pk_bf16_f32 %0, %1, %2" : "=v"(r) : "v"(lo), "v"(hi)); return r; }
typedef int i32x4_ __attribute__((ext_vector_type(4)));
typedef int i32x8_ __attribute__((ext_vector_type(8)));
template <class Epi, class Sched, bool ALIGN_EPI = false, bool SP2 = false, bool FP8 = false>
__device__ __forceinline__ void gemm_phase(PG8_LAS unsigned char* lds, const Gemm g, const Sched& S, const Epi& E) {
    int tid_ = threadIdx.x; asm volatile("" : "+v"(tid_)); const int tid = tid_, wid = __builtin_amdgcn_readfirstlane(tid >> 6), lane = tid & 63, wr = wid >> 2, wc = wid & 3, fr = lane & 15, fq = lane >> 4;
    const int K = g.K, nt = K / BK;
    unsigned voffA[2], voffB[2];
#pragma unroll
    for (int i = 0; i < 2; ++i) { int R, C; stage_rc(tid * 16 + i * 8192, R, C); const int Rb = Epi::PERM ? ((R & ~31) + perm32(R & 31)) : R;
        voffA[i] = (unsigned)(R * g.lda + C) * 2u; voffB[i] = (unsigned)(Rb * g.ldb + C) * 2u; }
    constexpr bool GATHER = Sched::GATHER;
    unsigned vAc[2][2] = {{0u, 0u}, {0u, 0u}}, vAn[2][2] = {{0u, 0u}, {0u, 0u}}, cbA[2] = {0u, 0u};
    if constexpr (GATHER) {
#pragma unroll
        for (int i = 0; i < 2; ++i) { int R, C; stage_rc(tid * 16 + i * 8192, R, C); cbA[i] = (unsigned)C * 2u; }
    }
#define PG8_IDX_DMA(un, slot) do { if constexpr (GATHER) { const int* rp_ = S.rows + (size_t)(un).pm * 256 + 128 * (lane >> 5) + 64 * ((lane >> 4) & 1) + 16 * (wid >> 1) + (lane & 15); \
        __builtin_amdgcn_global_load_lds((const unsigned*)rp_, (PG8_LAS unsigned*)(lds + STAGE_BYTES + wid * 512 + (slot) * 256), 4, 0, 0); } } while (0)
#define PG8_IDX_READ(dst, slot) do { if constexpr (GATHER) { int t3_ = threadIdx.x; asm volatile("" : "+v"(t3_));     \
        _Pragma("unroll") for (int h_ = 0; h_ < 2; ++h_) _Pragma("unroll") for (int i_ = 0; i_ < 2; ++i_) { int R_, C_; stage_rc(t3_ * 16 + i_ * 8192, R_, C_); \
        int tk_ = *(const PG8_LAS int*)(lds + STAGE_BYTES + (t3_ >> 6) * 512 + (slot) * 256 + 4 * (32 * h_ + 16 * i_ + ((t3_ & 63) >> 2))); tk_ = tk_ < 0 ? S.zero_row : tk_; \
        dst[h_][i_] = (unsigned)tk_ * (unsigned)(g.lda * 2) + (unsigned)C_ * 2u; } } } while (0)
#define PG8_STAGE_A(bufoff, base, h, nx) do { if constexpr (GATHER) { const unsigned vs_[2] = {(nx) ? vAn[h][0] : vAc[h][0], (nx) ? vAn[h][1] : vAc[h][1]}; PG8_STAGE(bufoff, base, vs_); } \
        else { PG8_STAGE(bufoff, (base) + (h) * hstepA, voffA); } } while (0)
    const size_t kstep = (size_t)(BK * 2);
    const size_t hstepA = (size_t)HALF * g.lda * 2, hstepB = (size_t)HALF * g.ldb * 2;
    const size_t tstepA = 2 * hstepA, tstepB = 2 * hstepB;
    const unsigned ldsw = (unsigned)wid * 1024u;
    const int aoff = lds_byte(wr * 64 + fr, fq * 8), boff = lds_byte(wc * 32 + fr, fq * 8);
#define PG8_SA(b, h) (((b) * 2 + (h)) * HTB)
#define PG8_SB(b, h) ((4 + (b) * 2 + (h)) * HTB)
#define PG8_STAGE(bufoff, gbase, voff) do { const char* gb_ = (const char*)(gbase); asm volatile("" : "+s"(gb_));   \
        _Pragma("unroll") for (int _i = 0; _i < 2; ++_i) \
        __builtin_amdgcn_global_load_lds((const unsigned*)(gb_ + (voff)[_i]), (PG8_LAS unsigned*)(lds + (bufoff) + ldsw + _i * 8192), 16, 0, 0); } while (0)
#define PG8_LDA(dst, b, h) do { _Pragma("unroll") for (int m = 0; m < 4; ++m) _Pragma("unroll") for (int k = 0; k < 2; ++k) dst[m][k] = *(const PG8_LAS bf16x8*)(lds + PG8_SA(b, h) + aoff + m * 2048 + k * 1024); } while (0)
#define PG8_LDB(dst, b, h) do { _Pragma("unroll") for (int n = 0; n < 2; ++n) _Pragma("unroll") for (int k = 0; k < 2; ++k) dst[n][k] = *(const PG8_LAS bf16x8*)(lds + PG8_SB(b, h) + boff + n * 2048 + k * 1024); } while (0)
#define PG8_MMA(ai, bj, At, Bt) do { __builtin_amdgcn_s_setprio(1); _Pragma("unroll") for (int m = 0; m < 4; ++m) _Pragma("unroll") for (int n = 0; n < 2; ++n) { \
        if constexpr (FP8) { const i32x8_ b8_ = __builtin_shufflevector(__builtin_bit_cast(i32x4_, Bt[n][0]), __builtin_bit_cast(i32x4_, Bt[n][1]), 0, 1, 2, 3, 4, 5, 6, 7); \
            const i32x8_ a8_ = __builtin_shufflevector(__builtin_bit_cast(i32x4_, At[m][0]), __builtin_bit_cast(i32x4_, At[m][1]), 0, 1, 2, 3, 4, 5, 6, 7); \
            acc[ai][bj][m][n] = __builtin_amdgcn_mfma_scale_f32_16x16x128_f8f6f4(b8_, a8_, acc[ai][bj][m][n], 0, 0, 0, 0, 0, 0); }     \
        else { _Pragma("unroll") for (int k = 0; k < 2; ++k) acc[ai][bj][m][n] = __builtin_amdgcn_mfma_f32_16x16x32_bf16(Bt[n][k], At[m][k], acc[ai][bj][m][n], 0, 0, 0); } } \
        __builtin_amdgcn_s_setprio(0); } while (0)
#define PG8_WAIT_V(n) asm volatile("s_waitcnt vmcnt(" #n ")" ::: "memory")
#define PG8_WAIT_L(n) asm volatile("s_waitcnt lgkmcnt(" #n ")" ::: "memory")
#define PG8_BAR __builtin_amdgcn_s_barrier()
#define PG8_SCHED __builtin_amdgcn_sched_barrier(0)
    Unit cur, nxt; int ui = 0;
    if (!S.next(0, cur)) return;
    float zf_ = 0.f; asm volatile("" : "+v"(zf_));
    f32x4 acc[2][2][4][2];
#pragma unroll
    for (int a = 0; a < 2; ++a)
#pragma unroll
        for (int b = 0; b < 2; ++b)
#pragma unroll
            for (int m = 0; m < 4; ++m)
#pragma unroll
                for (int n = 0; n < 2; ++n) acc[a][b][m][n] = (f32x4){zf_, zf_, zf_, zf_};
    bf16x8 At[4][2], B0[2][2], B1[2][2];
    const char* cA = (const char*)g.A + (GATHER ? (size_t)0 : (size_t)cur.pm * tstepA) + (size_t)cur.k0 * 2; const char* cB = (const char*)g.Bt + (size_t)cur.pn * tstepB + (size_t)cur.k0 * 2;
    S.a_ready(cur);
    if constexpr (GATHER) { PG8_IDX_DMA(cur, 0); asm volatile("s_waitcnt vmcnt(0)" ::: "memory"); PG8_IDX_READ(vAc, 0); }
    if constexpr (SP2) {
        PG8_STAGE(PG8_SB(0, 0), cB, voffB); PG8_STAGE(PG8_SB(0, 1), cB + hstepB, voffB); PG8_STAGE_A(PG8_SA(0, 0), cA, 0, false); PG8_STAGE_A(PG8_SA(0, 1), cA, 1, false);
        if (wr == 1) PG8_BAR;
        PG8_WAIT_V(2); PG8_BAR;
        PG8_STAGE(PG8_SB(1, 0), cB + kstep, voffB); PG8_STAGE_A(PG8_SA(1, 0), cA + kstep, 0, false); PG8_STAGE(PG8_SB(1, 1), cB + hstepB + kstep, voffB);
        PG8_WAIT_V(6); PG8_BAR;
    } else {
        PG8_STAGE(PG8_SB(0, 0), cB, voffB); PG8_STAGE(PG8_SA(0, 0), cA, voffA); PG8_STAGE(PG8_SB(0, 1), cB + hstepB, voffB); PG8_STAGE(PG8_SA(0, 1), cA + hstepA, voffA);
        if (wr == 1) PG8_BAR;
        PG8_WAIT_V(4); PG8_BAR;
        PG8_STAGE(PG8_SB(1, 0), cB + kstep, voffB); PG8_STAGE(PG8_SA(1, 0), cA + kstep, voffA); PG8_STAGE(PG8_SB(1, 1), cB + hstepB + kstep, voffB);
        PG8_WAIT_V(6); PG8_BAR;
    }
    for (;;) {
        const bool has_next = S.next(ui + 1, nxt);
        const char* nA = has_next ? (const char*)g.A + (GATHER ? (size_t)0 : (size_t)nxt.pm * tstepA) + (size_t)nxt.k0 * 2 : cA; const char* nB = has_next ? (const char*)g.Bt + (size_t)nxt.pn * tstepB + (size_t)nxt.k0 * 2 : cB;
        if constexpr (GATHER) { if (has_next) PG8_IDX_DMA(nxt, (ui + 1) & 1); }
        for (int t = 0; t < nt; t += 2) {
            const bool last = (t == nt - 2); const bool lnx = last && has_next;
            const char* a1 = cA + (size_t)(t + 1) * kstep;
            const char* a2 = last ? nA : cA + (size_t)(t + 2) * kstep; const char* b2 = last ? nB : cB + (size_t)(t + 2) * kstep;
            const char* a3 = a2 + kstep; const char* b3 = b2 + kstep;
            if (last && has_next) S.a_ready(nxt);
            if constexpr (GATHER) { if (lnx) PG8_IDX_READ(vAn, (ui + 1) & 1); }
            if constexpr (SP2) {
            PG8_LDB(B0, 0, 0); PG8_LDB(B1, 0, 1); PG8_SCHED; PG8_LDA(At, 0, 0); PG8_STAGE_A(PG8_SA(1, 1), a1, 1, false);
            PG8_WAIT_V(8); PG8_WAIT_L(0); PG8_BAR; PG8_MMA(0, 0, At, B0); PG8_MMA(0, 1, At, B1); PG8_BAR; PG8_SCHED;
            PG8_LDA(At, 0, 1); PG8_STAGE(PG8_SB(0, 0), b2, voffB); PG8_STAGE(PG8_SB(0, 1), b2 + hstepB, voffB); PG8_STAGE_A(PG8_SA(0, 0), a2, 0, lnx);
            PG8_WAIT_V(8); PG8_WAIT_L(0); PG8_BAR; PG8_MMA(1, 0, At, B0); PG8_MMA(1, 1, At, B1); PG8_BAR; PG8_SCHED;
            PG8_LDB(B0, 1, 0); PG8_LDB(B1, 1, 1); PG8_SCHED; PG8_LDA(At, 1, 0); PG8_STAGE_A(PG8_SA(0, 1), a2, 1, lnx);
            PG8_WAIT_V(8); PG8_WAIT_L(0); PG8_BAR; PG8_MMA(0, 0, At, B0); PG8_MMA(0, 1, At, B1); PG8_BAR; PG8_SCHED;
            PG8_LDA(At, 1, 1); PG8_STAGE(PG8_SB(1, 0), b3, voffB); PG8_STAGE(PG8_SB(1, 1), b3 + hstepB, voffB); PG8_STAGE_A(PG8_SA(1, 0), a3, 0, lnx);
            PG8_WAIT_V(8); PG8_WAIT_L(0); PG8_BAR; PG8_MMA(1, 0, At, B0); PG8_MMA(1, 1, At, B1); PG8_BAR; PG8_SCHED;
            } else {
            PG8_LDB(B0, 0, 0); PG8_SCHED; PG8_LDA(At, 0, 0); PG8_STAGE(PG8_SA(1, 1), a1 + hstepA, voffA);
            PG8_WAIT_L(8); PG8_BAR; PG8_WAIT_L(0); PG8_MMA(0, 0, At, B0); PG8_BAR; PG8_SCHED;
            PG8_LDB(B1, 0, 1); PG8_STAGE(PG8_SB(0, 0), b2, voffB);
            PG8_BAR; PG8_WAIT_L(0); PG8_MMA(0, 1, At, B1); PG8_BAR;
            PG8_LDA(At, 0, 1); PG8_STAGE(PG8_SA(0, 0), a2, voffA);
            PG8_BAR; PG8_WAIT_L(0); PG8_MMA(1, 0, At, B0); PG8_BAR; PG8_SCHED;
            PG8_STAGE(PG8_SB(0, 1), b2 + hstepB, voffB);
            PG8_WAIT_V(6); PG8_BAR; PG8_MMA(1, 1, At, B1); PG8_BAR;
            PG8_LDB(B0, 1, 0); PG8_SCHED; PG8_LDA(At, 1, 0); PG8_STAGE(PG8_SA(0, 1), a2 + hstepA, voffA);
            PG8_WAIT_L(8); PG8_BAR; PG8_WAIT_L(0); PG8_MMA(0, 0, At, B0); PG8_BAR; PG8_SCHED;
            PG8_LDB(B1, 1, 1); PG8_STAGE(PG8_SB(1, 0), b3, voffB);
            PG8_BAR; PG8_WAIT_L(0); PG8_MMA(0, 1, At, B1); PG8_BAR;
            PG8_LDA(At, 1, 1); PG8_STAGE(PG8_SA(1, 0), a3, voffA);
            PG8_BAR; PG8_WAIT_L(0); PG8_MMA(1, 0, At, B0); PG8_BAR; PG8_SCHED;
            PG8_STAGE(PG8_SB(1, 1), b3 + hstepB, voffB);
            PG8_WAIT_V(6); PG8_BAR; PG8_MMA(1, 1, At, B1); PG8_BAR;
            }
        }
        if constexpr (ALIGN_EPI) { if (wr == 0) PG8_BAR; }
        if constexpr (!Epi::AFTER_DRAIN) { int t2_ = threadIdx.x; asm volatile("" : "+v"(t2_)); const int fr2_ = t2_ & 15, fq2_ = (t2_ >> 4) & 3;
            E(acc, cur, wr, wc, fr2_, fq2_); S.done(cur); }
        if (!has_next) break;
#pragma unroll
        for (int a = 0; a < 2; ++a)
#pragma unroll
            for (int b = 0; b < 2; ++b)
#pragma unroll
                for (int m = 0; m < 4; ++m)
#pragma unroll
                    for (int n = 0; n < 2; ++n) acc[a][b][m][n] = (f32x4){zf_, zf_, zf_, zf_};
        cur = nxt; cA = nA; cB = nB; ++ui;
        if constexpr (GATHER) { vAc[0][0] = vAn[0][0]; vAc[0][1] = vAn[0][1]; vAc[1][0] = vAn[1][0]; vAc[1][1] = vAn[1][1]; }
        if constexpr (ALIGN_EPI) { if (wr == 1) PG8_BAR; }
    }
    PG8_WAIT_V(0);
    if constexpr (!ALIGN_EPI) { if (wr == 0) PG8_BAR; }
    PG8_BAR;
    if constexpr (Epi::AFTER_DRAIN) { E.fused(acc, cur, wr, wc, fr, fq, lds, wid, lane); S.done(cur); }
#undef PG8_SA
#undef PG8_SB
#undef PG8_STAGE
#undef PG8_STAGE_A
#undef PG8_IDX_DMA
#undef PG8_IDX_READ
#undef PG8_LDA
#undef PG8_LDB
#undef PG8_MMA
#undef PG8_WAIT_V
#undef PG8_WAIT_L
#undef PG8_BAR
#undef PG8_SCHED
}
}

typedef unsigned short bf16_t;
typedef short bf16x8 __attribute__((ext_vector_type(8)));
typedef short s16x4 __attribute__((ext_vector_type(4)));
typedef float f32x4 __attribute__((ext_vector_type(4)));
typedef float f32x16 __attribute__((ext_vector_type(16)));
typedef unsigned u32x4 __attribute__((ext_vector_type(4)));
typedef unsigned u32x2 __attribute__((ext_vector_type(2)));
#define LAS __attribute__((address_space(3)))
#define GAS __attribute__((address_space(1)))

constexpr int D = 1024, NB = 8, SEQ = 4096, NMETA = 16;
constexpr int RREAL = NB * SEQ;
constexpr int RVALID = RREAL + NMETA;
constexpr int NPAN = 129, RP = NPAN * 256;
constexpr int PMW = 1024, PRW = 1792;
constexpr int CW = 512;
constexpr int FF0 = 2816, FFE = 3584, NEXP = 8;
constexpr float RMS_EPS = 1e-6f, GN_EPS = 64e-5f;
constexpr int MOE_MAXPAN = 144;
constexpr int MOE_TAILPAN = 128, MOE_GAP = 8;
#ifndef MOE_CSKIP
#define MOE_CSKIP 5
#endif

typedef float f32x2_t __attribute__((ext_vector_type(2))); typedef __bf16 bf16x2_t __attribute__((ext_vector_type(2)));
__device__ __forceinline__ unsigned cvtpk(float lo, float hi) { f32x2_t v = {lo, hi}; bf16x2_t b = __builtin_convertvector(v, bf16x2_t); return __builtin_bit_cast(unsigned, b); }
__device__ __forceinline__ bf16_t f2bf_hw(float x) { return (bf16_t)(cvtpk(x, x) & 0xffffu); }
__device__ __forceinline__ float bf2f(bf16_t b) { return __uint_as_float(((unsigned)b) << 16); }
__device__ __forceinline__ bf16_t f2bf(float f) { unsigned u = __float_as_uint(f); u += 0x7fffu + ((u >> 16) & 1u); return (bf16_t)(u >> 16); }
__device__ __forceinline__ unsigned pk2(float lo, float hi) { return (unsigned)f2bf(lo) | ((unsigned)f2bf(hi) << 16); }
#define DPP_F(v_, ctrl_, rmask_) __int_as_float(__builtin_amdgcn_update_dpp(0, __float_as_int(v_), (ctrl_), (rmask_), 0xf, false))
__device__ __forceinline__ float wave_sum(float v) {
    v += DPP_F(v, 0xB1, 0xf); v += DPP_F(v, 0x4E, 0xf); v += DPP_F(v, 0x141, 0xf); v += DPP_F(v, 0x140, 0xf);
    v += DPP_F(v, 0x142, 0xa); v += DPP_F(v, 0x143, 0xc);
    return __int_as_float(__builtin_amdgcn_readlane(__float_as_int(v), 63));
}
__device__ __forceinline__ float wave_max(float v) {
    v = fmaxf(v, DPP_F(v, 0xB1, 0xf)); v = fmaxf(v, DPP_F(v, 0x4E, 0xf)); v = fmaxf(v, DPP_F(v, 0x141, 0xf)); v = fmaxf(v, DPP_F(v, 0x140, 0xf));
    v = fmaxf(v, DPP_F(v, 0x142, 0xa)); v = fmaxf(v, DPP_F(v, 0x143, 0xc));
    return __int_as_float(__builtin_amdgcn_readlane(__float_as_int(v), 63));
}
constexpr float F8_MAX = 448.0f, F8_ACT = 8.0f;
__device__ __forceinline__ unsigned pk4_f8(float a, float b, float c, float d) {
    float mx = F8_MAX; asm volatile("" : "+v"(mx));
    a = __builtin_amdgcn_fmed3f(a, -mx, mx); b = __builtin_amdgcn_fmed3f(b, -mx, mx); c = __builtin_amdgcn_fmed3f(c, -mx, mx); d = __builtin_amdgcn_fmed3f(d, -mx, mx);
    int r = __builtin_amdgcn_cvt_pk_fp8_f32(a, b, 0, false); r = __builtin_amdgcn_cvt_pk_fp8_f32(c, d, r, true); return (unsigned)r; }
__device__ __forceinline__ float moe_wscale(const unsigned* ctl, int t, int e);
__device__ __forceinline__ float quad_sum(float v) { v += DPP_F(v, 0xB1, 0xf); v += DPP_F(v, 0x4E, 0xf); return v; }
__device__ __forceinline__ float sigmoidf_(float x) { return 1.0f / (1.0f + __expf(-x)); }
__device__ __forceinline__ int row_pos(int row) { return row < RREAL ? NMETA + (row & (SEQ - 1)) : row - RREAL; }
__device__ __forceinline__ int row_prev(int row) { if (row < RREAL) return (row & (SEQ - 1)) ? row - 1 : RVALID - 1; return row == RREAL ? -1 : row - 1; }

constexpr size_t MiB = 1u << 20;
constexpr size_t WS_CTL = 0;
constexpr size_t WS_HMETA = 1 * MiB;
constexpr size_t WS_WB = 2 * MiB;
constexpr size_t LW_STRIDE = 10 * MiB;
constexpr size_t LW_WIN = 0, LW_WUQ = LW_WIN + (size_t)2816 * 1024 * 2, LW_WK = LW_WUQ + (size_t)768 * 512 * 2, LW_WV = LW_WK + (size_t)512 * 256 * 2,
                 LW_LORA = LW_WV + (size_t)512 * 256 * 2, LW_WOUT = LW_LORA + (size_t)1536 * 256 * 2, LW_END = LW_WOUT + (size_t)1024 * 1024 * 2;
static_assert(LW_END <= LW_STRIDE, "layer weights");
constexpr size_t WS_V1T = WS_WB + 2 * LW_STRIDE, WS_V2T = WS_V1T + (size_t)256 * 512 * 2, WS_FGU = WS_V2T + (size_t)512 * 256 * 2,
                 WS_FDN = WS_FGU + (size_t)5632 * 1024 * 2, WS_ROPE = WS_FDN + (size_t)1024 * 2816 * 2, WS_WB_END = WS_ROPE + (size_t)4112 * 64 * 4;
constexpr size_t WS_TB = WS_FGU;
constexpr size_t WS_ARENA = 41 * MiB;
static_assert(WS_WB_END <= WS_ARENA, "weights fit");
static_assert((size_t)8 * 256 * 1024 * 4 <= (size_t)5632 * 1024 * 2, "list-1 tail buffer fits the dense gate/up weight slot");
constexpr size_t SZ_R1024 = (size_t)RP * 1024 * 2, SZ_R512 = (size_t)RP * 512 * 2, SZ_R256 = (size_t)RP * 256 * 2;
constexpr size_t A_U = WS_ARENA;
constexpr size_t A_KN = A_U + SZ_R1024;
constexpr size_t A_VT = A_KN + SZ_R512;
constexpr size_t A_LOUT = A_U, A_VMIX = A_VT;
static_assert((size_t)RP * 1536 * 2 == SZ_R1024 + SZ_R512, "LORA_OUT fills the U and KN slots exactly");
constexpr size_t A_PM = A_VT + SZ_R512;
constexpr size_t A_PR = A_PM + SZ_R1024;
constexpr size_t A_SMALL = A_PR + (size_t)RP * PRW * 2;
constexpr size_t A_RSTDQ = A_SMALL, A_RSTDKV = A_RSTDQ + (size_t)RP * 4, A_KROPE = A_RSTDKV + (size_t)RP * 4, A_SMALL_END = A_KROPE + (size_t)RP * 64 * 2;
constexpr size_t A_LIN = (A_SMALL_END + 4095) & ~(size_t)4095;
constexpr size_t A_VSH = A_LIN + SZ_R256;
constexpr size_t A_CHK = A_LIN;
constexpr size_t SZ_CHK = (size_t)258 * 8 * 32768;
constexpr size_t A_VFIRST = (A_CHK + SZ_CHK > A_VSH + SZ_R512 ? A_CHK + SZ_CHK : A_VSH + SZ_R512);
constexpr size_t A_VP = A_VFIRST + SZ_R512;
constexpr size_t A_RK = A_VP + SZ_R512;
constexpr size_t A_YS = A_RK + (size_t)RP * 8 * 4;
constexpr size_t A_SCST = A_YS + SZ_R512;
constexpr size_t A_PART = A_SCST + (size_t)64 * 4096 * 4;
constexpr size_t A_END1 = A_PART + (size_t)11 * NMETA * 1024 * 4;
constexpr size_t A_ACT0 = A_PM;
constexpr size_t A_MGU = A_KN;
constexpr size_t A_MDN = A_MGU + (size_t)NEXP * 7168 * 1024 * 2;
constexpr size_t A_MTAB = A_MDN + (size_t)NEXP * 1024 * 3584 * 2;
constexpr size_t MT_E = 0, MT_G = MT_E + (size_t)2 * RREAL * 4, MT_STOK = MT_G + (size_t)2 * RREAL * 4, MT_TSLOT = MT_STOK + (size_t)2 * MOE_MAXPAN * 256 * 4  , MT_SGATE = MT_TSLOT + (size_t)RREAL * 4,
                 MT_BE = MT_SGATE + (size_t)2 * MOE_MAXPAN * 256 * 4, MT_END = MT_BE + 2 * 256 * 4;
constexpr size_t A_MACT = (A_MTAB + MT_END + 4095) & ~(size_t)4095;
constexpr size_t XB_LIST = (size_t)MOE_MAXPAN * 256 * 1024;
constexpr size_t A_XB = A_MACT + (size_t)MOE_MAXPAN * 256 * FFE;
static_assert(A_XB + 2 * XB_LIST <= A_MACT + (size_t)MOE_MAXPAN * 256 * FFE * 2, "XB inside the old activation footprint");
constexpr size_t A_END2 = A_MACT + (size_t)MOE_MAXPAN * 256 * FFE * 2;
constexpr size_t WS_NEED = (A_END1 > A_END2 ? A_END1 : A_END2);
static_assert(WS_NEED <= 557619232ull, "workspace budget (sum of the inputs' bytes)");
static_assert(A_ACT0 + (size_t)RP * FF0 * 2 <= A_SMALL, "dense act overlay");
constexpr int CW_CNT = 64;
constexpr int CW_FILL = 128;
constexpr int CW_NPAN = 192;
constexpr int CW_WINV = 16448;
constexpr int CW_WMAX = 16384;
constexpr int CW_WGCNT = 8192;


__device__ __forceinline__ unsigned long long kp_uniform(unsigned long long kp) { const unsigned lo = __builtin_amdgcn_readfirstlane((unsigned)kp), hi = __builtin_amdgcn_readfirstlane((unsigned)(kp >> 32)); return ((unsigned long long)hi << 32) | lo; }
__device__ __forceinline__ const void* ldk(unsigned long long kp, int off) { unsigned long long v;
    asm volatile("s_load_dwordx2 %0, %1, %2\n\ts_waitcnt lgkmcnt(0)" : "=s"(v) : "s"(kp), "i"(off) : "memory"); return (const void*)v; }
__device__ __forceinline__ int opq(int v) { asm volatile("" : "+v"(v)); return v; }
__device__ __forceinline__ int opqs(int v) { asm volatile("" : "+s"(v)); return v; }
__device__ __forceinline__ void lds_barrier() { asm volatile("s_waitcnt lgkmcnt(0)\n\ts_barrier" ::: "memory"); }

__device__ __forceinline__ float moe_wscale_bits(unsigned bits) { const float m = __uint_as_float(bits);
    return m > 0.f ? __builtin_amdgcn_exp2f(floorf(__builtin_amdgcn_logf(224.0f / m))) : 1.0f; }
__device__ __forceinline__ float moe_wscale(const unsigned* ctl, int t, int e) { return moe_wscale_bits((unsigned)__builtin_amdgcn_readfirstlane((int)ctl[CW_WMAX + t * 8 + e])); }
#define XB_TMO      128
#define XB_XCNT(j)  (256  + 64 * (j))
#define XB_XSUB(j)  (1280 + 64 * (j))
#define XB_XGEN(j)  (2304 + 64 * (j))
#define XB_TOP      3328
#define XB_TOPGEN   3392
#define XCD_BAR_WORDS 3456
#define XB_SPIN_CAP (1u << 18)

__device__ __forceinline__ unsigned xb_ld(unsigned* p)              { return __hip_atomic_load(p, __ATOMIC_RELAXED, __HIP_MEMORY_SCOPE_AGENT); }
__device__ __forceinline__ unsigned xb_add(unsigned* p, unsigned v) { return __hip_atomic_fetch_add(p, v, __ATOMIC_RELAXED, __HIP_MEMORY_SCOPE_AGENT); }
__device__ __forceinline__ unsigned xb_xcc_id() { return (unsigned)__builtin_amdgcn_s_getreg((3 << 11) | 20) & 0xFu; }
#define XB_SPIN(cond, bar) do { unsigned _sp = 0; while (cond) { __builtin_amdgcn_s_sleep(1); \
    if ((++_sp & 255u) == 0u) { if (xb_ld(&(bar)[XB_TMO])) break; if (_sp > XB_SPIN_CAP) { atomicAdd(&(bar)[XB_TMO], 1u); break; } } } } while (0)

struct XcdBarrier {
    unsigned* bar; unsigned x;
    volatile LAS unsigned* st;
};

__device__ __forceinline__ XcdBarrier xcd_barrier_post(unsigned* bar, volatile LAS unsigned* st) {
    XcdBarrier b; b.bar = bar; b.x = xb_xcc_id(); b.st = st;
    if (threadIdx.x == 0) (void)xb_add(&bar[XB_XCNT(b.x)], 1u);
    return b;
}
__device__ __forceinline__ void xcd_barrier_complete(unsigned* bar, unsigned x, unsigned& nloc, unsigned& nx) {
    const unsigned G = gridDim.x * gridDim.y * gridDim.z;
    unsigned sum, cnt, mine, sp = 0u;
    for (;;) {
        sum = 0u; cnt = 0u; mine = 0u;
#pragma unroll
        for (unsigned j = 0; j < 16; ++j) { const unsigned c = xb_ld(&bar[XB_XCNT(j)]); sum += c; cnt += (c > 0u) ? 1u : 0u; mine = (j == x) ? c : mine; }
        if (sum == G) break;
        __builtin_amdgcn_s_sleep(1);
        if ((++sp & 255u) == 0u) { if (xb_ld(&bar[XB_TMO])) break; if (sp > XB_SPIN_CAP) { atomicAdd(&bar[XB_TMO], 1u); break; } }
    }
    nloc = mine > 0u ? mine : 1u; nx = cnt > 0u ? cnt : 1u;
}

__device__ __attribute__((noinline)) void xcd_barrier_fn(unsigned* bar_, unsigned x_, volatile LAS unsigned* st_) {
    XcdBarrier b; b.bar = bar_; b.x = x_; b.st = st_;
    asm volatile("s_waitcnt vmcnt(0)" ::: "memory");
    __syncthreads();
    if (threadIdx.x == 0) {
        unsigned* bar = b.bar;
        __builtin_amdgcn_s_waitcnt(0);
        unsigned nloc = b.st[0], nx = b.st[1];
        if (nloc == 0u) { xcd_barrier_complete(bar, b.x, nloc, nx); b.st[0] = nloc; b.st[1] = nx; }
        const unsigned old = xb_add(&bar[XB_XSUB(b.x)], 1u);
        const unsigned gen = old / nloc;
        if (old + 1u == (gen + 1u) * nloc) {
            __builtin_amdgcn_fence(__ATOMIC_RELEASE, "agent");
            asm volatile("s_waitcnt vmcnt(0)" ::: "memory");
            const unsigned og = xb_add(&bar[XB_TOP], 1u);
            const unsigned tg = og / nx;
            if (og + 1u == (tg + 1u) * nx) xb_add(&bar[XB_TOPGEN], 1u);
            else XB_SPIN(xb_ld(&bar[XB_TOPGEN]) == tg, bar);
            __builtin_amdgcn_fence(__ATOMIC_ACQUIRE, "agent");
            xb_add(&bar[XB_XGEN(b.x)], 1u);
            asm volatile("s_waitcnt vmcnt(0)" ::: "memory");
        } else {
            XB_SPIN(xb_ld(&bar[XB_XGEN(b.x)]) == gen, bar);
            __builtin_amdgcn_fence(__ATOMIC_ACQUIRE, "agent");
            asm volatile("s_waitcnt vmcnt(0)" ::: "memory");
        }
    }
    __syncthreads();
}

__device__ __forceinline__ void xcd_barrier(const XcdBarrier& b) { xcd_barrier_fn(b.bar, b.x, b.st); }
using pg8::Unit;
struct EpiInProj { static constexpr bool PERM = true, AFTER_DRAIN = false; bf16_t* PM; bf16_t* PR;
    __device__ __forceinline__ void operator()(const f32x4 (&acc)[2][2][4][2], const Unit& u, int wr, int wc, int fr, int fq) const {
        const int row0 = u.pm * 256 + wr * 64 + fr; bf16_t* base; int ld, colt;
        if (u.pn < 4) { base = PM; ld = PMW; colt = u.pn * 256; } else { base = PR; ld = PRW; colt = (u.pn - 4) * 256; }
        const int col0 = colt + wc * 32 + 8 * fq;
#pragma unroll
        for (int ai = 0; ai < 2; ++ai)
#pragma unroll
            for (int m = 0; m < 4; ++m) { bf16_t* rowp = base + (size_t)(row0 + ai * 128 + m * 16) * ld + col0;
#pragma unroll
                for (int bj = 0; bj < 2; ++bj) { const f32x4 v0 = acc[ai][bj][m][0], v1 = acc[ai][bj][m][1];
                    u32x4 w; w.x = pg8::cvt_pk_bf16(v0[0], v0[1]); w.y = pg8::cvt_pk_bf16(v0[2], v0[3]); w.z = pg8::cvt_pk_bf16(v1[0], v1[1]); w.w = pg8::cvt_pk_bf16(v1[2], v1[3]);
                    *(u32x4*)(rowp + bj * 128) = w; } }
    }
};
struct EpiRowScale { static constexpr bool PERM = true, AFTER_DRAIN = false; bf16_t* O; const float* rs; int ldc, pad;
    __device__ __forceinline__ void operator()(const f32x4 (&acc)[2][2][4][2], const Unit& u, int wr, int wc, int fr, int fq) const {
        const int row0 = u.pm * 256 + wr * 64 + fr; const int col0 = u.pn * 256 + wc * 32 + 8 * fq;
#pragma unroll
        for (int ai = 0; ai < 2; ++ai)
#pragma unroll
            for (int m = 0; m < 4; ++m) { const int row = row0 + ai * 128 + m * 16; const float s = rs ? rs[row] : 1.f; bf16_t* rowp = O + (size_t)row * ldc + col0;
#pragma unroll
                for (int bj = 0; bj < 2; ++bj) { const f32x4 v0 = acc[ai][bj][m][0] * s, v1 = acc[ai][bj][m][1] * s;
                    u32x4 w; w.x = pg8::cvt_pk_bf16(v0[0], v0[1]); w.y = pg8::cvt_pk_bf16(v0[2], v0[3]); w.z = pg8::cvt_pk_bf16(v1[0], v1[1]); w.w = pg8::cvt_pk_bf16(v1[2], v1[3]);
                    *(u32x4*)(rowp + bj * 128) = w; } }
    }
};
struct EpiColScale { static constexpr bool PERM = true, AFTER_DRAIN = false; bf16_t* O; const float* cs; int ldc, pad;
    __device__ __forceinline__ void operator()(const f32x4 (&acc)[2][2][4][2], const Unit& u, int wr, int wc, int fr, int fq) const {
        const int row0 = u.pm * 256 + wr * 64 + fr; const int col0 = u.pn * 256 + wc * 32 + 8 * fq;
        f32x4 sc[2][2];
#pragma unroll
        for (int bj = 0; bj < 2; ++bj) { sc[bj][0] = *(const f32x4*)(cs + col0 + bj * 128); sc[bj][1] = *(const f32x4*)(cs + col0 + bj * 128 + 4); }
#pragma unroll
        for (int ai = 0; ai < 2; ++ai)
#pragma unroll
            for (int m = 0; m < 4; ++m) { bf16_t* rowp = O + (size_t)(row0 + ai * 128 + m * 16) * ldc + col0;
#pragma unroll
                for (int bj = 0; bj < 2; ++bj) { const f32x4 v0 = acc[ai][bj][m][0] * sc[bj][0], v1 = acc[ai][bj][m][1] * sc[bj][1];
                    u32x4 w; w.x = pg8::cvt_pk_bf16(v0[0], v0[1]); w.y = pg8::cvt_pk_bf16(v0[2], v0[3]); w.z = pg8::cvt_pk_bf16(v1[0], v1[1]); w.w = pg8::cvt_pk_bf16(v1[2], v1[3]);
                    *(u32x4*)(rowp + bj * 128) = w; } }
    }
};
struct EpiResid { static constexpr bool PERM = false, AFTER_DRAIN = false; float* out; float* hmeta; const float* src; float scale; int pad;
    __device__ __forceinline__ void operator()(const f32x4 (&acc)[2][2][4][2], const Unit& u, int wr, int wc, int fr, int fq) const {
        const int rl = wr * 64 + fr, col0 = u.pn * 256 + wc * 32 + 4 * fq;
        float* base = u.pm < 128 ? out + (size_t)u.pm * 256 * D : hmeta; const float* sbase = u.pm < 128 ? src + (size_t)u.pm * 256 * D : hmeta;
#pragma unroll
        for (int ai = 0; ai < 2; ++ai)
#pragma unroll
            for (int m = 0; m < 4; ++m) { const size_t ro = (size_t)(rl + ai * 128 + m * 16) * D + col0;
#pragma unroll
                for (int bj = 0; bj < 2; ++bj)
#pragma unroll
                    for (int n = 0; n < 2; ++n) { const f32x4 hv = *(const f32x4*)(sbase + ro + bj * 128 + n * 16); *(f32x4*)(base + ro + bj * 128 + n * 16) = hv + acc[ai][bj][m][n] * scale; }
                asm volatile("" ::: "memory"); }
    }
};
struct EpiSwiGLU { static constexpr bool PERM = true, AFTER_DRAIN = false; bf16_t* O; int ldc, nmod, pn_off, pad;
    __device__ __forceinline__ void operator()(const f32x4 (&acc)[2][2][4][2], const Unit& u, int wr, int wc, int fr, int fq) const {
        const int row0 = u.pm * 256 + wr * 64 + fr; const int pnl = (u.pn % nmod) - pn_off; const int col0 = pnl * 128 + wc * 32 + 8 * fq;
#pragma unroll
        for (int ai = 0; ai < 2; ++ai)
#pragma unroll
            for (int m = 0; m < 4; ++m) { bf16_t* rowp = O + (size_t)(row0 + ai * 128 + m * 16) * ldc + col0; float r[8];
#pragma unroll
                for (int n = 0; n < 2; ++n)
#pragma unroll
                    for (int j = 0; j < 4; ++j) { const float g = acc[ai][0][m][n][j], up = acc[ai][1][m][n][j]; r[4 * n + j] = g / (1.0f + __expf(-g)) * up; }
                u32x4 w; w.x = pg8::cvt_pk_bf16(r[0], r[1]); w.y = pg8::cvt_pk_bf16(r[2], r[3]); w.z = pg8::cvt_pk_bf16(r[4], r[5]); w.w = pg8::cvt_pk_bf16(r[6], r[7]);
                *(u32x4*)rowp = w; }
    }
};
struct EpiSwiGLU8 { static constexpr bool PERM = false, AFTER_DRAIN = false; unsigned char* O; const unsigned* ctl; int ldc, nmod;
    __device__ __forceinline__ void operator()(const f32x4 (&acc)[2][2][4][2], const Unit& u, int wr, int wc, int fr, int fq) const {
        const int row0 = u.pm * 256 + wr * 64 + fr; const int e = u.pn / nmod, pnl = u.pn % nmod; const int col0 = pnl * 128 + wc * 32 + 4 * fq;
        const float ig = __uint_as_float(__builtin_amdgcn_readfirstlane((int)ctl[CW_WINV + e])), iu = __uint_as_float(__builtin_amdgcn_readfirstlane((int)ctl[CW_WINV + 8 + e])) * F8_ACT;
#pragma unroll
        for (int ai = 0; ai < 2; ++ai)
#pragma unroll
            for (int m = 0; m < 4; ++m) { unsigned char* rowp = O + (size_t)(row0 + ai * 128 + m * 16) * ldc + col0;
#pragma unroll
                for (int n = 0; n < 2; ++n) { float r[4];
#pragma unroll
                    for (int j = 0; j < 4; ++j) { const float g = acc[ai][0][m][n][j] * ig, up = acc[ai][1][m][n][j] * iu; r[j] = g / (1.0f + __expf(-g)) * up; }
                    *(unsigned*)(rowp + n * 16) = pk4_f8(r[0], r[1], r[2], r[3]); } }
    }
};
struct EpiMoeDown { static constexpr bool PERM = false, AFTER_DRAIN = false; float* out; const int* stok; const float* sgate; int nmod; float scale; const unsigned* ctl;
    __device__ __forceinline__ void operator()(const f32x4 (&acc)[2][2][4][2], const Unit& u, int wr, int wc, int fr, int fq) const {
        const int row0 = u.pm * 256 + wr * 64 + fr; const int col0 = (u.pn % nmod) * 256 + wc * 32 + 4 * fq;
        const float winv = ctl ? __uint_as_float(__builtin_amdgcn_readfirstlane((int)ctl[CW_WINV + 16 + u.pn / nmod])) : 1.0f;
#pragma unroll
        for (int ai = 0; ai < 2; ++ai)
#pragma unroll
            for (int m = 0; m < 4; ++m) { const int prow = row0 + ai * 128 + m * 16; const int tok = stok[prow]; if (tok < 0) continue; const float gt = sgate[prow] * scale * winv;
                float* rowp = out + (size_t)tok * D + col0;
#pragma unroll
                for (int bj = 0; bj < 2; ++bj)
#pragma unroll
                    for (int n = 0; n < 2; ++n) { f32x4* p = (f32x4*)(rowp + bj * 128 + n * 16); *p = *p + acc[ai][bj][m][n] * gt; }
                asm volatile("" ::: "memory"); }
    }
};
struct EpiMoeDownStore { static constexpr bool PERM = false, AFTER_DRAIN = false; float* tb; const int* stok; const float* sgate; int nmod, pm0; const unsigned* ctl;
    __device__ __forceinline__ void operator()(const f32x4 (&acc)[2][2][4][2], const Unit& u, int wr, int wc, int fr, int fq) const {
        const int row0 = u.pm * 256 + wr * 64 + fr; const int col0 = (u.pn % nmod) * 256 + wc * 32 + 4 * fq;
#pragma unroll
        for (int ai = 0; ai < 2; ++ai)
#pragma unroll
            for (int m = 0; m < 4; ++m) { const int prow = row0 + ai * 128 + m * 16; const int tok = stok[prow]; if (tok < 0) continue; const float gt = sgate[prow] * __uint_as_float(__builtin_amdgcn_readfirstlane((int)ctl[CW_WINV + 16 + u.pn / nmod]));
                float* rowp = tb + (size_t)(prow - pm0 * 256) * D + col0;
#pragma unroll
                for (int bj = 0; bj < 2; ++bj)
#pragma unroll
                    for (int n = 0; n < 2; ++n) *(f32x4*)(rowp + bj * 128 + n * 16) = acc[ai][bj][m][n] * gt; }
    }
};
struct MoeOrder { static constexpr bool GATHER = false; const int* block_e; const unsigned* npan; int nN, emul, pn_off, G, c, lmax;
    __device__ __forceinline__ bool next(int i, Unit& u) const { const int L = i * G + c; const int np = __builtin_amdgcn_readfirstlane((int)(*npan)); if (L >= np * nN || (lmax && L >= lmax)) return false;
        const int pm = L / nN; u.k0 = 0; u.pm = pm; u.pn = __builtin_amdgcn_readfirstlane(block_e[pm]) * emul + pn_off + (L % nN); return true; }
    __device__ __forceinline__ void a_ready(const Unit&) const {}
    __device__ __forceinline__ void done(const Unit&) const {}
};


struct EpiResidPartial { static constexpr bool PERM = false, AFTER_DRAIN = false; float* part;
    __device__ __forceinline__ void operator()(const f32x4 (&acc)[2][2][4][2], const Unit& u, int wr, int wc, int fr, int fq) const {
        const int rl = wr * 64 + fr, col0 = u.pn * 256 + wc * 32 + 4 * fq; float* base = part + (size_t)(u.k0 >> 8) * NMETA * D;
#pragma unroll
        for (int ai = 0; ai < 2; ++ai)
#pragma unroll
            for (int m = 0; m < 4; ++m) { const int row = rl + ai * 128 + m * 16; if (row >= NMETA) continue;
                float* rowp = base + (size_t)row * D + col0;
#pragma unroll
                for (int bj = 0; bj < 2; ++bj)
#pragma unroll
                    for (int n = 0; n < 2; ++n) *(f32x4*)(rowp + bj * 128 + n * 16) = acc[ai][bj][m][n]; }
    }
};
struct DenseTailOrder { static constexpr bool GATHER = false; int nN, nsl, G, c;
    __device__ __forceinline__ bool next(int i, Unit& u) const { const int idx = i * G + c; if (idx >= nN * nsl) return false; u.pm = 128; u.pn = idx / nsl; u.k0 = (idx % nsl) * 256; return true; }
    __device__ __forceinline__ void a_ready(const Unit&) const {}
    __device__ __forceinline__ void done(const Unit&) const {}
};
template <bool GA> struct MoeGatherOrderT { static constexpr bool GATHER = GA;
    const int* block_e; const unsigned* npan; const int* rows; int nN, emul, pn_off, G, c, zero_row;
    int pm_lo, pm_hi, gap, rot, T, cskip;
    __device__ __forceinline__ bool next(int i, Unit& u) const {
        int cc = c - rot; cc += cc < 0 ? G : 0;
        int L;
        if (T == 0) L = i * G + cc;
        else { const int W0 = G - T; if (cc < W0) L = i < cskip ? i * W0 + cc : cskip * W0 + (i - cskip) * G + cc; else L = cskip * W0 + i * G + cc; }
        int np = __builtin_amdgcn_readfirstlane((int)(*npan)); np = np < pm_hi ? np : pm_hi;
        const int pl = pm_lo + L / nN; if (pl >= np) return false;
        const int pm = pl + (pl >= MOE_TAILPAN ? gap : 0); u.k0 = 0; u.pm = pm; u.pn = __builtin_amdgcn_readfirstlane(block_e[pm]) * emul + pn_off + (L % nN); return true; }
    __device__ __forceinline__ void a_ready(const Unit&) const {}
    __device__ __forceinline__ void done(const Unit&) const {}
};
using MoeGatherOrder = MoeGatherOrderT<true>; using MoeSlotOrder = MoeGatherOrderT<false>;
struct MoeShiftTailOrder { static constexpr bool GATHER = false; const int* block_e; const unsigned* npan; int nN, emul, gap, wg_first, c, pad;
    __device__ __forceinline__ bool next(int i, Unit& u) const { const int t = wg_first - c; const int np = __builtin_amdgcn_readfirstlane((int)(*npan)); const int L = MOE_TAILPAN * nN + t;
        if (i > 0 || t < 0 || L >= np * nN) return false;
        const int pm = L / nN + gap; u.k0 = 0; u.pm = pm; u.pn = __builtin_amdgcn_readfirstlane(block_e[pm]) * emul + (L % nN); return true; }
    __device__ __forceinline__ void a_ready(const Unit&) const {}
    __device__ __forceinline__ void done(const Unit&) const {}
};

__device__ __forceinline__ int map_row(int mode, int n, int rowoff) {
    if (mode == 1) return n < 832 ? n : n + 192;
    if (mode == 2) return rowoff + (n >> 7) * 256 + (n & 127);
    if (mode == 3) return rowoff + (n >> 7) * 256 + 128 + (n & 127);
    if (mode == 4) return (n >> 8) * 128 + (n & 127) + ((n & 128) ? 512 : 0);
    return rowoff + n;
}
__device__ __forceinline__ void transpose_item(const float* __restrict__ W, int K, int N, bf16_t* __restrict__ dst, int ld, int koff, int mode, int rowoff, const float* __restrict__ gain, LAS float* scr, int item, int lane) {
    const int nblk = N / 32; const int kb = item / nblk, nb = item % nblk, k0 = 64 * kb, n0 = 32 * nb;
#pragma unroll 8
    for (int i = 0; i < 32; ++i) { const int kk = 2 * i + (lane >> 5); float v = W[(size_t)(k0 + kk) * N + n0 + (lane & 31)]; if (gain) v *= gain[k0 + kk]; scr[kk * 33 + (lane & 31)] = v; }
    asm volatile("s_waitcnt lgkmcnt(0)" ::: "memory");
    const int c = lane & 7;
#pragma unroll
    for (int j = 0; j < 4; ++j) { const int n = (lane >> 3) + 8 * j; const LAS float* s = scr + (8 * c) * 33 + n;
        u32x4 o; o.x = pk2(s[0 * 33], s[1 * 33]); o.y = pk2(s[2 * 33], s[3 * 33]); o.z = pk2(s[4 * 33], s[5 * 33]); o.w = pk2(s[6 * 33], s[7 * 33]);
        *(u32x4*)(dst + (size_t)map_row(mode, n0 + n, rowoff) * ld + koff + k0 + 8 * c) = o; }
    asm volatile("s_waitcnt lgkmcnt(0)" ::: "memory");
}
__device__ __forceinline__ void transpose_item_f8(const float* __restrict__ W, int K, int N, unsigned char* __restrict__ dst, int ld, int mode, int rowoff, float scale, LAS float* scr, int item, int lane) {
    const int nblk = N / 32; const int kb = item / nblk, nb = item % nblk, k0 = 64 * kb, n0 = 32 * nb;
#pragma unroll 8
    for (int i = 0; i < 32; ++i) { const int kk = 2 * i + (lane >> 5); scr[kk * 33 + (lane & 31)] = W[(size_t)(k0 + kk) * N + n0 + (lane & 31)] * scale; }
    asm volatile("s_waitcnt lgkmcnt(0)" ::: "memory");
    const int c = lane & 7;
#pragma unroll
    for (int j = 0; j < 4; ++j) { const int n = (lane >> 3) + 8 * j; const LAS float* s = scr + (8 * c) * 33 + n;
        u32x2 o; o.x = pk4_f8(s[0 * 33], s[1 * 33], s[2 * 33], s[3 * 33]); o.y = pk4_f8(s[4 * 33], s[5 * 33], s[6 * 33], s[7 * 33]);
        *(u32x2*)(dst + (size_t)map_row(mode, n0 + n, rowoff) * ld + k0 + 8 * c) = o; }
    asm volatile("s_waitcnt lgkmcnt(0)" ::: "memory");
}
struct TrJob8 { const float* W; unsigned char* dst; int K, N, ld, mode, rowoff; float scale; };
__device__ __forceinline__ void ph_transpose_f8(const TrJob8& J, LAS float* scr, int gw, int ngw, int lane) {
    lane = opq(lane);
    const int nitems = (J.K / 64) * (J.N / 32);
    for (int it = gw; it < nitems; it += ngw) transpose_item_f8(J.W, J.K, J.N, J.dst, J.ld, J.mode, J.rowoff, J.scale, scr, it, lane);
}
struct TrJob { const float* W; const float* gain; bf16_t* dst; int K, N, ld, koff, mode, rowoff; };
__device__ __forceinline__ void ph_transpose(const TrJob& J, LAS float* scr, int gw, int ngw, int lane) {
    lane = opq(lane);
    const int nitems = (J.K / 64) * (J.N / 32);
    for (int it = gw; it < nitems; it += ngw) transpose_item(J.W, J.K, J.N, J.dst, J.ld, J.koff, J.mode, J.rowoff, J.gain, scr, it, lane);
}
__device__ __forceinline__ const float* hrow_c(const float* out, const float* hmeta, int row) { return row < RREAL ? out + (size_t)row * D : hmeta + (size_t)(row - RREAL) * D; }
__device__ __forceinline__ void ph_init(const float* __restrict__ x, const float* __restrict__ meta, float* __restrict__ out, float* __restrict__ hmeta, float* __restrict__ rope,
                                        const float* __restrict__ v1, const float* __restrict__ v2, bf16_t* __restrict__ v12t, size_t gt, size_t ngt) {
    (void)x; (void)out;
    for (size_t i = gt; i < (size_t)256 * D; i += ngt) hmeta[i] = i < (size_t)NMETA * D ? meta[i] : 0.f;
    for (size_t i = gt; i < (size_t)4112 * 32; i += ngt) { const int pos = (int)(i / 32), j = (int)(i % 32);
        const float inv = powf(10000.0f, -(float)j / 32.0f); const float ang = (float)pos * inv; rope[2 * i] = cosf(ang); rope[2 * i + 1] = sinf(ang); }
    for (size_t i = gt; i < (size_t)512 * 512; i += ngt) { const int n = (int)(i >> 9), k = (int)(i & 511); float s = 0.f;
#pragma unroll 8
        for (int j = 0; j < 32; ++j) s += v1[k * 32 + j] * v2[j * 512 + n];
        v12t[i] = f2bf(s); }
}
__device__ __forceinline__ void ph_rmsnorm(const float* __restrict__ out, const float* hmeta, const float* __restrict__ g, bf16_t* __restrict__ U, const float* __restrict__ part, int nsl, int gw, int ngw, int lane) {
    lane = opq(lane);
    for (int row = gw; row < RP; row += ngw) {
        unsigned long long* o8 = (unsigned long long*)(U + (size_t)row * D) + lane;
        if (row >= RVALID) {
#pragma unroll
            for (int j = 0; j < 4; ++j) o8[64 * j] = 0ull;
            continue; }
        const f32x4* xr = (const f32x4*)hrow_c(out, hmeta, row) + lane; const f32x4* g4 = (const f32x4*)g + lane;
        f32x4 v[4]; float s = 0.f;
#pragma unroll
        for (int j = 0; j < 4; ++j) v[j] = xr[64 * j];
        if (row >= RREAL && nsl > 0) {
            for (int sl = 0; sl < nsl; ++sl) { const f32x4* pr = (const f32x4*)(part + ((size_t)sl * NMETA + (row - RREAL)) * D) + lane;
#pragma unroll
                for (int j = 0; j < 4; ++j) v[j] = v[j] + pr[64 * j]; }
            f32x4* hw = (f32x4*)xr;
#pragma unroll
            for (int j = 0; j < 4; ++j) hw[64 * j] = v[j]; }
#pragma unroll
        for (int j = 0; j < 4; ++j) s += (v[j].x * v[j].x + v[j].y * v[j].y) + (v[j].z * v[j].z + v[j].w * v[j].w);
        const float rstd = rsqrtf(wave_sum(s) * (1.f / D) + RMS_EPS);
#pragma unroll
        for (int j = 0; j < 4; ++j) { const f32x4 gg = g4[64 * j]; o8[64 * j] = (unsigned long long)pk2(v[j].x * rstd * gg.x, v[j].y * rstd * gg.y) | ((unsigned long long)pk2(v[j].z * rstd * gg.z, v[j].w * rstd * gg.w) << 32); }
    }
}
__device__ __forceinline__ void unpack8(const u32x4 v, float (&f)[8]) {
    f[0] = __uint_as_float(v.x << 16); f[1] = __uint_as_float(v.x & 0xffff0000u); f[2] = __uint_as_float(v.y << 16); f[3] = __uint_as_float(v.y & 0xffff0000u);
    f[4] = __uint_as_float(v.z << 16); f[5] = __uint_as_float(v.z & 0xffff0000u); f[6] = __uint_as_float(v.w << 16); f[7] = __uint_as_float(v.w & 0xffff0000u);
}
__device__ __forceinline__ void ph_prep(const bf16_t* __restrict__ PM, const bf16_t* __restrict__ PR, const float* __restrict__ mu, const float* __restrict__ rope,
                                        float* __restrict__ rstdq, float* __restrict__ rstdkv, bf16_t* __restrict__ KR, bf16_t* __restrict__ LIN, bf16_t* __restrict__ VSH, int do_vsh, int gw, int ngw, int lane) {
    lane = opq(lane);
    for (int row = gw; row < RP; row += ngw) {
        const bf16_t* pm = PM + (size_t)row * PMW;
        float f[8], sq = 0.f, skv = 0.f;
        unpack8(*(const u32x4*)(pm + lane * 8), f);
#pragma unroll
        for (int j = 0; j < 8; ++j) sq += f[j] * f[j];
        if (lane < 32) { unpack8(*(const u32x4*)(pm + 512 + lane * 8), f);
#pragma unroll
            for (int j = 0; j < 8; ++j) skv += f[j] * f[j]; }
        sq = wave_sum(sq); skv = wave_sum(skv);
        if (lane == 0) { rstdq[row] = rsqrtf(sq * (1.f / 512.f) + RMS_EPS); rstdkv[row] = rsqrtf(skv * (1.f / 256.f) + RMS_EPS); }
        const int pos = row_pos(row);
        if (lane < 32) { const float x1 = bf2f(pm[768 + lane]), x2 = bf2f(pm[800 + lane]); const float c = rope[2 * (pos * 32 + lane)], s = rope[2 * (pos * 32 + lane) + 1];
            KR[(size_t)row * 64 + lane] = f2bf(x1 * c - x2 * s); KR[(size_t)row * 64 + 32 + lane] = f2bf(x1 * s + x2 * c); }
        const int pr = row_prev(row); const bool valid = row < RVALID; const float pmk = pr < 0 ? 0.f : 1.f;
        const bf16_t* x = PR + (size_t)row * PRW; const bf16_t* xp = PR + (size_t)(pr < 0 ? row : pr) * PRW;
        if (lane < 32) {
            float a[8], b[8]; unpack8(*(const u32x4*)(x + 1536 + lane * 8), a); unpack8(*(const u32x4*)(xp + 1536 + lane * 8), b);
            const f32x4 m0 = *(const f32x4*)(mu + 1536 + lane * 8), m1 = *(const f32x4*)(mu + 1536 + lane * 8 + 4); const float mm[8] = {m0.x, m0.y, m0.z, m0.w, m1.x, m1.y, m1.z, m1.w};
            float o[8];
#pragma unroll
            for (int j = 0; j < 8; ++j) { float v = a[j] + (pmk * b[j] - a[j]) * mm[j]; v = lane < 8 ? tanhf(v) : (lane < 16 ? v : sigmoidf_(v)); o[j] = valid ? v : 0.f; }
            u32x4 w; w.x = pk2(o[0], o[1]); w.y = pk2(o[2], o[3]); w.z = pk2(o[4], o[5]); w.w = pk2(o[6], o[7]); *(u32x4*)(LIN + (size_t)row * 256 + lane * 8) = w; }
        if (do_vsh) {
            float a[8], b[8]; unpack8(*(const u32x4*)(x + 1024 + lane * 8), a); unpack8(*(const u32x4*)(xp + 1024 + lane * 8), b);
            const f32x4 m0 = *(const f32x4*)(mu + 1024 + lane * 8), m1 = *(const f32x4*)(mu + 1024 + lane * 8 + 4); const float mm[8] = {m0.x, m0.y, m0.z, m0.w, m1.x, m1.y, m1.z, m1.w};
            float o[8];
#pragma unroll
            for (int j = 0; j < 8; ++j) { const float v = a[j] + (pmk * b[j] - a[j]) * mm[j]; o[j] = valid ? v : 0.f; }
            u32x4 w; w.x = pk2(o[0], o[1]); w.y = pk2(o[2], o[3]); w.z = pk2(o[4], o[5]); w.w = pk2(o[6], o[7]); *(u32x4*)(VSH + (size_t)row * 512 + lane * 8) = w; }
    }
}

__device__ __forceinline__ void ph_norm_route(LAS unsigned char* lds, const float* __restrict__ out, const float* __restrict__ g, const float* __restrict__ router, const float* __restrict__ rbias,
                                              bf16_t* __restrict__ U, int* __restrict__ TE, float* __restrict__ TG, int* __restrict__ STOK, unsigned* __restrict__ ctl, int bid, int nblk, int wave, int lane) {
    lane = opq(lane); nblk = opqs(nblk); bid = opqs(bid);
    { constexpr int NFILL = 2 * MOE_MAXPAN * 256 + RREAL; const int per = (NFILL + nblk - 1) / nblk; const int t_ = wave * 64 + lane;
      for (int i = t_; i < per; i += 512) { const int idx = bid * per + i; if (idx < NFILL) STOK[idx] = -1; } }
    const int rpw = (RREAL + nblk - 1) / nblk, rpwave = (rpw + 7) / 8;
    int c1[8], c2[8];
#pragma unroll
    for (int e = 0; e < 8; ++e) { c1[e] = 0; c2[e] = 0; }
    f32x4 nx[4];
    { const int rl0 = wave * rpwave, row_0 = bid * rpw + rl0; if (rl0 < rpw && row_0 < RREAL) { const f32x4* x0 = (const f32x4*)(out + (size_t)row_0 * D) + lane;
#pragma unroll
        for (int j = 0; j < 4; ++j) nx[j] = x0[64 * j]; } }
    for (int k = 0; k < rpwave; ++k) { const int rl = wave * rpwave + k; const int row = bid * rpw + rl; if (rl >= rpw || row >= RREAL) break;
        const f32x4* g4 = (const f32x4*)g + lane;
        f32x4 v[4]; float s = 0.f;
#pragma unroll
        for (int j = 0; j < 4; ++j) v[j] = nx[j];
        if (k + 1 < rpwave && rl + 1 < rpw && row + 1 < RREAL) { const f32x4* x1 = (const f32x4*)(out + (size_t)(row + 1) * D) + lane;
#pragma unroll
            for (int j = 0; j < 4; ++j) nx[j] = x1[64 * j]; }
#pragma unroll
        for (int j = 0; j < 4; ++j) s += (v[j].x * v[j].x + v[j].y * v[j].y) + (v[j].z * v[j].z + v[j].w * v[j].w);
        const float rstd = rsqrtf(wave_sum(s) * (1.f / D) + RMS_EPS);
        unsigned* o4 = (unsigned*)((unsigned char*)U + (size_t)row * D) + lane;
        float lg[8];
#pragma unroll
        for (int e = 0; e < 8; ++e) lg[e] = 0.f;
#pragma unroll
        for (int j = 0; j < 4; ++j) { const f32x4 gg = g4[64 * j]; f32x4 xn; xn.x = v[j].x * rstd * gg.x; xn.y = v[j].y * rstd * gg.y; xn.z = v[j].z * rstd * gg.z; xn.w = v[j].w * rstd * gg.w;
            o4[64 * j] = pk4_f8(xn.x * F8_ACT, xn.y * F8_ACT, xn.z * F8_ACT, xn.w * F8_ACT);
            const int d0 = 4 * (lane + 64 * j);
#pragma unroll
            for (int q = 0; q < 4; ++q) { const f32x4 ra = *(const f32x4*)(router + (size_t)(d0 + q) * 8), rb = *(const f32x4*)(router + (size_t)(d0 + q) * 8 + 4); const float xv = xn[q];
                lg[0] += xv * ra.x; lg[1] += xv * ra.y; lg[2] += xv * ra.z; lg[3] += xv * ra.w; lg[4] += xv * rb.x; lg[5] += xv * rb.y; lg[6] += xv * rb.z; lg[7] += xv * rb.w; }
            asm volatile("" ::: "memory"); }
#pragma unroll
        for (int e = 0; e < 8; ++e) { float t_ = wave_sum(lg[e]); asm volatile("" : "+v"(t_)); lg[e] = t_ + rbias[e]; }
        int e1 = 0; float l1 = lg[0];
#pragma unroll
        for (int e = 1; e < 8; ++e) if (lg[e] > l1) { l1 = lg[e]; e1 = e; }
        int e2 = e1 == 0 ? 1 : 0; float l2 = -INFINITY;
#pragma unroll
        for (int e = 0; e < 8; ++e) if (e != e1 && lg[e] > l2) { l2 = lg[e]; e2 = e; }
        const float g1 = 1.0f / (1.0f + __expf(l2 - l1)), g2 = 1.0f - g1;
        { const int e1v = e1, e2v = e2;
#pragma unroll
        for (int e = 0; e < 8; ++e) { c1[e] += (e1v == e) ? 1 : 0; c2[e] += (e2v == e) ? 1 : 0; } }
        if (lane == 0) { TE[row] = e1; TE[RREAL + row] = e2; TG[row] = g1; TG[RREAL + row] = g2; }
    }
    LAS int* wc = (LAS int*)(lds + 80000);
    if (lane == 0) {
#pragma unroll
        for (int e = 0; e < 8; ++e) { wc[wave * 16 + e] = c1[e]; wc[wave * 16 + 8 + e] = c2[e]; } }
    __syncthreads();
    const int t = wave * 64 + lane;
    if (t < 16) { int sum = 0;
#pragma unroll
        for (int ww = 0; ww < 8; ++ww) sum += wc[ww * 16 + t];
        ctl[CW_WGCNT + bid * 16 + t] = (unsigned)sum; }
}
__device__ __forceinline__ void ph_moe_assign(LAS unsigned char* lds, int list, const int* __restrict__ TE, const float* __restrict__ TG, int* __restrict__ STOK, float* __restrict__ SGATE, int* __restrict__ BE, unsigned* __restrict__ ctl,
                                              const unsigned char* __restrict__ U8, unsigned char* __restrict__ XB, int bid, int nblk, int tid) {
    LAS int* sh = (LAS int*)lds;
    __syncthreads();
    {
        LAS float* shf = (LAS float*)(lds + 2048);
        float tv[8], pv[8];
#pragma unroll
        for (int e = 0; e < 8; ++e) { tv[e] = 0.f; pv[e] = 0.f; }
        for (int b = tid; b < nblk; b += 512) { const u32x4* cp4 = (const u32x4*)(ctl + CW_WGCNT + b * 16 + 8 * list); const u32x4 c0 = cp4[0], c1 = cp4[1];
            const float v[8] = {(float)c0.x, (float)c0.y, (float)c0.z, (float)c0.w, (float)c1.x, (float)c1.y, (float)c1.z, (float)c1.w};
#pragma unroll
            for (int e = 0; e < 8; ++e) { tv[e] += v[e]; pv[e] += b < bid ? v[e] : 0.f; } }
        const int wv = tid >> 6;
#pragma unroll
        for (int e = 0; e < 8; ++e) { const float ts = wave_sum(tv[e]), ps = wave_sum(pv[e]); if ((tid & 63) == 0) { shf[wv * 16 + e] = ts; shf[wv * 16 + 8 + e] = ps; } }
        __syncthreads();
        if (tid < 8) { float tot = 0.f, pre = 0.f;
#pragma unroll
            for (int ww = 0; ww < 8; ++ww) { tot += shf[ww * 16 + tid]; pre += shf[ww * 16 + 8 + tid]; }
            sh[tid] = (int)tot; sh[8 + tid] = (int)pre; }
    }
    __syncthreads();
    if (tid == 0) { int pan = 0;
        for (int e = 0; e < 8; ++e) { const int np = (sh[e] + 255) >> 8; sh[16 + e] = pan << 8;
            if (bid == 0) for (int q = 0; q < np; ++q) { const int pi = pan + q; BE[256 * list + pi + (list == 1 && pi >= MOE_TAILPAN ? MOE_GAP : 0)] = e; }
            pan += np; }
        if (bid == 0) ctl[CW_NPAN + list] = (unsigned)pan; }
    __syncthreads();
    if (tid < 64) {
        const int rpw = (RREAL + nblk - 1) / nblk; int run[8];
#pragma unroll
        for (int q = 0; q < 8; ++q) run[q] = 0;
        for (int r0 = 0; r0 < rpw; r0 += 64) { const int rl = r0 + tid, row = bid * rpw + rl; const bool ok = rl < rpw && row < RREAL;
            const int ee = ok ? TE[list * RREAL + row] : -1; int slot = -1;
#pragma unroll
            for (int e = 0; e < 8; ++e) { const unsigned long long m = __builtin_amdgcn_ballot_w64(ee == e);
                const int rank = (int)__builtin_amdgcn_mbcnt_hi((unsigned)(m >> 32), __builtin_amdgcn_mbcnt_lo((unsigned)m, 0u));
                if (ee == e) { slot = sh[16 + e] + sh[8 + e] + run[e] + rank; if (list == 1 && slot >= MOE_TAILPAN * 256) slot += MOE_GAP * 256; }
                run[e] += __builtin_popcountll(m); }
            if (rl < rpw) sh[32 + rl] = ok ? slot : -1;
            if (ok) { STOK[list * (MOE_MAXPAN * 256) + slot] = row; SGATE[list * (MOE_MAXPAN * 256) + slot] = TG[list * RREAL + row];
                if (list == 1 && slot >= (MOE_TAILPAN + MOE_GAP) * 256) STOK[2 * MOE_MAXPAN * 256 + row] = slot - (MOE_TAILPAN + MOE_GAP) * 256; } }
    }
    __syncthreads();
    {
        const int rpw = (RREAL + nblk - 1) / nblk, w = tid >> 6, ln = tid & 63; unsigned char* xl = XB + (size_t)list * (MOE_MAXPAN * 256) * 1024;
        for (int rl = w; rl < rpw; rl += 8) { const int slot = sh[32 + rl]; if (slot >= 0) ((u32x4*)(xl + (size_t)slot * 1024))[ln] = ((const u32x4*)(U8 + (size_t)(bid * rpw + rl) * 1024))[ln]; }
        if (bid < 8) { const int e = bid, lo = sh[16 + e] + sh[e], hi = sh[16 + e] + (((sh[e] + 255) >> 8) << 8); unsigned z0 = 0u; asm volatile("" : "+v"(z0)); u32x4 z; z.x = z.y = z.z = z.w = z0;
            for (int p0 = lo + w; p0 < hi; p0 += 8) { const int slot = p0 + ((list == 1 && p0 >= MOE_TAILPAN * 256) ? MOE_GAP * 256 : 0); ((u32x4*)(xl + (size_t)slot * 1024))[ln] = z; } }
    }
}
__device__ __forceinline__ void ph_final(float* __restrict__ out, const float* __restrict__ g, const int* __restrict__ tslot, const float* __restrict__ tb, int gw, int ngw, int lane, float pscale = 1.0f) {
    lane = opq(lane);
    for (int row = gw; row < RREAL; row += ngw) {
        f32x4* xr = (f32x4*)(out + (size_t)row * D) + lane; const f32x4* g4 = (const f32x4*)g + lane;
        const int ts = __builtin_amdgcn_readfirstlane(tslot[row]);
        f32x4 v[4]; float s = 0.f;
#pragma unroll
        for (int j = 0; j < 4; ++j) v[j] = xr[64 * j];
        if (ts >= 0) { const f32x4* tr = (const f32x4*)(tb + (size_t)ts * D) + lane;
#pragma unroll
            for (int j = 0; j < 4; ++j) v[j] = v[j] + tr[64 * j]; }
#pragma unroll
        for (int j = 0; j < 4; ++j) s += (v[j].x * v[j].x + v[j].y * v[j].y) + (v[j].z * v[j].z + v[j].w * v[j].w);
        const float rstd = rsqrtf(wave_sum(s) * (1.f / D) + RMS_EPS);
#pragma unroll
        for (int j = 0; j < 4; ++j) { const f32x4 gg = g4[64 * j]; f32x4 o; o.x = v[j].x * rstd * gg.x * pscale; o.y = v[j].y * rstd * gg.y * pscale; o.z = v[j].z * rstd * gg.z * pscale; o.w = v[j].w * rstd * gg.w * pscale; xr[64 * j] = o; }
    }
}

constexpr int KS_STRIDE = 200, VS_STRIDE = 72;
constexpr int ATT_LDS = 64 * KS_STRIDE * 2 + 128 * VS_STRIDE * 2;
__device__ __forceinline__ bf16x8 pack8(const f32x16& x, int s) {
    u32x4 p;
    if (s == 0) { p.x = cvtpk(x[0], x[1]); p.y = cvtpk(x[2], x[3]); p.z = cvtpk(x[4], x[5]); p.w = cvtpk(x[6], x[7]); }
    else { p.x = cvtpk(x[8], x[9]); p.y = cvtpk(x[10], x[11]); p.z = cvtpk(x[12], x[13]); p.w = cvtpk(x[14], x[15]); }
    return __builtin_bit_cast(bf16x8, p);
}
__device__ __forceinline__ void attn_unit(LAS unsigned char* lds, const bf16_t* __restrict__ Q, const bf16_t* __restrict__ KN, const bf16_t* __restrict__ KR, const bf16_t* __restrict__ VT,
                                          bf16_t* __restrict__ MIX, const float* __restrict__ rope, int h, int qrow0, int kbase, int ntile, int wlim, bool wave_active) {
    const int tid = opq(threadIdx.x), lane = tid & 63, w = tid >> 6, r = lane & 31, hh = lane >> 5;
    LAS bf16_t* Ks = (LAS bf16_t*)lds; LAS bf16_t* Vs = (LAS bf16_t*)(lds + 64 * KS_STRIDE * 2);
    const int qrow = qrow0 + 32 * w + r;
    bf16x8 qf[12];
#pragma unroll
    for (int ks = 0; ks < 12; ++ks) qf[ks] = *(const GAS bf16x8*)(Q + (size_t)qrow * 768 + 192 * h + 16 * ks + 8 * hh);
    {
        const int pos = row_pos(qrow); const GAS float* rt = (const GAS float*)(rope + (size_t)pos * 64);
#pragma unroll
        for (int half = 0; half < 2; ++half) { const GAS float* cs = rt + 2 * (16 * half + 8 * hh);
#pragma unroll
            for (int j = 0; j < 8; ++j) { const float c = cs[2 * j], sn = cs[2 * j + 1]; const float x1 = bf2f((bf16_t)qf[8 + half][j]), x2 = bf2f((bf16_t)qf[10 + half][j]);
                qf[8 + half][j] = (short)f2bf(x1 * c - x2 * sn); qf[10 + half][j] = (short)f2bf(x1 * sn + x2 * c); } }
    }
    float z0 = 0.f; asm volatile("" : "+v"(z0));
    f32x16 oacc[4];
#pragma unroll
    for (int i = 0; i < 4; ++i)
#pragma unroll
        for (int j = 0; j < 16; ++j) oacc[i][j] = z0;
    float mrun = -INFINITY, lsum = 0.f;
    const float sc = 0.07216878364870322f * 1.4426950408889634f;
    u32x4 kreg[3], vreg[2];
    const unsigned kn_off0 = (unsigned)(((tid >> 4) * 512 + h * 128 + (tid & 15) * 8) * 2), kn_off1 = kn_off0 + 32u * 512u * 2u;
    const unsigned kr_off = (unsigned)(((tid >> 3) * 64 + (tid & 7) * 8) * 2);
    const unsigned vt_off0 = (unsigned)((((size_t)(h * 128 + (tid >> 3))) * RP + (tid & 7) * 8) * 2), vt_off1 = vt_off0 + 64u * (unsigned)RP * 2u;
#define ATT_GLOAD(tt_) do { const int krow0_ = (tt_) == 0 ? RREAL : kbase + 64 * ((tt_) - 1); \
    const char* knb_ = (const char*)KN + (size_t)krow0_ * 1024; const char* krb_ = (const char*)KR + (size_t)krow0_ * 128; const char* vtb_ = (const char*)VT + (size_t)krow0_ * 2; \
    kreg[0] = *(const GAS u32x4*)(knb_ + kn_off0); kreg[1] = *(const GAS u32x4*)(knb_ + kn_off1); kreg[2] = *(const GAS u32x4*)(krb_ + kr_off); \
    vreg[0] = *(const GAS u32x4*)(vtb_ + vt_off0); vreg[1] = *(const GAS u32x4*)(vtb_ + vt_off1); } while (0)
    ATT_GLOAD(0);
    for (int tt = 0; tt < ntile; ++tt) {
#ifdef PROBE_ATT_STAGE2
        __syncthreads();
        *(LAS u32x4*)(Ks + (tid >> 4) * KS_STRIDE + (tid & 15) * 8) = kreg[0]; *(LAS u32x4*)(Ks + (32 + (tid >> 4)) * KS_STRIDE + (tid & 15) * 8) = kreg[1];
        *(LAS u32x4*)(Ks + (tid >> 3) * KS_STRIDE + 128 + (tid & 7) * 8) = kreg[2];
#pragma unroll
        for (int i = 0; i < 2; ++i) {
            LAS u32x2* d = (LAS u32x2*)(Vs + ((tid >> 3) + 64 * i) * VS_STRIDE + ((tid & 7) >> 1) * 16 + (tid & 1) * 4);
            u32x2 lo; lo.x = vreg[i].x; lo.y = vreg[i].y; u32x2 hi; hi.x = vreg[i].z; hi.y = vreg[i].w; d[0] = lo; d[2] = hi; }
        __syncthreads();
#endif
        __syncthreads();
        *(LAS u32x4*)(Ks + (tid >> 4) * KS_STRIDE + (tid & 15) * 8) = kreg[0]; *(LAS u32x4*)(Ks + (32 + (tid >> 4)) * KS_STRIDE + (tid & 15) * 8) = kreg[1];
        *(LAS u32x4*)(Ks + (tid >> 3) * KS_STRIDE + 128 + (tid & 7) * 8) = kreg[2];
#pragma unroll
        for (int i = 0; i < 2; ++i) {
            LAS u32x2* d = (LAS u32x2*)(Vs + ((tid >> 3) + 64 * i) * VS_STRIDE + ((tid & 7) >> 1) * 16 + (tid & 1) * 4);
            u32x2 lo; lo.x = vreg[i].x; lo.y = vreg[i].y; u32x2 hi; hi.x = vreg[i].z; hi.y = vreg[i].w; d[0] = lo; d[2] = hi; }
        __syncthreads();
        const bool comp = wave_active && tt <= wlim;
        if (tt + 1 < ntile) ATT_GLOAD(tt + 1);
        if (comp) {
            f32x16 sacc[2];
#pragma unroll
            for (int b = 0; b < 2; ++b)
#pragma unroll
                for (int j = 0; j < 16; ++j) sacc[b][j] = z0;
#ifdef PROBE_ATT_QK2
            {
            __builtin_amdgcn_sched_barrier(0);
            {
                const LAS bf16_t* kb0 = Ks + r * KS_STRIDE + 8 * hh;
                bf16x8 kf[6];
#pragma unroll
                for (int i = 0; i < 6; ++i) kf[i] = *(const LAS bf16x8*)(kb0 + 16 * i);
#pragma unroll
                for (int i = 0; i < 24; ++i) { sacc[i / 12] = __builtin_amdgcn_mfma_f32_32x32x16_bf16(kf[i % 6], qf[i % 12], sacc[i / 12], 0, 0, 0);
                    if (i + 6 < 24) kf[i % 6] = *(const LAS bf16x8*)(kb0 + ((i + 6) / 12) * 32 * KS_STRIDE + 16 * ((i + 6) % 12)); }
                __builtin_amdgcn_sched_group_barrier(0x100, 6, 0);
#pragma unroll
                for (int i = 0; i < 18; ++i) { __builtin_amdgcn_sched_group_barrier(0x008, 1, 0); __builtin_amdgcn_sched_group_barrier(0x100, 1, 0); }
                __builtin_amdgcn_sched_group_barrier(0x008, 6, 0);
            }
            __builtin_amdgcn_sched_barrier(0);
                asm volatile("" : "+v"(sacc[0][0]), "+v"(sacc[1][0]));
#pragma unroll
                for (int b = 0; b < 2; ++b)
#pragma unroll
                    for (int j = 0; j < 16; ++j) sacc[b][j] = z0;
            }
#endif
            __builtin_amdgcn_sched_barrier(0);
            {
                const LAS bf16_t* kb0 = Ks + r * KS_STRIDE + 8 * hh;
                bf16x8 kf[6];
#pragma unroll
                for (int i = 0; i < 6; ++i) kf[i] = *(const LAS bf16x8*)(kb0 + 16 * i);
#pragma unroll
                for (int i = 0; i < 24; ++i) { sacc[i / 12] = __builtin_amdgcn_mfma_f32_32x32x16_bf16(kf[i % 6], qf[i % 12], sacc[i / 12], 0, 0, 0);
                    if (i + 6 < 24) kf[i % 6] = *(const LAS bf16x8*)(kb0 + ((i + 6) / 12) * 32 * KS_STRIDE + 16 * ((i + 6) % 12)); }
                __builtin_amdgcn_sched_group_barrier(0x100, 6, 0);
#pragma unroll
                for (int i = 0; i < 18; ++i) { __builtin_amdgcn_sched_group_barrier(0x008, 1, 0); __builtin_amdgcn_sched_group_barrier(0x100, 1, 0); }
                __builtin_amdgcn_sched_group_barrier(0x008, 6, 0);
            }
            __builtin_amdgcn_sched_barrier(0);
            if (tt == 0) {
#pragma unroll
                for (int j = 8; j < 16; ++j) sacc[0][j] = -INFINITY;
#pragma unroll
                for (int j = 0; j < 16; ++j) sacc[1][j] = -INFINITY; }
            float tmax = fmaxf(sacc[0][0], sacc[1][0]);
#pragma unroll
            for (int j = 1; j < 16; ++j) tmax = fmaxf(tmax, fmaxf(sacc[0][j], sacc[1][j]));
            tmax = fmaxf(tmax, __int_as_float(__builtin_amdgcn_ds_bpermute((lane ^ 32) << 2, __float_as_int(tmax)))) * sc;
            const float mnew = fmaxf(mrun, tmax); const float alpha = __builtin_amdgcn_exp2f(mrun - mnew); mrun = mnew;
            float psum = 0.f;
#pragma unroll
            for (int b = 0; b < 2; ++b)
#pragma unroll
                for (int j = 0; j < 16; ++j) { const float p = __builtin_amdgcn_exp2f(__builtin_fmaf(sacc[b][j], sc, -mnew)); sacc[b][j] = p; psum += p; }
            lsum = lsum * alpha + psum;
            if (__builtin_amdgcn_ballot_w64(alpha != 1.0f) != 0ull) {
#pragma unroll
            for (int i = 0; i < 4; ++i)
#pragma unroll
                for (int j = 0; j < 16; ++j) oacc[i][j] *= alpha; }
            bf16x8 pf[4];
            pf[0] = pack8(sacc[0], 0); pf[1] = pack8(sacc[0], 1); pf[2] = pack8(sacc[1], 0); pf[3] = pack8(sacc[1], 1);
#ifdef PROBE_ATT_PV2
            {
                const LAS bf16_t* vb0 = Vs + r * VS_STRIDE + 8 * hh;
#pragma unroll
                for (int j = 0; j < 16; ++j) { sacc[0][j] = z0; sacc[1][j] = z0; }
#pragma unroll
                for (int i = 0; i < 16; ++i) { const bf16x8 vfd = *(const LAS bf16x8*)(vb0 + 32 * (i >> 2) * VS_STRIDE + 16 * (i & 3));
                    sacc[i & 1] = __builtin_amdgcn_mfma_f32_32x32x16_bf16(vfd, pf[i & 3], sacc[i & 1], 0, 0, 0); }
                asm volatile("" :: "v"(sacc[0][0]), "v"(sacc[1][0]));
            }
#endif
            __builtin_amdgcn_sched_barrier(0);
            {
                const LAS bf16_t* vb0 = Vs + r * VS_STRIDE + 8 * hh;
                bf16x8 vf[16];
#pragma unroll
                for (int i = 0; i < 16; ++i) vf[i] = *(const LAS bf16x8*)(vb0 + 32 * (i >> 2) * VS_STRIDE + 16 * (i & 3));
#pragma unroll
                for (int i = 0; i < 16; ++i) oacc[i >> 2] = __builtin_amdgcn_mfma_f32_32x32x16_bf16(vf[i], pf[i & 3], oacc[i >> 2], 0, 0, 0);
                __builtin_amdgcn_sched_group_barrier(0x100, 8, 1);
#pragma unroll
                for (int i = 0; i < 8; ++i) { __builtin_amdgcn_sched_group_barrier(0x008, 1, 1); __builtin_amdgcn_sched_group_barrier(0x100, 1, 1); }
                __builtin_amdgcn_sched_group_barrier(0x008, 8, 1);
            }
            __builtin_amdgcn_sched_barrier(0);
        }
    }
    if (wave_active) {
        const float ltot = lsum + __int_as_float(__builtin_amdgcn_ds_bpermute((lane ^ 32) << 2, __float_as_int(lsum))); const float inv = 1.0f / ltot;
        bf16_t* orow = MIX + (size_t)qrow * D + 128 * h;
#pragma unroll
        for (int dvb = 0; dvb < 4; ++dvb)
#pragma unroll
            for (int g = 0; g < 4; ++g) { u32x2 o; o.x = cvtpk(oacc[dvb][4 * g] * inv, oacc[dvb][4 * g + 1] * inv); o.y = cvtpk(oacc[dvb][4 * g + 2] * inv, oacc[dvb][4 * g + 3] * inv);
                *(GAS u32x2*)(orow + 32 * dvb + 8 * g + 4 * hh) = o; }
    }
    __syncthreads();
}
__device__ __forceinline__ void attn_phase(LAS unsigned char* lds, const bf16_t* Q, const bf16_t* KN, const bf16_t* KR, const bf16_t* VT, bf16_t* MIX, const float* rope, int bid, int nblk) {
    const int w = opq(threadIdx.x) >> 6;
    for (int s = bid; s < 512; s += nblk) {
        const int round = s >> 8, x = s & 255; const int bh = (x >> 4) + 16 * round, qb = round ? 15 - (x & 15) : (x & 15);
        const int b = bh >> 2, h = bh & 3;
        attn_unit(lds, Q, KN, KR, VT, MIX, rope, h, b * SEQ + 256 * qb, b * SEQ, 4 * qb + 5, 4 * qb + (w >> 1) + 1, true);
    }
    for (int s = bid; s < 4; s += nblk)
        attn_unit(lds, Q, KN, KR, VT, MIX, rope, s, RREAL, 0, 1, 0, w == 0);
}

constexpr int CLS = 72;
constexpr int CSLOT = 64 * CLS * 2;
constexpr int CHK_BYTES = 32768;
constexpr int NSEQ_HALF0 = 257;
struct CpP { const bf16_t* PR; const bf16_t* LO; const bf16_t* VMIX; const bf16_t* VFIRST; bf16_t* VP; float* RK; unsigned char* CHK;
    const float *mu, *w0, *a0, *k_k, *k_a, *r_k, *v0; int layer, pad; };

__device__ __forceinline__ void mm64(f32x16& acc, const LAS bf16_t* a, const LAS bf16_t* b, int r, int hh) {
    bf16x8 af[4], bf[4];
#pragma unroll
    for (int ks = 0; ks < 4; ++ks) { af[ks] = *(const LAS bf16x8*)(a + r * CLS + 16 * ks + 8 * hh); bf[ks] = *(const LAS bf16x8*)(b + r * CLS + 16 * ks + 8 * hh); }
#pragma unroll
    for (int ks = 0; ks < 4; ++ks) acc = __builtin_amdgcn_mfma_f32_32x32x16_bf16(af[ks], bf[ks], acc, 0, 0, 0);
}
__device__ __forceinline__ void st_tile(const f32x16& acc, LAS bf16_t* dst, int m0, int n0, int r, int hh) {
#pragma unroll
    for (int q = 0; q < 16; ++q) dst[(m0 + (q & 3) + 8 * (q >> 2) + 4 * hh) * CLS + n0 + r] = f2bf_hw(acc[q]);
}
__device__ __forceinline__ void st_tile_t(const f32x16& acc, LAS bf16_t* dst, int m0, int n0, int r, int hh) {
#pragma unroll
    for (int g = 0; g < 4; ++g) { u32x2 o; o.x = cvtpk(acc[4 * g], acc[4 * g + 1]); o.y = cvtpk(acc[4 * g + 2], acc[4 * g + 3]);
        *(LAS u32x2*)(dst + (n0 + r) * CLS + m0 + 8 * g + 4 * hh) = o; }
}
__device__ __forceinline__ void zero16(f32x16& a, float z) {
#pragma unroll
    for (int q = 0; q < 16; ++q) a[q] = z;
}
typedef float f32x2 __attribute__((ext_vector_type(2)));
struct CpRaw { unsigned xr[5], xk[5], xv[5], lw[4], la[4], vm[4], vf[4]; f32x2 mu_r, mu_k, mu_v, w0, a0, kkc, kac, rkc, v0; float pm0; };
__device__ __forceinline__ void cp_issue(const CpP& P, int row0, int hd, int w, int lane, CpRaw& R) {
    const int cp = lane & 31, rh = lane >> 5, c = hd * 64 + 2 * cp;
    R.mu_r = *(const GAS f32x2*)(P.mu + c); R.mu_k = *(const GAS f32x2*)(P.mu + 512 + c); R.mu_v = *(const GAS f32x2*)(P.mu + 1024 + c); R.w0 = *(const GAS f32x2*)(P.w0 + c); R.a0 = *(const GAS f32x2*)(P.a0 + c);
    R.kkc = *(const GAS f32x2*)(P.k_k + c); R.kac = *(const GAS f32x2*)(P.k_a + c); R.rkc = *(const GAS f32x2*)(P.r_k + c);
    if (P.layer) R.v0 = *(const GAS f32x2*)(P.v0 + c); else { R.v0.x = 0.f; R.v0.y = 0.f; }
    const int rw0 = row0 + 8 * w + 4 * rh; const int prow0 = (w == 0 && rh == 0) ? row_prev(row0) : rw0 - 1; R.pm0 = prow0 < 0 ? 0.f : 1.f;
    { const bf16_t* xp = P.PR + (size_t)(prow0 < 0 ? rw0 : prow0) * PRW + c; R.xr[0] = *(const GAS unsigned*)xp; R.xk[0] = *(const GAS unsigned*)(xp + 512); R.xv[0] = *(const GAS unsigned*)(xp + 1024); }
#pragma unroll
    for (int q = 0; q < 4; ++q) { const bf16_t* x = P.PR + (size_t)(rw0 + q) * PRW + c; R.xr[q + 1] = *(const GAS unsigned*)x; R.xk[q + 1] = *(const GAS unsigned*)(x + 512); R.xv[q + 1] = *(const GAS unsigned*)(x + 1024);
        const bf16_t* lo = P.LO + (size_t)(rw0 + q) * 1536 + c; R.lw[q] = *(const GAS unsigned*)lo; R.la[q] = *(const GAS unsigned*)(lo + 512);
        if (P.layer) { R.vm[q] = *(const GAS unsigned*)(P.VMIX + (size_t)(rw0 + q) * 512 + c); R.vf[q] = *(const GAS unsigned*)(P.VFIRST + (size_t)(rw0 + q) * 512 + c); } else { R.vm[q] = 0u; R.vf[q] = 0u; } }
}
__device__ __forceinline__ float bfl(unsigned u) { return __uint_as_float(u << 16); }
__device__ __forceinline__ float bfh(unsigned u) { return __uint_as_float(u & 0xffff0000u); }
__device__ __forceinline__ float half_tot(float v) {
    v += DPP_F(v, 0xB1, 0xf); v += DPP_F(v, 0x4E, 0xf); v += DPP_F(v, 0x141, 0xf); v += DPP_F(v, 0x140, 0xf); v += DPP_F(v, 0x142, 0xa); return v; }
__device__ __forceinline__ void rwkv_cp_task(LAS unsigned char* lds, const CpP& P, int row0, int hd, unsigned char* out, CpRaw& R, bool has_next, int nrow0, int nhd) {
    const int tid = opq(threadIdx.x), lane = tid & 63, w = __builtin_amdgcn_readfirstlane(tid >> 6), r = lane & 31, hh = lane >> 5;
    float z0 = 0.f; asm volatile("" : "+v"(z0));
    LAS bf16_t* S_ATtm = (LAS bf16_t*)(lds + 0 * CSLOT);
    LAS bf16_t* S_BHtm = (LAS bf16_t*)(lds + 1 * CSLOT);
    LAS bf16_t* S_KHtm = (LAS bf16_t*)(lds + 2 * CSLOT);
    LAS bf16_t* S_RTtm = (LAS bf16_t*)(lds + 3 * CSLOT);
    LAS bf16_t* S_ATcm = (LAS bf16_t*)(lds + 4 * CSLOT);
    LAS bf16_t* S_BBcm = (LAS bf16_t*)(lds + 5 * CSLOT);
    LAS bf16_t* S_KBcm = (LAS bf16_t*)(lds + 6 * CSLOT);
    LAS bf16_t* S_VTcm = (LAS bf16_t*)(lds + 7 * CSLOT);
    LAS bf16_t* S_Q0a = (LAS bf16_t*)(lds + 8 * CSLOT);
    LAS bf16_t* S_Q0b = (LAS bf16_t*)(lds + 9 * CSLOT);
    LAS bf16_t* S_PP0 = (LAS bf16_t*)(lds + 10 * CSLOT);
    LAS bf16_t* S_Na = (LAS bf16_t*)(lds + 11 * CSLOT);
    LAS bf16_t* S_XT = (LAS bf16_t*)(lds + 12 * CSLOT);
    LAS bf16_t* S_Pa = (LAS bf16_t*)(lds + 13 * CSLOT);
    LAS bf16_t* S_Qa = (LAS bf16_t*)(lds + 14 * CSLOT);
    LAS float* S_TOT = (LAS float*)(lds + 15 * CSLOT);
    LAS bf16_t* Qa[2] = {S_Q0a, S_ATtm}; LAS bf16_t* Qb[2] = {S_Q0b, S_BHtm}; LAS bf16_t* PPa[2] = {S_PP0, S_KHtm};

    {
        const int cp = lane & 31, rh = lane >> 5, c = hd * 64 + 2 * cp;
        const f32x2 mu_r = R.mu_r, mu_k = R.mu_k, mu_v = R.mu_v, w0 = R.w0, a0 = R.a0, kkc = R.kkc, kac = R.kac, rkc = R.rkc, v0 = R.v0; const float pm0 = R.pm0;
        float fr[4][2], fk[4][2], fv[4][2], fa[4][2], fb[4][2], lw[4][2];
        const int rw0 = row0 + 8 * w + 4 * rh;
        constexpr float L2E = 1.4426950408889634f;
#pragma unroll
        for (int q = 0; q < 4; ++q) { const int row = rw0 + q; const bool valid = row < RVALID; const float pm = q == 0 ? pm0 : 1.f;
            float rr[2] = {bfl(R.xr[q + 1]), bfh(R.xr[q + 1])}, kk[2] = {bfl(R.xk[q + 1]), bfh(R.xk[q + 1])}, vv[2] = {bfl(R.xv[q + 1]), bfh(R.xv[q + 1])};
            const float pr[2] = {bfl(R.xr[q]), bfh(R.xr[q])}, pk[2] = {bfl(R.xk[q]), bfh(R.xk[q])}, pv[2] = {bfl(R.xv[q]), bfh(R.xv[q])};
            const float wpre[2] = {bfl(R.lw[q]), bfh(R.lw[q])}, apre[2] = {bfl(R.la[q]), bfh(R.la[q])};
            float lwv[2], asig[2], kkr[2], k2[2], kn[2];
#pragma unroll
            for (int e = 0; e < 2; ++e) {
                rr[e] = rr[e] + (pm * pr[e] - rr[e]) * mu_r[e]; kk[e] = kk[e] + (pm * pk[e] - kk[e]) * mu_k[e]; vv[e] = vv[e] + (pm * pv[e] - vv[e]) * mu_v[e];
                lwv[e] = -0.6065306597126334f * __builtin_amdgcn_rcpf(1.0f + __builtin_amdgcn_exp2f(-(w0[e] + wpre[e]) * L2E));
                asig[e] = __builtin_amdgcn_rcpf(1.0f + __builtin_amdgcn_exp2f(-(a0[e] + apre[e]) * L2E));
                kkr[e] = kk[e] * kkc[e]; k2[e] = kk[e] * (1.f + (asig[e] - 1.f) * kac[e]); }
            if (P.layer) { const float vm[2] = {bfl(R.vm[q]), bfh(R.vm[q])}, vf[2] = {bfl(R.vf[q]), bfh(R.vf[q])};
#pragma unroll
                for (int e = 0; e < 2; ++e) vv[e] = vv[e] + (vf[e] - vv[e]) * __builtin_amdgcn_rcpf(1.0f + __builtin_amdgcn_exp2f(-(v0[e] + vm[e]) * L2E)); }
            const float sst = half_tot(kkr[0] * kkr[0] + kkr[1] * kkr[1]);
            const float rkt = half_tot(rr[0] * k2[0] * rkc[0] + rr[1] * k2[1] * rkc[1]);
            const float ss0 = __int_as_float(__builtin_amdgcn_readlane(__float_as_int(sst), 31)), ss1 = __int_as_float(__builtin_amdgcn_readlane(__float_as_int(sst), 63));
            const float rs = rsqrtf(fmaxf(rh ? ss1 : ss0, 1e-24f));
            kn[0] = kkr[0] * rs; kn[1] = kkr[1] * rs;
            if (!valid) {
#pragma unroll
                for (int e = 0; e < 2; ++e) { rr[e] = 0.f; k2[e] = 0.f; vv[e] = 0.f; kn[e] = 0.f; lwv[e] = 0.f; } }
            *(GAS unsigned*)(P.VP + (size_t)row * 512 + c) = cvtpk(vv[0], vv[1]); if (cp == 31) ((GAS float*)P.RK)[(size_t)row * 8 + hd] = valid ? rkt : 0.f;
#pragma unroll
            for (int e = 0; e < 2; ++e) { fr[q][e] = rr[e]; fk[q][e] = k2[e]; fv[q][e] = vv[e]; fa[q][e] = -kn[e]; fb[q][e] = kn[e] * asig[e]; lw[q][e] = lwv[e]; } }
        if (has_next) cp_issue(P, nrow0, nhd, w, lane, R);
        float cum[4][2], hoff[2];
#pragma unroll
        for (int e = 0; e < 2; ++e) { cum[0][e] = lw[0][e];
#pragma unroll
            for (int q = 1; q < 4; ++q) cum[q][e] = cum[q - 1][e] + lw[q][e];
            const float pt = __int_as_float(__builtin_amdgcn_ds_bpermute((lane ^ 32) << 2, __float_as_int(cum[3][e]))); hoff[e] = rh ? pt : 0.f; }
        if (rh) { f32x2 t2; t2.x = hoff[0] + cum[3][0]; t2.y = hoff[1] + cum[3][1]; *(LAS f32x2*)(S_TOT + w * 64 + 2 * cp) = t2; }
        lds_barrier();
        float off[2] = {0.f, 0.f}, tot[2] = {0.f, 0.f};
#pragma unroll
        for (int ww = 0; ww < 8; ++ww) { const f32x2 tv = *(const LAS f32x2*)(S_TOT + ww * 64 + 2 * cp); off[0] += ww < w ? tv.x : 0.f; off[1] += ww < w ? tv.y : 0.f; tot[0] += tv.x; tot[1] += tv.y; }
        const float etot[2] = {__builtin_amdgcn_exp2f(tot[0] * L2E), __builtin_amdgcn_exp2f(tot[1] * L2E)};
        if (w == 0 && rh == 0) { f32x2 t2; t2.x = etot[0]; t2.y = etot[1]; *(LAS f32x2*)(S_TOT + 512 + 2 * cp) = t2; }
        float at[4][2], bh[4][2], kh[4][2], rt[4][2], bb[4][2], kb[4][2];
#pragma unroll
        for (int e = 0; e < 2; ++e) { const float base = off[e] + hoff[e];
            float ecprev = __builtin_amdgcn_exp2f(base * L2E);
#pragma unroll
            for (int q = 0; q < 4; ++q) { const float ci = base + cum[q][e]; const float ec = __builtin_amdgcn_exp2f(ci * L2E), ecp = ecprev, en = __builtin_amdgcn_rcpf(ec), ee = etot[e] * en; ecprev = ec;
                rt[q][e] = fr[q][e] * ec; at[q][e] = fa[q][e] * ecp; bh[q][e] = fb[q][e] * en; kh[q][e] = fk[q][e] * en; bb[q][e] = fb[q][e] * ee; kb[q][e] = fk[q][e] * ee; } }
#pragma unroll
        for (int q = 0; q < 4; ++q) { const int t = 8 * w + 4 * rh + q;
            *(LAS unsigned*)(S_ATtm + t * CLS + 2 * cp) = cvtpk(at[q][0], at[q][1]); *(LAS unsigned*)(S_BHtm + t * CLS + 2 * cp) = cvtpk(bh[q][0], bh[q][1]);
            *(LAS unsigned*)(S_KHtm + t * CLS + 2 * cp) = cvtpk(kh[q][0], kh[q][1]); *(LAS unsigned*)(S_RTtm + t * CLS + 2 * cp) = cvtpk(rt[q][0], rt[q][1]); }
#pragma unroll
        for (int e = 0; e < 2; ++e) { const int jo = (2 * cp + e) * CLS + 8 * w + 4 * rh; u32x2 o;
            o.x = cvtpk(at[0][e], at[1][e]); o.y = cvtpk(at[2][e], at[3][e]); *(LAS u32x2*)(S_ATcm + jo) = o;
            o.x = cvtpk(bb[0][e], bb[1][e]); o.y = cvtpk(bb[2][e], bb[3][e]); *(LAS u32x2*)(S_BBcm + jo) = o;
            o.x = cvtpk(kb[0][e], kb[1][e]); o.y = cvtpk(kb[2][e], kb[3][e]); *(LAS u32x2*)(S_KBcm + jo) = o;
            o.x = cvtpk(fv[0][e], fv[1][e]); o.y = cvtpk(fv[2][e], fv[3][e]); *(LAS u32x2*)(S_VTcm + jo) = o; }
    }
    lds_barrier();
    const int q4 = w & 3, mb = q4 >> 1, nb = q4 & 1; const bool upper = (mb == 0 && nb == 1);
    f32x16 pacc;
    {
        f32x16 a0, a1; zero16(a0, z0); zero16(a1, z0);
        const LAS bf16_t* lhs = (w < 4 ? S_ATtm : S_RTtm) + 32 * mb * CLS;
        if (!upper) { mm64(a0, lhs, S_BHtm + 32 * nb * CLS, r, hh); mm64(a1, lhs, S_KHtm + 32 * nb * CLS, r, hh); }
        const int s = 32 * nb + r;
#pragma unroll
        for (int q = 0; q < 16; ++q) { const int t = 32 * mb + (q & 3) + 8 * (q >> 2) + 4 * hh; const bool keep = w < 4 ? (s < t) : (s <= t); if (!keep) { a0[q] = z0; a1[q] = z0; } }
        if (w < 4) { st_tile(a0, S_Q0a, 32 * mb, 32 * nb, r, hh); st_tile_t(a0, S_Q0b, 32 * mb, 32 * nb, r, hh); st_tile(a1, S_Na, 32 * mb, 32 * nb, r, hh);
            pacc = a0;
#pragma unroll
            for (int q = 0; q < 16; ++q) { const int t = 32 * mb + (q & 3) + 8 * (q >> 2) + 4 * hh; if (t == s) pacc[q] += 1.0f; }
            st_tile(pacc, S_PP0, 32 * mb, 32 * nb, r, hh); }
        else { st_tile(a0, S_Pa, 32 * mb, 32 * nb, r, hh); st_tile(a1, S_Qa, 32 * mb, 32 * nb, r, hh); zero16(pacc, z0); }
    }
    lds_barrier();
    {
        f32x16 a; zero16(a, z0);
        if (w >= 4) { if (!upper) { mm64(a, Qa[0] + 32 * mb * CLS, Qb[0] + 32 * nb * CLS, r, hh); } st_tile(a, Qa[1], 32 * mb, 32 * nb, r, hh); st_tile_t(a, Qb[1], 32 * mb, 32 * nb, r, hh); }
        else { mm64(a, S_Na + 32 * mb * CLS, S_VTcm + 32 * nb * CLS, r, hh); st_tile_t(a, S_XT, 32 * mb, 32 * nb, r, hh); }
    }
    lds_barrier();
#pragma unroll 1
    for (int k = 1; k <= 5; ++k) {
        const int rs = k & 1, ws_ = rs ^ 1;
        if (w < 4) { if (!upper) mm64(pacc, PPa[ws_] + 32 * mb * CLS, Qb[rs] + 32 * nb * CLS, r, hh); st_tile(pacc, PPa[rs], 32 * mb, 32 * nb, r, hh); }
        else if (k < 5) { f32x16 a; zero16(a, z0); if (!upper) mm64(a, Qa[rs] + 32 * mb * CLS, Qb[rs] + 32 * nb * CLS, r, hh); st_tile(a, Qa[ws_], 32 * mb, 32 * nb, r, hh); st_tile_t(a, Qb[ws_], 32 * mb, 32 * nb, r, hh); }
        lds_barrier();
    }
    {
        f32x16 a; zero16(a, z0);
        mm64(a, PPa[1] + 32 * mb * CLS, (w < 4 ? S_ATcm : S_XT) + 32 * nb * CLS, r, hh);
        st_tile_t(a, w < 4 ? S_Q0a : S_Q0b, 32 * mb, 32 * nb, r, hh);
    }
    lds_barrier();
    {
        LAS bf16_t* W1T = S_Q0a; LAS bf16_t* U1T = S_Q0b;
        f32x16 a, b; zero16(a, z0); zero16(b, z0);
        GAS u32x4* o128 = (GAS u32x4*)out;
        if (w < 4) {
            mm64(a, S_BBcm + 32 * mb * CLS, U1T + 32 * nb * CLS, r, hh); mm64(a, S_KBcm + 32 * mb * CLS, S_VTcm + 32 * nb * CLS, r, hh);
            mm64(b, W1T + 32 * mb * CLS, S_BBcm + 32 * nb * CLS, r, hh);
            const float gam = S_TOT[512 + 32 * nb + r];
#pragma unroll
            for (int q = 0; q < 16; ++q) { const int j = 32 * mb + (q & 3) + 8 * (q >> 2) + 4 * hh; if (j == 32 * nb + r) b[q] += gam; }
            u32x4 h0, h1, g0, g1;
            h0.x = cvtpk(a[0], a[1]); h0.y = cvtpk(a[2], a[3]); h0.z = cvtpk(a[4], a[5]); h0.w = cvtpk(a[6], a[7]);
            h1.x = cvtpk(a[8], a[9]); h1.y = cvtpk(a[10], a[11]); h1.z = cvtpk(a[12], a[13]); h1.w = cvtpk(a[14], a[15]);
            g0.x = cvtpk(b[0], b[1]); g0.y = cvtpk(b[2], b[3]); g0.z = cvtpk(b[4], b[5]); g0.w = cvtpk(b[6], b[7]);
            g1.x = cvtpk(b[8], b[9]); g1.y = cvtpk(b[10], b[11]); g1.z = cvtpk(b[12], b[13]); g1.w = cvtpk(b[14], b[15]);
            o128[1024 + ((mb * 2 + nb) * 64 + lane) * 2] = h0; o128[1024 + ((mb * 2 + nb) * 64 + lane) * 2 + 1] = h1;
            o128[(nb * 4 + 2 * mb) * 64 + lane] = g0; o128[(nb * 4 + 2 * mb + 1) * 64 + lane] = g1;
        } else {
            mm64(a, S_Pa + 32 * mb * CLS, U1T + 32 * nb * CLS, r, hh); mm64(a, S_Qa + 32 * mb * CLS, S_VTcm + 32 * nb * CLS, r, hh);
            mm64(b, W1T + 32 * mb * CLS, S_Pa + 32 * nb * CLS, r, hh);
#pragma unroll
            for (int g = 0; g < 4; ++g) { const s16x4 rv = *(const LAS s16x4*)(S_RTtm + (32 * nb + r) * CLS + 32 * mb + 8 * g + 4 * hh);
#pragma unroll
                for (int e = 0; e < 4; ++e) b[4 * g + e] += bf2f((bf16_t)rv[e]); }
            u32x4 y0, y1, r0, r1;
            y0.x = cvtpk(a[0], a[1]); y0.y = cvtpk(a[2], a[3]); y0.z = cvtpk(a[4], a[5]); y0.w = cvtpk(a[6], a[7]);
            y1.x = cvtpk(a[8], a[9]); y1.y = cvtpk(a[10], a[11]); y1.z = cvtpk(a[12], a[13]); y1.w = cvtpk(a[14], a[15]);
            r0.x = cvtpk(b[0], b[1]); r0.y = cvtpk(b[2], b[3]); r0.z = cvtpk(b[4], b[5]); r0.w = cvtpk(b[6], b[7]);
            r1.x = cvtpk(b[8], b[9]); r1.y = cvtpk(b[10], b[11]); r1.z = cvtpk(b[12], b[13]); r1.w = cvtpk(b[14], b[15]);
            o128[1536 + ((mb * 2 + nb) * 64 + lane) * 2] = y0; o128[1536 + ((mb * 2 + nb) * 64 + lane) * 2 + 1] = y1;
            o128[512 + (nb * 4 + 2 * mb) * 64 + lane] = r0; o128[512 + (nb * 4 + 2 * mb + 1) * 64 + lane] = r1;
        }
    }
    lds_barrier();
}

struct ScP { const unsigned char* CHK; bf16_t* YS; };
__device__ __forceinline__ void scan_unpack16(f32x16& acc, const u32x4 y0, const u32x4 y1) {
    acc[0] = __uint_as_float(y0.x << 16); acc[1] = __uint_as_float(y0.x & 0xffff0000u); acc[2] = __uint_as_float(y0.y << 16); acc[3] = __uint_as_float(y0.y & 0xffff0000u);
    acc[4] = __uint_as_float(y0.z << 16); acc[5] = __uint_as_float(y0.z & 0xffff0000u); acc[6] = __uint_as_float(y0.w << 16); acc[7] = __uint_as_float(y0.w & 0xffff0000u);
    acc[8] = __uint_as_float(y1.x << 16); acc[9] = __uint_as_float(y1.x & 0xffff0000u); acc[10] = __uint_as_float(y1.y << 16); acc[11] = __uint_as_float(y1.y & 0xffff0000u);
    acc[12] = __uint_as_float(y1.z << 16); acc[13] = __uint_as_float(y1.z & 0xffff0000u); acc[14] = __uint_as_float(y1.w << 16); acc[15] = __uint_as_float(y1.w & 0xffff0000u);
}
__device__ __forceinline__ void scan_step(const LAS unsigned char* sl, LAS float* ybuf, f32x16 (&st)[2], int w, int lane, int r, int hh) {
    bf16x8 ar[2][4], ag[2][4]; u32x4 yi[2][2], hi[2][2];
#pragma unroll
    for (int tb = 0; tb < 2; ++tb) { const LAS u32x4* yf = (const LAS u32x4*)(sl + 24576) + ((tb * 2 + w) * 64 + lane) * 2; yi[tb][0] = yf[0]; yi[tb][1] = yf[1];
        const LAS u32x4* hf = (const LAS u32x4*)(sl + 16384) + ((tb * 2 + w) * 64 + lane) * 2; hi[tb][0] = hf[0]; hi[tb][1] = hf[1];
#pragma unroll
        for (int ks = 0; ks < 4; ++ks) { ar[tb][ks] = *(const LAS bf16x8*)(sl + 8192 + ((tb * 4 + ks) * 64 + lane) * 16); ag[tb][ks] = *(const LAS bf16x8*)(sl + ((tb * 4 + ks) * 64 + lane) * 16); } }
    bf16x8 sf[4];
    sf[0] = pack8(st[0], 0); sf[1] = pack8(st[0], 1); sf[2] = pack8(st[1], 0); sf[3] = pack8(st[1], 1);
    f32x16 ya[2], sa[2];
#pragma unroll
    for (int tb = 0; tb < 2; ++tb) { scan_unpack16(ya[tb], yi[tb][0], yi[tb][1]); scan_unpack16(sa[tb], hi[tb][0], hi[tb][1]); }
#pragma unroll
    for (int ks = 0; ks < 4; ++ks) {
        ya[0] = __builtin_amdgcn_mfma_f32_32x32x16_bf16(ar[0][ks], sf[ks], ya[0], 0, 0, 0); ya[1] = __builtin_amdgcn_mfma_f32_32x32x16_bf16(ar[1][ks], sf[ks], ya[1], 0, 0, 0);
        sa[0] = __builtin_amdgcn_mfma_f32_32x32x16_bf16(ag[0][ks], sf[ks], sa[0], 0, 0, 0); sa[1] = __builtin_amdgcn_mfma_f32_32x32x16_bf16(ag[1][ks], sf[ks], sa[1], 0, 0, 0); }
    st[0] = sa[0]; st[1] = sa[1];
#pragma unroll
    for (int tb = 0; tb < 2; ++tb)
#pragma unroll
        for (int q = 0; q < 16; ++q) ybuf[(32 * tb + (q & 3) + 8 * (q >> 2) + 4 * hh) * 64 + 32 * w + r] = ya[tb][q];
}
__device__ __forceinline__ void rwkv_scan_unit(LAS unsigned char* lds, const ScP& P, int seq0, int seqm, int nmeta, int nreal, int brow0, int hd, bool write_meta, const float* st_in, float* st_out) {
    const int tid = opq(threadIdx.x), lane = tid & 63, w = __builtin_amdgcn_readfirstlane(tid >> 6), r = lane & 31, hh = lane >> 5;
    const int N = nmeta + nreal;
    float z0 = 0.f; asm volatile("" : "+v"(z0));
    LAS float* ybuf = (LAS float*)(lds + 65536);
    f32x16 st[2]; zero16(st[0], z0); zero16(st[1], z0);
    if (st_in != nullptr && w < 2) { const GAS f32x4* sp = (const GAS f32x4*)(st_in + ((size_t)w * 64 + lane) * 32);
#pragma unroll
        for (int i = 0; i < 8; ++i) { const f32x4 v = sp[i];
#pragma unroll
            for (int j = 0; j < 4; ++j) st[i >> 2][4 * (i & 3) + j] = v[j]; } }
    const int c = hd * 64 + lane;
#define SCAN_SRC(n_) ((const GAS u32x4*)(P.CHK + ((size_t)((n_) < nmeta ? seqm : seq0 + (n_) - nmeta) * 8 + hd) * CHK_BYTES))
    u32x4 pa[4], pb[4], pc[4];
    { const GAS u32x4* s0 = SCAN_SRC(0); const GAS u32x4* s1 = SCAN_SRC(1); const GAS u32x4* s2 = SCAN_SRC(2);
#pragma unroll
      for (int i = 0; i < 4; ++i) pc[i] = s0[tid + 512 * i];
#pragma unroll
      for (int i = 0; i < 4; ++i) pa[i] = s1[tid + 512 * i];
#pragma unroll
      for (int i = 0; i < 4; ++i) pb[i] = s2[tid + 512 * i];
#pragma unroll
      for (int i = 0; i < 4; ++i) *(LAS u32x4*)(lds + (tid + 512 * i) * 16) = pc[i]; }
    lds_barrier();
#define SCAN_ITER(n_, PCUR, PMID, PNEXT) do { \
        const int n = (n_); \
        if (n + 3 < N) { const GAS u32x4* s3 = SCAN_SRC(n + 3); _Pragma("unroll") for (int i = 0; i < 4; ++i) PNEXT[i] = s3[tid + 512 * i]; } \
        if (w < 2) scan_step(lds + (n & 1) * 32768, ybuf, st, w, lane, r, hh); \
        lds_barrier(); \
        if (n + 1 < N) { _Pragma("unroll") for (int i = 0; i < 4; ++i) *(LAS u32x4*)(lds + ((n + 1) & 1) * 32768 + (tid + 512 * i) * 16) = PCUR[i]; } \
        if (w >= 2) { const int crow0 = n < nmeta ? RREAL : brow0 + 64 * (n - nmeta); const int nrow = n < nmeta ? (write_meta ? NMETA : 0) : 64; \
            for (int t = w - 2; t < nrow; t += 6) ((GAS bf16_t*)P.YS)[(size_t)(crow0 + t) * 512 + c] = f2bf_hw(ybuf[t * 64 + lane]); } \
        lds_barrier(); } while (0)
    int n3 = 0;
#pragma unroll 1
    for (; n3 + 3 <= N; n3 += 3) { SCAN_ITER(n3, pa, pb, pc); SCAN_ITER(n3 + 1, pb, pc, pa); SCAN_ITER(n3 + 2, pc, pa, pb); }
    if (N - n3 >= 1) SCAN_ITER(n3, pa, pb, pc);
    if (N - n3 >= 2) SCAN_ITER(n3 + 1, pb, pc, pa);
#undef SCAN_ITER
#undef SCAN_SRC
    if (st_out != nullptr && w < 2) { GAS f32x4* sp = (GAS f32x4*)(st_out + ((size_t)w * 64 + lane) * 32);
#pragma unroll
        for (int i = 0; i < 8; ++i) { f32x4 v;
#pragma unroll
            for (int j = 0; j < 4; ++j) v[j] = st[i >> 2][4 * (i & 3) + j];
            sp[i] = v; } }
}
struct PostP { const bf16_t* YS; const bf16_t* VP; const float* RK; const bf16_t* LO; bf16_t* MIX; const float *ln_w, *ln_b; };
__device__ __forceinline__ void rwkv_post(const PostP& P, int q, int rlo, int rhi, bool with_meta, int gw, int ngw, int lane) {
    lane = opq(lane);
    const int nreal = (rhi - rlo) * 8, ntot = nreal + (with_meta ? NMETA * 8 : 0);
    for (int item = gw; item < ntot; item += ngw) { const int ri = rlo + (item >> 3); const int row = item < nreal ? (ri >> 10) * SEQ + 1024 * q + (ri & 1023) : RREAL + ((item - nreal) >> 3); const int hd = item & 7, c = hd * 64 + lane;
        const float y = bf2f(P.YS[(size_t)row * 512 + c]); const float g = bf2f(P.LO[(size_t)row * 1536 + 1024 + c]), vp = bf2f(P.VP[(size_t)row * 512 + c]), rk = P.RK[(size_t)row * 8 + hd];
        const float mean = wave_sum(y) * (1.f / 64.f); const float d = y - mean; const float var = wave_sum(d * d) * (1.f / 64.f);
        const float yn = d * rsqrtf(var + GN_EPS) * P.ln_w[c] + P.ln_b[c];
        P.MIX[(size_t)row * D + 512 + c] = f2bf_hw((yn + rk * vp) * g); }
}

constexpr int LDS_BYTES = 147456, LDS_MISC = LDS_BYTES - 512;
struct Params { const float* in[33]; float* out; unsigned char* ws; };
constexpr int CW_BAR = 4096;


#ifndef PROBE_REP_MISC
#define PROBE_REP_MISC 1
#endif
#ifndef MOE_TAIL
#define MOE_TAIL 0
#endif
#ifndef PROBE_REP_OUTPROJ
#define PROBE_REP_OUTPROJ 1
#endif
#ifndef PROBE_REP_FFNDN
#define PROBE_REP_FFNDN 1
#endif
#ifndef PROBE_REP_MOEDN
#define PROBE_REP_MOEDN 1
#endif
#ifndef PROBE_REP_NORM
#define PROBE_REP_NORM 1
#endif
#ifndef PROBE_REP_INPROJ
#define PROBE_REP_INPROJ 1
#endif
#ifndef PROBE_REP_PREP
#define PROBE_REP_PREP 1
#endif
#ifndef PROBE_REP_P4A
#define PROBE_REP_P4A 1
#endif
#ifndef PROBE_REP_ATT
#define PROBE_REP_ATT 1
#endif
#ifndef PROBE_REP_P4B
#define PROBE_REP_P4B 1
#endif
#ifndef PROBE_REP_CP
#define PROBE_REP_CP 1
#endif
#ifndef PROBE_REP_SCAN
#define PROBE_REP_SCAN 1
#endif
#ifndef PROBE_REP_FFNGU
#define PROBE_REP_FFNGU 1
#endif
#ifndef PROBE_REP_MOETR
#define PROBE_REP_MOETR 1
#endif
#ifndef PROBE_REP_GATHER
#define PROBE_REP_GATHER 1
#endif
#ifndef PROBE_REP_MOEGU
#define PROBE_REP_MOEGU 1
#endif
#define LDP(k) ((const float*)ldk(kp, 8 * (k)))
#define OUTP ((float*)ldk(kp, 264))
#define WSP ((unsigned char*)ldk(kp, 272))
#define NOINL __device__ __attribute__((noinline))
#define WAVE_IDS() const int tid = threadIdx.x, lane = tid & 63, wave = __builtin_amdgcn_readfirstlane(tid >> 6), bid = (int)blockIdx.x, nblk = (int)gridDim.x, gw = bid * 8 + wave, ngw = nblk * 8; (void)lane; (void)gw; (void)ngw
NOINL void f_p0(unsigned long long kp_, LAS unsigned char* lds) {
    const unsigned long long kp = kp_uniform(kp_); WAVE_IDS(); LAS float* scr = (LAS float*)(lds + wave * 8448);
    {
        unsigned* ctl = (unsigned*)(WSP + WS_CTL);
#pragma unroll 1
        for (int te = wave; te < 24; te += 8) { const int t = te >> 3, e = te & 7;
            const float* wt = t == 0 ? LDP(30) : (t == 1 ? LDP(31) : LDP(32));
            const f32x4 v = ((const f32x4*)(wt + (size_t)e * ((size_t)D * FFE) + (size_t)(bid % 256) * 14336))[lane];
            const float m = wave_max(fmaxf(fmaxf(fabsf(v.x), fabsf(v.y)), fmaxf(fabsf(v.z), fabsf(v.w))));
            if (lane == 0) atomicMax(&ctl[CW_WMAX + te], __float_as_uint(m)); } }
    { unsigned char* ws = WSP;
      ph_init(LDP(0), LDP(1), OUTP, (float*)(ws + WS_HMETA), (float*)(ws + WS_ROPE), LDP(23), LDP(24), (bf16_t*)(ws + WS_V1T), (size_t)bid * 512 + tid, (size_t)nblk * 512); }
#pragma unroll 1
    for (int l = 0; l < 2; ++l) { unsigned char* lw = WSP + WS_WB + l * LW_STRIDE;
        { const TrJob J{LDP(5) + (size_t)l * D * 2624, nullptr, (bf16_t*)(lw + LW_WIN), D, 2624, 1024, 0, 1, 0}; ph_transpose(J, scr, gw, ngw, lane); }
        { const TrJob J{LDP(9) + (size_t)l * 512 * 768, LDP(7) + l * 512, (bf16_t*)(lw + LW_WUQ), 512, 768, 512, 0, 0, 0}; ph_transpose(J, scr, gw, ngw, lane); }
        { const TrJob J{LDP(10) + (size_t)l * 256 * 1024, LDP(8) + l * 256, (bf16_t*)(lw + LW_WK), 256, 1024, 256, 0, 4, 0}; ph_transpose(J, scr, gw, ngw, lane); }
        { const TrJob J{LDP(13) + (size_t)l * 64 * 512, nullptr, (bf16_t*)(lw + LW_LORA), 64, 512, 256, 0, 0, 0}; ph_transpose(J, scr, gw, ngw, lane); }
        { const TrJob J{LDP(15) + (size_t)l * 64 * 512, nullptr, (bf16_t*)(lw + LW_LORA), 64, 512, 256, 64, 0, 512}; ph_transpose(J, scr, gw, ngw, lane); }
        { const TrJob J{LDP(16) + (size_t)l * 128 * 512, nullptr, (bf16_t*)(lw + LW_LORA), 128, 512, 256, 128, 0, 1024}; ph_transpose(J, scr, gw, ngw, lane); }
        { const TrJob J{LDP(6) + (size_t)l * D * D, nullptr, (bf16_t*)(lw + LW_WOUT), D, D, 1024, 0, 0, 0}; ph_transpose(J, scr, gw, ngw, lane); }
    }
    { const TrJob J{LDP(25), nullptr, (bf16_t*)(WSP + WS_FGU), D, FF0, 1024, 0, 2, 0}; ph_transpose(J, scr, gw, ngw, lane); }
    { const TrJob J{LDP(26), nullptr, (bf16_t*)(WSP + WS_FGU), D, FF0, 1024, 0, 3, 0}; ph_transpose(J, scr, gw, ngw, lane); }
    { const TrJob J{LDP(27), nullptr, (bf16_t*)(WSP + WS_FDN), FF0, D, FF0, 0, 0, 0}; ph_transpose(J, scr, gw, ngw, lane); }
}
NOINL void f_rmsnorm(unsigned long long kp_, int which, int l) { const unsigned long long kp = kp_uniform(kp_); which = __builtin_amdgcn_readfirstlane(which); l = __builtin_amdgcn_readfirstlane(l); WAVE_IDS(); unsigned char* ws = WSP;
    const float* hsrc = (which == 0 && l == 0) ? LDP(0) : (const float*)OUTP;
    ph_rmsnorm(hsrc, (const float*)(ws + WS_HMETA), (which ? LDP(3) : LDP(2)) + l * D, (bf16_t*)(ws + A_U), (const float*)(ws + A_PART), which ? 4 : (l ? 11 : 0), gw, ngw, lane); }
NOINL void f_prep(unsigned long long kp_, int l) { const unsigned long long kp = kp_uniform(kp_); l = __builtin_amdgcn_readfirstlane(l); WAVE_IDS(); unsigned char* ws = WSP;
    ph_prep((const bf16_t*)(ws + A_PM), (const bf16_t*)(ws + A_PR), LDP(11) + l * 1792, (const float*)(ws + WS_ROPE), (float*)(ws + A_RSTDQ), (float*)(ws + A_RSTDKV),
            (bf16_t*)(ws + A_KROPE), (bf16_t*)(ws + A_LIN), (bf16_t*)(ws + A_VSH), l, gw, ngw, lane); }
constexpr int RW_NSEQ = 129;
constexpr size_t RW_BUF = (size_t)RW_NSEQ * 8 * CHK_BYTES;
static_assert(2 * RW_BUF <= A_VFIRST - A_CHK, "two chunk buffers fit the chunk region");
constexpr int RW_SKIP = 4;
__device__ __forceinline__ bool rw_is_scan_wg(int bid) { return (bid & 3) == 0; }
__device__ __forceinline__ int rw_rank(int bid) { return bid - (bid >> 2) - 1; }
__device__ __forceinline__ void f_rwkv_cp(unsigned long long kp_, LAS unsigned char* lds, int l, int q) {
    const unsigned long long kp = kp_uniform(kp_); l = __builtin_amdgcn_readfirstlane(l); q = __builtin_amdgcn_readfirstlane(q);
    const int bid = (int)blockIdx.x, nblk = (int)gridDim.x; unsigned char* ws = WSP;
    const CpP cp{(const bf16_t*)(ws + A_PR), (const bf16_t*)(ws + A_LOUT), (const bf16_t*)(ws + A_VMIX), (const bf16_t*)(ws + A_VFIRST), (bf16_t*)(ws + (l ? A_VP : A_VFIRST)), (float*)(ws + A_RK), ws + A_CHK + (size_t)(q & 1) * RW_BUF,
                 LDP(11) + l * 1792, LDP(12) + l * 512, LDP(14) + l * 512, LDP(17) + l * 512, LDP(18) + l * 512, LDP(19) + l * 512, LDP(22), l, 0};
    const int ntask = (q == 0 ? RW_NSEQ : RW_NSEQ - 1) * 8, hs = q == 0 ? 0 : RW_SKIP, NS = nblk - ((nblk + 3) >> 2);
    const bool scanwg = rw_is_scan_wg(bid); const int rank = rw_rank(bid);
#define RW_TASK(i_) (scanwg ? hs * NS + (i_) * nblk + bid : ((i_) < hs ? (i_) * NS + rank : hs * NS + ((i_) - hs) * nblk + bid))
#define RW_ROW0(t_) (((t_) >> 3) == 128 ? RREAL : ((t_) >> 7) * SEQ + (16 * q + (((t_) >> 3) & 15)) * 64)
    const int tid_ = opq(threadIdx.x), lane_ = tid_ & 63, w_ = __builtin_amdgcn_readfirstlane(tid_ >> 6);
    int task = RW_TASK(0); if (task >= ntask) return;
    CpRaw raw; cp_issue(cp, RW_ROW0(task), task & 7, w_, lane_, raw);
#pragma unroll 1
    for (int i = 0; ; ++i) { const int nxt = RW_TASK(i + 1); const bool has_next = nxt < ntask;
        rwkv_cp_task(lds, cp, RW_ROW0(task), task & 7, cp.CHK + (size_t)task * CHK_BYTES, raw, has_next, has_next ? RW_ROW0(nxt) : 0, nxt & 7);
        if (!has_next) break;
        task = nxt; }
#undef RW_TASK
#undef RW_ROW0
}
__device__ __forceinline__ void f_rwkv_scan(unsigned long long kp_, LAS unsigned char* lds, int l, int q) {
    const unsigned long long kp = kp_uniform(kp_); l = __builtin_amdgcn_readfirstlane(l); q = __builtin_amdgcn_readfirstlane(q);
    const int bid = (int)blockIdx.x, nblk = (int)gridDim.x; if (!rw_is_scan_wg(bid)) return;
    unsigned char* ws = WSP; const ScP sp{ws + A_CHK + (size_t)(q & 1) * RW_BUF, (bf16_t*)(ws + A_YS)};
#pragma unroll 1
    for (int unit = bid >> 2; unit < 64; unit += (nblk + 3) >> 2) { const int b = unit >> 3, hd = unit & 7; float* stp = (float*)(ws + A_SCST) + (size_t)unit * 4096;
        rwkv_scan_unit(lds, sp, b * 16, 128, q == 0 ? 1 : 0, 16, b * SEQ + q * 1024, hd, q == 0 && b == 0, q == 0 ? nullptr : stp, q == 3 ? nullptr : stp); }
}
NOINL void f_rwkv_post(unsigned long long kp_, int l, int q, int mode) {
    const unsigned long long kp = kp_uniform(kp_); l = __builtin_amdgcn_readfirstlane(l); q = __builtin_amdgcn_readfirstlane(q); mode = __builtin_amdgcn_readfirstlane(mode); WAVE_IDS(); unsigned char* ws = WSP;
    const PostP pp{(const bf16_t*)(ws + A_YS), (const bf16_t*)(ws + (l ? A_VP : A_VFIRST)), (const float*)(ws + A_RK), (const bf16_t*)(ws + A_LOUT), (bf16_t*)(ws + A_PM), LDP(20) + l * 512, LDP(21) + l * 512};
    const bool scanwg = rw_is_scan_wg(bid); const int nscan = (nblk + 3) >> 2, NS = nblk - nscan;
    if (mode == 2) rwkv_post(pp, q, 0, 8192, q == 0, gw, ngw, lane);
    else if (mode == 1) { if (!scanwg) rwkv_post(pp, q, 0, 8192, q == 0, rw_rank(bid) * 8 + wave, NS * 8, lane); }
    else if (scanwg) rwkv_post(pp, q, 0, 4096, false, (bid >> 2) * 8 + wave, nscan * 8, lane);
    else rwkv_post(pp, q, 4096, 8192, q == 0, rw_rank(bid) * 8 + wave, NS * 8, lane); }
NOINL void f_ffn_meta(unsigned long long kp_) {
    const unsigned long long kp = kp_uniform(kp_); WAVE_IDS(); unsigned char* ws = WSP;
    const int job = bid * 8 + wave; if (job >= FF0 / 16) return;
    const int f0 = job * 16, l15 = lane & 15, kq = lane >> 4;
    const bf16_t* wg = (const bf16_t*)(ws + WS_FGU) + (size_t)((f0 >> 7) * 256 + (f0 & 127) + l15) * 1024 + 8 * kq;
    const bf16_t* wu = wg + (size_t)128 * 1024;
    const bf16_t* xu = (const bf16_t*)(ws + A_U) + (size_t)(RREAL + l15) * D + 8 * kq;
    f32x4 ag = {0.f, 0.f, 0.f, 0.f}, au = {0.f, 0.f, 0.f, 0.f};
#pragma unroll 8
    for (int ks = 0; ks < 32; ++ks) { const bf16x8 a = *(const GAS bf16x8*)(wg + 32 * ks), b = *(const GAS bf16x8*)(wu + 32 * ks), x = *(const GAS bf16x8*)(xu + 32 * ks);
        ag = __builtin_amdgcn_mfma_f32_16x16x32_bf16(a, x, ag, 0, 0, 0); au = __builtin_amdgcn_mfma_f32_16x16x32_bf16(b, x, au, 0, 0, 0); }
    float r[4];
#pragma unroll
    for (int j = 0; j < 4; ++j) { const float g = ag[j], up = au[j]; r[j] = g / (1.0f + __expf(-g)) * up; }
    u32x2 o; o.x = cvtpk(r[0], r[1]); o.y = cvtpk(r[2], r[3]);
    *(GAS u32x2*)((bf16_t*)(ws + A_ACT0) + (size_t)(RREAL + l15) * FF0 + f0 + 4 * kq) = o;
}
NOINL void f_moe_tr(unsigned long long kp_, LAS unsigned char* lds) {
    const unsigned long long kp = kp_uniform(kp_); WAVE_IDS(); LAS float* scr = (LAS float*)(lds + wave * 8448);
    if (bid == 0 && tid < 24) { unsigned* ctlw = (unsigned*)(WSP + WS_CTL); const float sc = moe_wscale_bits(ctlw[CW_WMAX + tid]); ctlw[CW_WINV + tid] = __float_as_uint(1.0f / (F8_ACT * sc)); }
#pragma unroll 1
    for (int e = 0; e < NEXP * PROBE_REP_MOETR; ++e) { const int ee = e % NEXP;
        const unsigned* ctl = (const unsigned*)(WSP + WS_CTL);
        { const TrJob8 J{LDP(30) + (size_t)ee * D * FFE, WSP + A_MGU, D, FFE, 1024, 2, ee * 2 * FFE, moe_wscale(ctl, 0, ee)}; ph_transpose_f8(J, scr, gw, ngw, lane); }
        { const TrJob8 J{LDP(31) + (size_t)ee * D * FFE, WSP + A_MGU, D, FFE, 1024, 3, ee * 2 * FFE, moe_wscale(ctl, 1, ee)}; ph_transpose_f8(J, scr, gw, ngw, lane); }
        { const TrJob8 J{LDP(32) + (size_t)ee * FFE * D, WSP + A_MDN, FFE, D, FFE, 0, ee * D, moe_wscale(ctl, 2, ee)}; ph_transpose_f8(J, scr, gw, ngw, lane); }
    }
}
__device__ __forceinline__ void f_moe_route(unsigned long long kp_, LAS unsigned char* lds) {
    const unsigned long long kp = kp_uniform(kp_); WAVE_IDS(); unsigned char* ws = WSP;
    ph_norm_route(lds, OUTP, LDP(3) + D, LDP(28), LDP(29), (bf16_t*)(ws + A_U), (int*)(ws + A_MTAB + MT_E), (float*)(ws + A_MTAB + MT_G), (int*)(ws + A_MTAB + MT_STOK), (unsigned*)(ws + WS_CTL), bid, nblk, wave, lane); }
NOINL void f_moe_assign(unsigned long long kp_, LAS unsigned char* lds, int list) { const unsigned long long kp = kp_uniform(kp_); list = __builtin_amdgcn_readfirstlane(list); WAVE_IDS(); unsigned char* ws = WSP;
    ph_moe_assign(lds, list, (const int*)(ws + A_MTAB + MT_E), (const float*)(ws + A_MTAB + MT_G), (int*)(ws + A_MTAB + MT_STOK), (float*)(ws + A_MTAB + MT_SGATE), (int*)(ws + A_MTAB + MT_BE), (unsigned*)(ws + WS_CTL), ws + A_U, ws + A_XB, bid, nblk, tid); }
NOINL void f_final(unsigned long long kp_) { const unsigned long long kp = kp_uniform(kp_); WAVE_IDS(); unsigned char* ws = WSP; ph_final(OUTP, LDP(4), (const int*)(ws + A_MTAB + MT_TSLOT), (const float*)(ws + WS_TB), gw, ngw, lane); }

__global__ void __launch_bounds__(512, 2) fwd(Params P) {
    extern __shared__ __attribute__((aligned(16))) unsigned char lds_raw[];
    LAS unsigned char* lds = (LAS unsigned char*)lds_raw;
    const int tid = threadIdx.x;
    const int bid = (int)blockIdx.x, nblk = (int)gridDim.x;
    const unsigned long long kp = (unsigned long long)__builtin_amdgcn_kernarg_segment_ptr();
    volatile LAS unsigned* misc = (volatile LAS unsigned*)(lds + LDS_MISC);
    if (tid < 64) misc[tid] = 0u;
    __syncthreads();
    XcdBarrier bar;
    { unsigned* ctl0 = (unsigned*)(WSP + WS_CTL); bar = xcd_barrier_post(ctl0 + CW_BAR, misc + 8); }
#ifdef PROBE_BAR2
#define GRID_BAR() do { xcd_barrier(bar); xcd_barrier(bar); } while (0)
#else
#define GRID_BAR() xcd_barrier(bar)
#endif
    for (int rep_ = 0; rep_ < PROBE_REP_MISC; ++rep_) f_p0(kp, lds);
    GRID_BAR();

#pragma unroll 1
    for (int l = 0; l < 2; ++l) {
        for (int rep_ = 0; rep_ < PROBE_REP_NORM; ++rep_) f_rmsnorm(kp, 0, l);
        GRID_BAR();
_Pragma("unroll 1") for (int rep_ = 0; rep_ < PROBE_REP_INPROJ; ++rep_) {
        { unsigned char* ws = WSP; pg8::Gemm g{(const bf16_t*)(ws + A_U), (const bf16_t*)(ws + WS_WB + l * LW_STRIDE + LW_WIN), RP, 2816, 1024, 1024, 1024, 0}; pg8::StaticOrder S; S.init(RP, 2816, opqs(nblk), opqs(bid));
          EpiInProj E{(bf16_t*)(ws + A_PM), (bf16_t*)(ws + A_PR)};
          pg8::gemm_phase<EpiInProj, pg8::StaticOrder, true, true>(lds, g, S, E); }
}
        GRID_BAR();
        for (int rep_ = 0; rep_ < PROBE_REP_PREP; ++rep_) f_prep(kp, l);
        GRID_BAR();
_Pragma("unroll 1") for (int rep_ = 0; rep_ < PROBE_REP_P4A; ++rep_) {
        { unsigned char* ws = WSP; pg8::Gemm g{(const bf16_t*)(ws + A_PM), (const bf16_t*)(ws + WS_WB + l * LW_STRIDE + LW_WUQ), RP, 768, 512, 1024, 512, 0}; pg8::StaticOrder S; S.init(RP, 768, opqs(nblk), opqs(bid));
          EpiRowScale E{(bf16_t*)(ws + A_U), (const float*)(ws + A_RSTDQ), 768, 0};
          pg8::gemm_phase<EpiRowScale, pg8::StaticOrder, true, true>(lds, g, S, E); }
        { unsigned char* ws = WSP; pg8::Gemm g{(const bf16_t*)(ws + A_PM) + 512, (const bf16_t*)(ws + WS_WB + l * LW_STRIDE + LW_WK), RP, 512, 256, 1024, 256, 0}; pg8::StaticOrder S; S.init(RP, 512, opqs(nblk), opqs((bid + nblk - 131) % nblk));
          EpiRowScale E{(bf16_t*)(ws + A_KN), (const float*)(ws + A_RSTDKV), 512, 0};
          pg8::gemm_phase<EpiRowScale, pg8::StaticOrder, true, true>(lds, g, S, E); }
        { unsigned char* ws = WSP; pg8::Gemm g{(const bf16_t*)(ws + WS_WB + l * LW_STRIDE + LW_WV), (const bf16_t*)(ws + A_PM) + 512, 512, RP, 256, 256, 1024, 0}; pg8::StaticOrder S; S.init(512, RP, opqs(nblk), opqs((bid + nblk - 133) % nblk));
          EpiColScale E{(bf16_t*)(ws + A_VT), (const float*)(ws + A_RSTDKV), RP, 0};
          pg8::gemm_phase<EpiColScale, pg8::StaticOrder, true, true>(lds, g, S, E); }
}
        GRID_BAR();
_Pragma("unroll 1") for (int rep_ = 0; rep_ < PROBE_REP_ATT; ++rep_) {
        { unsigned char* ws = WSP; attn_phase(lds, (const bf16_t*)(ws + A_U), (const bf16_t*)(ws + A_KN), (const bf16_t*)(ws + A_KROPE), (const bf16_t*)(ws + A_VT), (bf16_t*)(ws + A_PM), (const float*)(ws + WS_ROPE), opqs(bid), opqs(nblk)); }
}
        GRID_BAR();
_Pragma("unroll 1") for (int rep_ = 0; rep_ < PROBE_REP_P4B; ++rep_) {
        { unsigned char* ws = WSP; pg8::Gemm g{(const bf16_t*)(ws + A_LIN), (const bf16_t*)(ws + WS_WB + l * LW_STRIDE + LW_LORA), RP, 1536, 256, 256, 256, 0}; pg8::StaticOrder S; S.init(RP, 1536, opqs(nblk), opqs(bid));
          EpiRowScale E{(bf16_t*)(ws + A_LOUT), nullptr, 1536, 0};
          pg8::gemm_phase<EpiRowScale, pg8::StaticOrder, true, true>(lds, g, S, E); }
        if (l == 1) {
            unsigned char* ws = WSP; pg8::Gemm g{(const bf16_t*)(ws + A_VSH), (const bf16_t*)(ws + WS_V1T), RP, 512, 512, 512, 512, 0}; pg8::StaticOrder S; S.init(RP, 512, opqs(nblk), opqs((bid + nblk - 6) % nblk));
            EpiRowScale E{(bf16_t*)(ws + A_VMIX), nullptr, 512, 0};
            pg8::gemm_phase<EpiRowScale, pg8::StaticOrder, true, true>(lds, g, S, E);
        }
}
        GRID_BAR();
#pragma unroll 1
        for (int stp = 0; stp < 6; ++stp) {
            if (stp >= 1 && stp <= 4) { _Pragma("unroll 1") for (int rep_ = 0; rep_ < PROBE_REP_SCAN; ++rep_) f_rwkv_scan(kp, lds, l, stp - 1); }
            if (stp <= 3) { _Pragma("unroll 1") for (int rep_ = 0; rep_ < PROBE_REP_CP; ++rep_) f_rwkv_cp(kp, lds, l, stp); }
            if (stp >= 2) { for (int rep_ = 0; rep_ < PROBE_REP_MISC; ++rep_) f_rwkv_post(kp, l, stp - 2, stp <= 3 ? 0 : stp - 3); }
            GRID_BAR();
        }
_Pragma("unroll 1") for (int rep_ = 0; rep_ < PROBE_REP_OUTPROJ; ++rep_) {
        { unsigned char* ws = WSP; pg8::Gemm g{(const bf16_t*)(ws + A_PM), (const bf16_t*)(ws + WS_WB + l * LW_STRIDE + LW_WOUT), RREAL, 1024, 1024, 1024, 1024, 0}; pg8::StaticOrder S; S.init(RREAL, 1024, opqs(nblk), opqs(bid));
          EpiResid E{OUTP, (float*)(ws + WS_HMETA), (l == 0 && rep_ == 0) ? LDP(0) : (const float*)OUTP, rep_ == 0 ? 1.0f : 0.0f, 0};
          pg8::gemm_phase<EpiResid, pg8::StaticOrder, true, true>(lds, g, S, E); }
        if (rep_ == 0 && l == 0) {
          unsigned char* ws = WSP; pg8::Gemm g{(const bf16_t*)(ws + A_PM), (const bf16_t*)(ws + WS_WB + l * LW_STRIDE + LW_WOUT), RP, 1024, 256, 1024, 1024, 0};
          const DenseTailOrder S{4, 4, opqs(nblk), opqs(bid)}; EpiResidPartial E{(float*)(ws + A_PART)};
          pg8::gemm_phase<EpiResidPartial, DenseTailOrder, true, true>(lds, g, S, E); }
}
        GRID_BAR();
        if (l == 0) {
            for (int rep_ = 0; rep_ < PROBE_REP_MISC; ++rep_) f_rmsnorm(kp, 1, 0);
            GRID_BAR();
_Pragma("unroll 1") for (int rep_ = 0; rep_ < PROBE_REP_FFNGU; ++rep_) {
            f_ffn_meta(kp);
            { unsigned char* ws = WSP; pg8::Gemm g{(const bf16_t*)(ws + A_U), (const bf16_t*)(ws + WS_FGU), RREAL, 2 * FF0, 1024, 1024, 1024, 0}; pg8::StaticOrder S; S.init(RREAL, 2 * FF0, opqs(nblk), opqs(bid));
              EpiSwiGLU E{(bf16_t*)(ws + A_ACT0), FF0, 22, 0, 0};
              pg8::gemm_phase<EpiSwiGLU, pg8::StaticOrder, true, true>(lds, g, S, E); }
}
            GRID_BAR();
_Pragma("unroll 1") for (int rep_ = 0; rep_ < PROBE_REP_FFNDN; ++rep_) {
            { unsigned char* ws = WSP; pg8::Gemm g{(const bf16_t*)(ws + A_ACT0), (const bf16_t*)(ws + WS_FDN), RREAL, 1024, FF0, FF0, FF0, 0}; pg8::StaticOrder S; S.init(RREAL, 1024, opqs(nblk), opqs(bid));
              EpiResid E{OUTP, (float*)(ws + WS_HMETA), (const float*)OUTP, rep_ == 0 ? 1.0f : 0.0f, 0};
              pg8::gemm_phase<EpiResid, pg8::StaticOrder, true, true>(lds, g, S, E); }
            if (rep_ == 0) {
              unsigned char* ws = WSP; pg8::Gemm g{(const bf16_t*)(ws + A_ACT0), (const bf16_t*)(ws + WS_FDN), RP, 1024, 256, FF0, FF0, 0};
              const DenseTailOrder S{4, 11, opqs(nblk), opqs(bid)}; EpiResidPartial E{(float*)(ws + A_PART)};
              pg8::gemm_phase<EpiResidPartial, DenseTailOrder, true, true>(lds, g, S, E); }
}
            GRID_BAR();
        } else {
            f_moe_tr(kp, lds);
            f_moe_route(kp, lds);
            GRID_BAR();
            f_moe_assign(kp, lds, 0);
            f_moe_assign(kp, lds, 1);
            GRID_BAR();
#pragma unroll 1
            for (int list = 0; list < 2; ++list) {
                const int np0 = __builtin_amdgcn_readfirstlane((int)((const unsigned*)(WSP + WS_CTL))[CW_NPAN]), np1 = __builtin_amdgcn_readfirstlane((int)((const unsigned*)(WSP + WS_CTL))[CW_NPAN + 1]);
                const int T0 = np0 > MOE_TAILPAN ? (np0 - MOE_TAILPAN) * 4 : 0, T1 = np1 > MOE_TAILPAN ? (np1 - MOE_TAILPAN) * 4 : 0;
                if (list == 1) {
                    { unsigned char* ws = WSP; pg8::Gemm g{(const bf16_t*)(ws + A_MACT), (const bf16_t*)(ws + A_MDN), 0, 0, FFE / 2, FFE / 2, FFE / 2, 0};
                      const MoeShiftTailOrder S{(const int*)(ws + A_MTAB + MT_BE), (const unsigned*)(ws + WS_CTL) + CW_NPAN, 4, 4, 0, opqs(nblk) - 1, opqs(bid), 0};
                      EpiMoeDown E{OUTP, (const int*)(ws + A_MTAB + MT_STOK), (const float*)(ws + A_MTAB + MT_SGATE), 4, 1.0f, (const unsigned*)(ws + WS_CTL)};
                      pg8::gemm_phase<EpiMoeDown, MoeShiftTailOrder, true, true, true>(lds, g, S, E); }
                    { unsigned char* ws = WSP; pg8::Gemm g{(const bf16_t*)(ws + A_MACT), (const bf16_t*)(ws + A_MDN), 0, 0, FFE / 2, FFE / 2, FFE / 2, 0};
                      const MoeShiftTailOrder S{(const int*)(ws + A_MTAB + MT_BE) + 256, (const unsigned*)(ws + WS_CTL) + CW_NPAN + 1, 4, 4, MOE_GAP, opqs(nblk) - 1 - T0, opqs(bid), 0};
                      EpiMoeDownStore E{(float*)(ws + WS_TB), (const int*)(ws + A_MTAB + MT_STOK) + MOE_MAXPAN * 256, (const float*)(ws + A_MTAB + MT_SGATE) + MOE_MAXPAN * 256, 4, MOE_TAILPAN + MOE_GAP, (const unsigned*)(ws + WS_CTL)};
                      pg8::gemm_phase<EpiMoeDownStore, MoeShiftTailOrder, true, true, true>(lds, g, S, E); }
                }
_Pragma("unroll 1") for (int rep_ = 0; rep_ < PROBE_REP_MOEGU; ++rep_) {
                { unsigned char* ws = WSP; pg8::Gemm g{(const bf16_t*)(ws + A_XB + (size_t)list * XB_LIST), (const bf16_t*)(ws + A_MGU), 0, 0, 512, 512, 512, 0};
                  const int Tt = list == 1 && T0 + T1 < opqs(nblk) ? T0 + T1 : 0;
                  const MoeSlotOrder S{(const int*)(ws + A_MTAB + MT_BE) + 256 * list, (const unsigned*)(ws + WS_CTL) + CW_NPAN + list, (const int*)(ws + A_MTAB + MT_STOK) + list * MOE_MAXPAN * 256, 28, 28, 0, opqs(nblk), opqs(bid), RREAL,
                                         0, list == 0 ? MOE_MAXPAN : MOE_TAILPAN, 0, 0, Tt, MOE_CSKIP};
                  EpiSwiGLU8 E{ws + A_MACT, (const unsigned*)(ws + WS_CTL), FFE, 28};
                  pg8::gemm_phase<EpiSwiGLU8, MoeSlotOrder, true, true, true>(lds, g, S, E); }
                if (list == 0) {
                  unsigned char* ws = WSP; pg8::Gemm g{(const bf16_t*)(ws + A_XB + XB_LIST), (const bf16_t*)(ws + A_MGU), 0, 0, 512, 512, 512, 0};
                  const int nb = opqs(nblk);
                  const MoeSlotOrder S{(const int*)(ws + A_MTAB + MT_BE) + 256, (const unsigned*)(ws + WS_CTL) + CW_NPAN + 1, (const int*)(ws + A_MTAB + MT_STOK) + MOE_MAXPAN * 256, 28, 28, 0, nb, opqs(bid), RREAL,
                                         MOE_TAILPAN, MOE_MAXPAN, MOE_GAP, (np0 * 28) % nb, 0, 0};
                  EpiSwiGLU8 E{ws + A_MACT, (const unsigned*)(ws + WS_CTL), FFE, 28};
                  pg8::gemm_phase<EpiSwiGLU8, MoeSlotOrder, true, true, true>(lds, g, S, E); }
}
                GRID_BAR();
_Pragma("unroll 1") for (int rep_ = 0; rep_ < PROBE_REP_MOEDN; ++rep_) {
                { unsigned char* ws = WSP; pg8::Gemm g{(const bf16_t*)(ws + A_MACT), (const bf16_t*)(ws + A_MDN), 0, 0, FFE / 2, FFE / 2, FFE / 2, 0};
                  const MoeOrder S{(const int*)(ws + A_MTAB + MT_BE) + 256 * list, (const unsigned*)(ws + WS_CTL) + CW_NPAN + list, 4, 4, 0, opqs(nblk), opqs(bid), MOE_TAILPAN * 4};
                  EpiMoeDown E{OUTP, (const int*)(ws + A_MTAB + MT_STOK) + list * MOE_MAXPAN * 256, (const float*)(ws + A_MTAB + MT_SGATE) + list * MOE_MAXPAN * 256, 4, rep_ == 0 ? 1.0f : 0.0f, (const unsigned*)(ws + WS_CTL)};
                  pg8::gemm_phase<EpiMoeDown, MoeOrder, true, true, true>(lds, g, S, E); }
}
                GRID_BAR();
            }
        }
    }
    f_final(kp);
}

extern "C" void kernel_launch(void* const* d_in, const int* in_sizes, int n_in, void* d_out, int out_size, void* d_ws, size_t ws_size, hipStream_t stream) {
    static int grid = 0;
    if (grid == 0) {
        if (n_in != 33 || ws_size < WS_NEED || out_size != RREAL * D) { fprintf(stderr, "kernel_launch: unexpected arguments (n_in %d, ws %zu need %zu, out %d)\n", n_in, ws_size, (size_t)WS_NEED, out_size); grid = -1; return; }
        int dev = 0, cus = 0;
        if (hipGetDevice(&dev) != hipSuccess || hipDeviceGetAttribute(&cus, hipDeviceAttributeMultiprocessorCount, dev) != hipSuccess) { grid = -1; return; }
        if (hipFuncSetAttribute((const void*)fwd, hipFuncAttributeMaxDynamicSharedMemorySize, LDS_BYTES) != hipSuccess) { fprintf(stderr, "kernel_launch: hipFuncSetAttribute failed\n"); grid = -1; return; }
        int per_cu = 0; (void)hipOccupancyMaxActiveBlocksPerMultiprocessor(&per_cu, (const void*)fwd, 512, LDS_BYTES); (void)hipGetLastError();
        grid = cus;
    }
    if (grid < 0) return;
    unsigned char* ws = (unsigned char*)d_ws;
    (void)hipMemsetAsync(ws + WS_CTL, 0, 1 * MiB, stream);
    (void)hipMemsetAsync(ws + WS_WB, 0, WS_ROPE - WS_WB, stream);
    Params p{};
    for (int i = 0; i < 33; ++i) p.in[i] = (const float*)d_in[i];
    p.out = (float*)d_out; p.ws = ws;
    hipLaunchKernelGGL(fwd, dim3(grid), dim3(512), LDS_BYTES, stream, p);
}
```

```cpp
#include <hip/hip_runtime.h>
#include <cstdio>
#include <cstdint>
namespace pg8 {
#define PG8_LAS __attribute__((address_space(3)))
typedef unsigned short bf16_t;
typedef short bf16x8 __attribute__((ext_vector_type(8)));
typedef float f32x4 __attribute__((ext_vector_type(4)));
typedef unsigned u32x4 __attribute__((ext_vector_type(4)));
constexpr int BM = 256, BK = 64, HALF = 128, HTB = HALF * BK * 2  , STAGE_BYTES = 8 * HTB, NXCD = 8, WGM = 8;

__host__ __device__ __forceinline__ int lds_byte(int r, int c) { const int st = (r >> 4) * 2 + (c >> 5), rr = r & 15, cc = c & 31, ob = rr * 64 + cc * 2; return st * 1024 + (ob ^ (((ob >> 9) & 1) << 5)); }
__host__ __device__ __forceinline__ void stage_rc(int b, int& R, int& C) { const int st = b / 1024, sb = b % 1024, swz = sb ^ (((sb >> 9) & 1) << 5); R = (st >> 1) * 16 + swz / 64; C = (st & 1) * 32 + (swz % 64) / 2; }
__host__ __device__ __forceinline__ int perm32(int rho) { const int n = rho >> 4, i = rho & 15; return 8 * (i >> 2) + 4 * n + (i & 3); }

struct Unit { int pm, pn, k0; };
struct Gemm { const bf16_t* A; const bf16_t* Bt; int M, N, K, lda, ldb, pad; };

struct StaticOrder {
    static constexpr bool GATHER = false;
    int nM, nN, nwg, G, c;
    __host__ __device__ void init(int M, int N, int G_, int c_) { nM = M / BM; nN = N / BM; nwg = nM * nN; G = G_; c = c_; }
    __host__ __device__ bool next(int i, Unit& u) const {
        const long L = (long)i * G + c; if (L >= nwg) return false;
        int wgid = (int)L; { const int q = nwg / NXCD, r = nwg % NXCD, xcd = wgid % NXCD, off = wgid / NXCD; wgid = (xcd < r ? xcd * (q + 1) : r * (q + 1) + (xcd - r) * q) + off; }
        const int nig = WGM * nN, gid = wgid / nig, fm = gid * WGM, gsz = (nM - fm) < WGM ? (nM - fm) : WGM;
        u.pm = fm + ((wgid % nig) % gsz); u.pn = (wgid % nig) / gsz; u.k0 = 0; return true;
    }
    __device__ __forceinline__ void a_ready(const Unit&) const {}
    __device__ __forceinline__ void done(const Unit&) const {}
};

__device__ __forceinline__ unsigned cvt_pk_bf16(float lo, float hi) { unsigned r; asm volatile("v_cvt_pk_bf16_f32 %0, %1, %2" : "=v"(r) : "v"(lo), "v"(hi)); return r; }
typedef int i32x4_ __attribute__((ext_vector_type(4)));
typedef int i32x8_ __attribute__((ext_vector_type(8)));
template <class Epi, class Sched, bool ALIGN_EPI = false, bool SP2 = false, bool FP8 = false>
__device__ __forceinline__ void gemm_phase(PG8_LAS unsigned char* lds, const Gemm g, const Sched& S, const Epi& E) {
    int tid_ = threadIdx.x; asm volatile("" : "+v"(tid_)); const int tid = tid_, wid = __builtin_amdgcn_readfirstlane(tid >> 6), lane = tid & 63, wr = wid >> 2, wc = wid & 3, fr = lane & 15, fq = lane >> 4;
    const int K = g.K, nt = K / BK;
    unsigned voffA[2], voffB[2];
#pragma unroll
    for (int i = 0; i < 2; ++i) { int R, C; stage_rc(tid * 16 + i * 8192, R, C); const int Rb = Epi::PERM ? ((R & ~31) + perm32(R & 31)) : R;
        voffA[i] = (unsigned)(R * g.lda + C) * 2u; voffB[i] = (unsigned)(Rb * g.ldb + C) * 2u; }
    constexpr bool GATHER = Sched::GATHER;
    unsigned vAc[2][2] = {{0u, 0u}, {0u, 0u}}, vAn[2][2] = {{0u, 0u}, {0u, 0u}}, cbA[2] = {0u, 0u};
    if constexpr (GATHER) {
#pragma unroll
        for (int i = 0; i < 2; ++i) { int R, C; stage_rc(tid * 16 + i * 8192, R, C); cbA[i] = (unsigned)C * 2u; }
    }
#define PG8_IDX_DMA(un, slot) do { if constexpr (GATHER) { const int* rp_ = S.rows + (size_t)(un).pm * 256 + 128 * (lane >> 5) + 64 * ((lane >> 4) & 1) + 16 * (wid >> 1) + (lane & 15); \
        __builtin_amdgcn_global_load_lds((const unsigned*)rp_, (PG8_LAS unsigned*)(lds + STAGE_BYTES + wid * 512 + (slot) * 256), 4, 0, 0); } } while (0)
#define PG8_IDX_READ(dst, slot) do { if constexpr (GATHER) { int t3_ = threadIdx.x; asm volatile("" : "+v"(t3_));     \
        _Pragma("unroll") for (int h_ = 0; h_ < 2; ++h_) _Pragma("unroll") for (int i_ = 0; i_ < 2; ++i_) { int R_, C_; stage_rc(t3_ * 16 + i_ * 8192, R_, C_); \
        int tk_ = *(const PG8_LAS int*)(lds + STAGE_BYTES + (t3_ >> 6) * 512 + (slot) * 256 + 4 * (32 * h_ + 16 * i_ + ((t3_ & 63) >> 2))); tk_ = tk_ < 0 ? S.zero_row : tk_; \
        dst[h_][i_] = (unsigned)tk_ * (unsigned)(g.lda * 2) + (unsigned)C_ * 2u; } } } while (0)
#define PG8_STAGE_A(bufoff, base, h, nx) do { if constexpr (GATHER) { const unsigned vs_[2] = {(nx) ? vAn[h][0] : vAc[h][0], (nx) ? vAn[h][1] : vAc[h][1]}; PG8_STAGE(bufoff, base, vs_); } \
        else { PG8_STAGE(bufoff, (base) + (h) * hstepA, voffA); } } while (0)
    const size_t kstep = (size_t)(BK * 2);
    const size_t hstepA = (size_t)HALF * g.lda * 2, hstepB = (size_t)HALF * g.ldb * 2;
    const size_t tstepA = 2 * hstepA, tstepB = 2 * hstepB;
    const unsigned ldsw = (unsigned)wid * 1024u;
    const int aoff = lds_byte(wr * 64 + fr, fq * 8), boff = lds_byte(wc * 32 + fr, fq * 8);
#define PG8_SA(b, h) (((b) * 2 + (h)) * HTB)
#define PG8_SB(b, h) ((4 + (b) * 2 + (h)) * HTB)
#define PG8_STAGE(bufoff, gbase, voff) do { const char* gb_ = (const char*)(gbase); asm volatile("" : "+s"(gb_));   \
        _Pragma("unroll") for (int _i = 0; _i < 2; ++_i) \
        __builtin_amdgcn_global_load_lds((const unsigned*)(gb_ + (voff)[_i]), (PG8_LAS unsigned*)(lds + (bufoff) + ldsw + _i * 8192), 16, 0, 0); } while (0)
#define PG8_LDA(dst, b, h) do { _Pragma("unroll") for (int m = 0; m < 4; ++m) _Pragma("unroll") for (int k = 0; k < 2; ++k) dst[m][k] = *(const PG8_LAS bf16x8*)(lds + PG8_SA(b, h) + aoff + m * 2048 + k * 1024); } while (0)
#define PG8_LDB(dst, b, h) do { _Pragma("unroll") for (int n = 0; n < 2; ++n) _Pragma("unroll") for (int k = 0; k < 2; ++k) dst[n][k] = *(const PG8_LAS bf16x8*)(lds + PG8_SB(b, h) + boff + n * 2048 + k * 1024); } while (0)
#define PG8_MMA(ai, bj, At, Bt) do { __builtin_amdgcn_s_setprio(1); _Pragma("unroll") for (int m = 0; m < 4; ++m) _Pragma("unroll") for (int n = 0; n < 2; ++n) { \
        if constexpr (FP8) { const i32x8_ b8_ = __builtin_shufflevector(__builtin_bit_cast(i32x4_, Bt[n][0]), __builtin_bit_cast(i32x4_, Bt[n][1]), 0, 1, 2, 3, 4, 5, 6, 7); \
            const i32x8_ a8_ = __builtin_shufflevector(__builtin_bit_cast(i32x4_, At[m][0]), __builtin_bit_cast(i32x4_, At[m][1]), 0, 1, 2, 3, 4, 5, 6, 7); \
            acc[ai][bj][m][n] = __builtin_amdgcn_mfma_scale_f32_16x16x128_f8f6f4(b8_, a8_, acc[ai][bj][m][n], 0, 0, 0, 0, 0, 0); }     \
        else { _Pragma("unroll") for (int k = 0; k < 2; ++k) acc[ai][bj][m][n] = __builtin_amdgcn_mfma_f32_16x16x32_bf16(Bt[n][k], At[m][k], acc[ai][bj][m][n], 0, 0, 0); } } \
        __builtin_amdgcn_s_setprio(0); } while (0)
#define PG8_WAIT_V(n) asm volatile("s_waitcnt vmcnt(" #n ")" ::: "memory")
#define PG8_WAIT_L(n) asm volatile("s_waitcnt lgkmcnt(" #n ")" ::: "memory")
#define PG8_BAR __builtin_amdgcn_s_barrier()
#define PG8_SCHED __builtin_amdgcn_sched_barrier(0)
    Unit cur, nxt; int ui = 0;
    if (!S.next(0, cur)) return;
    float zf_ = 0.f; asm volatile("" : "+v"(zf_));
    f32x4 acc[2][2][4][2];
#pragma unroll
    for (int a = 0; a < 2; ++a)
#pragma unroll
        for (int b = 0; b < 2; ++b)
#pragma unroll
            for (int m = 0; m < 4; ++m)
#pragma unroll
                for (int n = 0; n < 2; ++n) acc[a][b][m][n] = (f32x4){zf_, zf_, zf_, zf_};
    bf16x8 At[4][2], B0[2][2], B1[2][2];
    const char* cA = (const char*)g.A + (GATHER ? (size_t)0 : (size_t)cur.pm * tstepA) + (size_t)cur.k0 * 2; const char* cB = (const char*)g.Bt + (size_t)cur.pn * tstepB + (size_t)cur.k0 * 2;
    S.a_ready(cur);
    if constexpr (GATHER) { PG8_IDX_DMA(cur, 0); asm volatile("s_waitcnt vmcnt(0)" ::: "memory"); PG8_IDX_READ(vAc, 0); }
    if constexpr (SP2) {
        PG8_STAGE(PG8_SB(0, 0), cB, voffB); PG8_STAGE(PG8_SB(0, 1), cB + hstepB, voffB); PG8_STAGE_A(PG8_SA(0, 0), cA, 0, false); PG8_STAGE_A(PG8_SA(0, 1), cA, 1, false);
        if (wr == 1) PG8_BAR;
        PG8_WAIT_V(2); PG8_BAR;
        PG8_STAGE(PG8_SB(1, 0), cB + kstep, voffB); PG8_STAGE_A(PG8_SA(1, 0), cA + kstep, 0, false); PG8_STAGE(PG8_SB(1, 1), cB + hstepB + kstep, voffB);
        PG8_WAIT_V(6); PG8_BAR;
    } else {
        PG8_STAGE(PG8_SB(0, 0), cB, voffB); PG8_STAGE(PG8_SA(0, 0), cA, voffA); PG8_STAGE(PG8_SB(0, 1), cB + hstepB, voffB); PG8_STAGE(PG8_SA(0, 1), cA + hstepA, voffA);
        if (wr == 1) PG8_BAR;
        PG8_WAIT_V(4); PG8_BAR;
        PG8_STAGE(PG8_SB(1, 0), cB + kstep, voffB); PG8_STAGE(PG8_SA(1, 0), cA + kstep, voffA); PG8_STAGE(PG8_SB(1, 1), cB + hstepB + kstep, voffB);
        PG8_WAIT_V(6); PG8_BAR;
    }
    for (;;) {
        const bool has_next = S.next(ui + 1, nxt);
        const char* nA = has_next ? (const char*)g.A + (GATHER ? (size_t)0 : (size_t)nxt.pm * tstepA) + (size_t)nxt.k0 * 2 : cA; const char* nB = has_next ? (const char*)g.Bt + (size_t)nxt.pn * tstepB + (size_t)nxt.k0 * 2 : cB;
        if constexpr (GATHER) { if (has_next) PG8_IDX_DMA(nxt, (ui + 1) & 1); }
        for (int t = 0; t < nt; t += 2) {
            const bool last = (t == nt - 2); const bool lnx = last && has_next;
            const char* a1 = cA + (size_t)(t + 1) * kstep;
            const char* a2 = last ? nA : cA + (size_t)(t + 2) * kstep; const char* b2 = last ? nB : cB + (size_t)(t + 2) * kstep;
            const char* a3 = a2 + kstep; const char* b3 = b2 + kstep;
            if (last && has_next) S.a_ready(nxt);
            if constexpr (GATHER) { if (lnx) PG8_IDX_READ(vAn, (ui + 1) & 1); }
            if constexpr (SP2) {
            PG8_LDB(B0, 0, 0); PG8_LDB(B1, 0, 1); PG8_SCHED; PG8_LDA(At, 0, 0); PG8_STAGE_A(PG8_SA(1, 1), a1, 1, false);
            PG8_WAIT_V(8); PG8_WAIT_L(0); PG8_BAR; PG8_MMA(0, 0, At, B0); PG8_MMA(0, 1, At, B1); PG8_BAR; PG8_SCHED;
            PG8_LDA(At, 0, 1); PG8_STAGE(PG8_SB(0, 0), b2, voffB); PG8_STAGE(PG8_SB(0, 1), b2 + hstepB, voffB); PG8_STAGE_A(PG8_SA(0, 0), a2, 0, lnx);
            PG8_WAIT_V(8); PG8_WAIT_L(0); PG8_BAR; PG8_MMA(1, 0, At, B0); PG8_MMA(1, 1, At, B1); PG8_BAR; PG8_SCHED;
            PG8_LDB(B0, 1, 0); PG8_LDB(B1, 1, 1); PG8_SCHED; PG8_LDA(At, 1, 0); PG8_STAGE_A(PG8_SA(0, 1), a2, 1, lnx);
            PG8_WAIT_V(8); PG8_WAIT_L(0); PG8_BAR; PG8_MMA(0, 0, At, B0); PG8_MMA(0, 1, At, B1); PG8_BAR; PG8_SCHED;
            PG8_LDA(At, 1, 1); PG8_STAGE(PG8_SB(1, 0), b3, voffB); PG8_STAGE(PG8_SB(1, 1), b3 + hstepB, voffB); PG8_STAGE_A(PG8_SA(1, 0), a3, 0, lnx);
            PG8_WAIT_V(8); PG8_WAIT_L(0); PG8_BAR; PG8_MMA(1, 0, At, B0); PG8_MMA(1, 1, At, B1); PG8_BAR; PG8_SCHED;
            } else {
            PG8_LDB(B0, 0, 0); PG8_SCHED; PG8_LDA(At, 0, 0); PG8_STAGE(PG8_SA(1, 1), a1 + hstepA, voffA);
            PG8_WAIT_L(8); PG8_BAR; PG8_WAIT_L(0); PG8_MMA(0, 0, At, B0); PG8_BAR; PG8_SCHED;
            PG8_LDB(B1, 0, 1); PG8_STAGE(PG8_SB(0, 0), b2, voffB);
            PG8_BAR; PG8_WAIT_L(0); PG8_MMA(0, 1, At, B1); PG8_BAR;
            PG8_LDA(At, 0, 1); PG8_STAGE(PG8_SA(0, 0), a2, voffA);
            PG8_BAR; PG8_WAIT_L(0); PG8_MMA(1, 0, At, B0); PG8_BAR; PG8_SCHED;
            PG8_STAGE(PG8_SB(0, 1), b2 + hstepB, voffB);
            PG8_WAIT_V(6); PG8_BAR; PG8_MMA(1, 1, At, B1); PG8_BAR;
            PG8_LDB(B0, 1, 0); PG8_SCHED; PG8_LDA(At, 1, 0); PG8_STAGE(PG8_SA(0, 1), a2 + hstepA, voffA);
            PG8_WAIT_L(8); PG8_BAR; PG8_WAIT_L(0); PG8_MMA(0, 0, At, B0); PG8_BAR; PG8_SCHED;
            PG8_LDB(B1, 1, 1); PG8_STAGE(PG8_SB(1, 0), b3, voffB);
            PG8_BAR; PG8_WAIT_L(0); PG8_MMA(0, 1, At, B1); PG8_BAR;
            PG8_LDA(At, 1, 1); PG8_STAGE(PG8_SA(1, 0), a3, voffA);
            PG8_BAR; PG8_WAIT_L(0); PG8_MMA(1, 0, At, B0); PG8_BAR; PG8_SCHED;
            PG8_STAGE(PG8_SB(1, 1), b3 + hstepB, voffB);
            PG8_WAIT_V(6); PG8_BAR; PG8_MMA(1, 1, At, B1); PG8_BAR;
            }
        }
        if constexpr (ALIGN_EPI) { if (wr == 0) PG8_BAR; }
        if constexpr (!Epi::AFTER_DRAIN) { int t2_ = threadIdx.x; asm volatile("" : "+v"(t2_)); const int fr2_ = t2_ & 15, fq2_ = (t2_ >> 4) & 3;
            E(acc, cur, wr, wc, fr2_, fq2_); S.done(cur); }
        if (!has_next) break;
#pragma unroll
        for (int a = 0; a < 2; ++a)
#pragma unroll
            for (int b = 0; b < 2; ++b)
#pragma unroll
                for (int m = 0; m < 4; ++m)
#pragma unroll
                    for (int n = 0; n < 2; ++n) acc[a][b][m][n] = (f32x4){zf_, zf_, zf_, zf_};
        cur = nxt; cA = nA; cB = nB; ++ui;
        if constexpr (GATHER) { vAc[0][0] = vAn[0][0]; vAc[0][1] = vAn[0][1]; vAc[1][0] = vAn[1][0]; vAc[1][1] = vAn[1][1]; }
        if constexpr (ALIGN_EPI) { if (wr == 1) PG8_BAR; }
    }
    PG8_WAIT_V(0);
    if constexpr (!ALIGN_EPI) { if (wr == 0) PG8_BAR; }
    PG8_BAR;
    if constexpr (Epi::AFTER_DRAIN) { E.fused(acc, cur, wr, wc, fr, fq, lds, wid, lane); S.done(cur); }
#undef PG8_SA
#undef PG8_SB
#undef PG8_STAGE
#undef PG8_STAGE_A
#undef PG8_IDX_DMA
#undef PG8_IDX_READ
#undef PG8_LDA
#undef PG8_LDB
#undef PG8_MMA
#undef PG8_WAIT_V
#undef PG8_WAIT_L
#undef PG8_BAR
#undef PG8_SCHED
}
}

typedef unsigned short bf16_t;
typedef short bf16x8 __attribute__((ext_vector_type(8)));
typedef short s16x4 __attribute__((ext_vector_type(4)));
typedef float f32x4 __attribute__((ext_vector_type(4)));
typedef float f32x16 __attribute__((ext_vector_type(16)));
typedef unsigned u32x4 __attribute__((ext_vector_type(4)));
typedef unsigned u32x2 __attribute__((ext_vector_type(2)));
#define LAS __attribute__((address_space(3)))
#define GAS __attribute__((address_space(1)))

constexpr int D = 1024, NB = 8, SEQ = 4096, NMETA = 16;
constexpr int RREAL = NB * SEQ;
constexpr int RVALID = RREAL + NMETA;
constexpr int NPAN = 129, RP = NPAN * 256;
constexpr int PMW = 1024, PRW = 1792;
constexpr int CW = 512;
constexpr int FF0 = 2816, FFE = 3584, NEXP = 8;
constexpr float RMS_EPS = 1e-6f, GN_EPS = 64e-5f;
constexpr int MOE_MAXPAN = 144;
constexpr int MOE_TAILPAN = 128, MOE_GAP = 8;
#ifndef MOE_CSKIP
#define MOE_CSKIP 5
#endif

typedef float f32x2_t __attribute__((ext_vector_type(2))); typedef __bf16 bf16x2_t __attribute__((ext_vector_type(2)));
__device__ __forceinline__ unsigned cvtpk(float lo, float hi) { f32x2_t v = {lo, hi}; bf16x2_t b = __builtin_convertvector(v, bf16x2_t); return __builtin_bit_cast(unsigned, b); }
__device__ __forceinline__ bf16_t f2bf_hw(float x) { return (bf16_t)(cvtpk(x, x) & 0xffffu); }
__device__ __forceinline__ float bf2f(bf16_t b) { return __uint_as_float(((unsigned)b) << 16); }
__device__ __forceinline__ bf16_t f2bf(float f) { unsigned u = __float_as_uint(f); u += 0x7fffu + ((u >> 16) & 1u); return (bf16_t)(u >> 16); }
__device__ __forceinline__ unsigned pk2(float lo, float hi) { return (unsigned)f2bf(lo) | ((unsigned)f2bf(hi) << 16); }
#define DPP_F(v_, ctrl_, rmask_) __int_as_float(__builtin_amdgcn_update_dpp(0, __float_as_int(v_), (ctrl_), (rmask_), 0xf, false))
__device__ __forceinline__ float wave_sum(float v) {
    v += DPP_F(v, 0xB1, 0xf); v += DPP_F(v, 0x4E, 0xf); v += DPP_F(v, 0x141, 0xf); v += DPP_F(v, 0x140, 0xf);
    v += DPP_F(v, 0x142, 0xa); v += DPP_F(v, 0x143, 0xc);
    return __int_as_float(__builtin_amdgcn_readlane(__float_as_int(v), 63));
}
__device__ __forceinline__ float wave_max(float v) {
    v = fmaxf(v, DPP_F(v, 0xB1, 0xf)); v = fmaxf(v, DPP_F(v, 0x4E, 0xf)); v = fmaxf(v, DPP_F(v, 0x141, 0xf)); v = fmaxf(v, DPP_F(v, 0x140, 0xf));
    v = fmaxf(v, DPP_F(v, 0x142, 0xa)); v = fmaxf(v, DPP_F(v, 0x143, 0xc));
    return __int_as_float(__builtin_amdgcn_readlane(__float_as_int(v), 63));
}
constexpr float F8_MAX = 448.0f, F8_ACT = 8.0f;
__device__ __forceinline__ unsigned pk4_f8(float a, float b, float c, float d) {
    float mx = F8_MAX; asm volatile("" : "+v"(mx));
    a = __builtin_amdgcn_fmed3f(a, -mx, mx); b = __builtin_amdgcn_fmed3f(b, -mx, mx); c = __builtin_amdgcn_fmed3f(c, -mx, mx); d = __builtin_amdgcn_fmed3f(d, -mx, mx);
    int r = __builtin_amdgcn_cvt_pk_fp8_f32(a, b, 0, false); r = __builtin_amdgcn_cvt_pk_fp8_f32(c, d, r, true); return (unsigned)r; }
__device__ __forceinline__ float moe_wscale(const unsigned* ctl, int t, int e);
__device__ __forceinline__ float quad_sum(float v) { v += DPP_F(v, 0xB1, 0xf); v += DPP_F(v, 0x4E, 0xf); return v; }
__device__ __forceinline__ float sigmoidf_(float x) { return 1.0f / (1.0f + __expf(-x)); }
__device__ __forceinline__ int row_pos(int row) { return row < RREAL ? NMETA + (row & (SEQ - 1)) : row - RREAL; }
__device__ __forceinline__ int row_prev(int row) { if (row < RREAL) return (row & (SEQ - 1)) ? row - 1 : RVALID - 1; return row == RREAL ? -1 : row - 1; }

constexpr size_t MiB = 1u << 20;
constexpr size_t WS_CTL = 0;
constexpr size_t WS_HMETA = 1 * MiB;
constexpr size_t WS_WB = 2 * MiB;
constexpr size_t LW_STRIDE = 10 * MiB;
constexpr size_t LW_WIN = 0, LW_WUQ = LW_WIN + (size_t)2816 * 1024 * 2, LW_WK = LW_WUQ + (size_t)768 * 512 * 2, LW_WV = LW_WK + (size_t)512 * 256 * 2,
                 LW_LORA = LW_WV + (size_t)512 * 256 * 2, LW_WOUT = LW_LORA + (size_t)1536 * 256 * 2, LW_END = LW_WOUT + (size_t)1024 * 1024 * 2;
static_assert(LW_END <= LW_STRIDE, "layer weights");
constexpr size_t WS_V1T = WS_WB + 2 * LW_STRIDE, WS_V2T = WS_V1T + (size_t)256 * 512 * 2, WS_FGU = WS_V2T + (size_t)512 * 256 * 2,
                 WS_FDN = WS_FGU + (size_t)5632 * 1024 * 2, WS_ROPE = WS_FDN + (size_t)1024 * 2816 * 2, WS_WB_END = WS_ROPE + (size_t)4112 * 64 * 4;
constexpr size_t WS_TB = WS_FGU;
constexpr size_t WS_ARENA = 41 * MiB;
static_assert(WS_WB_END <= WS_ARENA, "weights fit");
static_assert((size_t)8 * 256 * 1024 * 4 <= (size_t)5632 * 1024 * 2, "list-1 tail buffer fits the dense gate/up weight slot");
constexpr size_t SZ_R1024 = (size_t)RP * 1024 * 2, SZ_R512 = (size_t)RP * 512 * 2, SZ_R256 = (size_t)RP * 256 * 2;
constexpr size_t A_U = WS_ARENA;
constexpr size_t A_KN = A_U + SZ_R1024;
constexpr size_t A_VT = A_KN + SZ_R512;
constexpr size_t A_LOUT = A_U, A_VMIX = A_VT;
static_assert((size_t)RP * 1536 * 2 == SZ_R1024 + SZ_R512, "LORA_OUT fills the U and KN slots exactly");
constexpr size_t A_PM = A_VT + SZ_R512;
constexpr size_t A_PR = A_PM + SZ_R1024;
constexpr size_t A_SMALL = A_PR + (size_t)RP * PRW * 2;
constexpr size_t A_RSTDQ = A_SMALL, A_RSTDKV = A_RSTDQ + (size_t)RP * 4, A_KROPE = A_RSTDKV + (size_t)RP * 4, A_SMALL_END = A_KROPE + (size_t)RP * 64 * 2;
constexpr size_t A_LIN = (A_SMALL_END + 4095) & ~(size_t)4095;
constexpr size_t A_VSH = A_LIN + SZ_R256;
constexpr size_t A_CHK = A_LIN;
constexpr size_t SZ_CHK = (size_t)258 * 8 * 32768;
constexpr size_t A_VFIRST = (A_CHK + SZ_CHK > A_VSH + SZ_R512 ? A_CHK + SZ_CHK : A_VSH + SZ_R512);
constexpr size_t A_VP = A_VFIRST + SZ_R512;
constexpr size_t A_RK = A_VP + SZ_R512;
constexpr size_t A_YS = A_RK + (size_t)RP * 8 * 4;
constexpr size_t A_SCST = A_YS + SZ_R512;
constexpr size_t A_PART = A_SCST + (size_t)64 * 4096 * 4;
constexpr size_t A_END1 = A_PART + (size_t)11 * NMETA * 1024 * 4;
constexpr size_t A_ACT0 = A_PM;
constexpr size_t A_MGU = A_KN;
constexpr size_t A_MDN = A_MGU + (size_t)NEXP * 7168 * 1024 * 2;
constexpr size_t A_MTAB = A_MDN + (size_t)NEXP * 1024 * 3584 * 2;
constexpr size_t MT_E = 0, MT_G = MT_E + (size_t)2 * RREAL * 4, MT_STOK = MT_G + (size_t)2 * RREAL * 4, MT_TSLOT = MT_STOK + (size_t)2 * MOE_MAXPAN * 256 * 4  , MT_SGATE = MT_TSLOT + (size_t)RREAL * 4,
                 MT_BE = MT_SGATE + (size_t)2 * MOE_MAXPAN * 256 * 4, MT_END = MT_BE + 2 * 256 * 4;
constexpr size_t A_MACT = (A_MTAB + MT_END + 4095) & ~(size_t)4095;
constexpr size_t XB_LIST = (size_t)MOE_MAXPAN * 256 * 1024;
constexpr size_t A_XB = A_MACT + (size_t)MOE_MAXPAN * 256 * FFE;
static_assert(A_XB + 2 * XB_LIST <= A_MACT + (size_t)MOE_MAXPAN * 256 * FFE * 2, "XB inside the old activation footprint");
constexpr size_t A_END2 = A_MACT + (size_t)MOE_MAXPAN * 256 * FFE * 2;
constexpr size_t WS_NEED = (A_END1 > A_END2 ? A_END1 : A_END2);
static_assert(WS_NEED <= 557619232ull, "workspace budget (sum of the inputs' bytes)");
static_assert(A_ACT0 + (size_t)RP * FF0 * 2 <= A_SMALL, "dense act overlay");
constexpr int CW_CNT = 64;
constexpr int CW_FILL = 128;
constexpr int CW_NPAN = 192;
constexpr int CW_WINV = 16448;
constexpr int CW_WMAX = 16384;
constexpr int CW_WGCNT = 8192;


__device__ __forceinline__ unsigned long long kp_uniform(unsigned long long kp) { const unsigned lo = __builtin_amdgcn_readfirstlane((unsigned)kp), hi = __builtin_amdgcn_readfirstlane((unsigned)(kp >> 32)); return ((unsigned long long)hi << 32) | lo; }
__device__ __forceinline__ const void* ldk(unsigned long long kp, int off) { unsigned long long v;
    asm volatile("s_load_dwordx2 %0, %1, %2\n\ts_waitcnt lgkmcnt(0)" : "=s"(v) : "s"(kp), "i"(off) : "memory"); return (const void*)v; }
__device__ __forceinline__ int opq(int v) { asm volatile("" : "+v"(v)); return v; }
__device__ __forceinline__ int opqs(int v) { asm volatile("" : "+s"(v)); return v; }
__device__ __forceinline__ void lds_barrier() { asm volatile("s_waitcnt lgkmcnt(0)\n\ts_barrier" ::: "memory"); }

__device__ __forceinline__ float moe_wscale_bits(unsigned bits) { const float m = __uint_as_float(bits);
    return m > 0.f ? __builtin_amdgcn_exp2f(floorf(__builtin_amdgcn_logf(224.0f / m))) : 1.0f; }
__device__ __forceinline__ float moe_wscale(const unsigned* ctl, int t, int e) { return moe_wscale_bits((unsigned)__builtin_amdgcn_readfirstlane((int)ctl[CW_WMAX + t * 8 + e])); }
#define XB_TMO      128
#define XB_XCNT(j)  (256  + 64 * (j))
#define XB_XSUB(j)  (1280 + 64 * (j))
#define XB_XGEN(j)  (2304 + 64 * (j))
#define XB_TOP      3328
#define XB_TOPGEN   3392
#define XCD_BAR_WORDS 3456
#define XB_SPIN_CAP (1u << 18)

__device__ __forceinline__ unsigned xb_ld(unsigned* p)              { return __hip_atomic_load(p, __ATOMIC_RELAXED, __HIP_MEMORY_SCOPE_AGENT); }
__device__ __forceinline__ unsigned xb_add(unsigned* p, unsigned v) { return __hip_atomic_fetch_add(p, v, __ATOMIC_RELAXED, __HIP_MEMORY_SCOPE_AGENT); }
__device__ __forceinline__ unsigned xb_xcc_id() { return (unsigned)__builtin_amdgcn_s_getreg((3 << 11) | 20) & 0xFu; }
#define XB_SPIN(cond, bar) do { unsigned _sp = 0; while (cond) { __builtin_amdgcn_s_sleep(1); \
    if ((++_sp & 255u) == 0u) { if (xb_ld(&(bar)[XB_TMO])) break; if (_sp > XB_SPIN_CAP) { atomicAdd(&(bar)[XB_TMO], 1u); break; } } } } while (0)

struct XcdBarrier {
    unsigned* bar; unsigned x;
    volatile LAS unsigned* st;
};

__device__ __forceinline__ XcdBarrier xcd_barrier_post(unsigned* bar, volatile LAS unsigned* st) {
    XcdBarrier b; b.bar = bar; b.x = xb_xcc_id(); b.st = st;
    if (threadIdx.x == 0) (void)xb_add(&bar[XB_XCNT(b.x)], 1u);
    return b;
}
__device__ __forceinline__ void xcd_barrier_complete(unsigned* bar, unsigned x, unsigned& nloc, unsigned& nx) {
    const unsigned G = gridDim.x * gridDim.y * gridDim.z;
    unsigned sum, cnt, mine, sp = 0u;
    for (;;) {
        sum = 0u; cnt = 0u; mine = 0u;
#pragma unroll
        for (unsigned j = 0; j < 16; ++j) { const unsigned c = xb_ld(&bar[XB_XCNT(j)]); sum += c; cnt += (c > 0u) ? 1u : 0u; mine = (j == x) ? c : mine; }
        if (sum == G) break;
        __builtin_amdgcn_s_sleep(1);
        if ((++sp & 255u) == 0u) { if (xb_ld(&bar[XB_TMO])) break; if (sp > XB_SPIN_CAP) { atomicAdd(&bar[XB_TMO], 1u); break; } }
    }
    nloc = mine > 0u ? mine : 1u; nx = cnt > 0u ? cnt : 1u;
}

__device__ __attribute__((noinline)) void xcd_barrier_fn(unsigned* bar_, unsigned x_, volatile LAS unsigned* st_) {
    XcdBarrier b; b.bar = bar_; b.x = x_; b.st = st_;
    asm volatile("s_waitcnt vmcnt(0)" ::: "memory");
    __syncthreads();
    if (threadIdx.x == 0) {
        unsigned* bar = b.bar;
        __builtin_amdgcn_s_waitcnt(0);
        unsigned nloc = b.st[0], nx = b.st[1];
        if (nloc == 0u) { xcd_barrier_complete(bar, b.x, nloc, nx); b.st[0] = nloc; b.st[1] = nx; }
        const unsigned old = xb_add(&bar[XB_XSUB(b.x)], 1u);
        const unsigned gen = old / nloc;
        if (old + 1u == (gen + 1u) * nloc) {
            __builtin_amdgcn_fence(__ATOMIC_RELEASE, "agent");
            asm volatile("s_waitcnt vmcnt(0)" ::: "memory");
            const unsigned og = xb_add(&bar[XB_TOP], 1u);
            const unsigned tg = og / nx;
            if (og + 1u == (tg + 1u) * nx) xb_add(&bar[XB_TOPGEN], 1u);
            else XB_SPIN(xb_ld(&bar[XB_TOPGEN]) == tg, bar);
            __builtin_amdgcn_fence(__ATOMIC_ACQUIRE, "agent");
            xb_add(&bar[XB_XGEN(b.x)], 1u);
            asm volatile("s_waitcnt vmcnt(0)" ::: "memory");
        } else {
            XB_SPIN(xb_ld(&bar[XB_XGEN(b.x)]) == gen, bar);
            __builtin_amdgcn_fence(__ATOMIC_ACQUIRE, "agent");
            asm volatile("s_waitcnt vmcnt(0)" ::: "memory");
        }
    }
    __syncthreads();
}

__device__ __forceinline__ void xcd_barrier(const XcdBarrier& b) { xcd_barrier_fn(b.bar, b.x, b.st); }
using pg8::Unit;
struct EpiInProj { static constexpr bool PERM = true, AFTER_DRAIN = false; bf16_t* PM; bf16_t* PR;
    __device__ __forceinline__ void operator()(const f32x4 (&acc)[2][2][4][2], const Unit& u, int wr, int wc, int fr, int fq) const {
        const int row0 = u.pm * 256 + wr * 64 + fr; bf16_t* base; int ld, colt;
        if (u.pn < 4) { base = PM; ld = PMW; colt = u.pn * 256; } else { base = PR; ld = PRW; colt = (u.pn - 4) * 256; }
        const int col0 = colt + wc * 32 + 8 * fq;
#pragma unroll
        for (int ai = 0; ai < 2; ++ai)
#pragma unroll
            for (int m = 0; m < 4; ++m) { bf16_t* rowp = base + (size_t)(row0 + ai * 128 + m * 16) * ld + col0;
#pragma unroll
                for (int bj = 0; bj < 2; ++bj) { const f32x4 v0 = acc[ai][bj][m][0], v1 = acc[ai][bj][m][1];
                    u32x4 w; w.x = pg8::cvt_pk_bf16(v0[0], v0[1]); w.y = pg8::cvt_pk_bf16(v0[2], v0[3]); w.z = pg8::cvt_pk_bf16(v1[0], v1[1]); w.w = pg8::cvt_pk_bf16(v1[2], v1[3]);
                    *(u32x4*)(rowp + bj * 128) = w; } }
    }
};
struct EpiRowScale { static constexpr bool PERM = true, AFTER_DRAIN = false; bf16_t* O; const float* rs; int ldc, pad;
    __device__ __forceinline__ void operator()(const f32x4 (&acc)[2][2][4][2], const Unit& u, int wr, int wc, int fr, int fq) const {
        const int row0 = u.pm * 256 + wr * 64 + fr; const int col0 = u.pn * 256 + wc * 32 + 8 * fq;
#pragma unroll
        for (int ai = 0; ai < 2; ++ai)
#pragma unroll
            for (int m = 0; m < 4; ++m) { const int row = row0 + ai * 128 + m * 16; const float s = rs ? rs[row] : 1.f; bf16_t* rowp = O + (size_t)row * ldc + col0;
#pragma unroll
                for (int bj = 0; bj < 2; ++bj) { const f32x4 v0 = acc[ai][bj][m][0] * s, v1 = acc[ai][bj][m][1] * s;
                    u32x4 w; w.x = pg8::cvt_pk_bf16(v0[0], v0[1]); w.y = pg8::cvt_pk_bf16(v0[2], v0[3]); w.z = pg8::cvt_pk_bf16(v1[0], v1[1]); w.w = pg8::cvt_pk_bf16(v1[2], v1[3]);
                    *(u32x4*)(rowp + bj * 128) = w; } }
    }
};
struct EpiColScale { static constexpr bool PERM = true, AFTER_DRAIN = false; bf16_t* O; const float* cs; int ldc, pad;
    __device__ __forceinline__ void operator()(const f32x4 (&acc)[2][2][4][2], const Unit& u, int wr, int wc, int fr, int fq) const {
        const int row0 = u.pm * 256 + wr * 64 + fr; const int col0 = u.pn * 256 + wc * 32 + 8 * fq;
        f32x4 sc[2][2];
#pragma unroll
        for (int bj = 0; bj < 2; ++bj) { sc[bj][0] = *(const f32x4*)(cs + col0 + bj * 128); sc[bj][1] = *(const f32x4*)(cs + col0 + bj * 128 + 4); }
#pragma unroll
        for (int ai = 0; ai < 2; ++ai)
#pragma unroll
            for (int m = 0; m < 4; ++m) { bf16_t* rowp = O + (size_t)(row0 + ai * 128 + m * 16) * ldc + col0;
#pragma unroll
                for (int bj = 0; bj < 2; ++bj) { const f32x4 v0 = acc[ai][bj][m][0] * sc[bj][0], v1 = acc[ai][bj][m][1] * sc[bj][1];
                    u32x4 w; w.x = pg8::cvt_pk_bf16(v0[0], v0[1]); w.y = pg8::cvt_pk_bf16(v0[2], v0[3]); w.z = pg8::cvt_pk_bf16(v1[0], v1[1]); w.w = pg8::cvt_pk_bf16(v1[2], v1[3]);
                    *(u32x4*)(rowp + bj * 128) = w; } }
    }
};
struct EpiResid { static constexpr bool PERM = false, AFTER_DRAIN = false; float* out; float* hmeta; const float* src; float scale; int pad;
    __device__ __forceinline__ void operator()(const f32x4 (&acc)[2][2][4][2], const Unit& u, int wr, int wc, int fr, int fq) const {
        const int rl = wr * 64 + fr, col0 = u.pn * 256 + wc * 32 + 4 * fq;
        float* base = u.pm < 128 ? out + (size_t)u.pm * 256 * D : hmeta; const float* sbase = u.pm < 128 ? src + (size_t)u.pm * 256 * D : hmeta;
#pragma unroll
        for (int ai = 0; ai < 2; ++ai)
#pragma unroll
            for (int m = 0; m < 4; ++m) { const size_t ro = (size_t)(rl + ai * 128 + m * 16) * D + col0;
#pragma unroll
                for (int bj = 0; bj < 2; ++bj)
#pragma unroll
                    for (int n = 0; n < 2; ++n) { const f32x4 hv = *(const f32x4*)(sbase + ro + bj * 128 + n * 16); *(f32x4*)(base + ro + bj * 128 + n * 16) = hv + acc[ai][bj][m][n] * scale; }
                asm volatile("" ::: "memory"); }
    }
};
struct EpiSwiGLU { static constexpr bool PERM = true, AFTER_DRAIN = false; bf16_t* O; int ldc, nmod, pn_off, pad;
    __device__ __forceinline__ void operator()(const f32x4 (&acc)[2][2][4][2], const Unit& u, int wr, int wc, int fr, int fq) const {
        const int row0 = u.pm * 256 + wr * 64 + fr; const int pnl = (u.pn % nmod) - pn_off; const int col0 = pnl * 128 + wc * 32 + 8 * fq;
#pragma unroll
        for (int ai = 0; ai < 2; ++ai)
#pragma unroll
            for (int m = 0; m < 4; ++m) { bf16_t* rowp = O + (size_t)(row0 + ai * 128 + m * 16) * ldc + col0; float r[8];
#pragma unroll
                for (int n = 0; n < 2; ++n)
#pragma unroll
                    for (int j = 0; j < 4; ++j) { const float g = acc[ai][0][m][n][j], up = acc[ai][1][m][n][j]; r[4 * n + j] = g / (1.0f + __expf(-g)) * up; }
                u32x4 w; w.x = pg8::cvt_pk_bf16(r[0], r[1]); w.y = pg8::cvt_pk_bf16(r[2], r[3]); w.z = pg8::cvt_pk_bf16(r[4], r[5]); w.w = pg8::cvt_pk_bf16(r[6], r[7]);
                *(u32x4*)rowp = w; }
    }
};
struct EpiSwiGLU8 { static constexpr bool PERM = false, AFTER_DRAIN = false; unsigned char* O; const unsigned* ctl; int ldc, nmod;
    __device__ __forceinline__ void operator()(const f32x4 (&acc)[2][2][4][2], const Unit& u, int wr, int wc, int fr, int fq) const {
        const int row0 = u.pm * 256 + wr * 64 + fr; const int e = u.pn / nmod, pnl = u.pn % nmod; const int col0 = pnl * 128 + wc * 32 + 4 * fq;
        const float ig = __uint_as_float(__builtin_amdgcn_readfirstlane((int)ctl[CW_WINV + e])), iu = __uint_as_float(__builtin_amdgcn_readfirstlane((int)ctl[CW_WINV + 8 + e])) * F8_ACT;
#pragma unroll
        for (int ai = 0; ai < 2; ++ai)
#pragma unroll
            for (int m = 0; m < 4; ++m) { unsigned char* rowp = O + (size_t)(row0 + ai * 128 + m * 16) * ldc + col0;
#pragma unroll
                for (int n = 0; n < 2; ++n) { float r[4];
#pragma unroll
                    for (int j = 0; j < 4; ++j) { const float g = acc[ai][0][m][n][j] * ig, up = acc[ai][1][m][n][j] * iu; r[j] = g / (1.0f + __expf(-g)) * up; }
                    *(unsigned*)(rowp + n * 16) = pk4_f8(r[0], r[1], r[2], r[3]); } }
    }
};
struct EpiMoeDown { static constexpr bool PERM = false, AFTER_DRAIN = false; float* out; const int* stok; const float* sgate; int nmod; float scale; const unsigned* ctl;
    __device__ __forceinline__ void operator()(const f32x4 (&acc)[2][2][4][2], const Unit& u, int wr, int wc, int fr, int fq) const {
        const int row0 = u.pm * 256 + wr * 64 + fr; const int col0 = (u.pn % nmod) * 256 + wc * 32 + 4 * fq;
        const float winv = ctl ? __uint_as_float(__builtin_amdgcn_readfirstlane((int)ctl[CW_WINV + 16 + u.pn / nmod])) : 1.0f;
#pragma unroll
        for (int ai = 0; ai < 2; ++ai)
#pragma unroll
            for (int m = 0; m < 4; ++m) { const int prow = row0 + ai * 128 + m * 16; const int tok = stok[prow]; if (tok < 0) continue; const float gt = sgate[prow] * scale * winv;
                float* rowp = out + (size_t)tok * D + col0;
#pragma unroll
                for (int bj = 0; bj < 2; ++bj)
#pragma unroll
                    for (int n = 0; n < 2; ++n) { f32x4* p = (f32x4*)(rowp + bj * 128 + n * 16); *p = *p + acc[ai][bj][m][n] * gt; }
                asm volatile("" ::: "memory"); }
    }
};
struct EpiMoeDownStore { static constexpr bool PERM = false, AFTER_DRAIN = false; float* tb; const int* stok; const float* sgate; int nmod, pm0; const unsigned* ctl;
    __device__ __forceinline__ void operator()(const f32x4 (&acc)[2][2][4][2], const Unit& u, int wr, int wc, int fr, int fq) const {
        const int row0 = u.pm * 256 + wr * 64 + fr; const int col0 = (u.pn % nmod) * 256 + wc * 32 + 4 * fq;
#pragma unroll
        for (int ai = 0; ai < 2; ++ai)
#pragma unroll
            for (int m = 0; m < 4; ++m) { const int prow = row0 + ai * 128 + m * 16; const int tok = stok[prow]; if (tok < 0) continue; const float gt = sgate[prow] * __uint_as_float(__builtin_amdgcn_readfirstlane((int)ctl[CW_WINV + 16 + u.pn / nmod]));
                float* rowp = tb + (size_t)(prow - pm0 * 256) * D + col0;
#pragma unroll
                for (int bj = 0; bj < 2; ++bj)
#pragma unroll
                    for (int n = 0; n < 2; ++n) *(f32x4*)(rowp + bj * 128 + n * 16) = acc[ai][bj][m][n] * gt; }
    }
};
struct MoeOrder { static constexpr bool GATHER = false; const int* block_e; const unsigned* npan; int nN, emul, pn_off, G, c, lmax;
    __device__ __forceinline__ bool next(int i, Unit& u) const { const int L = i * G + c; const int np = __builtin_amdgcn_readfirstlane((int)(*npan)); if (L >= np * nN || (lmax && L >= lmax)) return false;
        const int pm = L / nN; u.k0 = 0; u.pm = pm; u.pn = __builtin_amdgcn_readfirstlane(block_e[pm]) * emul + pn_off + (L % nN); return true; }
    __device__ __forceinline__ void a_ready(const Unit&) const {}
    __device__ __forceinline__ void done(const Unit&) const {}
};


struct EpiResidPartial { static constexpr bool PERM = false, AFTER_DRAIN = false; float* part;
    __device__ __forceinline__ void operator()(const f32x4 (&acc)[2][2][4][2], const Unit& u, int wr, int wc, int fr, int fq) const {
        const int rl = wr * 64 + fr, col0 = u.pn * 256 + wc * 32 + 4 * fq; float* base = part + (size_t)(u.k0 >> 8) * NMETA * D;
#pragma unroll
        for (int ai = 0; ai < 2; ++ai)
#pragma unroll
            for (int m = 0; m < 4; ++m) { const int row = rl + ai * 128 + m * 16; if (row >= NMETA) continue;
                float* rowp = base + (size_t)row * D + col0;
#pragma unroll
                for (int bj = 0; bj < 2; ++bj)
#pragma unroll
                    for (int n = 0; n < 2; ++n) *(f32x4*)(rowp + bj * 128 + n * 16) = acc[ai][bj][m][n]; }
    }
};
struct DenseTailOrder { static constexpr bool GATHER = false; int nN, nsl, G, c;
    __device__ __forceinline__ bool next(int i, Unit& u) const { const int idx = i * G + c; if (idx >= nN * nsl) return false; u.pm = 128; u.pn = idx / nsl; u.k0 = (idx % nsl) * 256; return true; }
    __device__ __forceinline__ void a_ready(const Unit&) const {}
    __device__ __forceinline__ void done(const Unit&) const {}
};
template <bool GA> struct MoeGatherOrderT { static constexpr bool GATHER = GA;
    const int* block_e; const unsigned* npan; const int* rows; int nN, emul, pn_off, G, c, zero_row;
    int pm_lo, pm_hi, gap, rot, T, cskip;
    __device__ __forceinline__ bool next(int i, Unit& u) const {
        int cc = c - rot; cc += cc < 0 ? G : 0;
        int L;
        if (T == 0) L = i * G + cc;
        else { const int W0 = G - T; if (cc < W0) L = i < cskip ? i * W0 + cc : cskip * W0 + (i - cskip) * G + cc; else L = cskip * W0 + i * G + cc; }
        int np = __builtin_amdgcn_readfirstlane((int)(*npan)); np = np < pm_hi ? np : pm_hi;
        const int pl = pm_lo + L / nN; if (pl >= np) return false;
        const int pm = pl + (pl >= MOE_TAILPAN ? gap : 0); u.k0 = 0; u.pm = pm; u.pn = __builtin_amdgcn_readfirstlane(block_e[pm]) * emul + pn_off + (L % nN); return true; }
    __device__ __forceinline__ void a_ready(const Unit&) const {}
    __device__ __forceinline__ void done(const Unit&) const {}
};
using MoeGatherOrder = MoeGatherOrderT<true>; using MoeSlotOrder = MoeGatherOrderT<false>;
struct MoeShiftTailOrder { static constexpr bool GATHER = false; const int* block_e; const unsigned* npan; int nN, emul, gap, wg_first, c, pad;
    __device__ __forceinline__ bool next(int i, Unit& u) const { const int t = wg_first - c; const int np = __builtin_amdgcn_readfirstlane((int)(*npan)); const int L = MOE_TAILPAN * nN + t;
        if (i > 0 || t < 0 || L >= np * nN) return false;
        const int pm = L / nN + gap; u.k0 = 0; u.pm = pm; u.pn = __builtin_amdgcn_readfirstlane(block_e[pm]) * emul + (L % nN); return true; }
    __device__ __forceinline__ void a_ready(const Unit&) const {}
    __device__ __forceinline__ void done(const Unit&) const {}
};

__device__ __forceinline__ int map_row(int mode, int n, int rowoff) {
    if (mode == 1) return n < 832 ? n : n + 192;
    if (mode == 2) return rowoff + (n >> 7) * 256 + (n & 127);
    if (mode == 3) return rowoff + (n >> 7) * 256 + 128 + (n & 127);
    if (mode == 4) return (n >> 8) * 128 + (n & 127) + ((n & 128) ? 512 : 0);
    return rowoff + n;
}
__device__ __forceinline__ void transpose_item(const float* __restrict__ W, int K, int N, bf16_t* __restrict__ dst, int ld, int koff, int mode, int rowoff, const float* __restrict__ gain, LAS float* scr, int item, int lane) {
    const int nblk = N / 32; const int kb = item / nblk, nb = item % nblk, k0 = 64 * kb, n0 = 32 * nb;
    float ld_[32];
#pragma unroll
    for (int i = 0; i < 32; ++i) ld_[i] = W[(size_t)(k0 + 2 * i + (lane >> 5)) * N + n0 + (lane & 31)];
#pragma unroll
    for (int i = 0; i < 32; ++i) { const int kk = 2 * i + (lane >> 5); float v = ld_[i]; if (gain) v *= gain[k0 + kk]; scr[kk * 33 + (lane & 31)] = v; }
    asm volatile("s_waitcnt lgkmcnt(0)" ::: "memory");
    const int c = lane & 7;
#pragma unroll
    for (int j = 0; j < 4; ++j) { const int n = (lane >> 3) + 8 * j; const LAS float* s = scr + (8 * c) * 33 + n;
        u32x4 o; o.x = pk2(s[0 * 33], s[1 * 33]); o.y = pk2(s[2 * 33], s[3 * 33]); o.z = pk2(s[4 * 33], s[5 * 33]); o.w = pk2(s[6 * 33], s[7 * 33]);
        *(u32x4*)(dst + (size_t)map_row(mode, n0 + n, rowoff) * ld + koff + k0 + 8 * c) = o; }
    asm volatile("s_waitcnt lgkmcnt(0)" ::: "memory");
}
__device__ __forceinline__ void transpose_item_f8(const float* __restrict__ W, int K, int N, unsigned char* __restrict__ dst, int ld, int mode, int rowoff, float scale, LAS float* scr, int item, int lane) {
    const int nblk = N / 32; const int kb = item / nblk, nb = item % nblk, k0 = 64 * kb, n0 = 32 * nb;
    float ld_[32];
#pragma unroll
    for (int i = 0; i < 32; ++i) ld_[i] = W[(size_t)(k0 + 2 * i + (lane >> 5)) * N + n0 + (lane & 31)];
#pragma unroll
    for (int i = 0; i < 32; ++i) { const int kk = 2 * i + (lane >> 5); scr[kk * 33 + (lane & 31)] = ld_[i] * scale; }
    asm volatile("s_waitcnt lgkmcnt(0)" ::: "memory");
    const int c = lane & 7;
#pragma unroll
    for (int j = 0; j < 4; ++j) { const int n = (lane >> 3) + 8 * j; const LAS float* s = scr + (8 * c) * 33 + n;
        u32x2 o; o.x = pk4_f8(s[0 * 33], s[1 * 33], s[2 * 33], s[3 * 33]); o.y = pk4_f8(s[4 * 33], s[5 * 33], s[6 * 33], s[7 * 33]);
        *(u32x2*)(dst + (size_t)map_row(mode, n0 + n, rowoff) * ld + k0 + 8 * c) = o; }
    asm volatile("s_waitcnt lgkmcnt(0)" ::: "memory");
}
struct TrJob8 { const float* W; unsigned char* dst; int K, N, ld, mode, rowoff; float scale; };
__device__ __forceinline__ void ph_transpose_f8(const TrJob8& J, LAS float* scr, int gw, int ngw, int lane, int rot = 0) {
    lane = opq(lane);
    const int nitems = (J.K / 64) * (J.N / 32);
    int it0 = gw - rot % ngw; it0 += it0 < 0 ? ngw : 0;
    for (int it = it0; it < nitems; it += ngw) transpose_item_f8(J.W, J.K, J.N, J.dst, J.ld, J.mode, J.rowoff, J.scale, scr, it, lane);
}
struct TrJob { const float* W; const float* gain; bf16_t* dst; int K, N, ld, koff, mode, rowoff; };
__device__ __forceinline__ void ph_transpose(const TrJob& J, LAS float* scr, int gw, int ngw, int lane, int rot = 0) {
    lane = opq(lane);
    const int nitems = (J.K / 64) * (J.N / 32);
    int it0 = gw - rot % ngw; it0 += it0 < 0 ? ngw : 0;
    for (int it = it0; it < nitems; it += ngw) transpose_item(J.W, J.K, J.N, J.dst, J.ld, J.koff, J.mode, J.rowoff, J.gain, scr, it, lane);
}
__device__ __forceinline__ const float* hrow_c(const float* out, const float* hmeta, int row) { return row < RREAL ? out + (size_t)row * D : hmeta + (size_t)(row - RREAL) * D; }
__device__ __forceinline__ void ph_init(const float* __restrict__ x, const float* __restrict__ meta, float* __restrict__ out, float* __restrict__ hmeta, float* __restrict__ rope,
                                        const float* __restrict__ v1, const float* __restrict__ v2, bf16_t* __restrict__ v12t, size_t gt, size_t ngt) {
    (void)x; (void)out;
    for (size_t i = gt; i < (size_t)256 * D; i += ngt) hmeta[i] = i < (size_t)NMETA * D ? meta[i] : 0.f;
    for (size_t i = gt; i < (size_t)4112 * 32; i += ngt) { const int pos = (int)(i / 32), j = (int)(i % 32);
        const float inv = powf(10000.0f, -(float)j / 32.0f); const float ang = (float)pos * inv; rope[2 * i] = cosf(ang); rope[2 * i + 1] = sinf(ang); }
    for (size_t i = gt; i < (size_t)512 * 512; i += ngt) { const int n = (int)(i >> 9), k = (int)(i & 511); float s = 0.f;
#pragma unroll 8
        for (int j = 0; j < 32; ++j) s += v1[k * 32 + j] * v2[j * 512 + n];
        v12t[i] = f2bf(s); }
}
__device__ __forceinline__ void ph_rmsnorm(const float* __restrict__ out, const float* hmeta, const float* __restrict__ g, bf16_t* __restrict__ U, const float* __restrict__ part, int nsl, int gw, int ngw, int lane) {
    lane = opq(lane);
    for (int row = gw; row < RP; row += ngw) {
        unsigned long long* o8 = (unsigned long long*)(U + (size_t)row * D) + lane;
        if (row >= RVALID) {
#pragma unroll
            for (int j = 0; j < 4; ++j) o8[64 * j] = 0ull;
            continue; }
        const f32x4* xr = (const f32x4*)hrow_c(out, hmeta, row) + lane; const f32x4* g4 = (const f32x4*)g + lane;
        f32x4 v[4]; float s = 0.f;
#pragma unroll
        for (int j = 0; j < 4; ++j) v[j] = xr[64 * j];
        if (row >= RREAL && nsl > 0) {
            for (int sl = 0; sl < nsl; ++sl) { const f32x4* pr = (const f32x4*)(part + ((size_t)sl * NMETA + (row - RREAL)) * D) + lane;
#pragma unroll
                for (int j = 0; j < 4; ++j) v[j] = v[j] + pr[64 * j]; }
            f32x4* hw = (f32x4*)xr;
#pragma unroll
            for (int j = 0; j < 4; ++j) hw[64 * j] = v[j]; }
#pragma unroll
        for (int j = 0; j < 4; ++j) s += (v[j].x * v[j].x + v[j].y * v[j].y) + (v[j].z * v[j].z + v[j].w * v[j].w);
        const float rstd = rsqrtf(wave_sum(s) * (1.f / D) + RMS_EPS);
#pragma unroll
        for (int j = 0; j < 4; ++j) { const f32x4 gg = g4[64 * j]; o8[64 * j] = (unsigned long long)pk2(v[j].x * rstd * gg.x, v[j].y * rstd * gg.y) | ((unsigned long long)pk2(v[j].z * rstd * gg.z, v[j].w * rstd * gg.w) << 32); }
    }
}
__device__ __forceinline__ void unpack8(const u32x4 v, float (&f)[8]) {
    f[0] = __uint_as_float(v.x << 16); f[1] = __uint_as_float(v.x & 0xffff0000u); f[2] = __uint_as_float(v.y << 16); f[3] = __uint_as_float(v.y & 0xffff0000u);
    f[4] = __uint_as_float(v.z << 16); f[5] = __uint_as_float(v.z & 0xffff0000u); f[6] = __uint_as_float(v.w << 16); f[7] = __uint_as_float(v.w & 0xffff0000u);
}
__device__ __forceinline__ void ph_prep(const bf16_t* __restrict__ PM, const bf16_t* __restrict__ PR, const float* __restrict__ mu, const float* __restrict__ rope,
                                        float* __restrict__ rstdq, float* __restrict__ rstdkv, bf16_t* __restrict__ KR, bf16_t* __restrict__ LIN, bf16_t* __restrict__ VSH, int do_vsh, int gw, int ngw, int lane) {
    lane = opq(lane);
    for (int row = gw; row < RP; row += ngw) {
        const bf16_t* pm = PM + (size_t)row * PMW;
        float f[8], sq = 0.f, skv = 0.f;
        unpack8(*(const u32x4*)(pm + lane * 8), f);
#pragma unroll
        for (int j = 0; j < 8; ++j) sq += f[j] * f[j];
        if (lane < 32) { unpack8(*(const u32x4*)(pm + 512 + lane * 8), f);
#pragma unroll
            for (int j = 0; j < 8; ++j) skv += f[j] * f[j]; }
        sq = wave_sum(sq); skv = wave_sum(skv);
        if (lane == 0) { rstdq[row] = rsqrtf(sq * (1.f / 512.f) + RMS_EPS); rstdkv[row] = rsqrtf(skv * (1.f / 256.f) + RMS_EPS); }
        const int pos = row_pos(row);
        if (lane < 32) { const float x1 = bf2f(pm[768 + lane]), x2 = bf2f(pm[800 + lane]); const float c = rope[2 * (pos * 32 + lane)], s = rope[2 * (pos * 32 + lane) + 1];
            KR[(size_t)row * 64 + lane] = f2bf(x1 * c - x2 * s); KR[(size_t)row * 64 + 32 + lane] = f2bf(x1 * s + x2 * c); }
        const int pr = row_prev(row); const bool valid = row < RVALID; const float pmk = pr < 0 ? 0.f : 1.f;
        const bf16_t* x = PR + (size_t)row * PRW; const bf16_t* xp = PR + (size_t)(pr < 0 ? row : pr) * PRW;
        if (lane < 32) {
            float a[8], b[8]; unpack8(*(const u32x4*)(x + 1536 + lane * 8), a); unpack8(*(const u32x4*)(xp + 1536 + lane * 8), b);
            const f32x4 m0 = *(const f32x4*)(mu + 1536 + lane * 8), m1 = *(const f32x4*)(mu + 1536 + lane * 8 + 4); const float mm[8] = {m0.x, m0.y, m0.z, m0.w, m1.x, m1.y, m1.z, m1.w};
            float o[8];
#pragma unroll
            for (int j = 0; j < 8; ++j) { float v = a[j] + (pmk * b[j] - a[j]) * mm[j]; v = lane < 8 ? tanhf(v) : (lane < 16 ? v : sigmoidf_(v)); o[j] = valid ? v : 0.f; }
            u32x4 w; w.x = pk2(o[0], o[1]); w.y = pk2(o[2], o[3]); w.z = pk2(o[4], o[5]); w.w = pk2(o[6], o[7]); *(u32x4*)(LIN + (size_t)row * 256 + lane * 8) = w; }
        if (do_vsh) {
            float a[8], b[8]; unpack8(*(const u32x4*)(x + 1024 + lane * 8), a); unpack8(*(const u32x4*)(xp + 1024 + lane * 8), b);
            const f32x4 m0 = *(const f32x4*)(mu + 1024 + lane * 8), m1 = *(const f32x4*)(mu + 1024 + lane * 8 + 4); const float mm[8] = {m0.x, m0.y, m0.z, m0.w, m1.x, m1.y, m1.z, m1.w};
            float o[8];
#pragma unroll
            for (int j = 0; j < 8; ++j) { const float v = a[j] + (pmk * b[j] - a[j]) * mm[j]; o[j] = valid ? v : 0.f; }
            u32x4 w; w.x = pk2(o[0], o[1]); w.y = pk2(o[2], o[3]); w.z = pk2(o[4], o[5]); w.w = pk2(o[6], o[7]); *(u32x4*)(VSH + (size_t)row * 512 + lane * 8) = w; }
    }
}

__device__ __forceinline__ void ph_norm_route(LAS unsigned char* lds, const float* __restrict__ out, const float* __restrict__ g, const float* __restrict__ router, const float* __restrict__ rbias,
                                              bf16_t* __restrict__ U, int* __restrict__ TE, float* __restrict__ TG, int* __restrict__ STOK, unsigned* __restrict__ ctl, int bid, int nblk, int wave, int lane) {
    lane = opq(lane); nblk = opqs(nblk); bid = opqs(bid);
    { constexpr int NFILL = 2 * MOE_MAXPAN * 256 + RREAL; const int per = (NFILL + nblk - 1) / nblk; const int t_ = wave * 64 + lane;
      for (int i = t_; i < per; i += 512) { const int idx = bid * per + i; if (idx < NFILL) STOK[idx] = -1; } }
    const int rpw = (RREAL + nblk - 1) / nblk, rpwave = (rpw + 7) / 8;
    int c1[8], c2[8];
#pragma unroll
    for (int e = 0; e < 8; ++e) { c1[e] = 0; c2[e] = 0; }
    f32x4 nx[4];
    { const int rl0 = wave * rpwave, row_0 = bid * rpw + rl0; if (rl0 < rpw && row_0 < RREAL) { const f32x4* x0 = (const f32x4*)(out + (size_t)row_0 * D) + lane;
#pragma unroll
        for (int j = 0; j < 4; ++j) nx[j] = x0[64 * j]; } }
    for (int k = 0; k < rpwave; ++k) { const int rl = wave * rpwave + k; const int row = bid * rpw + rl; if (rl >= rpw || row >= RREAL) break;
        const f32x4* g4 = (const f32x4*)g + lane;
        f32x4 v[4]; float s = 0.f;
#pragma unroll
        for (int j = 0; j < 4; ++j) v[j] = nx[j];
        if (k + 1 < rpwave && rl + 1 < rpw && row + 1 < RREAL) { const f32x4* x1 = (const f32x4*)(out + (size_t)(row + 1) * D) + lane;
#pragma unroll
            for (int j = 0; j < 4; ++j) nx[j] = x1[64 * j]; }
#pragma unroll
        for (int j = 0; j < 4; ++j) s += (v[j].x * v[j].x + v[j].y * v[j].y) + (v[j].z * v[j].z + v[j].w * v[j].w);
        const float rstd = rsqrtf(wave_sum(s) * (1.f / D) + RMS_EPS);
        unsigned* o4 = (unsigned*)((unsigned char*)U + (size_t)row * D) + lane;
        float lg[8];
#pragma unroll
        for (int e = 0; e < 8; ++e) lg[e] = 0.f;
#pragma unroll
        for (int j = 0; j < 4; ++j) { const f32x4 gg = g4[64 * j]; f32x4 xn; xn.x = v[j].x * rstd * gg.x; xn.y = v[j].y * rstd * gg.y; xn.z = v[j].z * rstd * gg.z; xn.w = v[j].w * rstd * gg.w;
            o4[64 * j] = pk4_f8(xn.x * F8_ACT, xn.y * F8_ACT, xn.z * F8_ACT, xn.w * F8_ACT);
            const int d0 = 4 * (lane + 64 * j);
#pragma unroll
            for (int q = 0; q < 4; ++q) { const f32x4 ra = *(const f32x4*)(router + (size_t)(d0 + q) * 8), rb = *(const f32x4*)(router + (size_t)(d0 + q) * 8 + 4); const float xv = xn[q];
                lg[0] += xv * ra.x; lg[1] += xv * ra.y; lg[2] += xv * ra.z; lg[3] += xv * ra.w; lg[4] += xv * rb.x; lg[5] += xv * rb.y; lg[6] += xv * rb.z; lg[7] += xv * rb.w; }
            asm volatile("" ::: "memory"); }
#pragma unroll
        for (int e = 0; e < 8; ++e) { float t_ = wave_sum(lg[e]); asm volatile("" : "+v"(t_)); lg[e] = t_ + rbias[e]; }
        int e1 = 0; float l1 = lg[0];
#pragma unroll
        for (int e = 1; e < 8; ++e) if (lg[e] > l1) { l1 = lg[e]; e1 = e; }
        int e2 = e1 == 0 ? 1 : 0; float l2 = -INFINITY;
#pragma unroll
        for (int e = 0; e < 8; ++e) if (e != e1 && lg[e] > l2) { l2 = lg[e]; e2 = e; }
        const float g1 = 1.0f / (1.0f + __expf(l2 - l1)), g2 = 1.0f - g1;
        { const int e1v = e1, e2v = e2;
#pragma unroll
        for (int e = 0; e < 8; ++e) { c1[e] += (e1v == e) ? 1 : 0; c2[e] += (e2v == e) ? 1 : 0; } }
        if (lane == 0) { TE[row] = e1; TE[RREAL + row] = e2; TG[row] = g1; TG[RREAL + row] = g2; }
    }
    LAS int* wc = (LAS int*)(lds + 80000);
    if (lane == 0) {
#pragma unroll
        for (int e = 0; e < 8; ++e) { wc[wave * 16 + e] = c1[e]; wc[wave * 16 + 8 + e] = c2[e]; } }
    __syncthreads();
    const int t = wave * 64 + lane;
    if (t < 16) { int sum = 0;
#pragma unroll
        for (int ww = 0; ww < 8; ++ww) sum += wc[ww * 16 + t];
        ctl[CW_WGCNT + bid * 16 + t] = (unsigned)sum; }
}
__device__ __forceinline__ void ph_moe_assign(LAS unsigned char* lds, int list, const int* __restrict__ TE, const float* __restrict__ TG, int* __restrict__ STOK, float* __restrict__ SGATE, int* __restrict__ BE, unsigned* __restrict__ ctl,
                                              const unsigned char* __restrict__ U8, unsigned char* __restrict__ XB, int bid, int nblk, int tid) {
    LAS int* sh = (LAS int*)lds;
    __syncthreads();
    {
        LAS float* shf = (LAS float*)(lds + 2048);
        float tv[8], pv[8];
#pragma unroll
        for (int e = 0; e < 8; ++e) { tv[e] = 0.f; pv[e] = 0.f; }
        for (int b = tid; b < nblk; b += 512) { const u32x4* cp4 = (const u32x4*)(ctl + CW_WGCNT + b * 16 + 8 * list); const u32x4 c0 = cp4[0], c1 = cp4[1];
            const float v[8] = {(float)c0.x, (float)c0.y, (float)c0.z, (float)c0.w, (float)c1.x, (float)c1.y, (float)c1.z, (float)c1.w};
#pragma unroll
            for (int e = 0; e < 8; ++e) { tv[e] += v[e]; pv[e] += b < bid ? v[e] : 0.f; } }
        const int wv = tid >> 6;
#pragma unroll
        for (int e = 0; e < 8; ++e) { const float ts = wave_sum(tv[e]), ps = wave_sum(pv[e]); if ((tid & 63) == 0) { shf[wv * 16 + e] = ts; shf[wv * 16 + 8 + e] = ps; } }
        __syncthreads();
        if (tid < 8) { float tot = 0.f, pre = 0.f;
#pragma unroll
            for (int ww = 0; ww < 8; ++ww) { tot += shf[ww * 16 + tid]; pre += shf[ww * 16 + 8 + tid]; }
            sh[tid] = (int)tot; sh[8 + tid] = (int)pre; }
    }
    __syncthreads();
    if (tid == 0) { int pan = 0;
        for (int e = 0; e < 8; ++e) { const int np = (sh[e] + 255) >> 8; sh[16 + e] = pan << 8;
            if (bid == 0) for (int q = 0; q < np; ++q) { const int pi = pan + q; BE[256 * list + pi + (list == 1 && pi >= MOE_TAILPAN ? MOE_GAP : 0)] = e; }
            pan += np; }
        if (bid == 0) ctl[CW_NPAN + list] = (unsigned)pan; }
    __syncthreads();
    if (tid < 64) {
        const int rpw = (RREAL + nblk - 1) / nblk; int run[8];
#pragma unroll
        for (int q = 0; q < 8; ++q) run[q] = 0;
        for (int r0 = 0; r0 < rpw; r0 += 64) { const int rl = r0 + tid, row = bid * rpw + rl; const bool ok = rl < rpw && row < RREAL;
            const int ee = ok ? TE[list * RREAL + row] : -1; int slot = -1;
#pragma unroll
            for (int e = 0; e < 8; ++e) { const unsigned long long m = __builtin_amdgcn_ballot_w64(ee == e);
                const int rank = (int)__builtin_amdgcn_mbcnt_hi((unsigned)(m >> 32), __builtin_amdgcn_mbcnt_lo((unsigned)m, 0u));
                if (ee == e) { slot = sh[16 + e] + sh[8 + e] + run[e] + rank; if (list == 1 && slot >= MOE_TAILPAN * 256) slot += MOE_GAP * 256; }
                run[e] += __builtin_popcountll(m); }
            if (rl < rpw) sh[32 + rl] = ok ? slot : -1;
            if (ok) { STOK[list * (MOE_MAXPAN * 256) + slot] = row; SGATE[list * (MOE_MAXPAN * 256) + slot] = TG[list * RREAL + row];
                if (list == 1 && slot >= (MOE_TAILPAN + MOE_GAP) * 256) STOK[2 * MOE_MAXPAN * 256 + row] = slot - (MOE_TAILPAN + MOE_GAP) * 256; } }
    }
    __syncthreads();
    {
        const int rpw = (RREAL + nblk - 1) / nblk, w = tid >> 6, ln = tid & 63; unsigned char* xl = XB + (size_t)list * (MOE_MAXPAN * 256) * 1024;
        for (int rl = w; rl < rpw; rl += 8) { const int slot = sh[32 + rl]; if (slot >= 0) ((u32x4*)(xl + (size_t)slot * 1024))[ln] = ((const u32x4*)(U8 + (size_t)(bid * rpw + rl) * 1024))[ln]; }
        if (bid < 8) { const int e = bid, lo = sh[16 + e] + sh[e], hi = sh[16 + e] + (((sh[e] + 255) >> 8) << 8); unsigned z0 = 0u; asm volatile("" : "+v"(z0)); u32x4 z; z.x = z.y = z.z = z.w = z0;
            for (int p0 = lo + w; p0 < hi; p0 += 8) { const int slot = p0 + ((list == 1 && p0 >= MOE_TAILPAN * 256) ? MOE_GAP * 256 : 0); ((u32x4*)(xl + (size_t)slot * 1024))[ln] = z; } }
    }
}
__device__ __forceinline__ void ph_final(float* __restrict__ out, const float* __restrict__ g, const int* __restrict__ tslot, const float* __restrict__ tb, int gw, int ngw, int lane, float pscale = 1.0f) {
    lane = opq(lane);
    for (int row = gw; row < RREAL; row += ngw) {
        f32x4* xr = (f32x4*)(out + (size_t)row * D) + lane; const f32x4* g4 = (const f32x4*)g + lane;
        const int ts = __builtin_amdgcn_readfirstlane(tslot[row]);
        f32x4 v[4]; float s = 0.f;
#pragma unroll
        for (int j = 0; j < 4; ++j) v[j] = xr[64 * j];
        if (ts >= 0) { const f32x4* tr = (const f32x4*)(tb + (size_t)ts * D) + lane;
#pragma unroll
            for (int j = 0; j < 4; ++j) v[j] = v[j] + tr[64 * j]; }
#pragma unroll
        for (int j = 0; j < 4; ++j) s += (v[j].x * v[j].x + v[j].y * v[j].y) + (v[j].z * v[j].z + v[j].w * v[j].w);
        const float rstd = rsqrtf(wave_sum(s) * (1.f / D) + RMS_EPS);
#pragma unroll
        for (int j = 0; j < 4; ++j) { const f32x4 gg = g4[64 * j]; f32x4 o; o.x = v[j].x * rstd * gg.x * pscale; o.y = v[j].y * rstd * gg.y * pscale; o.z = v[j].z * rstd * gg.z * pscale; o.w = v[j].w * rstd * gg.w * pscale; xr[64 * j] = o; }
    }
}

constexpr int KS_STRIDE = 200, VS_STRIDE = 72;
constexpr int ATT_LDS = 64 * KS_STRIDE * 2 + 128 * VS_STRIDE * 2;
__device__ __forceinline__ bf16x8 pack8(const f32x16& x, int s) {
    u32x4 p;
    if (s == 0) { p.x = cvtpk(x[0], x[1]); p.y = cvtpk(x[2], x[3]); p.z = cvtpk(x[4], x[5]); p.w = cvtpk(x[6], x[7]); }
    else { p.x = cvtpk(x[8], x[9]); p.y = cvtpk(x[10], x[11]); p.z = cvtpk(x[12], x[13]); p.w = cvtpk(x[14], x[15]); }
    return __builtin_bit_cast(bf16x8, p);
}
__device__ __forceinline__ void attn_unit(LAS unsigned char* lds, const bf16_t* __restrict__ Q, const bf16_t* __restrict__ KN, const bf16_t* __restrict__ KR, const bf16_t* __restrict__ VT,
                                          bf16_t* __restrict__ MIX, const float* __restrict__ rope, int h, int qrow0, int kbase, int ntile, int wlim, bool wave_active) {
    const int tid = opq(threadIdx.x), lane = tid & 63, w = tid >> 6, r = lane & 31, hh = lane >> 5;
    LAS bf16_t* Ks = (LAS bf16_t*)lds; LAS bf16_t* Vs = (LAS bf16_t*)(lds + 64 * KS_STRIDE * 2);
    const int qrow = qrow0 + 32 * w + r;
    bf16x8 qf[12];
#pragma unroll
    for (int ks = 0; ks < 12; ++ks) qf[ks] = *(const GAS bf16x8*)(Q + (size_t)qrow * 768 + 192 * h + 16 * ks + 8 * hh);
    {
        const int pos = row_pos(qrow); const GAS float* rt = (const GAS float*)(rope + (size_t)pos * 64);
#pragma unroll
        for (int half = 0; half < 2; ++half) { const GAS float* cs = rt + 2 * (16 * half + 8 * hh);
#pragma unroll
            for (int j = 0; j < 8; ++j) { const float c = cs[2 * j], sn = cs[2 * j + 1]; const float x1 = bf2f((bf16_t)qf[8 + half][j]), x2 = bf2f((bf16_t)qf[10 + half][j]);
                qf[8 + half][j] = (short)f2bf(x1 * c - x2 * sn); qf[10 + half][j] = (short)f2bf(x1 * sn + x2 * c); } }
    }
    float z0 = 0.f; asm volatile("" : "+v"(z0));
    f32x16 oacc[4];
#pragma unroll
    for (int i = 0; i < 4; ++i)
#pragma unroll
        for (int j = 0; j < 16; ++j) oacc[i][j] = z0;
    float mrun = -INFINITY, lsum = 0.f;
    const float sc = 0.07216878364870322f * 1.4426950408889634f;
    u32x4 kreg[3], vreg[2];
    const unsigned kn_off0 = (unsigned)(((tid >> 4) * 512 + h * 128 + (tid & 15) * 8) * 2), kn_off1 = kn_off0 + 32u * 512u * 2u;
    const unsigned kr_off = (unsigned)(((tid >> 3) * 64 + (tid & 7) * 8) * 2);
    const unsigned vt_off0 = (unsigned)((((size_t)(h * 128 + (tid >> 3))) * RP + (tid & 7) * 8) * 2), vt_off1 = vt_off0 + 64u * (unsigned)RP * 2u;
#define ATT_GLOAD(tt_) do { const int krow0_ = (tt_) == 0 ? RREAL : kbase + 64 * ((tt_) - 1); \
    const char* knb_ = (const char*)KN + (size_t)krow0_ * 1024; const char* krb_ = (const char*)KR + (size_t)krow0_ * 128; const char* vtb_ = (const char*)VT + (size_t)krow0_ * 2; \
    kreg[0] = *(const GAS u32x4*)(knb_ + kn_off0); kreg[1] = *(const GAS u32x4*)(knb_ + kn_off1); kreg[2] = *(const GAS u32x4*)(krb_ + kr_off); \
    vreg[0] = *(const GAS u32x4*)(vtb_ + vt_off0); vreg[1] = *(const GAS u32x4*)(vtb_ + vt_off1); } while (0)
    ATT_GLOAD(0);
    for (int tt = 0; tt < ntile; ++tt) {
#ifdef PROBE_ATT_STAGE2
        __syncthreads();
        *(LAS u32x4*)(Ks + (tid >> 4) * KS_STRIDE + (tid & 15) * 8) = kreg[0]; *(LAS u32x4*)(Ks + (32 + (tid >> 4)) * KS_STRIDE + (tid & 15) * 8) = kreg[1];
        *(LAS u32x4*)(Ks + (tid >> 3) * KS_STRIDE + 128 + (tid & 7) * 8) = kreg[2];
#pragma unroll
        for (int i = 0; i < 2; ++i) {
            LAS u32x2* d = (LAS u32x2*)(Vs + ((tid >> 3) + 64 * i) * VS_STRIDE + ((tid & 7) >> 1) * 16 + (tid & 1) * 4);
            u32x2 lo; lo.x = vreg[i].x; lo.y = vreg[i].y; u32x2 hi; hi.x = vreg[i].z; hi.y = vreg[i].w; d[0] = lo; d[2] = hi; }
        __syncthreads();
#endif
        __syncthreads();
        *(LAS u32x4*)(Ks + (tid >> 4) * KS_STRIDE + (tid & 15) * 8) = kreg[0]; *(LAS u32x4*)(Ks + (32 + (tid >> 4)) * KS_STRIDE + (tid & 15) * 8) = kreg[1];
        *(LAS u32x4*)(Ks + (tid >> 3) * KS_STRIDE + 128 + (tid & 7) * 8) = kreg[2];
#pragma unroll
        for (int i = 0; i < 2; ++i) {
            LAS u32x2* d = (LAS u32x2*)(Vs + ((tid >> 3) + 64 * i) * VS_STRIDE + ((tid & 7) >> 1) * 16 + (tid & 1) * 4);
            u32x2 lo; lo.x = vreg[i].x; lo.y = vreg[i].y; u32x2 hi; hi.x = vreg[i].z; hi.y = vreg[i].w; d[0] = lo; d[2] = hi; }
        __syncthreads();
        const bool comp = wave_active && tt <= wlim;
        if (tt + 1 < ntile) ATT_GLOAD(tt + 1);
        if (comp) {
            f32x16 sacc[2];
#pragma unroll
            for (int b = 0; b < 2; ++b)
#pragma unroll
                for (int j = 0; j < 16; ++j) sacc[b][j] = z0;
#ifdef PROBE_ATT_QK2
            {
            __builtin_amdgcn_sched_barrier(0);
            {
                const LAS bf16_t* kb0 = Ks + r * KS_STRIDE + 8 * hh;
                bf16x8 kf[6];
#pragma unroll
                for (int i = 0; i < 6; ++i) kf[i] = *(const LAS bf16x8*)(kb0 + 16 * i);
#pragma unroll
                for (int i = 0; i < 24; ++i) { sacc[i / 12] = __builtin_amdgcn_mfma_f32_32x32x16_bf16(kf[i % 6], qf[i % 12], sacc[i / 12], 0, 0, 0);
                    if (i + 6 < 24) kf[i % 6] = *(const LAS bf16x8*)(kb0 + ((i + 6) / 12) * 32 * KS_STRIDE + 16 * ((i + 6) % 12)); }
                __builtin_amdgcn_sched_group_barrier(0x100, 6, 0);
#pragma unroll
                for (int i = 0; i < 18; ++i) { __builtin_amdgcn_sched_group_barrier(0x008, 1, 0); __builtin_amdgcn_sched_group_barrier(0x100, 1, 0); }
                __builtin_amdgcn_sched_group_barrier(0x008, 6, 0);
            }
            __builtin_amdgcn_sched_barrier(0);
                asm volatile("" : "+v"(sacc[0][0]), "+v"(sacc[1][0]));
#pragma unroll
                for (int b = 0; b < 2; ++b)
#pragma unroll
                    for (int j = 0; j < 16; ++j) sacc[b][j] = z0;
            }
#endif
            __builtin_amdgcn_sched_barrier(0);
            {
                const LAS bf16_t* kb0 = Ks + r * KS_STRIDE + 8 * hh;
                bf16x8 kf[6];
#pragma unroll
                for (int i = 0; i < 6; ++i) kf[i] = *(const LAS bf16x8*)(kb0 + 16 * i);
#pragma unroll
                for (int i = 0; i < 24; ++i) { sacc[i / 12] = __builtin_amdgcn_mfma_f32_32x32x16_bf16(kf[i % 6], qf[i % 12], sacc[i / 12], 0, 0, 0);
                    if (i + 6 < 24) kf[i % 6] = *(const LAS bf16x8*)(kb0 + ((i + 6) / 12) * 32 * KS_STRIDE + 16 * ((i + 6) % 12)); }
                __builtin_amdgcn_sched_group_barrier(0x100, 6, 0);
#pragma unroll
                for (int i = 0; i < 18; ++i) { __builtin_amdgcn_sched_group_barrier(0x008, 1, 0); __builtin_amdgcn_sched_group_barrier(0x100, 1, 0); }
                __builtin_amdgcn_sched_group_barrier(0x008, 6, 0);
            }
            __builtin_amdgcn_sched_barrier(0);
            if (tt == 0) {
#pragma unroll
                for (int j = 8; j < 16; ++j) sacc[0][j] = -INFINITY;
#pragma unroll
                for (int j = 0; j < 16; ++j) sacc[1][j] = -INFINITY; }
            float tmax = fmaxf(sacc[0][0], sacc[1][0]);
#pragma unroll
            for (int j = 1; j < 16; ++j) tmax = fmaxf(tmax, fmaxf(sacc[0][j], sacc[1][j]));
            tmax = fmaxf(tmax, __int_as_float(__builtin_amdgcn_ds_bpermute((lane ^ 32) << 2, __float_as_int(tmax)))) * sc;
            const float mnew = fmaxf(mrun, tmax); const float alpha = __builtin_amdgcn_exp2f(mrun - mnew); mrun = mnew;
            float psum = 0.f;
#pragma unroll
            for (int b = 0; b < 2; ++b)
#pragma unroll
                for (int j = 0; j < 16; ++j) { const float p = __builtin_amdgcn_exp2f(__builtin_fmaf(sacc[b][j], sc, -mnew)); sacc[b][j] = p; psum += p; }
            lsum = lsum * alpha + psum;
            if (__builtin_amdgcn_ballot_w64(alpha != 1.0f) != 0ull) {
#pragma unroll
            for (int i = 0; i < 4; ++i)
#pragma unroll
                for (int j = 0; j < 16; ++j) oacc[i][j] *= alpha; }
            bf16x8 pf[4];
            pf[0] = pack8(sacc[0], 0); pf[1] = pack8(sacc[0], 1); pf[2] = pack8(sacc[1], 0); pf[3] = pack8(sacc[1], 1);
#ifdef PROBE_ATT_PV2
            {
                const LAS bf16_t* vb0 = Vs + r * VS_STRIDE + 8 * hh;
#pragma unroll
                for (int j = 0; j < 16; ++j) { sacc[0][j] = z0; sacc[1][j] = z0; }
#pragma unroll
                for (int i = 0; i < 16; ++i) { const bf16x8 vfd = *(const LAS bf16x8*)(vb0 + 32 * (i >> 2) * VS_STRIDE + 16 * (i & 3));
                    sacc[i & 1] = __builtin_amdgcn_mfma_f32_32x32x16_bf16(vfd, pf[i & 3], sacc[i & 1], 0, 0, 0); }
                asm volatile("" :: "v"(sacc[0][0]), "v"(sacc[1][0]));
            }
#endif
            __builtin_amdgcn_sched_barrier(0);
            {
                const LAS bf16_t* vb0 = Vs + r * VS_STRIDE + 8 * hh;
                bf16x8 vf[16];
#pragma unroll
                for (int i = 0; i < 16; ++i) vf[i] = *(const LAS bf16x8*)(vb0 + 32 * (i >> 2) * VS_STRIDE + 16 * (i & 3));
#pragma unroll
                for (int i = 0; i < 16; ++i) oacc[i >> 2] = __builtin_amdgcn_mfma_f32_32x32x16_bf16(vf[i], pf[i & 3], oacc[i >> 2], 0, 0, 0);
                __builtin_amdgcn_sched_group_barrier(0x100, 8, 1);
#pragma unroll
                for (int i = 0; i < 8; ++i) { __builtin_amdgcn_sched_group_barrier(0x008, 1, 1); __builtin_amdgcn_sched_group_barrier(0x100, 1, 1); }
                __builtin_amdgcn_sched_group_barrier(0x008, 8, 1);
            }
            __builtin_amdgcn_sched_barrier(0);
        }
    }
    if (wave_active) {
        const float ltot = lsum + __int_as_float(__builtin_amdgcn_ds_bpermute((lane ^ 32) << 2, __float_as_int(lsum))); const float inv = 1.0f / ltot;
        bf16_t* orow = MIX + (size_t)qrow * D + 128 * h;
#pragma unroll
        for (int dvb = 0; dvb < 4; ++dvb)
#pragma unroll
            for (int g = 0; g < 4; ++g) { u32x2 o; o.x = cvtpk(oacc[dvb][4 * g] * inv, oacc[dvb][4 * g + 1] * inv); o.y = cvtpk(oacc[dvb][4 * g + 2] * inv, oacc[dvb][4 * g + 3] * inv);
                *(GAS u32x2*)(orow + 32 * dvb + 8 * g + 4 * hh) = o; }
    }
    __syncthreads();
}
__device__ __forceinline__ void attn_phase(LAS unsigned char* lds, const bf16_t* Q, const bf16_t* KN, const bf16_t* KR, const bf16_t* VT, bf16_t* MIX, const float* rope, int bid, int nblk) {
    const int w = opq(threadIdx.x) >> 6;
    for (int s = bid; s < 512; s += nblk) {
        const int round = s >> 8, x = s & 255; const int bh = (x >> 4) + 16 * round, qb = round ? 15 - (x & 15) : (x & 15);
        const int b = bh >> 2, h = bh & 3;
        attn_unit(lds, Q, KN, KR, VT, MIX, rope, h, b * SEQ + 256 * qb, b * SEQ, 4 * qb + 5, 4 * qb + (w >> 1) + 1, true);
    }
    for (int s = bid; s < 4; s += nblk)
        attn_unit(lds, Q, KN, KR, VT, MIX, rope, s, RREAL, 0, 1, 0, w == 0);
}

constexpr int CLS = 72;
constexpr int CSLOT = 64 * CLS * 2;
constexpr int CHK_BYTES = 32768;
constexpr int NSEQ_HALF0 = 257;
struct CpP { const bf16_t* PR; const bf16_t* LO; const bf16_t* VMIX; const bf16_t* VFIRST; bf16_t* VP; float* RK; unsigned char* CHK;
    const float *mu, *w0, *a0, *k_k, *k_a, *r_k, *v0; int layer, pad; };

__device__ __forceinline__ void mm64(f32x16& acc, const LAS bf16_t* a, const LAS bf16_t* b, int r, int hh) {
    bf16x8 af[4], bf[4];
#pragma unroll
    for (int ks = 0; ks < 4; ++ks) { af[ks] = *(const LAS bf16x8*)(a + r * CLS + 16 * ks + 8 * hh); bf[ks] = *(const LAS bf16x8*)(b + r * CLS + 16 * ks + 8 * hh); }
#pragma unroll
    for (int ks = 0; ks < 4; ++ks) acc = __builtin_amdgcn_mfma_f32_32x32x16_bf16(af[ks], bf[ks], acc, 0, 0, 0);
}
__device__ __forceinline__ void st_tile(const f32x16& acc, LAS bf16_t* dst, int m0, int n0, int r, int hh) {
#pragma unroll
    for (int q = 0; q < 16; ++q) dst[(m0 + (q & 3) + 8 * (q >> 2) + 4 * hh) * CLS + n0 + r] = f2bf_hw(acc[q]);
}
__device__ __forceinline__ void st_tile_t(const f32x16& acc, LAS bf16_t* dst, int m0, int n0, int r, int hh) {
#pragma unroll
    for (int g = 0; g < 4; ++g) { u32x2 o; o.x = cvtpk(acc[4 * g], acc[4 * g + 1]); o.y = cvtpk(acc[4 * g + 2], acc[4 * g + 3]);
        *(LAS u32x2*)(dst + (n0 + r) * CLS + m0 + 8 * g + 4 * hh) = o; }
}
__device__ __forceinline__ void zero16(f32x16& a, float z) {
#pragma unroll
    for (int q = 0; q < 16; ++q) a[q] = z;
}
typedef float f32x2 __attribute__((ext_vector_type(2)));
struct CpRaw { unsigned xr[5], xk[5], xv[5], lw[4], la[4], vm[4], vf[4]; f32x2 mu_r, mu_k, mu_v, w0, a0, kkc, kac, rkc, v0; float pm0; };
__device__ __forceinline__ void cp_issue(const CpP& P, int row0, int hd, int w, int lane, CpRaw& R) {
    const int cp = lane & 31, rh = lane >> 5, c = hd * 64 + 2 * cp;
    R.mu_r = *(const GAS f32x2*)(P.mu + c); R.mu_k = *(const GAS f32x2*)(P.mu + 512 + c); R.mu_v = *(const GAS f32x2*)(P.mu + 1024 + c); R.w0 = *(const GAS f32x2*)(P.w0 + c); R.a0 = *(const GAS f32x2*)(P.a0 + c);
    R.kkc = *(const GAS f32x2*)(P.k_k + c); R.kac = *(const GAS f32x2*)(P.k_a + c); R.rkc = *(const GAS f32x2*)(P.r_k + c);
    if (P.layer) R.v0 = *(const GAS f32x2*)(P.v0 + c); else { R.v0.x = 0.f; R.v0.y = 0.f; }
    const int rw0 = row0 + 8 * w + 4 * rh; const int prow0 = (w == 0 && rh == 0) ? row_prev(row0) : rw0 - 1; R.pm0 = prow0 < 0 ? 0.f : 1.f;
    { const bf16_t* xp = P.PR + (size_t)(prow0 < 0 ? rw0 : prow0) * PRW + c; R.xr[0] = *(const GAS unsigned*)xp; R.xk[0] = *(const GAS unsigned*)(xp + 512); R.xv[0] = *(const GAS unsigned*)(xp + 1024); }
#pragma unroll
    for (int q = 0; q < 4; ++q) { const bf16_t* x = P.PR + (size_t)(rw0 + q) * PRW + c; R.xr[q + 1] = *(const GAS unsigned*)x; R.xk[q + 1] = *(const GAS unsigned*)(x + 512); R.xv[q + 1] = *(const GAS unsigned*)(x + 1024);
        const bf16_t* lo = P.LO + (size_t)(rw0 + q) * 1536 + c; R.lw[q] = *(const GAS unsigned*)lo; R.la[q] = *(const GAS unsigned*)(lo + 512);
        if (P.layer) { R.vm[q] = *(const GAS unsigned*)(P.VMIX + (size_t)(rw0 + q) * 512 + c); R.vf[q] = *(const GAS unsigned*)(P.VFIRST + (size_t)(rw0 + q) * 512 + c); } else { R.vm[q] = 0u; R.vf[q] = 0u; } }
}
__device__ __forceinline__ float bfl(unsigned u) { return __uint_as_float(u << 16); }
__device__ __forceinline__ float bfh(unsigned u) { return __uint_as_float(u & 0xffff0000u); }
__device__ __forceinline__ float half_tot(float v) {
    v += DPP_F(v, 0xB1, 0xf); v += DPP_F(v, 0x4E, 0xf); v += DPP_F(v, 0x141, 0xf); v += DPP_F(v, 0x140, 0xf); v += DPP_F(v, 0x142, 0xa); return v; }
__device__ __forceinline__ void rwkv_cp_task(LAS unsigned char* lds, const CpP& P, int row0, int hd, unsigned char* out, CpRaw& R, bool has_next, int nrow0, int nhd) {
    const int tid = opq(threadIdx.x), lane = tid & 63, w = __builtin_amdgcn_readfirstlane(tid >> 6), r = lane & 31, hh = lane >> 5;
    float z0 = 0.f; asm volatile("" : "+v"(z0));
    LAS bf16_t* S_ATtm = (LAS bf16_t*)(lds + 0 * CSLOT);
    LAS bf16_t* S_BHtm = (LAS bf16_t*)(lds + 1 * CSLOT);
    LAS bf16_t* S_KHtm = (LAS bf16_t*)(lds + 2 * CSLOT);
    LAS bf16_t* S_RTtm = (LAS bf16_t*)(lds + 3 * CSLOT);
    LAS bf16_t* S_ATcm = (LAS bf16_t*)(lds + 4 * CSLOT);
    LAS bf16_t* S_BBcm = (LAS bf16_t*)(lds + 5 * CSLOT);
    LAS bf16_t* S_KBcm = (LAS bf16_t*)(lds + 6 * CSLOT);
    LAS bf16_t* S_VTcm = (LAS bf16_t*)(lds + 7 * CSLOT);
    LAS bf16_t* S_Q0a = (LAS bf16_t*)(lds + 8 * CSLOT);
    LAS bf16_t* S_Q0b = (LAS bf16_t*)(lds + 9 * CSLOT);
    LAS bf16_t* S_PP0 = (LAS bf16_t*)(lds + 10 * CSLOT);
    LAS bf16_t* S_Na = (LAS bf16_t*)(lds + 11 * CSLOT);
    LAS bf16_t* S_XT = (LAS bf16_t*)(lds + 12 * CSLOT);
    LAS bf16_t* S_Pa = (LAS bf16_t*)(lds + 13 * CSLOT);
    LAS bf16_t* S_Qa = (LAS bf16_t*)(lds + 14 * CSLOT);
    LAS float* S_TOT = (LAS float*)(lds + 15 * CSLOT);
    LAS bf16_t* Qa[2] = {S_Q0a, S_ATtm}; LAS bf16_t* Qb[2] = {S_Q0b, S_BHtm}; LAS bf16_t* PPa[2] = {S_PP0, S_KHtm};

    {
        const int cp = lane & 31, rh = lane >> 5, c = hd * 64 + 2 * cp;
        const f32x2 mu_r = R.mu_r, mu_k = R.mu_k, mu_v = R.mu_v, w0 = R.w0, a0 = R.a0, kkc = R.kkc, kac = R.kac, rkc = R.rkc, v0 = R.v0; const float pm0 = R.pm0;
        float fr[4][2], fk[4][2], fv[4][2], fa[4][2], fb[4][2], lw[4][2];
        const int rw0 = row0 + 8 * w + 4 * rh;
        constexpr float L2E = 1.4426950408889634f;
#pragma unroll
        for (int q = 0; q < 4; ++q) { const int row = rw0 + q; const bool valid = row < RVALID; const float pm = q == 0 ? pm0 : 1.f;
            float rr[2] = {bfl(R.xr[q + 1]), bfh(R.xr[q + 1])}, kk[2] = {bfl(R.xk[q + 1]), bfh(R.xk[q + 1])}, vv[2] = {bfl(R.xv[q + 1]), bfh(R.xv[q + 1])};
            const float pr[2] = {bfl(R.xr[q]), bfh(R.xr[q])}, pk[2] = {bfl(R.xk[q]), bfh(R.xk[q])}, pv[2] = {bfl(R.xv[q]), bfh(R.xv[q])};
            const float wpre[2] = {bfl(R.lw[q]), bfh(R.lw[q])}, apre[2] = {bfl(R.la[q]), bfh(R.la[q])};
            float lwv[2], asig[2], kkr[2], k2[2], kn[2];
#pragma unroll
            for (int e = 0; e < 2; ++e) {
                rr[e] = rr[e] + (pm * pr[e] - rr[e]) * mu_r[e]; kk[e] = kk[e] + (pm * pk[e] - kk[e]) * mu_k[e]; vv[e] = vv[e] + (pm * pv[e] - vv[e]) * mu_v[e];
                lwv[e] = -0.6065306597126334f * __builtin_amdgcn_rcpf(1.0f + __builtin_amdgcn_exp2f(-(w0[e] + wpre[e]) * L2E));
                asig[e] = __builtin_amdgcn_rcpf(1.0f + __builtin_amdgcn_exp2f(-(a0[e] + apre[e]) * L2E));
                kkr[e] = kk[e] * kkc[e]; k2[e] = kk[e] * (1.f + (asig[e] - 1.f) * kac[e]); }
            if (P.layer) { const float vm[2] = {bfl(R.vm[q]), bfh(R.vm[q])}, vf[2] = {bfl(R.vf[q]), bfh(R.vf[q])};
#pragma unroll
                for (int e = 0; e < 2; ++e) vv[e] = vv[e] + (vf[e] - vv[e]) * __builtin_amdgcn_rcpf(1.0f + __builtin_amdgcn_exp2f(-(v0[e] + vm[e]) * L2E)); }
            const float sst = half_tot(kkr[0] * kkr[0] + kkr[1] * kkr[1]);
            const float rkt = half_tot(rr[0] * k2[0] * rkc[0] + rr[1] * k2[1] * rkc[1]);
            const float ss0 = __int_as_float(__builtin_amdgcn_readlane(__float_as_int(sst), 31)), ss1 = __int_as_float(__builtin_amdgcn_readlane(__float_as_int(sst), 63));
            const float rs = rsqrtf(fmaxf(rh ? ss1 : ss0, 1e-24f));
            kn[0] = kkr[0] * rs; kn[1] = kkr[1] * rs;
            if (!valid) {
#pragma unroll
                for (int e = 0; e < 2; ++e) { rr[e] = 0.f; k2[e] = 0.f; vv[e] = 0.f; kn[e] = 0.f; lwv[e] = 0.f; } }
            *(GAS unsigned*)(P.VP + (size_t)row * 512 + c) = cvtpk(vv[0], vv[1]); if (cp == 31) ((GAS float*)P.RK)[(size_t)row * 8 + hd] = valid ? rkt : 0.f;
#pragma unroll
            for (int e = 0; e < 2; ++e) { fr[q][e] = rr[e]; fk[q][e] = k2[e]; fv[q][e] = vv[e]; fa[q][e] = -kn[e]; fb[q][e] = kn[e] * asig[e]; lw[q][e] = lwv[e]; } }
        if (has_next) cp_issue(P, nrow0, nhd, w, lane, R);
        float cum[4][2], hoff[2];
#pragma unroll
        for (int e = 0; e < 2; ++e) { cum[0][e] = lw[0][e];
#pragma unroll
            for (int q = 1; q < 4; ++q) cum[q][e] = cum[q - 1][e] + lw[q][e];
            const float pt = __int_as_float(__builtin_amdgcn_ds_bpermute((lane ^ 32) << 2, __float_as_int(cum[3][e]))); hoff[e] = rh ? pt : 0.f; }
        if (rh) { f32x2 t2; t2.x = hoff[0] + cum[3][0]; t2.y = hoff[1] + cum[3][1]; *(LAS f32x2*)(S_TOT + w * 64 + 2 * cp) = t2; }
        lds_barrier();
        float off[2] = {0.f, 0.f}, tot[2] = {0.f, 0.f};
#pragma unroll
        for (int ww = 0; ww < 8; ++ww) { const f32x2 tv = *(const LAS f32x2*)(S_TOT + ww * 64 + 2 * cp); off[0] += ww < w ? tv.x : 0.f; off[1] += ww < w ? tv.y : 0.f; tot[0] += tv.x; tot[1] += tv.y; }
        const float etot[2] = {__builtin_amdgcn_exp2f(tot[0] * L2E), __builtin_amdgcn_exp2f(tot[1] * L2E)};
        if (w == 0 && rh == 0) { f32x2 t2; t2.x = etot[0]; t2.y = etot[1]; *(LAS f32x2*)(S_TOT + 512 + 2 * cp) = t2; }
        float at[4][2], bh[4][2], kh[4][2], rt[4][2], bb[4][2], kb[4][2];
#pragma unroll
        for (int e = 0; e < 2; ++e) { const float base = off[e] + hoff[e];
            float ecprev = __builtin_amdgcn_exp2f(base * L2E);
#pragma unroll
            for (int q = 0; q < 4; ++q) { const float ci = base + cum[q][e]; const float ec = __builtin_amdgcn_exp2f(ci * L2E), ecp = ecprev, en = __builtin_amdgcn_rcpf(ec), ee = etot[e] * en; ecprev = ec;
                rt[q][e] = fr[q][e] * ec; at[q][e] = fa[q][e] * ecp; bh[q][e] = fb[q][e] * en; kh[q][e] = fk[q][e] * en; bb[q][e] = fb[q][e] * ee; kb[q][e] = fk[q][e] * ee; } }
#pragma unroll
        for (int q = 0; q < 4; ++q) { const int t = 8 * w + 4 * rh + q;
            *(LAS unsigned*)(S_ATtm + t * CLS + 2 * cp) = cvtpk(at[q][0], at[q][1]); *(LAS unsigned*)(S_BHtm + t * CLS + 2 * cp) = cvtpk(bh[q][0], bh[q][1]);
            *(LAS unsigned*)(S_KHtm + t * CLS + 2 * cp) = cvtpk(kh[q][0], kh[q][1]); *(LAS unsigned*)(S_RTtm + t * CLS + 2 * cp) = cvtpk(rt[q][0], rt[q][1]); }
#pragma unroll
        for (int e = 0; e < 2; ++e) { const int jo = (2 * cp + e) * CLS + 8 * w + 4 * rh; u32x2 o;
            o.x = cvtpk(at[0][e], at[1][e]); o.y = cvtpk(at[2][e], at[3][e]); *(LAS u32x2*)(S_ATcm + jo) = o;
            o.x = cvtpk(bb[0][e], bb[1][e]); o.y = cvtpk(bb[2][e], bb[3][e]); *(LAS u32x2*)(S_BBcm + jo) = o;
            o.x = cvtpk(kb[0][e], kb[1][e]); o.y = cvtpk(kb[2][e], kb[3][e]); *(LAS u32x2*)(S_KBcm + jo) = o;
            o.x = cvtpk(fv[0][e], fv[1][e]); o.y = cvtpk(fv[2][e], fv[3][e]); *(LAS u32x2*)(S_VTcm + jo) = o; }
    }
    lds_barrier();
    const int q4 = w & 3, mb = q4 >> 1, nb = q4 & 1; const bool upper = (mb == 0 && nb == 1);
    f32x16 pacc;
    {
        f32x16 a0, a1; zero16(a0, z0); zero16(a1, z0);
        const LAS bf16_t* lhs = (w < 4 ? S_ATtm : S_RTtm) + 32 * mb * CLS;
        if (!upper) { mm64(a0, lhs, S_BHtm + 32 * nb * CLS, r, hh); mm64(a1, lhs, S_KHtm + 32 * nb * CLS, r, hh); }
        const int s = 32 * nb + r;
#pragma unroll
        for (int q = 0; q < 16; ++q) { const int t = 32 * mb + (q & 3) + 8 * (q >> 2) + 4 * hh; const bool keep = w < 4 ? (s < t) : (s <= t); if (!keep) { a0[q] = z0; a1[q] = z0; } }
        if (w < 4) { st_tile(a0, S_Q0a, 32 * mb, 32 * nb, r, hh); st_tile_t(a0, S_Q0b, 32 * mb, 32 * nb, r, hh); st_tile(a1, S_Na, 32 * mb, 32 * nb, r, hh);
            pacc = a0;
#pragma unroll
            for (int q = 0; q < 16; ++q) { const int t = 32 * mb + (q & 3) + 8 * (q >> 2) + 4 * hh; if (t == s) pacc[q] += 1.0f; }
            st_tile(pacc, S_PP0, 32 * mb, 32 * nb, r, hh); }
        else { st_tile(a0, S_Pa, 32 * mb, 32 * nb, r, hh); st_tile(a1, S_Qa, 32 * mb, 32 * nb, r, hh); zero16(pacc, z0); }
    }
    lds_barrier();
    {
        f32x16 a; zero16(a, z0);
        if (w >= 4) { if (!upper) { mm64(a, Qa[0] + 32 * mb * CLS, Qb[0] + 32 * nb * CLS, r, hh); } st_tile(a, Qa[1], 32 * mb, 32 * nb, r, hh); st_tile_t(a, Qb[1], 32 * mb, 32 * nb, r, hh); }
        else { mm64(a, S_Na + 32 * mb * CLS, S_VTcm + 32 * nb * CLS, r, hh); st_tile_t(a, S_XT, 32 * mb, 32 * nb, r, hh); }
    }
    lds_barrier();
#pragma unroll 1
    for (int k = 1; k <= 5; ++k) {
        const int rs = k & 1, ws_ = rs ^ 1;
        if (w < 4) { if (!upper) mm64(pacc, PPa[ws_] + 32 * mb * CLS, Qb[rs] + 32 * nb * CLS, r, hh); st_tile(pacc, PPa[rs], 32 * mb, 32 * nb, r, hh); }
        else if (k < 5) { f32x16 a; zero16(a, z0); if (!upper) mm64(a, Qa[rs] + 32 * mb * CLS, Qb[rs] + 32 * nb * CLS, r, hh); st_tile(a, Qa[ws_], 32 * mb, 32 * nb, r, hh); st_tile_t(a, Qb[ws_], 32 * mb, 32 * nb, r, hh); }
        lds_barrier();
    }
    {
        f32x16 a; zero16(a, z0);
        mm64(a, PPa[1] + 32 * mb * CLS, (w < 4 ? S_ATcm : S_XT) + 32 * nb * CLS, r, hh);
        st_tile_t(a, w < 4 ? S_Q0a : S_Q0b, 32 * mb, 32 * nb, r, hh);
    }
    lds_barrier();
    {
        LAS bf16_t* W1T = S_Q0a; LAS bf16_t* U1T = S_Q0b;
        f32x16 a, b; zero16(a, z0); zero16(b, z0);
        GAS u32x4* o128 = (GAS u32x4*)out;
        if (w < 4) {
            mm64(a, S_BBcm + 32 * mb * CLS, U1T + 32 * nb * CLS, r, hh); mm64(a, S_KBcm + 32 * mb * CLS, S_VTcm + 32 * nb * CLS, r, hh);
            mm64(b, W1T + 32 * mb * CLS, S_BBcm + 32 * nb * CLS, r, hh);
            const float gam = S_TOT[512 + 32 * nb + r];
#pragma unroll
            for (int q = 0; q < 16; ++q) { const int j = 32 * mb + (q & 3) + 8 * (q >> 2) + 4 * hh; if (j == 32 * nb + r) b[q] += gam; }
            u32x4 h0, h1, g0, g1;
            h0.x = cvtpk(a[0], a[1]); h0.y = cvtpk(a[2], a[3]); h0.z = cvtpk(a[4], a[5]); h0.w = cvtpk(a[6], a[7]);
            h1.x = cvtpk(a[8], a[9]); h1.y = cvtpk(a[10], a[11]); h1.z = cvtpk(a[12], a[13]); h1.w = cvtpk(a[14], a[15]);
            g0.x = cvtpk(b[0], b[1]); g0.y = cvtpk(b[2], b[3]); g0.z = cvtpk(b[4], b[5]); g0.w = cvtpk(b[6], b[7]);
            g1.x = cvtpk(b[8], b[9]); g1.y = cvtpk(b[10], b[11]); g1.z = cvtpk(b[12], b[13]); g1.w = cvtpk(b[14], b[15]);
            o128[1024 + ((mb * 2 + nb) * 64 + lane) * 2] = h0; o128[1024 + ((mb * 2 + nb) * 64 + lane) * 2 + 1] = h1;
            o128[(nb * 4 + 2 * mb) * 64 + lane] = g0; o128[(nb * 4 + 2 * mb + 1) * 64 + lane] = g1;
        } else {
            mm64(a, S_Pa + 32 * mb * CLS, U1T + 32 * nb * CLS, r, hh); mm64(a, S_Qa + 32 * mb * CLS, S_VTcm + 32 * nb * CLS, r, hh);
            mm64(b, W1T + 32 * mb * CLS, S_Pa + 32 * nb * CLS, r, hh);
#pragma unroll
            for (int g = 0; g < 4; ++g) { const s16x4 rv = *(const LAS s16x4*)(S_RTtm + (32 * nb + r) * CLS + 32 * mb + 8 * g + 4 * hh);
#pragma unroll
                for (int e = 0; e < 4; ++e) b[4 * g + e] += bf2f((bf16_t)rv[e]); }
            u32x4 y0, y1, r0, r1;
            y0.x = cvtpk(a[0], a[1]); y0.y = cvtpk(a[2], a[3]); y0.z = cvtpk(a[4], a[5]); y0.w = cvtpk(a[6], a[7]);
            y1.x = cvtpk(a[8], a[9]); y1.y = cvtpk(a[10], a[11]); y1.z = cvtpk(a[12], a[13]); y1.w = cvtpk(a[14], a[15]);
            r0.x = cvtpk(b[0], b[1]); r0.y = cvtpk(b[2], b[3]); r0.z = cvtpk(b[4], b[5]); r0.w = cvtpk(b[6], b[7]);
            r1.x = cvtpk(b[8], b[9]); r1.y = cvtpk(b[10], b[11]); r1.z = cvtpk(b[12], b[13]); r1.w = cvtpk(b[14], b[15]);
            o128[1536 + ((mb * 2 + nb) * 64 + lane) * 2] = y0; o128[1536 + ((mb * 2 + nb) * 64 + lane) * 2 + 1] = y1;
            o128[512 + (nb * 4 + 2 * mb) * 64 + lane] = r0; o128[512 + (nb * 4 + 2 * mb + 1) * 64 + lane] = r1;
        }
    }
    lds_barrier();
}

struct ScP { const unsigned char* CHK; bf16_t* YS; };
__device__ __forceinline__ void scan_unpack16(f32x16& acc, const u32x4 y0, const u32x4 y1) {
    acc[0] = __uint_as_float(y0.x << 16); acc[1] = __uint_as_float(y0.x & 0xffff0000u); acc[2] = __uint_as_float(y0.y << 16); acc[3] = __uint_as_float(y0.y & 0xffff0000u);
    acc[4] = __uint_as_float(y0.z << 16); acc[5] = __uint_as_float(y0.z & 0xffff0000u); acc[6] = __uint_as_float(y0.w << 16); acc[7] = __uint_as_float(y0.w & 0xffff0000u);
    acc[8] = __uint_as_float(y1.x << 16); acc[9] = __uint_as_float(y1.x & 0xffff0000u); acc[10] = __uint_as_float(y1.y << 16); acc[11] = __uint_as_float(y1.y & 0xffff0000u);
    acc[12] = __uint_as_float(y1.z << 16); acc[13] = __uint_as_float(y1.z & 0xffff0000u); acc[14] = __uint_as_float(y1.w << 16); acc[15] = __uint_as_float(y1.w & 0xffff0000u);
}
__device__ __forceinline__ void scan_step(const LAS unsigned char* sl, LAS float* ybuf, f32x16 (&st)[2], int w, int lane, int r, int hh) {
    bf16x8 ar[2][4], ag[2][4]; u32x4 yi[2][2], hi[2][2];
#pragma unroll
    for (int tb = 0; tb < 2; ++tb) { const LAS u32x4* yf = (const LAS u32x4*)(sl + 24576) + ((tb * 2 + w) * 64 + lane) * 2; yi[tb][0] = yf[0]; yi[tb][1] = yf[1];
        const LAS u32x4* hf = (const LAS u32x4*)(sl + 16384) + ((tb * 2 + w) * 64 + lane) * 2; hi[tb][0] = hf[0]; hi[tb][1] = hf[1];
#pragma unroll
        for (int ks = 0; ks < 4; ++ks) { ar[tb][ks] = *(const LAS bf16x8*)(sl + 8192 + ((tb * 4 + ks) * 64 + lane) * 16); ag[tb][ks] = *(const LAS bf16x8*)(sl + ((tb * 4 + ks) * 64 + lane) * 16); } }
    bf16x8 sf[4];
    sf[0] = pack8(st[0], 0); sf[1] = pack8(st[0], 1); sf[2] = pack8(st[1], 0); sf[3] = pack8(st[1], 1);
    f32x16 ya[2], sa[2];
#pragma unroll
    for (int tb = 0; tb < 2; ++tb) { scan_unpack16(ya[tb], yi[tb][0], yi[tb][1]); scan_unpack16(sa[tb], hi[tb][0], hi[tb][1]); }
#pragma unroll
    for (int ks = 0; ks < 4; ++ks) {
        ya[0] = __builtin_amdgcn_mfma_f32_32x32x16_bf16(ar[0][ks], sf[ks], ya[0], 0, 0, 0); ya[1] = __builtin_amdgcn_mfma_f32_32x32x16_bf16(ar[1][ks], sf[ks], ya[1], 0, 0, 0);
        sa[0] = __builtin_amdgcn_mfma_f32_32x32x16_bf16(ag[0][ks], sf[ks], sa[0], 0, 0, 0); sa[1] = __builtin_amdgcn_mfma_f32_32x32x16_bf16(ag[1][ks], sf[ks], sa[1], 0, 0, 0); }
    st[0] = sa[0]; st[1] = sa[1];
#pragma unroll
    for (int tb = 0; tb < 2; ++tb)
#pragma unroll
        for (int q = 0; q < 16; ++q) ybuf[(32 * tb + (q & 3) + 8 * (q >> 2) + 4 * hh) * 64 + 32 * w + r] = ya[tb][q];
}
__device__ __forceinline__ void rwkv_scan_unit(LAS unsigned char* lds, const ScP& P, int seq0, int seqm, int nmeta, int nreal, int brow0, int hd, bool write_meta, const float* st_in, float* st_out) {
    const int tid = opq(threadIdx.x), lane = tid & 63, w = __builtin_amdgcn_readfirstlane(tid >> 6), r = lane & 31, hh = lane >> 5;
    const int N = nmeta + nreal;
    float z0 = 0.f; asm volatile("" : "+v"(z0));
    LAS float* ybuf = (LAS float*)(lds + 65536);
    f32x16 st[2]; zero16(st[0], z0); zero16(st[1], z0);
    if (st_in != nullptr && w < 2) { const GAS f32x4* sp = (const GAS f32x4*)(st_in + ((size_t)w * 64 + lane) * 32);
#pragma unroll
        for (int i = 0; i < 8; ++i) { const f32x4 v = sp[i];
#pragma unroll
            for (int j = 0; j < 4; ++j) st[i >> 2][4 * (i & 3) + j] = v[j]; } }
    const int c = hd * 64 + lane;
#define SCAN_SRC(n_) ((const GAS u32x4*)(P.CHK + ((size_t)((n_) < nmeta ? seqm : seq0 + (n_) - nmeta) * 8 + hd) * CHK_BYTES))
    u32x4 pa[4], pb[4], pc[4];
    { const GAS u32x4* s0 = SCAN_SRC(0); const GAS u32x4* s1 = SCAN_SRC(1); const GAS u32x4* s2 = SCAN_SRC(2);
#pragma unroll
      for (int i = 0; i < 4; ++i) pc[i] = s0[tid + 512 * i];
#pragma unroll
      for (int i = 0; i < 4; ++i) pa[i] = s1[tid + 512 * i];
#pragma unroll
      for (int i = 0; i < 4; ++i) pb[i] = s2[tid + 512 * i];
#pragma unroll
      for (int i = 0; i < 4; ++i) *(LAS u32x4*)(lds + (tid + 512 * i) * 16) = pc[i]; }
    lds_barrier();
#define SCAN_ITER(n_, PCUR, PMID, PNEXT) do { \
        const int n = (n_); \
        if (n + 3 < N) { const GAS u32x4* s3 = SCAN_SRC(n + 3); _Pragma("unroll") for (int i = 0; i < 4; ++i) PNEXT[i] = s3[tid + 512 * i]; } \
        if (w < 2) scan_step(lds + (n & 1) * 32768, ybuf, st, w, lane, r, hh); \
        lds_barrier(); \
        if (n + 1 < N) { _Pragma("unroll") for (int i = 0; i < 4; ++i) *(LAS u32x4*)(lds + ((n + 1) & 1) * 32768 + (tid + 512 * i) * 16) = PCUR[i]; } \
        if (w >= 2) { const int crow0 = n < nmeta ? RREAL : brow0 + 64 * (n - nmeta); const int nrow = n < nmeta ? (write_meta ? NMETA : 0) : 64; \
            for (int t = w - 2; t < nrow; t += 6) ((GAS bf16_t*)P.YS)[(size_t)(crow0 + t) * 512 + c] = f2bf_hw(ybuf[t * 64 + lane]); } \
        lds_barrier(); } while (0)
    int n3 = 0;
#pragma unroll 1
    for (; n3 + 3 <= N; n3 += 3) { SCAN_ITER(n3, pa, pb, pc); SCAN_ITER(n3 + 1, pb, pc, pa); SCAN_ITER(n3 + 2, pc, pa, pb); }
    if (N - n3 >= 1) SCAN_ITER(n3, pa, pb, pc);
    if (N - n3 >= 2) SCAN_ITER(n3 + 1, pb, pc, pa);
#undef SCAN_ITER
#undef SCAN_SRC
    if (st_out != nullptr && w < 2) { GAS f32x4* sp = (GAS f32x4*)(st_out + ((size_t)w * 64 + lane) * 32);
#pragma unroll
        for (int i = 0; i < 8; ++i) { f32x4 v;
#pragma unroll
            for (int j = 0; j < 4; ++j) v[j] = st[i >> 2][4 * (i & 3) + j];
            sp[i] = v; } }
}
struct PostP { const bf16_t* YS; const bf16_t* VP; const float* RK; const bf16_t* LO; bf16_t* MIX; const float *ln_w, *ln_b; };
__device__ __forceinline__ void rwkv_post(const PostP& P, int q, int rlo, int rhi, bool with_meta, int gw, int ngw, int lane) {
    lane = opq(lane);
    const int nreal = (rhi - rlo) * 8, ntot = nreal + (with_meta ? NMETA * 8 : 0);
    for (int item = gw; item < ntot; item += ngw) { const int ri = rlo + (item >> 3); const int row = item < nreal ? (ri >> 10) * SEQ + 1024 * q + (ri & 1023) : RREAL + ((item - nreal) >> 3); const int hd = item & 7, c = hd * 64 + lane;
        const float y = bf2f(P.YS[(size_t)row * 512 + c]); const float g = bf2f(P.LO[(size_t)row * 1536 + 1024 + c]), vp = bf2f(P.VP[(size_t)row * 512 + c]), rk = P.RK[(size_t)row * 8 + hd];
        const float mean = wave_sum(y) * (1.f / 64.f); const float d = y - mean; const float var = wave_sum(d * d) * (1.f / 64.f);
        const float yn = d * rsqrtf(var + GN_EPS) * P.ln_w[c] + P.ln_b[c];
        P.MIX[(size_t)row * D + 512 + c] = f2bf_hw((yn + rk * vp) * g); }
}

constexpr int LDS_BYTES = 147456, LDS_MISC = LDS_BYTES - 512;
struct Params { const float* in[33]; float* out; unsigned char* ws; };
constexpr int CW_BAR = 4096;


#ifndef PROBE_REP_MISC
#define PROBE_REP_MISC 1
#endif
#ifndef MOE_TAIL
#define MOE_TAIL 0
#endif
#ifndef PROBE_REP_OUTPROJ
#define PROBE_REP_OUTPROJ 1
#endif
#ifndef PROBE_REP_FFNDN
#define PROBE_REP_FFNDN 1
#endif
#ifndef PROBE_REP_MOEDN
#define PROBE_REP_MOEDN 1
#endif
#ifndef PROBE_REP_NORM
#define PROBE_REP_NORM 1
#endif
#ifndef PROBE_REP_INPROJ
#define PROBE_REP_INPROJ 1
#endif
#ifndef PROBE_REP_PREP
#define PROBE_REP_PREP 1
#endif
#ifndef PROBE_REP_P4A
#define PROBE_REP_P4A 1
#endif
#ifndef PROBE_REP_ATT
#define PROBE_REP_ATT 1
#endif
#ifndef PROBE_REP_P4B
#define PROBE_REP_P4B 1
#endif
#ifndef PROBE_REP_CP
#define PROBE_REP_CP 1
#endif
#ifndef PROBE_REP_SCAN
#define PROBE_REP_SCAN 1
#endif
#ifndef PROBE_REP_FFNGU
#define PROBE_REP_FFNGU 1
#endif
#ifndef PROBE_REP_MOETR
#define PROBE_REP_MOETR 1
#endif
#ifndef PROBE_REP_GATHER
#define PROBE_REP_GATHER 1
#endif
#ifndef PROBE_REP_MOEGU
#define PROBE_REP_MOEGU 1
#endif
#define LDP(k) ((const float*)ldk(kp, 8 * (k)))
#define OUTP ((float*)ldk(kp, 264))
#define WSP ((unsigned char*)ldk(kp, 272))
#define NOINL __device__ __attribute__((noinline))
#define WAVE_IDS() const int tid = threadIdx.x, lane = tid & 63, wave = __builtin_amdgcn_readfirstlane(tid >> 6), bid = (int)blockIdx.x, nblk = (int)gridDim.x, gw = bid * 8 + wave, ngw = nblk * 8; (void)lane; (void)gw; (void)ngw
NOINL void f_p0(unsigned long long kp_, LAS unsigned char* lds) {
    const unsigned long long kp = kp_uniform(kp_); WAVE_IDS(); LAS float* scr = (LAS float*)(lds + wave * 8448);
    {
        unsigned* ctl = (unsigned*)(WSP + WS_CTL);
#pragma unroll 1
        for (int te = wave; te < 24; te += 8) { const int t = te >> 3, e = te & 7;
            const float* wt = t == 0 ? LDP(30) : (t == 1 ? LDP(31) : LDP(32));
            const f32x4 v = ((const f32x4*)(wt + (size_t)e * ((size_t)D * FFE) + (size_t)(bid % 256) * 14336))[lane];
            const float m = wave_max(fmaxf(fmaxf(fabsf(v.x), fabsf(v.y)), fmaxf(fabsf(v.z), fabsf(v.w))));
            if (lane == 0) atomicMax(&ctl[CW_WMAX + te], __float_as_uint(m)); } }
    { unsigned char* ws = WSP;
      ph_init(LDP(0), LDP(1), OUTP, (float*)(ws + WS_HMETA), (float*)(ws + WS_ROPE), LDP(23), LDP(24), (bf16_t*)(ws + WS_V1T), (size_t)bid * 512 + tid, (size_t)nblk * 512); }
    int rot = 0;
#pragma unroll 1
    for (int l = 0; l < 2; ++l) { unsigned char* lw = WSP + WS_WB + l * LW_STRIDE;
        { const TrJob J{LDP(5) + (size_t)l * D * 2624, nullptr, (bf16_t*)(lw + LW_WIN), D, 2624, 1024, 0, 1, 0}; ph_transpose(J, scr, gw, ngw, lane, rot); rot += (J.K / 64) * (J.N / 32); }
        { const TrJob J{LDP(9) + (size_t)l * 512 * 768, LDP(7) + l * 512, (bf16_t*)(lw + LW_WUQ), 512, 768, 512, 0, 0, 0}; ph_transpose(J, scr, gw, ngw, lane, rot); rot += (J.K / 64) * (J.N / 32); }
        { const TrJob J{LDP(10) + (size_t)l * 256 * 1024, LDP(8) + l * 256, (bf16_t*)(lw + LW_WK), 256, 1024, 256, 0, 4, 0}; ph_transpose(J, scr, gw, ngw, lane, rot); rot += (J.K / 64) * (J.N / 32); }
        { const TrJob J{LDP(13) + (size_t)l * 64 * 512, nullptr, (bf16_t*)(lw + LW_LORA), 64, 512, 256, 0, 0, 0}; ph_transpose(J, scr, gw, ngw, lane, rot); rot += (J.K / 64) * (J.N / 32); }
        { const TrJob J{LDP(15) + (size_t)l * 64 * 512, nullptr, (bf16_t*)(lw + LW_LORA), 64, 512, 256, 64, 0, 512}; ph_transpose(J, scr, gw, ngw, lane, rot); rot += (J.K / 64) * (J.N / 32); }
        { const TrJob J{LDP(16) + (size_t)l * 128 * 512, nullptr, (bf16_t*)(lw + LW_LORA), 128, 512, 256, 128, 0, 1024}; ph_transpose(J, scr, gw, ngw, lane, rot); rot += (J.K / 64) * (J.N / 32); }
        { const TrJob J{LDP(6) + (size_t)l * D * D, nullptr, (bf16_t*)(lw + LW_WOUT), D, D, 1024, 0, 0, 0}; ph_transpose(J, scr, gw, ngw, lane, rot); rot += (J.K / 64) * (J.N / 32); }
    }
    { const TrJob J{LDP(25), nullptr, (bf16_t*)(WSP + WS_FGU), D, FF0, 1024, 0, 2, 0}; ph_transpose(J, scr, gw, ngw, lane, rot); rot += (J.K / 64) * (J.N / 32); }
    { const TrJob J{LDP(26), nullptr, (bf16_t*)(WSP + WS_FGU), D, FF0, 1024, 0, 3, 0}; ph_transpose(J, scr, gw, ngw, lane, rot); rot += (J.K / 64) * (J.N / 32); }
    { const TrJob J{LDP(27), nullptr, (bf16_t*)(WSP + WS_FDN), FF0, D, FF0, 0, 0, 0}; ph_transpose(J, scr, gw, ngw, lane, rot); rot += (J.K / 64) * (J.N / 32); }
}
NOINL void f_rmsnorm(unsigned long long kp_, int which, int l) { const unsigned long long kp = kp_uniform(kp_); which = __builtin_amdgcn_readfirstlane(which); l = __builtin_amdgcn_readfirstlane(l); WAVE_IDS(); unsigned char* ws = WSP;
    const float* hsrc = (which == 0 && l == 0) ? LDP(0) : (const float*)OUTP;
    ph_rmsnorm(hsrc, (const float*)(ws + WS_HMETA), (which ? LDP(3) : LDP(2)) + l * D, (bf16_t*)(ws + A_U), (const float*)(ws + A_PART), which ? 4 : (l ? 11 : 0), gw, ngw, lane); }
NOINL void f_prep(unsigned long long kp_, int l) { const unsigned long long kp = kp_uniform(kp_); l = __builtin_amdgcn_readfirstlane(l); WAVE_IDS(); unsigned char* ws = WSP;
    ph_prep((const bf16_t*)(ws + A_PM), (const bf16_t*)(ws + A_PR), LDP(11) + l * 1792, (const float*)(ws + WS_ROPE), (float*)(ws + A_RSTDQ), (float*)(ws + A_RSTDKV),
            (bf16_t*)(ws + A_KROPE), (bf16_t*)(ws + A_LIN), (bf16_t*)(ws + A_VSH), l, gw, ngw, lane); }
constexpr int RW_NSEQ = 129;
constexpr size_t RW_BUF = (size_t)RW_NSEQ * 8 * CHK_BYTES;
static_assert(2 * RW_BUF <= A_VFIRST - A_CHK, "two chunk buffers fit the chunk region");
constexpr int RW_SKIP = 4;
__device__ __forceinline__ bool rw_is_scan_wg(int bid) { return (bid & 3) == 0; }
__device__ __forceinline__ int rw_rank(int bid) { return bid - (bid >> 2) - 1; }
__device__ __forceinline__ void f_rwkv_cp(unsigned long long kp_, LAS unsigned char* lds, int l, int q) {
    const unsigned long long kp = kp_uniform(kp_); l = __builtin_amdgcn_readfirstlane(l); q = __builtin_amdgcn_readfirstlane(q);
    const int bid = (int)blockIdx.x, nblk = (int)gridDim.x; unsigned char* ws = WSP;
    const CpP cp{(const bf16_t*)(ws + A_PR), (const bf16_t*)(ws + A_LOUT), (const bf16_t*)(ws + A_VMIX), (const bf16_t*)(ws + A_VFIRST), (bf16_t*)(ws + (l ? A_VP : A_VFIRST)), (float*)(ws + A_RK), ws + A_CHK + (size_t)(q & 1) * RW_BUF,
                 LDP(11) + l * 1792, LDP(12) + l * 512, LDP(14) + l * 512, LDP(17) + l * 512, LDP(18) + l * 512, LDP(19) + l * 512, LDP(22), l, 0};
    const int ntask = (q == 0 ? RW_NSEQ : RW_NSEQ - 1) * 8, hs = q == 0 ? 0 : RW_SKIP, NS = nblk - ((nblk + 3) >> 2);
    const bool scanwg = rw_is_scan_wg(bid); const int rank = rw_rank(bid);
#define RW_TASK(i_) (scanwg ? hs * NS + (i_) * nblk + bid : ((i_) < hs ? (i_) * NS + rank : hs * NS + ((i_) - hs) * nblk + bid))
#define RW_ROW0(t_) (((t_) >> 3) == 128 ? RREAL : ((t_) >> 7) * SEQ + (16 * q + (((t_) >> 3) & 15)) * 64)
    const int tid_ = opq(threadIdx.x), lane_ = tid_ & 63, w_ = __builtin_amdgcn_readfirstlane(tid_ >> 6);
    int task = RW_TASK(0); if (task >= ntask) return;
    CpRaw raw; cp_issue(cp, RW_ROW0(task), task & 7, w_, lane_, raw);
#pragma unroll 1
    for (int i = 0; ; ++i) { const int nxt = RW_TASK(i + 1); const bool has_next = nxt < ntask;
        rwkv_cp_task(lds, cp, RW_ROW0(task), task & 7, cp.CHK + (size_t)task * CHK_BYTES, raw, has_next, has_next ? RW_ROW0(nxt) : 0, nxt & 7);
        if (!has_next) break;
        task = nxt; }
#undef RW_TASK
#undef RW_ROW0
}
__device__ __forceinline__ void f_rwkv_scan(unsigned long long kp_, LAS unsigned char* lds, int l, int q) {
    const unsigned long long kp = kp_uniform(kp_); l = __builtin_amdgcn_readfirstlane(l); q = __builtin_amdgcn_readfirstlane(q);
    const int bid = (int)blockIdx.x, nblk = (int)gridDim.x; if (!rw_is_scan_wg(bid)) return;
    unsigned char* ws = WSP; const ScP sp{ws + A_CHK + (size_t)(q & 1) * RW_BUF, (bf16_t*)(ws + A_YS)};
#pragma unroll 1
    for (int unit = bid >> 2; unit < 64; unit += (nblk + 3) >> 2) { const int b = unit >> 3, hd = unit & 7; float* stp = (float*)(ws + A_SCST) + (size_t)unit * 4096;
        rwkv_scan_unit(lds, sp, b * 16, 128, q == 0 ? 1 : 0, 16, b * SEQ + q * 1024, hd, q == 0 && b == 0, q == 0 ? nullptr : stp, q == 3 ? nullptr : stp); }
}
NOINL void f_rwkv_post(unsigned long long kp_, int l, int q, int mode) {
    const unsigned long long kp = kp_uniform(kp_); l = __builtin_amdgcn_readfirstlane(l); q = __builtin_amdgcn_readfirstlane(q); mode = __builtin_amdgcn_readfirstlane(mode); WAVE_IDS(); unsigned char* ws = WSP;
    const PostP pp{(const bf16_t*)(ws + A_YS), (const bf16_t*)(ws + (l ? A_VP : A_VFIRST)), (const float*)(ws + A_RK), (const bf16_t*)(ws + A_LOUT), (bf16_t*)(ws + A_PM), LDP(20) + l * 512, LDP(21) + l * 512};
    const bool scanwg = rw_is_scan_wg(bid); const int nscan = (nblk + 3) >> 2, NS = nblk - nscan;
    if (mode == 2) rwkv_post(pp, q, 0, 8192, q == 0, gw, ngw, lane);
    else if (mode == 1) { if (!scanwg) rwkv_post(pp, q, 0, 8192, q == 0, rw_rank(bid) * 8 + wave, NS * 8, lane); }
    else if (scanwg) rwkv_post(pp, q, 0, 4096, false, (bid >> 2) * 8 + wave, nscan * 8, lane);
    else rwkv_post(pp, q, 4096, 8192, q == 0, rw_rank(bid) * 8 + wave, NS * 8, lane); }
NOINL void f_ffn_meta(unsigned long long kp_) {
    const unsigned long long kp = kp_uniform(kp_); WAVE_IDS(); unsigned char* ws = WSP;
    const int job = bid * 8 + wave; if (job >= FF0 / 16) return;
    const int f0 = job * 16, l15 = lane & 15, kq = lane >> 4;
    const bf16_t* wg = (const bf16_t*)(ws + WS_FGU) + (size_t)((f0 >> 7) * 256 + (f0 & 127) + l15) * 1024 + 8 * kq;
    const bf16_t* wu = wg + (size_t)128 * 1024;
    const bf16_t* xu = (const bf16_t*)(ws + A_U) + (size_t)(RREAL + l15) * D + 8 * kq;
    f32x4 ag = {0.f, 0.f, 0.f, 0.f}, au = {0.f, 0.f, 0.f, 0.f};
#pragma unroll 8
    for (int ks = 0; ks < 32; ++ks) { const bf16x8 a = *(const GAS bf16x8*)(wg + 32 * ks), b = *(const GAS bf16x8*)(wu + 32 * ks), x = *(const GAS bf16x8*)(xu + 32 * ks);
        ag = __builtin_amdgcn_mfma_f32_16x16x32_bf16(a, x, ag, 0, 0, 0); au = __builtin_amdgcn_mfma_f32_16x16x32_bf16(b, x, au, 0, 0, 0); }
    float r[4];
#pragma unroll
    for (int j = 0; j < 4; ++j) { const float g = ag[j], up = au[j]; r[j] = g / (1.0f + __expf(-g)) * up; }
    u32x2 o; o.x = cvtpk(r[0], r[1]); o.y = cvtpk(r[2], r[3]);
    *(GAS u32x2*)((bf16_t*)(ws + A_ACT0) + (size_t)(RREAL + l15) * FF0 + f0 + 4 * kq) = o;
}
NOINL void f_moe_tr(unsigned long long kp_, LAS unsigned char* lds) {
    const unsigned long long kp = kp_uniform(kp_); WAVE_IDS(); LAS float* scr = (LAS float*)(lds + wave * 8448);
    if (bid == 0 && tid < 24) { unsigned* ctlw = (unsigned*)(WSP + WS_CTL); const float sc = moe_wscale_bits(ctlw[CW_WMAX + tid]); ctlw[CW_WINV + tid] = __float_as_uint(1.0f / (F8_ACT * sc)); }
    int rot = 0;
#pragma unroll 1
    for (int e = 0; e < NEXP * PROBE_REP_MOETR; ++e) { const int ee = e % NEXP;
        const unsigned* ctl = (const unsigned*)(WSP + WS_CTL);
        { const TrJob8 J{LDP(30) + (size_t)ee * D * FFE, WSP + A_MGU, D, FFE, 1024, 2, ee * 2 * FFE, moe_wscale(ctl, 0, ee)}; ph_transpose_f8(J, scr, gw, ngw, lane, rot); rot += (J.K / 64) * (J.N / 32); }
        { const TrJob8 J{LDP(31) + (size_t)ee * D * FFE, WSP + A_MGU, D, FFE, 1024, 3, ee * 2 * FFE, moe_wscale(ctl, 1, ee)}; ph_transpose_f8(J, scr, gw, ngw, lane, rot); rot += (J.K / 64) * (J.N / 32); }
        { const TrJob8 J{LDP(32) + (size_t)ee * FFE * D, WSP + A_MDN, FFE, D, FFE, 0, ee * D, moe_wscale(ctl, 2, ee)}; ph_transpose_f8(J, scr, gw, ngw, lane, rot); rot += (J.K / 64) * (J.N / 32); }
    }
}
__device__ __forceinline__ void f_moe_route(unsigned long long kp_, LAS unsigned char* lds) {
    const unsigned long long kp = kp_uniform(kp_); WAVE_IDS(); unsigned char* ws = WSP;
    ph_norm_route(lds, OUTP, LDP(3) + D, LDP(28), LDP(29), (bf16_t*)(ws + A_U), (int*)(ws + A_MTAB + MT_E), (float*)(ws + A_MTAB + MT_G), (int*)(ws + A_MTAB + MT_STOK), (unsigned*)(ws + WS_CTL), bid, nblk, wave, lane); }
NOINL void f_moe_assign(unsigned long long kp_, LAS unsigned char* lds, int list) { const unsigned long long kp = kp_uniform(kp_); list = __builtin_amdgcn_readfirstlane(list); WAVE_IDS(); unsigned char* ws = WSP;
    ph_moe_assign(lds, list, (const int*)(ws + A_MTAB + MT_E), (const float*)(ws + A_MTAB + MT_G), (int*)(ws + A_MTAB + MT_STOK), (float*)(ws + A_MTAB + MT_SGATE), (int*)(ws + A_MTAB + MT_BE), (unsigned*)(ws + WS_CTL), ws + A_U, ws + A_XB, bid, nblk, tid); }
NOINL void f_final(unsigned long long kp_) { const unsigned long long kp = kp_uniform(kp_); WAVE_IDS(); unsigned char* ws = WSP; ph_final(OUTP, LDP(4), (const int*)(ws + A_MTAB + MT_TSLOT), (const float*)(ws + WS_TB), gw, ngw, lane); }

__global__ void __launch_bounds__(512, 2) fwd(Params P) {
    extern __shared__ __attribute__((aligned(16))) unsigned char lds_raw[];
    LAS unsigned char* lds = (LAS unsigned char*)lds_raw;
    const int tid = threadIdx.x;
    const int bid = (int)blockIdx.x, nblk = (int)gridDim.x;
    const unsigned long long kp = (unsigned long long)__builtin_amdgcn_kernarg_segment_ptr();
    volatile LAS unsigned* misc = (volatile LAS unsigned*)(lds + LDS_MISC);
    if (tid < 64) misc[tid] = 0u;
    __syncthreads();
    XcdBarrier bar;
    { unsigned* ctl0 = (unsigned*)(WSP + WS_CTL); bar = xcd_barrier_post(ctl0 + CW_BAR, misc + 8); }
#ifdef PROBE_BAR2
#define GRID_BAR() do { xcd_barrier(bar); xcd_barrier(bar); } while (0)
#else
#define GRID_BAR() xcd_barrier(bar)
#endif
    for (int rep_ = 0; rep_ < PROBE_REP_MISC; ++rep_) f_p0(kp, lds);
    GRID_BAR();

#pragma unroll 1
    for (int l = 0; l < 2; ++l) {
        for (int rep_ = 0; rep_ < PROBE_REP_NORM; ++rep_) f_rmsnorm(kp, 0, l);
        GRID_BAR();
_Pragma("unroll 1") for (int rep_ = 0; rep_ < PROBE_REP_INPROJ; ++rep_) {
        { unsigned char* ws = WSP; pg8::Gemm g{(const bf16_t*)(ws + A_U), (const bf16_t*)(ws + WS_WB + l * LW_STRIDE + LW_WIN), RP, 2816, 1024, 1024, 1024, 0}; pg8::StaticOrder S; S.init(RP, 2816, opqs(nblk), opqs(bid));
          EpiInProj E{(bf16_t*)(ws + A_PM), (bf16_t*)(ws + A_PR)};
          pg8::gemm_phase<EpiInProj, pg8::StaticOrder, true, true>(lds, g, S, E); }
}
        GRID_BAR();
        for (int rep_ = 0; rep_ < PROBE_REP_PREP; ++rep_) f_prep(kp, l);
        GRID_BAR();
_Pragma("unroll 1") for (int rep_ = 0; rep_ < PROBE_REP_P4A; ++rep_) {
        { unsigned char* ws = WSP; pg8::Gemm g{(const bf16_t*)(ws + A_PM), (const bf16_t*)(ws + WS_WB + l * LW_STRIDE + LW_WUQ), RP, 768, 512, 1024, 512, 0}; pg8::StaticOrder S; S.init(RP, 768, opqs(nblk), opqs(bid));
          EpiRowScale E{(bf16_t*)(ws + A_U), (const float*)(ws + A_RSTDQ), 768, 0};
          pg8::gemm_phase<EpiRowScale, pg8::StaticOrder, true, true>(lds, g, S, E); }
        { unsigned char* ws = WSP; pg8::Gemm g{(const bf16_t*)(ws + A_PM) + 512, (const bf16_t*)(ws + WS_WB + l * LW_STRIDE + LW_WK), RP, 512, 256, 1024, 256, 0}; pg8::StaticOrder S; S.init(RP, 512, opqs(nblk), opqs((bid + nblk - 131) % nblk));
          EpiRowScale E{(bf16_t*)(ws + A_KN), (const float*)(ws + A_RSTDKV), 512, 0};
          pg8::gemm_phase<EpiRowScale, pg8::StaticOrder, true, true>(lds, g, S, E); }
        { unsigned char* ws = WSP; pg8::Gemm g{(const bf16_t*)(ws + WS_WB + l * LW_STRIDE + LW_WV), (const bf16_t*)(ws + A_PM) + 512, 512, RP, 256, 256, 1024, 0}; pg8::StaticOrder S; S.init(512, RP, opqs(nblk), opqs((bid + nblk - 133) % nblk));
          EpiColScale E{(bf16_t*)(ws + A_VT), (const float*)(ws + A_RSTDKV), RP, 0};
          pg8::gemm_phase<EpiColScale, pg8::StaticOrder, true, true>(lds, g, S, E); }
}
        GRID_BAR();
_Pragma("unroll 1") for (int rep_ = 0; rep_ < PROBE_REP_ATT; ++rep_) {
        { unsigned char* ws = WSP; attn_phase(lds, (const bf16_t*)(ws + A_U), (const bf16_t*)(ws + A_KN), (const bf16_t*)(ws + A_KROPE), (const bf16_t*)(ws + A_VT), (bf16_t*)(ws + A_PM), (const float*)(ws + WS_ROPE), opqs(bid), opqs(nblk)); }
}
        GRID_BAR();
_Pragma("unroll 1") for (int rep_ = 0; rep_ < PROBE_REP_P4B; ++rep_) {
        { unsigned char* ws = WSP; pg8::Gemm g{(const bf16_t*)(ws + A_LIN), (const bf16_t*)(ws + WS_WB + l * LW_STRIDE + LW_LORA), RP, 1536, 256, 256, 256, 0}; pg8::StaticOrder S; S.init(RP, 1536, opqs(nblk), opqs(bid));
          EpiRowScale E{(bf16_t*)(ws + A_LOUT), nullptr, 1536, 0};
          pg8::gemm_phase<EpiRowScale, pg8::StaticOrder, true, true>(lds, g, S, E); }
        if (l == 1) {
            unsigned char* ws = WSP; pg8::Gemm g{(const bf16_t*)(ws + A_VSH), (const bf16_t*)(ws + WS_V1T), RP, 512, 512, 512, 512, 0}; pg8::StaticOrder S; S.init(RP, 512, opqs(nblk), opqs((bid + nblk - 6) % nblk));
            EpiRowScale E{(bf16_t*)(ws + A_VMIX), nullptr, 512, 0};
            pg8::gemm_phase<EpiRowScale, pg8::StaticOrder, true, true>(lds, g, S, E);
        }
}
        GRID_BAR();
#pragma unroll 1
        for (int stp = 0; stp < 6; ++stp) {
            if (stp >= 1 && stp <= 4) { _Pragma("unroll 1") for (int rep_ = 0; rep_ < PROBE_REP_SCAN; ++rep_) f_rwkv_scan(kp, lds, l, stp - 1); }
            if (stp <= 3) { _Pragma("unroll 1") for (int rep_ = 0; rep_ < PROBE_REP_CP; ++rep_) f_rwkv_cp(kp, lds, l, stp); }
            if (stp >= 2) { for (int rep_ = 0; rep_ < PROBE_REP_MISC; ++rep_) f_rwkv_post(kp, l, stp - 2, stp <= 3 ? 0 : stp - 3); }
            GRID_BAR();
        }
_Pragma("unroll 1") for (int rep_ = 0; rep_ < PROBE_REP_OUTPROJ; ++rep_) {
        { unsigned char* ws = WSP; pg8::Gemm g{(const bf16_t*)(ws + A_PM), (const bf16_t*)(ws + WS_WB + l * LW_STRIDE + LW_WOUT), RREAL, 1024, 1024, 1024, 1024, 0}; pg8::StaticOrder S; S.init(RREAL, 1024, opqs(nblk), opqs(bid));
          EpiResid E{OUTP, (float*)(ws + WS_HMETA), (l == 0 && rep_ == 0) ? LDP(0) : (const float*)OUTP, rep_ == 0 ? 1.0f : 0.0f, 0};
          pg8::gemm_phase<EpiResid, pg8::StaticOrder, true, true>(lds, g, S, E); }
        if (rep_ == 0 && l == 0) {
          unsigned char* ws = WSP; pg8::Gemm g{(const bf16_t*)(ws + A_PM), (const bf16_t*)(ws + WS_WB + l * LW_STRIDE + LW_WOUT), RP, 1024, 256, 1024, 1024, 0};
          const DenseTailOrder S{4, 4, opqs(nblk), opqs(bid)}; EpiResidPartial E{(float*)(ws + A_PART)};
          pg8::gemm_phase<EpiResidPartial, DenseTailOrder, true, true>(lds, g, S, E); }
}
        GRID_BAR();
        if (l == 0) {
            for (int rep_ = 0; rep_ < PROBE_REP_MISC; ++rep_) f_rmsnorm(kp, 1, 0);
            GRID_BAR();
_Pragma("unroll 1") for (int rep_ = 0; rep_ < PROBE_REP_FFNGU; ++rep_) {
            f_ffn_meta(kp);
            { unsigned char* ws = WSP; pg8::Gemm g{(const bf16_t*)(ws + A_U), (const bf16_t*)(ws + WS_FGU), RREAL, 2 * FF0, 1024, 1024, 1024, 0}; pg8::StaticOrder S; S.init(RREAL, 2 * FF0, opqs(nblk), opqs(bid));
              EpiSwiGLU E{(bf16_t*)(ws + A_ACT0), FF0, 22, 0, 0};
              pg8::gemm_phase<EpiSwiGLU, pg8::StaticOrder, true, true>(lds, g, S, E); }
}
            GRID_BAR();
_Pragma("unroll 1") for (int rep_ = 0; rep_ < PROBE_REP_FFNDN; ++rep_) {
            { unsigned char* ws = WSP; pg8::Gemm g{(const bf16_t*)(ws + A_ACT0), (const bf16_t*)(ws + WS_FDN), RREAL, 1024, FF0, FF0, FF0, 0}; pg8::StaticOrder S; S.init(RREAL, 1024, opqs(nblk), opqs(bid));
              EpiResid E{OUTP, (float*)(ws + WS_HMETA), (const float*)OUTP, rep_ == 0 ? 1.0f : 0.0f, 0};
              pg8::gemm_phase<EpiResid, pg8::StaticOrder, true, true>(lds, g, S, E); }
            if (rep_ == 0) {
              unsigned char* ws = WSP; pg8::Gemm g{(const bf16_t*)(ws + A_ACT0), (const bf16_t*)(ws + WS_FDN), RP, 1024, 256, FF0, FF0, 0};
              const DenseTailOrder S{4, 11, opqs(nblk), opqs(bid)}; EpiResidPartial E{(float*)(ws + A_PART)};
              pg8::gemm_phase<EpiResidPartial, DenseTailOrder, true, true>(lds, g, S, E); }
}
            GRID_BAR();
        } else {
            f_moe_tr(kp, lds);
            f_moe_route(kp, lds);
            GRID_BAR();
            f_moe_assign(kp, lds, 0);
            f_moe_assign(kp, lds, 1);
            GRID_BAR();
#pragma unroll 1
            for (int list = 0; list < 2; ++list) {
                const int np0 = __builtin_amdgcn_readfirstlane((int)((const unsigned*)(WSP + WS_CTL))[CW_NPAN]), np1 = __builtin_amdgcn_readfirstlane((int)((const unsigned*)(WSP + WS_CTL))[CW_NPAN + 1]);
                const int T0 = np0 > MOE_TAILPAN ? (np0 - MOE_TAILPAN) * 4 : 0, T1 = np1 > MOE_TAILPAN ? (np1 - MOE_TAILPAN) * 4 : 0;
                if (list == 1) {
                    { unsigned char* ws = WSP; pg8::Gemm g{(const bf16_t*)(ws + A_MACT), (const bf16_t*)(ws + A_MDN), 0, 0, FFE / 2, FFE / 2, FFE / 2, 0};
                      const MoeShiftTailOrder S{(const int*)(ws + A_MTAB + MT_BE), (const unsigned*)(ws + WS_CTL) + CW_NPAN, 4, 4, 0, opqs(nblk) - 1, opqs(bid), 0};
                      EpiMoeDown E{OUTP, (const int*)(ws + A_MTAB + MT_STOK), (const float*)(ws + A_MTAB + MT_SGATE), 4, 1.0f, (const unsigned*)(ws + WS_CTL)};
                      pg8::gemm_phase<EpiMoeDown, MoeShiftTailOrder, true, true, true>(lds, g, S, E); }
                    { unsigned char* ws = WSP; pg8::Gemm g{(const bf16_t*)(ws + A_MACT), (const bf16_t*)(ws + A_MDN), 0, 0, FFE / 2, FFE / 2, FFE / 2, 0};
                      const MoeShiftTailOrder S{(const int*)(ws + A_MTAB + MT_BE) + 256, (const unsigned*)(ws + WS_CTL) + CW_NPAN + 1, 4, 4, MOE_GAP, opqs(nblk) - 1 - T0, opqs(bid), 0};
                      EpiMoeDownStore E{(float*)(ws + WS_TB), (const int*)(ws + A_MTAB + MT_STOK) + MOE_MAXPAN * 256, (const float*)(ws + A_MTAB + MT_SGATE) + MOE_MAXPAN * 256, 4, MOE_TAILPAN + MOE_GAP, (const unsigned*)(ws + WS_CTL)};
                      pg8::gemm_phase<EpiMoeDownStore, MoeShiftTailOrder, true, true, true>(lds, g, S, E); }
                }
_Pragma("unroll 1") for (int rep_ = 0; rep_ < PROBE_REP_MOEGU; ++rep_) {
                { unsigned char* ws = WSP; pg8::Gemm g{(const bf16_t*)(ws + A_XB + (size_t)list * XB_LIST), (const bf16_t*)(ws + A_MGU), 0, 0, 512, 512, 512, 0};
                  const int Tt = list == 1 && T0 + T1 < opqs(nblk) ? T0 + T1 : 0;
                  const MoeSlotOrder S{(const int*)(ws + A_MTAB + MT_BE) + 256 * list, (const unsigned*)(ws + WS_CTL) + CW_NPAN + list, (const int*)(ws + A_MTAB + MT_STOK) + list * MOE_MAXPAN * 256, 28, 28, 0, opqs(nblk), opqs(bid), RREAL,
                                         0, list == 0 ? MOE_MAXPAN : MOE_TAILPAN, 0, 0, Tt, MOE_CSKIP};
                  EpiSwiGLU8 E{ws + A_MACT, (const unsigned*)(ws + WS_CTL), FFE, 28};
                  pg8::gemm_phase<EpiSwiGLU8, MoeSlotOrder, true, true, true>(lds, g, S, E); }
                if (list == 0) {
                  unsigned char* ws = WSP; pg8::Gemm g{(const bf16_t*)(ws + A_XB + XB_LIST), (const bf16_t*)(ws + A_MGU), 0, 0, 512, 512, 512, 0};
                  const int nb = opqs(nblk);
                  const MoeSlotOrder S{(const int*)(ws + A_MTAB + MT_BE) + 256, (const unsigned*)(ws + WS_CTL) + CW_NPAN + 1, (const int*)(ws + A_MTAB + MT_STOK) + MOE_MAXPAN * 256, 28, 28, 0, nb, opqs(bid), RREAL,
                                         MOE_TAILPAN, MOE_MAXPAN, MOE_GAP, (np0 * 28) % nb, 0, 0};
                  EpiSwiGLU8 E{ws + A_MACT, (const unsigned*)(ws + WS_CTL), FFE, 28};
                  pg8::gemm_phase<EpiSwiGLU8, MoeSlotOrder, true, true, true>(lds, g, S, E); }
}
                GRID_BAR();
_Pragma("unroll 1") for (int rep_ = 0; rep_ < PROBE_REP_MOEDN; ++rep_) {
                { unsigned char* ws = WSP; pg8::Gemm g{(const bf16_t*)(ws + A_MACT), (const bf16_t*)(ws + A_MDN), 0, 0, FFE / 2, FFE / 2, FFE / 2, 0};
                  const MoeOrder S{(const int*)(ws + A_MTAB + MT_BE) + 256 * list, (const unsigned*)(ws + WS_CTL) + CW_NPAN + list, 4, 4, 0, opqs(nblk), opqs(bid), MOE_TAILPAN * 4};
                  EpiMoeDown E{OUTP, (const int*)(ws + A_MTAB + MT_STOK) + list * MOE_MAXPAN * 256, (const float*)(ws + A_MTAB + MT_SGATE) + list * MOE_MAXPAN * 256, 4, rep_ == 0 ? 1.0f : 0.0f, (const unsigned*)(ws + WS_CTL)};
                  pg8::gemm_phase<EpiMoeDown, MoeOrder, true, true, true>(lds, g, S, E); }
}
                GRID_BAR();
            }
        }
    }
    f_final(kp);
}

extern "C" void kernel_launch(void* const* d_in, const int* in_sizes, int n_in, void* d_out, int out_size, void* d_ws, size_t ws_size, hipStream_t stream) {
    static int grid = 0;
    if (grid == 0) {
        if (n_in != 33 || ws_size < WS_NEED || out_size != RREAL * D) { fprintf(stderr, "kernel_launch: unexpected arguments (n_in %d, ws %zu need %zu, out %d)\n", n_in, ws_size, (size_t)WS_NEED, out_size); grid = -1; return; }
        int dev = 0, cus = 0;
        if (hipGetDevice(&dev) != hipSuccess || hipDeviceGetAttribute(&cus, hipDeviceAttributeMultiprocessorCount, dev) != hipSuccess) { grid = -1; return; }
        if (hipFuncSetAttribute((const void*)fwd, hipFuncAttributeMaxDynamicSharedMemorySize, LDS_BYTES) != hipSuccess) { fprintf(stderr, "kernel_launch: hipFuncSetAttribute failed\n"); grid = -1; return; }
        int per_cu = 0; (void)hipOccupancyMaxActiveBlocksPerMultiprocessor(&per_cu, (const void*)fwd, 512, LDS_BYTES); (void)hipGetLastError();
        grid = cus;
    }
    if (grid < 0) return;
    unsigned char* ws = (unsigned char*)d_ws;
    (void)hipMemsetAsync(ws + WS_CTL, 0, 1 * MiB, stream);
    (void)hipMemsetAsync(ws + WS_WB, 0, WS_ROPE - WS_WB, stream);
    Params p{};
    for (int i = 0; i < 33; ++i) p.in[i] = (const float*)d_in[i];
    p.out = (float*)d_out; p.ws = ws;
    hipLaunchKernelGGL(fwd, dim3(grid), dim3(512), LDS_BYTES, stream, p);
}
```

```cpp
#include <hip/hip_runtime.h>
#include <cstdio>
#include <cstdint>
namespace pg8 {
#define PG8_LAS __attribute__((address_space(3)))
typedef unsigned short bf16_t;
typedef short bf16x8 __attribute__((ext_vector_type(8)));
typedef float f32x4 __attribute__((ext_vector_type(4)));
typedef unsigned u32x4 __attribute__((ext_vector_type(4)));
constexpr int BM = 256, BK = 64, HALF = 128, HTB = HALF * BK * 2  , STAGE_BYTES = 8 * HTB, NXCD = 8, WGM = 8;

__host__ __device__ __forceinline__ int lds_byte(int r, int c) { const int st = (r >> 4) * 2 + (c >> 5), rr = r & 15, cc = c & 31, ob = rr * 64 + cc * 2; return st * 1024 + (ob ^ (((ob >> 9) & 1) << 5)); }
__host__ __device__ __forceinline__ void stage_rc(int b, int& R, int& C) { const int st = b / 1024, sb = b % 1024, swz = sb ^ (((sb >> 9) & 1) << 5); R = (st >> 1) * 16 + swz / 64; C = (st & 1) * 32 + (swz % 64) / 2; }
__host__ __device__ __forceinline__ int perm32(int rho) { const int n = rho >> 4, i = rho & 15; return 8 * (i >> 2) + 4 * n + (i & 3); }

struct Unit { int pm, pn, k0; };
struct Gemm { const bf16_t* A; const bf16_t* Bt; int M, N, K, lda, ldb, pad; };

struct StaticOrder {
    static constexpr bool GATHER = false;
    int nM, nN, nwg, G, c;
    __host__ __device__ void init(int M, int N, int G_, int c_) { nM = M / BM; nN = N / BM; nwg = nM * nN; G = G_; c = c_; }
    __host__ __device__ bool next(int i, Unit& u) const {
        const long L = (long)i * G + c; if (L >= nwg) return false;
        int wgid = (int)L; { const int q = nwg / NXCD, r = nwg % NXCD, xcd = wgid % NXCD, off = wgid / NXCD; wgid = (xcd < r ? xcd * (q + 1) : r * (q + 1) + (xcd - r) * q) + off; }
        const int nig = WGM * nN, gid = wgid / nig, fm = gid * WGM, gsz = (nM - fm) < WGM ? (nM - fm) : WGM;
        u.pm = fm + ((wgid % nig) % gsz); u.pn = (wgid % nig) / gsz; u.k0 = 0; return true;
    }
    __device__ __forceinline__ void a_ready(const Unit&) const {}
    __device__ __forceinline__ void done(const Unit&) const {}
};

__device__ __forceinline__ unsigned cvt_pk_bf16(float lo, float hi) { unsigned r; asm volatile("v_cvt_pk_bf16_f32 %0, %1, %2" : "=v"(r) : "v"(lo), "v"(hi)); return r; }
typedef int i32x4_ __attribute__((ext_vector_type(4)));
typedef int i32x8_ __attribute__((ext_vector_type(8)));
template <class Epi, class Sched, bool ALIGN_EPI = false, bool SP2 = false, bool FP8 = false>
__device__ __forceinline__ void gemm_phase(PG8_LAS unsigned char* lds, const Gemm g, const Sched& S, const Epi& E) {
    int tid_ = threadIdx.x; asm volatile("" : "+v"(tid_)); const int tid = tid_, wid = __builtin_amdgcn_readfirstlane(tid >> 6), lane = tid & 63, wr = wid >> 2, wc = wid & 3, fr = lane & 15, fq = lane >> 4;
    const int K = g.K, nt = K / BK;
    unsigned voffA[2], voffB[2];
#pragma unroll
    for (int i = 0; i < 2; ++i) { int R, C; stage_rc(tid * 16 + i * 8192, R, C); const int Rb = Epi::PERM ? ((R & ~31) + perm32(R & 31)) : R;
        voffA[i] = (unsigned)(R * g.lda + C) * 2u; voffB[i] = (unsigned)(Rb * g.ldb + C) * 2u; }
    constexpr bool GATHER = Sched::GATHER;
    unsigned vAc[2][2] = {{0u, 0u}, {0u, 0u}}, vAn[2][2] = {{0u, 0u}, {0u, 0u}}, cbA[2] = {0u, 0u};
    if constexpr (GATHER) {
#pragma unroll
        for (int i = 0; i < 2; ++i) { int R, C; stage_rc(tid * 16 + i * 8192, R, C); cbA[i] = (unsigned)C * 2u; }
    }
#define PG8_IDX_DMA(un, slot) do { if constexpr (GATHER) { const int* rp_ = S.rows + (size_t)(un).pm * 256 + 128 * (lane >> 5) + 64 * ((lane >> 4) & 1) + 16 * (wid >> 1) + (lane & 15); \
        __builtin_amdgcn_global_load_lds((const unsigned*)rp_, (PG8_LAS unsigned*)(lds + STAGE_BYTES + wid * 512 + (slot) * 256), 4, 0, 0); } } while (0)
#define PG8_IDX_READ(dst, slot) do { if constexpr (GATHER) { int t3_ = threadIdx.x; asm volatile("" : "+v"(t3_));     \
        _Pragma("unroll") for (int h_ = 0; h_ < 2; ++h_) _Pragma("unroll") for (int i_ = 0; i_ < 2; ++i_) { int R_, C_; stage_rc(t3_ * 16 + i_ * 8192, R_, C_); \
        int tk_ = *(const PG8_LAS int*)(lds + STAGE_BYTES + (t3_ >> 6) * 512 + (slot) * 256 + 4 * (32 * h_ + 16 * i_ + ((t3_ & 63) >> 2))); tk_ = tk_ < 0 ? S.zero_row : tk_; \
        dst[h_][i_] = (unsigned)tk_ * (unsigned)(g.lda * 2) + (unsigned)C_ * 2u; } } } while (0)
#define PG8_STAGE_A(bufoff, base, h, nx) do { if constexpr (GATHER) { const unsigned vs_[2] = {(nx) ? vAn[h][0] : vAc[h][0], (nx) ? vAn[h][1] : vAc[h][1]}; PG8_STAGE(bufoff, base, vs_); } \
        else { PG8_STAGE(bufoff, (base) + (h) * hstepA, voffA); } } while (0)
    const size_t kstep = (size_t)(BK * 2);
    const size_t hstepA = (size_t)HALF * g.lda * 2, hstepB = (size_t)HALF * g.ldb * 2;
    const size_t tstepA = 2 * hstepA, tstepB = 2 * hstepB;
    const unsigned ldsw = (unsigned)wid * 1024u;
    const int aoff = lds_byte(wr * 64 + fr, fq * 8), boff = lds_byte(wc * 32 + fr, fq * 8);
#define PG8_SA(b, h) (((b) * 2 + (h)) * HTB)
#define PG8_SB(b, h) ((4 + (b) * 2 + (h)) * HTB)
#define PG8_STAGE(bufoff, gbase, voff) do { const char* gb_ = (const char*)(gbase); asm volatile("" : "+s"(gb_));   \
        _Pragma("unroll") for (int _i = 0; _i < 2; ++_i) \
        __builtin_amdgcn_global_load_lds((const unsigned*)(gb_ + (voff)[_i]), (PG8_LAS unsigned*)(lds + (bufoff) + ldsw + _i * 8192), 16, 0, 0); } while (0)
#define PG8_LDA(dst, b, h) do { _Pragma("unroll") for (int m = 0; m < 4; ++m) _Pragma("unroll") for (int k = 0; k < 2; ++k) dst[m][k] = *(const PG8_LAS bf16x8*)(lds + PG8_SA(b, h) + aoff + m * 2048 + k * 1024); } while (0)
#define PG8_LDB(dst, b, h) do { _Pragma("unroll") for (int n = 0; n < 2; ++n) _Pragma("unroll") for (int k = 0; k < 2; ++k) dst[n][k] = *(const PG8_LAS bf16x8*)(lds + PG8_SB(b, h) + boff + n * 2048 + k * 1024); } while (0)
#define PG8_MMA(ai, bj, At, Bt) do { __builtin_amdgcn_s_setprio(1); _Pragma("unroll") for (int m = 0; m < 4; ++m) _Pragma("unroll") for (int n = 0; n < 2; ++n) { \
        if constexpr (FP8) { const i32x8_ b8_ = __builtin_shufflevector(__builtin_bit_cast(i32x4_, Bt[n][0]), __builtin_bit_cast(i32x4_, Bt[n][1]), 0, 1, 2, 3, 4, 5, 6, 7); \
            const i32x8_ a8_ = __builtin_shufflevector(__builtin_bit_cast(i32x4_, At[m][0]), __builtin_bit_cast(i32x4_, At[m][1]), 0, 1, 2, 3, 4, 5, 6, 7); \
            acc[ai][bj][m][n] = __builtin_amdgcn_mfma_scale_f32_16x16x128_f8f6f4(b8_, a8_, acc[ai][bj][m][n], 0, 0, 0, 0, 0, 0); }     \
        else { _Pragma("unroll") for (int k = 0; k < 2; ++k) acc[ai][bj][m][n] = __builtin_amdgcn_mfma_f32_16x16x32_bf16(Bt[n][k], At[m][k], acc[ai][bj][m][n], 0, 0, 0); } } \
        __builtin_amdgcn_s_setprio(0); } while (0)
#define PG8_WAIT_V(n) asm volatile("s_waitcnt vmcnt(" #n ")" ::: "memory")
#define PG8_WAIT_L(n) asm volatile("s_waitcnt lgkmcnt(" #n ")" ::: "memory")
#define PG8_BAR __builtin_amdgcn_s_barrier()
#define PG8_SCHED __builtin_amdgcn_sched_barrier(0)
    Unit cur, nxt; int ui = 0;
    if (!S.next(0, cur)) return;
    float zf_ = 0.f; asm volatile("" : "+v"(zf_));
    f32x4 acc[2][2][4][2];
#pragma unroll
    for (int a = 0; a < 2; ++a)
#pragma unroll
        for (int b = 0; b < 2; ++b)
#pragma unroll
            for (int m = 0; m < 4; ++m)
#pragma unroll
                for (int n = 0; n < 2; ++n) acc[a][b][m][n] = (f32x4){zf_, zf_, zf_, zf_};
    bf16x8 At[4][2], B0[2][2], B1[2][2];
    const char* cA = (const char*)g.A + (GATHER ? (size_t)0 : (size_t)cur.pm * tstepA) + (size_t)cur.k0 * 2; const char* cB = (const char*)g.Bt + (size_t)cur.pn * tstepB + (size_t)cur.k0 * 2;
    S.a_ready(cur);
    if constexpr (GATHER) { PG8_IDX_DMA(cur, 0); asm volatile("s_waitcnt vmcnt(0)" ::: "memory"); PG8_IDX_READ(vAc, 0); }
    if constexpr (SP2) {
        PG8_STAGE(PG8_SB(0, 0), cB, voffB); PG8_STAGE(PG8_SB(0, 1), cB + hstepB, voffB); PG8_STAGE_A(PG8_SA(0, 0), cA, 0, false); PG8_STAGE_A(PG8_SA(0, 1), cA, 1, false);
        if (wr == 1) PG8_BAR;
        PG8_WAIT_V(2); PG8_BAR;
        PG8_STAGE(PG8_SB(1, 0), cB + kstep, voffB); PG8_STAGE_A(PG8_SA(1, 0), cA + kstep, 0, false); PG8_STAGE(PG8_SB(1, 1), cB + hstepB + kstep, voffB);
        PG8_WAIT_V(6); PG8_BAR;
    } else {
        PG8_STAGE(PG8_SB(0, 0), cB, voffB); PG8_STAGE(PG8_SA(0, 0), cA, voffA); PG8_STAGE(PG8_SB(0, 1), cB + hstepB, voffB); PG8_STAGE(PG8_SA(0, 1), cA + hstepA, voffA);
        if (wr == 1) PG8_BAR;
        PG8_WAIT_V(4); PG8_BAR;
        PG8_STAGE(PG8_SB(1, 0), cB + kstep, voffB); PG8_STAGE(PG8_SA(1, 0), cA + kstep, voffA); PG8_STAGE(PG8_SB(1, 1), cB + hstepB + kstep, voffB);
        PG8_WAIT_V(6); PG8_BAR;
    }
    for (;;) {
        const bool has_next = S.next(ui + 1, nxt);
        const char* nA = has_next ? (const char*)g.A + (GATHER ? (size_t)0 : (size_t)nxt.pm * tstepA) + (size_t)nxt.k0 * 2 : cA; const char* nB = has_next ? (const char*)g.Bt + (size_t)nxt.pn * tstepB + (size_t)nxt.k0 * 2 : cB;
        if constexpr (GATHER) { if (has_next) PG8_IDX_DMA(nxt, (ui + 1) & 1); }
        for (int t = 0; t < nt; t += 2) {
            const bool last = (t == nt - 2); const bool lnx = last && has_next;
            const char* a1 = cA + (size_t)(t + 1) * kstep;
            const char* a2 = last ? nA : cA + (size_t)(t + 2) * kstep; const char* b2 = last ? nB : cB + (size_t)(t + 2) * kstep;
            const char* a3 = a2 + kstep; const char* b3 = b2 + kstep;
            if (last && has_next) S.a_ready(nxt);
            if constexpr (GATHER) { if (lnx) PG8_IDX_READ(vAn, (ui + 1) & 1); }
            if constexpr (SP2) {
            PG8_LDB(B0, 0, 0); PG8_LDB(B1, 0, 1); PG8_SCHED; PG8_LDA(At, 0, 0); PG8_STAGE_A(PG8_SA(1, 1), a1, 1, false);
            PG8_WAIT_V(8); PG8_WAIT_L(0); PG8_BAR; PG8_MMA(0, 0, At, B0); PG8_MMA(0, 1, At, B1); PG8_BAR; PG8_SCHED;
            PG8_LDA(At, 0, 1); PG8_STAGE(PG8_SB(0, 0), b2, voffB); PG8_STAGE(PG8_SB(0, 1), b2 + hstepB, voffB); PG8_STAGE_A(PG8_SA(0, 0), a2, 0, lnx);
            PG8_WAIT_V(8); PG8_WAIT_L(0); PG8_BAR; PG8_MMA(1, 0, At, B0); PG8_MMA(1, 1, At, B1); PG8_BAR; PG8_SCHED;
            PG8_LDB(B0, 1, 0); PG8_LDB(B1, 1, 1); PG8_SCHED; PG8_LDA(At, 1, 0); PG8_STAGE_A(PG8_SA(0, 1), a2, 1, lnx);
            PG8_WAIT_V(8); PG8_WAIT_L(0); PG8_BAR; PG8_MMA(0, 0, At, B0); PG8_MMA(0, 1, At, B1); PG8_BAR; PG8_SCHED;
            PG8_LDA(At, 1, 1); PG8_STAGE(PG8_SB(1, 0), b3, voffB); PG8_STAGE(PG8_SB(1, 1), b3 + hstepB, voffB); PG8_STAGE_A(PG8_SA(1, 0), a3, 0, lnx);
            PG8_WAIT_V(8); PG8_WAIT_L(0); PG8_BAR; PG8_MMA(1, 0, At, B0); PG8_MMA(1, 1, At, B1); PG8_BAR; PG8_SCHED;
            } else {
            PG8_LDB(B0, 0, 0); PG8_SCHED; PG8_LDA(At, 0, 0); PG8_STAGE(PG8_SA(1, 1), a1 + hstepA, voffA);
            PG8_WAIT_L(8); PG8_BAR; PG8_WAIT_L(0); PG8_MMA(0, 0, At, B0); PG8_BAR; PG8_SCHED;
            PG8_LDB(B1, 0, 1); PG8_STAGE(PG8_SB(0, 0), b2, voffB);
            PG8_BAR; PG8_WAIT_L(0); PG8_MMA(0, 1, At, B1); PG8_BAR;
            PG8_LDA(At, 0, 1); PG8_STAGE(PG8_SA(0, 0), a2, voffA);
            PG8_BAR; PG8_WAIT_L(0); PG8_MMA(1, 0, At, B0); PG8_BAR; PG8_SCHED;
            PG8_STAGE(PG8_SB(0, 1), b2 + hstepB, voffB);
            PG8_WAIT_V(6); PG8_BAR; PG8_MMA(1, 1, At, B1); PG8_BAR;
            PG8_LDB(B0, 1, 0); PG8_SCHED; PG8_LDA(At, 1, 0); PG8_STAGE(PG8_SA(0, 1), a2 + hstepA, voffA);
            PG8_WAIT_L(8); PG8_BAR; PG8_WAIT_L(0); PG8_MMA(0, 0, At, B0); PG8_BAR; PG8_SCHED;
            PG8_LDB(B1, 1, 1); PG8_STAGE(PG8_SB(1, 0), b3, voffB);
            PG8_BAR; PG8_WAIT_L(0); PG8_MMA(0, 1, At, B1); PG8_BAR;
            PG8_LDA(At, 1, 1); PG8_STAGE(PG8_SA(1, 0), a3, voffA);
            PG8_BAR; PG8_WAIT_L(0); PG8_MMA(1, 0, At, B0); PG8_BAR; PG8_SCHED;
            PG8_STAGE(PG8_SB(1, 1), b3 + hstepB, voffB);
            PG8_WAIT_V(6); PG8_BAR; PG8_MMA(1, 1, At, B1); PG8_BAR;
            }
        }
        if constexpr (ALIGN_EPI) { if (wr == 0) PG8_BAR; }
        if constexpr (!Epi::AFTER_DRAIN) { int t2_ = threadIdx.x; asm volatile("" : "+v"(t2_)); const int fr2_ = t2_ & 15, fq2_ = (t2_ >> 4) & 3;
            E(acc, cur, wr, wc, fr2_, fq2_); S.done(cur); }
        if (!has_next) break;
#pragma unroll
        for (int a = 0; a < 2; ++a)
#pragma unroll
            for (int b = 0; b < 2; ++b)
#pragma unroll
                for (int m = 0; m < 4; ++m)
#pragma unroll
                    for (int n = 0; n < 2; ++n) acc[a][b][m][n] = (f32x4){zf_, zf_, zf_, zf_};
        cur = nxt; cA = nA; cB = nB; ++ui;
        if constexpr (GATHER) { vAc[0][0] = vAn[0][0]; vAc[0][1] = vAn[0][1]; vAc[1][0] = vAn[1][0]; vAc[1][1] = vAn[1][1]; }
        if constexpr (ALIGN_EPI) { if (wr == 1) PG8_BAR; }
    }
    PG8_WAIT_V(0);
    if constexpr (!ALIGN_EPI) { if (wr == 0) PG8_BAR; }
    PG8_BAR;
    if constexpr (Epi::AFTER_DRAIN) { E.fused(acc, cur, wr, wc, fr, fq, lds, wid, lane); S.done(cur); }
#undef PG8_SA
#undef PG8_SB
#undef PG8_STAGE
#undef PG8_STAGE_A
#undef PG8_IDX_DMA
#undef PG8_IDX_READ
#undef PG8_LDA
#undef PG8_LDB
#undef PG8_MMA
#undef PG8_WAIT_V
#undef PG8_WAIT_L
#undef PG8_BAR
#undef PG8_SCHED
}
}

typedef unsigned short bf16_t;
typedef short bf16x8 __attribute__((ext_vector_type(8)));
typedef short s16x4 __attribute__((ext_vector_type(4)));
typedef float f32x4 __attribute__((ext_vector_type(4)));
typedef float f32x16 __attribute__((ext_vector_type(16)));
typedef unsigned u32x4 __attribute__((ext_vector_type(4)));
typedef unsigned u32x2 __attribute__((ext_vector_type(2)));
#define LAS __attribute__((address_space(3)))
#define GAS __attribute__((address_space(1)))

constexpr int D = 1024, NB = 8, SEQ = 4096, NMETA = 16;
constexpr int RREAL = NB * SEQ;
constexpr int RVALID = RREAL + NMETA;
constexpr int NPAN = 129, RP = NPAN * 256;
constexpr int PMW = 1024, PRW = 1792;
constexpr int CW = 512;
constexpr int FF0 = 2816, FFE = 3584, NEXP = 8;
constexpr float RMS_EPS = 1e-6f, GN_EPS = 64e-5f;
constexpr int MOE_MAXPAN = 144;
constexpr int MOE_TAILPAN = 128, MOE_GAP = 8;
#ifndef MOE_CSKIP
#define MOE_CSKIP 5
#endif

typedef float f32x2_t __attribute__((ext_vector_type(2))); typedef __bf16 bf16x2_t __attribute__((ext_vector_type(2)));
__device__ __forceinline__ unsigned cvtpk(float lo, float hi) { f32x2_t v = {lo, hi}; bf16x2_t b = __builtin_convertvector(v, bf16x2_t); return __builtin_bit_cast(unsigned, b); }
__device__ __forceinline__ bf16_t f2bf_hw(float x) { return (bf16_t)(cvtpk(x, x) & 0xffffu); }
__device__ __forceinline__ float bf2f(bf16_t b) { return __uint_as_float(((unsigned)b) << 16); }
__device__ __forceinline__ bf16_t f2bf(float f) { unsigned u = __float_as_uint(f); u += 0x7fffu + ((u >> 16) & 1u); return (bf16_t)(u >> 16); }
__device__ __forceinline__ unsigned pk2(float lo, float hi) { return (unsigned)f2bf(lo) | ((unsigned)f2bf(hi) << 16); }
#define DPP_F(v_, ctrl_, rmask_) __int_as_float(__builtin_amdgcn_update_dpp(0, __float_as_int(v_), (ctrl_), (rmask_), 0xf, false))
__device__ __forceinline__ float wave_sum(float v) {
    v += DPP_F(v, 0xB1, 0xf); v += DPP_F(v, 0x4E, 0xf); v += DPP_F(v, 0x141, 0xf); v += DPP_F(v, 0x140, 0xf);
    v += DPP_F(v, 0x142, 0xa); v += DPP_F(v, 0x143, 0xc);
    return __int_as_float(__builtin_amdgcn_readlane(__float_as_int(v), 63));
}
__device__ __forceinline__ float wave_max(float v) {
    v = fmaxf(v, DPP_F(v, 0xB1, 0xf)); v = fmaxf(v, DPP_F(v, 0x4E, 0xf)); v = fmaxf(v, DPP_F(v, 0x141, 0xf)); v = fmaxf(v, DPP_F(v, 0x140, 0xf));
    v = fmaxf(v, DPP_F(v, 0x142, 0xa)); v = fmaxf(v, DPP_F(v, 0x143, 0xc));
    return __int_as_float(__builtin_amdgcn_readlane(__float_as_int(v), 63));
}
constexpr float F8_MAX = 448.0f, F8_ACT = 8.0f;
__device__ __forceinline__ unsigned pk4_f8(float a, float b, float c, float d) {
    float mx = F8_MAX; asm volatile("" : "+v"(mx));
    a = __builtin_amdgcn_fmed3f(a, -mx, mx); b = __builtin_amdgcn_fmed3f(b, -mx, mx); c = __builtin_amdgcn_fmed3f(c, -mx, mx); d = __builtin_amdgcn_fmed3f(d, -mx, mx);
    int r = __builtin_amdgcn_cvt_pk_fp8_f32(a, b, 0, false); r = __builtin_amdgcn_cvt_pk_fp8_f32(c, d, r, true); return (unsigned)r; }
__device__ __forceinline__ float moe_wscale(const unsigned* ctl, int t, int e);
__device__ __forceinline__ float quad_sum(float v) { v += DPP_F(v, 0xB1, 0xf); v += DPP_F(v, 0x4E, 0xf); return v; }
__device__ __forceinline__ float sigmoidf_(float x) { return 1.0f / (1.0f + __expf(-x)); }
__device__ __forceinline__ int row_pos(int row) { return row < RREAL ? NMETA + (row & (SEQ - 1)) : row - RREAL; }
__device__ __forceinline__ int row_prev(int row) { if (row < RREAL) return (row & (SEQ - 1)) ? row - 1 : RVALID - 1; return row == RREAL ? -1 : row - 1; }

constexpr size_t MiB = 1u << 20;
constexpr size_t WS_CTL = 0;
constexpr size_t WS_HMETA = 1 * MiB;
constexpr size_t WS_WB = 2 * MiB;
constexpr size_t LW_STRIDE = 10 * MiB;
constexpr size_t LW_WIN = 0, LW_WUQ = LW_WIN + (size_t)2816 * 1024 * 2, LW_WK = LW_WUQ + (size_t)768 * 512 * 2, LW_WV = LW_WK + (size_t)512 * 256 * 2,
                 LW_LORA = LW_WV + (size_t)512 * 256 * 2, LW_WOUT = LW_LORA + (size_t)1536 * 256 * 2, LW_END = LW_WOUT + (size_t)1024 * 1024 * 2;
static_assert(LW_END <= LW_STRIDE, "layer weights");
constexpr size_t WS_V1T = WS_WB + 2 * LW_STRIDE, WS_V2T = WS_V1T + (size_t)256 * 512 * 2, WS_FGU = WS_V2T + (size_t)512 * 256 * 2,
                 WS_FDN = WS_FGU + (size_t)5632 * 1024 * 2, WS_ROPE = WS_FDN + (size_t)1024 * 2816 * 2, WS_WB_END = WS_ROPE + (size_t)4112 * 64 * 4;
constexpr size_t WS_TB = WS_FGU;
constexpr size_t WS_ARENA = 41 * MiB;
static_assert(WS_WB_END <= WS_ARENA, "weights fit");
static_assert((size_t)8 * 256 * 1024 * 4 <= (size_t)5632 * 1024 * 2, "list-1 tail buffer fits the dense gate/up weight slot");
constexpr size_t SZ_R1024 = (size_t)RP * 1024 * 2, SZ_R512 = (size_t)RP * 512 * 2, SZ_R256 = (size_t)RP * 256 * 2;
constexpr size_t A_U = WS_ARENA;
constexpr size_t A_KN = A_U + SZ_R1024;
constexpr size_t A_VT = A_KN + SZ_R512;
constexpr size_t A_LOUT = A_U, A_VMIX = A_VT;
static_assert((size_t)RP * 1536 * 2 == SZ_R1024 + SZ_R512, "LORA_OUT fills the U and KN slots exactly");
constexpr size_t A_PM = A_VT + SZ_R512;
constexpr size_t A_PR = A_PM + SZ_R1024;
constexpr size_t A_SMALL = A_PR + (size_t)RP * PRW * 2;
constexpr size_t A_RSTDQ = A_SMALL, A_RSTDKV = A_RSTDQ + (size_t)RP * 4, A_KROPE = A_RSTDKV + (size_t)RP * 4, A_SMALL_END = A_KROPE + (size_t)RP * 64 * 2;
constexpr size_t A_LIN = (A_SMALL_END + 4095) & ~(size_t)4095;
constexpr size_t A_VSH = A_LIN + SZ_R256;
constexpr size_t A_CHK = A_LIN;
constexpr size_t SZ_CHK = (size_t)258 * 8 * 32768;
constexpr size_t A_VFIRST = (A_CHK + SZ_CHK > A_VSH + SZ_R512 ? A_CHK + SZ_CHK : A_VSH + SZ_R512);
constexpr size_t A_VP = A_VFIRST + SZ_R512;
constexpr size_t A_RK = A_VP + SZ_R512;
constexpr size_t A_YS = A_RK + (size_t)RP * 8 * 4;
constexpr size_t A_SCST = A_YS + SZ_R512;
constexpr size_t A_PART = A_SCST + (size_t)64 * 4096 * 4;
constexpr size_t A_END1 = A_PART + (size_t)11 * NMETA * 1024 * 4;
constexpr size_t A_ACT0 = A_PM;
constexpr size_t A_MGU = A_KN;
constexpr size_t A_MDN = A_MGU + (size_t)NEXP * 7168 * 1024 * 2;
constexpr size_t A_MTAB = A_MDN + (size_t)NEXP * 1024 * 3584 * 2;
constexpr size_t MT_E = 0, MT_G = MT_E + (size_t)2 * RREAL * 4, MT_STOK = MT_G + (size_t)2 * RREAL * 4, MT_TSLOT = MT_STOK + (size_t)2 * MOE_MAXPAN * 256 * 4  , MT_SGATE = MT_TSLOT + (size_t)RREAL * 4,
                 MT_BE = MT_SGATE + (size_t)2 * MOE_MAXPAN * 256 * 4, MT_END = MT_BE + 2 * 256 * 4;
constexpr size_t A_MACT = (A_MTAB + MT_END + 4095) & ~(size_t)4095;
constexpr size_t XB_LIST = (size_t)MOE_MAXPAN * 256 * 1024;
constexpr size_t A_XB = A_MACT + (size_t)MOE_MAXPAN * 256 * FFE;
static_assert(A_XB + 2 * XB_LIST <= A_MACT + (size_t)MOE_MAXPAN * 256 * FFE * 2, "XB inside the old activation footprint");
constexpr size_t A_END2 = A_MACT + (size_t)MOE_MAXPAN * 256 * FFE * 2;
constexpr size_t WS_NEED = (A_END1 > A_END2 ? A_END1 : A_END2);
static_assert(WS_NEED <= 557619232ull, "workspace budget (sum of the inputs' bytes)");
static_assert(A_ACT0 + (size_t)RP * FF0 * 2 <= A_SMALL, "dense act overlay");
constexpr int CW_CNT = 64;
constexpr int CW_FILL = 128;
constexpr int CW_NPAN = 192;
constexpr int CW_WINV = 16448;
constexpr int CW_WMAX = 16384;
constexpr int CW_WGCNT = 8192;


__device__ __forceinline__ unsigned long long kp_uniform(unsigned long long kp) { const unsigned lo = __builtin_amdgcn_readfirstlane((unsigned)kp), hi = __builtin_amdgcn_readfirstlane((unsigned)(kp >> 32)); return ((unsigned long long)hi << 32) | lo; }
__device__ __forceinline__ const void* ldk(unsigned long long kp, int off) { unsigned long long v;
    asm volatile("s_load_dwordx2 %0, %1, %2\n\ts_waitcnt lgkmcnt(0)" : "=s"(v) : "s"(kp), "i"(off) : "memory"); return (const void*)v; }
__device__ __forceinline__ int opq(int v) { asm volatile("" : "+v"(v)); return v; }
__device__ __forceinline__ int opqs(int v) { asm volatile("" : "+s"(v)); return v; }
__device__ __forceinline__ void lds_barrier() { asm volatile("s_waitcnt lgkmcnt(0)\n\ts_barrier" ::: "memory"); }

__device__ __forceinline__ float moe_wscale_bits(unsigned bits) { const float m = __uint_as_float(bits);
    return m > 0.f ? __builtin_amdgcn_exp2f(floorf(__builtin_amdgcn_logf(224.0f / m))) : 1.0f; }
__device__ __forceinline__ float moe_wscale(const unsigned* ctl, int t, int e) { return moe_wscale_bits((unsigned)__builtin_amdgcn_readfirstlane((int)ctl[CW_WMAX + t * 8 + e])); }
#define XB_TMO      128
#define XB_XCNT(j)  (256  + 64 * (j))
#define XB_XSUB(j)  (1280 + 64 * (j))
#define XB_XGEN(j)  (2304 + 64 * (j))
#define XB_TOP      3328
#define XB_TOPGEN   3392
#define XCD_BAR_WORDS 3456
#define XB_SPIN_CAP (1u << 18)

__device__ __forceinline__ unsigned xb_ld(unsigned* p)              { return __hip_atomic_load(p, __ATOMIC_RELAXED, __HIP_MEMORY_SCOPE_AGENT); }
__device__ __forceinline__ unsigned xb_add(unsigned* p, unsigned v) { return __hip_atomic_fetch_add(p, v, __ATOMIC_RELAXED, __HIP_MEMORY_SCOPE_AGENT); }
__device__ __forceinline__ unsigned xb_xcc_id() { return (unsigned)__builtin_amdgcn_s_getreg((3 << 11) | 20) & 0xFu; }
#define XB_SPIN(cond, bar) do { unsigned _sp = 0; while (cond) { __builtin_amdgcn_s_sleep(1); \
    if ((++_sp & 255u) == 0u) { if (xb_ld(&(bar)[XB_TMO])) break; if (_sp > XB_SPIN_CAP) { atomicAdd(&(bar)[XB_TMO], 1u); break; } } } } while (0)

struct XcdBarrier {
    unsigned* bar; unsigned x;
    volatile LAS unsigned* st;
};

__device__ __forceinline__ XcdBarrier xcd_barrier_post(unsigned* bar, volatile LAS unsigned* st) {
    XcdBarrier b; b.bar = bar; b.x = xb_xcc_id(); b.st = st;
    if (threadIdx.x == 0) (void)xb_add(&bar[XB_XCNT(b.x)], 1u);
    return b;
}
__device__ __forceinline__ void xcd_barrier_complete(unsigned* bar, unsigned x, unsigned& nloc, unsigned& nx) {
    const unsigned G = gridDim.x * gridDim.y * gridDim.z;
    unsigned sum, cnt, mine, sp = 0u;
    for (;;) {
        sum = 0u; cnt = 0u; mine = 0u;
#pragma unroll
        for (unsigned j = 0; j < 16; ++j) { const unsigned c = xb_ld(&bar[XB_XCNT(j)]); sum += c; cnt += (c > 0u) ? 1u : 0u; mine = (j == x) ? c : mine; }
        if (sum == G) break;
        __builtin_amdgcn_s_sleep(1);
        if ((++sp & 255u) == 0u) { if (xb_ld(&bar[XB_TMO])) break; if (sp > XB_SPIN_CAP) { atomicAdd(&bar[XB_TMO], 1u); break; } }
    }
    nloc = mine > 0u ? mine : 1u; nx = cnt > 0u ? cnt : 1u;
}

__device__ __attribute__((noinline)) void xcd_barrier_fn(unsigned* bar_, unsigned x_, volatile LAS unsigned* st_) {
    XcdBarrier b; b.bar = bar_; b.x = x_; b.st = st_;
    asm volatile("s_waitcnt vmcnt(0)" ::: "memory");
    __syncthreads();
    if (threadIdx.x == 0) {
        unsigned* bar = b.bar;
        __builtin_amdgcn_s_waitcnt(0);
        unsigned nloc = b.st[0], nx = b.st[1];
        if (nloc == 0u) { xcd_barrier_complete(bar, b.x, nloc, nx); b.st[0] = nloc; b.st[1] = nx; }
        const unsigned old = xb_add(&bar[XB_XSUB(b.x)], 1u);
        const unsigned gen = old / nloc;
        if (old + 1u == (gen + 1u) * nloc) {
            __builtin_amdgcn_fence(__ATOMIC_RELEASE, "agent");
            asm volatile("s_waitcnt vmcnt(0)" ::: "memory");
            const unsigned og = xb_add(&bar[XB_TOP], 1u);
            const unsigned tg = og / nx;
            if (og + 1u == (tg + 1u) * nx) xb_add(&bar[XB_TOPGEN], 1u);
            else XB_SPIN(xb_ld(&bar[XB_TOPGEN]) == tg, bar);
            __builtin_amdgcn_fence(__ATOMIC_ACQUIRE, "agent");
            xb_add(&bar[XB_XGEN(b.x)], 1u);
            asm volatile("s_waitcnt vmcnt(0)" ::: "memory");
        } else {
            XB_SPIN(xb_ld(&bar[XB_XGEN(b.x)]) == gen, bar);
            __builtin_amdgcn_fence(__ATOMIC_ACQUIRE, "agent");
            asm volatile("s_waitcnt vmcnt(0)" ::: "memory");
        }
    }
    __syncthreads();
}

__device__ __forceinline__ void xcd_barrier(const XcdBarrier& b) { xcd_barrier_fn(b.bar, b.x, b.st); }
using pg8::Unit;
struct EpiInProj { static constexpr bool PERM = true, AFTER_DRAIN = false; bf16_t* PM; bf16_t* PR;
    __device__ __forceinline__ void operator()(const f32x4 (&acc)[2][2][4][2], const Unit& u, int wr, int wc, int fr, int fq) const {
        const int row0 = u.pm * 256 + wr * 64 + fr; bf16_t* base; int ld, colt;
        if (u.pn < 4) { base = PM; ld = PMW; colt = u.pn * 256; } else { base = PR; ld = PRW; colt = (u.pn - 4) * 256; }
        const int col0 = colt + wc * 32 + 8 * fq;
#pragma unroll
        for (int ai = 0; ai < 2; ++ai)
#pragma unroll
            for (int m = 0; m < 4; ++m) { bf16_t* rowp = base + (size_t)(row0 + ai * 128 + m * 16) * ld + col0;
#pragma unroll
                for (int bj = 0; bj < 2; ++bj) { const f32x4 v0 = acc[ai][bj][m][0], v1 = acc[ai][bj][m][1];
                    u32x4 w; w.x = pg8::cvt_pk_bf16(v0[0], v0[1]); w.y = pg8::cvt_pk_bf16(v0[2], v0[3]); w.z = pg8::cvt_pk_bf16(v1[0], v1[1]); w.w = pg8::cvt_pk_bf16(v1[2], v1[3]);
                    *(u32x4*)(rowp + bj * 128) = w; } }
    }
};
struct EpiRowScale { static constexpr bool PERM = true, AFTER_DRAIN = false; bf16_t* O; const float* rs; int ldc, pad;
    __device__ __forceinline__ void operator()(const f32x4 (&acc)[2][2][4][2], const Unit& u, int wr, int wc, int fr, int fq) const {
        const int row0 = u.pm * 256 + wr * 64 + fr; const int col0 = u.pn * 256 + wc * 32 + 8 * fq;
#pragma unroll
        for (int ai = 0; ai < 2; ++ai)
#pragma unroll
            for (int m = 0; m < 4; ++m) { const int row = row0 + ai * 128 + m * 16; const float s = rs ? rs[row] : 1.f; bf16_t* rowp = O + (size_t)row * ldc + col0;
#pragma unroll
                for (int bj = 0; bj < 2; ++bj) { const f32x4 v0 = acc[ai][bj][m][0] * s, v1 = acc[ai][bj][m][1] * s;
                    u32x4 w; w.x = pg8::cvt_pk_bf16(v0[0], v0[1]); w.y = pg8::cvt_pk_bf16(v0[2], v0[3]); w.z = pg8::cvt_pk_bf16(v1[0], v1[1]); w.w = pg8::cvt_pk_bf16(v1[2], v1[3]);
                    *(u32x4*)(rowp + bj * 128) = w; } }
    }
};
struct EpiColScale { static constexpr bool PERM = true, AFTER_DRAIN = false; bf16_t* O; const float* cs; int ldc, pad;
    __device__ __forceinline__ void operator()(const f32x4 (&acc)[2][2][4][2], const Unit& u, int wr, int wc, int fr, int fq) const {
        const int row0 = u.pm * 256 + wr * 64 + fr; const int col0 = u.pn * 256 + wc * 32 + 8 * fq;
        f32x4 sc[2][2];
#pragma unroll
        for (int bj = 0; bj < 2; ++bj) { sc[bj][0] = *(const f32x4*)(cs + col0 + bj * 128); sc[bj][1] = *(const f32x4*)(cs + col0 + bj * 128 + 4); }
#pragma unroll
        for (int ai = 0; ai < 2; ++ai)
#pragma unroll
            for (int m = 0; m < 4; ++m) { bf16_t* rowp = O + (size_t)(row0 + ai * 128 + m * 16) * ldc + col0;
#pragma unroll
                for (int bj = 0; bj < 2; ++bj) { const f32x4 v0 = acc[ai][bj][m][0] * sc[bj][0], v1 = acc[ai][bj][m][1] * sc[bj][1];
                    u32x4 w; w.x = pg8::cvt_pk_bf16(v0[0], v0[1]); w.y = pg8::cvt_pk_bf16(v0[2], v0[3]); w.z = pg8::cvt_pk_bf16(v1[0], v1[1]); w.w = pg8::cvt_pk_bf16(v1[2], v1[3]);
                    *(u32x4*)(rowp + bj * 128) = w; } }
    }
};
struct EpiResid { static constexpr bool PERM = false, AFTER_DRAIN = false; float* out; float* hmeta; const float* src; float scale; int pad;
    __device__ __forceinline__ void operator()(const f32x4 (&acc)[2][2][4][2], const Unit& u, int wr, int wc, int fr, int fq) const {
        const int rl = wr * 64 + fr, col0 = u.pn * 256 + wc * 32 + 4 * fq;
        float* base = u.pm < 128 ? out + (size_t)u.pm * 256 * D : hmeta; const float* sbase = u.pm < 128 ? src + (size_t)u.pm * 256 * D : hmeta;
#pragma unroll
        for (int ai = 0; ai < 2; ++ai)
#pragma unroll
            for (int m = 0; m < 4; ++m) { const size_t ro = (size_t)(rl + ai * 128 + m * 16) * D + col0;
#pragma unroll
                for (int bj = 0; bj < 2; ++bj)
#pragma unroll
                    for (int n = 0; n < 2; ++n) { const f32x4 hv = *(const f32x4*)(sbase + ro + bj * 128 + n * 16); *(f32x4*)(base + ro + bj * 128 + n * 16) = hv + acc[ai][bj][m][n] * scale; }
                asm volatile("" ::: "memory"); }
    }
};
struct EpiSwiGLU { static constexpr bool PERM = true, AFTER_DRAIN = false; bf16_t* O; int ldc, nmod, pn_off, pad;
    __device__ __forceinline__ void operator()(const f32x4 (&acc)[2][2][4][2], const Unit& u, int wr, int wc, int fr, int fq) const {
        const int row0 = u.pm * 256 + wr * 64 + fr; const int pnl = (u.pn % nmod) - pn_off; const int col0 = pnl * 128 + wc * 32 + 8 * fq;
#pragma unroll
        for (int ai = 0; ai < 2; ++ai)
#pragma unroll
            for (int m = 0; m < 4; ++m) { bf16_t* rowp = O + (size_t)(row0 + ai * 128 + m * 16) * ldc + col0; float r[8];
#pragma unroll
                for (int n = 0; n < 2; ++n)
#pragma unroll
                    for (int j = 0; j < 4; ++j) { const float g = acc[ai][0][m][n][j], up = acc[ai][1][m][n][j]; r[4 * n + j] = g / (1.0f + __expf(-g)) * up; }
                u32x4 w; w.x = pg8::cvt_pk_bf16(r[0], r[1]); w.y = pg8::cvt_pk_bf16(r[2], r[3]); w.z = pg8::cvt_pk_bf16(r[4], r[5]); w.w = pg8::cvt_pk_bf16(r[6], r[7]);
                *(u32x4*)rowp = w; }
    }
};
struct EpiSwiGLU8 { static constexpr bool PERM = false, AFTER_DRAIN = false; unsigned char* O; const unsigned* ctl; int ldc, nmod;
    __device__ __forceinline__ void operator()(const f32x4 (&acc)[2][2][4][2], const Unit& u, int wr, int wc, int fr, int fq) const {
        const int row0 = u.pm * 256 + wr * 64 + fr; const int e = u.pn / nmod, pnl = u.pn % nmod; const int col0 = pnl * 128 + wc * 32 + 4 * fq;
        const float ig = __uint_as_float(__builtin_amdgcn_readfirstlane((int)ctl[CW_WINV + e])), iu = __uint_as_float(__builtin_amdgcn_readfirstlane((int)ctl[CW_WINV + 8 + e])) * F8_ACT;
#pragma unroll
        for (int ai = 0; ai < 2; ++ai)
#pragma unroll
            for (int m = 0; m < 4; ++m) { unsigned char* rowp = O + (size_t)(row0 + ai * 128 + m * 16) * ldc + col0;
#pragma unroll
                for (int n = 0; n < 2; ++n) { float r[4];
#pragma unroll
                    for (int j = 0; j < 4; ++j) { const float g = acc[ai][0][m][n][j] * ig, up = acc[ai][1][m][n][j] * iu; r[j] = g / (1.0f + __expf(-g)) * up; }
                    *(unsigned*)(rowp + n * 16) = pk4_f8(r[0], r[1], r[2], r[3]); } }
    }
};
struct EpiMoeDown { static constexpr bool PERM = false, AFTER_DRAIN = false; float* out; const int* stok; const float* sgate; int nmod; float scale; const unsigned* ctl;
    __device__ __forceinline__ void operator()(const f32x4 (&acc)[2][2][4][2], const Unit& u, int wr, int wc, int fr, int fq) const {
        const int row0 = u.pm * 256 + wr * 64 + fr; const int col0 = (u.pn % nmod) * 256 + wc * 32 + 4 * fq;
        const float winv = ctl ? __uint_as_float(__builtin_amdgcn_readfirstlane((int)ctl[CW_WINV + 16 + u.pn / nmod])) : 1.0f;
#pragma unroll
        for (int ai = 0; ai < 2; ++ai)
#pragma unroll
            for (int m = 0; m < 4; ++m) { const int prow = row0 + ai * 128 + m * 16; const int tok = stok[prow]; if (tok < 0) continue; const float gt = sgate[prow] * scale * winv;
                float* rowp = out + (size_t)tok * D + col0;
#pragma unroll
                for (int bj = 0; bj < 2; ++bj)
#pragma unroll
                    for (int n = 0; n < 2; ++n) { f32x4* p = (f32x4*)(rowp + bj * 128 + n * 16); *p = *p + acc[ai][bj][m][n] * gt; }
                asm volatile("" ::: "memory"); }
    }
};
struct EpiMoeDownStore { static constexpr bool PERM = false, AFTER_DRAIN = false; float* tb; const int* stok; const float* sgate; int nmod, pm0; const unsigned* ctl;
    __device__ __forceinline__ void operator()(const f32x4 (&acc)[2][2][4][2], const Unit& u, int wr, int wc, int fr, int fq) const {
        const int row0 = u.pm * 256 + wr * 64 + fr; const int col0 = (u.pn % nmod) * 256 + wc * 32 + 4 * fq;
#pragma unroll
        for (int ai = 0; ai < 2; ++ai)
#pragma unroll
            for (int m = 0; m < 4; ++m) { const int prow = row0 + ai * 128 + m * 16; const int tok = stok[prow]; if (tok < 0) continue; const float gt = sgate[prow] * __uint_as_float(__builtin_amdgcn_readfirstlane((int)ctl[CW_WINV + 16 + u.pn / nmod]));
                float* rowp = tb + (size_t)(prow - pm0 * 256) * D + col0;
#pragma unroll
                for (int bj = 0; bj < 2; ++bj)
#pragma unroll
                    for (int n = 0; n < 2; ++n) *(f32x4*)(rowp + bj * 128 + n * 16) = acc[ai][bj][m][n] * gt; }
    }
};
struct MoeOrder { static constexpr bool GATHER = false; const int* block_e; const unsigned* npan; int nN, emul, pn_off, G, c, lmax;
    __device__ __forceinline__ bool next(int i, Unit& u) const { const int L = i * G + c; const int np = __builtin_amdgcn_readfirstlane((int)(*npan)); if (L >= np * nN || (lmax && L >= lmax)) return false;
        const int pm = L / nN; u.k0 = 0; u.pm = pm; u.pn = __builtin_amdgcn_readfirstlane(block_e[pm]) * emul + pn_off + (L % nN); return true; }
    __device__ __forceinline__ void a_ready(const Unit&) const {}
    __device__ __forceinline__ void done(const Unit&) const {}
};


struct EpiResidPartial { static constexpr bool PERM = false, AFTER_DRAIN = false; float* part;
    __device__ __forceinline__ void operator()(const f32x4 (&acc)[2][2][4][2], const Unit& u, int wr, int wc, int fr, int fq) const {
        const int rl = wr * 64 + fr, col0 = u.pn * 256 + wc * 32 + 4 * fq; float* base = part + (size_t)(u.k0 >> 8) * NMETA * D;
#pragma unroll
        for (int ai = 0; ai < 2; ++ai)
#pragma unroll
            for (int m = 0; m < 4; ++m) { const int row = rl + ai * 128 + m * 16; if (row >= NMETA) continue;
                float* rowp = base + (size_t)row * D + col0;
#pragma unroll
                for (int bj = 0; bj < 2; ++bj)
#pragma unroll
                    for (int n = 0; n < 2; ++n) *(f32x4*)(rowp + bj * 128 + n * 16) = acc[ai][bj][m][n]; }
    }
};
struct DenseTailOrder { static constexpr bool GATHER = false; int nN, nsl, G, c;
    __device__ __forceinline__ bool next(int i, Unit& u) const { const int idx = i * G + c; if (idx >= nN * nsl) return false; u.pm = 128; u.pn = idx / nsl; u.k0 = (idx % nsl) * 256; return true; }
    __device__ __forceinline__ void a_ready(const Unit&) const {}
    __device__ __forceinline__ void done(const Unit&) const {}
};
template <bool GA> struct MoeGatherOrderT { static constexpr bool GATHER = GA;
    const int* block_e; const unsigned* npan; const int* rows; int nN, emul, pn_off, G, c, zero_row;
    int pm_lo, pm_hi, gap, rot, T, cskip;
    __device__ __forceinline__ bool next(int i, Unit& u) const {
        int cc = c - rot; cc += cc < 0 ? G : 0;
        int L;
        if (T == 0) L = i * G + cc;
        else { const int W0 = G - T; if (cc < W0) L = i < cskip ? i * W0 + cc : cskip * W0 + (i - cskip) * G + cc; else L = cskip * W0 + i * G + cc; }
        int np = __builtin_amdgcn_readfirstlane((int)(*npan)); np = np < pm_hi ? np : pm_hi;
        const int pl = pm_lo + L / nN; if (pl >= np) return false;
        const int pm = pl + (pl >= MOE_TAILPAN ? gap : 0); u.k0 = 0; u.pm = pm; u.pn = __builtin_amdgcn_readfirstlane(block_e[pm]) * emul + pn_off + (L % nN); return true; }
    __device__ __forceinline__ void a_ready(const Unit&) const {}
    __device__ __forceinline__ void done(const Unit&) const {}
};
using MoeGatherOrder = MoeGatherOrderT<true>; using MoeSlotOrder = MoeGatherOrderT<false>;
struct MoeShiftTailOrder { static constexpr bool GATHER = false; const int* block_e; const unsigned* npan; int nN, emul, gap, wg_first, c, pad;
    __device__ __forceinline__ bool next(int i, Unit& u) const { const int t = wg_first - c; const int np = __builtin_amdgcn_readfirstlane((int)(*npan)); const int L = MOE_TAILPAN * nN + t;
        if (i > 0 || t < 0 || L >= np * nN) return false;
        const int pm = L / nN + gap; u.k0 = 0; u.pm = pm; u.pn = __builtin_amdgcn_readfirstlane(block_e[pm]) * emul + (L % nN); return true; }
    __device__ __forceinline__ void a_ready(const Unit&) const {}
    __device__ __forceinline__ void done(const Unit&) const {}
};

__device__ __forceinline__ int map_row(int mode, int n, int rowoff) {
    if (mode == 1) return n < 832 ? n : n + 192;
    if (mode == 2) return rowoff + (n >> 7) * 256 + (n & 127);
    if (mode == 3) return rowoff + (n >> 7) * 256 + 128 + (n & 127);
    if (mode == 4) return (n >> 8) * 128 + (n & 127) + ((n & 128) ? 512 : 0);
    return rowoff + n;
}
__device__ __forceinline__ void transpose_item(const float* __restrict__ W, int K, int N, bf16_t* __restrict__ dst, int ld, int koff, int mode, int rowoff, const float* __restrict__ gain, LAS float* scr, int item, int lane) {
    const int nblk = N / 32; const int kb = item / nblk, nb = item % nblk, k0 = 64 * kb, n0 = 32 * nb;
    float ld_[32];
#pragma unroll
    for (int i = 0; i < 32; ++i) ld_[i] = W[(size_t)(k0 + 2 * i + (lane >> 5)) * N + n0 + (lane & 31)];
#pragma unroll
    for (int i = 0; i < 32; ++i) { const int kk = 2 * i + (lane >> 5); float v = ld_[i]; if (gain) v *= gain[k0 + kk]; scr[kk * 33 + (lane & 31)] = v; }
    asm volatile("s_waitcnt lgkmcnt(0)" ::: "memory");
    const int c = lane & 7;
#pragma unroll
    for (int j = 0; j < 4; ++j) { const int n = (lane >> 3) + 8 * j; const LAS float* s = scr + (8 * c) * 33 + n;
        u32x4 o; o.x = pk2(s[0 * 33], s[1 * 33]); o.y = pk2(s[2 * 33], s[3 * 33]); o.z = pk2(s[4 * 33], s[5 * 33]); o.w = pk2(s[6 * 33], s[7 * 33]);
        *(u32x4*)(dst + (size_t)map_row(mode, n0 + n, rowoff) * ld + koff + k0 + 8 * c) = o; }
    asm volatile("s_waitcnt lgkmcnt(0)" ::: "memory");
}
__device__ __forceinline__ void transpose_item_f8(const float* __restrict__ W, int K, int N, unsigned char* __restrict__ dst, int ld, int mode, int rowoff, float scale, LAS float* scr, int item, int lane) {
    const int nblk = N / 32; const int kb = item / nblk, nb = item % nblk, k0 = 64 * kb, n0 = 32 * nb;
    float ld_[32];
#pragma unroll
    for (int i = 0; i < 32; ++i) ld_[i] = W[(size_t)(k0 + 2 * i + (lane >> 5)) * N + n0 + (lane & 31)];
#pragma unroll
    for (int i = 0; i < 32; ++i) { const int kk = 2 * i + (lane >> 5); scr[kk * 33 + (lane & 31)] = ld_[i] * scale; }
    asm volatile("s_waitcnt lgkmcnt(0)" ::: "memory");
    const int c = lane & 7;
#pragma unroll
    for (int j = 0; j < 4; ++j) { const int n = (lane >> 3) + 8 * j; const LAS float* s = scr + (8 * c) * 33 + n;
        u32x2 o; o.x = pk4_f8(s[0 * 33], s[1 * 33], s[2 * 33], s[3 * 33]); o.y = pk4_f8(s[4 * 33], s[5 * 33], s[6 * 33], s[7 * 33]);
        *(u32x2*)(dst + (size_t)map_row(mode, n0 + n, rowoff) * ld + k0 + 8 * c) = o; }
    asm volatile("s_waitcnt lgkmcnt(0)" ::: "memory");
}
struct TrJob8 { const float* W; unsigned char* dst; int K, N, ld, mode, rowoff; float scale; };
__device__ __forceinline__ void ph_transpose_f8(const TrJob8& J, LAS float* scr, int gw, int ngw, int lane, int rot = 0) {
    lane = opq(lane);
    const int nitems = (J.K / 64) * (J.N / 32);
    int it0 = gw - rot % ngw; it0 += it0 < 0 ? ngw : 0;
    for (int it = it0; it < nitems; it += ngw) transpose_item_f8(J.W, J.K, J.N, J.dst, J.ld, J.mode, J.rowoff, J.scale, scr, it, lane);
}
struct TrJob { const float* W; const float* gain; bf16_t* dst; int K, N, ld, koff, mode, rowoff; };
__device__ __forceinline__ void ph_transpose(const TrJob& J, LAS float* scr, int gw, int ngw, int lane, int rot = 0) {
    lane = opq(lane);
    const int nitems = (J.K / 64) * (J.N / 32);
    int it0 = gw - rot % ngw; it0 += it0 < 0 ? ngw : 0;
    for (int it = it0; it < nitems; it += ngw) transpose_item(J.W, J.K, J.N, J.dst, J.ld, J.koff, J.mode, J.rowoff, J.gain, scr, it, lane);
}
__device__ __forceinline__ const float* hrow_c(const float* out, const float* hmeta, int row) { return row < RREAL ? out + (size_t)row * D : hmeta + (size_t)(row - RREAL) * D; }
__device__ __forceinline__ void ph_init(const float* __restrict__ x, const float* __restrict__ meta, float* __restrict__ out, float* __restrict__ hmeta, float* __restrict__ rope,
                                        const float* __restrict__ v1, const float* __restrict__ v2, bf16_t* __restrict__ v12t, size_t gt, size_t ngt) {
    (void)x; (void)out;
    for (size_t i = gt; i < (size_t)256 * D; i += ngt) hmeta[i] = i < (size_t)NMETA * D ? meta[i] : 0.f;
    for (size_t i = gt; i < (size_t)4112 * 32; i += ngt) { const int pos = (int)(i / 32), j = (int)(i % 32);
        const float inv = powf(10000.0f, -(float)j / 32.0f); const float ang = (float)pos * inv; rope[2 * i] = cosf(ang); rope[2 * i + 1] = sinf(ang); }
    for (size_t i = gt; i < (size_t)512 * 512; i += ngt) { const int n = (int)(i >> 9), k = (int)(i & 511); float s = 0.f;
#pragma unroll 8
        for (int j = 0; j < 32; ++j) s += v1[k * 32 + j] * v2[j * 512 + n];
        v12t[i] = f2bf(s); }
}
__device__ __forceinline__ void ph_rmsnorm(const float* __restrict__ out, const float* hmeta, const float* __restrict__ g, bf16_t* __restrict__ U, const float* __restrict__ part, int nsl, int gw, int ngw, int lane) {
    lane = opq(lane);
    for (int row = gw; row < RP; row += ngw) {
        unsigned long long* o8 = (unsigned long long*)(U + (size_t)row * D) + lane;
        if (row >= RVALID) {
#pragma unroll
            for (int j = 0; j < 4; ++j) o8[64 * j] = 0ull;
            continue; }
        const f32x4* xr = (const f32x4*)hrow_c(out, hmeta, row) + lane; const f32x4* g4 = (const f32x4*)g + lane;
        f32x4 v[4]; float s = 0.f;
#pragma unroll
        for (int j = 0; j < 4; ++j) v[j] = xr[64 * j];
        if (row >= RREAL && nsl > 0) {
            for (int sl = 0; sl < nsl; ++sl) { const f32x4* pr = (const f32x4*)(part + ((size_t)sl * NMETA + (row - RREAL)) * D) + lane;
#pragma unroll
                for (int j = 0; j < 4; ++j) v[j] = v[j] + pr[64 * j]; }
            f32x4* hw = (f32x4*)xr;
#pragma unroll
            for (int j = 0; j < 4; ++j) hw[64 * j] = v[j]; }
#pragma unroll
        for (int j = 0; j < 4; ++j) s += (v[j].x * v[j].x + v[j].y * v[j].y) + (v[j].z * v[j].z + v[j].w * v[j].w);
        const float rstd = rsqrtf(wave_sum(s) * (1.f / D) + RMS_EPS);
#pragma unroll
        for (int j = 0; j < 4; ++j) { const f32x4 gg = g4[64 * j]; o8[64 * j] = (unsigned long long)pk2(v[j].x * rstd * gg.x, v[j].y * rstd * gg.y) | ((unsigned long long)pk2(v[j].z * rstd * gg.z, v[j].w * rstd * gg.w) << 32); }
    }
}
__device__ __forceinline__ void unpack8(const u32x4 v, float (&f)[8]) {
    f[0] = __uint_as_float(v.x << 16); f[1] = __uint_as_float(v.x & 0xffff0000u); f[2] = __uint_as_float(v.y << 16); f[3] = __uint_as_float(v.y & 0xffff0000u);
    f[4] = __uint_as_float(v.z << 16); f[5] = __uint_as_float(v.z & 0xffff0000u); f[6] = __uint_as_float(v.w << 16); f[7] = __uint_as_float(v.w & 0xffff0000u);
}
__device__ __forceinline__ void ph_prep(const bf16_t* __restrict__ PM, const bf16_t* __restrict__ PR, const float* __restrict__ mu, const float* __restrict__ rope,
                                        float* __restrict__ rstdq, float* __restrict__ rstdkv, bf16_t* __restrict__ KR, bf16_t* __restrict__ LIN, bf16_t* __restrict__ VSH, int do_vsh, int gw, int ngw, int lane) {
    lane = opq(lane);
    for (int row = gw; row < RP; row += ngw) {
        const bf16_t* pm = PM + (size_t)row * PMW;
        float f[8], sq = 0.f, skv = 0.f;
        unpack8(*(const u32x4*)(pm + lane * 8), f);
#pragma unroll
        for (int j = 0; j < 8; ++j) sq += f[j] * f[j];
        if (lane < 32) { unpack8(*(const u32x4*)(pm + 512 + lane * 8), f);
#pragma unroll
            for (int j = 0; j < 8; ++j) skv += f[j] * f[j]; }
        sq = wave_sum(sq); skv = wave_sum(skv);
        if (lane == 0) { rstdq[row] = rsqrtf(sq * (1.f / 512.f) + RMS_EPS); rstdkv[row] = rsqrtf(skv * (1.f / 256.f) + RMS_EPS); }
        const int pos = row_pos(row);
        if (lane < 32) { const float x1 = bf2f(pm[768 + lane]), x2 = bf2f(pm[800 + lane]); const float c = rope[2 * (pos * 32 + lane)], s = rope[2 * (pos * 32 + lane) + 1];
            KR[(size_t)row * 64 + lane] = f2bf(x1 * c - x2 * s); KR[(size_t)row * 64 + 32 + lane] = f2bf(x1 * s + x2 * c); }
        const int pr = row_prev(row); const bool valid = row < RVALID; const float pmk = pr < 0 ? 0.f : 1.f;
        const bf16_t* x = PR + (size_t)row * PRW; const bf16_t* xp = PR + (size_t)(pr < 0 ? row : pr) * PRW;
        if (lane < 32) {
            float a[8], b[8]; unpack8(*(const u32x4*)(x + 1536 + lane * 8), a); unpack8(*(const u32x4*)(xp + 1536 + lane * 8), b);
            const f32x4 m0 = *(const f32x4*)(mu + 1536 + lane * 8), m1 = *(const f32x4*)(mu + 1536 + lane * 8 + 4); const float mm[8] = {m0.x, m0.y, m0.z, m0.w, m1.x, m1.y, m1.z, m1.w};
            float o[8];
#pragma unroll
            for (int j = 0; j < 8; ++j) { float v = a[j] + (pmk * b[j] - a[j]) * mm[j]; v = lane < 8 ? tanhf(v) : (lane < 16 ? v : sigmoidf_(v)); o[j] = valid ? v : 0.f; }
            u32x4 w; w.x = pk2(o[0], o[1]); w.y = pk2(o[2], o[3]); w.z = pk2(o[4], o[5]); w.w = pk2(o[6], o[7]); *(u32x4*)(LIN + (size_t)row * 256 + lane * 8) = w; }
        if (do_vsh) {
            float a[8], b[8]; unpack8(*(const u32x4*)(x + 1024 + lane * 8), a); unpack8(*(const u32x4*)(xp + 1024 + lane * 8), b);
            const f32x4 m0 = *(const f32x4*)(mu + 1024 + lane * 8), m1 = *(const f32x4*)(mu + 1024 + lane * 8 + 4); const float mm[8] = {m0.x, m0.y, m0.z, m0.w, m1.x, m1.y, m1.z, m1.w};
            float o[8];
#pragma unroll
            for (int j = 0; j < 8; ++j) { const float v = a[j] + (pmk * b[j] - a[j]) * mm[j]; o[j] = valid ? v : 0.f; }
            u32x4 w; w.x = pk2(o[0], o[1]); w.y = pk2(o[2], o[3]); w.z = pk2(o[4], o[5]); w.w = pk2(o[6], o[7]); *(u32x4*)(VSH + (size_t)row * 512 + lane * 8) = w; }
    }
}

__device__ __forceinline__ void ph_norm_route(LAS unsigned char* lds, const float* __restrict__ out, const float* __restrict__ g, const float* __restrict__ router, const float* __restrict__ rbias,
                                              bf16_t* __restrict__ U, int* __restrict__ TE, float* __restrict__ TG, int* __restrict__ STOK, unsigned* __restrict__ ctl, int bid, int nblk, int wave, int lane) {
    lane = opq(lane); nblk = opqs(nblk); bid = opqs(bid);
    { constexpr int NFILL = 2 * MOE_MAXPAN * 256 + RREAL; const int per = (NFILL + nblk - 1) / nblk; const int t_ = wave * 64 + lane;
      for (int i = t_; i < per; i += 512) { const int idx = bid * per + i; if (idx < NFILL) STOK[idx] = -1; } }
    const int rpw = (RREAL + nblk - 1) / nblk, rpwave = (rpw + 7) / 8;
    int c1[8], c2[8];
#pragma unroll
    for (int e = 0; e < 8; ++e) { c1[e] = 0; c2[e] = 0; }
    f32x4 rwa[16], rwb[16];
#pragma unroll
    for (int j = 0; j < 4; ++j)
#pragma unroll
        for (int q = 0; q < 4; ++q) { const float* rp = router + (size_t)(4 * (lane + 64 * j) + q) * 8; rwa[4 * j + q] = *(const f32x4*)rp; rwb[4 * j + q] = *(const f32x4*)(rp + 4); }
    f32x4 nx[4];
    { const int rl0 = wave * rpwave, row_0 = bid * rpw + rl0; if (rl0 < rpw && row_0 < RREAL) { const f32x4* x0 = (const f32x4*)(out + (size_t)row_0 * D) + lane;
#pragma unroll
        for (int j = 0; j < 4; ++j) nx[j] = x0[64 * j]; } }
    for (int k = 0; k < rpwave; ++k) { const int rl = wave * rpwave + k; const int row = bid * rpw + rl; if (rl >= rpw || row >= RREAL) break;
        const f32x4* g4 = (const f32x4*)g + lane;
        f32x4 v[4]; float s = 0.f;
#pragma unroll
        for (int j = 0; j < 4; ++j) v[j] = nx[j];
        if (k + 1 < rpwave && rl + 1 < rpw && row + 1 < RREAL) { const f32x4* x1 = (const f32x4*)(out + (size_t)(row + 1) * D) + lane;
#pragma unroll
            for (int j = 0; j < 4; ++j) nx[j] = x1[64 * j]; }
#pragma unroll
        for (int j = 0; j < 4; ++j) s += (v[j].x * v[j].x + v[j].y * v[j].y) + (v[j].z * v[j].z + v[j].w * v[j].w);
        const float rstd = rsqrtf(wave_sum(s) * (1.f / D) + RMS_EPS);
        unsigned* o4 = (unsigned*)((unsigned char*)U + (size_t)row * D) + lane;
        float lg[8];
#pragma unroll
        for (int e = 0; e < 8; ++e) lg[e] = 0.f;
#pragma unroll
        for (int j = 0; j < 4; ++j) { const f32x4 gg = g4[64 * j]; f32x4 xn; xn.x = v[j].x * rstd * gg.x; xn.y = v[j].y * rstd * gg.y; xn.z = v[j].z * rstd * gg.z; xn.w = v[j].w * rstd * gg.w;
            o4[64 * j] = pk4_f8(xn.x * F8_ACT, xn.y * F8_ACT, xn.z * F8_ACT, xn.w * F8_ACT);
#pragma unroll
            for (int q = 0; q < 4; ++q) { const f32x4 ra = rwa[4 * j + q], rb = rwb[4 * j + q]; const float xv = xn[q];
                lg[0] += xv * ra.x; lg[1] += xv * ra.y; lg[2] += xv * ra.z; lg[3] += xv * ra.w; lg[4] += xv * rb.x; lg[5] += xv * rb.y; lg[6] += xv * rb.z; lg[7] += xv * rb.w; }
            }
#pragma unroll
        for (int e = 0; e < 8; ++e) { float t_ = wave_sum(lg[e]); asm volatile("" : "+v"(t_)); lg[e] = t_ + rbias[e]; }
        int e1 = 0; float l1 = lg[0];
#pragma unroll
        for (int e = 1; e < 8; ++e) if (lg[e] > l1) { l1 = lg[e]; e1 = e; }
        int e2 = e1 == 0 ? 1 : 0; float l2 = -INFINITY;
#pragma unroll
        for (int e = 0; e < 8; ++e) if (e != e1 && lg[e] > l2) { l2 = lg[e]; e2 = e; }
        const float g1 = 1.0f / (1.0f + __expf(l2 - l1)), g2 = 1.0f - g1;
        { const int e1v = e1, e2v = e2;
#pragma unroll
        for (int e = 0; e < 8; ++e) { c1[e] += (e1v == e) ? 1 : 0; c2[e] += (e2v == e) ? 1 : 0; } }
        if (lane == 0) { TE[row] = e1; TE[RREAL + row] = e2; TG[row] = g1; TG[RREAL + row] = g2; }
    }
    LAS int* wc = (LAS int*)(lds + 80000);
    if (lane == 0) {
#pragma unroll
        for (int e = 0; e < 8; ++e) { wc[wave * 16 + e] = c1[e]; wc[wave * 16 + 8 + e] = c2[e]; } }
    __syncthreads();
    const int t = wave * 64 + lane;
    if (t < 16) { int sum = 0;
#pragma unroll
        for (int ww = 0; ww < 8; ++ww) sum += wc[ww * 16 + t];
        ctl[CW_WGCNT + bid * 16 + t] = (unsigned)sum; }
}
__device__ __forceinline__ void ph_moe_assign(LAS unsigned char* lds, int list, const int* __restrict__ TE, const float* __restrict__ TG, int* __restrict__ STOK, float* __restrict__ SGATE, int* __restrict__ BE, unsigned* __restrict__ ctl,
                                              const unsigned char* __restrict__ U8, unsigned char* __restrict__ XB, int bid, int nblk, int tid) {
    LAS int* sh = (LAS int*)lds;
    __syncthreads();
    {
        LAS float* shf = (LAS float*)(lds + 2048);
        float tv[8], pv[8];
#pragma unroll
        for (int e = 0; e < 8; ++e) { tv[e] = 0.f; pv[e] = 0.f; }
        for (int b = tid; b < nblk; b += 512) { const u32x4* cp4 = (const u32x4*)(ctl + CW_WGCNT + b * 16 + 8 * list); const u32x4 c0 = cp4[0], c1 = cp4[1];
            const float v[8] = {(float)c0.x, (float)c0.y, (float)c0.z, (float)c0.w, (float)c1.x, (float)c1.y, (float)c1.z, (float)c1.w};
#pragma unroll
            for (int e = 0; e < 8; ++e) { tv[e] += v[e]; pv[e] += b < bid ? v[e] : 0.f; } }
        const int wv = tid >> 6;
#pragma unroll
        for (int e = 0; e < 8; ++e) { const float ts = wave_sum(tv[e]), ps = wave_sum(pv[e]); if ((tid & 63) == 0) { shf[wv * 16 + e] = ts; shf[wv * 16 + 8 + e] = ps; } }
        __syncthreads();
        if (tid < 8) { float tot = 0.f, pre = 0.f;
#pragma unroll
            for (int ww = 0; ww < 8; ++ww) { tot += shf[ww * 16 + tid]; pre += shf[ww * 16 + 8 + tid]; }
            sh[tid] = (int)tot; sh[8 + tid] = (int)pre; }
    }
    __syncthreads();
    if (tid == 0) { int pan = 0;
        for (int e = 0; e < 8; ++e) { const int np = (sh[e] + 255) >> 8; sh[16 + e] = pan << 8;
            if (bid == 0) for (int q = 0; q < np; ++q) { const int pi = pan + q; BE[256 * list + pi + (list == 1 && pi >= MOE_TAILPAN ? MOE_GAP : 0)] = e; }
            pan += np; }
        if (bid == 0) ctl[CW_NPAN + list] = (unsigned)pan; }
    __syncthreads();
    if (tid < 64) {
        const int rpw = (RREAL + nblk - 1) / nblk; int run[8];
#pragma unroll
        for (int q = 0; q < 8; ++q) run[q] = 0;
        for (int r0 = 0; r0 < rpw; r0 += 64) { const int rl = r0 + tid, row = bid * rpw + rl; const bool ok = rl < rpw && row < RREAL;
            const int ee = ok ? TE[list * RREAL + row] : -1; int slot = -1;
#pragma unroll
            for (int e = 0; e < 8; ++e) { const unsigned long long m = __builtin_amdgcn_ballot_w64(ee == e);
                const int rank = (int)__builtin_amdgcn_mbcnt_hi((unsigned)(m >> 32), __builtin_amdgcn_mbcnt_lo((unsigned)m, 0u));
                if (ee == e) { slot = sh[16 + e] + sh[8 + e] + run[e] + rank; if (list == 1 && slot >= MOE_TAILPAN * 256) slot += MOE_GAP * 256; }
                run[e] += __builtin_popcountll(m); }
            if (rl < rpw) sh[32 + rl] = ok ? slot : -1;
            if (ok) { STOK[list * (MOE_MAXPAN * 256) + slot] = row; SGATE[list * (MOE_MAXPAN * 256) + slot] = TG[list * RREAL + row];
                if (list == 1 && slot >= (MOE_TAILPAN + MOE_GAP) * 256) STOK[2 * MOE_MAXPAN * 256 + row] = slot - (MOE_TAILPAN + MOE_GAP) * 256; } }
    }
    __syncthreads();
    {
        const int rpw = (RREAL + nblk - 1) / nblk, w = tid >> 6, ln = tid & 63; unsigned char* xl = XB + (size_t)list * (MOE_MAXPAN * 256) * 1024;
        for (int rl = w; rl < rpw; rl += 8) { const int slot = sh[32 + rl]; if (slot >= 0) ((u32x4*)(xl + (size_t)slot * 1024))[ln] = ((const u32x4*)(U8 + (size_t)(bid * rpw + rl) * 1024))[ln]; }
        if (bid < 8) { const int e = bid, lo = sh[16 + e] + sh[e], hi = sh[16 + e] + (((sh[e] + 255) >> 8) << 8); unsigned z0 = 0u; asm volatile("" : "+v"(z0)); u32x4 z; z.x = z.y = z.z = z.w = z0;
            for (int p0 = lo + w; p0 < hi; p0 += 8) { const int slot = p0 + ((list == 1 && p0 >= MOE_TAILPAN * 256) ? MOE_GAP * 256 : 0); ((u32x4*)(xl + (size_t)slot * 1024))[ln] = z; } }
    }
}
__device__ __forceinline__ void ph_final(float* __restrict__ out, const float* __restrict__ g, const int* __restrict__ tslot, const float* __restrict__ tb, int gw, int ngw, int lane, float pscale = 1.0f) {
    lane = opq(lane);
    for (int row = gw; row < RREAL; row += ngw) {
        f32x4* xr = (f32x4*)(out + (size_t)row * D) + lane; const f32x4* g4 = (const f32x4*)g + lane;
        const int ts = __builtin_amdgcn_readfirstlane(tslot[row]);
        f32x4 v[4]; float s = 0.f;
#pragma unroll
        for (int j = 0; j < 4; ++j) v[j] = xr[64 * j];
        if (ts >= 0) { const f32x4* tr = (const f32x4*)(tb + (size_t)ts * D) + lane;
#pragma unroll
            for (int j = 0; j < 4; ++j) v[j] = v[j] + tr[64 * j]; }
#pragma unroll
        for (int j = 0; j < 4; ++j) s += (v[j].x * v[j].x + v[j].y * v[j].y) + (v[j].z * v[j].z + v[j].w * v[j].w);
        const float rstd = rsqrtf(wave_sum(s) * (1.f / D) + RMS_EPS);
#pragma unroll
        for (int j = 0; j < 4; ++j) { const f32x4 gg = g4[64 * j]; f32x4 o; o.x = v[j].x * rstd * gg.x * pscale; o.y = v[j].y * rstd * gg.y * pscale; o.z = v[j].z * rstd * gg.z * pscale; o.w = v[j].w * rstd * gg.w * pscale; xr[64 * j] = o; }
    }
}

constexpr int KS_STRIDE = 200, VS_STRIDE = 72;
constexpr int ATT_LDS = 64 * KS_STRIDE * 2 + 128 * VS_STRIDE * 2;
__device__ __forceinline__ bf16x8 pack8(const f32x16& x, int s) {
    u32x4 p;
    if (s == 0) { p.x = cvtpk(x[0], x[1]); p.y = cvtpk(x[2], x[3]); p.z = cvtpk(x[4], x[5]); p.w = cvtpk(x[6], x[7]); }
    else { p.x = cvtpk(x[8], x[9]); p.y = cvtpk(x[10], x[11]); p.z = cvtpk(x[12], x[13]); p.w = cvtpk(x[14], x[15]); }
    return __builtin_bit_cast(bf16x8, p);
}
__device__ __forceinline__ void attn_unit(LAS unsigned char* lds, const bf16_t* __restrict__ Q, const bf16_t* __restrict__ KN, const bf16_t* __restrict__ KR, const bf16_t* __restrict__ VT,
                                          bf16_t* __restrict__ MIX, const float* __restrict__ rope, int h, int qrow0, int kbase, int ntile, int wlim, bool wave_active) {
    const int tid = opq(threadIdx.x), lane = tid & 63, w = tid >> 6, r = lane & 31, hh = lane >> 5;
    LAS bf16_t* Ks = (LAS bf16_t*)lds; LAS bf16_t* Vs = (LAS bf16_t*)(lds + 64 * KS_STRIDE * 2);
    const int qrow = qrow0 + 32 * w + r;
    bf16x8 qf[12];
#pragma unroll
    for (int ks = 0; ks < 12; ++ks) qf[ks] = *(const GAS bf16x8*)(Q + (size_t)qrow * 768 + 192 * h + 16 * ks + 8 * hh);
    {
        const int pos = row_pos(qrow); const GAS float* rt = (const GAS float*)(rope + (size_t)pos * 64);
#pragma unroll
        for (int half = 0; half < 2; ++half) { const GAS float* cs = rt + 2 * (16 * half + 8 * hh);
#pragma unroll
            for (int j = 0; j < 8; ++j) { const float c = cs[2 * j], sn = cs[2 * j + 1]; const float x1 = bf2f((bf16_t)qf[8 + half][j]), x2 = bf2f((bf16_t)qf[10 + half][j]);
                qf[8 + half][j] = (short)f2bf(x1 * c - x2 * sn); qf[10 + half][j] = (short)f2bf(x1 * sn + x2 * c); } }
    }
    float z0 = 0.f; asm volatile("" : "+v"(z0));
    f32x16 oacc[4];
#pragma unroll
    for (int i = 0; i < 4; ++i)
#pragma unroll
        for (int j = 0; j < 16; ++j) oacc[i][j] = z0;
    float mrun = -INFINITY, lsum = 0.f;
    const float sc = 0.07216878364870322f * 1.4426950408889634f;
    u32x4 kreg[3], vreg[2];
    const unsigned kn_off0 = (unsigned)(((tid >> 4) * 512 + h * 128 + (tid & 15) * 8) * 2), kn_off1 = kn_off0 + 32u * 512u * 2u;
    const unsigned kr_off = (unsigned)(((tid >> 3) * 64 + (tid & 7) * 8) * 2);
    const unsigned vt_off0 = (unsigned)((((size_t)(h * 128 + (tid >> 3))) * RP + (tid & 7) * 8) * 2), vt_off1 = vt_off0 + 64u * (unsigned)RP * 2u;
#define ATT_GLOAD(tt_) do { const int krow0_ = (tt_) == 0 ? RREAL : kbase + 64 * ((tt_) - 1); \
    const char* knb_ = (const char*)KN + (size_t)krow0_ * 1024; const char* krb_ = (const char*)KR + (size_t)krow0_ * 128; const char* vtb_ = (const char*)VT + (size_t)krow0_ * 2; \
    kreg[0] = *(const GAS u32x4*)(knb_ + kn_off0); kreg[1] = *(const GAS u32x4*)(knb_ + kn_off1); kreg[2] = *(const GAS u32x4*)(krb_ + kr_off); \
    vreg[0] = *(const GAS u32x4*)(vtb_ + vt_off0); vreg[1] = *(const GAS u32x4*)(vtb_ + vt_off1); } while (0)
    ATT_GLOAD(0);
    for (int tt = 0; tt < ntile; ++tt) {
#ifdef PROBE_ATT_STAGE2
        __syncthreads();
        *(LAS u32x4*)(Ks + (tid >> 4) * KS_STRIDE + (tid & 15) * 8) = kreg[0]; *(LAS u32x4*)(Ks + (32 + (tid >> 4)) * KS_STRIDE + (tid & 15) * 8) = kreg[1];
        *(LAS u32x4*)(Ks + (tid >> 3) * KS_STRIDE + 128 + (tid & 7) * 8) = kreg[2];
#pragma unroll
        for (int i = 0; i < 2; ++i) {
            LAS u32x2* d = (LAS u32x2*)(Vs + ((tid >> 3) + 64 * i) * VS_STRIDE + ((tid & 7) >> 1) * 16 + (tid & 1) * 4);
            u32x2 lo; lo.x = vreg[i].x; lo.y = vreg[i].y; u32x2 hi; hi.x = vreg[i].z; hi.y = vreg[i].w; d[0] = lo; d[2] = hi; }
        __syncthreads();
#endif
        __syncthreads();
        *(LAS u32x4*)(Ks + (tid >> 4) * KS_STRIDE + (tid & 15) * 8) = kreg[0]; *(LAS u32x4*)(Ks + (32 + (tid >> 4)) * KS_STRIDE + (tid & 15) * 8) = kreg[1];
        *(LAS u32x4*)(Ks + (tid >> 3) * KS_STRIDE + 128 + (tid & 7) * 8) = kreg[2];
#pragma unroll
        for (int i = 0; i < 2; ++i) {
            LAS u32x2* d = (LAS u32x2*)(Vs + ((tid >> 3) + 64 * i) * VS_STRIDE + ((tid & 7) >> 1) * 16 + (tid & 1) * 4);
            u32x2 lo; lo.x = vreg[i].x; lo.y = vreg[i].y; u32x2 hi; hi.x = vreg[i].z; hi.y = vreg[i].w; d[0] = lo; d[2] = hi; }
        __syncthreads();
        const bool comp = wave_active && tt <= wlim;
        if (tt + 1 < ntile) ATT_GLOAD(tt + 1);
        if (comp) {
            f32x16 sacc[2];
#pragma unroll
            for (int b = 0; b < 2; ++b)
#pragma unroll
                for (int j = 0; j < 16; ++j) sacc[b][j] = z0;
#ifdef PROBE_ATT_QK2
            {
            __builtin_amdgcn_sched_barrier(0);
            {
                const LAS bf16_t* kb0 = Ks + r * KS_STRIDE + 8 * hh;
                bf16x8 kf[6];
#pragma unroll
                for (int i = 0; i < 6; ++i) kf[i] = *(const LAS bf16x8*)(kb0 + 16 * i);
#pragma unroll
                for (int i = 0; i < 24; ++i) { sacc[i / 12] = __builtin_amdgcn_mfma_f32_32x32x16_bf16(kf[i % 6], qf[i % 12], sacc[i / 12], 0, 0, 0);
                    if (i + 6 < 24) kf[i % 6] = *(const LAS bf16x8*)(kb0 + ((i + 6) / 12) * 32 * KS_STRIDE + 16 * ((i + 6) % 12)); }
                __builtin_amdgcn_sched_group_barrier(0x100, 6, 0);
#pragma unroll
                for (int i = 0; i < 18; ++i) { __builtin_amdgcn_sched_group_barrier(0x008, 1, 0); __builtin_amdgcn_sched_group_barrier(0x100, 1, 0); }
                __builtin_amdgcn_sched_group_barrier(0x008, 6, 0);
            }
            __builtin_amdgcn_sched_barrier(0);
                asm volatile("" : "+v"(sacc[0][0]), "+v"(sacc[1][0]));
#pragma unroll
                for (int b = 0; b < 2; ++b)
#pragma unroll
                    for (int j = 0; j < 16; ++j) sacc[b][j] = z0;
            }
#endif
            __builtin_amdgcn_sched_barrier(0);
            {
                const LAS bf16_t* kb0 = Ks + r * KS_STRIDE + 8 * hh;
                bf16x8 kf[6];
#pragma unroll
                for (int i = 0; i < 6; ++i) kf[i] = *(const LAS bf16x8*)(kb0 + 16 * i);
#pragma unroll
                for (int i = 0; i < 24; ++i) { sacc[i / 12] = __builtin_amdgcn_mfma_f32_32x32x16_bf16(kf[i % 6], qf[i % 12], sacc[i / 12], 0, 0, 0);
                    if (i + 6 < 24) kf[i % 6] = *(const LAS bf16x8*)(kb0 + ((i + 6) / 12) * 32 * KS_STRIDE + 16 * ((i + 6) % 12)); }
                __builtin_amdgcn_sched_group_barrier(0x100, 6, 0);
#pragma unroll
                for (int i = 0; i < 18; ++i) { __builtin_amdgcn_sched_group_barrier(0x008, 1, 0); __builtin_amdgcn_sched_group_barrier(0x100, 1, 0); }
                __builtin_amdgcn_sched_group_barrier(0x008, 6, 0);
            }
            __builtin_amdgcn_sched_barrier(0);
            if (tt == 0) {
#pragma unroll
                for (int j = 8; j < 16; ++j) sacc[0][j] = -INFINITY;
#pragma unroll
                for (int j = 0; j < 16; ++j) sacc[1][j] = -INFINITY; }
            float tmax = fmaxf(sacc[0][0], sacc[1][0]);
#pragma unroll
            for (int j = 1; j < 16; ++j) tmax = fmaxf(tmax, fmaxf(sacc[0][j], sacc[1][j]));
            tmax = fmaxf(tmax, __int_as_float(__builtin_amdgcn_ds_bpermute((lane ^ 32) << 2, __float_as_int(tmax)))) * sc;
            const float mnew = fmaxf(mrun, tmax); const float alpha = __builtin_amdgcn_exp2f(mrun - mnew); mrun = mnew;
            float psum = 0.f;
#pragma unroll
            for (int b = 0; b < 2; ++b)
#pragma unroll
                for (int j = 0; j < 16; ++j) { const float p = __builtin_amdgcn_exp2f(__builtin_fmaf(sacc[b][j], sc, -mnew)); sacc[b][j] = p; psum += p; }
            lsum = lsum * alpha + psum;
            if (__builtin_amdgcn_ballot_w64(alpha != 1.0f) != 0ull) {
#pragma unroll
            for (int i = 0; i < 4; ++i)
#pragma unroll
                for (int j = 0; j < 16; ++j) oacc[i][j] *= alpha; }
            bf16x8 pf[4];
            pf[0] = pack8(sacc[0], 0); pf[1] = pack8(sacc[0], 1); pf[2] = pack8(sacc[1], 0); pf[3] = pack8(sacc[1], 1);
#ifdef PROBE_ATT_PV2
            {
                const LAS bf16_t* vb0 = Vs + r * VS_STRIDE + 8 * hh;
#pragma unroll
                for (int j = 0; j < 16; ++j) { sacc[0][j] = z0; sacc[1][j] = z0; }
#pragma unroll
                for (int i = 0; i < 16; ++i) { const bf16x8 vfd = *(const LAS bf16x8*)(vb0 + 32 * (i >> 2) * VS_STRIDE + 16 * (i & 3));
                    sacc[i & 1] = __builtin_amdgcn_mfma_f32_32x32x16_bf16(vfd, pf[i & 3], sacc[i & 1], 0, 0, 0); }
                asm volatile("" :: "v"(sacc[0][0]), "v"(sacc[1][0]));
            }
#endif
            __builtin_amdgcn_sched_barrier(0);
            {
                const LAS bf16_t* vb0 = Vs + r * VS_STRIDE + 8 * hh;
                bf16x8 vf[16];
#pragma unroll
                for (int i = 0; i < 16; ++i) vf[i] = *(const LAS bf16x8*)(vb0 + 32 * (i >> 2) * VS_STRIDE + 16 * (i & 3));
#pragma unroll
                for (int i = 0; i < 16; ++i) oacc[i >> 2] = __builtin_amdgcn_mfma_f32_32x32x16_bf16(vf[i], pf[i & 3], oacc[i >> 2], 0, 0, 0);
                __builtin_amdgcn_sched_group_barrier(0x100, 8, 1);
#pragma unroll
                for (int i = 0; i < 8; ++i) { __builtin_amdgcn_sched_group_barrier(0x008, 1, 1); __builtin_amdgcn_sched_group_barrier(0x100, 1, 1); }
                __builtin_amdgcn_sched_group_barrier(0x008, 8, 1);
            }
            __builtin_amdgcn_sched_barrier(0);
        }
    }
    if (wave_active) {
        const float ltot = lsum + __int_as_float(__builtin_amdgcn_ds_bpermute((lane ^ 32) << 2, __float_as_int(lsum))); const float inv = 1.0f / ltot;
        bf16_t* orow = MIX + (size_t)qrow * D + 128 * h;
#pragma unroll
        for (int dvb = 0; dvb < 4; ++dvb)
#pragma unroll
            for (int g = 0; g < 4; ++g) { u32x2 o; o.x = cvtpk(oacc[dvb][4 * g] * inv, oacc[dvb][4 * g + 1] * inv); o.y = cvtpk(oacc[dvb][4 * g + 2] * inv, oacc[dvb][4 * g + 3] * inv);
                *(GAS u32x2*)(orow + 32 * dvb + 8 * g + 4 * hh) = o; }
    }
    __syncthreads();
}
__device__ __forceinline__ void attn_phase(LAS unsigned char* lds, const bf16_t* Q, const bf16_t* KN, const bf16_t* KR, const bf16_t* VT, bf16_t* MIX, const float* rope, int bid, int nblk) {
    const int w = opq(threadIdx.x) >> 6;
    for (int s = bid; s < 512; s += nblk) {
        const int round = s >> 8, x = s & 255; const int bh = (x >> 4) + 16 * round, qb = round ? 15 - (x & 15) : (x & 15);
        const int b = bh >> 2, h = bh & 3;
        attn_unit(lds, Q, KN, KR, VT, MIX, rope, h, b * SEQ + 256 * qb, b * SEQ, 4 * qb + 5, 4 * qb + (w >> 1) + 1, true);
    }
    for (int s = bid; s < 4; s += nblk)
        attn_unit(lds, Q, KN, KR, VT, MIX, rope, s, RREAL, 0, 1, 0, w == 0);
}

constexpr int CLS = 72;
constexpr int CSLOT = 64 * CLS * 2;
constexpr int CHK_BYTES = 32768;
constexpr int NSEQ_HALF0 = 257;
struct CpP { const bf16_t* PR; const bf16_t* LO; const bf16_t* VMIX; const bf16_t* VFIRST; bf16_t* VP; float* RK; unsigned char* CHK;
    const float *mu, *w0, *a0, *k_k, *k_a, *r_k, *v0; int layer, pad; };

__device__ __forceinline__ void mm64(f32x16& acc, const LAS bf16_t* a, const LAS bf16_t* b, int r, int hh) {
    bf16x8 af[4], bf[4];
#pragma unroll
    for (int ks = 0; ks < 4; ++ks) { af[ks] = *(const LAS bf16x8*)(a + r * CLS + 16 * ks + 8 * hh); bf[ks] = *(const LAS bf16x8*)(b + r * CLS + 16 * ks + 8 * hh); }
#pragma unroll
    for (int ks = 0; ks < 4; ++ks) acc = __builtin_amdgcn_mfma_f32_32x32x16_bf16(af[ks], bf[ks], acc, 0, 0, 0);
}
__device__ __forceinline__ void st_tile(const f32x16& acc, LAS bf16_t* dst, int m0, int n0, int r, int hh) {
#pragma unroll
    for (int q = 0; q < 16; ++q) dst[(m0 + (q & 3) + 8 * (q >> 2) + 4 * hh) * CLS + n0 + r] = f2bf_hw(acc[q]);
}
__device__ __forceinline__ void st_tile_t(const f32x16& acc, LAS bf16_t* dst, int m0, int n0, int r, int hh) {
#pragma unroll
    for (int g = 0; g < 4; ++g) { u32x2 o; o.x = cvtpk(acc[4 * g], acc[4 * g + 1]); o.y = cvtpk(acc[4 * g + 2], acc[4 * g + 3]);
        *(LAS u32x2*)(dst + (n0 + r) * CLS + m0 + 8 * g + 4 * hh) = o; }
}
__device__ __forceinline__ void zero16(f32x16& a, float z) {
#pragma unroll
    for (int q = 0; q < 16; ++q) a[q] = z;
}
typedef float f32x2 __attribute__((ext_vector_type(2)));
struct CpRaw { unsigned xr[5], xk[5], xv[5], lw[4], la[4], vm[4], vf[4]; f32x2 mu_r, mu_k, mu_v, w0, a0, kkc, kac, rkc, v0; float pm0; };
__device__ __forceinline__ void cp_issue(const CpP& P, int row0, int hd, int w, int lane, CpRaw& R) {
    const int cp = lane & 31, rh = lane >> 5, c = hd * 64 + 2 * cp;
    R.mu_r = *(const GAS f32x2*)(P.mu + c); R.mu_k = *(const GAS f32x2*)(P.mu + 512 + c); R.mu_v = *(const GAS f32x2*)(P.mu + 1024 + c); R.w0 = *(const GAS f32x2*)(P.w0 + c); R.a0 = *(const GAS f32x2*)(P.a0 + c);
    R.kkc = *(const GAS f32x2*)(P.k_k + c); R.kac = *(const GAS f32x2*)(P.k_a + c); R.rkc = *(const GAS f32x2*)(P.r_k + c);
    if (P.layer) R.v0 = *(const GAS f32x2*)(P.v0 + c); else { R.v0.x = 0.f; R.v0.y = 0.f; }
    const int rw0 = row0 + 8 * w + 4 * rh; const int prow0 = (w == 0 && rh == 0) ? row_prev(row0) : rw0 - 1; R.pm0 = prow0 < 0 ? 0.f : 1.f;
    { const bf16_t* xp = P.PR + (size_t)(prow0 < 0 ? rw0 : prow0) * PRW + c; R.xr[0] = *(const GAS unsigned*)xp; R.xk[0] = *(const GAS unsigned*)(xp + 512); R.xv[0] = *(const GAS unsigned*)(xp + 1024); }
#pragma unroll
    for (int q = 0; q < 4; ++q) { const bf16_t* x = P.PR + (size_t)(rw0 + q) * PRW + c; R.xr[q + 1] = *(const GAS unsigned*)x; R.xk[q + 1] = *(const GAS unsigned*)(x + 512); R.xv[q + 1] = *(const GAS unsigned*)(x + 1024);
        const bf16_t* lo = P.LO + (size_t)(rw0 + q) * 1536 + c; R.lw[q] = *(const GAS unsigned*)lo; R.la[q] = *(const GAS unsigned*)(lo + 512);
        if (P.layer) { R.vm[q] = *(const GAS unsigned*)(P.VMIX + (size_t)(rw0 + q) * 512 + c); R.vf[q] = *(const GAS unsigned*)(P.VFIRST + (size_t)(rw0 + q) * 512 + c); } else { R.vm[q] = 0u; R.vf[q] = 0u; } }
}
__device__ __forceinline__ float bfl(unsigned u) { return __uint_as_float(u << 16); }
__device__ __forceinline__ float bfh(unsigned u) { return __uint_as_float(u & 0xffff0000u); }
__device__ __forceinline__ float half_tot(float v) {
    v += DPP_F(v, 0xB1, 0xf); v += DPP_F(v, 0x4E, 0xf); v += DPP_F(v, 0x141, 0xf); v += DPP_F(v, 0x140, 0xf); v += DPP_F(v, 0x142, 0xa); return v; }
__device__ __forceinline__ void rwkv_cp_task(LAS unsigned char* lds, const CpP& P, int row0, int hd, unsigned char* out, CpRaw& R, bool has_next, int nrow0, int nhd) {
    const int tid = opq(threadIdx.x), lane = tid & 63, w = __builtin_amdgcn_readfirstlane(tid >> 6), r = lane & 31, hh = lane >> 5;
    float z0 = 0.f; asm volatile("" : "+v"(z0));
    LAS bf16_t* S_ATtm = (LAS bf16_t*)(lds + 0 * CSLOT);
    LAS bf16_t* S_BHtm = (LAS bf16_t*)(lds + 1 * CSLOT);
    LAS bf16_t* S_KHtm = (LAS bf16_t*)(lds + 2 * CSLOT);
    LAS bf16_t* S_RTtm = (LAS bf16_t*)(lds + 3 * CSLOT);
    LAS bf16_t* S_ATcm = (LAS bf16_t*)(lds + 4 * CSLOT);
    LAS bf16_t* S_BBcm = (LAS bf16_t*)(lds + 5 * CSLOT);
    LAS bf16_t* S_KBcm = (LAS bf16_t*)(lds + 6 * CSLOT);
    LAS bf16_t* S_VTcm = (LAS bf16_t*)(lds + 7 * CSLOT);
    LAS bf16_t* S_Q0a = (LAS bf16_t*)(lds + 8 * CSLOT);
    LAS bf16_t* S_Q0b = (LAS bf16_t*)(lds + 9 * CSLOT);
    LAS bf16_t* S_PP0 = (LAS bf16_t*)(lds + 10 * CSLOT);
    LAS bf16_t* S_Na = (LAS bf16_t*)(lds + 11 * CSLOT);
    LAS bf16_t* S_XT = (LAS bf16_t*)(lds + 12 * CSLOT);
    LAS bf16_t* S_Pa = (LAS bf16_t*)(lds + 13 * CSLOT);
    LAS bf16_t* S_Qa = (LAS bf16_t*)(lds + 14 * CSLOT);
    LAS float* S_TOT = (LAS float*)(lds + 15 * CSLOT);
    LAS bf16_t* Qa[2] = {S_Q0a, S_ATtm}; LAS bf16_t* Qb[2] = {S_Q0b, S_BHtm}; LAS bf16_t* PPa[2] = {S_PP0, S_KHtm};

    {
        const int cp = lane & 31, rh = lane >> 5, c = hd * 64 + 2 * cp;
        const f32x2 mu_r = R.mu_r, mu_k = R.mu_k, mu_v = R.mu_v, w0 = R.w0, a0 = R.a0, kkc = R.kkc, kac = R.kac, rkc = R.rkc, v0 = R.v0; const float pm0 = R.pm0;
        float fr[4][2], fk[4][2], fv[4][2], fa[4][2], fb[4][2], lw[4][2];
        const int rw0 = row0 + 8 * w + 4 * rh;
        constexpr float L2E = 1.4426950408889634f;
#pragma unroll
        for (int q = 0; q < 4; ++q) { const int row = rw0 + q; const bool valid = row < RVALID; const float pm = q == 0 ? pm0 : 1.f;
            float rr[2] = {bfl(R.xr[q + 1]), bfh(R.xr[q + 1])}, kk[2] = {bfl(R.xk[q + 1]), bfh(R.xk[q + 1])}, vv[2] = {bfl(R.xv[q + 1]), bfh(R.xv[q + 1])};
            const float pr[2] = {bfl(R.xr[q]), bfh(R.xr[q])}, pk[2] = {bfl(R.xk[q]), bfh(R.xk[q])}, pv[2] = {bfl(R.xv[q]), bfh(R.xv[q])};
            const float wpre[2] = {bfl(R.lw[q]), bfh(R.lw[q])}, apre[2] = {bfl(R.la[q]), bfh(R.la[q])};
            float lwv[2], asig[2], kkr[2], k2[2], kn[2];
#pragma unroll
            for (int e = 0; e < 2; ++e) {
                rr[e] = rr[e] + (pm * pr[e] - rr[e]) * mu_r[e]; kk[e] = kk[e] + (pm * pk[e] - kk[e]) * mu_k[e]; vv[e] = vv[e] + (pm * pv[e] - vv[e]) * mu_v[e];
                lwv[e] = -0.6065306597126334f * __builtin_amdgcn_rcpf(1.0f + __builtin_amdgcn_exp2f(-(w0[e] + wpre[e]) * L2E));
                asig[e] = __builtin_amdgcn_rcpf(1.0f + __builtin_amdgcn_exp2f(-(a0[e] + apre[e]) * L2E));
                kkr[e] = kk[e] * kkc[e]; k2[e] = kk[e] * (1.f + (asig[e] - 1.f) * kac[e]); }
            if (P.layer) { const float vm[2] = {bfl(R.vm[q]), bfh(R.vm[q])}, vf[2] = {bfl(R.vf[q]), bfh(R.vf[q])};
#pragma unroll
                for (int e = 0; e < 2; ++e) vv[e] = vv[e] + (vf[e] - vv[e]) * __builtin_amdgcn_rcpf(1.0f + __builtin_amdgcn_exp2f(-(v0[e] + vm[e]) * L2E)); }
            const float sst = half_tot(kkr[0] * kkr[0] + kkr[1] * kkr[1]);
            const float rkt = half_tot(rr[0] * k2[0] * rkc[0] + rr[1] * k2[1] * rkc[1]);
            const float ss0 = __int_as_float(__builtin_amdgcn_readlane(__float_as_int(sst), 31)), ss1 = __int_as_float(__builtin_amdgcn_readlane(__float_as_int(sst), 63));
            const float rs = rsqrtf(fmaxf(rh ? ss1 : ss0, 1e-24f));
            kn[0] = kkr[0] * rs; kn[1] = kkr[1] * rs;
            if (!valid) {
#pragma unroll
                for (int e = 0; e < 2; ++e) { rr[e] = 0.f; k2[e] = 0.f; vv[e] = 0.f; kn[e] = 0.f; lwv[e] = 0.f; } }
            *(GAS unsigned*)(P.VP + (size_t)row * 512 + c) = cvtpk(vv[0], vv[1]); if (cp == 31) ((GAS float*)P.RK)[(size_t)row * 8 + hd] = valid ? rkt : 0.f;
#pragma unroll
            for (int e = 0; e < 2; ++e) { fr[q][e] = rr[e]; fk[q][e] = k2[e]; fv[q][e] = vv[e]; fa[q][e] = -kn[e]; fb[q][e] = kn[e] * asig[e]; lw[q][e] = lwv[e]; } }
        if (has_next) cp_issue(P, nrow0, nhd, w, lane, R);
        float cum[4][2], hoff[2];
#pragma unroll
        for (int e = 0; e < 2; ++e) { cum[0][e] = lw[0][e];
#pragma unroll
            for (int q = 1; q < 4; ++q) cum[q][e] = cum[q - 1][e] + lw[q][e];
            const float pt = __int_as_float(__builtin_amdgcn_ds_bpermute((lane ^ 32) << 2, __float_as_int(cum[3][e]))); hoff[e] = rh ? pt : 0.f; }
        if (rh) { f32x2 t2; t2.x = hoff[0] + cum[3][0]; t2.y = hoff[1] + cum[3][1]; *(LAS f32x2*)(S_TOT + w * 64 + 2 * cp) = t2; }
        lds_barrier();
        float off[2] = {0.f, 0.f}, tot[2] = {0.f, 0.f};
#pragma unroll
        for (int ww = 0; ww < 8; ++ww) { const f32x2 tv = *(const LAS f32x2*)(S_TOT + ww * 64 + 2 * cp); off[0] += ww < w ? tv.x : 0.f; off[1] += ww < w ? tv.y : 0.f; tot[0] += tv.x; tot[1] += tv.y; }
        const float etot[2] = {__builtin_amdgcn_exp2f(tot[0] * L2E), __builtin_amdgcn_exp2f(tot[1] * L2E)};
        if (w == 0 && rh == 0) { f32x2 t2; t2.x = etot[0]; t2.y = etot[1]; *(LAS f32x2*)(S_TOT + 512 + 2 * cp) = t2; }
        float at[4][2], bh[4][2], kh[4][2], rt[4][2], bb[4][2], kb[4][2];
#pragma unroll
        for (int e = 0; e < 2; ++e) { const float base = off[e] + hoff[e];
            float ecprev = __builtin_amdgcn_exp2f(base * L2E);
#pragma unroll
            for (int q = 0; q < 4; ++q) { const float ci = base + cum[q][e]; const float ec = __builtin_amdgcn_exp2f(ci * L2E), ecp = ecprev, en = __builtin_amdgcn_rcpf(ec), ee = etot[e] * en; ecprev = ec;
                rt[q][e] = fr[q][e] * ec; at[q][e] = fa[q][e] * ecp; bh[q][e] = fb[q][e] * en; kh[q][e] = fk[q][e] * en; bb[q][e] = fb[q][e] * ee; kb[q][e] = fk[q][e] * ee; } }
#pragma unroll
        for (int q = 0; q < 4; ++q) { const int t = 8 * w + 4 * rh + q;
            *(LAS unsigned*)(S_ATtm + t * CLS + 2 * cp) = cvtpk(at[q][0], at[q][1]); *(LAS unsigned*)(S_BHtm + t * CLS + 2 * cp) = cvtpk(bh[q][0], bh[q][1]);
            *(LAS unsigned*)(S_KHtm + t * CLS + 2 * cp) = cvtpk(kh[q][0], kh[q][1]); *(LAS unsigned*)(S_RTtm + t * CLS + 2 * cp) = cvtpk(rt[q][0], rt[q][1]); }
#pragma unroll
        for (int e = 0; e < 2; ++e) { const int jo = (2 * cp + e) * CLS + 8 * w + 4 * rh; u32x2 o;
            o.x = cvtpk(at[0][e], at[1][e]); o.y = cvtpk(at[2][e], at[3][e]); *(LAS u32x2*)(S_ATcm + jo) = o;
            o.x = cvtpk(bb[0][e], bb[1][e]); o.y = cvtpk(bb[2][e], bb[3][e]); *(LAS u32x2*)(S_BBcm + jo) = o;
            o.x = cvtpk(kb[0][e], kb[1][e]); o.y = cvtpk(kb[2][e], kb[3][e]); *(LAS u32x2*)(S_KBcm + jo) = o;
            o.x = cvtpk(fv[0][e], fv[1][e]); o.y = cvtpk(fv[2][e], fv[3][e]); *(LAS u32x2*)(S_VTcm + jo) = o; }
    }
    lds_barrier();
    const int q4 = w & 3, mb = q4 >> 1, nb = q4 & 1; const bool upper = (mb == 0 && nb == 1);
    f32x16 pacc;
    {
        f32x16 a0, a1; zero16(a0, z0); zero16(a1, z0);
        const LAS bf16_t* lhs = (w < 4 ? S_ATtm : S_RTtm) + 32 * mb * CLS;
        if (!upper) { mm64(a0, lhs, S_BHtm + 32 * nb * CLS, r, hh); mm64(a1, lhs, S_KHtm + 32 * nb * CLS, r, hh); }
        const int s = 32 * nb + r;
#pragma unroll
        for (int q = 0; q < 16; ++q) { const int t = 32 * mb + (q & 3) + 8 * (q >> 2) + 4 * hh; const bool keep = w < 4 ? (s < t) : (s <= t); if (!keep) { a0[q] = z0; a1[q] = z0; } }
        if (w < 4) { st_tile(a0, S_Q0a, 32 * mb, 32 * nb, r, hh); st_tile_t(a0, S_Q0b, 32 * mb, 32 * nb, r, hh); st_tile(a1, S_Na, 32 * mb, 32 * nb, r, hh);
            pacc = a0;
#pragma unroll
            for (int q = 0; q < 16; ++q) { const int t = 32 * mb + (q & 3) + 8 * (q >> 2) + 4 * hh; if (t == s) pacc[q] += 1.0f; }
            st_tile(pacc, S_PP0, 32 * mb, 32 * nb, r, hh); }
        else { st_tile(a0, S_Pa, 32 * mb, 32 * nb, r, hh); st_tile(a1, S_Qa, 32 * mb, 32 * nb, r, hh); zero16(pacc, z0); }
    }
    lds_barrier();
    {
        f32x16 a; zero16(a, z0);
        if (w >= 4) { if (!upper) { mm64(a, Qa[0] + 32 * mb * CLS, Qb[0] + 32 * nb * CLS, r, hh); } st_tile(a, Qa[1], 32 * mb, 32 * nb, r, hh); st_tile_t(a, Qb[1], 32 * mb, 32 * nb, r, hh); }
        else { mm64(a, S_Na + 32 * mb * CLS, S_VTcm + 32 * nb * CLS, r, hh); st_tile_t(a, S_XT, 32 * mb, 32 * nb, r, hh); }
    }
    lds_barrier();
#pragma unroll 1
    for (int k = 1; k <= 5; ++k) {
        const int rs = k & 1, ws_ = rs ^ 1;
        if (w < 4) { if (!upper) mm64(pacc, PPa[ws_] + 32 * mb * CLS, Qb[rs] + 32 * nb * CLS, r, hh); st_tile(pacc, PPa[rs], 32 * mb, 32 * nb, r, hh); }
        else if (k < 5) { f32x16 a; zero16(a, z0); if (!upper) mm64(a, Qa[rs] + 32 * mb * CLS, Qb[rs] + 32 * nb * CLS, r, hh); st_tile(a, Qa[ws_], 32 * mb, 32 * nb, r, hh); st_tile_t(a, Qb[ws_], 32 * mb, 32 * nb, r, hh); }
        lds_barrier();
    }
    {
        f32x16 a; zero16(a, z0);
        mm64(a, PPa[1] + 32 * mb * CLS, (w < 4 ? S_ATcm : S_XT) + 32 * nb * CLS, r, hh);
        st_tile_t(a, w < 4 ? S_Q0a : S_Q0b, 32 * mb, 32 * nb, r, hh);
    }
    lds_barrier();
    {
        LAS bf16_t* W1T = S_Q0a; LAS bf16_t* U1T = S_Q0b;
        f32x16 a, b; zero16(a, z0); zero16(b, z0);
        GAS u32x4* o128 = (GAS u32x4*)out;
        if (w < 4) {
            mm64(a, S_BBcm + 32 * mb * CLS, U1T + 32 * nb * CLS, r, hh); mm64(a, S_KBcm + 32 * mb * CLS, S_VTcm + 32 * nb * CLS, r, hh);
            mm64(b, W1T + 32 * mb * CLS, S_BBcm + 32 * nb * CLS, r, hh);
            const float gam = S_TOT[512 + 32 * nb + r];
#pragma unroll
            for (int q = 0; q < 16; ++q) { const int j = 32 * mb + (q & 3) + 8 * (q >> 2) + 4 * hh; if (j == 32 * nb + r) b[q] += gam; }
            u32x4 h0, h1, g0, g1;
            h0.x = cvtpk(a[0], a[1]); h0.y = cvtpk(a[2], a[3]); h0.z = cvtpk(a[4], a[5]); h0.w = cvtpk(a[6], a[7]);
            h1.x = cvtpk(a[8], a[9]); h1.y = cvtpk(a[10], a[11]); h1.z = cvtpk(a[12], a[13]); h1.w = cvtpk(a[14], a[15]);
            g0.x = cvtpk(b[0], b[1]); g0.y = cvtpk(b[2], b[3]); g0.z = cvtpk(b[4], b[5]); g0.w = cvtpk(b[6], b[7]);
            g1.x = cvtpk(b[8], b[9]); g1.y = cvtpk(b[10], b[11]); g1.z = cvtpk(b[12], b[13]); g1.w = cvtpk(b[14], b[15]);
            o128[1024 + ((mb * 2 + nb) * 64 + lane) * 2] = h0; o128[1024 + ((mb * 2 + nb) * 64 + lane) * 2 + 1] = h1;
            o128[(nb * 4 + 2 * mb) * 64 + lane] = g0; o128[(nb * 4 + 2 * mb + 1) * 64 + lane] = g1;
        } else {
            mm64(a, S_Pa + 32 * mb * CLS, U1T + 32 * nb * CLS, r, hh); mm64(a, S_Qa + 32 * mb * CLS, S_VTcm + 32 * nb * CLS, r, hh);
            mm64(b, W1T + 32 * mb * CLS, S_Pa + 32 * nb * CLS, r, hh);
#pragma unroll
            for (int g = 0; g < 4; ++g) { const s16x4 rv = *(const LAS s16x4*)(S_RTtm + (32 * nb + r) * CLS + 32 * mb + 8 * g + 4 * hh);
#pragma unroll
                for (int e = 0; e < 4; ++e) b[4 * g + e] += bf2f((bf16_t)rv[e]); }
            u32x4 y0, y1, r0, r1;
            y0.x = cvtpk(a[0], a[1]); y0.y = cvtpk(a[2], a[3]); y0.z = cvtpk(a[4], a[5]); y0.w = cvtpk(a[6], a[7]);
            y1.x = cvtpk(a[8], a[9]); y1.y = cvtpk(a[10], a[11]); y1.z = cvtpk(a[12], a[13]); y1.w = cvtpk(a[14], a[15]);
            r0.x = cvtpk(b[0], b[1]); r0.y = cvtpk(b[2], b[3]); r0.z = cvtpk(b[4], b[5]); r0.w = cvtpk(b[6], b[7]);
            r1.x = cvtpk(b[8], b[9]); r1.y = cvtpk(b[10], b[11]); r1.z = cvtpk(b[12], b[13]); r1.w = cvtpk(b[14], b[15]);
            o128[1536 + ((mb * 2 + nb) * 64 + lane) * 2] = y0; o128[1536 + ((mb * 2 + nb) * 64 + lane) * 2 + 1] = y1;
            o128[512 + (nb * 4 + 2 * mb) * 64 + lane] = r0; o128[512 + (nb * 4 + 2 * mb + 1) * 64 + lane] = r1;
        }
    }
    lds_barrier();
}

struct ScP { const unsigned char* CHK; bf16_t* YS; };
__device__ __forceinline__ void scan_unpack16(f32x16& acc, const u32x4 y0, const u32x4 y1) {
    acc[0] = __uint_as_float(y0.x << 16); acc[1] = __uint_as_float(y0.x & 0xffff0000u); acc[2] = __uint_as_float(y0.y << 16); acc[3] = __uint_as_float(y0.y & 0xffff0000u);
    acc[4] = __uint_as_float(y0.z << 16); acc[5] = __uint_as_float(y0.z & 0xffff0000u); acc[6] = __uint_as_float(y0.w << 16); acc[7] = __uint_as_float(y0.w & 0xffff0000u);
    acc[8] = __uint_as_float(y1.x << 16); acc[9] = __uint_as_float(y1.x & 0xffff0000u); acc[10] = __uint_as_float(y1.y << 16); acc[11] = __uint_as_float(y1.y & 0xffff0000u);
    acc[12] = __uint_as_float(y1.z << 16); acc[13] = __uint_as_float(y1.z & 0xffff0000u); acc[14] = __uint_as_float(y1.w << 16); acc[15] = __uint_as_float(y1.w & 0xffff0000u);
}
__device__ __forceinline__ void scan_step(const LAS unsigned char* sl, LAS float* ybuf, f32x16 (&st)[2], int w, int lane, int r, int hh) {
    bf16x8 ar[2][4], ag[2][4]; u32x4 yi[2][2], hi[2][2];
#pragma unroll
    for (int tb = 0; tb < 2; ++tb) { const LAS u32x4* yf = (const LAS u32x4*)(sl + 24576) + ((tb * 2 + w) * 64 + lane) * 2; yi[tb][0] = yf[0]; yi[tb][1] = yf[1];
        const LAS u32x4* hf = (const LAS u32x4*)(sl + 16384) + ((tb * 2 + w) * 64 + lane) * 2; hi[tb][0] = hf[0]; hi[tb][1] = hf[1];
#pragma unroll
        for (int ks = 0; ks < 4; ++ks) { ar[tb][ks] = *(const LAS bf16x8*)(sl + 8192 + ((tb * 4 + ks) * 64 + lane) * 16); ag[tb][ks] = *(const LAS bf16x8*)(sl + ((tb * 4 + ks) * 64 + lane) * 16); } }
    bf16x8 sf[4];
    sf[0] = pack8(st[0], 0); sf[1] = pack8(st[0], 1); sf[2] = pack8(st[1], 0); sf[3] = pack8(st[1], 1);
    f32x16 ya[2], sa[2];
#pragma unroll
    for (int tb = 0; tb < 2; ++tb) { scan_unpack16(ya[tb], yi[tb][0], yi[tb][1]); scan_unpack16(sa[tb], hi[tb][0], hi[tb][1]); }
#pragma unroll
    for (int ks = 0; ks < 4; ++ks) {
        ya[0] = __builtin_amdgcn_mfma_f32_32x32x16_bf16(ar[0][ks], sf[ks], ya[0], 0, 0, 0); ya[1] = __builtin_amdgcn_mfma_f32_32x32x16_bf16(ar[1][ks], sf[ks], ya[1], 0, 0, 0);
        sa[0] = __builtin_amdgcn_mfma_f32_32x32x16_bf16(ag[0][ks], sf[ks], sa[0], 0, 0, 0); sa[1] = __builtin_amdgcn_mfma_f32_32x32x16_bf16(ag[1][ks], sf[ks], sa[1], 0, 0, 0); }
    st[0] = sa[0]; st[1] = sa[1];
#pragma unroll
    for (int tb = 0; tb < 2; ++tb)
#pragma unroll
        for (int q = 0; q < 16; ++q) ybuf[(32 * tb + (q & 3) + 8 * (q >> 2) + 4 * hh) * 64 + 32 * w + r] = ya[tb][q];
}
__device__ __forceinline__ void rwkv_scan_unit(LAS unsigned char* lds, const ScP& P, int seq0, int seqm, int nmeta, int nreal, int brow0, int hd, bool write_meta, const float* st_in, float* st_out) {
    const int tid = opq(threadIdx.x), lane = tid & 63, w = __builtin_amdgcn_readfirstlane(tid >> 6), r = lane & 31, hh = lane >> 5;
    const int N = nmeta + nreal;
    float z0 = 0.f; asm volatile("" : "+v"(z0));
    LAS float* ybuf = (LAS float*)(lds + 65536);
    f32x16 st[2]; zero16(st[0], z0); zero16(st[1], z0);
    if (st_in != nullptr && w < 2) { const GAS f32x4* sp = (const GAS f32x4*)(st_in + ((size_t)w * 64 + lane) * 32);
#pragma unroll
        for (int i = 0; i < 8; ++i) { const f32x4 v = sp[i];
#pragma unroll
            for (int j = 0; j < 4; ++j) st[i >> 2][4 * (i & 3) + j] = v[j]; } }
    const int c = hd * 64 + lane;
#define SCAN_SRC(n_) ((const GAS u32x4*)(P.CHK + ((size_t)((n_) < nmeta ? seqm : seq0 + (n_) - nmeta) * 8 + hd) * CHK_BYTES))
    u32x4 pa[4], pb[4], pc[4];
    { const GAS u32x4* s0 = SCAN_SRC(0); const GAS u32x4* s1 = SCAN_SRC(1); const GAS u32x4* s2 = SCAN_SRC(2);
#pragma unroll
      for (int i = 0; i < 4; ++i) pc[i] = s0[tid + 512 * i];
#pragma unroll
      for (int i = 0; i < 4; ++i) pa[i] = s1[tid + 512 * i];
#pragma unroll
      for (int i = 0; i < 4; ++i) pb[i] = s2[tid + 512 * i];
#pragma unroll
      for (int i = 0; i < 4; ++i) *(LAS u32x4*)(lds + (tid + 512 * i) * 16) = pc[i]; }
    lds_barrier();
#define SCAN_ITER(n_, PCUR, PMID, PNEXT) do { \
        const int n = (n_); \
        if (n + 3 < N) { const GAS u32x4* s3 = SCAN_SRC(n + 3); _Pragma("unroll") for (int i = 0; i < 4; ++i) PNEXT[i] = s3[tid + 512 * i]; } \
        if (w < 2) scan_step(lds + (n & 1) * 32768, ybuf, st, w, lane, r, hh); \
        lds_barrier(); \
        if (n + 1 < N) { _Pragma("unroll") for (int i = 0; i < 4; ++i) *(LAS u32x4*)(lds + ((n + 1) & 1) * 32768 + (tid + 512 * i) * 16) = PCUR[i]; } \
        if (w >= 2) { const int crow0 = n < nmeta ? RREAL : brow0 + 64 * (n - nmeta); const int nrow = n < nmeta ? (write_meta ? NMETA : 0) : 64; \
            for (int t = w - 2; t < nrow; t += 6) ((GAS bf16_t*)P.YS)[(size_t)(crow0 + t) * 512 + c] = f2bf_hw(ybuf[t * 64 + lane]); } \
        lds_barrier(); } while (0)
    int n3 = 0;
#pragma unroll 1
    for (; n3 + 3 <= N; n3 += 3) { SCAN_ITER(n3, pa, pb, pc); SCAN_ITER(n3 + 1, pb, pc, pa); SCAN_ITER(n3 + 2, pc, pa, pb); }
    if (N - n3 >= 1) SCAN_ITER(n3, pa, pb, pc);
    if (N - n3 >= 2) SCAN_ITER(n3 + 1, pb, pc, pa);
#undef SCAN_ITER
#undef SCAN_SRC
    if (st_out != nullptr && w < 2) { GAS f32x4* sp = (GAS f32x4*)(st_out + ((size_t)w * 64 + lane) * 32);
#pragma unroll
        for (int i = 0; i < 8; ++i) { f32x4 v;
#pragma unroll
            for (int j = 0; j < 4; ++j) v[j] = st[i >> 2][4 * (i & 3) + j];
            sp[i] = v; } }
}
struct PostP { const bf16_t* YS; const bf16_t* VP; const float* RK; const bf16_t* LO; bf16_t* MIX; const float *ln_w, *ln_b; };
__device__ __forceinline__ void rwkv_post(const PostP& P, int q, int rlo, int rhi, bool with_meta, int gw, int ngw, int lane) {
    lane = opq(lane);
    const int nreal = (rhi - rlo) * 8, ntot = nreal + (with_meta ? NMETA * 8 : 0);
    for (int item = gw; item < ntot; item += ngw) { const int ri = rlo + (item >> 3); const int row = item < nreal ? (ri >> 10) * SEQ + 1024 * q + (ri & 1023) : RREAL + ((item - nreal) >> 3); const int hd = item & 7, c = hd * 64 + lane;
        const float y = bf2f(P.YS[(size_t)row * 512 + c]); const float g = bf2f(P.LO[(size_t)row * 1536 + 1024 + c]), vp = bf2f(P.VP[(size_t)row * 512 + c]), rk = P.RK[(size_t)row * 8 + hd];
        const float mean = wave_sum(y) * (1.f / 64.f); const float d = y - mean; const float var = wave_sum(d * d) * (1.f / 64.f);
        const float yn = d * rsqrtf(var + GN_EPS) * P.ln_w[c] + P.ln_b[c];
        P.MIX[(size_t)row * D + 512 + c] = f2bf_hw((yn + rk * vp) * g); }
}

constexpr int LDS_BYTES = 147456, LDS_MISC = LDS_BYTES - 512;
struct Params { const float* in[33]; float* out; unsigned char* ws; };
constexpr int CW_BAR = 4096;


#ifndef PROBE_REP_MISC
#define PROBE_REP_MISC 1
#endif
#ifndef MOE_TAIL
#define MOE_TAIL 0
#endif
#ifndef PROBE_REP_OUTPROJ
#define PROBE_REP_OUTPROJ 1
#endif
#ifndef PROBE_REP_FFNDN
#define PROBE_REP_FFNDN 1
#endif
#ifndef PROBE_REP_MOEDN
#define PROBE_REP_MOEDN 1
#endif
#ifndef PROBE_REP_NORM
#define PROBE_REP_NORM 1
#endif
#ifndef PROBE_REP_INPROJ
#define PROBE_REP_INPROJ 1
#endif
#ifndef PROBE_REP_PREP
#define PROBE_REP_PREP 1
#endif
#ifndef PROBE_REP_P4A
#define PROBE_REP_P4A 1
#endif
#ifndef PROBE_REP_ATT
#define PROBE_REP_ATT 1
#endif
#ifndef PROBE_REP_P4B
#define PROBE_REP_P4B 1
#endif
#ifndef PROBE_REP_CP
#define PROBE_REP_CP 1
#endif
#ifndef PROBE_REP_SCAN
#define PROBE_REP_SCAN 1
#endif
#ifndef PROBE_REP_FFNGU
#define PROBE_REP_FFNGU 1
#endif
#ifndef PROBE_REP_MOETR
#define PROBE_REP_MOETR 1
#endif
#ifndef PROBE_REP_GATHER
#define PROBE_REP_GATHER 1
#endif
#ifndef PROBE_REP_MOEGU
#define PROBE_REP_MOEGU 1
#endif
#define LDP(k) ((const float*)ldk(kp, 8 * (k)))
#define OUTP ((float*)ldk(kp, 264))
#define WSP ((unsigned char*)ldk(kp, 272))
#define NOINL __device__ __attribute__((noinline))
#define WAVE_IDS() const int tid = threadIdx.x, lane = tid & 63, wave = __builtin_amdgcn_readfirstlane(tid >> 6), bid = (int)blockIdx.x, nblk = (int)gridDim.x, gw = bid * 8 + wave, ngw = nblk * 8; (void)lane; (void)gw; (void)ngw
NOINL void f_p0(unsigned long long kp_, LAS unsigned char* lds) {
    const unsigned long long kp = kp_uniform(kp_); WAVE_IDS(); LAS float* scr = (LAS float*)(lds + wave * 8448);
    {
        unsigned* ctl = (unsigned*)(WSP + WS_CTL);
#pragma unroll 1
        for (int te = wave; te < 24; te += 8) { const int t = te >> 3, e = te & 7;
            const float* wt = t == 0 ? LDP(30) : (t == 1 ? LDP(31) : LDP(32));
            const f32x4 v = ((const f32x4*)(wt + (size_t)e * ((size_t)D * FFE) + (size_t)(bid % 256) * 14336))[lane];
            const float m = wave_max(fmaxf(fmaxf(fabsf(v.x), fabsf(v.y)), fmaxf(fabsf(v.z), fabsf(v.w))));
            if (lane == 0) atomicMax(&ctl[CW_WMAX + te], __float_as_uint(m)); } }
    { unsigned char* ws = WSP;
      ph_init(LDP(0), LDP(1), OUTP, (float*)(ws + WS_HMETA), (float*)(ws + WS_ROPE), LDP(23), LDP(24), (bf16_t*)(ws + WS_V1T), (size_t)bid * 512 + tid, (size_t)nblk * 512); }
    int rot = 0;
#pragma unroll 1
    for (int l = 0; l < 2; ++l) { unsigned char* lw = WSP + WS_WB + l * LW_STRIDE;
        { const TrJob J{LDP(5) + (size_t)l * D * 2624, nullptr, (bf16_t*)(lw + LW_WIN), D, 2624, 1024, 0, 1, 0}; ph_transpose(J, scr, gw, ngw, lane, rot); rot += (J.K / 64) * (J.N / 32); }
        { const TrJob J{LDP(9) + (size_t)l * 512 * 768, LDP(7) + l * 512, (bf16_t*)(lw + LW_WUQ), 512, 768, 512, 0, 0, 0}; ph_transpose(J, scr, gw, ngw, lane, rot); rot += (J.K / 64) * (J.N / 32); }
        { const TrJob J{LDP(10) + (size_t)l * 256 * 1024, LDP(8) + l * 256, (bf16_t*)(lw + LW_WK), 256, 1024, 256, 0, 4, 0}; ph_transpose(J, scr, gw, ngw, lane, rot); rot += (J.K / 64) * (J.N / 32); }
        { const TrJob J{LDP(13) + (size_t)l * 64 * 512, nullptr, (bf16_t*)(lw + LW_LORA), 64, 512, 256, 0, 0, 0}; ph_transpose(J, scr, gw, ngw, lane, rot); rot += (J.K / 64) * (J.N / 32); }
        { const TrJob J{LDP(15) + (size_t)l * 64 * 512, nullptr, (bf16_t*)(lw + LW_LORA), 64, 512, 256, 64, 0, 512}; ph_transpose(J, scr, gw, ngw, lane, rot); rot += (J.K / 64) * (J.N / 32); }
        { const TrJob J{LDP(16) + (size_t)l * 128 * 512, nullptr, (bf16_t*)(lw + LW_LORA), 128, 512, 256, 128, 0, 1024}; ph_transpose(J, scr, gw, ngw, lane, rot); rot += (J.K / 64) * (J.N / 32); }
        { const TrJob J{LDP(6) + (size_t)l * D * D, nullptr, (bf16_t*)(lw + LW_WOUT), D, D, 1024, 0, 0, 0}; ph_transpose(J, scr, gw, ngw, lane, rot); rot += (J.K / 64) * (J.N / 32); }
    }
    { const TrJob J{LDP(25), nullptr, (bf16_t*)(WSP + WS_FGU), D, FF0, 1024, 0, 2, 0}; ph_transpose(J, scr, gw, ngw, lane, rot); rot += (J.K / 64) * (J.N / 32); }
    { const TrJob J{LDP(26), nullptr, (bf16_t*)(WSP + WS_FGU), D, FF0, 1024, 0, 3, 0}; ph_transpose(J, scr, gw, ngw, lane, rot); rot += (J.K / 64) * (J.N / 32); }
    { const TrJob J{LDP(27), nullptr, (bf16_t*)(WSP + WS_FDN), FF0, D, FF0, 0, 0, 0}; ph_transpose(J, scr, gw, ngw, lane, rot); rot += (J.K / 64) * (J.N / 32); }
}
NOINL void f_rmsnorm(unsigned long long kp_, int which, int l) { const unsigned long long kp = kp_uniform(kp_); which = __builtin_amdgcn_readfirstlane(which); l = __builtin_amdgcn_readfirstlane(l); WAVE_IDS(); unsigned char* ws = WSP;
    const float* hsrc = (which == 0 && l == 0) ? LDP(0) : (const float*)OUTP;
    ph_rmsnorm(hsrc, (const float*)(ws + WS_HMETA), (which ? LDP(3) : LDP(2)) + l * D, (bf16_t*)(ws + A_U), (const float*)(ws + A_PART), which ? 4 : (l ? 11 : 0), gw, ngw, lane); }
NOINL void f_prep(unsigned long long kp_, int l) { const unsigned long long kp = kp_uniform(kp_); l = __builtin_amdgcn_readfirstlane(l); WAVE_IDS(); unsigned char* ws = WSP;
    ph_prep((const bf16_t*)(ws + A_PM), (const bf16_t*)(ws + A_PR), LDP(11) + l * 1792, (const float*)(ws + WS_ROPE), (float*)(ws + A_RSTDQ), (float*)(ws + A_RSTDKV),
            (bf16_t*)(ws + A_KROPE), (bf16_t*)(ws + A_LIN), (bf16_t*)(ws + A_VSH), l, gw, ngw, lane); }
constexpr int RW_NSEQ = 129;
constexpr size_t RW_BUF = (size_t)RW_NSEQ * 8 * CHK_BYTES;
static_assert(2 * RW_BUF <= A_VFIRST - A_CHK, "two chunk buffers fit the chunk region");
constexpr int RW_SKIP = 4;
__device__ __forceinline__ bool rw_is_scan_wg(int bid) { return (bid & 3) == 0; }
__device__ __forceinline__ int rw_rank(int bid) { return bid - (bid >> 2) - 1; }
__device__ __forceinline__ void f_rwkv_cp(unsigned long long kp_, LAS unsigned char* lds, int l, int q) {
    const unsigned long long kp = kp_uniform(kp_); l = __builtin_amdgcn_readfirstlane(l); q = __builtin_amdgcn_readfirstlane(q);
    const int bid = (int)blockIdx.x, nblk = (int)gridDim.x; unsigned char* ws = WSP;
    const CpP cp{(const bf16_t*)(ws + A_PR), (const bf16_t*)(ws + A_LOUT), (const bf16_t*)(ws + A_VMIX), (const bf16_t*)(ws + A_VFIRST), (bf16_t*)(ws + (l ? A_VP : A_VFIRST)), (float*)(ws + A_RK), ws + A_CHK + (size_t)(q & 1) * RW_BUF,
                 LDP(11) + l * 1792, LDP(12) + l * 512, LDP(14) + l * 512, LDP(17) + l * 512, LDP(18) + l * 512, LDP(19) + l * 512, LDP(22), l, 0};
    const int ntask = (q == 0 ? RW_NSEQ : RW_NSEQ - 1) * 8, hs = q == 0 ? 0 : RW_SKIP, NS = nblk - ((nblk + 3) >> 2);
    const bool scanwg = rw_is_scan_wg(bid); const int rank = rw_rank(bid);
#define RW_TASK(i_) (scanwg ? hs * NS + (i_) * nblk + bid : ((i_) < hs ? (i_) * NS + rank : hs * NS + ((i_) - hs) * nblk + bid))
#define RW_ROW0(t_) (((t_) >> 3) == 128 ? RREAL : ((t_) >> 7) * SEQ + (16 * q + (((t_) >> 3) & 15)) * 64)
    const int tid_ = opq(threadIdx.x), lane_ = tid_ & 63, w_ = __builtin_amdgcn_readfirstlane(tid_ >> 6);
    int task = RW_TASK(0); if (task >= ntask) return;
    CpRaw raw; cp_issue(cp, RW_ROW0(task), task & 7, w_, lane_, raw);
#pragma unroll 1
    for (int i = 0; ; ++i) { const int nxt = RW_TASK(i + 1); const bool has_next = nxt < ntask;
        rwkv_cp_task(lds, cp, RW_ROW0(task), task & 7, cp.CHK + (size_t)task * CHK_BYTES, raw, has_next, has_next ? RW_ROW0(nxt) : 0, nxt & 7);
        if (!has_next) break;
        task = nxt; }
#undef RW_TASK
#undef RW_ROW0
}
__device__ __forceinline__ void f_rwkv_scan(unsigned long long kp_, LAS unsigned char* lds, int l, int q) {
    const unsigned long long kp = kp_uniform(kp_); l = __builtin_amdgcn_readfirstlane(l); q = __builtin_amdgcn_readfirstlane(q);
    const int bid = (int)blockIdx.x, nblk = (int)gridDim.x; if (!rw_is_scan_wg(bid)) return;
    unsigned char* ws = WSP; const ScP sp{ws + A_CHK + (size_t)(q & 1) * RW_BUF, (bf16_t*)(ws + A_YS)};
#pragma unroll 1
    for (int unit = bid >> 2; unit < 64; unit += (nblk + 3) >> 2) { const int b = unit >> 3, hd = unit & 7; float* stp = (float*)(ws + A_SCST) + (size_t)unit * 4096;
        rwkv_scan_unit(lds, sp, b * 16, 128, q == 0 ? 1 : 0, 16, b * SEQ + q * 1024, hd, q == 0 && b == 0, q == 0 ? nullptr : stp, q == 3 ? nullptr : stp); }
}
NOINL void f_rwkv_post(unsigned long long kp_, int l, int q, int mode) {
    const unsigned long long kp = kp_uniform(kp_); l = __builtin_amdgcn_readfirstlane(l); q = __builtin_amdgcn_readfirstlane(q); mode = __builtin_amdgcn_readfirstlane(mode); WAVE_IDS(); unsigned char* ws = WSP;
    const PostP pp{(const bf16_t*)(ws + A_YS), (const bf16_t*)(ws + (l ? A_VP : A_VFIRST)), (const float*)(ws + A_RK), (const bf16_t*)(ws + A_LOUT), (bf16_t*)(ws + A_PM), LDP(20) + l * 512, LDP(21) + l * 512};
    const bool scanwg = rw_is_scan_wg(bid); const int nscan = (nblk + 3) >> 2, NS = nblk - nscan;
    if (mode == 2) rwkv_post(pp, q, 0, 8192, q == 0, gw, ngw, lane);
    else if (mode == 1) { if (!scanwg) rwkv_post(pp, q, 0, 8192, q == 0, rw_rank(bid) * 8 + wave, NS * 8, lane); }
    else if (scanwg) rwkv_post(pp, q, 0, 4096, false, (bid >> 2) * 8 + wave, nscan * 8, lane);
    else rwkv_post(pp, q, 4096, 8192, q == 0, rw_rank(bid) * 8 + wave, NS * 8, lane); }
NOINL void f_ffn_meta(unsigned long long kp_) {
    const unsigned long long kp = kp_uniform(kp_); WAVE_IDS(); unsigned char* ws = WSP;
    const int job = bid * 8 + wave; if (job >= FF0 / 16) return;
    const int f0 = job * 16, l15 = lane & 15, kq = lane >> 4;
    const bf16_t* wg = (const bf16_t*)(ws + WS_FGU) + (size_t)((f0 >> 7) * 256 + (f0 & 127) + l15) * 1024 + 8 * kq;
    const bf16_t* wu = wg + (size_t)128 * 1024;
    const bf16_t* xu = (const bf16_t*)(ws + A_U) + (size_t)(RREAL + l15) * D + 8 * kq;
    f32x4 ag = {0.f, 0.f, 0.f, 0.f}, au = {0.f, 0.f, 0.f, 0.f};
#pragma unroll 8
    for (int ks = 0; ks < 32; ++ks) { const bf16x8 a = *(const GAS bf16x8*)(wg + 32 * ks), b = *(const GAS bf16x8*)(wu + 32 * ks), x = *(const GAS bf16x8*)(xu + 32 * ks);
        ag = __builtin_amdgcn_mfma_f32_16x16x32_bf16(a, x, ag, 0, 0, 0); au = __builtin_amdgcn_mfma_f32_16x16x32_bf16(b, x, au, 0, 0, 0); }
    float r[4];
#pragma unroll
    for (int j = 0; j < 4; ++j) { const float g = ag[j], up = au[j]; r[j] = g / (1.0f + __expf(-g)) * up; }
    u32x2 o; o.x = cvtpk(r[0], r[1]); o.y = cvtpk(r[2], r[3]);
    *(GAS u32x2*)((bf16_t*)(ws + A_ACT0) + (size_t)(RREAL + l15) * FF0 + f0 + 4 * kq) = o;
}
NOINL void f_moe_tr(unsigned long long kp_, LAS unsigned char* lds) {
    const unsigned long long kp = kp_uniform(kp_); WAVE_IDS(); LAS float* scr = (LAS float*)(lds + wave * 8448);
    if (bid == 0 && tid < 24) { unsigned* ctlw = (unsigned*)(WSP + WS_CTL); const float sc = moe_wscale_bits(ctlw[CW_WMAX + tid]); ctlw[CW_WINV + tid] = __float_as_uint(1.0f / (F8_ACT * sc)); }
    int rot = 0;
#pragma unroll 1
    for (int e = 0; e < NEXP * PROBE_REP_MOETR; ++e) { const int ee = e % NEXP;
        const unsigned* ctl = (const unsigned*)(WSP + WS_CTL);
        { const TrJob8 J{LDP(30) + (size_t)ee * D * FFE, WSP + A_MGU, D, FFE, 1024, 2, ee * 2 * FFE, moe_wscale(ctl, 0, ee)}; ph_transpose_f8(J, scr, gw, ngw, lane, rot); rot += (J.K / 64) * (J.N / 32); }
        { const TrJob8 J{LDP(31) + (size_t)ee * D * FFE, WSP + A_MGU, D, FFE, 1024, 3, ee * 2 * FFE, moe_wscale(ctl, 1, ee)}; ph_transpose_f8(J, scr, gw, ngw, lane, rot); rot += (J.K / 64) * (J.N / 32); }
        { const TrJob8 J{LDP(32) + (size_t)ee * FFE * D, WSP + A_MDN, FFE, D, FFE, 0, ee * D, moe_wscale(ctl, 2, ee)}; ph_transpose_f8(J, scr, gw, ngw, lane, rot); rot += (J.K / 64) * (J.N / 32); }
    }
}
__device__ __forceinline__ void f_moe_route(unsigned long long kp_, LAS unsigned char* lds) {
    const unsigned long long kp = kp_uniform(kp_); WAVE_IDS(); unsigned char* ws = WSP;
    ph_norm_route(lds, OUTP, LDP(3) + D, LDP(28), LDP(29), (bf16_t*)(ws + A_U), (int*)(ws + A_MTAB + MT_E), (float*)(ws + A_MTAB + MT_G), (int*)(ws + A_MTAB + MT_STOK), (unsigned*)(ws + WS_CTL), bid, nblk, wave, lane); }
NOINL void f_moe_assign(unsigned long long kp_, LAS unsigned char* lds, int list) { const unsigned long long kp = kp_uniform(kp_); list = __builtin_amdgcn_readfirstlane(list); WAVE_IDS(); unsigned char* ws = WSP;
    ph_moe_assign(lds, list, (const int*)(ws + A_MTAB + MT_E), (const float*)(ws + A_MTAB + MT_G), (int*)(ws + A_MTAB + MT_STOK), (float*)(ws + A_MTAB + MT_SGATE), (int*)(ws + A_MTAB + MT_BE), (unsigned*)(ws + WS_CTL), ws + A_U, ws + A_XB, bid, nblk, tid); }
NOINL void f_final(unsigned long long kp_) { const unsigned long long kp = kp_uniform(kp_); WAVE_IDS(); unsigned char* ws = WSP; ph_final(OUTP, LDP(4), (const int*)(ws + A_MTAB + MT_TSLOT), (const float*)(ws + WS_TB), gw, ngw, lane); }

__global__ void __launch_bounds__(512, 2) fwd(Params P) {
    extern __shared__ __attribute__((aligned(16))) unsigned char lds_raw[];
    LAS unsigned char* lds = (LAS unsigned char*)lds_raw;
    const int tid = threadIdx.x;
    const int bid = (int)blockIdx.x, nblk = (int)gridDim.x;
    const unsigned long long kp = (unsigned long long)__builtin_amdgcn_kernarg_segment_ptr();
    volatile LAS unsigned* misc = (volatile LAS unsigned*)(lds + LDS_MISC);
    if (tid < 64) misc[tid] = 0u;
    __syncthreads();
    XcdBarrier bar;
    { unsigned* ctl0 = (unsigned*)(WSP + WS_CTL); bar = xcd_barrier_post(ctl0 + CW_BAR, misc + 8); }
#ifdef PROBE_BAR2
#define GRID_BAR() do { xcd_barrier(bar); xcd_barrier(bar); } while (0)
#else
#define GRID_BAR() xcd_barrier(bar)
#endif
    for (int rep_ = 0; rep_ < PROBE_REP_MISC; ++rep_) f_p0(kp, lds);
    GRID_BAR();

#pragma unroll 1
    for (int l = 0; l < 2; ++l) {
        for (int rep_ = 0; rep_ < PROBE_REP_NORM; ++rep_) f_rmsnorm(kp, 0, l);
        GRID_BAR();
_Pragma("unroll 1") for (int rep_ = 0; rep_ < PROBE_REP_INPROJ; ++rep_) {
        { unsigned char* ws = WSP; pg8::Gemm g{(const bf16_t*)(ws + A_U), (const bf16_t*)(ws + WS_WB + l * LW_STRIDE + LW_WIN), RP, 2816, 1024, 1024, 1024, 0}; pg8::StaticOrder S; S.init(RP, 2816, opqs(nblk), opqs(bid));
          EpiInProj E{(bf16_t*)(ws + A_PM), (bf16_t*)(ws + A_PR)};
          pg8::gemm_phase<EpiInProj, pg8::StaticOrder, true, true>(lds, g, S, E); }
}
        GRID_BAR();
        for (int rep_ = 0; rep_ < PROBE_REP_PREP; ++rep_) f_prep(kp, l);
        GRID_BAR();
_Pragma("unroll 1") for (int rep_ = 0; rep_ < PROBE_REP_P4A; ++rep_) {
        { unsigned char* ws = WSP; pg8::Gemm g{(const bf16_t*)(ws + A_PM), (const bf16_t*)(ws + WS_WB + l * LW_STRIDE + LW_WUQ), RP, 768, 512, 1024, 512, 0}; pg8::StaticOrder S; S.init(RP, 768, opqs(nblk), opqs(bid));
          EpiRowScale E{(bf16_t*)(ws + A_U), (const float*)(ws + A_RSTDQ), 768, 0};
          pg8::gemm_phase<EpiRowScale, pg8::StaticOrder, true, true>(lds, g, S, E); }
        { unsigned char* ws = WSP; pg8::Gemm g{(const bf16_t*)(ws + A_PM) + 512, (const bf16_t*)(ws + WS_WB + l * LW_STRIDE + LW_WK), RP, 512, 256, 1024, 256, 0}; pg8::StaticOrder S; S.init(RP, 512, opqs(nblk), opqs((bid + nblk - 131) % nblk));
          EpiRowScale E{(bf16_t*)(ws + A_KN), (const float*)(ws + A_RSTDKV), 512, 0};
          pg8::gemm_phase<EpiRowScale, pg8::StaticOrder, true, true>(lds, g, S, E); }
        { unsigned char* ws = WSP; pg8::Gemm g{(const bf16_t*)(ws + WS_WB + l * LW_STRIDE + LW_WV), (const bf16_t*)(ws + A_PM) + 512, 512, RP, 256, 256, 1024, 0}; pg8::StaticOrder S; S.init(512, RP, opqs(nblk), opqs((bid + nblk - 133) % nblk));
          EpiColScale E{(bf16_t*)(ws + A_VT), (const float*)(ws + A_RSTDKV), RP, 0};
          pg8::gemm_phase<EpiColScale, pg8::StaticOrder, true, true>(lds, g, S, E); }
}
        GRID_BAR();
_Pragma("unroll 1") for (int rep_ = 0; rep_ < PROBE_REP_ATT; ++rep_) {
        { unsigned char* ws = WSP; attn_phase(lds, (const bf16_t*)(ws + A_U), (const bf16_t*)(ws + A_KN), (const bf16_t*)(ws + A_KROPE), (const bf16_t*)(ws + A_VT), (bf16_t*)(ws + A_PM), (const float*)(ws + WS_ROPE), opqs(bid), opqs(nblk)); }
}
        GRID_BAR();
_Pragma("unroll 1") for (int rep_ = 0; rep_ < PROBE_REP_P4B; ++rep_) {
        { unsigned char* ws = WSP; pg8::Gemm g{(const bf16_t*)(ws + A_LIN), (const bf16_t*)(ws + WS_WB + l * LW_STRIDE + LW_LORA), RP, 1536, 256, 256, 256, 0}; pg8::StaticOrder S; S.init(RP, 1536, opqs(nblk), opqs(bid));
          EpiRowScale E{(bf16_t*)(ws + A_LOUT), nullptr, 1536, 0};
          pg8::gemm_phase<EpiRowScale, pg8::StaticOrder, true, true>(lds, g, S, E); }
        if (l == 1) {
            unsigned char* ws = WSP; pg8::Gemm g{(const bf16_t*)(ws + A_VSH), (const bf16_t*)(ws + WS_V1T), RP, 512, 512, 512, 512, 0}; pg8::StaticOrder S; S.init(RP, 512, opqs(nblk), opqs((bid + nblk - 6) % nblk));
            EpiRowScale E{(bf16_t*)(ws + A_VMIX), nullptr, 512, 0};
            pg8::gemm_phase<EpiRowScale, pg8::StaticOrder, true, true>(lds, g, S, E);
        }
}
        GRID_BAR();
#pragma unroll 1
        for (int stp = 0; stp < 6; ++stp) {
            if (stp >= 1 && stp <= 4) { _Pragma("unroll 1") for (int rep_ = 0; rep_ < PROBE_REP_SCAN; ++rep_) f_rwkv_scan(kp, lds, l, stp - 1); }
            if (stp <= 3) { _Pragma("unroll 1") for (int rep_ = 0; rep_ < PROBE_REP_CP; ++rep_) f_rwkv_cp(kp, lds, l, stp); }
            if (stp >= 2) { for (int rep_ = 0; rep_ < PROBE_REP_MISC; ++rep_) f_rwkv_post(kp, l, stp - 2, stp <= 3 ? 0 : stp - 3); }
            GRID_BAR();
        }
_Pragma("unroll 1") for (int rep_ = 0; rep_ < PROBE_REP_OUTPROJ; ++rep_) {
        { unsigned char* ws = WSP; pg8::Gemm g{(const bf16_t*)(ws + A_PM), (const bf16_t*)(ws + WS_WB + l * LW_STRIDE + LW_WOUT), RREAL, 1024, 1024, 1024, 1024, 0}; pg8::StaticOrder S; S.init(RREAL, 1024, opqs(nblk), opqs(bid));
          EpiResid E{OUTP, (float*)(ws + WS_HMETA), (l == 0 && rep_ == 0) ? LDP(0) : (const float*)OUTP, rep_ == 0 ? 1.0f : 0.0f, 0};
          pg8::gemm_phase<EpiResid, pg8::StaticOrder, true, true>(lds, g, S, E); }
        if (rep_ == 0 && l == 0) {
          unsigned char* ws = WSP; pg8::Gemm g{(const bf16_t*)(ws + A_PM), (const bf16_t*)(ws + WS_WB + l * LW_STRIDE + LW_WOUT), RP, 1024, 256, 1024, 1024, 0};
          const DenseTailOrder S{4, 4, opqs(nblk), opqs(bid)}; EpiResidPartial E{(float*)(ws + A_PART)};
          pg8::gemm_phase<EpiResidPartial, DenseTailOrder, true, true>(lds, g, S, E); }
}
        GRID_BAR();
        if (l == 0) {
            for (int rep_ = 0; rep_ < PROBE_REP_MISC; ++rep_) f_rmsnorm(kp, 1, 0);
            GRID_BAR();
_Pragma("unroll 1") for (int rep_ = 0; rep_ < PROBE_REP_FFNGU; ++rep_) {
            f_ffn_meta(kp);
            { unsigned char* ws = WSP; pg8::Gemm g{(const bf16_t*)(ws + A_U), (const bf16_t*)(ws + WS_FGU), RREAL, 2 * FF0, 1024, 1024, 1024, 0}; pg8::StaticOrder S; S.init(RREAL, 2 * FF0, opqs(nblk), opqs(bid));
              EpiSwiGLU E{(bf16_t*)(ws + A_ACT0), FF0, 22, 0, 0};
              pg8::gemm_phase<EpiSwiGLU, pg8::StaticOrder, true, true>(lds, g, S, E); }
}
            GRID_BAR();
_Pragma("unroll 1") for (int rep_ = 0; rep_ < PROBE_REP_FFNDN; ++rep_) {
            { unsigned char* ws = WSP; pg8::Gemm g{(const bf16_t*)(ws + A_ACT0), (const bf16_t*)(ws + WS_FDN), RREAL, 1024, FF0, FF0, FF0, 0}; pg8::StaticOrder S; S.init(RREAL, 1024, opqs(nblk), opqs(bid));
              EpiResid E{OUTP, (float*)(ws + WS_HMETA), (const float*)OUTP, rep_ == 0 ? 1.0f : 0.0f, 0};
              pg8::gemm_phase<EpiResid, pg8::StaticOrder, true, true>(lds, g, S, E); }
            if (rep_ == 0) {
              unsigned char* ws = WSP; pg8::Gemm g{(const bf16_t*)(ws + A_ACT0), (const bf16_t*)(ws + WS_FDN), RP, 1024, 256, FF0, FF0, 0};
              const DenseTailOrder S{4, 11, opqs(nblk), opqs(bid)}; EpiResidPartial E{(float*)(ws + A_PART)};
              pg8::gemm_phase<EpiResidPartial, DenseTailOrder, true, true>(lds, g, S, E); }
}
            GRID_BAR();
        } else {
            f_moe_tr(kp, lds);
            f_moe_route(kp, lds);
            GRID_BAR();
            f_moe_assign(kp, lds, 0);
            f_moe_assign(kp, lds, 1);
            GRID_BAR();
#pragma unroll 1
            for (int list = 0; list < 2; ++list) {
                const int np0 = __builtin_amdgcn_readfirstlane((int)((const unsigned*)(WSP + WS_CTL))[CW_NPAN]), np1 = __builtin_amdgcn_readfirstlane((int)((const unsigned*)(WSP + WS_CTL))[CW_NPAN + 1]);
                const int T0 = np0 > MOE_TAILPAN ? (np0 - MOE_TAILPAN) * 4 : 0, T1 = np1 > MOE_TAILPAN ? (np1 - MOE_TAILPAN) * 4 : 0;
                if (list == 1) {
                    { unsigned char* ws = WSP; pg8::Gemm g{(const bf16_t*)(ws + A_MACT), (const bf16_t*)(ws + A_MDN), 0, 0, FFE / 2, FFE / 2, FFE / 2, 0};
                      const MoeShiftTailOrder S{(const int*)(ws + A_MTAB + MT_BE), (const unsigned*)(ws + WS_CTL) + CW_NPAN, 4, 4, 0, opqs(nblk) - 1, opqs(bid), 0};
                      EpiMoeDown E{OUTP, (const int*)(ws + A_MTAB + MT_STOK), (const float*)(ws + A_MTAB + MT_SGATE), 4, 1.0f, (const unsigned*)(ws + WS_CTL)};
                      pg8::gemm_phase<EpiMoeDown, MoeShiftTailOrder, true, true, true>(lds, g, S, E); }
                    { unsigned char* ws = WSP; pg8::Gemm g{(const bf16_t*)(ws + A_MACT), (const bf16_t*)(ws + A_MDN), 0, 0, FFE / 2, FFE / 2, FFE / 2, 0};
                      const MoeShiftTailOrder S{(const int*)(ws + A_MTAB + MT_BE) + 256, (const unsigned*)(ws + WS_CTL) + CW_NPAN + 1, 4, 4, MOE_GAP, opqs(nblk) - 1 - T0, opqs(bid), 0};
                      EpiMoeDownStore E{(float*)(ws + WS_TB), (const int*)(ws + A_MTAB + MT_STOK) + MOE_MAXPAN * 256, (const float*)(ws + A_MTAB + MT_SGATE) + MOE_MAXPAN * 256, 4, MOE_TAILPAN + MOE_GAP, (const unsigned*)(ws + WS_CTL)};
                      pg8::gemm_phase<EpiMoeDownStore, MoeShiftTailOrder, true, true, true>(lds, g, S, E); }
                }
_Pragma("unroll 1") for (int rep_ = 0; rep_ < PROBE_REP_MOEGU; ++rep_) {
                { unsigned char* ws = WSP; pg8::Gemm g{(const bf16_t*)(ws + A_XB + (size_t)list * XB_LIST), (const bf16_t*)(ws + A_MGU), 0, 0, 512, 512, 512, 0};
                  const int Tt = list == 1 && T0 + T1 < opqs(nblk) ? T0 + T1 : 0;
                  const MoeSlotOrder S{(const int*)(ws + A_MTAB + MT_BE) + 256 * list, (const unsigned*)(ws + WS_CTL) + CW_NPAN + list, (const int*)(ws + A_MTAB + MT_STOK) + list * MOE_MAXPAN * 256, 28, 28, 0, opqs(nblk), opqs(bid), RREAL,
                                         0, list == 0 ? MOE_MAXPAN : MOE_TAILPAN, 0, 0, Tt, MOE_CSKIP};
                  EpiSwiGLU8 E{ws + A_MACT, (const unsigned*)(ws + WS_CTL), FFE, 28};
                  pg8::gemm_phase<EpiSwiGLU8, MoeSlotOrder, true, true, true>(lds, g, S, E); }
                if (list == 0) {
                  unsigned char* ws = WSP; pg8::Gemm g{(const bf16_t*)(ws + A_XB + XB_LIST), (const bf16_t*)(ws + A_MGU), 0, 0, 512, 512, 512, 0};
                  const int nb = opqs(nblk);
                  const MoeSlotOrder S{(const int*)(ws + A_MTAB + MT_BE) + 256, (const unsigned*)(ws + WS_CTL) + CW_NPAN + 1, (const int*)(ws + A_MTAB + MT_STOK) + MOE_MAXPAN * 256, 28, 28, 0, nb, opqs(bid), RREAL,
                                         MOE_TAILPAN, MOE_MAXPAN, MOE_GAP, (np0 * 28) % nb, 0, 0};
                  EpiSwiGLU8 E{ws + A_MACT, (const unsigned*)(ws + WS_CTL), FFE, 28};
                  pg8::gemm_phase<EpiSwiGLU8, MoeSlotOrder, true, true, true>(lds, g, S, E); }
}
                GRID_BAR();
_Pragma("unroll 1") for (int rep_ = 0; rep_ < PROBE_REP_MOEDN; ++rep_) {
                { unsigned char* ws = WSP; pg8::Gemm g{(const bf16_t*)(ws + A_MACT), (const bf16_t*)(ws + A_MDN), 0, 0, FFE / 2, FFE / 2, FFE / 2, 0};
                  const MoeOrder S{(const int*)(ws + A_MTAB + MT_BE) + 256 * list, (const unsigned*)(ws + WS_CTL) + CW_NPAN + list, 4, 4, 0, opqs(nblk), opqs(bid), MOE_TAILPAN * 4};
                  EpiMoeDown E{OUTP, (const int*)(ws + A_MTAB + MT_STOK) + list * MOE_MAXPAN * 256, (const float*)(ws + A_MTAB + MT_SGATE) + list * MOE_MAXPAN * 256, 4, rep_ == 0 ? 1.0f : 0.0f, (const unsigned*)(ws + WS_CTL)};
                  pg8::gemm_phase<EpiMoeDown, MoeOrder, true, true, true>(lds, g, S, E); }
}
                GRID_BAR();
            }
        }
    }
    f_final(kp);
}

extern "C" void kernel_launch(void* const* d_in, const int* in_sizes, int n_in, void* d_out, int out_size, void* d_ws, size_t ws_size, hipStream_t stream) {
    static int grid = 0;
    if (grid == 0) {
        if (n_in != 33 || ws_size < WS_NEED || out_size != RREAL * D) { fprintf(stderr, "kernel_launch: unexpected arguments (n_in %d, ws %zu need %zu, out %d)\n", n_in, ws_size, (size_t)WS_NEED, out_size); grid = -1; return; }
        int dev = 0, cus = 0;
        if (hipGetDevice(&dev) != hipSuccess || hipDeviceGetAttribute(&cus, hipDeviceAttributeMultiprocessorCount, dev) != hipSuccess) { grid = -1; return; }
        if (hipFuncSetAttribute((const void*)fwd, hipFuncAttributeMaxDynamicSharedMemorySize, LDS_BYTES) != hipSuccess) { fprintf(stderr, "kernel_launch: hipFuncSetAttribute failed\n"); grid = -1; return; }
        int per_cu = 0; (void)hipOccupancyMaxActiveBlocksPerMultiprocessor(&per_cu, (const void*)fwd, 512, LDS_BYTES); (void)hipGetLastError();
        grid = cus;
    }
    if (grid < 0) return;
    unsigned char* ws = (unsigned char*)d_ws;
    (void)hipMemsetAsync(ws + WS_CTL, 0, 1 * MiB, stream);
    (void)hipMemsetAsync(ws + WS_WB, 0, WS_ROPE - WS_WB, stream);
    Params p{};
    for (int i = 0; i < 33; ++i) p.in[i] = (const float*)d_in[i];
    p.out = (float*)d_out; p.ws = ws;
    hipLaunchKernelGGL(fwd, dim3(grid), dim3(512), LDS_BYTES, stream, p);
}
```

```cpp
#include <hip/hip_runtime.h>
#include <cstdio>
#include <cstdint>
namespace pg8 {
#define PG8_LAS __attribute__((address_space(3)))
typedef unsigned short bf16_t;
typedef short bf16x8 __attribute__((ext_vector_type(8)));
typedef float f32x4 __attribute__((ext_vector_type(4)));
typedef unsigned u32x4 __attribute__((ext_vector_type(4)));
constexpr int BM = 256, BK = 64, HALF = 128, HTB = HALF * BK * 2  , STAGE_BYTES = 8 * HTB, NXCD = 8, WGM = 8;

__host__ __device__ __forceinline__ int lds_byte(int r, int c) { const int st = (r >> 4) * 2 + (c >> 5), rr = r & 15, cc = c & 31, ob = rr * 64 + cc * 2; return st * 1024 + (ob ^ (((ob >> 9) & 1) << 5)); }
__host__ __device__ __forceinline__ void stage_rc(int b, int& R, int& C) { const int st = b / 1024, sb = b % 1024, swz = sb ^ (((sb >> 9) & 1) << 5); R = (st >> 1) * 16 + swz / 64; C = (st & 1) * 32 + (swz % 64) / 2; }
__host__ __device__ __forceinline__ int perm32(int rho) { const int n = rho >> 4, i = rho & 15; return 8 * (i >> 2) + 4 * n + (i & 3); }

struct Unit { int pm, pn, k0; };
struct Gemm { const bf16_t* A; const bf16_t* Bt; int M, N, K, lda, ldb, pad; };

struct StaticOrder {
    static constexpr bool GATHER = false;
    int nM, nN, nwg, G, c;
    __host__ __device__ void init(int M, int N, int G_, int c_) { nM = M / BM; nN = N / BM; nwg = nM * nN; G = G_; c = c_; }
    __host__ __device__ bool next(int i, Unit& u) const {
        const long L = (long)i * G + c; if (L >= nwg) return false;
        int wgid = (int)L; { const int q = nwg / NXCD, r = nwg % NXCD, xcd = wgid % NXCD, off = wgid / NXCD; wgid = (xcd < r ? xcd * (q + 1) : r * (q + 1) + (xcd - r) * q) + off; }
        const int nig = WGM * nN, gid = wgid / nig, fm = gid * WGM, gsz = (nM - fm) < WGM ? (nM - fm) : WGM;
        u.pm = fm + ((wgid % nig) % gsz); u.pn = (wgid % nig) / gsz; u.k0 = 0; return true;
    }
    __device__ __forceinline__ void a_ready(const Unit&) const {}
    __device__ __forceinline__ void done(const Unit&) const {}
};

__device__ __forceinline__ unsigned cvt_pk_bf16(float lo, float hi) { unsigned r; asm volatile("v_cvt_pk_bf16_f32 %0, %1, %2" : "=v"(r) : "v"(lo), "v"(hi)); return r; }
typedef int i32x4_ __attribute__((ext_vector_type(4)));
typedef int i32x8_ __attribute__((ext_vector_type(8)));
template <class Epi, class Sched, bool ALIGN_EPI = false, bool SP2 = false, bool FP8 = false>
__device__ __forceinline__ void gemm_phase(PG8_LAS unsigned char* lds, const Gemm g, const Sched& S, const Epi& E) {
    int tid_ = threadIdx.x; asm volatile("" : "+v"(tid_)); const int tid = tid_, wid = __builtin_amdgcn_readfirstlane(tid >> 6), lane = tid & 63, wr = wid >> 2, wc = wid & 3, fr = lane & 15, fq = lane >> 4;
    const int K = g.K, nt = K / BK;
    unsigned voffA[2], voffB[2];
#pragma unroll
    for (int i = 0; i < 2; ++i) { int R, C; stage_rc(tid * 16 + i * 8192, R, C); const int Rb = Epi::PERM ? ((R & ~31) + perm32(R & 31)) : R;
        voffA[i] = (unsigned)(R * g.lda + C) * 2u; voffB[i] = (unsigned)(Rb * g.ldb + C) * 2u; }
    constexpr bool GATHER = Sched::GATHER;
    unsigned vAc[2][2] = {{0u, 0u}, {0u, 0u}}, vAn[2][2] = {{0u, 0u}, {0u, 0u}}, cbA[2] = {0u, 0u};
    if constexpr (GATHER) {
#pragma unroll
        for (int i = 0; i < 2; ++i) { int R, C; stage_rc(tid * 16 + i * 8192, R, C); cbA[i] = (unsigned)C * 2u; }
    }
#define PG8_IDX_DMA(un, slot) do { if constexpr (GATHER) { const int* rp_ = S.rows + (size_t)(un).pm * 256 + 128 * (lane >> 5) + 64 * ((lane >> 4) & 1) + 16 * (wid >> 1) + (lane & 15); \
        __builtin_amdgcn_global_load_lds((const unsigned*)rp_, (PG8_LAS unsigned*)(lds + STAGE_BYTES + wid * 512 + (slot) * 256), 4, 0, 0); } } while (0)
#define PG8_IDX_READ(dst, slot) do { if constexpr (GATHER) { int t3_ = threadIdx.x; asm volatile("" : "+v"(t3_));     \
        _Pragma("unroll") for (int h_ = 0; h_ < 2; ++h_) _Pragma("unroll") for (int i_ = 0; i_ < 2; ++i_) { int R_, C_; stage_rc(t3_ * 16 + i_ * 8192, R_, C_); \
        int tk_ = *(const PG8_LAS int*)(lds + STAGE_BYTES + (t3_ >> 6) * 512 + (slot) * 256 + 4 * (32 * h_ + 16 * i_ + ((t3_ & 63) >> 2))); tk_ = tk_ < 0 ? S.zero_row : tk_; \
        dst[h_][i_] = (unsigned)tk_ * (unsigned)(g.lda * 2) + (unsigned)C_ * 2u; } } } while (0)
#define PG8_STAGE_A(bufoff, base, h, nx) do { if constexpr (GATHER) { const unsigned vs_[2] = {(nx) ? vAn[h][0] : vAc[h][0], (nx) ? vAn[h][1] : vAc[h][1]}; PG8_STAGE(bufoff, base, vs_); } \
        else { PG8_STAGE(bufoff, (base) + (h) * hstepA, voffA); } } while (0)
    const size_t kstep = (size_t)(BK * 2);
    const size_t hstepA = (size_t)HALF * g.lda * 2, hstepB = (size_t)HALF * g.ldb * 2;
    const size_t tstepA = 2 * hstepA, tstepB = 2 * hstepB;
    const unsigned ldsw = (unsigned)wid * 1024u;
    const int aoff = lds_byte(wr * 64 + fr, fq * 8), boff = lds_byte(wc * 32 + fr, fq * 8);
#define PG8_SA(b, h) (((b) * 2 + (h)) * HTB)
#define PG8_SB(b, h) ((4 + (b) * 2 + (h)) * HTB)
#define PG8_STAGE(bufoff, gbase, voff) do { const char* gb_ = (const char*)(gbase); asm volatile("" : "+s"(gb_));   \
        _Pragma("unroll") for (int _i = 0; _i < 2; ++_i) \
        __builtin_amdgcn_global_load_lds((const unsigned*)(gb_ + (voff)[_i]), (PG8_LAS unsigned*)(lds + (bufoff) + ldsw + _i * 8192), 16, 0, 0); } while (0)
#define PG8_LDA(dst, b, h) do { _Pragma("unroll") for (int m = 0; m < 4; ++m) _Pragma("unroll") for (int k = 0; k < 2; ++k) dst[m][k] = *(const PG8_LAS bf16x8*)(lds + PG8_SA(b, h) + aoff + m * 2048 + k * 1024); } while (0)
#define PG8_LDB(dst, b, h) do { _Pragma("unroll") for (int n = 0; n < 2; ++n) _Pragma("unroll") for (int k = 0; k < 2; ++k) dst[n][k] = *(const PG8_LAS bf16x8*)(lds + PG8_SB(b, h) + boff + n * 2048 + k * 1024); } while (0)
#define PG8_MMA(ai, bj, At, Bt) do { __builtin_amdgcn_s_setprio(1); _Pragma("unroll") for (int m = 0; m < 4; ++m) _Pragma("unroll") for (int n = 0; n < 2; ++n) { \
        if constexpr (FP8) { const i32x8_ b8_ = __builtin_shufflevector(__builtin_bit_cast(i32x4_, Bt[n][0]), __builtin_bit_cast(i32x4_, Bt[n][1]), 0, 1, 2, 3, 4, 5, 6, 7); \
            const i32x8_ a8_ = __builtin_shufflevector(__builtin_bit_cast(i32x4_, At[m][0]), __builtin_bit_cast(i32x4_, At[m][1]), 0, 1, 2, 3, 4, 5, 6, 7); \
            acc[ai][bj][m][n] = __builtin_amdgcn_mfma_scale_f32_16x16x128_f8f6f4(b8_, a8_, acc[ai][bj][m][n], 0, 0, 0, 0, 0, 0); }     \
        else { _Pragma("unroll") for (int k = 0; k < 2; ++k) acc[ai][bj][m][n] = __builtin_amdgcn_mfma_f32_16x16x32_bf16(Bt[n][k], At[m][k], acc[ai][bj][m][n], 0, 0, 0); } } \
        __builtin_amdgcn_s_setprio(0); } while (0)
#define PG8_WAIT_V(n) asm volatile("s_waitcnt vmcnt(" #n ")" ::: "memory")
#define PG8_WAIT_L(n) asm volatile("s_waitcnt lgkmcnt(" #n ")" ::: "memory")
#define PG8_BAR __builtin_amdgcn_s_barrier()
#define PG8_SCHED __builtin_amdgcn_sched_barrier(0)
    Unit cur, nxt; int ui = 0;
    if (!S.next(0, cur)) return;
    float zf_ = 0.f; asm volatile("" : "+v"(zf_));
    f32x4 acc[2][2][4][2];
#pragma unroll
    for (int a = 0; a < 2; ++a)
#pragma unroll
        for (int b = 0; b < 2; ++b)
#pragma unroll
            for (int m = 0; m < 4; ++m)
#pragma unroll
                for (int n = 0; n < 2; ++n) acc[a][b][m][n] = (f32x4){zf_, zf_, zf_, zf_};
    bf16x8 At[4][2], B0[2][2], B1[2][2];
    const char* cA = (const char*)g.A + (GATHER ? (size_t)0 : (size_t)cur.pm * tstepA) + (size_t)cur.k0 * 2; const char* cB = (const char*)g.Bt + (size_t)cur.pn * tstepB + (size_t)cur.k0 * 2;
    S.a_ready(cur);
    if constexpr (GATHER) { PG8_IDX_DMA(cur, 0); asm volatile("s_waitcnt vmcnt(0)" ::: "memory"); PG8_IDX_READ(vAc, 0); }
    if constexpr (SP2) {
        PG8_STAGE(PG8_SB(0, 0), cB, voffB); PG8_STAGE(PG8_SB(0, 1), cB + hstepB, voffB); PG8_STAGE_A(PG8_SA(0, 0), cA, 0, false); PG8_STAGE_A(PG8_SA(0, 1), cA, 1, false);
        if (wr == 1) PG8_BAR;
        PG8_WAIT_V(2); PG8_BAR;
        PG8_STAGE(PG8_SB(1, 0), cB + kstep, voffB); PG8_STAGE_A(PG8_SA(1, 0), cA + kstep, 0, false); PG8_STAGE(PG8_SB(1, 1), cB + hstepB + kstep, voffB);
        PG8_WAIT_V(6); PG8_BAR;
    } else {
        PG8_STAGE(PG8_SB(0, 0), cB, voffB); PG8_STAGE(PG8_SA(0, 0), cA, voffA); PG8_STAGE(PG8_SB(0, 1), cB + hstepB, voffB); PG8_STAGE(PG8_SA(0, 1), cA + hstepA, voffA);
        if (wr == 1) PG8_BAR;
        PG8_WAIT_V(4); PG8_BAR;
        PG8_STAGE(PG8_SB(1, 0), cB + kstep, voffB); PG8_STAGE(PG8_SA(1, 0), cA + kstep, voffA); PG8_STAGE(PG8_SB(1, 1), cB + hstepB + kstep, voffB);
        PG8_WAIT_V(6); PG8_BAR;
    }
    for (;;) {
        const bool has_next = S.next(ui + 1, nxt);
        const char* nA = has_next ? (const char*)g.A + (GATHER ? (size_t)0 : (size_t)nxt.pm * tstepA) + (size_t)nxt.k0 * 2 : cA; const char* nB = has_next ? (const char*)g.Bt + (size_t)nxt.pn * tstepB + (size_t)nxt.k0 * 2 : cB;
        if constexpr (GATHER) { if (has_next) PG8_IDX_DMA(nxt, (ui + 1) & 1); }
        for (int t = 0; t < nt; t += 2) {
            const bool last = (t == nt - 2); const bool lnx = last && has_next;
            const char* a1 = cA + (size_t)(t + 1) * kstep;
            const char* a2 = last ? nA : cA + (size_t)(t + 2) * kstep; const char* b2 = last ? nB : cB + (size_t)(t + 2) * kstep;
            const char* a3 = a2 + kstep; const char* b3 = b2 + kstep;
            if (last && has_next) S.a_ready(nxt);
            if constexpr (GATHER) { if (lnx) PG8_IDX_READ(vAn, (ui + 1) & 1); }
            if constexpr (SP2) {
            PG8_LDB(B0, 0, 0); PG8_LDB(B1, 0, 1); PG8_SCHED; PG8_LDA(At, 0, 0); PG8_STAGE_A(PG8_SA(1, 1), a1, 1, false);
            PG8_WAIT_V(8); PG8_WAIT_L(0); PG8_BAR; PG8_MMA(0, 0, At, B0); PG8_MMA(0, 1, At, B1); PG8_BAR; PG8_SCHED;
            PG8_LDA(At, 0, 1); PG8_STAGE(PG8_SB(0, 0), b2, voffB); PG8_STAGE(PG8_SB(0, 1), b2 + hstepB, voffB); PG8_STAGE_A(PG8_SA(0, 0), a2, 0, lnx);
            PG8_WAIT_V(8); PG8_WAIT_L(0); PG8_BAR; PG8_MMA(1, 0, At, B0); PG8_MMA(1, 1, At, B1); PG8_BAR; PG8_SCHED;
            PG8_LDB(B0, 1, 0); PG8_LDB(B1, 1, 1); PG8_SCHED; PG8_LDA(At, 1, 0); PG8_STAGE_A(PG8_SA(0, 1), a2, 1, lnx);
            PG8_WAIT_V(8); PG8_WAIT_L(0); PG8_BAR; PG8_MMA(0, 0, At, B0); PG8_MMA(0, 1, At, B1); PG8_BAR; PG8_SCHED;
            PG8_LDA(At, 1, 1); PG8_STAGE(PG8_SB(1, 0), b3, voffB); PG8_STAGE(PG8_SB(1, 1), b3 + hstepB, voffB); PG8_STAGE_A(PG8_SA(1, 0), a3, 0, lnx);
            PG8_WAIT_V(8); PG8_WAIT_L(0); PG8_BAR; PG8_MMA(1, 0, At, B0); PG8_MMA(1, 1, At, B1); PG8_BAR; PG8_SCHED;
            } else {
            PG8_LDB(B0, 0, 0); PG8_SCHED; PG8_LDA(At, 0, 0); PG8_STAGE(PG8_SA(1, 1), a1 + hstepA, voffA);
            PG8_WAIT_L(8); PG8_BAR; PG8_WAIT_L(0); PG8_MMA(0, 0, At, B0); PG8_BAR; PG8_SCHED;
            PG8_LDB(B1, 0, 1); PG8_STAGE(PG8_SB(0, 0), b2, voffB);
            PG8_BAR; PG8_WAIT_L(0); PG8_MMA(0, 1, At, B1); PG8_BAR;
            PG8_LDA(At, 0, 1); PG8_STAGE(PG8_SA(0, 0), a2, voffA);
            PG8_BAR; PG8_WAIT_L(0); PG8_MMA(1, 0, At, B0); PG8_BAR; PG8_SCHED;
            PG8_STAGE(PG8_SB(0, 1), b2 + hstepB, voffB);
            PG8_WAIT_V(6); PG8_BAR; PG8_MMA(1, 1, At, B1); PG8_BAR;
            PG8_LDB(B0, 1, 0); PG8_SCHED; PG8_LDA(At, 1, 0); PG8_STAGE(PG8_SA(0, 1), a2 + hstepA, voffA);
            PG8_WAIT_L(8); PG8_BAR; PG8_WAIT_L(0); PG8_MMA(0, 0, At, B0); PG8_BAR; PG8_SCHED;
            PG8_LDB(B1, 1, 1); PG8_STAGE(PG8_SB(1, 0), b3, voffB);
            PG8_BAR; PG8_WAIT_L(0); PG8_MMA(0, 1, At, B1); PG8_BAR;
            PG8_LDA(At, 1, 1); PG8_STAGE(PG8_SA(1, 0), a3, voffA);
            PG8_BAR; PG8_WAIT_L(0); PG8_MMA(1, 0, At, B0); PG8_BAR; PG8_SCHED;
            PG8_STAGE(PG8_SB(1, 1), b3 + hstepB, voffB);
            PG8_WAIT_V(6); PG8_BAR; PG8_MMA(1, 1, At, B1); PG8_BAR;
            }
        }
        if constexpr (ALIGN_EPI) { if (wr == 0) PG8_BAR; }
        if constexpr (!Epi::AFTER_DRAIN) { int t2_ = threadIdx.x; asm volatile("" : "+v"(t2_)); const int fr2_ = t2_ & 15, fq2_ = (t2_ >> 4) & 3;
            E(acc, cur, wr, wc, fr2_, fq2_); S.done(cur); }
        if (!has_next) break;
#pragma unroll
        for (int a = 0; a < 2; ++a)
#pragma unroll
            for (int b = 0; b < 2; ++b)
#pragma unroll
                for (int m = 0; m < 4; ++m)
#pragma unroll
                    for (int n = 0; n < 2; ++n) acc[a][b][m][n] = (f32x4){zf_, zf_, zf_, zf_};
        cur = nxt; cA = nA; cB = nB; ++ui;
        if constexpr (GATHER) { vAc[0][0] = vAn[0][0]; vAc[0][1] = vAn[0][1]; vAc[1][0] = vAn[1][0]; vAc[1][1] = vAn[1][1]; }
        if constexpr (ALIGN_EPI) { if (wr == 1) PG8_BAR; }
    }
    PG8_WAIT_V(0);
    if constexpr (!ALIGN_EPI) { if (wr == 0) PG8_BAR; }
    PG8_BAR;
    if constexpr (Epi::AFTER_DRAIN) { E.fused(acc, cur, wr, wc, fr, fq, lds, wid, lane); S.done(cur); }
#undef PG8_SA
#undef PG8_SB
#undef PG8_STAGE
#undef PG8_STAGE_A
#undef PG8_IDX_DMA
#undef PG8_IDX_READ
#undef PG8_LDA
#undef PG8_LDB
#undef PG8_MMA
#undef PG8_WAIT_V
#undef PG8_WAIT_L
#undef PG8_BAR
#undef PG8_SCHED
}
}

typedef unsigned short bf16_t;
typedef short bf16x8 __attribute__((ext_vector_type(8)));
typedef short s16x4 __attribute__((ext_vector_type(4)));
typedef float f32x4 __attribute__((ext_vector_type(4)));
typedef float f32x16 __attribute__((ext_vector_type(16)));
typedef unsigned u32x4 __attribute__((ext_vector_type(4)));
typedef unsigned u32x2 __attribute__((ext_vector_type(2)));
#define LAS __attribute__((address_space(3)))
#define GAS __attribute__((address_space(1)))

constexpr int D = 1024, NB = 8, SEQ = 4096, NMETA = 16;
constexpr int RREAL = NB * SEQ;
constexpr int RVALID = RREAL + NMETA;
constexpr int NPAN = 129, RP = NPAN * 256;
constexpr int PMW = 1024, PRW = 1792;
constexpr int CW = 512;
constexpr int FF0 = 2816, FFE = 3584, NEXP = 8;
constexpr float RMS_EPS = 1e-6f, GN_EPS = 64e-5f;
constexpr int MOE_MAXPAN = 144;
constexpr int MOE_TAILPAN = 128, MOE_GAP = 8;
#ifndef MOE_CSKIP
#define MOE_CSKIP 5
#endif

typedef float f32x2_t __attribute__((ext_vector_type(2))); typedef __bf16 bf16x2_t __attribute__((ext_vector_type(2)));
__device__ __forceinline__ unsigned cvtpk(float lo, float hi) { f32x2_t v = {lo, hi}; bf16x2_t b = __builtin_convertvector(v, bf16x2_t); return __builtin_bit_cast(unsigned, b); }
__device__ __forceinline__ bf16_t f2bf_hw(float x) { return (bf16_t)(cvtpk(x, x) & 0xffffu); }
__device__ __forceinline__ float bf2f(bf16_t b) { return __uint_as_float(((unsigned)b) << 16); }
__device__ __forceinline__ bf16_t f2bf(float f) { unsigned u = __float_as_uint(f); u += 0x7fffu + ((u >> 16) & 1u); return (bf16_t)(u >> 16); }
__device__ __forceinline__ unsigned pk2(float lo, float hi) { return (unsigned)f2bf(lo) | ((unsigned)f2bf(hi) << 16); }
#define DPP_F(v_, ctrl_, rmask_) __int_as_float(__builtin_amdgcn_update_dpp(0, __float_as_int(v_), (ctrl_), (rmask_), 0xf, false))
__device__ __forceinline__ float wave_sum(float v) {
    v += DPP_F(v, 0xB1, 0xf); v += DPP_F(v, 0x4E, 0xf); v += DPP_F(v, 0x141, 0xf); v += DPP_F(v, 0x140, 0xf);
    v += DPP_F(v, 0x142, 0xa); v += DPP_F(v, 0x143, 0xc);
    return __int_as_float(__builtin_amdgcn_readlane(__float_as_int(v), 63));
}
__device__ __forceinline__ float wave_max(float v) {
    v = fmaxf(v, DPP_F(v, 0xB1, 0xf)); v = fmaxf(v, DPP_F(v, 0x4E, 0xf)); v = fmaxf(v, DPP_F(v, 0x141, 0xf)); v = fmaxf(v, DPP_F(v, 0x140, 0xf));
    v = fmaxf(v, DPP_F(v, 0x142, 0xa)); v = fmaxf(v, DPP_F(v, 0x143, 0xc));
    return __int_as_float(__builtin_amdgcn_readlane(__float_as_int(v), 63));
}
constexpr float F8_MAX = 448.0f, F8_ACT = 8.0f;
__device__ __forceinline__ unsigned pk4_f8(float a, float b, float c, float d) {
    float mx = F8_MAX; asm volatile("" : "+v"(mx));
    a = __builtin_amdgcn_fmed3f(a, -mx, mx); b = __builtin_amdgcn_fmed3f(b, -mx, mx); c = __builtin_amdgcn_fmed3f(c, -mx, mx); d = __builtin_amdgcn_fmed3f(d, -mx, mx);
    int r = __builtin_amdgcn_cvt_pk_fp8_f32(a, b, 0, false); r = __builtin_amdgcn_cvt_pk_fp8_f32(c, d, r, true); return (unsigned)r; }
__device__ __forceinline__ float moe_wscale(const unsigned* ctl, int t, int e);
__device__ __forceinline__ float quad_sum(float v) { v += DPP_F(v, 0xB1, 0xf); v += DPP_F(v, 0x4E, 0xf); return v; }
__device__ __forceinline__ float sigmoidf_(float x) { return 1.0f / (1.0f + __expf(-x)); }
__device__ __forceinline__ int row_pos(int row) { return row < RREAL ? NMETA + (row & (SEQ - 1)) : row - RREAL; }
__device__ __forceinline__ int row_prev(int row) { if (row < RREAL) return (row & (SEQ - 1)) ? row - 1 : RVALID - 1; return row == RREAL ? -1 : row - 1; }

constexpr size_t MiB = 1u << 20;
constexpr size_t WS_CTL = 0;
constexpr size_t WS_HMETA = 1 * MiB;
constexpr size_t WS_WB = 2 * MiB;
constexpr size_t LW_STRIDE = 10 * MiB;
constexpr size_t LW_WIN = 0, LW_WUQ = LW_WIN + (size_t)2816 * 1024 * 2, LW_WK = LW_WUQ + (size_t)768 * 512 * 2, LW_WV = LW_WK + (size_t)512 * 256 * 2,
                 LW_LORA = LW_WV + (size_t)512 * 256 * 2, LW_WOUT = LW_LORA + (size_t)1536 * 256 * 2, LW_END = LW_WOUT + (size_t)1024 * 1024 * 2;
static_assert(LW_END <= LW_STRIDE, "layer weights");
constexpr size_t WS_V1T = WS_WB + 2 * LW_STRIDE, WS_V2T = WS_V1T + (size_t)256 * 512 * 2, WS_FGU = WS_V2T + (size_t)512 * 256 * 2,
                 WS_FDN = WS_FGU + (size_t)5632 * 1024 * 2, WS_ROPE = WS_FDN + (size_t)1024 * 2816 * 2, WS_WB_END = WS_ROPE + (size_t)4112 * 64 * 4;
constexpr size_t WS_TB = WS_FGU;
constexpr size_t WS_ARENA = 41 * MiB;
static_assert(WS_WB_END <= WS_ARENA, "weights fit");
static_assert((size_t)8 * 256 * 1024 * 4 <= (size_t)5632 * 1024 * 2, "list-1 tail buffer fits the dense gate/up weight slot");
constexpr size_t SZ_R1024 = (size_t)RP * 1024 * 2, SZ_R512 = (size_t)RP * 512 * 2, SZ_R256 = (size_t)RP * 256 * 2;
constexpr size_t A_U = WS_ARENA;
constexpr size_t A_KN = A_U + SZ_R1024;
constexpr size_t A_VT = A_KN + SZ_R512;
constexpr size_t A_LOUT = A_U, A_VMIX = A_VT;
static_assert((size_t)RP * 1536 * 2 == SZ_R1024 + SZ_R512, "LORA_OUT fills the U and KN slots exactly");
constexpr size_t A_PM = A_VT + SZ_R512;
constexpr size_t A_PR = A_PM + SZ_R1024;
constexpr size_t A_SMALL = A_PR + (size_t)RP * PRW * 2;
constexpr size_t A_RSTDQ = A_SMALL, A_RSTDKV = A_RSTDQ + (size_t)RP * 4, A_KROPE = A_RSTDKV + (size_t)RP * 4, A_SMALL_END = A_KROPE + (size_t)RP * 64 * 2;
constexpr size_t A_LIN = (A_SMALL_END + 4095) & ~(size_t)4095;
constexpr size_t A_VSH = A_LIN + SZ_R256;
constexpr size_t A_CHK = A_LIN;
constexpr size_t SZ_CHK = (size_t)258 * 8 * 32768;
constexpr size_t A_VFIRST = (A_CHK + SZ_CHK > A_VSH + SZ_R512 ? A_CHK + SZ_CHK : A_VSH + SZ_R512);
constexpr size_t A_VP = A_VFIRST + SZ_R512;
constexpr size_t A_RK = A_VP + SZ_R512;
constexpr size_t A_YS = A_RK + (size_t)RP * 8 * 4;
constexpr size_t A_SCST = A_YS + SZ_R512;
constexpr size_t A_PART = A_SCST + (size_t)64 * 4096 * 4;
constexpr size_t A_END1 = A_PART + (size_t)11 * NMETA * 1024 * 4;
constexpr size_t A_ACT0 = A_PM;
constexpr size_t A_MGU = A_KN;
constexpr size_t A_MDN = A_MGU + (size_t)NEXP * 7168 * 1024 * 2;
constexpr size_t A_MTAB = A_MDN + (size_t)NEXP * 1024 * 3584 * 2;
constexpr size_t MT_E = 0, MT_G = MT_E + (size_t)2 * RREAL * 4, MT_STOK = MT_G + (size_t)2 * RREAL * 4, MT_TSLOT = MT_STOK + (size_t)2 * MOE_MAXPAN * 256 * 4  , MT_SGATE = MT_TSLOT + (size_t)RREAL * 4,
                 MT_BE = MT_SGATE + (size_t)2 * MOE_MAXPAN * 256 * 4, MT_END = MT_BE + 2 * 256 * 4;
constexpr size_t A_MACT = (A_MTAB + MT_END + 4095) & ~(size_t)4095;
constexpr size_t XB_LIST = (size_t)MOE_MAXPAN * 256 * 1024;
constexpr size_t A_XB = A_MACT + (size_t)MOE_MAXPAN * 256 * FFE;
static_assert(A_XB + 2 * XB_LIST <= A_MACT + (size_t)MOE_MAXPAN * 256 * FFE * 2, "XB inside the old activation footprint");
constexpr size_t A_END2 = A_MACT + (size_t)MOE_MAXPAN * 256 * FFE * 2;
constexpr size_t WS_NEED = (A_END1 > A_END2 ? A_END1 : A_END2);
static_assert(WS_NEED <= 557619232ull, "workspace budget (sum of the inputs' bytes)");
static_assert(A_ACT0 + (size_t)RP * FF0 * 2 <= A_SMALL, "dense act overlay");
constexpr int CW_CNT = 64;
constexpr int CW_FILL = 128;
constexpr int CW_NPAN = 192;
constexpr int CW_WINV = 16448;
constexpr int CW_WMAX = 16384;
constexpr int CW_WGCNT = 8192;


__device__ __forceinline__ unsigned long long kp_uniform(unsigned long long kp) { const unsigned lo = __builtin_amdgcn_readfirstlane((unsigned)kp), hi = __builtin_amdgcn_readfirstlane((unsigned)(kp >> 32)); return ((unsigned long long)hi << 32) | lo; }
__device__ __forceinline__ const void* ldk(unsigned long long kp, int off) { unsigned long long v;
    asm volatile("s_load_dwordx2 %0, %1, %2\n\ts_waitcnt lgkmcnt(0)" : "=s"(v) : "s"(kp), "i"(off) : "memory"); return (const void*)v; }
__device__ __forceinline__ int opq(int v) { asm volatile("" : "+v"(v)); return v; }
__device__ __forceinline__ int opqs(int v) { asm volatile("" : "+s"(v)); return v; }
__device__ __forceinline__ void lds_barrier() { asm volatile("s_waitcnt lgkmcnt(0)\n\ts_barrier" ::: "memory"); }

__device__ __forceinline__ float moe_wscale_bits(unsigned bits) { const float m = __uint_as_float(bits);
    return m > 0.f ? __builtin_amdgcn_exp2f(floorf(__builtin_amdgcn_logf(224.0f / m))) : 1.0f; }
__device__ __forceinline__ float moe_wscale(const unsigned* ctl, int t, int e) { return moe_wscale_bits((unsigned)__builtin_amdgcn_readfirstlane((int)ctl[CW_WMAX + t * 8 + e])); }
#define XB_TMO      128
#define XB_XCNT(j)  (256  + 64 * (j))
#define XB_XSUB(j)  (1280 + 64 * (j))
#define XB_XGEN(j)  (2304 + 64 * (j))
#define XB_TOP      3328
#define XB_TOPGEN   3392
#define XCD_BAR_WORDS 3456
#define XB_SPIN_CAP (1u << 18)

__device__ __forceinline__ unsigned xb_ld(unsigned* p)              { return __hip_atomic_load(p, __ATOMIC_RELAXED, __HIP_MEMORY_SCOPE_AGENT); }
__device__ __forceinline__ unsigned xb_add(unsigned* p, unsigned v) { return __hip_atomic_fetch_add(p, v, __ATOMIC_RELAXED, __HIP_MEMORY_SCOPE_AGENT); }
__device__ __forceinline__ unsigned xb_xcc_id() { return (unsigned)__builtin_amdgcn_s_getreg((3 << 11) | 20) & 0xFu; }
#define XB_SPIN(cond, bar) do { unsigned _sp = 0; while (cond) { __builtin_amdgcn_s_sleep(1); \
    if ((++_sp & 255u) == 0u) { if (xb_ld(&(bar)[XB_TMO])) break; if (_sp > XB_SPIN_CAP) { atomicAdd(&(bar)[XB_TMO], 1u); break; } } } } while (0)

struct XcdBarrier {
    unsigned* bar; unsigned x;
    volatile LAS unsigned* st;
};

__device__ __forceinline__ XcdBarrier xcd_barrier_post(unsigned* bar, volatile LAS unsigned* st) {
    XcdBarrier b; b.bar = bar; b.x = xb_xcc_id(); b.st = st;
    if (threadIdx.x == 0) (void)xb_add(&bar[XB_XCNT(b.x)], 1u);
    return b;
}
__device__ __forceinline__ void xcd_barrier_complete(unsigned* bar, unsigned x, unsigned& nloc, unsigned& nx) {
    const unsigned G = gridDim.x * gridDim.y * gridDim.z;
    unsigned sum, cnt, mine, sp = 0u;
    for (;;) {
        sum = 0u; cnt = 0u; mine = 0u;
#pragma unroll
        for (unsigned j = 0; j < 16; ++j) { const unsigned c = xb_ld(&bar[XB_XCNT(j)]); sum += c; cnt += (c > 0u) ? 1u : 0u; mine = (j == x) ? c : mine; }
        if (sum == G) break;
        __builtin_amdgcn_s_sleep(1);
        if ((++sp & 255u) == 0u) { if (xb_ld(&bar[XB_TMO])) break; if (sp > XB_SPIN_CAP) { atomicAdd(&bar[XB_TMO], 1u); break; } }
    }
    nloc = mine > 0u ? mine : 1u; nx = cnt > 0u ? cnt : 1u;
}

__device__ __attribute__((noinline)) void xcd_barrier_fn(unsigned* bar_, unsigned x_, volatile LAS unsigned* st_) {
    XcdBarrier b; b.bar = bar_; b.x = x_; b.st = st_;
    asm volatile("s_waitcnt vmcnt(0)" ::: "memory");
    __syncthreads();
    if (threadIdx.x == 0) {
        unsigned* bar = b.bar;
        __builtin_amdgcn_s_waitcnt(0);
        unsigned nloc = b.st[0], nx = b.st[1];
        if (nloc == 0u) { xcd_barrier_complete(bar, b.x, nloc, nx); b.st[0] = nloc; b.st[1] = nx; }
        const unsigned old = xb_add(&bar[XB_XSUB(b.x)], 1u);
        const unsigned gen = old / nloc;
        if (old + 1u == (gen + 1u) * nloc) {
            __builtin_amdgcn_fence(__ATOMIC_RELEASE, "agent");
            asm volatile("s_waitcnt vmcnt(0)" ::: "memory");
            const unsigned og = xb_add(&bar[XB_TOP], 1u);
            const unsigned tg = og / nx;
            if (og + 1u == (tg + 1u) * nx) xb_add(&bar[XB_TOPGEN], 1u);
            else XB_SPIN(xb_ld(&bar[XB_TOPGEN]) == tg, bar);
            __builtin_amdgcn_fence(__ATOMIC_ACQUIRE, "agent");
            xb_add(&bar[XB_XGEN(b.x)], 1u);
            asm volatile("s_waitcnt vmcnt(0)" ::: "memory");
        } else {
            XB_SPIN(xb_ld(&bar[XB_XGEN(b.x)]) == gen, bar);
            __builtin_amdgcn_fence(__ATOMIC_ACQUIRE, "agent");
            asm volatile("s_waitcnt vmcnt(0)" ::: "memory");
        }
    }
    __syncthreads();
}

__device__ __forceinline__ void xcd_barrier(const XcdBarrier& b) { xcd_barrier_fn(b.bar, b.x, b.st); }
using pg8::Unit;
struct EpiInProj { static constexpr bool PERM = true, AFTER_DRAIN = false; bf16_t* PM; bf16_t* PR;
    __device__ __forceinline__ void operator()(const f32x4 (&acc)[2][2][4][2], const Unit& u, int wr, int wc, int fr, int fq) const {
        const int row0 = u.pm * 256 + wr * 64 + fr; bf16_t* base; int ld, colt;
        if (u.pn < 4) { base = PM; ld = PMW; colt = u.pn * 256; } else { base = PR; ld = PRW; colt = (u.pn - 4) * 256; }
        const int col0 = colt + wc * 32 + 8 * fq;
#pragma unroll
        for (int ai = 0; ai < 2; ++ai)
#pragma unroll
            for (int m = 0; m < 4; ++m) { bf16_t* rowp = base + (size_t)(row0 + ai * 128 + m * 16) * ld + col0;
#pragma unroll
                for (int bj = 0; bj < 2; ++bj) { const f32x4 v0 = acc[ai][bj][m][0], v1 = acc[ai][bj][m][1];
                    u32x4 w; w.x = pg8::cvt_pk_bf16(v0[0], v0[1]); w.y = pg8::cvt_pk_bf16(v0[2], v0[3]); w.z = pg8::cvt_pk_bf16(v1[0], v1[1]); w.w = pg8::cvt_pk_bf16(v1[2], v1[3]);
                    *(u32x4*)(rowp + bj * 128) = w; } }
    }
};
struct EpiRowScale { static constexpr bool PERM = true, AFTER_DRAIN = false; bf16_t* O; const float* rs; int ldc, pad;
    __device__ __forceinline__ void operator()(const f32x4 (&acc)[2][2][4][2], const Unit& u, int wr, int wc, int fr, int fq) const {
        const int row0 = u.pm * 256 + wr * 64 + fr; const int col0 = u.pn * 256 + wc * 32 + 8 * fq;
#pragma unroll
        for (int ai = 0; ai < 2; ++ai)
#pragma unroll
            for (int m = 0; m < 4; ++m) { const int row = row0 + ai * 128 + m * 16; const float s = rs ? rs[row] : 1.f; bf16_t* rowp = O + (size_t)row * ldc + col0;
#pragma unroll
                for (int bj = 0; bj < 2; ++bj) { const f32x4 v0 = acc[ai][bj][m][0] * s, v1 = acc[ai][bj][m][1] * s;
                    u32x4 w; w.x = pg8::cvt_pk_bf16(v0[0], v0[1]); w.y = pg8::cvt_pk_bf16(v0[2], v0[3]); w.z = pg8::cvt_pk_bf16(v1[0], v1[1]); w.w = pg8::cvt_pk_bf16(v1[2], v1[3]);
                    *(u32x4*)(rowp + bj * 128) = w; } }
    }
};
struct EpiColScale { static constexpr bool PERM = true, AFTER_DRAIN = false; bf16_t* O; const float* cs; int ldc, pad;
    __device__ __forceinline__ void operator()(const f32x4 (&acc)[2][2][4][2], const Unit& u, int wr, int wc, int fr, int fq) const {
        const int row0 = u.pm * 256 + wr * 64 + fr; const int col0 = u.pn * 256 + wc * 32 + 8 * fq;
        f32x4 sc[2][2];
#pragma unroll
        for (int bj = 0; bj < 2; ++bj) { sc[bj][0] = *(const f32x4*)(cs + col0 + bj * 128); sc[bj][1] = *(const f32x4*)(cs + col0 + bj * 128 + 4); }
#pragma unroll
        for (int ai = 0; ai < 2; ++ai)
#pragma unroll
            for (int m = 0; m < 4; ++m) { bf16_t* rowp = O + (size_t)(row0 + ai * 128 + m * 16) * ldc + col0;
#pragma unroll
                for (int bj = 0; bj < 2; ++bj) { const f32x4 v0 = acc[ai][bj][m][0] * sc[bj][0], v1 = acc[ai][bj][m][1] * sc[bj][1];
                    u32x4 w; w.x = pg8::cvt_pk_bf16(v0[0], v0[1]); w.y = pg8::cvt_pk_bf16(v0[2], v0[3]); w.z = pg8::cvt_pk_bf16(v1[0], v1[1]); w.w = pg8::cvt_pk_bf16(v1[2], v1[3]);
                    *(u32x4*)(rowp + bj * 128) = w; } }
    }
};
struct EpiResid { static constexpr bool PERM = false, AFTER_DRAIN = false; float* out; float* hmeta; const float* src; float scale; int pad;
    __device__ __forceinline__ void operator()(const f32x4 (&acc)[2][2][4][2], const Unit& u, int wr, int wc, int fr, int fq) const {
        const int rl = wr * 64 + fr, col0 = u.pn * 256 + wc * 32 + 4 * fq;
        float* base = u.pm < 128 ? out + (size_t)u.pm * 256 * D : hmeta; const float* sbase = u.pm < 128 ? src + (size_t)u.pm * 256 * D : hmeta;
        f32x4 hv[2][4];
#pragma unroll
        for (int bj = 0; bj < 2; ++bj)
#pragma unroll
            for (int n = 0; n < 2; ++n) hv[0][bj * 2 + n] = *(const f32x4*)(sbase + (size_t)rl * D + col0 + bj * 128 + n * 16);
#pragma unroll
        for (int g = 0; g < 8; ++g) { const size_t ro = (size_t)(rl + (g >> 2) * 128 + (g & 3) * 16) * D + col0;
            if (g + 1 < 8) { const size_t rn = (size_t)(rl + ((g + 1) >> 2) * 128 + ((g + 1) & 3) * 16) * D + col0;
#pragma unroll
                for (int bj = 0; bj < 2; ++bj)
#pragma unroll
                    for (int n = 0; n < 2; ++n) hv[(g + 1) & 1][bj * 2 + n] = *(const f32x4*)(sbase + rn + bj * 128 + n * 16); }
#pragma unroll
            for (int bj = 0; bj < 2; ++bj)
#pragma unroll
                for (int n = 0; n < 2; ++n) *(f32x4*)(base + ro + bj * 128 + n * 16) = hv[g & 1][bj * 2 + n] + acc[g >> 2][bj][g & 3][n] * scale;
            asm volatile("" ::: "memory"); }
    }
};
struct EpiSwiGLU { static constexpr bool PERM = true, AFTER_DRAIN = false; bf16_t* O; int ldc, nmod, pn_off, pad;
    __device__ __forceinline__ void operator()(const f32x4 (&acc)[2][2][4][2], const Unit& u, int wr, int wc, int fr, int fq) const {
        const int row0 = u.pm * 256 + wr * 64 + fr; const int pnl = (u.pn % nmod) - pn_off; const int col0 = pnl * 128 + wc * 32 + 8 * fq;
#pragma unroll
        for (int ai = 0; ai < 2; ++ai)
#pragma unroll
            for (int m = 0; m < 4; ++m) { bf16_t* rowp = O + (size_t)(row0 + ai * 128 + m * 16) * ldc + col0; float r[8];
#pragma unroll
                for (int n = 0; n < 2; ++n)
#pragma unroll
                    for (int j = 0; j < 4; ++j) { const float g = acc[ai][0][m][n][j], up = acc[ai][1][m][n][j]; r[4 * n + j] = g / (1.0f + __expf(-g)) * up; }
                u32x4 w; w.x = pg8::cvt_pk_bf16(r[0], r[1]); w.y = pg8::cvt_pk_bf16(r[2], r[3]); w.z = pg8::cvt_pk_bf16(r[4], r[5]); w.w = pg8::cvt_pk_bf16(r[6], r[7]);
                *(u32x4*)rowp = w; }
    }
};
struct EpiSwiGLU8 { static constexpr bool PERM = false, AFTER_DRAIN = false; unsigned char* O; const unsigned* ctl; int ldc, nmod;
    __device__ __forceinline__ void operator()(const f32x4 (&acc)[2][2][4][2], const Unit& u, int wr, int wc, int fr, int fq) const {
        const int row0 = u.pm * 256 + wr * 64 + fr; const int e = u.pn / nmod, pnl = u.pn % nmod; const int col0 = pnl * 128 + wc * 32 + 4 * fq;
        const float ig = __uint_as_float(__builtin_amdgcn_readfirstlane((int)ctl[CW_WINV + e])), iu = __uint_as_float(__builtin_amdgcn_readfirstlane((int)ctl[CW_WINV + 8 + e])) * F8_ACT;
#pragma unroll
        for (int ai = 0; ai < 2; ++ai)
#pragma unroll
            for (int m = 0; m < 4; ++m) { unsigned char* rowp = O + (size_t)(row0 + ai * 128 + m * 16) * ldc + col0;
#pragma unroll
                for (int n = 0; n < 2; ++n) { float r[4];
#pragma unroll
                    for (int j = 0; j < 4; ++j) { const float g = acc[ai][0][m][n][j] * ig, up = acc[ai][1][m][n][j] * iu; r[j] = g / (1.0f + __expf(-g)) * up; }
                    *(unsigned*)(rowp + n * 16) = pk4_f8(r[0], r[1], r[2], r[3]); } }
    }
};
struct EpiMoeDown { static constexpr bool PERM = false, AFTER_DRAIN = false; float* out; const int* stok; const float* sgate; int nmod; float scale; const unsigned* ctl;
    __device__ __forceinline__ void operator()(const f32x4 (&acc)[2][2][4][2], const Unit& u, int wr, int wc, int fr, int fq) const {
        const int row0 = u.pm * 256 + wr * 64 + fr; const int col0 = (u.pn % nmod) * 256 + wc * 32 + 4 * fq;
        const float winv = ctl ? __uint_as_float(__builtin_amdgcn_readfirstlane((int)ctl[CW_WINV + 16 + u.pn / nmod])) : 1.0f;
        int tok[8]; float gt[8];
#pragma unroll
        for (int g = 0; g < 8; ++g) { const int prow = row0 + (g >> 2) * 128 + (g & 3) * 16; tok[g] = stok[prow]; gt[g] = sgate[prow] * scale * winv; }
        f32x4 hv[2][4];
        { const float* rp0 = out + (size_t)(tok[0] < 0 ? 0 : tok[0]) * D + col0;
#pragma unroll
          for (int bj = 0; bj < 2; ++bj)
#pragma unroll
              for (int n = 0; n < 2; ++n) hv[0][bj * 2 + n] = *(const f32x4*)(rp0 + bj * 128 + n * 16); }
#pragma unroll
        for (int g = 0; g < 8; ++g) {
            if (g + 1 < 8) { const float* rpn = out + (size_t)(tok[g + 1] < 0 ? 0 : tok[g + 1]) * D + col0;
#pragma unroll
                for (int bj = 0; bj < 2; ++bj)
#pragma unroll
                    for (int n = 0; n < 2; ++n) hv[(g + 1) & 1][bj * 2 + n] = *(const f32x4*)(rpn + bj * 128 + n * 16); }
            if (tok[g] >= 0) { float* rowp = out + (size_t)tok[g] * D + col0;
#pragma unroll
                for (int bj = 0; bj < 2; ++bj)
#pragma unroll
                    for (int n = 0; n < 2; ++n) *(f32x4*)(rowp + bj * 128 + n * 16) = hv[g & 1][bj * 2 + n] + acc[g >> 2][bj][g & 3][n] * gt[g]; }
            asm volatile("" ::: "memory"); }
    }
};
struct EpiMoeDownStore { static constexpr bool PERM = false, AFTER_DRAIN = false; float* tb; const int* stok; const float* sgate; int nmod, pm0; const unsigned* ctl;
    __device__ __forceinline__ void operator()(const f32x4 (&acc)[2][2][4][2], const Unit& u, int wr, int wc, int fr, int fq) const {
        const int row0 = u.pm * 256 + wr * 64 + fr; const int col0 = (u.pn % nmod) * 256 + wc * 32 + 4 * fq;
#pragma unroll
        for (int ai = 0; ai < 2; ++ai)
#pragma unroll
            for (int m = 0; m < 4; ++m) { const int prow = row0 + ai * 128 + m * 16; const int tok = stok[prow]; if (tok < 0) continue; const float gt = sgate[prow] * __uint_as_float(__builtin_amdgcn_readfirstlane((int)ctl[CW_WINV + 16 + u.pn / nmod]));
                float* rowp = tb + (size_t)(prow - pm0 * 256) * D + col0;
#pragma unroll
                for (int bj = 0; bj < 2; ++bj)
#pragma unroll
                    for (int n = 0; n < 2; ++n) *(f32x4*)(rowp + bj * 128 + n * 16) = acc[ai][bj][m][n] * gt; }
    }
};
struct MoeOrder { static constexpr bool GATHER = false; const int* block_e; const unsigned* npan; int nN, emul, pn_off, G, c, lmax;
    __device__ __forceinline__ bool next(int i, Unit& u) const { const int L = i * G + c; const int np = __builtin_amdgcn_readfirstlane((int)(*npan)); if (L >= np * nN || (lmax && L >= lmax)) return false;
        const int pm = L / nN; u.k0 = 0; u.pm = pm; u.pn = __builtin_amdgcn_readfirstlane(block_e[pm]) * emul + pn_off + (L % nN); return true; }
    __device__ __forceinline__ void a_ready(const Unit&) const {}
    __device__ __forceinline__ void done(const Unit&) const {}
};


struct EpiResidPartial { static constexpr bool PERM = false, AFTER_DRAIN = false; float* part;
    __device__ __forceinline__ void operator()(const f32x4 (&acc)[2][2][4][2], const Unit& u, int wr, int wc, int fr, int fq) const {
        const int rl = wr * 64 + fr, col0 = u.pn * 256 + wc * 32 + 4 * fq; float* base = part + (size_t)(u.k0 >> 8) * NMETA * D;
#pragma unroll
        for (int ai = 0; ai < 2; ++ai)
#pragma unroll
            for (int m = 0; m < 4; ++m) { const int row = rl + ai * 128 + m * 16; if (row >= NMETA) continue;
                float* rowp = base + (size_t)row * D + col0;
#pragma unroll
                for (int bj = 0; bj < 2; ++bj)
#pragma unroll
                    for (int n = 0; n < 2; ++n) *(f32x4*)(rowp + bj * 128 + n * 16) = acc[ai][bj][m][n]; }
    }
};
struct DenseTailOrder { static constexpr bool GATHER = false; int nN, nsl, G, c;
    __device__ __forceinline__ bool next(int i, Unit& u) const { const int idx = i * G + c; if (idx >= nN * nsl) return false; u.pm = 128; u.pn = idx / nsl; u.k0 = (idx % nsl) * 256; return true; }
    __device__ __forceinline__ void a_ready(const Unit&) const {}
    __device__ __forceinline__ void done(const Unit&) const {}
};
template <bool GA> struct MoeGatherOrderT { static constexpr bool GATHER = GA;
    const int* block_e; const unsigned* npan; const int* rows; int nN, emul, pn_off, G, c, zero_row;
    int pm_lo, pm_hi, gap, rot, T, cskip;
    __device__ __forceinline__ bool next(int i, Unit& u) const {
        int cc = c - rot; cc += cc < 0 ? G : 0;
        int L;
        if (T == 0) { L = i * G + cc;
            int npx = __builtin_amdgcn_readfirstlane((int)(*npan)); npx = npx < pm_hi ? npx : pm_hi; const int nwg = (npx - pm_lo) * nN;
            if (L >= nwg) return false;
            const int q8 = nwg >> 3, r8 = nwg & 7, xcd = L & 7, off = L >> 3; L = (xcd < r8 ? xcd * (q8 + 1) : r8 * (q8 + 1) + (xcd - r8) * q8) + off; }
        else { const int W0 = G - T; if (cc < W0) L = i < cskip ? i * W0 + cc : cskip * W0 + (i - cskip) * G + cc; else L = cskip * W0 + i * G + cc; }
        int np = __builtin_amdgcn_readfirstlane((int)(*npan)); np = np < pm_hi ? np : pm_hi;
        const int pl = pm_lo + L / nN; if (pl >= np) return false;
        const int pm = pl + (pl >= MOE_TAILPAN ? gap : 0); u.k0 = 0; u.pm = pm; u.pn = __builtin_amdgcn_readfirstlane(block_e[pm]) * emul + pn_off + (L % nN); return true; }
    __device__ __forceinline__ void a_ready(const Unit&) const {}
    __device__ __forceinline__ void done(const Unit&) const {}
};
using MoeGatherOrder = MoeGatherOrderT<true>; using MoeSlotOrder = MoeGatherOrderT<false>;
struct MoeShiftTailOrder { static constexpr bool GATHER = false; const int* block_e; const unsigned* npan; int nN, emul, gap, wg_first, c, pad;
    __device__ __forceinline__ bool next(int i, Unit& u) const { const int t = wg_first - c; const int np = __builtin_amdgcn_readfirstlane((int)(*npan)); const int L = MOE_TAILPAN * nN + t;
        if (i > 0 || t < 0 || L >= np * nN) return false;
        const int pm = L / nN + gap; u.k0 = 0; u.pm = pm; u.pn = __builtin_amdgcn_readfirstlane(block_e[pm]) * emul + (L % nN); return true; }
    __device__ __forceinline__ void a_ready(const Unit&) const {}
    __device__ __forceinline__ void done(const Unit&) const {}
};

__device__ __forceinline__ int map_row(int mode, int n, int rowoff) {
    if (mode == 1) return n < 832 ? n : n + 192;
    if (mode == 2) return rowoff + (n >> 7) * 256 + (n & 127);
    if (mode == 3) return rowoff + (n >> 7) * 256 + 128 + (n & 127);
    if (mode == 4) return (n >> 8) * 128 + (n & 127) + ((n & 128) ? 512 : 0);
    return rowoff + n;
}
__device__ __forceinline__ void transpose_item(const float* __restrict__ W, int K, int N, bf16_t* __restrict__ dst, int ld, int koff, int mode, int rowoff, const float* __restrict__ gain, LAS float* scr, int item, int lane) {
    const int nblk = N / 32; const int kb = item / nblk, nb = item % nblk, k0 = 64 * kb, n0 = 32 * nb;
    float ld_[32];
#pragma unroll
    for (int i = 0; i < 32; ++i) ld_[i] = W[(size_t)(k0 + 2 * i + (lane >> 5)) * N + n0 + (lane & 31)];
#pragma unroll
    for (int i = 0; i < 32; ++i) { const int kk = 2 * i + (lane >> 5); float v = ld_[i]; if (gain) v *= gain[k0 + kk]; scr[kk * 33 + (lane & 31)] = v; }
    asm volatile("s_waitcnt lgkmcnt(0)" ::: "memory");
    const int c = lane & 7;
#pragma unroll
    for (int j = 0; j < 4; ++j) { const int n = (lane >> 3) + 8 * j; const LAS float* s = scr + (8 * c) * 33 + n;
        u32x4 o; o.x = pk2(s[0 * 33], s[1 * 33]); o.y = pk2(s[2 * 33], s[3 * 33]); o.z = pk2(s[4 * 33], s[5 * 33]); o.w = pk2(s[6 * 33], s[7 * 33]);
        *(u32x4*)(dst + (size_t)map_row(mode, n0 + n, rowoff) * ld + koff + k0 + 8 * c) = o; }
    asm volatile("s_waitcnt lgkmcnt(0)" ::: "memory");
}
__device__ __forceinline__ void transpose_item_f8(const float* __restrict__ W, int K, int N, unsigned char* __restrict__ dst, int ld, int mode, int rowoff, float scale, LAS float* scr, int item, int lane) {
    const int nblk = N / 32; const int kb = item / nblk, nb = item % nblk, k0 = 64 * kb, n0 = 32 * nb;
    float ld_[32];
#pragma unroll
    for (int i = 0; i < 32; ++i) ld_[i] = W[(size_t)(k0 + 2 * i + (lane >> 5)) * N + n0 + (lane & 31)];
#pragma unroll
    for (int i = 0; i < 32; ++i) { const int kk = 2 * i + (lane >> 5); scr[kk * 33 + (lane & 31)] = ld_[i] * scale; }
    asm volatile("s_waitcnt lgkmcnt(0)" ::: "memory");
    const int c = lane & 7;
#pragma unroll
    for (int j = 0; j < 4; ++j) { const int n = (lane >> 3) + 8 * j; const LAS float* s = scr + (8 * c) * 33 + n;
        u32x2 o; o.x = pk4_f8(s[0 * 33], s[1 * 33], s[2 * 33], s[3 * 33]); o.y = pk4_f8(s[4 * 33], s[5 * 33], s[6 * 33], s[7 * 33]);
        *(u32x2*)(dst + (size_t)map_row(mode, n0 + n, rowoff) * ld + k0 + 8 * c) = o; }
    asm volatile("s_waitcnt lgkmcnt(0)" ::: "memory");
}
struct TrJob8 { const float* W; unsigned char* dst; int K, N, ld, mode, rowoff; float scale; };
__device__ __forceinline__ void ph_transpose_f8(const TrJob8& J, LAS float* scr, int gw, int ngw, int lane, int rot = 0) {
    lane = opq(lane);
    const int nitems = (J.K / 64) * (J.N / 32);
    int it0 = gw - rot % ngw; it0 += it0 < 0 ? ngw : 0;
    for (int it = it0; it < nitems; it += ngw) transpose_item_f8(J.W, J.K, J.N, J.dst, J.ld, J.mode, J.rowoff, J.scale, scr, it, lane);
}
struct TrJob { const float* W; const float* gain; bf16_t* dst; int K, N, ld, koff, mode, rowoff; };
__device__ __forceinline__ void ph_transpose(const TrJob& J, LAS float* scr, int gw, int ngw, int lane, int rot = 0) {
    lane = opq(lane);
    const int nitems = (J.K / 64) * (J.N / 32);
    int it0 = gw - rot % ngw; it0 += it0 < 0 ? ngw : 0;
    for (int it = it0; it < nitems; it += ngw) transpose_item(J.W, J.K, J.N, J.dst, J.ld, J.koff, J.mode, J.rowoff, J.gain, scr, it, lane);
}
__device__ __forceinline__ const float* hrow_c(const float* out, const float* hmeta, int row) { return row < RREAL ? out + (size_t)row * D : hmeta + (size_t)(row - RREAL) * D; }
__device__ __forceinline__ void ph_init(const float* __restrict__ x, const float* __restrict__ meta, float* __restrict__ out, float* __restrict__ hmeta, float* __restrict__ rope,
                                        const float* __restrict__ v1, const float* __restrict__ v2, bf16_t* __restrict__ v12t, size_t gt, size_t ngt) {
    (void)x; (void)out;
    for (size_t i = gt; i < (size_t)256 * D; i += ngt) hmeta[i] = i < (size_t)NMETA * D ? meta[i] : 0.f;
    for (size_t i = gt; i < (size_t)4112 * 32; i += ngt) { const int pos = (int)(i / 32), j = (int)(i % 32);
        const float inv = powf(10000.0f, -(float)j / 32.0f); const float ang = (float)pos * inv; rope[2 * i] = cosf(ang); rope[2 * i + 1] = sinf(ang); }
    for (size_t i = gt; i < (size_t)512 * 512; i += ngt) { const int n = (int)(i >> 9), k = (int)(i & 511); float s = 0.f;
#pragma unroll 8
        for (int j = 0; j < 32; ++j) s += v1[k * 32 + j] * v2[j * 512 + n];
        v12t[i] = f2bf(s); }
}
__device__ __forceinline__ void ph_rmsnorm(const float* __restrict__ out, const float* hmeta, const float* __restrict__ g, bf16_t* __restrict__ U, const float* __restrict__ part, int nsl, int gw, int ngw, int lane) {
    lane = opq(lane);
    for (int row = gw; row < RP; row += ngw) {
        unsigned long long* o8 = (unsigned long long*)(U + (size_t)row * D) + lane;
        if (row >= RVALID) {
#pragma unroll
            for (int j = 0; j < 4; ++j) o8[64 * j] = 0ull;
            continue; }
        const f32x4* xr = (const f32x4*)hrow_c(out, hmeta, row) + lane; const f32x4* g4 = (const f32x4*)g + lane;
        f32x4 v[4]; float s = 0.f;
#pragma unroll
        for (int j = 0; j < 4; ++j) v[j] = xr[64 * j];
        if (row >= RREAL && nsl > 0) {
            for (int sl = 0; sl < nsl; ++sl) { const f32x4* pr = (const f32x4*)(part + ((size_t)sl * NMETA + (row - RREAL)) * D) + lane;
#pragma unroll
                for (int j = 0; j < 4; ++j) v[j] = v[j] + pr[64 * j]; }
            f32x4* hw = (f32x4*)xr;
#pragma unroll
            for (int j = 0; j < 4; ++j) hw[64 * j] = v[j]; }
#pragma unroll
        for (int j = 0; j < 4; ++j) s += (v[j].x * v[j].x + v[j].y * v[j].y) + (v[j].z * v[j].z + v[j].w * v[j].w);
        const float rstd = rsqrtf(wave_sum(s) * (1.f / D) + RMS_EPS);
#pragma unroll
        for (int j = 0; j < 4; ++j) { const f32x4 gg = g4[64 * j]; o8[64 * j] = (unsigned long long)pk2(v[j].x * rstd * gg.x, v[j].y * rstd * gg.y) | ((unsigned long long)pk2(v[j].z * rstd * gg.z, v[j].w * rstd * gg.w) << 32); }
    }
}
__device__ __forceinline__ void unpack8(const u32x4 v, float (&f)[8]) {
    f[0] = __uint_as_float(v.x << 16); f[1] = __uint_as_float(v.x & 0xffff0000u); f[2] = __uint_as_float(v.y << 16); f[3] = __uint_as_float(v.y & 0xffff0000u);
    f[4] = __uint_as_float(v.z << 16); f[5] = __uint_as_float(v.z & 0xffff0000u); f[6] = __uint_as_float(v.w << 16); f[7] = __uint_as_float(v.w & 0xffff0000u);
}
__device__ __forceinline__ void ph_prep(const bf16_t* __restrict__ PM, const bf16_t* __restrict__ PR, const float* __restrict__ mu, const float* __restrict__ rope,
                                        float* __restrict__ rstdq, float* __restrict__ rstdkv, bf16_t* __restrict__ KR, bf16_t* __restrict__ LIN, bf16_t* __restrict__ VSH, int do_vsh, int gw, int ngw, int lane) {
    lane = opq(lane);
    for (int row = gw; row < RP; row += ngw) {
        const bf16_t* pm = PM + (size_t)row * PMW;
        float f[8], sq = 0.f, skv = 0.f;
        unpack8(*(const u32x4*)(pm + lane * 8), f);
#pragma unroll
        for (int j = 0; j < 8; ++j) sq += f[j] * f[j];
        if (lane < 32) { unpack8(*(const u32x4*)(pm + 512 + lane * 8), f);
#pragma unroll
            for (int j = 0; j < 8; ++j) skv += f[j] * f[j]; }
        sq = wave_sum(sq); skv = wave_sum(skv);
        if (lane == 0) { rstdq[row] = rsqrtf(sq * (1.f / 512.f) + RMS_EPS); rstdkv[row] = rsqrtf(skv * (1.f / 256.f) + RMS_EPS); }
        const int pos = row_pos(row);
        if (lane < 32) { const float x1 = bf2f(pm[768 + lane]), x2 = bf2f(pm[800 + lane]); const float c = rope[2 * (pos * 32 + lane)], s = rope[2 * (pos * 32 + lane) + 1];
            KR[(size_t)row * 64 + lane] = f2bf(x1 * c - x2 * s); KR[(size_t)row * 64 + 32 + lane] = f2bf(x1 * s + x2 * c); }
        const int pr = row_prev(row); const bool valid = row < RVALID; const float pmk = pr < 0 ? 0.f : 1.f;
        const bf16_t* x = PR + (size_t)row * PRW; const bf16_t* xp = PR + (size_t)(pr < 0 ? row : pr) * PRW;
        if (lane < 32) {
            float a[8], b[8]; unpack8(*(const u32x4*)(x + 1536 + lane * 8), a); unpack8(*(const u32x4*)(xp + 1536 + lane * 8), b);
            const f32x4 m0 = *(const f32x4*)(mu + 1536 + lane * 8), m1 = *(const f32x4*)(mu + 1536 + lane * 8 + 4); const float mm[8] = {m0.x, m0.y, m0.z, m0.w, m1.x, m1.y, m1.z, m1.w};
            float o[8];
#pragma unroll
            for (int j = 0; j < 8; ++j) { float v = a[j] + (pmk * b[j] - a[j]) * mm[j]; v = lane < 8 ? tanhf(v) : (lane < 16 ? v : sigmoidf_(v)); o[j] = valid ? v : 0.f; }
            u32x4 w; w.x = pk2(o[0], o[1]); w.y = pk2(o[2], o[3]); w.z = pk2(o[4], o[5]); w.w = pk2(o[6], o[7]); *(u32x4*)(LIN + (size_t)row * 256 + lane * 8) = w; }
        if (do_vsh) {
            float a[8], b[8]; unpack8(*(const u32x4*)(x + 1024 + lane * 8), a); unpack8(*(const u32x4*)(xp + 1024 + lane * 8), b);
            const f32x4 m0 = *(const f32x4*)(mu + 1024 + lane * 8), m1 = *(const f32x4*)(mu + 1024 + lane * 8 + 4); const float mm[8] = {m0.x, m0.y, m0.z, m0.w, m1.x, m1.y, m1.z, m1.w};
            float o[8];
#pragma unroll
            for (int j = 0; j < 8; ++j) { const float v = a[j] + (pmk * b[j] - a[j]) * mm[j]; o[j] = valid ? v : 0.f; }
            u32x4 w; w.x = pk2(o[0], o[1]); w.y = pk2(o[2], o[3]); w.z = pk2(o[4], o[5]); w.w = pk2(o[6], o[7]); *(u32x4*)(VSH + (size_t)row * 512 + lane * 8) = w; }
    }
}

__device__ __forceinline__ void ph_norm_route(LAS unsigned char* lds, const float* __restrict__ out, const float* __restrict__ g, const float* __restrict__ router, const float* __restrict__ rbias,
                                              bf16_t* __restrict__ U, int* __restrict__ TE, float* __restrict__ TG, int* __restrict__ STOK, unsigned* __restrict__ ctl, int bid, int nblk, int wave, int lane) {
    lane = opq(lane); nblk = opqs(nblk); bid = opqs(bid);
    { constexpr int NFILL = 2 * MOE_MAXPAN * 256 + RREAL; const int per = (NFILL + nblk - 1) / nblk; const int t_ = wave * 64 + lane;
      for (int i = t_; i < per; i += 512) { const int idx = bid * per + i; if (idx < NFILL) STOK[idx] = -1; } }
    const int rpw = (RREAL + nblk - 1) / nblk, rpwave = (rpw + 7) / 8;
    int c1[8], c2[8];
#pragma unroll
    for (int e = 0; e < 8; ++e) { c1[e] = 0; c2[e] = 0; }
    f32x4 rwa[16], rwb[16];
#pragma unroll
    for (int j = 0; j < 4; ++j)
#pragma unroll
        for (int q = 0; q < 4; ++q) { const float* rp = router + (size_t)(4 * (lane + 64 * j) + q) * 8; rwa[4 * j + q] = *(const f32x4*)rp; rwb[4 * j + q] = *(const f32x4*)(rp + 4); }
    float rbq[8];
#pragma unroll
    for (int e = 0; e < 8; ++e) rbq[e] = rbias[e];
    f32x4 gq[4];
#pragma unroll
    for (int j = 0; j < 4; ++j) gq[j] = ((const f32x4*)g + lane)[64 * j];
    f32x4 nx[4];
    { const int rl0 = wave * rpwave, row_0 = bid * rpw + rl0; if (rl0 < rpw && row_0 < RREAL) { const f32x4* x0 = (const f32x4*)(out + (size_t)row_0 * D) + lane;
#pragma unroll
        for (int j = 0; j < 4; ++j) nx[j] = x0[64 * j]; } }
    for (int k = 0; k < rpwave; ++k) { const int rl = wave * rpwave + k; const int row = bid * rpw + rl; if (rl >= rpw || row >= RREAL) break;
        f32x4 v[4]; float s = 0.f;
#pragma unroll
        for (int j = 0; j < 4; ++j) v[j] = nx[j];
        if (k + 1 < rpwave && rl + 1 < rpw && row + 1 < RREAL) { const f32x4* x1 = (const f32x4*)(out + (size_t)(row + 1) * D) + lane;
#pragma unroll
            for (int j = 0; j < 4; ++j) nx[j] = x1[64 * j]; }
#pragma unroll
        for (int j = 0; j < 4; ++j) s += (v[j].x * v[j].x + v[j].y * v[j].y) + (v[j].z * v[j].z + v[j].w * v[j].w);
        const float rstd = rsqrtf(wave_sum(s) * (1.f / D) + RMS_EPS);
        unsigned* o4 = (unsigned*)((unsigned char*)U + (size_t)row * D) + lane;
        float lg[8];
#pragma unroll
        for (int e = 0; e < 8; ++e) lg[e] = 0.f;
#pragma unroll
        for (int j = 0; j < 4; ++j) { const f32x4 gg = gq[j]; f32x4 xn; xn.x = v[j].x * rstd * gg.x; xn.y = v[j].y * rstd * gg.y; xn.z = v[j].z * rstd * gg.z; xn.w = v[j].w * rstd * gg.w;
            o4[64 * j] = pk4_f8(xn.x * F8_ACT, xn.y * F8_ACT, xn.z * F8_ACT, xn.w * F8_ACT);
#pragma unroll
            for (int q = 0; q < 4; ++q) { const f32x4 ra = rwa[4 * j + q], rb = rwb[4 * j + q]; const float xv = xn[q];
                lg[0] += xv * ra.x; lg[1] += xv * ra.y; lg[2] += xv * ra.z; lg[3] += xv * ra.w; lg[4] += xv * rb.x; lg[5] += xv * rb.y; lg[6] += xv * rb.z; lg[7] += xv * rb.w; }
            }
#pragma unroll
        for (int e = 0; e < 8; ++e) { float t_ = wave_sum(lg[e]); asm volatile("" : "+v"(t_)); lg[e] = t_ + rbq[e]; }
        int e1 = 0; float l1 = lg[0];
#pragma unroll
        for (int e = 1; e < 8; ++e) if (lg[e] > l1) { l1 = lg[e]; e1 = e; }
        int e2 = e1 == 0 ? 1 : 0; float l2 = -INFINITY;
#pragma unroll
        for (int e = 0; e < 8; ++e) if (e != e1 && lg[e] > l2) { l2 = lg[e]; e2 = e; }
        const float g1 = 1.0f / (1.0f + __expf(l2 - l1)), g2 = 1.0f - g1;
        { const int e1v = e1, e2v = e2;
#pragma unroll
        for (int e = 0; e < 8; ++e) { c1[e] += (e1v == e) ? 1 : 0; c2[e] += (e2v == e) ? 1 : 0; } }
        if (lane == 0) { TE[row] = e1; TE[RREAL + row] = e2; TG[row] = g1; TG[RREAL + row] = g2; }
    }
    LAS int* wc = (LAS int*)(lds + 80000);
    if (lane == 0) {
#pragma unroll
        for (int e = 0; e < 8; ++e) { wc[wave * 16 + e] = c1[e]; wc[wave * 16 + 8 + e] = c2[e]; } }
    __syncthreads();
    const int t = wave * 64 + lane;
    if (t < 16) { int sum = 0;
#pragma unroll
        for (int ww = 0; ww < 8; ++ww) sum += wc[ww * 16 + t];
        ctl[CW_WGCNT + bid * 16 + t] = (unsigned)sum; }
}
__device__ __forceinline__ void ph_moe_assign(LAS unsigned char* lds, int list, const int* __restrict__ TE, const float* __restrict__ TG, int* __restrict__ STOK, float* __restrict__ SGATE, int* __restrict__ BE, unsigned* __restrict__ ctl,
                                              const unsigned char* __restrict__ U8, unsigned char* __restrict__ XB, int bid, int nblk, int tid) {
    LAS int* sh = (LAS int*)lds;
    __syncthreads();
    {
        LAS float* shf = (LAS float*)(lds + 2048);
        float tv[8], pv[8];
#pragma unroll
        for (int e = 0; e < 8; ++e) { tv[e] = 0.f; pv[e] = 0.f; }
        for (int b = tid; b < nblk; b += 512) { const u32x4* cp4 = (const u32x4*)(ctl + CW_WGCNT + b * 16 + 8 * list); const u32x4 c0 = cp4[0], c1 = cp4[1];
            const float v[8] = {(float)c0.x, (float)c0.y, (float)c0.z, (float)c0.w, (float)c1.x, (float)c1.y, (float)c1.z, (float)c1.w};
#pragma unroll
            for (int e = 0; e < 8; ++e) { tv[e] += v[e]; pv[e] += b < bid ? v[e] : 0.f; } }
        const int wv = tid >> 6;
#pragma unroll
        for (int e = 0; e < 8; ++e) { const float ts = wave_sum(tv[e]), ps = wave_sum(pv[e]); if ((tid & 63) == 0) { shf[wv * 16 + e] = ts; shf[wv * 16 + 8 + e] = ps; } }
        __syncthreads();
        if (tid < 8) { float tot = 0.f, pre = 0.f;
#pragma unroll
            for (int ww = 0; ww < 8; ++ww) { tot += shf[ww * 16 + tid]; pre += shf[ww * 16 + 8 + tid]; }
            sh[tid] = (int)tot; sh[8 + tid] = (int)pre; }
    }
    __syncthreads();
    if (tid == 0) { int pan = 0;
        for (int e = 0; e < 8; ++e) { const int np = (sh[e] + 255) >> 8; sh[16 + e] = pan << 8;
            if (bid == 0) for (int q = 0; q < np; ++q) { const int pi = pan + q; BE[256 * list + pi + (list == 1 && pi >= MOE_TAILPAN ? MOE_GAP : 0)] = e; }
            pan += np; }
        if (bid == 0) ctl[CW_NPAN + list] = (unsigned)pan; }
    __syncthreads();
    if (tid < 64) {
        const int rpw = (RREAL + nblk - 1) / nblk; int run[8];
#pragma unroll
        for (int q = 0; q < 8; ++q) run[q] = 0;
        for (int r0 = 0; r0 < rpw; r0 += 64) { const int rl = r0 + tid, row = bid * rpw + rl; const bool ok = rl < rpw && row < RREAL;
            const int ee = ok ? TE[list * RREAL + row] : -1; int slot = -1;
#pragma unroll
            for (int e = 0; e < 8; ++e) { const unsigned long long m = __builtin_amdgcn_ballot_w64(ee == e);
                const int rank = (int)__builtin_amdgcn_mbcnt_hi((unsigned)(m >> 32), __builtin_amdgcn_mbcnt_lo((unsigned)m, 0u));
                if (ee == e) { slot = sh[16 + e] + sh[8 + e] + run[e] + rank; if (list == 1 && slot >= MOE_TAILPAN * 256) slot += MOE_GAP * 256; }
                run[e] += __builtin_popcountll(m); }
            if (rl < rpw) sh[32 + rl] = ok ? slot : -1;
            if (ok) { STOK[list * (MOE_MAXPAN * 256) + slot] = row; SGATE[list * (MOE_MAXPAN * 256) + slot] = TG[list * RREAL + row];
                if (list == 1 && slot >= (MOE_TAILPAN + MOE_GAP) * 256) STOK[2 * MOE_MAXPAN * 256 + row] = slot - (MOE_TAILPAN + MOE_GAP) * 256; } }
    }
    __syncthreads();
    {
        const int rpw = (RREAL + nblk - 1) / nblk, w = tid >> 6, ln = tid & 63; unsigned char* xl = XB + (size_t)list * (MOE_MAXPAN * 256) * 1024;
        for (int rl = w; rl < rpw; rl += 8) { const int slot = sh[32 + rl]; if (slot >= 0) ((u32x4*)(xl + (size_t)slot * 1024))[ln] = ((const u32x4*)(U8 + (size_t)(bid * rpw + rl) * 1024))[ln]; }
        if (bid < 8) { const int e = bid, lo = sh[16 + e] + sh[e], hi = sh[16 + e] + (((sh[e] + 255) >> 8) << 8); unsigned z0 = 0u; asm volatile("" : "+v"(z0)); u32x4 z; z.x = z.y = z.z = z.w = z0;
            for (int p0 = lo + w; p0 < hi; p0 += 8) { const int slot = p0 + ((list == 1 && p0 >= MOE_TAILPAN * 256) ? MOE_GAP * 256 : 0); ((u32x4*)(xl + (size_t)slot * 1024))[ln] = z; } }
    }
}
__device__ __forceinline__ void ph_final(float* __restrict__ out, const float* __restrict__ g, const int* __restrict__ tslot, const float* __restrict__ tb, int gw, int ngw, int lane, float pscale = 1.0f) {
    lane = opq(lane);
    for (int row = gw; row < RREAL; row += ngw) {
        f32x4* xr = (f32x4*)(out + (size_t)row * D) + lane; const f32x4* g4 = (const f32x4*)g + lane;
        const int ts = __builtin_amdgcn_readfirstlane(tslot[row]);
        f32x4 v[4]; float s = 0.f;
#pragma unroll
        for (int j = 0; j < 4; ++j) v[j] = xr[64 * j];
        if (ts >= 0) { const f32x4* tr = (const f32x4*)(tb + (size_t)ts * D) + lane;
#pragma unroll
            for (int j = 0; j < 4; ++j) v[j] = v[j] + tr[64 * j]; }
#pragma unroll
        for (int j = 0; j < 4; ++j) s += (v[j].x * v[j].x + v[j].y * v[j].y) + (v[j].z * v[j].z + v[j].w * v[j].w);
        const float rstd = rsqrtf(wave_sum(s) * (1.f / D) + RMS_EPS);
#pragma unroll
        for (int j = 0; j < 4; ++j) { const f32x4 gg = g4[64 * j]; f32x4 o; o.x = v[j].x * rstd * gg.x * pscale; o.y = v[j].y * rstd * gg.y * pscale; o.z = v[j].z * rstd * gg.z * pscale; o.w = v[j].w * rstd * gg.w * pscale; xr[64 * j] = o; }
    }
}

constexpr int KS_STRIDE = 200, VS_STRIDE = 72;
constexpr int ATT_LDS = 64 * KS_STRIDE * 2 + 128 * VS_STRIDE * 2;
__device__ __forceinline__ bf16x8 pack8(const f32x16& x, int s) {
    u32x4 p;
    if (s == 0) { p.x = cvtpk(x[0], x[1]); p.y = cvtpk(x[2], x[3]); p.z = cvtpk(x[4], x[5]); p.w = cvtpk(x[6], x[7]); }
    else { p.x = cvtpk(x[8], x[9]); p.y = cvtpk(x[10], x[11]); p.z = cvtpk(x[12], x[13]); p.w = cvtpk(x[14], x[15]); }
    return __builtin_bit_cast(bf16x8, p);
}
__device__ __forceinline__ void attn_unit(LAS unsigned char* lds, const bf16_t* __restrict__ Q, const bf16_t* __restrict__ KN, const bf16_t* __restrict__ KR, const bf16_t* __restrict__ VT,
                                          bf16_t* __restrict__ MIX, const float* __restrict__ rope, int h, int qrow0, int kbase, int ntile, int wlim, bool wave_active) {
    const int tid = opq(threadIdx.x), lane = tid & 63, w = tid >> 6, r = lane & 31, hh = lane >> 5;
    LAS bf16_t* Ks = (LAS bf16_t*)lds; LAS bf16_t* Vs = (LAS bf16_t*)(lds + 64 * KS_STRIDE * 2);
    const int qrow = qrow0 + 32 * w + r;
    bf16x8 qf[12];
#pragma unroll
    for (int ks = 0; ks < 12; ++ks) qf[ks] = *(const GAS bf16x8*)(Q + (size_t)qrow * 768 + 192 * h + 16 * ks + 8 * hh);
    {
        const int pos = row_pos(qrow); const GAS float* rt = (const GAS float*)(rope + (size_t)pos * 64);
#pragma unroll
        for (int half = 0; half < 2; ++half) { const GAS float* cs = rt + 2 * (16 * half + 8 * hh);
#pragma unroll
            for (int j = 0; j < 8; ++j) { const float c = cs[2 * j], sn = cs[2 * j + 1]; const float x1 = bf2f((bf16_t)qf[8 + half][j]), x2 = bf2f((bf16_t)qf[10 + half][j]);
                qf[8 + half][j] = (short)f2bf(x1 * c - x2 * sn); qf[10 + half][j] = (short)f2bf(x1 * sn + x2 * c); } }
    }
    float z0 = 0.f; asm volatile("" : "+v"(z0));
    f32x16 oacc[4];
#pragma unroll
    for (int i = 0; i < 4; ++i)
#pragma unroll
        for (int j = 0; j < 16; ++j) oacc[i][j] = z0;
    float mrun = -INFINITY, lsum = 0.f;
    const float sc = 0.07216878364870322f * 1.4426950408889634f;
    u32x4 kreg[3], vreg[2];
    const unsigned kn_off0 = (unsigned)(((tid >> 4) * 512 + h * 128 + (tid & 15) * 8) * 2), kn_off1 = kn_off0 + 32u * 512u * 2u;
    const unsigned kr_off = (unsigned)(((tid >> 3) * 64 + (tid & 7) * 8) * 2);
    const unsigned vt_off0 = (unsigned)((((size_t)(h * 128 + (tid >> 3))) * RP + (tid & 7) * 8) * 2), vt_off1 = vt_off0 + 64u * (unsigned)RP * 2u;
#define ATT_GLOAD(tt_) do { const int krow0_ = (tt_) == 0 ? RREAL : kbase + 64 * ((tt_) - 1); \
    const char* knb_ = (const char*)KN + (size_t)krow0_ * 1024; const char* krb_ = (const char*)KR + (size_t)krow0_ * 128; const char* vtb_ = (const char*)VT + (size_t)krow0_ * 2; \
    kreg[0] = *(const GAS u32x4*)(knb_ + kn_off0); kreg[1] = *(const GAS u32x4*)(knb_ + kn_off1); kreg[2] = *(const GAS u32x4*)(krb_ + kr_off); \
    vreg[0] = *(const GAS u32x4*)(vtb_ + vt_off0); vreg[1] = *(const GAS u32x4*)(vtb_ + vt_off1); } while (0)
    ATT_GLOAD(0);
    for (int tt = 0; tt < ntile; ++tt) {
#ifdef PROBE_ATT_STAGE2
        __syncthreads();
        *(LAS u32x4*)(Ks + (tid >> 4) * KS_STRIDE + (tid & 15) * 8) = kreg[0]; *(LAS u32x4*)(Ks + (32 + (tid >> 4)) * KS_STRIDE + (tid & 15) * 8) = kreg[1];
        *(LAS u32x4*)(Ks + (tid >> 3) * KS_STRIDE + 128 + (tid & 7) * 8) = kreg[2];
#pragma unroll
        for (int i = 0; i < 2; ++i) {
            LAS u32x2* d = (LAS u32x2*)(Vs + ((tid >> 3) + 64 * i) * VS_STRIDE + ((tid & 7) >> 1) * 16 + (tid & 1) * 4);
            u32x2 lo; lo.x = vreg[i].x; lo.y = vreg[i].y; u32x2 hi; hi.x = vreg[i].z; hi.y = vreg[i].w; d[0] = lo; d[2] = hi; }
        __syncthreads();
#endif
        __syncthreads();
        *(LAS u32x4*)(Ks + (tid >> 4) * KS_STRIDE + (tid & 15) * 8) = kreg[0]; *(LAS u32x4*)(Ks + (32 + (tid >> 4)) * KS_STRIDE + (tid & 15) * 8) = kreg[1];
        *(LAS u32x4*)(Ks + (tid >> 3) * KS_STRIDE + 128 + (tid & 7) * 8) = kreg[2];
#pragma unroll
        for (int i = 0; i < 2; ++i) {
            LAS u32x2* d = (LAS u32x2*)(Vs + ((tid >> 3) + 64 * i) * VS_STRIDE + ((tid & 7) >> 1) * 16 + (tid & 1) * 4);
            u32x2 lo; lo.x = vreg[i].x; lo.y = vreg[i].y; u32x2 hi; hi.x = vreg[i].z; hi.y = vreg[i].w; d[0] = lo; d[2] = hi; }
        __syncthreads();
        const bool comp = wave_active && tt <= wlim;
        if (tt + 1 < ntile) ATT_GLOAD(tt + 1);
        if (comp) {
            f32x16 sacc[2];
#pragma unroll
            for (int b = 0; b < 2; ++b)
#pragma unroll
                for (int j = 0; j < 16; ++j) sacc[b][j] = z0;
#ifdef PROBE_ATT_QK2
            {
            __builtin_amdgcn_sched_barrier(0);
            {
                const LAS bf16_t* kb0 = Ks + r * KS_STRIDE + 8 * hh;
                bf16x8 kf[6];
#pragma unroll
                for (int i = 0; i < 6; ++i) kf[i] = *(const LAS bf16x8*)(kb0 + 16 * i);
#pragma unroll
                for (int i = 0; i < 24; ++i) { sacc[i / 12] = __builtin_amdgcn_mfma_f32_32x32x16_bf16(kf[i % 6], qf[i % 12], sacc[i / 12], 0, 0, 0);
                    if (i + 6 < 24) kf[i % 6] = *(const LAS bf16x8*)(kb0 + ((i + 6) / 12) * 32 * KS_STRIDE + 16 * ((i + 6) % 12)); }
                __builtin_amdgcn_sched_group_barrier(0x100, 6, 0);
#pragma unroll
                for (int i = 0; i < 18; ++i) { __builtin_amdgcn_sched_group_barrier(0x008, 1, 0); __builtin_amdgcn_sched_group_barrier(0x100, 1, 0); }
                __builtin_amdgcn_sched_group_barrier(0x008, 6, 0);
            }
            __builtin_amdgcn_sched_barrier(0);
                asm volatile("" : "+v"(sacc[0][0]), "+v"(sacc[1][0]));
#pragma unroll
                for (int b = 0; b < 2; ++b)
#pragma unroll
                    for (int j = 0; j < 16; ++j) sacc[b][j] = z0;
            }
#endif
            __builtin_amdgcn_sched_barrier(0);
            {
                const LAS bf16_t* kb0 = Ks + r * KS_STRIDE + 8 * hh;
                bf16x8 kf[6];
#pragma unroll
                for (int i = 0; i < 6; ++i) kf[i] = *(const LAS bf16x8*)(kb0 + 16 * i);
#pragma unroll
                for (int i = 0; i < 24; ++i) { sacc[i / 12] = __builtin_amdgcn_mfma_f32_32x32x16_bf16(kf[i % 6], qf[i % 12], sacc[i / 12], 0, 0, 0);
                    if (i + 6 < 24) kf[i % 6] = *(const LAS bf16x8*)(kb0 + ((i + 6) / 12) * 32 * KS_STRIDE + 16 * ((i + 6) % 12)); }
                __builtin_amdgcn_sched_group_barrier(0x100, 6, 0);
#pragma unroll
                for (int i = 0; i < 18; ++i) { __builtin_amdgcn_sched_group_barrier(0x008, 1, 0); __builtin_amdgcn_sched_group_barrier(0x100, 1, 0); }
                __builtin_amdgcn_sched_group_barrier(0x008, 6, 0);
            }
            __builtin_amdgcn_sched_barrier(0);
            if (tt == 0) {
#pragma unroll
                for (int j = 8; j < 16; ++j) sacc[0][j] = -INFINITY;
#pragma unroll
                for (int j = 0; j < 16; ++j) sacc[1][j] = -INFINITY; }
            float tmax = fmaxf(sacc[0][0], sacc[1][0]);
#pragma unroll
            for (int j = 1; j < 16; ++j) tmax = fmaxf(tmax, fmaxf(sacc[0][j], sacc[1][j]));
            tmax = fmaxf(tmax, __int_as_float(__builtin_amdgcn_ds_bpermute((lane ^ 32) << 2, __float_as_int(tmax)))) * sc;
            const float mnew = fmaxf(mrun, tmax); const float alpha = __builtin_amdgcn_exp2f(mrun - mnew); mrun = mnew;
            float psum = 0.f;
#pragma unroll
            for (int b = 0; b < 2; ++b)
#pragma unroll
                for (int j = 0; j < 16; ++j) { const float p = __builtin_amdgcn_exp2f(__builtin_fmaf(sacc[b][j], sc, -mnew)); sacc[b][j] = p; psum += p; }
            lsum = lsum * alpha + psum;
            if (__builtin_amdgcn_ballot_w64(alpha != 1.0f) != 0ull) {
#pragma unroll
            for (int i = 0; i < 4; ++i)
#pragma unroll
                for (int j = 0; j < 16; ++j) oacc[i][j] *= alpha; }
            bf16x8 pf[4];
            pf[0] = pack8(sacc[0], 0); pf[1] = pack8(sacc[0], 1); pf[2] = pack8(sacc[1], 0); pf[3] = pack8(sacc[1], 1);
#ifdef PROBE_ATT_PV2
            {
                const LAS bf16_t* vb0 = Vs + r * VS_STRIDE + 8 * hh;
#pragma unroll
                for (int j = 0; j < 16; ++j) { sacc[0][j] = z0; sacc[1][j] = z0; }
#pragma unroll
                for (int i = 0; i < 16; ++i) { const bf16x8 vfd = *(const LAS bf16x8*)(vb0 + 32 * (i >> 2) * VS_STRIDE + 16 * (i & 3));
                    sacc[i & 1] = __builtin_amdgcn_mfma_f32_32x32x16_bf16(vfd, pf[i & 3], sacc[i & 1], 0, 0, 0); }
                asm volatile("" :: "v"(sacc[0][0]), "v"(sacc[1][0]));
            }
#endif
            __builtin_amdgcn_sched_barrier(0);
            {
                const LAS bf16_t* vb0 = Vs + r * VS_STRIDE + 8 * hh;
                bf16x8 vf[16];
#pragma unroll
                for (int i = 0; i < 16; ++i) vf[i] = *(const LAS bf16x8*)(vb0 + 32 * (i >> 2) * VS_STRIDE + 16 * (i & 3));
#pragma unroll
                for (int i = 0; i < 16; ++i) oacc[i >> 2] = __builtin_amdgcn_mfma_f32_32x32x16_bf16(vf[i], pf[i & 3], oacc[i >> 2], 0, 0, 0);
                __builtin_amdgcn_sched_group_barrier(0x100, 8, 1);
#pragma unroll
                for (int i = 0; i < 8; ++i) { __builtin_amdgcn_sched_group_barrier(0x008, 1, 1); __builtin_amdgcn_sched_group_barrier(0x100, 1, 1); }
                __builtin_amdgcn_sched_group_barrier(0x008, 8, 1);
            }
            __builtin_amdgcn_sched_barrier(0);
        }
    }
    if (wave_active) {
        const float ltot = lsum + __int_as_float(__builtin_amdgcn_ds_bpermute((lane ^ 32) << 2, __float_as_int(lsum))); const float inv = 1.0f / ltot;
        bf16_t* orow = MIX + (size_t)qrow * D + 128 * h;
#pragma unroll
        for (int dvb = 0; dvb < 4; ++dvb)
#pragma unroll
            for (int g = 0; g < 4; ++g) { u32x2 o; o.x = cvtpk(oacc[dvb][4 * g] * inv, oacc[dvb][4 * g + 1] * inv); o.y = cvtpk(oacc[dvb][4 * g + 2] * inv, oacc[dvb][4 * g + 3] * inv);
                *(GAS u32x2*)(orow + 32 * dvb + 8 * g + 4 * hh) = o; }
    }
    __syncthreads();
}
__device__ __forceinline__ void attn_phase(LAS unsigned char* lds, const bf16_t* Q, const bf16_t* KN, const bf16_t* KR, const bf16_t* VT, bf16_t* MIX, const float* rope, int bid, int nblk) {
    const int w = opq(threadIdx.x) >> 6;
    for (int s = bid; s < 512; s += nblk) {
        const int round = s >> 8, x = s & 255; const int bh = (x >> 4) + 16 * round, qb = round ? 15 - (x & 15) : (x & 15);
        const int b = bh >> 2, h = bh & 3;
        attn_unit(lds, Q, KN, KR, VT, MIX, rope, h, b * SEQ + 256 * qb, b * SEQ, 4 * qb + 5, 4 * qb + (w >> 1) + 1, true);
    }
    for (int s = bid; s < 4; s += nblk)
        attn_unit(lds, Q, KN, KR, VT, MIX, rope, s, RREAL, 0, 1, 0, w == 0);
}

constexpr int CLS = 72;
constexpr int CSLOT = 64 * CLS * 2;
constexpr int CHK_BYTES = 32768;
constexpr int NSEQ_HALF0 = 257;
struct CpP { const bf16_t* PR; const bf16_t* LO; const bf16_t* VMIX; const bf16_t* VFIRST; bf16_t* VP; float* RK; unsigned char* CHK;
    const float *mu, *w0, *a0, *k_k, *k_a, *r_k, *v0; int layer, pad; };

__device__ __forceinline__ void mm64(f32x16& acc, const LAS bf16_t* a, const LAS bf16_t* b, int r, int hh) {
    bf16x8 af[4], bf[4];
#pragma unroll
    for (int ks = 0; ks < 4; ++ks) { af[ks] = *(const LAS bf16x8*)(a + r * CLS + 16 * ks + 8 * hh); bf[ks] = *(const LAS bf16x8*)(b + r * CLS + 16 * ks + 8 * hh); }
#pragma unroll
    for (int ks = 0; ks < 4; ++ks) acc = __builtin_amdgcn_mfma_f32_32x32x16_bf16(af[ks], bf[ks], acc, 0, 0, 0);
}
__device__ __forceinline__ void st_tile(const f32x16& acc, LAS bf16_t* dst, int m0, int n0, int r, int hh) {
#pragma unroll
    for (int q = 0; q < 16; ++q) dst[(m0 + (q & 3) + 8 * (q >> 2) + 4 * hh) * CLS + n0 + r] = f2bf_hw(acc[q]);
}
__device__ __forceinline__ void st_tile_t(const f32x16& acc, LAS bf16_t* dst, int m0, int n0, int r, int hh) {
#pragma unroll
    for (int g = 0; g < 4; ++g) { u32x2 o; o.x = cvtpk(acc[4 * g], acc[4 * g + 1]); o.y = cvtpk(acc[4 * g + 2], acc[4 * g + 3]);
        *(LAS u32x2*)(dst + (n0 + r) * CLS + m0 + 8 * g + 4 * hh) = o; }
}
__device__ __forceinline__ void zero16(f32x16& a, float z) {
#pragma unroll
    for (int q = 0; q < 16; ++q) a[q] = z;
}
typedef float f32x2 __attribute__((ext_vector_type(2)));
struct CpRaw { unsigned xr[5], xk[5], xv[5], lw[4], la[4], vm[4], vf[4]; f32x2 mu_r, mu_k, mu_v, w0, a0, kkc, kac, rkc, v0; float pm0; };
__device__ __forceinline__ void cp_issue(const CpP& P, int row0, int hd, int w, int lane, CpRaw& R) {
    const int cp = lane & 31, rh = lane >> 5, c = hd * 64 + 2 * cp;
    R.mu_r = *(const GAS f32x2*)(P.mu + c); R.mu_k = *(const GAS f32x2*)(P.mu + 512 + c); R.mu_v = *(const GAS f32x2*)(P.mu + 1024 + c); R.w0 = *(const GAS f32x2*)(P.w0 + c); R.a0 = *(const GAS f32x2*)(P.a0 + c);
    R.kkc = *(const GAS f32x2*)(P.k_k + c); R.kac = *(const GAS f32x2*)(P.k_a + c); R.rkc = *(const GAS f32x2*)(P.r_k + c);
    if (P.layer) R.v0 = *(const GAS f32x2*)(P.v0 + c); else { R.v0.x = 0.f; R.v0.y = 0.f; }
    const int rw0 = row0 + 8 * w + 4 * rh; const int prow0 = (w == 0 && rh == 0) ? row_prev(row0) : rw0 - 1; R.pm0 = prow0 < 0 ? 0.f : 1.f;
    { const bf16_t* xp = P.PR + (size_t)(prow0 < 0 ? rw0 : prow0) * PRW + c; R.xr[0] = *(const GAS unsigned*)xp; R.xk[0] = *(const GAS unsigned*)(xp + 512); R.xv[0] = *(const GAS unsigned*)(xp + 1024); }
#pragma unroll
    for (int q = 0; q < 4; ++q) { const bf16_t* x = P.PR + (size_t)(rw0 + q) * PRW + c; R.xr[q + 1] = *(const GAS unsigned*)x; R.xk[q + 1] = *(const GAS unsigned*)(x + 512); R.xv[q + 1] = *(const GAS unsigned*)(x + 1024);
        const bf16_t* lo = P.LO + (size_t)(rw0 + q) * 1536 + c; R.lw[q] = *(const GAS unsigned*)lo; R.la[q] = *(const GAS unsigned*)(lo + 512);
        if (P.layer) { R.vm[q] = *(const GAS unsigned*)(P.VMIX + (size_t)(rw0 + q) * 512 + c); R.vf[q] = *(const GAS unsigned*)(P.VFIRST + (size_t)(rw0 + q) * 512 + c); } else { R.vm[q] = 0u; R.vf[q] = 0u; } }
}
__device__ __forceinline__ float bfl(unsigned u) { return __uint_as_float(u << 16); }
__device__ __forceinline__ float bfh(unsigned u) { return __uint_as_float(u & 0xffff0000u); }
__device__ __forceinline__ float half_tot(float v) {
    v += DPP_F(v, 0xB1, 0xf); v += DPP_F(v, 0x4E, 0xf); v += DPP_F(v, 0x141, 0xf); v += DPP_F(v, 0x140, 0xf); v += DPP_F(v, 0x142, 0xa); return v; }
__device__ __forceinline__ void rwkv_cp_task(LAS unsigned char* lds, const CpP& P, int row0, int hd, unsigned char* out, CpRaw& R, bool has_next, int nrow0, int nhd) {
    const int tid = opq(threadIdx.x), lane = tid & 63, w = __builtin_amdgcn_readfirstlane(tid >> 6), r = lane & 31, hh = lane >> 5;
    float z0 = 0.f; asm volatile("" : "+v"(z0));
    LAS bf16_t* S_ATtm = (LAS bf16_t*)(lds + 0 * CSLOT);
    LAS bf16_t* S_BHtm = (LAS bf16_t*)(lds + 1 * CSLOT);
    LAS bf16_t* S_KHtm = (LAS bf16_t*)(lds + 2 * CSLOT);
    LAS bf16_t* S_RTtm = (LAS bf16_t*)(lds + 3 * CSLOT);
    LAS bf16_t* S_ATcm = (LAS bf16_t*)(lds + 4 * CSLOT);
    LAS bf16_t* S_BBcm = (LAS bf16_t*)(lds + 5 * CSLOT);
    LAS bf16_t* S_KBcm = (LAS bf16_t*)(lds + 6 * CSLOT);
    LAS bf16_t* S_VTcm = (LAS bf16_t*)(lds + 7 * CSLOT);
    LAS bf16_t* S_Q0a = (LAS bf16_t*)(lds + 8 * CSLOT);
    LAS bf16_t* S_Q0b = (LAS bf16_t*)(lds + 9 * CSLOT);
    LAS bf16_t* S_PP0 = (LAS bf16_t*)(lds + 10 * CSLOT);
    LAS bf16_t* S_Na = (LAS bf16_t*)(lds + 11 * CSLOT);
    LAS bf16_t* S_XT = (LAS bf16_t*)(lds + 12 * CSLOT);
    LAS bf16_t* S_Pa = (LAS bf16_t*)(lds + 13 * CSLOT);
    LAS bf16_t* S_Qa = (LAS bf16_t*)(lds + 14 * CSLOT);
    LAS float* S_TOT = (LAS float*)(lds + 15 * CSLOT);
    LAS bf16_t* Qa[2] = {S_Q0a, S_ATtm}; LAS bf16_t* Qb[2] = {S_Q0b, S_BHtm}; LAS bf16_t* PPa[2] = {S_PP0, S_KHtm};

    {
        const int cp = lane & 31, rh = lane >> 5, c = hd * 64 + 2 * cp;
        const f32x2 mu_r = R.mu_r, mu_k = R.mu_k, mu_v = R.mu_v, w0 = R.w0, a0 = R.a0, kkc = R.kkc, kac = R.kac, rkc = R.rkc, v0 = R.v0; const float pm0 = R.pm0;
        float fr[4][2], fk[4][2], fv[4][2], fa[4][2], fb[4][2], lw[4][2];
        const int rw0 = row0 + 8 * w + 4 * rh;
        constexpr float L2E = 1.4426950408889634f;
#pragma unroll
        for (int q = 0; q < 4; ++q) { const int row = rw0 + q; const bool valid = row < RVALID; const float pm = q == 0 ? pm0 : 1.f;
            float rr[2] = {bfl(R.xr[q + 1]), bfh(R.xr[q + 1])}, kk[2] = {bfl(R.xk[q + 1]), bfh(R.xk[q + 1])}, vv[2] = {bfl(R.xv[q + 1]), bfh(R.xv[q + 1])};
            const float pr[2] = {bfl(R.xr[q]), bfh(R.xr[q])}, pk[2] = {bfl(R.xk[q]), bfh(R.xk[q])}, pv[2] = {bfl(R.xv[q]), bfh(R.xv[q])};
            const float wpre[2] = {bfl(R.lw[q]), bfh(R.lw[q])}, apre[2] = {bfl(R.la[q]), bfh(R.la[q])};
            float lwv[2], asig[2], kkr[2], k2[2], kn[2];
#pragma unroll
            for (int e = 0; e < 2; ++e) {
                rr[e] = rr[e] + (pm * pr[e] - rr[e]) * mu_r[e]; kk[e] = kk[e] + (pm * pk[e] - kk[e]) * mu_k[e]; vv[e] = vv[e] + (pm * pv[e] - vv[e]) * mu_v[e];
                lwv[e] = -0.6065306597126334f * __builtin_amdgcn_rcpf(1.0f + __builtin_amdgcn_exp2f(-(w0[e] + wpre[e]) * L2E));
                asig[e] = __builtin_amdgcn_rcpf(1.0f + __builtin_amdgcn_exp2f(-(a0[e] + apre[e]) * L2E));
                kkr[e] = kk[e] * kkc[e]; k2[e] = kk[e] * (1.f + (asig[e] - 1.f) * kac[e]); }
            if (P.layer) { const float vm[2] = {bfl(R.vm[q]), bfh(R.vm[q])}, vf[2] = {bfl(R.vf[q]), bfh(R.vf[q])};
#pragma unroll
                for (int e = 0; e < 2; ++e) vv[e] = vv[e] + (vf[e] - vv[e]) * __builtin_amdgcn_rcpf(1.0f + __builtin_amdgcn_exp2f(-(v0[e] + vm[e]) * L2E)); }
            const float sst = half_tot(kkr[0] * kkr[0] + kkr[1] * kkr[1]);
            const float rkt = half_tot(rr[0] * k2[0] * rkc[0] + rr[1] * k2[1] * rkc[1]);
            const float ss0 = __int_as_float(__builtin_amdgcn_readlane(__float_as_int(sst), 31)), ss1 = __int_as_float(__builtin_amdgcn_readlane(__float_as_int(sst), 63));
            const float rs = rsqrtf(fmaxf(rh ? ss1 : ss0, 1e-24f));
            kn[0] = kkr[0] * rs; kn[1] = kkr[1] * rs;
            if (!valid) {
#pragma unroll
                for (int e = 0; e < 2; ++e) { rr[e] = 0.f; k2[e] = 0.f; vv[e] = 0.f; kn[e] = 0.f; lwv[e] = 0.f; } }
            *(GAS unsigned*)(P.VP + (size_t)row * 512 + c) = cvtpk(vv[0], vv[1]); if (cp == 31) ((GAS float*)P.RK)[(size_t)row * 8 + hd] = valid ? rkt : 0.f;
#pragma unroll
            for (int e = 0; e < 2; ++e) { fr[q][e] = rr[e]; fk[q][e] = k2[e]; fv[q][e] = vv[e]; fa[q][e] = -kn[e]; fb[q][e] = kn[e] * asig[e]; lw[q][e] = lwv[e]; } }
        if (has_next) cp_issue(P, nrow0, nhd, w, lane, R);
        float cum[4][2], hoff[2];
#pragma unroll
        for (int e = 0; e < 2; ++e) { cum[0][e] = lw[0][e];
#pragma unroll
            for (int q = 1; q < 4; ++q) cum[q][e] = cum[q - 1][e] + lw[q][e];
            const float pt = __int_as_float(__builtin_amdgcn_ds_bpermute((lane ^ 32) << 2, __float_as_int(cum[3][e]))); hoff[e] = rh ? pt : 0.f; }
        if (rh) { f32x2 t2; t2.x = hoff[0] + cum[3][0]; t2.y = hoff[1] + cum[3][1]; *(LAS f32x2*)(S_TOT + w * 64 + 2 * cp) = t2; }
        lds_barrier();
        float off[2] = {0.f, 0.f}, tot[2] = {0.f, 0.f};
#pragma unroll
        for (int ww = 0; ww < 8; ++ww) { const f32x2 tv = *(const LAS f32x2*)(S_TOT + ww * 64 + 2 * cp); off[0] += ww < w ? tv.x : 0.f; off[1] += ww < w ? tv.y : 0.f; tot[0] += tv.x; tot[1] += tv.y; }
        const float etot[2] = {__builtin_amdgcn_exp2f(tot[0] * L2E), __builtin_amdgcn_exp2f(tot[1] * L2E)};
        if (w == 0 && rh == 0) { f32x2 t2; t2.x = etot[0]; t2.y = etot[1]; *(LAS f32x2*)(S_TOT + 512 + 2 * cp) = t2; }
        float at[4][2], bh[4][2], kh[4][2], rt[4][2], bb[4][2], kb[4][2];
#pragma unroll
        for (int e = 0; e < 2; ++e) { const float base = off[e] + hoff[e];
            float ecprev = __builtin_amdgcn_exp2f(base * L2E);
#pragma unroll
            for (int q = 0; q < 4; ++q) { const float ci = base + cum[q][e]; const float ec = __builtin_amdgcn_exp2f(ci * L2E), ecp = ecprev, en = __builtin_amdgcn_rcpf(ec), ee = etot[e] * en; ecprev = ec;
                rt[q][e] = fr[q][e] * ec; at[q][e] = fa[q][e] * ecp; bh[q][e] = fb[q][e] * en; kh[q][e] = fk[q][e] * en; bb[q][e] = fb[q][e] * ee; kb[q][e] = fk[q][e] * ee; } }
#pragma unroll
        for (int q = 0; q < 4; ++q) { const int t = 8 * w + 4 * rh + q;
            *(LAS unsigned*)(S_ATtm + t * CLS + 2 * cp) = cvtpk(at[q][0], at[q][1]); *(LAS unsigned*)(S_BHtm + t * CLS + 2 * cp) = cvtpk(bh[q][0], bh[q][1]);
            *(LAS unsigned*)(S_KHtm + t * CLS + 2 * cp) = cvtpk(kh[q][0], kh[q][1]); *(LAS unsigned*)(S_RTtm + t * CLS + 2 * cp) = cvtpk(rt[q][0], rt[q][1]); }
#pragma unroll
        for (int e = 0; e < 2; ++e) { const int jo = (2 * cp + e) * CLS + 8 * w + 4 * rh; u32x2 o;
            o.x = cvtpk(at[0][e], at[1][e]); o.y = cvtpk(at[2][e], at[3][e]); *(LAS u32x2*)(S_ATcm + jo) = o;
            o.x = cvtpk(bb[0][e], bb[1][e]); o.y = cvtpk(bb[2][e], bb[3][e]); *(LAS u32x2*)(S_BBcm + jo) = o;
            o.x = cvtpk(kb[0][e], kb[1][e]); o.y = cvtpk(kb[2][e], kb[3][e]); *(LAS u32x2*)(S_KBcm + jo) = o;
            o.x = cvtpk(fv[0][e], fv[1][e]); o.y = cvtpk(fv[2][e], fv[3][e]); *(LAS u32x2*)(S_VTcm + jo) = o; }
    }
    lds_barrier();
    const int q4 = w & 3, mb = q4 >> 1, nb = q4 & 1; const bool upper = (mb == 0 && nb == 1);
    f32x16 pacc;
    {
        f32x16 a0, a1; zero16(a0, z0); zero16(a1, z0);
        const LAS bf16_t* lhs = (w < 4 ? S_ATtm : S_RTtm) + 32 * mb * CLS;
        if (!upper) { mm64(a0, lhs, S_BHtm + 32 * nb * CLS, r, hh); mm64(a1, lhs, S_KHtm + 32 * nb * CLS, r, hh); }
        const int s = 32 * nb + r;
#pragma unroll
        for (int q = 0; q < 16; ++q) { const int t = 32 * mb + (q & 3) + 8 * (q >> 2) + 4 * hh; const bool keep = w < 4 ? (s < t) : (s <= t); if (!keep) { a0[q] = z0; a1[q] = z0; } }
        if (w < 4) { st_tile(a0, S_Q0a, 32 * mb, 32 * nb, r, hh); st_tile_t(a0, S_Q0b, 32 * mb, 32 * nb, r, hh); st_tile(a1, S_Na, 32 * mb, 32 * nb, r, hh);
            pacc = a0;
#pragma unroll
            for (int q = 0; q < 16; ++q) { const int t = 32 * mb + (q & 3) + 8 * (q >> 2) + 4 * hh; if (t == s) pacc[q] += 1.0f; }
            st_tile(pacc, S_PP0, 32 * mb, 32 * nb, r, hh); }
        else { st_tile(a0, S_Pa, 32 * mb, 32 * nb, r, hh); st_tile(a1, S_Qa, 32 * mb, 32 * nb, r, hh); zero16(pacc, z0); }
    }
    lds_barrier();
    {
        f32x16 a; zero16(a, z0);
        if (w >= 4) { if (!upper) { mm64(a, Qa[0] + 32 * mb * CLS, Qb[0] + 32 * nb * CLS, r, hh); } st_tile(a, Qa[1], 32 * mb, 32 * nb, r, hh); st_tile_t(a, Qb[1], 32 * mb, 32 * nb, r, hh); }
        else { mm64(a, S_Na + 32 * mb * CLS, S_VTcm + 32 * nb * CLS, r, hh); st_tile_t(a, S_XT, 32 * mb, 32 * nb, r, hh); }
    }
    lds_barrier();
#pragma unroll 1
    for (int k = 1; k <= 5; ++k) {
        const int rs = k & 1, ws_ = rs ^ 1;
        if (w < 4) { if (!upper) mm64(pacc, PPa[ws_] + 32 * mb * CLS, Qb[rs] + 32 * nb * CLS, r, hh); st_tile(pacc, PPa[rs], 32 * mb, 32 * nb, r, hh); }
        else if (k < 5) { f32x16 a; zero16(a, z0); if (!upper) mm64(a, Qa[rs] + 32 * mb * CLS, Qb[rs] + 32 * nb * CLS, r, hh); st_tile(a, Qa[ws_], 32 * mb, 32 * nb, r, hh); st_tile_t(a, Qb[ws_], 32 * mb, 32 * nb, r, hh); }
        lds_barrier();
    }
    {
        f32x16 a; zero16(a, z0);
        mm64(a, PPa[1] + 32 * mb * CLS, (w < 4 ? S_ATcm : S_XT) + 32 * nb * CLS, r, hh);
        st_tile_t(a, w < 4 ? S_Q0a : S_Q0b, 32 * mb, 32 * nb, r, hh);
    }
    lds_barrier();
    {
        LAS bf16_t* W1T = S_Q0a; LAS bf16_t* U1T = S_Q0b;
        f32x16 a, b; zero16(a, z0); zero16(b, z0);
        GAS u32x4* o128 = (GAS u32x4*)out;
        if (w < 4) {
            mm64(a, S_BBcm + 32 * mb * CLS, U1T + 32 * nb * CLS, r, hh); mm64(a, S_KBcm + 32 * mb * CLS, S_VTcm + 32 * nb * CLS, r, hh);
            mm64(b, W1T + 32 * mb * CLS, S_BBcm + 32 * nb * CLS, r, hh);
            const float gam = S_TOT[512 + 32 * nb + r];
#pragma unroll
            for (int q = 0; q < 16; ++q) { const int j = 32 * mb + (q & 3) + 8 * (q >> 2) + 4 * hh; if (j == 32 * nb + r) b[q] += gam; }
            u32x4 h0, h1, g0, g1;
            h0.x = cvtpk(a[0], a[1]); h0.y = cvtpk(a[2], a[3]); h0.z = cvtpk(a[4], a[5]); h0.w = cvtpk(a[6], a[7]);
            h1.x = cvtpk(a[8], a[9]); h1.y = cvtpk(a[10], a[11]); h1.z = cvtpk(a[12], a[13]); h1.w = cvtpk(a[14], a[15]);
            g0.x = cvtpk(b[0], b[1]); g0.y = cvtpk(b[2], b[3]); g0.z = cvtpk(b[4], b[5]); g0.w = cvtpk(b[6], b[7]);
            g1.x = cvtpk(b[8], b[9]); g1.y = cvtpk(b[10], b[11]); g1.z = cvtpk(b[12], b[13]); g1.w = cvtpk(b[14], b[15]);
            o128[1024 + ((mb * 2 + nb) * 64 + lane) * 2] = h0; o128[1024 + ((mb * 2 + nb) * 64 + lane) * 2 + 1] = h1;
            o128[(nb * 4 + 2 * mb) * 64 + lane] = g0; o128[(nb * 4 + 2 * mb + 1) * 64 + lane] = g1;
        } else {
            mm64(a, S_Pa + 32 * mb * CLS, U1T + 32 * nb * CLS, r, hh); mm64(a, S_Qa + 32 * mb * CLS, S_VTcm + 32 * nb * CLS, r, hh);
            mm64(b, W1T + 32 * mb * CLS, S_Pa + 32 * nb * CLS, r, hh);
#pragma unroll
            for (int g = 0; g < 4; ++g) { const s16x4 rv = *(const LAS s16x4*)(S_RTtm + (32 * nb + r) * CLS + 32 * mb + 8 * g + 4 * hh);
#pragma unroll
                for (int e = 0; e < 4; ++e) b[4 * g + e] += bf2f((bf16_t)rv[e]); }
            u32x4 y0, y1, r0, r1;
            y0.x = cvtpk(a[0], a[1]); y0.y = cvtpk(a[2], a[3]); y0.z = cvtpk(a[4], a[5]); y0.w = cvtpk(a[6], a[7]);
            y1.x = cvtpk(a[8], a[9]); y1.y = cvtpk(a[10], a[11]); y1.z = cvtpk(a[12], a[13]); y1.w = cvtpk(a[14], a[15]);
            r0.x = cvtpk(b[0], b[1]); r0.y = cvtpk(b[2], b[3]); r0.z = cvtpk(b[4], b[5]); r0.w = cvtpk(b[6], b[7]);
            r1.x = cvtpk(b[8], b[9]); r1.y = cvtpk(b[10], b[11]); r1.z = cvtpk(b[12], b[13]); r1.w = cvtpk(b[14], b[15]);
            o128[1536 + ((mb * 2 + nb) * 64 + lane) * 2] = y0; o128[1536 + ((mb * 2 + nb) * 64 + lane) * 2 + 1] = y1;
            o128[512 + (nb * 4 + 2 * mb) * 64 + lane] = r0; o128[512 + (nb * 4 + 2 * mb + 1) * 64 + lane] = r1;
        }
    }
    lds_barrier();
}

struct ScP { const unsigned char* CHK; bf16_t* YS; };
__device__ __forceinline__ void scan_unpack16(f32x16& acc, const u32x4 y0, const u32x4 y1) {
    acc[0] = __uint_as_float(y0.x << 16); acc[1] = __uint_as_float(y0.x & 0xffff0000u); acc[2] = __uint_as_float(y0.y << 16); acc[3] = __uint_as_float(y0.y & 0xffff0000u);
    acc[4] = __uint_as_float(y0.z << 16); acc[5] = __uint_as_float(y0.z & 0xffff0000u); acc[6] = __uint_as_float(y0.w << 16); acc[7] = __uint_as_float(y0.w & 0xffff0000u);
    acc[8] = __uint_as_float(y1.x << 16); acc[9] = __uint_as_float(y1.x & 0xffff0000u); acc[10] = __uint_as_float(y1.y << 16); acc[11] = __uint_as_float(y1.y & 0xffff0000u);
    acc[12] = __uint_as_float(y1.z << 16); acc[13] = __uint_as_float(y1.z & 0xffff0000u); acc[14] = __uint_as_float(y1.w << 16); acc[15] = __uint_as_float(y1.w & 0xffff0000u);
}
__device__ __forceinline__ void scan_step(const LAS unsigned char* sl, LAS float* ybuf, f32x16 (&st)[2], int w, int lane, int r, int hh) {
    bf16x8 ar[2][4], ag[2][4]; u32x4 yi[2][2], hi[2][2];
#pragma unroll
    for (int tb = 0; tb < 2; ++tb) { const LAS u32x4* yf = (const LAS u32x4*)(sl + 24576) + ((tb * 2 + w) * 64 + lane) * 2; yi[tb][0] = yf[0]; yi[tb][1] = yf[1];
        const LAS u32x4* hf = (const LAS u32x4*)(sl + 16384) + ((tb * 2 + w) * 64 + lane) * 2; hi[tb][0] = hf[0]; hi[tb][1] = hf[1];
#pragma unroll
        for (int ks = 0; ks < 4; ++ks) { ar[tb][ks] = *(const LAS bf16x8*)(sl + 8192 + ((tb * 4 + ks) * 64 + lane) * 16); ag[tb][ks] = *(const LAS bf16x8*)(sl + ((tb * 4 + ks) * 64 + lane) * 16); } }
    bf16x8 sf[4];
    sf[0] = pack8(st[0], 0); sf[1] = pack8(st[0], 1); sf[2] = pack8(st[1], 0); sf[3] = pack8(st[1], 1);
    f32x16 ya[2], sa[2];
#pragma unroll
    for (int tb = 0; tb < 2; ++tb) { scan_unpack16(ya[tb], yi[tb][0], yi[tb][1]); scan_unpack16(sa[tb], hi[tb][0], hi[tb][1]); }
#pragma unroll
    for (int ks = 0; ks < 4; ++ks) {
        ya[0] = __builtin_amdgcn_mfma_f32_32x32x16_bf16(ar[0][ks], sf[ks], ya[0], 0, 0, 0); ya[1] = __builtin_amdgcn_mfma_f32_32x32x16_bf16(ar[1][ks], sf[ks], ya[1], 0, 0, 0);
        sa[0] = __builtin_amdgcn_mfma_f32_32x32x16_bf16(ag[0][ks], sf[ks], sa[0], 0, 0, 0); sa[1] = __builtin_amdgcn_mfma_f32_32x32x16_bf16(ag[1][ks], sf[ks], sa[1], 0, 0, 0); }
    st[0] = sa[0]; st[1] = sa[1];
#pragma unroll
    for (int tb = 0; tb < 2; ++tb)
#pragma unroll
        for (int q = 0; q < 16; ++q) ybuf[(32 * tb + (q & 3) + 8 * (q >> 2) + 4 * hh) * 64 + 32 * w + r] = ya[tb][q];
}
__device__ __forceinline__ void rwkv_scan_unit(LAS unsigned char* lds, const ScP& P, int seq0, int seqm, int nmeta, int nreal, int brow0, int hd, bool write_meta, const float* st_in, float* st_out) {
    const int tid = opq(threadIdx.x), lane = tid & 63, w = __builtin_amdgcn_readfirstlane(tid >> 6), r = lane & 31, hh = lane >> 5;
    const int N = nmeta + nreal;
    float z0 = 0.f; asm volatile("" : "+v"(z0));
    LAS float* ybuf = (LAS float*)(lds + 65536);
    f32x16 st[2]; zero16(st[0], z0); zero16(st[1], z0);
    if (st_in != nullptr && w < 2) { const GAS f32x4* sp = (const GAS f32x4*)(st_in + ((size_t)w * 64 + lane) * 32);
#pragma unroll
        for (int i = 0; i < 8; ++i) { const f32x4 v = sp[i];
#pragma unroll
            for (int j = 0; j < 4; ++j) st[i >> 2][4 * (i & 3) + j] = v[j]; } }
    const int c = hd * 64 + lane;
#define SCAN_SRC(n_) ((const GAS u32x4*)(P.CHK + ((size_t)((n_) < nmeta ? seqm : seq0 + (n_) - nmeta) * 8 + hd) * CHK_BYTES))
    u32x4 pa[4], pb[4], pc[4];
    { const GAS u32x4* s0 = SCAN_SRC(0); const GAS u32x4* s1 = SCAN_SRC(1); const GAS u32x4* s2 = SCAN_SRC(2);
#pragma unroll
      for (int i = 0; i < 4; ++i) pc[i] = s0[tid + 512 * i];
#pragma unroll
      for (int i = 0; i < 4; ++i) pa[i] = s1[tid + 512 * i];
#pragma unroll
      for (int i = 0; i < 4; ++i) pb[i] = s2[tid + 512 * i];
#pragma unroll
      for (int i = 0; i < 4; ++i) *(LAS u32x4*)(lds + (tid + 512 * i) * 16) = pc[i]; }
    lds_barrier();
#define SCAN_ITER(n_, PCUR, PMID, PNEXT) do { \
        const int n = (n_); \
        if (n + 3 < N) { const GAS u32x4* s3 = SCAN_SRC(n + 3); _Pragma("unroll") for (int i = 0; i < 4; ++i) PNEXT[i] = s3[tid + 512 * i]; } \
        if (w < 2) scan_step(lds + (n & 1) * 32768, ybuf, st, w, lane, r, hh); \
        lds_barrier(); \
        if (n + 1 < N) { _Pragma("unroll") for (int i = 0; i < 4; ++i) *(LAS u32x4*)(lds + ((n + 1) & 1) * 32768 + (tid + 512 * i) * 16) = PCUR[i]; } \
        if (w >= 2) { const int crow0 = n < nmeta ? RREAL : brow0 + 64 * (n - nmeta); const int nrow = n < nmeta ? (write_meta ? NMETA : 0) : 64; \
            for (int t = w - 2; t < nrow; t += 6) ((GAS bf16_t*)P.YS)[(size_t)(crow0 + t) * 512 + c] = f2bf_hw(ybuf[t * 64 + lane]); } \
        lds_barrier(); } while (0)
    int n3 = 0;
#pragma unroll 1
    for (; n3 + 3 <= N; n3 += 3) { SCAN_ITER(n3, pa, pb, pc); SCAN_ITER(n3 + 1, pb, pc, pa); SCAN_ITER(n3 + 2, pc, pa, pb); }
    if (N - n3 >= 1) SCAN_ITER(n3, pa, pb, pc);
    if (N - n3 >= 2) SCAN_ITER(n3 + 1, pb, pc, pa);
#undef SCAN_ITER
#undef SCAN_SRC
    if (st_out != nullptr && w < 2) { GAS f32x4* sp = (GAS f32x4*)(st_out + ((size_t)w * 64 + lane) * 32);
#pragma unroll
        for (int i = 0; i < 8; ++i) { f32x4 v;
#pragma unroll
            for (int j = 0; j < 4; ++j) v[j] = st[i >> 2][4 * (i & 3) + j];
            sp[i] = v; } }
}
struct PostP { const bf16_t* YS; const bf16_t* VP; const float* RK; const bf16_t* LO; bf16_t* MIX; const float *ln_w, *ln_b; };
__device__ __forceinline__ void rwkv_post(const PostP& P, int q, int rlo, int rhi, bool with_meta, int gw, int ngw, int lane) {
    lane = opq(lane);
    const int nreal = (rhi - rlo) * 8, ntot = nreal + (with_meta ? NMETA * 8 : 0);
    for (int item0 = gw; item0 < ntot; item0 += 4 * ngw) {
        int row[4], cc[4]; bool ok[4]; bf16_t yb[4], gb[4], vb[4]; float rk[4], lw_[4], lb_[4];
#pragma unroll
        for (int u = 0; u < 4; ++u) { const int item = item0 + u * ngw; ok[u] = item < ntot; const int it = ok[u] ? item : gw; const int ri = rlo + (it >> 3);
            row[u] = it < nreal ? (ri >> 10) * SEQ + 1024 * q + (ri & 1023) : RREAL + ((it - nreal) >> 3); const int hd = it & 7; cc[u] = hd * 64 + lane;
            yb[u] = P.YS[(size_t)row[u] * 512 + cc[u]]; gb[u] = P.LO[(size_t)row[u] * 1536 + 1024 + cc[u]]; vb[u] = P.VP[(size_t)row[u] * 512 + cc[u]]; rk[u] = P.RK[(size_t)row[u] * 8 + hd];
            lw_[u] = P.ln_w[cc[u]]; lb_[u] = P.ln_b[cc[u]]; }
#pragma unroll
        for (int u = 0; u < 4; ++u) { const float y = bf2f(yb[u]), g = bf2f(gb[u]), vp = bf2f(vb[u]);
            const float mean = wave_sum(y) * (1.f / 64.f); const float d = y - mean; const float var = wave_sum(d * d) * (1.f / 64.f);
            const float yn = d * rsqrtf(var + GN_EPS) * lw_[u] + lb_[u];
            if (ok[u]) P.MIX[(size_t)row[u] * D + 512 + cc[u]] = f2bf_hw((yn + rk[u] * vp) * g); } }
}

constexpr int LDS_BYTES = 147456, LDS_MISC = LDS_BYTES - 512;
struct Params { const float* in[33]; float* out; unsigned char* ws; };
constexpr int CW_BAR = 4096;


#ifndef PROBE_REP_MISC
#define PROBE_REP_MISC 1
#endif
#ifndef MOE_TAIL
#define MOE_TAIL 0
#endif
#ifndef PROBE_REP_OUTPROJ
#define PROBE_REP_OUTPROJ 1
#endif
#ifndef PROBE_REP_FFNDN
#define PROBE_REP_FFNDN 1
#endif
#ifndef PROBE_REP_MOEDN
#define PROBE_REP_MOEDN 1
#endif
#ifndef PROBE_REP_NORM
#define PROBE_REP_NORM 1
#endif
#ifndef PROBE_REP_INPROJ
#define PROBE_REP_INPROJ 1
#endif
#ifndef PROBE_REP_PREP
#define PROBE_REP_PREP 1
#endif
#ifndef PROBE_REP_P4A
#define PROBE_REP_P4A 1
#endif
#ifndef PROBE_REP_ATT
#define PROBE_REP_ATT 1
#endif
#ifndef PROBE_REP_P4B
#define PROBE_REP_P4B 1
#endif
#ifndef PROBE_REP_CP
#define PROBE_REP_CP 1
#endif
#ifndef PROBE_REP_SCAN
#define PROBE_REP_SCAN 1
#endif
#ifndef PROBE_REP_FFNGU
#define PROBE_REP_FFNGU 1
#endif
#ifndef PROBE_REP_MOETR
#define PROBE_REP_MOETR 1
#endif
#ifndef PROBE_REP_GATHER
#define PROBE_REP_GATHER 1
#endif
#ifndef PROBE_REP_MOEGU
#define PROBE_REP_MOEGU 1
#endif
#define LDP(k) ((const float*)ldk(kp, 8 * (k)))
#define OUTP ((float*)ldk(kp, 264))
#define WSP ((unsigned char*)ldk(kp, 272))
#define NOINL __device__ __attribute__((noinline))
#define WAVE_IDS() const int tid = threadIdx.x, lane = tid & 63, wave = __builtin_amdgcn_readfirstlane(tid >> 6), bid = (int)blockIdx.x, nblk = (int)gridDim.x, gw = bid * 8 + wave, ngw = nblk * 8; (void)lane; (void)gw; (void)ngw
NOINL void f_p0(unsigned long long kp_, LAS unsigned char* lds) {
    const unsigned long long kp = kp_uniform(kp_); WAVE_IDS(); LAS float* scr = (LAS float*)(lds + wave * 8448);
    {
        unsigned* ctl = (unsigned*)(WSP + WS_CTL);
#pragma unroll 1
        for (int te = wave; te < 24; te += 8) { const int t = te >> 3, e = te & 7;
            const float* wt = t == 0 ? LDP(30) : (t == 1 ? LDP(31) : LDP(32));
            const f32x4 v = ((const f32x4*)(wt + (size_t)e * ((size_t)D * FFE) + (size_t)(bid % 256) * 14336))[lane];
            const float m = wave_max(fmaxf(fmaxf(fabsf(v.x), fabsf(v.y)), fmaxf(fabsf(v.z), fabsf(v.w))));
            if (lane == 0) atomicMax(&ctl[CW_WMAX + te], __float_as_uint(m)); } }
    { unsigned char* ws = WSP;
      ph_init(LDP(0), LDP(1), OUTP, (float*)(ws + WS_HMETA), (float*)(ws + WS_ROPE), LDP(23), LDP(24), (bf16_t*)(ws + WS_V1T), (size_t)bid * 512 + tid, (size_t)nblk * 512); }
    int rot = 0;
#pragma unroll 1
    for (int l = 0; l < 2; ++l) { unsigned char* lw = WSP + WS_WB + l * LW_STRIDE;
        { const TrJob J{LDP(5) + (size_t)l * D * 2624, nullptr, (bf16_t*)(lw + LW_WIN), D, 2624, 1024, 0, 1, 0}; ph_transpose(J, scr, gw, ngw, lane, rot); rot += (J.K / 64) * (J.N / 32); }
        { const TrJob J{LDP(9) + (size_t)l * 512 * 768, LDP(7) + l * 512, (bf16_t*)(lw + LW_WUQ), 512, 768, 512, 0, 0, 0}; ph_transpose(J, scr, gw, ngw, lane, rot); rot += (J.K / 64) * (J.N / 32); }
        { const TrJob J{LDP(10) + (size_t)l * 256 * 1024, LDP(8) + l * 256, (bf16_t*)(lw + LW_WK), 256, 1024, 256, 0, 4, 0}; ph_transpose(J, scr, gw, ngw, lane, rot); rot += (J.K / 64) * (J.N / 32); }
        { const TrJob J{LDP(13) + (size_t)l * 64 * 512, nullptr, (bf16_t*)(lw + LW_LORA), 64, 512, 256, 0, 0, 0}; ph_transpose(J, scr, gw, ngw, lane, rot); rot += (J.K / 64) * (J.N / 32); }
        { const TrJob J{LDP(15) + (size_t)l * 64 * 512, nullptr, (bf16_t*)(lw + LW_LORA), 64, 512, 256, 64, 0, 512}; ph_transpose(J, scr, gw, ngw, lane, rot); rot += (J.K / 64) * (J.N / 32); }
        { const TrJob J{LDP(16) + (size_t)l * 128 * 512, nullptr, (bf16_t*)(lw + LW_LORA), 128, 512, 256, 128, 0, 1024}; ph_transpose(J, scr, gw, ngw, lane, rot); rot += (J.K / 64) * (J.N / 32); }
        { const TrJob J{LDP(6) + (size_t)l * D * D, nullptr, (bf16_t*)(lw + LW_WOUT), D, D, 1024, 0, 0, 0}; ph_transpose(J, scr, gw, ngw, lane, rot); rot += (J.K / 64) * (J.N / 32); }
    }
    { const TrJob J{LDP(25), nullptr, (bf16_t*)(WSP + WS_FGU), D, FF0, 1024, 0, 2, 0}; ph_transpose(J, scr, gw, ngw, lane, rot); rot += (J.K / 64) * (J.N / 32); }
    { const TrJob J{LDP(26), nullptr, (bf16_t*)(WSP + WS_FGU), D, FF0, 1024, 0, 3, 0}; ph_transpose(J, scr, gw, ngw, lane, rot); rot += (J.K / 64) * (J.N / 32); }
    { const TrJob J{LDP(27), nullptr, (bf16_t*)(WSP + WS_FDN), FF0, D, FF0, 0, 0, 0}; ph_transpose(J, scr, gw, ngw, lane, rot); rot += (J.K / 64) * (J.N / 32); }
}
NOINL void f_rmsnorm(unsigned long long kp_, int which, int l) { const unsigned long long kp = kp_uniform(kp_); which = __builtin_amdgcn_readfirstlane(which); l = __builtin_amdgcn_readfirstlane(l); WAVE_IDS(); unsigned char* ws = WSP;
    const float* hsrc = (which == 0 && l == 0) ? LDP(0) : (const float*)OUTP;
    ph_rmsnorm(hsrc, (const float*)(ws + WS_HMETA), (which ? LDP(3) : LDP(2)) + l * D, (bf16_t*)(ws + A_U), (const float*)(ws + A_PART), which ? 4 : (l ? 11 : 0), gw, ngw, lane); }
NOINL void f_prep(unsigned long long kp_, int l) { const unsigned long long kp = kp_uniform(kp_); l = __builtin_amdgcn_readfirstlane(l); WAVE_IDS(); unsigned char* ws = WSP;
    ph_prep((const bf16_t*)(ws + A_PM), (const bf16_t*)(ws + A_PR), LDP(11) + l * 1792, (const float*)(ws + WS_ROPE), (float*)(ws + A_RSTDQ), (float*)(ws + A_RSTDKV),
            (bf16_t*)(ws + A_KROPE), (bf16_t*)(ws + A_LIN), (bf16_t*)(ws + A_VSH), l, gw, ngw, lane); }
constexpr int RW_NSEQ = 129;
constexpr size_t RW_BUF = (size_t)RW_NSEQ * 8 * CHK_BYTES;
static_assert(2 * RW_BUF <= A_VFIRST - A_CHK, "two chunk buffers fit the chunk region");
constexpr int RW_SKIP = 4;
__device__ __forceinline__ bool rw_is_scan_wg(int bid) { return (bid & 3) == 0; }
__device__ __forceinline__ int rw_rank(int bid) { return bid - (bid >> 2) - 1; }
__device__ __forceinline__ void f_rwkv_cp(unsigned long long kp_, LAS unsigned char* lds, int l, int q) {
    const unsigned long long kp = kp_uniform(kp_); l = __builtin_amdgcn_readfirstlane(l); q = __builtin_amdgcn_readfirstlane(q);
    const int bid = (int)blockIdx.x, nblk = (int)gridDim.x; unsigned char* ws = WSP;
    const CpP cp{(const bf16_t*)(ws + A_PR), (const bf16_t*)(ws + A_LOUT), (const bf16_t*)(ws + A_VMIX), (const bf16_t*)(ws + A_VFIRST), (bf16_t*)(ws + (l ? A_VP : A_VFIRST)), (float*)(ws + A_RK), ws + A_CHK + (size_t)(q & 1) * RW_BUF,
                 LDP(11) + l * 1792, LDP(12) + l * 512, LDP(14) + l * 512, LDP(17) + l * 512, LDP(18) + l * 512, LDP(19) + l * 512, LDP(22), l, 0};
    const int ntask = (q == 0 ? RW_NSEQ : RW_NSEQ - 1) * 8, hs = q == 0 ? 0 : RW_SKIP, NS = nblk - ((nblk + 3) >> 2);
    const bool scanwg = rw_is_scan_wg(bid); const int rank = rw_rank(bid);
#define RW_TASK(i_) (scanwg ? hs * NS + (i_) * nblk + bid : ((i_) < hs ? (i_) * NS + rank : hs * NS + ((i_) - hs) * nblk + bid))
#define RW_ROW0(t_) (((t_) >> 3) == 128 ? RREAL : ((t_) >> 7) * SEQ + (16 * q + (((t_) >> 3) & 15)) * 64)
    const int tid_ = opq(threadIdx.x), lane_ = tid_ & 63, w_ = __builtin_amdgcn_readfirstlane(tid_ >> 6);
    int task = RW_TASK(0); if (task >= ntask) return;
    CpRaw raw; cp_issue(cp, RW_ROW0(task), task & 7, w_, lane_, raw);
#pragma unroll 1
    for (int i = 0; ; ++i) { const int nxt = RW_TASK(i + 1); const bool has_next = nxt < ntask;
        rwkv_cp_task(lds, cp, RW_ROW0(task), task & 7, cp.CHK + (size_t)task * CHK_BYTES, raw, has_next, has_next ? RW_ROW0(nxt) : 0, nxt & 7);
        if (!has_next) break;
        task = nxt; }
#undef RW_TASK
#undef RW_ROW0
}
__device__ __forceinline__ void f_rwkv_scan(unsigned long long kp_, LAS unsigned char* lds, int l, int q) {
    const unsigned long long kp = kp_uniform(kp_); l = __builtin_amdgcn_readfirstlane(l); q = __builtin_amdgcn_readfirstlane(q);
    const int bid = (int)blockIdx.x, nblk = (int)gridDim.x; if (!rw_is_scan_wg(bid)) return;
    unsigned char* ws = WSP; const ScP sp{ws + A_CHK + (size_t)(q & 1) * RW_BUF, (bf16_t*)(ws + A_YS)};
#pragma unroll 1
    for (int unit = bid >> 2; unit < 64; unit += (nblk + 3) >> 2) { const int b = unit >> 3, hd = unit & 7; float* stp = (float*)(ws + A_SCST) + (size_t)unit * 4096;
        rwkv_scan_unit(lds, sp, b * 16, 128, q == 0 ? 1 : 0, 16, b * SEQ + q * 1024, hd, q == 0 && b == 0, q == 0 ? nullptr : stp, q == 3 ? nullptr : stp); }
}
__device__ __forceinline__ void f_rwkv_post(unsigned long long kp_, int l, int q, int mode) {
    const unsigned long long kp = kp_uniform(kp_); l = __builtin_amdgcn_readfirstlane(l); q = __builtin_amdgcn_readfirstlane(q); mode = __builtin_amdgcn_readfirstlane(mode); WAVE_IDS(); unsigned char* ws = WSP;
    const PostP pp{(const bf16_t*)(ws + A_YS), (const bf16_t*)(ws + (l ? A_VP : A_VFIRST)), (const float*)(ws + A_RK), (const bf16_t*)(ws + A_LOUT), (bf16_t*)(ws + A_PM), LDP(20) + l * 512, LDP(21) + l * 512};
    const bool scanwg = rw_is_scan_wg(bid); const int nscan = (nblk + 3) >> 2, NS = nblk - nscan;
    if (mode == 2) rwkv_post(pp, q, 0, 8192, q == 0, gw, ngw, lane);
    else if (mode == 1) { if (!scanwg) rwkv_post(pp, q, 0, 8192, q == 0, rw_rank(bid) * 8 + wave, NS * 8, lane); }
    else if (scanwg) rwkv_post(pp, q, 0, 4096, false, (bid >> 2) * 8 + wave, nscan * 8, lane);
    else rwkv_post(pp, q, 4096, 8192, q == 0, rw_rank(bid) * 8 + wave, NS * 8, lane); }
NOINL void f_ffn_meta(unsigned long long kp_) {
    const unsigned long long kp = kp_uniform(kp_); WAVE_IDS(); unsigned char* ws = WSP;
    const int job = bid * 8 + wave; if (job >= FF0 / 16) return;
    const int f0 = job * 16, l15 = lane & 15, kq = lane >> 4;
    const bf16_t* wg = (const bf16_t*)(ws + WS_FGU) + (size_t)((f0 >> 7) * 256 + (f0 & 127) + l15) * 1024 + 8 * kq;
    const bf16_t* wu = wg + (size_t)128 * 1024;
    const bf16_t* xu = (const bf16_t*)(ws + A_U) + (size_t)(RREAL + l15) * D + 8 * kq;
    f32x4 ag = {0.f, 0.f, 0.f, 0.f}, au = {0.f, 0.f, 0.f, 0.f};
#pragma unroll 8
    for (int ks = 0; ks < 32; ++ks) { const bf16x8 a = *(const GAS bf16x8*)(wg + 32 * ks), b = *(const GAS bf16x8*)(wu + 32 * ks), x = *(const GAS bf16x8*)(xu + 32 * ks);
        ag = __builtin_amdgcn_mfma_f32_16x16x32_bf16(a, x, ag, 0, 0, 0); au = __builtin_amdgcn_mfma_f32_16x16x32_bf16(b, x, au, 0, 0, 0); }
    float r[4];
#pragma unroll
    for (int j = 0; j < 4; ++j) { const float g = ag[j], up = au[j]; r[j] = g / (1.0f + __expf(-g)) * up; }
    u32x2 o; o.x = cvtpk(r[0], r[1]); o.y = cvtpk(r[2], r[3]);
    *(GAS u32x2*)((bf16_t*)(ws + A_ACT0) + (size_t)(RREAL + l15) * FF0 + f0 + 4 * kq) = o;
}
NOINL void f_moe_tr(unsigned long long kp_, LAS unsigned char* lds) {
    const unsigned long long kp = kp_uniform(kp_); WAVE_IDS(); LAS float* scr = (LAS float*)(lds + wave * 8448);
    if (bid == 0 && tid < 24) { unsigned* ctlw = (unsigned*)(WSP + WS_CTL); const float sc = moe_wscale_bits(ctlw[CW_WMAX + tid]); ctlw[CW_WINV + tid] = __float_as_uint(1.0f / (F8_ACT * sc)); }
    int rot = 0;
#pragma unroll 1
    for (int e = 0; e < NEXP * PROBE_REP_MOETR; ++e) { const int ee = e % NEXP;
        const unsigned* ctl = (const unsigned*)(WSP + WS_CTL);
        { const TrJob8 J{LDP(30) + (size_t)ee * D * FFE, WSP + A_MGU, D, FFE, 1024, 2, ee * 2 * FFE, moe_wscale(ctl, 0, ee)}; ph_transpose_f8(J, scr, gw, ngw, lane, rot); rot += (J.K / 64) * (J.N / 32); }
        { const TrJob8 J{LDP(31) + (size_t)ee * D * FFE, WSP + A_MGU, D, FFE, 1024, 3, ee * 2 * FFE, moe_wscale(ctl, 1, ee)}; ph_transpose_f8(J, scr, gw, ngw, lane, rot); rot += (J.K / 64) * (J.N / 32); }
        { const TrJob8 J{LDP(32) + (size_t)ee * FFE * D, WSP + A_MDN, FFE, D, FFE, 0, ee * D, moe_wscale(ctl, 2, ee)}; ph_transpose_f8(J, scr, gw, ngw, lane, rot); rot += (J.K / 64) * (J.N / 32); }
    }
}
__device__ __forceinline__ void f_moe_route(unsigned long long kp_, LAS unsigned char* lds) {
    const unsigned long long kp = kp_uniform(kp_); WAVE_IDS(); unsigned char* ws = WSP;
    ph_norm_route(lds, OUTP, LDP(3) + D, LDP(28), LDP(29), (bf16_t*)(ws + A_U), (int*)(ws + A_MTAB + MT_E), (float*)(ws + A_MTAB + MT_G), (int*)(ws + A_MTAB + MT_STOK), (unsigned*)(ws + WS_CTL), bid, nblk, wave, lane); }
NOINL void f_moe_assign(unsigned long long kp_, LAS unsigned char* lds, int list) { const unsigned long long kp = kp_uniform(kp_); list = __builtin_amdgcn_readfirstlane(list); WAVE_IDS(); unsigned char* ws = WSP;
    ph_moe_assign(lds, list, (const int*)(ws + A_MTAB + MT_E), (const float*)(ws + A_MTAB + MT_G), (int*)(ws + A_MTAB + MT_STOK), (float*)(ws + A_MTAB + MT_SGATE), (int*)(ws + A_MTAB + MT_BE), (unsigned*)(ws + WS_CTL), ws + A_U, ws + A_XB, bid, nblk, tid); }
NOINL void f_final(unsigned long long kp_) { const unsigned long long kp = kp_uniform(kp_); WAVE_IDS(); unsigned char* ws = WSP; ph_final(OUTP, LDP(4), (const int*)(ws + A_MTAB + MT_TSLOT), (const float*)(ws + WS_TB), gw, ngw, lane); }

__global__ void __launch_bounds__(512, 2) fwd(Params P) {
    extern __shared__ __attribute__((aligned(16))) unsigned char lds_raw[];
    LAS unsigned char* lds = (LAS unsigned char*)lds_raw;
    const int tid = threadIdx.x;
    const int bid = (int)blockIdx.x, nblk = (int)gridDim.x;
    const unsigned long long kp = (unsigned long long)__builtin_amdgcn_kernarg_segment_ptr();
    volatile LAS unsigned* misc = (volatile LAS unsigned*)(lds + LDS_MISC);
    if (tid < 64) misc[tid] = 0u;
    __syncthreads();
    XcdBarrier bar;
    { unsigned* ctl0 = (unsigned*)(WSP + WS_CTL); bar = xcd_barrier_post(ctl0 + CW_BAR, misc + 8); }
#ifdef PROBE_BAR2
#define GRID_BAR() do { xcd_barrier(bar); xcd_barrier(bar); } while (0)
#else
#define GRID_BAR() xcd_barrier(bar)
#endif
    for (int rep_ = 0; rep_ < PROBE_REP_MISC; ++rep_) f_p0(kp, lds);
    GRID_BAR();

#pragma unroll 1
    for (int l = 0; l < 2; ++l) {
        for (int rep_ = 0; rep_ < PROBE_REP_NORM; ++rep_) f_rmsnorm(kp, 0, l);
        GRID_BAR();
_Pragma("unroll 1") for (int rep_ = 0; rep_ < PROBE_REP_INPROJ; ++rep_) {
        { unsigned char* ws = WSP; pg8::Gemm g{(const bf16_t*)(ws + A_U), (const bf16_t*)(ws + WS_WB + l * LW_STRIDE + LW_WIN), RP, 2816, 1024, 1024, 1024, 0}; pg8::StaticOrder S; S.init(RP, 2816, opqs(nblk), opqs(bid));
          EpiInProj E{(bf16_t*)(ws + A_PM), (bf16_t*)(ws + A_PR)};
          pg8::gemm_phase<EpiInProj, pg8::StaticOrder, true, true>(lds, g, S, E); }
}
        GRID_BAR();
        for (int rep_ = 0; rep_ < PROBE_REP_PREP; ++rep_) f_prep(kp, l);
        GRID_BAR();
_Pragma("unroll 1") for (int rep_ = 0; rep_ < PROBE_REP_P4A; ++rep_) {
        { unsigned char* ws = WSP; pg8::Gemm g{(const bf16_t*)(ws + A_PM), (const bf16_t*)(ws + WS_WB + l * LW_STRIDE + LW_WUQ), RP, 768, 512, 1024, 512, 0}; pg8::StaticOrder S; S.init(RP, 768, opqs(nblk), opqs(bid));
          EpiRowScale E{(bf16_t*)(ws + A_U), (const float*)(ws + A_RSTDQ), 768, 0};
          pg8::gemm_phase<EpiRowScale, pg8::StaticOrder, true, true>(lds, g, S, E); }
        { unsigned char* ws = WSP; pg8::Gemm g{(const bf16_t*)(ws + A_PM) + 512, (const bf16_t*)(ws + WS_WB + l * LW_STRIDE + LW_WK), RP, 512, 256, 1024, 256, 0}; pg8::StaticOrder S; S.init(RP, 512, opqs(nblk), opqs((bid + nblk - 131) % nblk));
          EpiRowScale E{(bf16_t*)(ws + A_KN), (const float*)(ws + A_RSTDKV), 512, 0};
          pg8::gemm_phase<EpiRowScale, pg8::StaticOrder, true, true>(lds, g, S, E); }
        { unsigned char* ws = WSP; pg8::Gemm g{(const bf16_t*)(ws + WS_WB + l * LW_STRIDE + LW_WV), (const bf16_t*)(ws + A_PM) + 512, 512, RP, 256, 256, 1024, 0}; pg8::StaticOrder S; S.init(512, RP, opqs(nblk), opqs((bid + nblk - 133) % nblk));
          EpiColScale E{(bf16_t*)(ws + A_VT), (const float*)(ws + A_RSTDKV), RP, 0};
          pg8::gemm_phase<EpiColScale, pg8::StaticOrder, true, true>(lds, g, S, E); }
}
        GRID_BAR();
_Pragma("unroll 1") for (int rep_ = 0; rep_ < PROBE_REP_ATT; ++rep_) {
        { unsigned char* ws = WSP; attn_phase(lds, (const bf16_t*)(ws + A_U), (const bf16_t*)(ws + A_KN), (const bf16_t*)(ws + A_KROPE), (const bf16_t*)(ws + A_VT), (bf16_t*)(ws + A_PM), (const float*)(ws + WS_ROPE), opqs(bid), opqs(nblk)); }
}
        GRID_BAR();
_Pragma("unroll 1") for (int rep_ = 0; rep_ < PROBE_REP_P4B; ++rep_) {
        { unsigned char* ws = WSP; pg8::Gemm g{(const bf16_t*)(ws + A_LIN), (const bf16_t*)(ws + WS_WB + l * LW_STRIDE + LW_LORA), RP, 1536, 256, 256, 256, 0}; pg8::StaticOrder S; S.init(RP, 1536, opqs(nblk), opqs(bid));
          EpiRowScale E{(bf16_t*)(ws + A_LOUT), nullptr, 1536, 0};
          pg8::gemm_phase<EpiRowScale, pg8::StaticOrder, true, true>(lds, g, S, E); }
        if (l == 1) {
            unsigned char* ws = WSP; pg8::Gemm g{(const bf16_t*)(ws + A_VSH), (const bf16_t*)(ws + WS_V1T), RP, 512, 512, 512, 512, 0}; pg8::StaticOrder S; S.init(RP, 512, opqs(nblk), opqs((bid + nblk - 6) % nblk));
            EpiRowScale E{(bf16_t*)(ws + A_VMIX), nullptr, 512, 0};
            pg8::gemm_phase<EpiRowScale, pg8::StaticOrder, true, true>(lds, g, S, E);
        }
}
        GRID_BAR();
#pragma unroll 1
        for (int stp = 0; stp < 6; ++stp) {
            if (stp >= 1 && stp <= 4) { _Pragma("unroll 1") for (int rep_ = 0; rep_ < PROBE_REP_SCAN; ++rep_) f_rwkv_scan(kp, lds, l, stp - 1); }
            if (stp <= 3) { _Pragma("unroll 1") for (int rep_ = 0; rep_ < PROBE_REP_CP; ++rep_) f_rwkv_cp(kp, lds, l, stp); }
            if (stp >= 2) { for (int rep_ = 0; rep_ < PROBE_REP_MISC; ++rep_) f_rwkv_post(kp, l, stp - 2, stp <= 3 ? 0 : stp - 3); }
            GRID_BAR();
        }
_Pragma("unroll 1") for (int rep_ = 0; rep_ < PROBE_REP_OUTPROJ; ++rep_) {
        { unsigned char* ws = WSP; pg8::Gemm g{(const bf16_t*)(ws + A_PM), (const bf16_t*)(ws + WS_WB + l * LW_STRIDE + LW_WOUT), RREAL, 1024, 1024, 1024, 1024, 0}; pg8::StaticOrder S; S.init(RREAL, 1024, opqs(nblk), opqs(bid));
          EpiResid E{OUTP, (float*)(ws + WS_HMETA), (l == 0 && rep_ == 0) ? LDP(0) : (const float*)OUTP, rep_ == 0 ? 1.0f : 0.0f, 0};
          pg8::gemm_phase<EpiResid, pg8::StaticOrder, true, true>(lds, g, S, E); }
        if (rep_ == 0 && l == 0) {
          unsigned char* ws = WSP; pg8::Gemm g{(const bf16_t*)(ws + A_PM), (const bf16_t*)(ws + WS_WB + l * LW_STRIDE + LW_WOUT), RP, 1024, 256, 1024, 1024, 0};
          const DenseTailOrder S{4, 4, opqs(nblk), opqs(bid)}; EpiResidPartial E{(float*)(ws + A_PART)};
          pg8::gemm_phase<EpiResidPartial, DenseTailOrder, true, true>(lds, g, S, E); }
}
        GRID_BAR();
        if (l == 0) {
            for (int rep_ = 0; rep_ < PROBE_REP_MISC; ++rep_) f_rmsnorm(kp, 1, 0);
            GRID_BAR();
_Pragma("unroll 1") for (int rep_ = 0; rep_ < PROBE_REP_FFNGU; ++rep_) {
            f_ffn_meta(kp);
            { unsigned char* ws = WSP; pg8::Gemm g{(const bf16_t*)(ws + A_U), (const bf16_t*)(ws + WS_FGU), RREAL, 2 * FF0, 1024, 1024, 1024, 0}; pg8::StaticOrder S; S.init(RREAL, 2 * FF0, opqs(nblk), opqs(bid));
              EpiSwiGLU E{(bf16_t*)(ws + A_ACT0), FF0, 22, 0, 0};
              pg8::gemm_phase<EpiSwiGLU, pg8::StaticOrder, true, true>(lds, g, S, E); }
}
            GRID_BAR();
_Pragma("unroll 1") for (int rep_ = 0; rep_ < PROBE_REP_FFNDN; ++rep_) {
            { unsigned char* ws = WSP; pg8::Gemm g{(const bf16_t*)(ws + A_ACT0), (const bf16_t*)(ws + WS_FDN), RREAL, 1024, FF0, FF0, FF0, 0}; pg8::StaticOrder S; S.init(RREAL, 1024, opqs(nblk), opqs(bid));
              EpiResid E{OUTP, (float*)(ws + WS_HMETA), (const float*)OUTP, rep_ == 0 ? 1.0f : 0.0f, 0};
              pg8::gemm_phase<EpiResid, pg8::StaticOrder, true, true>(lds, g, S, E); }
            if (rep_ == 0) {
              unsigned char* ws = WSP; pg8::Gemm g{(const bf16_t*)(ws + A_ACT0), (const bf16_t*)(ws + WS_FDN), RP, 1024, 256, FF0, FF0, 0};
              const DenseTailOrder S{4, 11, opqs(nblk), opqs(bid)}; EpiResidPartial E{(float*)(ws + A_PART)};
              pg8::gemm_phase<EpiResidPartial, DenseTailOrder, true, true>(lds, g, S, E); }
}
            GRID_BAR();
        } else {
            f_moe_tr(kp, lds);
            f_moe_route(kp, lds);
            GRID_BAR();
            f_moe_assign(kp, lds, 0);
            f_moe_assign(kp, lds, 1);
            GRID_BAR();
#pragma unroll 1
            for (int list = 0; list < 2; ++list) {
                const int np0 = __builtin_amdgcn_readfirstlane((int)((const unsigned*)(WSP + WS_CTL))[CW_NPAN]), np1 = __builtin_amdgcn_readfirstlane((int)((const unsigned*)(WSP + WS_CTL))[CW_NPAN + 1]);
                const int T0 = np0 > MOE_TAILPAN ? (np0 - MOE_TAILPAN) * 4 : 0, T1 = np1 > MOE_TAILPAN ? (np1 - MOE_TAILPAN) * 4 : 0;
                if (list == 1) {
                    { unsigned char* ws = WSP; pg8::Gemm g{(const bf16_t*)(ws + A_MACT), (const bf16_t*)(ws + A_MDN), 0, 0, FFE / 2, FFE / 2, FFE / 2, 0};
                      const MoeShiftTailOrder S{(const int*)(ws + A_MTAB + MT_BE), (const unsigned*)(ws + WS_CTL) + CW_NPAN, 4, 4, 0, opqs(nblk) - 1, opqs(bid), 0};
                      EpiMoeDown E{OUTP, (const int*)(ws + A_MTAB + MT_STOK), (const float*)(ws + A_MTAB + MT_SGATE), 4, 1.0f, (const unsigned*)(ws + WS_CTL)};
                      pg8::gemm_phase<EpiMoeDown, MoeShiftTailOrder, true, true, true>(lds, g, S, E); }
                    { unsigned char* ws = WSP; pg8::Gemm g{(const bf16_t*)(ws + A_MACT), (const bf16_t*)(ws + A_MDN), 0, 0, FFE / 2, FFE / 2, FFE / 2, 0};
                      const MoeShiftTailOrder S{(const int*)(ws + A_MTAB + MT_BE) + 256, (const unsigned*)(ws + WS_CTL) + CW_NPAN + 1, 4, 4, MOE_GAP, opqs(nblk) - 1 - T0, opqs(bid), 0};
                      EpiMoeDownStore E{(float*)(ws + WS_TB), (const int*)(ws + A_MTAB + MT_STOK) + MOE_MAXPAN * 256, (const float*)(ws + A_MTAB + MT_SGATE) + MOE_MAXPAN * 256, 4, MOE_TAILPAN + MOE_GAP, (const unsigned*)(ws + WS_CTL)};
                      pg8::gemm_phase<EpiMoeDownStore, MoeShiftTailOrder, true, true, true>(lds, g, S, E); }
                }
_Pragma("unroll 1") for (int rep_ = 0; rep_ < PROBE_REP_MOEGU; ++rep_) {
                { unsigned char* ws = WSP; pg8::Gemm g{(const bf16_t*)(ws + A_XB + (size_t)list * XB_LIST), (const bf16_t*)(ws + A_MGU), 0, 0, 512, 512, 512, 0};
                  const int Tt = list == 1 && T0 + T1 < opqs(nblk) ? T0 + T1 : 0;
                  const MoeSlotOrder S{(const int*)(ws + A_MTAB + MT_BE) + 256 * list, (const unsigned*)(ws + WS_CTL) + CW_NPAN + list, (const int*)(ws + A_MTAB + MT_STOK) + list * MOE_MAXPAN * 256, 28, 28, 0, opqs(nblk), opqs(bid), RREAL,
                                         0, list == 0 ? MOE_MAXPAN : MOE_TAILPAN, 0, 0, Tt, MOE_CSKIP};
                  EpiSwiGLU8 E{ws + A_MACT, (const unsigned*)(ws + WS_CTL), FFE, 28};
                  pg8::gemm_phase<EpiSwiGLU8, MoeSlotOrder, true, true, true>(lds, g, S, E); }
                if (list == 0) {
                  unsigned char* ws = WSP; pg8::Gemm g{(const bf16_t*)(ws + A_XB + XB_LIST), (const bf16_t*)(ws + A_MGU), 0, 0, 512, 512, 512, 0};
                  const int nb = opqs(nblk);
                  const MoeSlotOrder S{(const int*)(ws + A_MTAB + MT_BE) + 256, (const unsigned*)(ws + WS_CTL) + CW_NPAN + 1, (const int*)(ws + A_MTAB + MT_STOK) + MOE_MAXPAN * 256, 28, 28, 0, nb, opqs(bid), RREAL,
                                         MOE_TAILPAN, MOE_MAXPAN, MOE_GAP, (np0 * 28) % nb, 0, 0};
                  EpiSwiGLU8 E{ws + A_MACT, (const unsigned*)(ws + WS_CTL), FFE, 28};
                  pg8::gemm_phase<EpiSwiGLU8, MoeSlotOrder, true, true, true>(lds, g, S, E); }
}
                GRID_BAR();
_Pragma("unroll 1") for (int rep_ = 0; rep_ < PROBE_REP_MOEDN; ++rep_) {
                { unsigned char* ws = WSP; pg8::Gemm g{(const bf16_t*)(ws + A_MACT), (const bf16_t*)(ws + A_MDN), 0, 0, FFE / 2, FFE / 2, FFE / 2, 0};
                  const MoeOrder S{(const int*)(ws + A_MTAB + MT_BE) + 256 * list, (const unsigned*)(ws + WS_CTL) + CW_NPAN + list, 4, 4, 0, opqs(nblk), opqs(bid), MOE_TAILPAN * 4};
                  EpiMoeDown E{OUTP, (const int*)(ws + A_MTAB + MT_STOK) + list * MOE_MAXPAN * 256, (const float*)(ws + A_MTAB + MT_SGATE) + list * MOE_MAXPAN * 256, 4, rep_ == 0 ? 1.0f : 0.0f, (const unsigned*)(ws + WS_CTL)};
                  pg8::gemm_phase<EpiMoeDown, MoeOrder, true, true, true>(lds, g, S, E); }
}
                GRID_BAR();
            }
        }
    }
    f_final(kp);
}

extern "C" void kernel_launch(void* const* d_in, const int* in_sizes, int n_in, void* d_out, int out_size, void* d_ws, size_t ws_size, hipStream_t stream) {
    static int grid = 0;
    if (grid == 0) {
        if (n_in != 33 || ws_size < WS_NEED || out_size != RREAL * D) { fprintf(stderr, "kernel_launch: unexpected arguments (n_in %d, ws %zu need %zu, out %d)\n", n_in, ws_size, (size_t)WS_NEED, out_size); grid = -1; return; }
        int dev = 0, cus = 0;
        if (hipGetDevice(&dev) != hipSuccess || hipDeviceGetAttribute(&cus, hipDeviceAttributeMultiprocessorCount, dev) != hipSuccess) { grid = -1; return; }
        if (hipFuncSetAttribute((const void*)fwd, hipFuncAttributeMaxDynamicSharedMemorySize, LDS_BYTES) != hipSuccess) { fprintf(stderr, "kernel_launch: hipFuncSetAttribute failed\n"); grid = -1; return; }
        int per_cu = 0; (void)hipOccupancyMaxActiveBlocksPerMultiprocessor(&per_cu, (const void*)fwd, 512, LDS_BYTES); (void)hipGetLastError();
        grid = cus;
    }
    if (grid < 0) return;
    unsigned char* ws = (unsigned char*)d_ws;
    (void)hipMemsetAsync(ws + WS_CTL, 0, 1 * MiB, stream);
    (void)hipMemsetAsync(ws + WS_WB, 0, WS_ROPE - WS_WB, stream);
    Params p{};
    for (int i = 0; i < 33; ++i) p.in[i] = (const float*)d_in[i];
    p.out = (float*)d_out; p.ws = ws;
    hipLaunchKernelGGL(fwd, dim3(grid), dim3(512), LDS_BYTES, stream, p);
}
```
